# Optimizing an MI355X kernel written in HIP

```python
import math
import jax, jax.numpy as jnp
from jax import lax
import numpy as np

D_MODEL = 1024
BATCH = 16
SEQ = 2048
DEPTH = 1

CHUNK = 64
Q_BLOCK = 128
N_HEADS_A = 4
HEAD_DIM_A = 128
D_QK_A = 2 * N_HEADS_A * HEAD_DIM_A
D_V_A = 2 * N_HEADS_A * HEAD_DIM_A
D_CONV = D_MODEL
CONV_WIDTH = 3
N_BUCKETS = 32
MAX_DISTANCE = 128
N_GROUPS = 4
EXPERTS_PER_GROUP = 8
N_EXPERTS = N_GROUPS * EXPERTS_PER_GROUP
TOP_K = 2
D_EXPERT = 512
MOE_BLOCK = 512
LN_EPS = 1e-5
RMS_EPS = 1e-6
DEEPNORM_ALPHA = (2.0 * DEPTH) ** 0.25
DEEPNORM_BETA = (8.0 * DEPTH) ** -0.25
N_IN = 2 * D_QK_A + D_V_A + 3 * D_CONV + 2 * D_MODEL
SPLITS = (D_QK_A, 2 * D_QK_A, 2 * D_QK_A + D_V_A,
          2 * D_QK_A + D_V_A + D_CONV, 2 * D_QK_A + D_V_A + 2 * D_CONV,
          2 * D_QK_A + D_V_A + 3 * D_CONV, 2 * D_QK_A + D_V_A + 3 * D_CONV + D_MODEL)

kernel_name = 'hybrid_diffattn_shortconv_hiermoe_deepnorm'


def layer_norm(x, g, b):
    xf = x.astype(jnp.float32)
    mu = jnp.mean(xf, axis=-1, keepdims=True)
    var = jnp.mean(jnp.square(xf - mu), axis=-1, keepdims=True)
    y = (xf - mu) * lax.rsqrt(var + LN_EPS) * g.astype(jnp.float32) + b.astype(jnp.float32)
    return y.astype(x.dtype)


def t5_bucket(rel):
    nb = N_BUCKETS // 2
    max_exact = nb // 2
    bucket = jnp.where(rel > 0, nb, 0)
    n = jnp.abs(rel)
    nf = jnp.maximum(n, 1).astype(jnp.float32)
    large = max_exact + (jnp.log(nf / max_exact) / math.log(MAX_DISTANCE / max_exact)
                         * (nb - max_exact)).astype(jnp.int32)
    large = jnp.minimum(large, nb - 1)
    return bucket + jnp.where(n < max_exact, n, large)


def diff_attention(q, k, v, rel_bias, lam, lam_init, subln_g):
    bsz, seq = q.shape[0], q.shape[1]
    scale = HEAD_DIM_A ** -0.5
    outs = []
    for qb in range(seq // Q_BLOCK):
        q0 = qb * Q_BLOCK
        kv_end = q0 + Q_BLOCK
        q_blk = q[:, q0:kv_end]
        k_blk = k[:, :kv_end]
        v_blk = v[:, :kv_end]
        qpos = jnp.arange(q0, kv_end, dtype=jnp.int32)
        kpos = jnp.arange(kv_end, dtype=jnp.int32)
        bias = rel_bias.astype(jnp.float32)[t5_bucket(kpos[None, :] - qpos[:, None])]
        bias = jnp.transpose(bias, (2, 0, 1))
        allowed = (kpos[None, :] // CHUNK) <= (qpos[:, None] // CHUNK)
        logits = jnp.einsum('bqhmd,bkhmd->bhmqk', q_blk, k_blk).astype(jnp.float32) * scale
        logits = logits + bias[None, :, None]
        logits = jnp.where(allowed, logits, -jnp.inf)
        p = jax.nn.softmax(logits, axis=-1)
        attn = p[:, :, 0] - lam * p[:, :, 1]
        outs.append(jnp.einsum('bhqk,bkhd->bqhd', attn.astype(v.dtype), v_blk))
    o = jnp.concatenate(outs, axis=1)
    of = o.astype(jnp.float32)
    of = of * lax.rsqrt(jnp.mean(jnp.square(of), axis=-1, keepdims=True) + RMS_EPS)
    of = of * subln_g.astype(jnp.float32) * (1.0 - lam_init)
    return of.astype(o.dtype).reshape(bsz, seq, N_HEADS_A * 2 * HEAD_DIM_A)


def mixer_block(u, w_in, b_gate, lambda_q, lambda_k, subln_g, rel_bias, conv_w,
                w_a_proj, w_b_proj, w_o, lam_init):
    bsz, seq, _ = u.shape
    proj = u @ w_in
    q, k, v, cb, cc, ch, ga, gb = jnp.split(proj, SPLITS, axis=-1)
    q = q.reshape(bsz, seq, N_HEADS_A, 2, HEAD_DIM_A)
    k = k.reshape(bsz, seq, N_HEADS_A, 2, HEAD_DIM_A)
    v = v.reshape(bsz, seq, N_HEADS_A, 2 * HEAD_DIM_A)
    lq = lambda_q.astype(jnp.float32)
    lk = lambda_k.astype(jnp.float32)
    lam = jnp.exp(jnp.sum(lq[0] * lk[0])) - jnp.exp(jnp.sum(lq[1] * lk[1])) + lam_init
    y_a = diff_attention(q, k, v, rel_bias, lam, lam_init, subln_g) @ w_a_proj
    z = cc * ch
    z = lax.conv_general_dilated(z, conv_w, window_strides=(1,),
                                 padding=[(CONV_WIDTH - 1, 0)],
                                 dimension_numbers=('NWC', 'WIO', 'NWC'),
                                 feature_group_count=D_CONV)
    y_b = (cb * z) @ w_b_proj
    g_a = jax.nn.sigmoid(ga + b_gate[0])
    g_b = jax.nn.sigmoid(gb + b_gate[1])
    return (g_a * y_a + g_b * y_b) @ w_o


def hier_moe(h, w_group, b_group, w_sub, b_sub, w_gate_e, w_up_e, w_down_e):
    bsz, seq, d = h.shape
    n_tok = bsz * seq
    xt = h.reshape(n_tok, d)
    xf = xt.astype(jnp.float32)
    g_prob = jax.nn.softmax(xf @ w_group.astype(jnp.float32) + b_group.astype(jnp.float32), axis=-1)
    g_p, g_idx = lax.top_k(g_prob, 1)
    sub_logits = jnp.einsum('td,gde->tge', xf, w_sub.astype(jnp.float32)) + b_sub.astype(jnp.float32)
    sel = jnp.take_along_axis(sub_logits, g_idx[:, :, None], axis=1)[:, 0]
    s_top, s_idx = lax.top_k(sel, TOP_K)
    weights = g_p * jax.nn.softmax(s_top, axis=-1)
    expert = g_idx * EXPERTS_PER_GROUP + s_idx
    n_assign = n_tok * TOP_K
    e_flat = expert.reshape(n_assign)
    tok_flat = jnp.repeat(jnp.arange(n_tok, dtype=jnp.int32), TOP_K)
    w_flat = weights.reshape(n_assign)
    order = jnp.argsort(e_flat)
    e_s, tok_s, w_s = e_flat[order], tok_flat[order], w_flat[order]
    counts = jnp.bincount(e_flat, length=N_EXPERTS)
    padded = ((counts + MOE_BLOCK - 1) // MOE_BLOCK) * MOE_BLOCK
    pad_end = jnp.cumsum(padded)
    pad_start = pad_end - padded
    cnt_start = jnp.cumsum(counts) - counts
    dest = pad_start[e_s] + (jnp.arange(n_assign, dtype=jnp.int32) - cnt_start[e_s])
    n_blocks = -(-n_assign // MOE_BLOCK) + N_EXPERTS
    n_rows = n_blocks * MOE_BLOCK
    tok_pad = jnp.full((n_rows,), n_tok, dtype=jnp.int32).at[dest].set(tok_s)
    w_pad = jnp.zeros((n_rows,), jnp.float32).at[dest].set(w_s)
    block_expert = jnp.minimum(
        jnp.searchsorted(pad_end, jnp.arange(n_blocks, dtype=jnp.int32) * MOE_BLOCK, side='right'),
        N_EXPERTS - 1).astype(jnp.int32)
    x_pad = jnp.concatenate([xt, jnp.zeros((1, d), xt.dtype)], axis=0)
    xb = x_pad[tok_pad].reshape(n_blocks, MOE_BLOCK, d)

    def expert_block(args):
        x_blk, e = args
        return (jax.nn.silu(x_blk @ w_gate_e[e]) * (x_blk @ w_up_e[e])) @ w_down_e[e]

    yb = lax.map(expert_block, (xb, block_expert))
    y = yb.reshape(n_rows, d).astype(jnp.float32) * w_pad[:, None]
    out = jax.ops.segment_sum(y, tok_pad, num_segments=n_tok + 1)[:n_tok]
    return out.astype(h.dtype).reshape(bsz, seq, d)


def setup_inputs(seed: int = 0) -> dict:
    key = jax.random.key(seed)
    ks = jax.random.split(key, 32)
    f32 = jnp.float32
    D = D_MODEL
    beta = DEEPNORM_BETA

    def nrm(k, shape, scale):
        return jax.random.normal(k, shape, f32) * scale

    w_q = nrm(ks[1], (DEPTH, D, D_QK_A), D ** -0.5)
    w_k = nrm(ks[2], (DEPTH, D, D_QK_A), D ** -0.5)
    w_v = nrm(ks[3], (DEPTH, D, D_V_A), beta * D ** -0.5)
    w_rest = nrm(ks[4], (DEPTH, D, 3 * D_CONV + 2 * D_MODEL), D ** -0.5)
    w_in = jnp.concatenate([w_q, w_k, w_v, w_rest], axis=-1)
    return {
        'x': jax.random.normal(ks[0], (BATCH, SEQ, D), f32),
        'ln_in_g': 1.0 + nrm(ks[5], (D,), 0.02),
        'ln_in_b': nrm(ks[6], (D,), 0.02),
        'w_in': w_in,
        'b_gate': nrm(ks[7], (DEPTH, 2, D), 0.02),
        'lambda_q': nrm(ks[8], (DEPTH, 2, HEAD_DIM_A), 0.1),
        'lambda_k': nrm(ks[9], (DEPTH, 2, HEAD_DIM_A), 0.1),
        'subln_g': 1.0 + nrm(ks[10], (DEPTH, 2 * HEAD_DIM_A), 0.02),
        'rel_bias': nrm(ks[11], (N_BUCKETS, N_HEADS_A), 0.5),
        'conv_w': nrm(ks[12], (DEPTH, CONV_WIDTH, 1, D_CONV), CONV_WIDTH ** -0.5),
        'w_a_proj': nrm(ks[13], (DEPTH, D_V_A, D), beta * D_V_A ** -0.5),
        'w_b_proj': nrm(ks[14], (DEPTH, D_CONV, D), beta * D_CONV ** -0.5),
        'w_o': nrm(ks[15], (DEPTH, D, D), beta * D ** -0.5),
        'ln1_g': 1.0 + nrm(ks[16], (DEPTH, D), 0.02),
        'ln1_b': nrm(ks[17], (DEPTH, D), 0.02),
        'w_group': nrm(ks[18], (DEPTH, D, N_GROUPS), D ** -0.5),
        'b_group': nrm(ks[19], (DEPTH, N_GROUPS), 0.01),
        'w_sub': nrm(ks[20], (DEPTH, N_GROUPS, D, EXPERTS_PER_GROUP), D ** -0.5),
        'b_sub': nrm(ks[21], (DEPTH, N_GROUPS, EXPERTS_PER_GROUP), 0.01),
        'w_gate_e': nrm(ks[22], (DEPTH, N_EXPERTS, D, D_EXPERT), beta * D ** -0.5),
        'w_up_e': nrm(ks[23], (DEPTH, N_EXPERTS, D, D_EXPERT), beta * D ** -0.5),
        'w_down_e': nrm(ks[24], (DEPTH, N_EXPERTS, D_EXPERT, D), beta * D_EXPERT ** -0.5),
        'ln2_g': 1.0 + nrm(ks[25], (DEPTH, D), 0.02),
        'ln2_b': nrm(ks[26], (DEPTH, D), 0.02),
    }


def reference(x, ln_in_g, ln_in_b, w_in, b_gate, lambda_q, lambda_k, subln_g, rel_bias,
              conv_w, w_a_proj, w_b_proj, w_o, ln1_g, ln1_b, w_group, b_group, w_sub, b_sub,
              w_gate_e, w_up_e, w_down_e, ln2_g, ln2_b):
    x = layer_norm(x, ln_in_g, ln_in_b)
    for l in range(DEPTH):
        lam_init = 0.8 - 0.6 * math.exp(-0.3 * l)
        mix = mixer_block(x, w_in[l], b_gate[l], lambda_q[l], lambda_k[l], subln_g[l], rel_bias,
                          conv_w[l], w_a_proj[l], w_b_proj[l], w_o[l], lam_init)
        x = layer_norm(DEEPNORM_ALPHA * x + mix, ln1_g[l], ln1_b[l])
        ffn = hier_moe(x, w_group[l], b_group[l], w_sub[l], b_sub[l],
                       w_gate_e[l], w_up_e[l], w_down_e[l])
        x = layer_norm(DEEPNORM_ALPHA * x + ffn, ln2_g[l], ln2_b[l])
    return x
```

```cpp
#include <hip/hip_runtime.h>
#include <cstdio>
#include <cstdint>
#include <cmath>
#ifndef HYBRID
#define HYBRID 0
#endif
namespace pg8 {
#define PG8_LAS __attribute__((address_space(3)))
typedef unsigned short bf16_t;
typedef short bf16x8 __attribute__((ext_vector_type(8)));
typedef float f32x4 __attribute__((ext_vector_type(4)));
typedef unsigned u32x4 __attribute__((ext_vector_type(4)));
constexpr int BM = 256, BK = 64, HALF = 128, HTB = HALF * BK * 2  , STAGE_BYTES = 8 * HTB, NXCD = 8, WGM = 8;

__host__ __device__ __forceinline__ int lds_byte(int r, int c) { const int st = (r >> 4) * 2 + (c >> 5), rr = r & 15, cc = c & 31, ob = rr * 64 + cc * 2; return st * 1024 + (ob ^ (((ob >> 9) & 1) << 5)); }
__host__ __device__ __forceinline__ void stage_rc(int b, int& R, int& C) { const int st = b / 1024, sb = b % 1024, swz = sb ^ (((sb >> 9) & 1) << 5); R = (st >> 1) * 16 + swz / 64; C = (st & 1) * 32 + (swz % 64) / 2; }
__host__ __device__ __forceinline__ int perm32(int rho) { const int n = rho >> 4, i = rho & 15; return 8 * (i >> 2) + 4 * n + (i & 3); }

struct Unit { int pm, pn; };
struct Gemm { const bf16_t* A; const bf16_t* Bt; int M, N, K; };

struct StaticOrder {
    int nM, nN, nwg, G, c;
    __host__ __device__ void init(int M, int N, int G_, int c_) { nM = M / BM; nN = N / BM; nwg = nM * nN; G = G_; c = c_; }
    __host__ __device__ bool next(int i, Unit& u) const {
        const long L = (long)i * G + c; if (L >= nwg) return false;
        int wgid = (int)L; { const int q = nwg / NXCD, r = nwg % NXCD, xcd = wgid % NXCD, off = wgid / NXCD; wgid = (xcd < r ? xcd * (q + 1) : r * (q + 1) + (xcd - r) * q) + off; }
        const int nig = WGM * nN, gid = wgid / nig, fm = gid * WGM, gsz = (nM - fm) < WGM ? (nM - fm) : WGM;
        u.pm = fm + ((wgid % nig) % gsz); u.pn = (wgid % nig) / gsz; return true;
    }
    __device__ __forceinline__ void a_ready(const Unit&) const {}
    __device__ __forceinline__ void done(const Unit&) const {}
};

__device__ __forceinline__ unsigned cvt_pk_bf16(float lo, float hi) { unsigned r; asm volatile("v_cvt_pk_bf16_f32 %0, %1, %2" : "=v"(r) : "v"(lo), "v"(hi)); return r; }
typedef float f32x2 __attribute__((ext_vector_type(2)));
__device__ __forceinline__ u32x4 pack8f(const f32x4 a, const f32x4 b) { u32x4 w; w.x = cvt_pk_bf16(a[0], a[1]); w.y = cvt_pk_bf16(a[2], a[3]); w.z = cvt_pk_bf16(b[0], b[1]); w.w = cvt_pk_bf16(b[2], b[3]); return w; }
__device__ __forceinline__ void unpack8f(const u32x4 w, f32x4& a, f32x4& b) {
    a[0] = __uint_as_float(w.x << 16); a[1] = __uint_as_float(w.x & 0xffff0000u); a[2] = __uint_as_float(w.y << 16); a[3] = __uint_as_float(w.y & 0xffff0000u);
    b[0] = __uint_as_float(w.z << 16); b[1] = __uint_as_float(w.z & 0xffff0000u); b[2] = __uint_as_float(w.w << 16); b[3] = __uint_as_float(w.w & 0xffff0000u); }
__device__ __forceinline__ float sigmoidf_fast(float x) { return __builtin_amdgcn_rcpf(1.0f + __expf(-x)); }

struct EpiInProj {
    static constexpr bool PERM = true, AFTER_DRAIN = false;
    bf16_t* qkv; size_t stride;
    bf16_t* cb;
    bf16_t* z;
    bf16_t* sga; bf16_t* sgb;
    __device__ __forceinline__ void operator()(const f32x4 (&acc)[2][2][4][2], const Unit& u, int wr, int wc, int fr, int fq) const {
        const int row0 = u.pm * BM + wr * 64 + fr; const int pn = u.pn;
        if (pn < 16 || pn >= 24) {
            bf16_t* base = (pn < 12) ? qkv + (size_t)(pn >> 2) * stride : (pn < 16 ? cb : (pn < 28 ? sga : sgb)); const int col0 = (pn & 3) * BM + wc * 32 + 8 * fq;
#pragma unroll
            for (int ai = 0; ai < 2; ++ai)
#pragma unroll
                for (int m = 0; m < 4; ++m) { bf16_t* rowp = base + (size_t)(row0 + ai * HALF + m * 16) * 1024 + col0;
#pragma unroll
                    for (int bj = 0; bj < 2; ++bj) *(u32x4*)(rowp + bj * HALF) = pack8f(acc[ai][bj][m][0], acc[ai][bj][m][1]); }
        } else {
            const int col0 = (pn - 16) * HALF + wc * 32 + 8 * fq;
#pragma unroll
            for (int ai = 0; ai < 2; ++ai)
#pragma unroll
                for (int m = 0; m < 4; ++m) { bf16_t* rowp = z + (size_t)(row0 + ai * HALF + m * 16) * 1024 + col0;
                    *(u32x4*)rowp = pack8f(acc[ai][0][m][0] * acc[ai][1][m][0], acc[ai][0][m][1] * acc[ai][1][m][1]); }
        }
    }
};
template <bool SECOND> struct EpiGate {
    static constexpr bool PERM = true, AFTER_DRAIN = false;
    const bf16_t* gate; const bf16_t* prev; bf16_t* out; const float* gbias;
    __device__ __forceinline__ void operator()(const f32x4 (&acc)[2][2][4][2], const Unit& u, int wr, int wc, int fr, int fq) const {
        const int row0 = u.pm * BM + wr * 64 + fr; const int col0 = u.pn * BM + wc * 32 + 8 * fq;
        f32x4 bv[2][2];
#pragma unroll
        for (int bj = 0; bj < 2; ++bj)
#pragma unroll
            for (int n = 0; n < 2; ++n) bv[bj][n] = *(const f32x4*)(gbias + col0 + bj * HALF + 4 * n);
#pragma unroll
        for (int ai = 0; ai < 2; ++ai)
#pragma unroll
            for (int m = 0; m < 4; ++m) { const size_t off = (size_t)(row0 + ai * HALF + m * 16) * 1024 + col0;
#pragma unroll
                for (int bj = 0; bj < 2; ++bj) { f32x4 g0, g1; unpack8f(*(const u32x4*)(gate + off + bj * HALF), g0, g1); g0 += bv[bj][0]; g1 += bv[bj][1];
#pragma unroll
                    for (int i = 0; i < 4; ++i) { g0[i] = sigmoidf_fast(g0[i]); g1[i] = sigmoidf_fast(g1[i]); }
                    f32x4 v0 = acc[ai][bj][m][0] * g0, v1 = acc[ai][bj][m][1] * g1;
                    if (SECOND) { f32x4 p0, p1; unpack8f(*(const u32x4*)(prev + off + bj * HALF), p0, p1); v0 += p0; v1 += p1; }
                    *(u32x4*)(out + off + bj * HALF) = pack8f(v0, v1); } }
    }
};
struct EpiPre {
    static constexpr bool PERM = false, AFTER_DRAIN = false;
    const float* x; const float* stats; const float* g; const float* b; float* pre; float alpha;
    __device__ __forceinline__ void operator()(const f32x4 (&acc)[2][2][4][2], const Unit& u, int wr, int wc, int fr, int fq) const {
        const int row0 = u.pm * BM + wr * 64 + fr; const int col0 = u.pn * BM + wc * 32 + 4 * fq;
#pragma unroll
        for (int ai = 0; ai < 2; ++ai)
#pragma unroll
            for (int m = 0; m < 4; ++m) { const int row = row0 + ai * HALF + m * 16; const size_t off = (size_t)row * 1024 + col0;
                const float mu = stats[2 * row], rs = stats[2 * row + 1];
#pragma unroll
                for (int bj = 0; bj < 2; ++bj)
#pragma unroll
                    for (int n = 0; n < 2; ++n) { const int c = bj * HALF + n * 16; const f32x4 xv = *(const f32x4*)(x + off + c), gv = *(const f32x4*)(g + col0 + c), bv = *(const f32x4*)(b + col0 + c);
                        *(f32x4*)(pre + off + c) = ((xv - mu) * rs * gv + bv) * alpha + acc[ai][bj][m][n]; } }
    }
};
struct EpiMoeUp {
    static constexpr bool PERM = true, AFTER_DRAIN = false;
    bf16_t* h;
    __device__ __forceinline__ void operator()(const f32x4 (&acc)[2][2][4][2], const Unit& u, int wr, int wc, int fr, int fq) const {
        const int row0 = u.pm * BM + wr * 64 + fr; const int col0 = (u.pn & 3) * HALF + wc * 32 + 8 * fq;
#pragma unroll
        for (int ai = 0; ai < 2; ++ai)
#pragma unroll
            for (int m = 0; m < 4; ++m) { f32x4 v[2];
#pragma unroll
                for (int n = 0; n < 2; ++n)
#pragma unroll
                    for (int i = 0; i < 4; ++i) { const float gv = acc[ai][0][m][n][i]; v[n][i] = gv * sigmoidf_fast(gv) * acc[ai][1][m][n][i]; }
                *(u32x4*)(h + (size_t)(row0 + ai * HALF + m * 16) * 512 + col0) = pack8f(v[0], v[1]); }
    }
};
struct EpiMoeDown {
    static constexpr bool PERM = true, AFTER_DRAIN = false;
    bf16_t* y;
    __device__ __forceinline__ void operator()(const f32x4 (&acc)[2][2][4][2], const Unit& u, int wr, int wc, int fr, int fq) const {
        const int row0 = u.pm * BM + wr * 64 + fr; const int col0 = (u.pn & 3) * BM + wc * 32 + 8 * fq;
#pragma unroll
        for (int ai = 0; ai < 2; ++ai)
#pragma unroll
            for (int m = 0; m < 4; ++m) { bf16_t* rowp = y + (size_t)(row0 + ai * HALF + m * 16) * 1024 + col0;
#pragma unroll
                for (int bj = 0; bj < 2; ++bj) *(u32x4*)(rowp + bj * HALF) = pack8f(acc[ai][bj][m][0], acc[ai][bj][m][1]); }
    }
};
struct MoeOrder {
    const PG8_LAS int* tab; int G, c;
    __device__ __forceinline__ bool next(int i, Unit& u) const {
        const int nunits = (tab[32] >> 8) * 4; const int L = i * G + c; if (L >= nunits) return false;
        const int tile = L >> 2, s = tile << 8; int e = 0;
#pragma unroll 1
        for (int k = 1; k < 32; ++k) e = (tab[k] <= s) ? k : e;
        u.pm = __builtin_amdgcn_readfirstlane(tile); u.pn = __builtin_amdgcn_readfirstlane(e * 4 + (L & 3)); return true;
    }
    __device__ __forceinline__ void a_ready(const Unit&) const {}
    __device__ __forceinline__ void done(const Unit&) const {}
};
template <class Epi, class Sched, bool ALIGN_EPI = false, bool SP2 = false>
__device__ __forceinline__ void gemm_phase(PG8_LAS unsigned char* lds, const Gemm g, const Sched& S, const Epi& E) {
    const int tid = threadIdx.x, wid = __builtin_amdgcn_readfirstlane(tid >> 6), lane = tid & 63, wr = wid >> 2, wc = wid & 3, fr = lane & 15, fq = lane >> 4;
    const int K = g.K, nt = K / BK;
    unsigned voffA[2], voffB[2];
#pragma unroll
    for (int i = 0; i < 2; ++i) { int R, C; stage_rc(tid * 16 + i * 8192, R, C); const int Rb = Epi::PERM ? ((R & ~31) + perm32(R & 31)) : R;
        voffA[i] = (unsigned)(R * K + C) * 2u; voffB[i] = (unsigned)(Rb * K + C) * 2u; }
    const size_t kstep = (size_t)(BK * 2);
    const size_t hstep = (size_t)HALF * K * 2;
    const size_t tstep = 2 * hstep;
    const unsigned ldsw = (unsigned)wid * 1024u;
    const int aoff = lds_byte(wr * 64 + fr, fq * 8), boff = lds_byte(wc * 32 + fr, fq * 8);
#define PG8_SA(b, h) (((b) * 2 + (h)) * HTB)
#define PG8_SB(b, h) ((4 + (b) * 2 + (h)) * HTB)
#define PG8_STAGE(bufoff, gbase, voff) do { _Pragma("unroll") for (int _i = 0; _i < 2; ++_i) \
        __builtin_amdgcn_global_load_lds((const unsigned*)((const char*)(gbase) + (voff)[_i]), (PG8_LAS unsigned*)(lds + (bufoff) + ldsw + _i * 8192), 16, 0, 0); } while (0)
#define PG8_LDA(dst, b, h) do { _Pragma("unroll") for (int m = 0; m < 4; ++m) _Pragma("unroll") for (int k = 0; k < 2; ++k) dst[m][k] = *(const PG8_LAS bf16x8*)(lds + PG8_SA(b, h) + aoff + m * 2048 + k * 1024); } while (0)
#define PG8_LDB(dst, b, h) do { _Pragma("unroll") for (int n = 0; n < 2; ++n) _Pragma("unroll") for (int k = 0; k < 2; ++k) dst[n][k] = *(const PG8_LAS bf16x8*)(lds + PG8_SB(b, h) + boff + n * 2048 + k * 1024); } while (0)
#define PG8_MMA(ai, bj, At, Bt) do { __builtin_amdgcn_s_setprio(1); _Pragma("unroll") for (int m = 0; m < 4; ++m) _Pragma("unroll") for (int n = 0; n < 2; ++n) _Pragma("unroll") for (int k = 0; k < 2; ++k) \
        acc[ai][bj][m][n] = __builtin_amdgcn_mfma_f32_16x16x32_bf16(Bt[n][k], At[m][k], acc[ai][bj][m][n], 0, 0, 0); __builtin_amdgcn_s_setprio(0); } while (0)
#define PG8_WAIT_V(n) asm volatile("s_waitcnt vmcnt(" #n ")" ::: "memory")
#define PG8_WAIT_L(n) asm volatile("s_waitcnt lgkmcnt(" #n ")" ::: "memory")
#define PG8_BAR __builtin_amdgcn_s_barrier()
#define PG8_SCHED __builtin_amdgcn_sched_barrier(0)
    Unit cur, nxt; int ui = 0;
    if (!S.next(0, cur)) return;
    f32x4 acc[2][2][4][2];
#pragma unroll
    for (int a = 0; a < 2; ++a)
#pragma unroll
        for (int b = 0; b < 2; ++b)
#pragma unroll
            for (int m = 0; m < 4; ++m)
#pragma unroll
                for (int n = 0; n < 2; ++n) acc[a][b][m][n] = (f32x4){0.f, 0.f, 0.f, 0.f};
    bf16x8 At[4][2], B0[2][2], B1[2][2];
    const char* cA = (const char*)g.A + (size_t)cur.pm * tstep; const char* cB = (const char*)g.Bt + (size_t)cur.pn * tstep;
    S.a_ready(cur);
    if constexpr (SP2) {
        PG8_STAGE(PG8_SB(0, 0), cB, voffB); PG8_STAGE(PG8_SB(0, 1), cB + hstep, voffB); PG8_STAGE(PG8_SA(0, 0), cA, voffA); PG8_STAGE(PG8_SA(0, 1), cA + hstep, voffA);
        if (wr == 1) PG8_BAR;
        PG8_WAIT_V(2); PG8_BAR;
        PG8_STAGE(PG8_SB(1, 0), cB + kstep, voffB); PG8_STAGE(PG8_SA(1, 0), cA + kstep, voffA); PG8_STAGE(PG8_SB(1, 1), cB + hstep + kstep, voffB);
        PG8_WAIT_V(6); PG8_BAR;
    } else {
        PG8_STAGE(PG8_SB(0, 0), cB, voffB); PG8_STAGE(PG8_SA(0, 0), cA, voffA); PG8_STAGE(PG8_SB(0, 1), cB + hstep, voffB); PG8_STAGE(PG8_SA(0, 1), cA + hstep, voffA);
        if (wr == 1) PG8_BAR;
        PG8_WAIT_V(4); PG8_BAR;
        PG8_STAGE(PG8_SB(1, 0), cB + kstep, voffB); PG8_STAGE(PG8_SA(1, 0), cA + kstep, voffA); PG8_STAGE(PG8_SB(1, 1), cB + hstep + kstep, voffB);
        PG8_WAIT_V(6); PG8_BAR;
    }
    for (;;) {
        const bool has_next = S.next(ui + 1, nxt);
        const char* nA = has_next ? (const char*)g.A + (size_t)nxt.pm * tstep : cA; const char* nB = has_next ? (const char*)g.Bt + (size_t)nxt.pn * tstep : cB;
        for (int t = 0; t < nt; t += 2) {
            const bool last = (t == nt - 2);
            const char* a1 = cA + (size_t)(t + 1) * kstep;
            const char* a2 = last ? nA : cA + (size_t)(t + 2) * kstep; const char* b2 = last ? nB : cB + (size_t)(t + 2) * kstep;
            const char* a3 = a2 + kstep; const char* b3 = b2 + kstep;
            if (last && has_next) S.a_ready(nxt);
            if constexpr (SP2) {
            PG8_LDB(B0, 0, 0); PG8_LDB(B1, 0, 1); PG8_SCHED; PG8_LDA(At, 0, 0); PG8_STAGE(PG8_SA(1, 1), a1 + hstep, voffA);
            PG8_WAIT_V(8); PG8_WAIT_L(0); PG8_BAR; PG8_MMA(0, 0, At, B0); PG8_MMA(0, 1, At, B1); PG8_BAR; PG8_SCHED;
            PG8_LDA(At, 0, 1); PG8_STAGE(PG8_SB(0, 0), b2, voffB); PG8_STAGE(PG8_SB(0, 1), b2 + hstep, voffB); PG8_STAGE(PG8_SA(0, 0), a2, voffA);
            PG8_WAIT_V(8); PG8_WAIT_L(0); PG8_BAR; PG8_MMA(1, 0, At, B0); PG8_MMA(1, 1, At, B1); PG8_BAR; PG8_SCHED;
            PG8_LDB(B0, 1, 0); PG8_LDB(B1, 1, 1); PG8_SCHED; PG8_LDA(At, 1, 0); PG8_STAGE(PG8_SA(0, 1), a2 + hstep, voffA);
            PG8_WAIT_V(8); PG8_WAIT_L(0); PG8_BAR; PG8_MMA(0, 0, At, B0); PG8_MMA(0, 1, At, B1); PG8_BAR; PG8_SCHED;
            PG8_LDA(At, 1, 1); PG8_STAGE(PG8_SB(1, 0), b3, voffB); PG8_STAGE(PG8_SB(1, 1), b3 + hstep, voffB); PG8_STAGE(PG8_SA(1, 0), a3, voffA);
            PG8_WAIT_V(8); PG8_WAIT_L(0); PG8_BAR; PG8_MMA(1, 0, At, B0); PG8_MMA(1, 1, At, B1); PG8_BAR; PG8_SCHED;
            } else {
            PG8_LDB(B0, 0, 0); PG8_SCHED; PG8_LDA(At, 0, 0); PG8_STAGE(PG8_SA(1, 1), a1 + hstep, voffA);
            PG8_WAIT_L(8); PG8_BAR; PG8_WAIT_L(0); PG8_MMA(0, 0, At, B0); PG8_BAR; PG8_SCHED;
            PG8_LDB(B1, 0, 1); PG8_STAGE(PG8_SB(0, 0), b2, voffB);
            PG8_BAR; PG8_WAIT_L(0); PG8_MMA(0, 1, At, B1); PG8_BAR;
            PG8_LDA(At, 0, 1); PG8_STAGE(PG8_SA(0, 0), a2, voffA);
            PG8_BAR; PG8_WAIT_L(0); PG8_MMA(1, 0, At, B0); PG8_BAR; PG8_SCHED;
            PG8_STAGE(PG8_SB(0, 1), b2 + hstep, voffB);
            PG8_WAIT_V(6); PG8_BAR; PG8_MMA(1, 1, At, B1); PG8_BAR;
            PG8_LDB(B0, 1, 0); PG8_SCHED; PG8_LDA(At, 1, 0); PG8_STAGE(PG8_SA(0, 1), a2 + hstep, voffA);
            PG8_WAIT_L(8); PG8_BAR; PG8_WAIT_L(0); PG8_MMA(0, 0, At, B0); PG8_BAR; PG8_SCHED;
            PG8_LDB(B1, 1, 1); PG8_STAGE(PG8_SB(1, 0), b3, voffB);
            PG8_BAR; PG8_WAIT_L(0); PG8_MMA(0, 1, At, B1); PG8_BAR;
            PG8_LDA(At, 1, 1); PG8_STAGE(PG8_SA(1, 0), a3, voffA);
            PG8_BAR; PG8_WAIT_L(0); PG8_MMA(1, 0, At, B0); PG8_BAR; PG8_SCHED;
            PG8_STAGE(PG8_SB(1, 1), b3 + hstep, voffB);
            PG8_WAIT_V(6); PG8_BAR; PG8_MMA(1, 1, At, B1); PG8_BAR;
            }
        }
        if constexpr (ALIGN_EPI) { if (wr == 0) PG8_BAR; }
        if constexpr (!Epi::AFTER_DRAIN) { E(acc, cur, wr, wc, fr, fq); S.done(cur); }
        if (!has_next) break;
#pragma unroll
        for (int a = 0; a < 2; ++a)
#pragma unroll
            for (int b = 0; b < 2; ++b)
#pragma unroll
                for (int m = 0; m < 4; ++m)
#pragma unroll
                    for (int n = 0; n < 2; ++n) acc[a][b][m][n] = (f32x4){0.f, 0.f, 0.f, 0.f};
        cur = nxt; cA = nA; cB = nB; ++ui;
        if constexpr (ALIGN_EPI) { if (wr == 1) PG8_BAR; }
    }
    PG8_WAIT_V(0);
    if constexpr (!ALIGN_EPI) { if (wr == 0) PG8_BAR; }
    PG8_BAR;
    if constexpr (Epi::AFTER_DRAIN) { E.fused(acc, cur, wr, wc, fr, fq, lds, wid, lane); S.done(cur); }
#undef PG8_SA
#undef PG8_SB
#undef PG8_STAGE
#undef PG8_LDA
#undef PG8_LDB
#undef PG8_MMA
#undef PG8_WAIT_V
#undef PG8_WAIT_L
#undef PG8_BAR
#undef PG8_SCHED
}
}

namespace attn {
typedef short bf16x8 __attribute__((ext_vector_type(8)));
typedef short s16x4 __attribute__((ext_vector_type(4)));
typedef float f32x16 __attribute__((ext_vector_type(16)));
typedef unsigned u32x4 __attribute__((ext_vector_type(4)));
typedef unsigned short bf16;
constexpr int D = 128, PITCH = 1024, SEQ = 2048;
constexpr float SCALE = 0.08838834764831845f, THR = 8.f;
constexpr int NW = 8, QBLK = 32, KVBLK = 64, QB = NW * QBLK;
constexpr int SHM_V = KVBLK * D * 2, SHM_K = KVBLK * D * 2;
constexpr int BIAS_OFF = 2 * SHM_V + 2 * SHM_K + NW * 64 * 4, NBIAS = 320;
constexpr int LDS_BYTES = BIAS_OFF + NBIAS * 4;
#define KSWZ(row, colB) ((row) * 256 + ((colB) ^ (((row) & 7) << 4)))
#define SBAR() __builtin_amdgcn_sched_barrier(0)
__device__ __forceinline__ int v_st(int k, int c) { const int kk = (k & ~0xC) | ((k & 4) << 1) | ((k & 8) >> 1); return ((kk >> 3) * 4 + (c >> 5)) * 512 + ((kk & 7) * 32 + (c & 31)) * 2; }
__device__ __forceinline__ int v_rd_base(int lane) { return ((lane & 3) << 3) | (((lane >> 2) & 3) << 6) | (((lane >> 4) & 1) << 5) | (((lane >> 5) & 1) << 8); }
constexpr int v_rd_off(int d0, int ks, int half) { return d0 * 512 + ks * 4096 + half * 2048; }
__device__ __forceinline__ int crow(int r, int hi) { return (r & 3) + 8 * (r >> 2) + 4 * hi; }
__device__ __forceinline__ unsigned cvtpk(float lo, float hi) { unsigned r; asm volatile("v_cvt_pk_bf16_f32 %0, %1, %2" : "=v"(r) : "v"(lo), "v"(hi)); return r; }
__device__ __forceinline__ bf16x8 load8(const bf16* p) { return *reinterpret_cast<const bf16x8*>(p); }
__device__ __forceinline__ int t5_bucket(int rel) {
    const int b = rel > 0 ? 16 : 0; const int n = rel < 0 ? -rel : rel; int v;
    if (n < 8) v = n; else if (n < 12) v = 8; else if (n < 16) v = 9; else if (n < 23) v = 10; else if (n < 32) v = 11; else if (n < 46) v = 12; else if (n < 65) v = 13; else if (n < 91) v = 14; else v = 15;
    return b + v;
}
__device__ __forceinline__ void bias_tile(f32x16& p0, f32x16& p1, const float* tabp) {
#pragma unroll
    for (int r = 0; r < 16; ++r) { const int c = (r & 3) + 8 * (r >> 2); p0[r] += tabp[59 - c]; p1[r] += tabp[59 - c - 32]; }
}
__device__ __forceinline__ void partialSM(f32x16& p0, f32x16& p1, float& m_reg, float& mn, float& alpha) {
    float pmax = p0[0]; for (int r = 1; r < 16; ++r) pmax = fmaxf(pmax, p0[r]); for (int r = 0; r < 16; ++r) pmax = fmaxf(pmax, p1[r]);
    { auto rr = __builtin_amdgcn_permlane32_swap(__float_as_uint(pmax), __float_as_uint(pmax), false, false);
      pmax = fmaxf(__uint_as_float(rr[0]), __uint_as_float(rr[1])); }
    constexpr float C2 = 1.4426950408889634f * SCALE;
    if (__builtin_expect(__all((pmax - m_reg) * SCALE <= THR), 1)) { mn = m_reg; alpha = 1.f; }
    else { mn = fmaxf(m_reg, pmax); alpha = __builtin_amdgcn_exp2f((m_reg - mn) * C2); m_reg = mn; }
    const float mnL = -mn * C2;
    for (int r = 0; r < 16; ++r) p0[r] = fmaf(p0[r], C2, mnL); for (int r = 0; r < 16; ++r) p1[r] = fmaf(p1[r], C2, mnL);
    for (int r = 0; r < 16; ++r) p0[r] = __builtin_amdgcn_exp2f(p0[r]);
}
__device__ __forceinline__ void finishSM(f32x16& p0, f32x16& p1, float alpha, float& l_reg, bf16x8& pa0, bf16x8& pa1, bf16x8& pa2, bf16x8& pa3) {
    for (int r = 0; r < 16; ++r) p1[r] = __builtin_amdgcn_exp2f(p1[r]);
    float ps = 0; for (int r = 0; r < 16; ++r) ps += p0[r]; for (int r = 0; r < 16; ++r) ps += p1[r];
    { auto rr = __builtin_amdgcn_permlane32_swap(__float_as_uint(ps), __float_as_uint(ps), false, false);
      ps = __uint_as_float(rr[0]) + __uint_as_float(rr[1]); }
    l_reg = l_reg * alpha + ps;
#define PK4(P, B_, OUT) do { unsigned a0 = cvtpk(P[B_+0], P[B_+1]), a1 = cvtpk(P[B_+2], P[B_+3]);                          \
        unsigned b0 = cvtpk(P[B_+4], P[B_+5]), b1 = cvtpk(P[B_+6], P[B_+7]);                                             \
        auto r0 = __builtin_amdgcn_permlane32_swap(a0, b0, false, false); auto r1 = __builtin_amdgcn_permlane32_swap(a1, b1, false, false); \
        u32x4 w = {r0[0], r1[0], r0[1], r1[1]}; OUT = *reinterpret_cast<bf16x8*>(&w); } while (0)
    PK4(p0, 0, pa0); PK4(p0, 8, pa1); PK4(p1, 0, pa2); PK4(p1, 8, pa3);
#undef PK4
}
template <int KB>
__device__ __forceinline__ void qkt(f32x16& p0, f32x16& p1, const char* K_lds, int r32, int hi, const bf16x8* qr, bool act) {
    if (!act) { const float NEG = -__builtin_inff();
#pragma unroll
        for (int r = 0; r < 16; ++r) { p0[r] = NEG; p1[r] = NEG; } return; }
    p0 = f32x16{}; p1 = f32x16{};
    const char* kb[4];
#pragma unroll
    for (int dd = 0; dd < 4; ++dd) kb[dd] = K_lds + KB * SHM_K + KSWZ(r32, (dd * 16 + hi * 8) * 2);
#pragma unroll
    for (int d0 = 0; d0 < 8; ++d0) { const char* a = kb[d0 & 3] + (d0 >> 2) * 128;
        bf16x8 b0 = *reinterpret_cast<const bf16x8*>(a);
        bf16x8 b1 = *reinterpret_cast<const bf16x8*>(a + 32 * 256);
        p0 = __builtin_amdgcn_mfma_f32_32x32x16_bf16(b0, qr[d0], p0, 0, 0, 0);
        p1 = __builtin_amdgcn_mfma_f32_32x32x16_bf16(b1, qr[d0], p1, 0, 0, 0); }
}
template <int VB>
__device__ __forceinline__ void pv_tile(f32x16* o, int vb0, bf16x8 pa0, bf16x8 pa1, bf16x8 pa2, bf16x8 pa3, bool act) {
    if (!act) return;
#define TRRD(dst, off) asm volatile("ds_read_b64_tr_b16 %0, %1 offset:%2" : "=&v"(dst) : "v"(vb0), "i"(off) : "memory")
#define PV_D0(d0) do { s16x4 l0, l1, l2, l3, h0, h1, h2, h3; constexpr int b_ = VB * SHM_V + v_rd_off(d0, 0, 0); \
        TRRD(l0, b_); TRRD(h0, b_ + 2048); TRRD(l1, b_ + 4096); TRRD(h1, b_ + 6144); TRRD(l2, b_ + 8192); TRRD(h2, b_ + 10240); TRRD(l3, b_ + 12288); TRRD(h3, b_ + 14336); \
        asm volatile("s_waitcnt lgkmcnt(0)" ::: "memory"); SBAR();   \
        o[d0] = __builtin_amdgcn_mfma_f32_32x32x16_bf16(pa0, (bf16x8){l0[0], l0[1], l0[2], l0[3], h0[0], h0[1], h0[2], h0[3]}, o[d0], 0, 0, 0);   \
        o[d0] = __builtin_amdgcn_mfma_f32_32x32x16_bf16(pa1, (bf16x8){l1[0], l1[1], l1[2], l1[3], h1[0], h1[1], h1[2], h1[3]}, o[d0], 0, 0, 0);   \
        o[d0] = __builtin_amdgcn_mfma_f32_32x32x16_bf16(pa2, (bf16x8){l2[0], l2[1], l2[2], l2[3], h2[0], h2[1], h2[2], h2[3]}, o[d0], 0, 0, 0);   \
        o[d0] = __builtin_amdgcn_mfma_f32_32x32x16_bf16(pa3, (bf16x8){l3[0], l3[1], l3[2], l3[3], h3[0], h3[1], h3[2], h3[3]}, o[d0], 0, 0, 0); } while (0)
    PV_D0(0); PV_D0(1); PV_D0(2); PV_D0(3);
#undef PV_D0
#undef TRRD
}
struct BlockRef { const bf16* Q; const bf16* K; const bf16* V; bf16* O; int P0; };
struct Seam { bf16x8 qr[8]; bf16x8 st_v0, st_v1, st_k0, st_k1; };
#define ROW(p, k0, rr) ((p) + (size_t)((k0) + (rr)) * PITCH + sc)
#define VMW() asm volatile("s_waitcnt vmcnt(0)" ::: "memory")
#define VMWN(n) asm volatile("s_waitcnt vmcnt(%0)" :: "i"(n) : "memory")
#define SLOAD_H(Kp, Vp, k0) do { S.st_v0 = load8(ROW(Vp, k0, sr)); S.st_v1 = load8(ROW(Vp, k0, 32 + sr)); S.st_k0 = load8(ROW(Kp, k0, sr)); S.st_k1 = load8(ROW(Kp, k0, 32 + sr)); } while (0)
#define SWRITE_HK(bf) do { *(bf16x8*)(K_lds + (bf) * SHM_K + kws) = S.st_k0; *(bf16x8*)(K_lds + (bf) * SHM_K + kws + 32 * 256) = S.st_k1; } while (0)
#define SWRITE_HV(bf) do { *(bf16x8*)(V_lds + (bf) * SHM_V + vst0) = S.st_v0; *(bf16x8*)(V_lds + (bf) * SHM_V + vst1) = S.st_v1; } while (0)
#define SWRITE_H(bf) do { SWRITE_HV(bf); SWRITE_HK(bf); } while (0)
__device__ __forceinline__ void attn_prime(const BlockRef& cur, char* lds, Seam& S) {
    const int tid = threadIdx.x, wid = __builtin_amdgcn_readfirstlane(tid >> 6), lane = tid & 63, r32 = lane & 31, hi = lane >> 5;
    const int sr = tid >> 4, sc = (tid & 15) * 8, kws = KSWZ(sr, sc * 2); char* K_lds = lds + 2 * SHM_V;
#pragma unroll
    for (int d0 = 0; d0 < 8; ++d0) S.qr[d0] = load8(cur.Q + (size_t)(wid * QBLK + r32) * PITCH + d0 * 16 + hi * 8);
    SLOAD_H(cur.K, cur.V, 0); VMW(); SWRITE_HK(0);
    __syncthreads();
}
__device__ __forceinline__ void attn_block(const BlockRef& cur, const BlockRef& nxt, char* lds, Seam& S) {
    const int tid = threadIdx.x, wid = __builtin_amdgcn_readfirstlane(tid >> 6), lane = tid & 63, r32 = lane & 31, hi = lane >> 5;
    const int NT = cur.P0 / KVBLK + QB / KVBLK;
    const int qlo = cur.P0 + wid * QBLK, cw = qlo >> 6;
    char* V_lds = lds; char* K_lds = lds + 2 * SHM_V;
    float* ws = (float*)(lds + 2 * SHM_V + 2 * SHM_K) + wid * 64; float* li_l = ws, * al_l = ws + 32;
    const float* btab = (const float*)(lds + BIAS_OFF);
    float m_reg = -1e30f, l_reg = 0; f32x16 o[4] = {};
    const int sr = tid >> 4, sc = (tid & 15) * 8, vst0 = v_st(sr, sc), vst1 = v_st(32 + sr, sc), kws = KSWZ(sr, sc * 2);
    const int vb0 = (int)(uintptr_t)V_lds + v_rd_base(lane);
    const bf16* Kh = cur.K; const bf16* Vh = cur.V;
    const int bb0 = qlo + r32 - 4 * hi + 4;
#define RESC(a) do { if (__any((a) < 1.f)) { if (hi == 0) al_l[r32] = (a); asm volatile("s_waitcnt lgkmcnt(0)" ::: "memory");              \
                     for (int d_ = 0; d_ < 4; ++d_) for (int r = 0; r < 16; ++r) o[d_][r] *= al_l[crow(r, hi)]; } } while (0)
#define KBASE(t) ((t) * KVBLK)
#define ACT(t) ((t) <= cw)
#define BIAST(P0_, P1_, t) do { if ((t) <= cw && (t) + 2 >= cw) bias_tile(P0_, P1_, btab + (bb0 - KBASE(t))); } while (0)
    constexpr int NQL = 8;
#define SEAM_K0() do { VMWN(NQL); SWRITE_HK(0); SBAR(); } while (0)
    f32x16 pA0, pA1, pB0, pB1; float mnA, mnB, alA, alB; bf16x8 pa0, pa1, pa2, pa3;
    SWRITE_HV(0); SBAR();
    SLOAD_H(Kh, Vh, KBASE(1));
    SBAR(); qkt<0>(pA0, pA1, K_lds, r32, hi, S.qr, ACT(0));
    BIAST(pA0, pA1, 0); partialSM(pA0, pA1, m_reg, mnA, alA);
    VMW(); SWRITE_H(1);
    __syncthreads();
#define HALF_STEP(PX0, PX1, mnX, alX, PY0, PY1, alY, t, KB, VB, SB) do {                                                      \
        SBAR(); qkt<KB>(PX0, PX1, K_lds, r32, hi, S.qr, ACT(t));                                                 \
        finishSM(PY0, PY1, alY, l_reg, pa0, pa1, pa2, pa3); SBAR();                                                           \
        if ((t) + 1 < NT) { SLOAD_H(Kh, Vh, KBASE((t) + 1)); SBAR(); }                                                         \
        pv_tile<VB>(o, vb0, pa0, pa1, pa2, pa3, ACT((t) - 1)); BIAST(PX0, PX1, (t)); partialSM(PX0, PX1, m_reg, mnX, alX);    \
        __syncthreads();                                                                                                      \
        if ((t) + 1 < NT) { VMW(); SWRITE_H(SB); }                                                                             \
        RESC(alX); __syncthreads(); } while (0)
    for (int t = 1; t + 1 < NT; t += 2) {
        HALF_STEP(pB0, pB1, mnB, alB, pA0, pA1, alA, t, 1, 0, 0);
        HALF_STEP(pA0, pA1, mnA, alA, pB0, pB1, alB, t + 1, 0, 1, 1);
    }
    { SBAR(); qkt<1>(pB0, pB1, K_lds, r32, hi, S.qr, ACT(NT - 1)); SBAR(); }
    SLOAD_H(nxt.K, nxt.V, 0); SBAR();
#pragma unroll
    for (int d0 = 0; d0 < 8; ++d0) S.qr[d0] = load8(nxt.Q + (size_t)(wid * QBLK + r32) * PITCH + d0 * 16 + hi * 8);
    SBAR();
    finishSM(pA0, pA1, alA, l_reg, pa0, pa1, pa2, pa3); SBAR();
    pv_tile<0>(o, vb0, pa0, pa1, pa2, pa3, ACT(NT - 2));
    { BIAST(pB0, pB1, NT - 1); partialSM(pB0, pB1, m_reg, mnB, alB); __syncthreads(); RESC(alB);
      finishSM(pB0, pB1, alB, l_reg, pa0, pa1, pa2, pa3); SBAR(); pv_tile<1>(o, vb0, pa0, pa1, pa2, pa3, ACT(NT - 1)); }
    SBAR(); SEAM_K0();
    if (hi == 0) li_l[r32] = l_reg; asm volatile("s_waitcnt lgkmcnt(0)" ::: "memory");
    float rli[16];
#pragma unroll
    for (int r = 0; r < 16; ++r) rli[r] = __builtin_amdgcn_rcpf(li_l[crow(r, hi)]);
    bf16* Ow = cur.O + (size_t)(wid * QBLK) * PITCH;
#pragma unroll
    for (int r = 0; r < 16; ++r) { const int orow = crow(r, hi);
#pragma unroll
        for (int d0 = 0; d0 < 4; ++d0) { const float v = o[d0][r] * rli[r];
            const float vn = __shfl_xor(v, 1);
            if ((r32 & 1) == 0) *(unsigned*)(Ow + (size_t)orow * PITCH + d0 * 32 + r32) = cvtpk(v, vn); } }
    __syncthreads();
#undef RESC
#undef KBASE
#undef ACT
#undef BIAST
#undef SEAM_K0
#undef HALF_STEP
}
#undef ROW
#undef VMW
#undef VMWN
#undef SLOAD_H
#undef SWRITE_HK
#undef SWRITE_HV
#undef SWRITE_H
#undef KSWZ
}

constexpr int NWAVES = 8;
constexpr int BATCH = 16, SEQ = 2048, T = BATCH * SEQ, D = 1024, NIN = 8192, NE = 32, DE = 512;
constexpr int MAXT = 288, MAXS = MAXT * 256;
constexpr float LN_EPS = 1e-5f, RMS_EPS = 1e-6f, ALPHA = 1.189207115002721f, LAM_INIT = 0.2f;
constexpr size_t MiB = 1u << 20;
constexpr size_t WS_CTL = 0, CTL_ZERO_BYTES = 1 * MiB;
constexpr size_t WS_STATS = 1 * MiB, WS_EID = WS_STATS + 256 * 1024, WS_EW = WS_EID + 256 * 1024, WS_RANK = WS_EW + 256 * 1024, WS_SLOT = 2 * MiB, WS_CNTWG = WS_SLOT + 256 * 1024;
constexpr size_t WS_WA = 4 * MiB, WS_WB = 6 * MiB, WS_WO = 8 * MiB, WS_WIN = 10 * MiB;
constexpr size_t WS_XN = 26 * MiB, WS_Q = 90 * MiB, WS_K = 154 * MiB, WS_V = 218 * MiB, WS_CB = 282 * MiB, WS_Z = 346 * MiB, WS_O1 = 410 * MiB;
constexpr size_t WS_WGU = 90 * MiB, WS_WD = 154 * MiB, WS_PRE = 186 * MiB, WS_XG = 314 * MiB, WS_END = 458 * MiB;
constexpr int CW_TMO = 0, CW_CODE = 1, CW_BAR = 4096;
constexpr int RING_OFF = 0, RING_BYTES = 131072, RW_BYTES = 147456;
constexpr int LDSCTL_OFF = RW_BYTES, MISC_OFF = LDSCTL_OFF + 320, TAB_OFF = LDSCTL_OFF + 512, RSCR_OFF = LDSCTL_OFF + 1024;
constexpr int LDS_BYTES = 163840;
static_assert(RSCR_OFF + 8 * 128 * 4 + 1024 <= LDS_BYTES, "LDS map");

#define GAS __attribute__((address_space(1)))
#define LAS __attribute__((address_space(3)))
typedef unsigned short bf16;
#ifdef SWAP_CB_SGA
#define BUF_CB(P)  ((bf16*)(P).out)
#define BUF_SGA(P) ((bf16*)((P).ws + WS_CB))
#else
#define BUF_CB(P)  ((bf16*)((P).ws + WS_CB))
#define BUF_SGA(P) ((bf16*)(P).out)
#endif
#define BUF_SGB(P) ((bf16*)(P).out + (size_t)T * D)
typedef unsigned v4u __attribute__((ext_vector_type(4)));
typedef unsigned v2u __attribute__((ext_vector_type(2)));
typedef float f32x4 __attribute__((ext_vector_type(4)));
typedef GAS unsigned gu32;
#define RLX_AGENT __ATOMIC_RELAXED, __HIP_MEMORY_SCOPE_AGENT
#define LDS_WAIT() asm volatile("s_waitcnt lgkmcnt(0)" ::: "memory")
#define VM_WAIT() asm volatile("s_waitcnt vmcnt(0)" ::: "memory")
__device__ __forceinline__ unsigned f2bf(float f) { unsigned u = __builtin_bit_cast(unsigned, f); return (u + 0x7fffu + ((u >> 16) & 1u)) >> 16; }
__device__ __forceinline__ unsigned pk2(float lo, float hi) { return f2bf(lo) | (f2bf(hi) << 16); }
__device__ __forceinline__ float bflo(unsigned w) { return __uint_as_float(w << 16); }
__device__ __forceinline__ float bfhi(unsigned w) { return __uint_as_float(w & 0xffff0000u); }

#define XB_TMO      128
#define XB_XCNT(j)  (256  + 64 * (j))
#define XB_XSUB(j)  (1280 + 64 * (j))
#define XB_XGEN(j)  (2304 + 64 * (j))
#define XB_TOP      3328
#define XB_TOPGEN   3392
#define XCD_BAR_WORDS 3456
#define XB_SPIN_CAP (1u << 18)
__device__ __forceinline__ unsigned xb_ld(unsigned* p)              { return __hip_atomic_load(p, __ATOMIC_RELAXED, __HIP_MEMORY_SCOPE_AGENT); }
__device__ __forceinline__ unsigned xb_add(unsigned* p, unsigned v) { return __hip_atomic_fetch_add(p, v, __ATOMIC_RELAXED, __HIP_MEMORY_SCOPE_AGENT); }
__device__ __forceinline__ unsigned xb_xcc_id() { return (unsigned)__builtin_amdgcn_s_getreg((3 << 11) | 20) & 0xFu; }
#define XB_SPIN(cond, bar) do { unsigned _sp = 0; while (cond) { __builtin_amdgcn_s_sleep(1); \
    if ((++_sp & 255u) == 0u) { if (xb_ld(&(bar)[XB_TMO])) break; if (_sp > XB_SPIN_CAP) { atomicAdd(&(bar)[XB_TMO], 1u); break; } } } } while (0)
struct XcdBarrier { unsigned* bar; unsigned x; volatile LAS unsigned* st; };
__device__ __forceinline__ XcdBarrier xcd_barrier_post(unsigned* bar, volatile LAS unsigned* st) {
    XcdBarrier b; b.bar = bar; b.x = xb_xcc_id(); b.st = st;
    if (threadIdx.x == 0) (void)xb_add(&bar[XB_XCNT(b.x)], 1u);
    return b;
}
__device__ __forceinline__ void xcd_barrier_complete(unsigned* bar, unsigned x, unsigned& nloc, unsigned& nx) {
    const unsigned G = gridDim.x * gridDim.y * gridDim.z;
    unsigned sum, cnt, mine, sp = 0u;
    for (;;) {
        sum = 0u; cnt = 0u; mine = 0u;
#pragma unroll
        for (unsigned j = 0; j < 16; ++j) { const unsigned c = xb_ld(&bar[XB_XCNT(j)]); sum += c; cnt += (c > 0u) ? 1u : 0u; mine = (j == x) ? c : mine; }
        if (sum == G) break;
        __builtin_amdgcn_s_sleep(1);
        if ((++sp & 255u) == 0u) { if (xb_ld(&bar[XB_TMO])) break; if (sp > XB_SPIN_CAP) { atomicAdd(&bar[XB_TMO], 1u); break; } }
    }
    nloc = mine > 0u ? mine : 1u; nx = cnt > 0u ? cnt : 1u;
}
__device__ __forceinline__ void xcd_barrier(const XcdBarrier& b) {
    asm volatile("s_waitcnt vmcnt(0)" ::: "memory");
    __syncthreads();
    if (threadIdx.x == 0) {
        unsigned* bar = b.bar;
        __builtin_amdgcn_s_waitcnt(0);
        unsigned nloc = b.st[0], nx = b.st[1];
        if (nloc == 0u) { xcd_barrier_complete(bar, b.x, nloc, nx); b.st[0] = nloc; b.st[1] = nx; }
        const unsigned old = xb_add(&bar[XB_XSUB(b.x)], 1u);
        const unsigned gen = old / nloc;
        if (old + 1u == (gen + 1u) * nloc) {
            __builtin_amdgcn_fence(__ATOMIC_RELEASE, "agent");
            asm volatile("s_waitcnt vmcnt(0)" ::: "memory");
            const unsigned og = xb_add(&bar[XB_TOP], 1u);
            const unsigned tg = og / nx;
            if (og + 1u == (tg + 1u) * nx) xb_add(&bar[XB_TOPGEN], 1u);
            else XB_SPIN(xb_ld(&bar[XB_TOPGEN]) == tg, bar);
            __builtin_amdgcn_fence(__ATOMIC_ACQUIRE, "agent");
            xb_add(&bar[XB_XGEN(b.x)], 1u);
            asm volatile("s_waitcnt vmcnt(0)" ::: "memory");
        } else {
            XB_SPIN(xb_ld(&bar[XB_XGEN(b.x)]) == gen, bar);
            __builtin_amdgcn_fence(__ATOMIC_ACQUIRE, "agent");
            asm volatile("s_waitcnt vmcnt(0)" ::: "memory");
        }
    }
    __syncthreads();
}

struct Frame {
    LAS unsigned char* lds; volatile LAS unsigned* MISC; gu32* ctl;
    int tid, lane, wave, vcu, G;
};
__device__ __forceinline__ float wave_sum(float v) {
#pragma unroll
    for (int o = 1; o < 64; o <<= 1) v += __shfl_xor(v, o);
    return v;
}
__device__ __forceinline__ void transpose_item(const float* W, int K, int N, int k0, int n0, bf16* WT, int drow0, LAS float* scr, int lane) {
#pragma unroll 8
    for (int i = 0; i < 32; ++i) { const int kk = 2 * i + (lane >> 5); scr[kk * 33 + (lane & 31)] = W[(size_t)(k0 + kk) * N + n0 + (lane & 31)]; }
    LDS_WAIT(); asm volatile("" ::: "memory");
    const int c = lane & 7;
#pragma unroll
    for (int j = 0; j < 4; ++j) { const int n = (lane >> 3) + 8 * j; const LAS float* s = scr + (8 * c) * 33 + n;
        v4u o; o.x = pk2(s[0 * 33], s[1 * 33]); o.y = pk2(s[2 * 33], s[3 * 33]); o.z = pk2(s[4 * 33], s[5 * 33]); o.w = pk2(s[6 * 33], s[7 * 33]);
        *(GAS v4u*)(WT + (size_t)(drow0 + n) * K + k0 + 8 * c) = o; }
    LDS_WAIT(); asm volatile("" ::: "memory");
}
__device__ __forceinline__ int win_drow(int n0) {
    if (n0 < 4096 || n0 >= 6144) return n0;
    if (n0 < 5120) { const int r = n0 - 4096; return 4096 + 256 * (r >> 7) + (r & 127); }
    const int r = n0 - 5120; return 4096 + 256 * (r >> 7) + 128 + (r & 127);
}
struct Ptrs {
    const float *x, *ln_in_g, *ln_in_b, *w_in, *b_gate, *lq, *lk, *subln_g, *rel_bias, *conv_w, *w_a, *w_b, *w_o, *ln1_g, *ln1_b, *w_group, *b_group, *w_sub, *b_sub, *w_gate_e, *w_up_e, *w_down_e, *ln2_g, *ln2_b;
    float* out; unsigned char* ws;
};
__device__ __forceinline__ void p0_prologue(Frame& F, const Ptrs& P) {
    LAS float* scr = (LAS float*)(F.lds + RING_OFF + F.wave * 16384);
    const int gw = F.vcu * NWAVES + F.wave, NGW = F.G * NWAVES;
    constexpr int I_IN = (D / 64) * (NIN / 32), I_SQ = (D / 64) * (D / 32);
    bf16* Wt_in = (bf16*)(P.ws + WS_WIN); bf16* Wt_a = (bf16*)(P.ws + WS_WA); bf16* Wt_b = (bf16*)(P.ws + WS_WB); bf16* Wt_o = (bf16*)(P.ws + WS_WO);
    for (int it = gw; it < I_IN + 3 * I_SQ; it += NGW) {
        int r = it;
        if (r < I_IN) { const int kb = r / (NIN / 32), nb = r % (NIN / 32); transpose_item(P.w_in, D, NIN, 64 * kb, 32 * nb, Wt_in, win_drow(32 * nb), scr, F.lane); continue; } r -= I_IN;
        const int which = r / I_SQ; r -= which * I_SQ; const int kb = r / (D / 32), nb = r % (D / 32);
        const float* W = which == 0 ? P.w_a : (which == 1 ? P.w_b : P.w_o); bf16* WT = which == 0 ? Wt_a : (which == 1 ? Wt_b : Wt_o);
        transpose_item(W, D, D, 64 * kb, 32 * nb, WT, 32 * nb, scr, F.lane);
    }
    bf16* XN = (bf16*)(P.ws + WS_XN); float* stats = (float*)(P.ws + WS_STATS);
    for (int m = gw; m < T; m += NGW) {
        const GAS f32x4* xr = (const GAS f32x4*)(P.x + (size_t)m * D) + F.lane;
        f32x4 v[4]; float s = 0.f;
#pragma unroll
        for (int j = 0; j < 4; ++j) { v[j] = xr[64 * j]; s += (v[j].x + v[j].y) + (v[j].z + v[j].w); }
        const float mean = wave_sum(s) * (1.f / D); float s2 = 0.f;
#pragma unroll
        for (int j = 0; j < 4; ++j) { v[j] = v[j] - mean; s2 += (v[j].x * v[j].x + v[j].y * v[j].y) + (v[j].z * v[j].z + v[j].w * v[j].w); }
        const float rstd = 1.f / sqrtf(wave_sum(s2) * (1.f / D) + LN_EPS);
        GAS unsigned long long* o8 = (GAS unsigned long long*)(XN + (size_t)m * D) + F.lane;
#pragma unroll
        for (int j = 0; j < 4; ++j) { const f32x4 g = *((const GAS f32x4*)P.ln_in_g + F.lane + 64 * j), b = *((const GAS f32x4*)P.ln_in_b + F.lane + 64 * j); const f32x4 y = v[j] * rstd * g + b;
            o8[64 * j] = (unsigned long long)pk2(y.x, y.y) | ((unsigned long long)pk2(y.z, y.w) << 32); }
        if (F.lane == 0) { stats[2 * m] = mean; stats[2 * m + 1] = rstd; }
    }
}
__device__ __forceinline__ void p2_conv(Frame& F, const Ptrs& P) {
    bf16* CB = BUF_CB(P); const bf16* Z = (const bf16*)(P.ws + WS_Z);
    const int gw = F.vcu * NWAVES + F.wave, NGW = F.G * NWAVES, c0 = 16 * F.lane;
    float w0[16], w1[16], w2[16];
#pragma unroll
    for (int i = 0; i < 16; ++i) { w0[i] = P.conv_w[c0 + i]; w1[i] = P.conv_w[D + c0 + i]; w2[i] = P.conv_w[2 * D + c0 + i]; }
    for (int ch = gw; ch < T / 16; ch += NGW) {
        const int r0 = ch * 16; float z2[16], z1[16];
        if ((r0 & (SEQ - 1)) == 0) {
#pragma unroll
            for (int i = 0; i < 16; ++i) { z2[i] = 0.f; z1[i] = 0.f; }
        } else {
            const v4u a0 = *(const GAS v4u*)(Z + (size_t)(r0 - 2) * D + c0), a1 = *(const GAS v4u*)(Z + (size_t)(r0 - 2) * D + c0 + 8), b0 = *(const GAS v4u*)(Z + (size_t)(r0 - 1) * D + c0), b1 = *(const GAS v4u*)(Z + (size_t)(r0 - 1) * D + c0 + 8);
#pragma unroll
            for (int i = 0; i < 4; ++i) { z2[2 * i] = bflo(a0[i]); z2[2 * i + 1] = bfhi(a0[i]); z2[8 + 2 * i] = bflo(a1[i]); z2[8 + 2 * i + 1] = bfhi(a1[i]);
                                          z1[2 * i] = bflo(b0[i]); z1[2 * i + 1] = bfhi(b0[i]); z1[8 + 2 * i] = bflo(b1[i]); z1[8 + 2 * i + 1] = bfhi(b1[i]); }
        }
#pragma unroll 2
        for (int rr = 0; rr < 16; ++rr) { const size_t off = (size_t)(r0 + rr) * D + c0;
            const v4u za = *(const GAS v4u*)(Z + off), zb = *(const GAS v4u*)(Z + off + 8), ca = *(const GAS v4u*)(CB + off), cb = *(const GAS v4u*)(CB + off + 8);
            float zc[16], cv[16];
#pragma unroll
            for (int i = 0; i < 4; ++i) { zc[2 * i] = bflo(za[i]); zc[2 * i + 1] = bfhi(za[i]); zc[8 + 2 * i] = bflo(zb[i]); zc[8 + 2 * i + 1] = bfhi(zb[i]);
                                          cv[2 * i] = bflo(ca[i]); cv[2 * i + 1] = bfhi(ca[i]); cv[8 + 2 * i] = bflo(cb[i]); cv[8 + 2 * i + 1] = bfhi(cb[i]); }
            float u[16];
#pragma unroll
            for (int i = 0; i < 16; ++i) { u[i] = cv[i] * (z2[i] * w0[i] + z1[i] * w1[i] + zc[i] * w2[i]); z2[i] = z1[i]; z1[i] = zc[i]; }
            v4u oa, ob;
#pragma unroll
            for (int i = 0; i < 4; ++i) { oa[i] = pk2(u[2 * i], u[2 * i + 1]); ob[i] = pk2(u[8 + 2 * i], u[8 + 2 * i + 1]); }
            *(GAS v4u*)(CB + off) = oa; *(GAS v4u*)(CB + off + 8) = ob; }
    }
}
__device__ __forceinline__ attn::BlockRef attn_ref(const Ptrs& P, int s, int qb) {
    const int vh = s & 1, m = (s >> 1) & 1, h = (s >> 2) & 3, b = s >> 4;
    attn::BlockRef r; const size_t rowb = (size_t)b * SEQ * D;
    r.Q = (const bf16*)(P.ws + WS_Q) + rowb + (size_t)qb * 256 * D + h * 256 + m * 128;
    r.K = (const bf16*)(P.ws + WS_K) + rowb + h * 256 + m * 128;
    r.V = (const bf16*)(P.ws + WS_V) + rowb + h * 256 + vh * 128;
    r.O = (bf16*)(P.ws + (m ? WS_O1 : WS_XN)) + rowb + (size_t)qb * 256 * D + h * 256 + vh * 128;
    r.P0 = qb * 256; return r;
}
__device__ __forceinline__ void p2_attention(Frame& F, const Ptrs& P, char* lds) {
    float* btab = (float*)(lds + attn::BIAS_OFF);
    for (int s = F.vcu; s < BATCH * 16; s += F.G) {
        const int h = (s >> 2) & 3;
        __syncthreads();
        if (F.tid < attn::NBIAS) { const int rel = 63 - F.tid; btab[F.tid] = (P.rel_bias[attn::t5_bucket(rel) * 4 + h] - P.rel_bias[15 * 4 + h]) * (1.0f / attn::SCALE); }
        __syncthreads();
        attn::Seam S; attn::BlockRef cur = attn_ref(P, s, 0);
        attn::attn_prime(cur, lds, S);
#pragma unroll 1
        for (int qb = 0; qb < 8; ++qb) {
            const attn::BlockRef nxt = (qb < 7) ? attn_ref(P, s, qb + 1) : cur;
            attn::attn_block(cur, nxt, lds, S);
            cur = nxt;
        }
    }
}
__device__ __forceinline__ void p2b_combine(Frame& F, const Ptrs& P) {
    bf16* O0 = (bf16*)(P.ws + WS_XN); const bf16* O1 = (const bf16*)(P.ws + WS_O1);
    const int gw = F.vcu * NWAVES + F.wave, NGW = F.G * NWAVES, c0 = 16 * F.lane;
    const float l0 = wave_sum(P.lq[F.lane] * P.lk[F.lane] + P.lq[64 + F.lane] * P.lk[64 + F.lane]), l1 = wave_sum(P.lq[128 + F.lane] * P.lk[128 + F.lane] + P.lq[192 + F.lane] * P.lk[192 + F.lane]);
    const float lam = expf(l0) - expf(l1) + LAM_INIT;
    float g[16];
#pragma unroll
    for (int i = 0; i < 16; ++i) g[i] = P.subln_g[(c0 & 255) + i] * (1.f - LAM_INIT);
    for (int m = gw; m < T; m += NGW) { const size_t off = (size_t)m * D + c0;
        const v4u a0 = *(const GAS v4u*)(O0 + off), a1 = *(const GAS v4u*)(O0 + off + 8), b0 = *(const GAS v4u*)(O1 + off), b1 = *(const GAS v4u*)(O1 + off + 8);
        float d[16]; float ss = 0.f;
#pragma unroll
        for (int i = 0; i < 4; ++i) { d[2 * i] = bflo(a0[i]) - lam * bflo(b0[i]); d[2 * i + 1] = bfhi(a0[i]) - lam * bfhi(b0[i]); d[8 + 2 * i] = bflo(a1[i]) - lam * bflo(b1[i]); d[8 + 2 * i + 1] = bfhi(a1[i]) - lam * bfhi(b1[i]); }
#pragma unroll
        for (int i = 0; i < 16; ++i) ss += d[i] * d[i];
        ss += __shfl_xor(ss, 1); ss += __shfl_xor(ss, 2); ss += __shfl_xor(ss, 4); ss += __shfl_xor(ss, 8);
        const float rs = 1.f / sqrtf(ss * (1.f / 256.f) + RMS_EPS);
        v4u oa, ob;
#pragma unroll
        for (int i = 0; i < 4; ++i) { oa[i] = pk2(d[2 * i] * rs * g[2 * i], d[2 * i + 1] * rs * g[2 * i + 1]); ob[i] = pk2(d[8 + 2 * i] * rs * g[8 + 2 * i], d[8 + 2 * i + 1] * rs * g[8 + 2 * i + 1]); }
        *(GAS v4u*)(O0 + off) = oa; *(GAS v4u*)(O0 + off + 8) = ob; }
}
__device__ __forceinline__ void pe_experts(Frame& F, const Ptrs& P) {
    LAS float* scr = (LAS float*)(F.lds + RING_OFF + F.wave * 16384);
    const int gw = F.vcu * NWAVES + F.wave, NGW = F.G * NWAVES;
    bf16* Wgu = (bf16*)(P.ws + WS_WGU); bf16* Wd = (bf16*)(P.ws + WS_WD);
    constexpr int I_GU = (D / 64) * (DE / 32), I_DN = (DE / 64) * (D / 32);
    for (int it = gw; it < NE * (2 * I_GU + I_DN); it += NGW) {
        const int e = it / (2 * I_GU + I_DN); int r = it - e * (2 * I_GU + I_DN);
        if (r < 2 * I_GU) { const int up = r >= I_GU; r -= up * I_GU; const int kb = r / (DE / 32), nb = r % (DE / 32), n0 = 32 * nb;
            transpose_item((up ? P.w_up_e : P.w_gate_e) + (size_t)e * D * DE, D, DE, 64 * kb, n0, Wgu + (size_t)e * 1024 * D, 256 * (n0 >> 7) + 128 * up + (n0 & 127), scr, F.lane); }
        else { r -= 2 * I_GU; const int kb = r / (D / 32), nb = r % (D / 32);
            transpose_item(P.w_down_e + (size_t)e * DE * D, DE, D, 64 * kb, 32 * nb, Wd + (size_t)e * D * DE, 32 * nb, scr, F.lane); }
    }
}
__device__ __forceinline__ void p5_ln_route(Frame& F, const Ptrs& P) {
    LAS float* RW = (LAS float*)(F.lds + RING_OFF);
    LAS int* lcnt = (LAS int*)(F.lds + TAB_OFF);
    LAS float* rs = (LAS float*)(F.lds + RSCR_OFF) + F.wave * 128;
    for (int idx = F.tid; idx < D * 36; idx += NWAVES * 64) { const int d = idx / 36, o = idx - d * 36; float w;
        if (o < 4) w = P.w_group[d * 4 + o]; else { const int g = (o - 4) >> 3, e = (o - 4) & 7; w = P.w_sub[((size_t)g * D + d) * 8 + e]; }
        const int j = d >> 8, l = (d & 255) >> 2, i = d & 3, c = o >> 2, k = o & 3;
        RW[((((j * 4 + i) * 9 + c) * 64 + l) << 2) + k] = w; }
    if (F.tid < 32) lcnt[F.tid] = 0;
    __syncthreads();
    float* pre = (float*)(P.ws + WS_PRE); bf16* x1b = (bf16*)(P.ws + WS_XN);
    int* eid = (int*)(P.ws + WS_EID); float* ew = (float*)(P.ws + WS_EW); int* rank = (int*)(P.ws + WS_RANK);
    const int rows_per_wg = T / F.G, rbase = blockIdx.x * rows_per_wg;
    for (int rp = F.wave * 2; rp < rows_per_wg; rp += NWAVES * 2) {
        f32x4 xv[2][4];
#pragma unroll
        for (int r = 0; r < 2; ++r) { const int row = rbase + rp + r;
            GAS f32x4* pr = (GAS f32x4*)(pre + (size_t)row * D) + F.lane; f32x4 v[4]; float s = 0.f;
#pragma unroll
            for (int j = 0; j < 4; ++j) { v[j] = pr[64 * j]; s += (v[j].x + v[j].y) + (v[j].z + v[j].w); }
            const float mean = wave_sum(s) * (1.f / D); float s2 = 0.f;
#pragma unroll
            for (int j = 0; j < 4; ++j) { v[j] = v[j] - mean; s2 += (v[j].x * v[j].x + v[j].y * v[j].y) + (v[j].z * v[j].z + v[j].w * v[j].w); }
            const float rstd = 1.f / sqrtf(wave_sum(s2) * (1.f / D) + LN_EPS);
            GAS unsigned long long* o8 = (GAS unsigned long long*)(x1b + (size_t)row * D) + F.lane;
#pragma unroll
            for (int j = 0; j < 4; ++j) { const f32x4 g = *((const GAS f32x4*)P.ln1_g + F.lane + 64 * j), b = *((const GAS f32x4*)P.ln1_b + F.lane + 64 * j); const f32x4 y = v[j] * rstd * g + b;
                xv[r][j] = y; pr[64 * j] = y; o8[64 * j] = (unsigned long long)pk2(y.x, y.y) | ((unsigned long long)pk2(y.z, y.w) << 32); } }
        f32x4 acc[2][9];
#pragma unroll
        for (int r = 0; r < 2; ++r)
#pragma unroll
            for (int c = 0; c < 9; ++c) acc[r][c] = (f32x4){0.f, 0.f, 0.f, 0.f};
        asm volatile("" ::: "memory"); __builtin_amdgcn_sched_barrier(0);
#pragma unroll
        for (int j = 0; j < 4; ++j)
#pragma unroll
            for (int i = 0; i < 4; ++i)
                { const LAS f32x4* wp = (const LAS f32x4*)(RW + (((j * 4 + i) * 9 * 64 + F.lane) << 2));
#pragma unroll
                  for (int c = 0; c < 9; ++c) { const f32x4 w = wp[c * 64]; acc[0][c] += w * xv[0][j][i]; acc[1][c] += w * xv[1][j][i]; }
                  asm volatile("" : "+v"(acc[0][0]), "+v"(acc[0][1]), "+v"(acc[0][2]), "+v"(acc[0][3]), "+v"(acc[0][4]), "+v"(acc[0][5]), "+v"(acc[0][6]), "+v"(acc[0][7]), "+v"(acc[0][8]) :: "memory");
                  asm volatile("" : "+v"(acc[1][0]), "+v"(acc[1][1]), "+v"(acc[1][2]), "+v"(acc[1][3]), "+v"(acc[1][4]), "+v"(acc[1][5]), "+v"(acc[1][6]), "+v"(acc[1][7]), "+v"(acc[1][8]) :: "memory");
                  __builtin_amdgcn_sched_barrier(0); }
#pragma unroll
        for (int r = 0; r < 2; ++r)
#pragma unroll
            for (int c = 0; c < 9; ++c)
#pragma unroll
                for (int k = 0; k < 4; ++k) { const float sres = wave_sum(acc[r][c][k]); if (F.lane == 0) rs[r * 64 + c * 4 + k] = sres; }
        LDS_WAIT(); asm volatile("" ::: "memory");
        if (F.lane < 2) { const int r = F.lane, row = rbase + rp + r; const LAS float* sa = rs + r * 64;
            float gmax = sa[0] + P.b_group[0]; int gi = 0;
            for (int g = 1; g < 4; ++g) { const float v = sa[g] + P.b_group[g]; if (v > gmax) { gmax = v; gi = g; } }
            float z = 0.f;
            for (int g = 0; g < 4; ++g) z += expf(sa[g] + P.b_group[g] - gmax);
            const float gp = 1.f / z;
            const LAS float* sl = sa + 4 + gi * 8; const float* bs = P.b_sub + gi * 8;
            float b0 = sl[0] + bs[0]; int i0 = 0;
            for (int e = 1; e < 8; ++e) { const float v = sl[e] + bs[e]; if (v > b0) { b0 = v; i0 = e; } }
            float b1 = -__builtin_inff(); int i1 = 0;
            for (int e = 0; e < 8; ++e) { const float v = sl[e] + bs[e]; if (e != i0 && v > b1) { b1 = v; i1 = e; } }
            const float e1 = expf(b1 - b0); const float w0 = gp / (1.f + e1), w1 = gp * e1 / (1.f + e1);
            const int ex0 = gi * 8 + i0, ex1 = gi * 8 + i1;
            eid[row * 2] = ex0; eid[row * 2 + 1] = ex1; ew[row * 2] = w0; ew[row * 2 + 1] = w1;
            rank[row * 2] = __hip_atomic_fetch_add(lcnt + ex0, 1, __ATOMIC_RELAXED, __HIP_MEMORY_SCOPE_WORKGROUP);
            rank[row * 2 + 1] = __hip_atomic_fetch_add(lcnt + ex1, 1, __ATOMIC_RELAXED, __HIP_MEMORY_SCOPE_WORKGROUP); }
        LDS_WAIT(); asm volatile("" ::: "memory");
    }
    __syncthreads();
    if (F.tid < 32) ((int*)(P.ws + WS_CNTWG))[blockIdx.x * 32 + F.tid] = lcnt[F.tid];
}
__device__ __forceinline__ void p5b_place(Frame& F, const Ptrs& P) {
    LAS int* tab = (LAS int*)(F.lds + TAB_OFF);
    const int* cntwg = (const int*)(P.ws + WS_CNTWG);
    __syncthreads();
    if (F.tid < 32) { int tot = 0, base = 0;
        for (int w = 0; w < F.G; ++w) { const int c = __hip_atomic_load(cntwg + w * 32 + F.tid, __ATOMIC_RELAXED, __HIP_MEMORY_SCOPE_AGENT); base += (w < (int)blockIdx.x) ? c : 0; tot += c; }
        tab[96 + F.tid] = tot; tab[64 + F.tid] = base; }
    __syncthreads();
    if (F.tid == 0) { int s = 0; for (int e = 0; e < 32; ++e) { tab[e] = s; s += (tab[96 + e] + 255) & ~255; } tab[32] = s; }
    __syncthreads();
    const int rows_per_wg = T / F.G, rbase = blockIdx.x * rows_per_wg;
    const int* eid = (const int*)(P.ws + WS_EID); const int* rank = (const int*)(P.ws + WS_RANK); int* slot = (int*)(P.ws + WS_SLOT);
    const bf16* x1b = (const bf16*)(P.ws + WS_XN); bf16* xg = (bf16*)(P.ws + WS_XG);
    for (int a = F.wave; a < rows_per_wg * 2; a += NWAVES) { const int ga = rbase * 2 + a, e = eid[ga]; const int s = tab[e] + tab[64 + e] + rank[ga];
        if (F.lane == 0) slot[ga] = s;
        const GAS v4u* src = (const GAS v4u*)(x1b + (size_t)(ga >> 1) * D) + F.lane; GAS v4u* dst = (GAS v4u*)(xg + (size_t)s * D) + F.lane;
        dst[0] = src[0]; dst[64] = src[64]; }
}
__device__ __forceinline__ void p8_final(Frame& F, const Ptrs& P, bool poison) {
    const float* x1 = (const float*)(P.ws + WS_PRE); const bf16* y = (const bf16*)(P.ws + WS_XG);
    const int* slot = (const int*)(P.ws + WS_SLOT); const float* ew = (const float*)(P.ws + WS_EW);
    const int rows_per_wg = T / F.G, rbase = blockIdx.x * rows_per_wg;
    for (int rr = F.wave; rr < rows_per_wg; rr += NWAVES) { const int row = rbase + rr;
        const int s0 = slot[row * 2], s1 = slot[row * 2 + 1]; const float w0 = ew[row * 2], w1 = ew[row * 2 + 1];
        const GAS f32x4* xr = (const GAS f32x4*)(x1 + (size_t)row * D) + F.lane; const GAS v2u* y0 = (const GAS v2u*)(y + (size_t)s0 * D) + F.lane; const GAS v2u* y1 = (const GAS v2u*)(y + (size_t)s1 * D) + F.lane;
        f32x4 v[4]; float s = 0.f;
#pragma unroll
        for (int j = 0; j < 4; ++j) { const f32x4 xx = xr[64 * j]; const v2u a = y0[64 * j], b = y1[64 * j];
            v[j].x = ALPHA * xx.x + w0 * bflo(a.x) + w1 * bflo(b.x); v[j].y = ALPHA * xx.y + w0 * bfhi(a.x) + w1 * bfhi(b.x); v[j].z = ALPHA * xx.z + w0 * bflo(a.y) + w1 * bflo(b.y); v[j].w = ALPHA * xx.w + w0 * bfhi(a.y) + w1 * bfhi(b.y);
            s += (v[j].x + v[j].y) + (v[j].z + v[j].w); }
        const float mean = wave_sum(s) * (1.f / D); float s2 = 0.f;
#pragma unroll
        for (int j = 0; j < 4; ++j) { v[j] = v[j] - mean; s2 += (v[j].x * v[j].x + v[j].y * v[j].y) + (v[j].z * v[j].z + v[j].w * v[j].w); }
        const float rstd = 1.f / sqrtf(wave_sum(s2) * (1.f / D) + LN_EPS);
        GAS f32x4* o = (GAS f32x4*)(P.out + (size_t)row * D) + F.lane; const float qn = __builtin_nanf("");
#pragma unroll
        for (int j = 0; j < 4; ++j) { const f32x4 g = *((const GAS f32x4*)P.ln2_g + F.lane + 64 * j), b = *((const GAS f32x4*)P.ln2_b + F.lane + 64 * j); f32x4 yv = v[j] * rstd * g + b;
            if (poison) yv = (f32x4){qn, qn, qn, qn}; o[64 * j] = yv; }
    }
}

constexpr int N_PHASES = 11;
struct Args { Ptrs p; int ph_lo, ph_hi, bar_region, flags; };
__global__ void __launch_bounds__(NWAVES * 64, 2) mega_fwd(Args args) {
    extern __shared__ __attribute__((aligned(16))) unsigned char lds[];
    Frame F; const Ptrs& P = args.p;
    F.lds = (LAS unsigned char*)lds; F.MISC = (volatile LAS unsigned*)(F.lds + MISC_OFF);
    F.tid = threadIdx.x; F.lane = F.tid & 63; F.wave = __builtin_amdgcn_readfirstlane(F.tid >> 6);
    F.G = gridDim.x; { const int bx = blockIdx.x; F.vcu = (F.G % 8 == 0) ? (bx % 8) * (F.G / 8) + bx / 8 : bx; }
    F.ctl = (gu32*)(P.ws + WS_CTL);
    for (int u = F.tid; u < (LDS_BYTES - LDSCTL_OFF) / 4; u += NWAVES * 64) ((LAS unsigned*)(F.lds + LDSCTL_OFF))[u] = 0u;
    __syncthreads();
    XcdBarrier bar = xcd_barrier_post((unsigned*)(F.ctl + CW_BAR) + args.bar_region * XCD_BAR_WORDS, F.MISC + 8);
    const int lo = args.ph_lo, hi = args.ph_hi;
#ifndef PH_MASK
#define PH_MASK 0x7ff
#endif
#define IN(k) (((PH_MASK >> (k)) & 1) && lo <= (k) && (k) < hi)
#define BOTH(k) (IN(k) && IN((k) + 1))
#define GRID_BAR() xcd_barrier(bar)
    const bool grid_ok = (F.G == 256);

    if (IN(0)) { p0_prologue(F, P); if (BOTH(0)) GRID_BAR(); }
    if (IN(1)) {
        pg8::Gemm g{(const pg8::bf16_t*)(P.ws + WS_XN), (const pg8::bf16_t*)(P.ws + WS_WIN), T, NIN, D}; pg8::StaticOrder S; S.init(T, NIN, F.G, (int)blockIdx.x);
        pg8::EpiInProj E{(pg8::bf16_t*)(P.ws + WS_Q), (size_t)(WS_K - WS_Q) / 2, BUF_CB(P), (pg8::bf16_t*)(P.ws + WS_Z), BUF_SGA(P), BUF_SGB(P)};
        pg8::gemm_phase<pg8::EpiInProj, pg8::StaticOrder, true, true>(F.lds + RING_OFF, g, S, E);
        if (BOTH(1)) GRID_BAR();
    }
    if (IN(2)) { p2_conv(F, P); p2_attention(F, P, (char*)lds + RING_OFF); if (BOTH(2)) GRID_BAR(); }
    if (IN(3)) { if (!(args.flags & 1)) p2b_combine(F, P); pe_experts(F, P); if (BOTH(3)) GRID_BAR(); }
    if (IN(4)) {
        { pg8::Gemm g{(const pg8::bf16_t*)(P.ws + WS_XN), (const pg8::bf16_t*)(P.ws + WS_WA), T, D, D}; pg8::StaticOrder S; S.init(T, D, F.G, (int)blockIdx.x);
          pg8::EpiGate<false> E{BUF_SGA(P), nullptr, (pg8::bf16_t*)(P.ws + WS_O1), P.b_gate};
          pg8::gemm_phase<pg8::EpiGate<false>, pg8::StaticOrder, true, true>(F.lds + RING_OFF, g, S, E); }
        __syncthreads();
        { pg8::Gemm g{BUF_CB(P), (const pg8::bf16_t*)(P.ws + WS_WB), T, D, D}; pg8::StaticOrder S; S.init(T, D, F.G, (int)blockIdx.x);
          pg8::EpiGate<true> E{BUF_SGB(P), (const pg8::bf16_t*)(P.ws + WS_O1), (pg8::bf16_t*)(P.ws + WS_Z), P.b_gate + 1024};
          pg8::gemm_phase<pg8::EpiGate<true>, pg8::StaticOrder, true, true>(F.lds + RING_OFF, g, S, E); }
        if (BOTH(4)) GRID_BAR();
    }
    if (IN(5)) {
        pg8::Gemm g{(const pg8::bf16_t*)(P.ws + WS_Z), (const pg8::bf16_t*)(P.ws + WS_WO), T, D, D}; pg8::StaticOrder S; S.init(T, D, F.G, (int)blockIdx.x);
        pg8::EpiPre E{P.x, (const float*)(P.ws + WS_STATS), P.ln_in_g, P.ln_in_b, (float*)(P.ws + WS_PRE), ALPHA};
        pg8::gemm_phase<pg8::EpiPre, pg8::StaticOrder, true, true>(F.lds + RING_OFF, g, S, E);
        if (BOTH(5)) GRID_BAR();
    }
    if (IN(6)) { if (grid_ok) p5_ln_route(F, P); if (BOTH(6)) GRID_BAR(); }
    if (IN(7)) { if (grid_ok) p5b_place(F, P); if (BOTH(7)) GRID_BAR(); }
    if (IN(8)) {
        if (grid_ok) { pg8::Gemm g{(const pg8::bf16_t*)(P.ws + WS_XG), (const pg8::bf16_t*)(P.ws + WS_WGU), MAXS, NE * 1024, D};
          pg8::MoeOrder S{(const PG8_LAS int*)(F.lds + TAB_OFF), F.G, F.vcu}; pg8::EpiMoeUp E{(pg8::bf16_t*)P.out};
          pg8::gemm_phase<pg8::EpiMoeUp, pg8::MoeOrder, true, true>(F.lds + RING_OFF, g, S, E); }
        if (BOTH(8)) GRID_BAR();
    }
    if (IN(9)) {
        if (grid_ok) { pg8::Gemm g{(const pg8::bf16_t*)P.out, (const pg8::bf16_t*)(P.ws + WS_WD), MAXS, NE * 1024, DE};
          pg8::MoeOrder S{(const PG8_LAS int*)(F.lds + TAB_OFF), F.G, F.vcu}; pg8::EpiMoeDown E{(pg8::bf16_t*)(P.ws + WS_XG)};
          pg8::gemm_phase<pg8::EpiMoeDown, pg8::MoeOrder, true, true>(F.lds + RING_OFF, g, S, E); }
        if (BOTH(9)) GRID_BAR();
    }
    if (IN(10)) {
        bool poison = !grid_ok || (__hip_atomic_load(F.ctl + CW_BAR + args.bar_region * XCD_BAR_WORDS + XB_TMO, RLX_AGENT) != 0u);
        if (grid_ok) p8_final(F, P, poison);
        else { const float qn = __builtin_nanf(""); for (size_t i = (size_t)blockIdx.x * 512 + F.tid; i < (size_t)T * D; i += (size_t)F.G * 512) P.out[i] = qn; }
    }
#undef IN
#undef BOTH
#undef GRID_BAR
}

#if HYBRID
namespace nv {
constexpr int D = 1024, BATCH = 16, SEQ = 2048, T = BATCH * SEQ, NIN = 8192, NH = 4, HD = 128, NE = 32, DE = 512;
constexpr float LN_EPS = 1e-5f, RMS_EPS = 1e-6f;
constexpr float ALPHA = 1.189207115002721f;
constexpr float LAM_INIT = 0.2f;
constexpr int MOE_PAD = 64;
constexpr int MAX_SLOTS = 2 * T + NE * MOE_PAD;
constexpr int MAX_TILES = MAX_SLOTS / MOE_PAD;

__device__ __forceinline__ float wave_sum(float v) {
#pragma unroll
    for (int o = 1; o < 64; o <<= 1) v += __shfl_xor(v, o);
    return v;
}
__device__ __forceinline__ float wave_max(float v) {
#pragma unroll
    for (int o = 1; o < 64; o <<= 1) v = fmaxf(v, __shfl_xor(v, o));
    return v;
}
__device__ __forceinline__ float block_sum(float v, float* scr) {
    v = wave_sum(v); __syncthreads();
    if ((threadIdx.x & 63) == 0) scr[threadIdx.x >> 6] = v; __syncthreads();
    float r = 0.f; for (int i = 0; i < (int)(blockDim.x >> 6); ++i) r += scr[i]; __syncthreads(); return r;
}
__device__ __forceinline__ float block_max(float v, float* scr) {
    v = wave_max(v); __syncthreads();
    if ((threadIdx.x & 63) == 0) scr[threadIdx.x >> 6] = v; __syncthreads();
    float r = -INFINITY; for (int i = 0; i < (int)(blockDim.x >> 6); ++i) r = fmaxf(r, scr[i]); __syncthreads(); return r;
}

__global__ void k_ln_rows(const float* x, float a, const float* add, const float* g, const float* b, float* y) {
    __shared__ float scr[8];
    const size_t row = blockIdx.x; const float* xr = x + row * D; const float* ar = add ? add + row * D : nullptr;
    float v[4]; float s = 0.f;
    for (int j = 0; j < 4; ++j) { const int c = threadIdx.x + 256 * j; v[j] = a * xr[c] + (ar ? ar[c] : 0.f); s += v[j]; }
    const float mean = block_sum(s, scr) * (1.f / D); float q = 0.f;
    for (int j = 0; j < 4; ++j) { v[j] -= mean; q += v[j] * v[j]; }
    const float rstd = 1.f / sqrtf(block_sum(q, scr) * (1.f / D) + LN_EPS);
    for (int j = 0; j < 4; ++j) { const int c = threadIdx.x + 256 * j; y[row * D + c] = v[j] * rstd * g[c] + b[c]; }
}

struct TileAcc { float c[4][4]; };
__device__ __forceinline__ void gemm_tile(const float* __restrict__ A, int lda, const int* rowidx, int row0, const float* __restrict__ B, int ldb, int col0, int K, TileAcc& acc, float (*As)[65], float (*Bs)[65]) {
    const int tid = threadIdx.x, tx = tid & 15, ty = tid >> 4;
    for (int i = 0; i < 4; ++i) for (int j = 0; j < 4; ++j) acc.c[i][j] = 0.f;
    for (int k0 = 0; k0 < K; k0 += 16) {
        for (int e = tid; e < 64 * 16; e += 256) { const int r = e >> 4, k = e & 15; int gr = row0 + r; float v = 0.f;
            if (rowidx) { const int t = rowidx[gr]; if (t >= 0) v = A[(size_t)t * lda + k0 + k]; } else v = A[(size_t)gr * lda + k0 + k];
            As[k][r] = v; }
        for (int e = tid; e < 16 * 64; e += 256) { const int k = e >> 6, c = e & 63; Bs[k][c] = B[(size_t)(k0 + k) * ldb + col0 + c]; }
        __syncthreads();
#pragma unroll
        for (int k = 0; k < 16; ++k) { float a[4], b[4];
            for (int i = 0; i < 4; ++i) a[i] = As[k][ty * 4 + i];
            for (int j = 0; j < 4; ++j) b[j] = Bs[k][tx * 4 + j];
            for (int i = 0; i < 4; ++i) for (int j = 0; j < 4; ++j) acc.c[i][j] += a[i] * b[j]; }
        __syncthreads();
    }
}
__global__ void k_gemm(const float* A, int lda, const float* B, int ldb, float* C, int ldc, int K) {
    __shared__ float As[16][65], Bs[16][65];
    TileAcc acc; const int row0 = blockIdx.y * 64, col0 = blockIdx.x * 64;
    gemm_tile(A, lda, nullptr, row0, B, ldb, col0, K, acc, As, Bs);
    const int tx = threadIdx.x & 15, ty = threadIdx.x >> 4;
    for (int i = 0; i < 4; ++i) for (int j = 0; j < 4; ++j) C[(size_t)(row0 + ty * 4 + i) * ldc + col0 + tx * 4 + j] = acc.c[i][j];
}

__device__ __forceinline__ int t5_bucket(int rel) {
    int b = rel > 0 ? 16 : 0; const int n = rel < 0 ? -rel : rel; int v;
    if (n < 8) v = n; else if (n < 12) v = 8; else if (n < 16) v = 9; else if (n < 23) v = 10; else if (n < 32) v = 11; else if (n < 46) v = 12; else if (n < 65) v = 13; else if (n < 91) v = 14; else v = 15;
    return b + v;
}
__global__ void k_attn(const float* P, const float* rel_bias, const float* lq, const float* lk, const float* subln_g, float* ao) {
    __shared__ float q1[128], q2[128], lg[2][SEQ], scr[8];
    const int q = blockIdx.x, h = blockIdx.y, tid = threadIdx.x;
    float l0 = 0.f, l1 = 0.f; for (int i = 0; i < 128; ++i) { l0 += lq[i] * lk[i]; l1 += lq[128 + i] * lk[128 + i]; }
    const float lam = expf(l0) - expf(l1) + LAM_INIT;
    if (tid < 128) q1[tid] = P[(size_t)q * NIN + h * 256 + tid]; else q2[tid - 128] = P[(size_t)q * NIN + h * 256 + tid];
    __syncthreads();
    const int nk = (q / 64 + 1) * 64; const float scale = 0.08838834764831845f;
    float m1 = -INFINITY, m2 = -INFINITY;
    for (int k = tid; k < nk; k += 256) { const float* kr = P + (size_t)k * NIN + 1024 + h * 256; float s1 = 0.f, s2 = 0.f;
        for (int d = 0; d < 128; ++d) { s1 += q1[d] * kr[d]; s2 += q2[d] * kr[128 + d]; }
        const float bias = rel_bias[t5_bucket(k - q) * NH + h];
        s1 = s1 * scale + bias; s2 = s2 * scale + bias; lg[0][k] = s1; lg[1][k] = s2; m1 = fmaxf(m1, s1); m2 = fmaxf(m2, s2); }
    m1 = block_max(m1, scr); m2 = block_max(m2, scr);
    float z1 = 0.f, z2 = 0.f;
    for (int k = tid; k < nk; k += 256) { const float e1 = expf(lg[0][k] - m1), e2 = expf(lg[1][k] - m2); lg[0][k] = e1; lg[1][k] = e2; z1 += e1; z2 += e2; }
    z1 = block_sum(z1, scr); z2 = block_sum(z2, scr);
    for (int k = tid; k < nk; k += 256) lg[0][k] = lg[0][k] / z1 - lam * (lg[1][k] / z2);
    __syncthreads();
    float o = 0.f; const float* vb = P + 2048 + h * 256 + tid;
    for (int k = 0; k < nk; ++k) o += lg[0][k] * vb[(size_t)k * NIN];
    const float ms = block_sum(o * o, scr) * (1.f / 256.f);
    ao[(size_t)q * D + h * 256 + tid] = o * (1.f / sqrtf(ms + RMS_EPS)) * subln_g[tid] * (1.f - LAM_INIT);
}
__global__ void k_conv(const float* P, const float* cw, float* u) {
    const int t = blockIdx.x;
    for (int c = threadIdx.x; c < D; c += 256) { float z = 0.f;
        for (int w = 0; w < 3; ++w) { const int tt = t + w - 2; if (tt >= 0) z += P[(size_t)tt * NIN + 4096 + c] * P[(size_t)tt * NIN + 5120 + c] * cw[w * D + c]; }
        u[(size_t)t * D + c] = P[(size_t)t * NIN + 3072 + c] * z; }
}
__global__ void k_merge(const float* P, const float* bg, const float* yA, const float* yB, float* m) {
    const int t = blockIdx.x;
    for (int c = threadIdx.x; c < D; c += 256) { const float ga = 1.f / (1.f + expf(-(P[(size_t)t * NIN + 6144 + c] + bg[c]))), gb = 1.f / (1.f + expf(-(P[(size_t)t * NIN + 7168 + c] + bg[D + c])));
        m[(size_t)t * D + c] = ga * yA[(size_t)t * D + c] + gb * yB[(size_t)t * D + c]; }
}
__global__ void k_route(const float* x1, const float* wg, const float* bg, const float* wsub, const float* bsub, int* eid, float* ew, int* rank, int* cnt) {
    const int t = blockIdx.x * 4 + (threadIdx.x >> 6), lane = threadIdx.x & 63;
    float acc[36];
#pragma unroll
    for (int i = 0; i < 36; ++i) acc[i] = 0.f;
    for (int j = 0; j < 16; ++j) { const int d = lane + 64 * j; const float xv = x1[(size_t)t * D + d];
#pragma unroll
        for (int g = 0; g < 4; ++g) acc[g] += xv * wg[d * 4 + g];
#pragma unroll
        for (int g = 0; g < 4; ++g) {
#pragma unroll
            for (int e = 0; e < 8; ++e) acc[4 + g * 8 + e] += xv * wsub[((size_t)g * D + d) * 8 + e]; } }
#pragma unroll
    for (int i = 0; i < 36; ++i) acc[i] = wave_sum(acc[i]);
    __shared__ float sacc[4][36];
    const int wv = threadIdx.x >> 6;
#pragma unroll
    for (int i = 0; i < 36; ++i) if (lane == 0) sacc[wv][i] = acc[i];
    __syncthreads();
    if (lane == 0) {
        const float* sa = sacc[wv];
        float gmax = sa[0] + bg[0]; int gi = 0;
        for (int g = 1; g < 4; ++g) { const float v = sa[g] + bg[g]; if (v > gmax) { gmax = v; gi = g; } }
        float z = 0.f;
        for (int g = 0; g < 4; ++g) z += expf(sa[g] + bg[g] - gmax);
        const float gp = 1.f / z;
        const float* sl = sa + 4 + gi * 8; const float* bs = bsub + gi * 8;
        float b0 = sl[0] + bs[0]; int i0 = 0;
        for (int e = 1; e < 8; ++e) { const float v = sl[e] + bs[e]; if (v > b0) { b0 = v; i0 = e; } }
        float b1 = -INFINITY; int i1 = 0;
        for (int e = 0; e < 8; ++e) { const float v = sl[e] + bs[e]; if (e != i0 && v > b1) { b1 = v; i1 = e; } }
        const float e1 = expf(b1 - b0); const float w0 = gp / (1.f + e1), w1 = gp * e1 / (1.f + e1);
        const int ex0 = gi * 8 + i0, ex1 = gi * 8 + i1;
        eid[t * 2] = ex0; eid[t * 2 + 1] = ex1; ew[t * 2] = w0; ew[t * 2 + 1] = w1;
        rank[t * 2] = atomicAdd(&cnt[ex0], 1); rank[t * 2 + 1] = atomicAdd(&cnt[ex1], 1);
    }
}
__global__ void k_offsets(const int* cnt, int* pad_start, int* tile_expert) {
    if (threadIdx.x == 0) { int s = 0; for (int e = 0; e < NE; ++e) { pad_start[e] = s; const int p = (cnt[e] + MOE_PAD - 1) / MOE_PAD * MOE_PAD; for (int i = 0; i < p / MOE_PAD; ++i) tile_expert[s / MOE_PAD + i] = e; s += p; }
        pad_start[NE] = s; for (int i = s / MOE_PAD; i < MAX_TILES; ++i) tile_expert[i] = -1; }
}
__global__ void k_place(const int* eid, const float* ew, const int* rank, const int* pad_start, int* tok, float* wslot) {
    const int a = blockIdx.x * 256 + threadIdx.x; if (a >= 2 * T) return;
    const int s = pad_start[eid[a]] + rank[a]; tok[s] = a >> 1; wslot[s] = ew[a];
}
__global__ void k_moe_up(const float* x1, const int* tok, const int* tile_expert, const float* Wg, const float* Wu, float* h) {
    __shared__ float As[16][65], Bs[16][65];
    const int e = tile_expert[blockIdx.y]; if (e < 0) return;
    TileAcc g, u; const int row0 = blockIdx.y * 64, col0 = blockIdx.x * 64;
    gemm_tile(x1, D, tok, row0, Wg + (size_t)e * D * DE, DE, col0, D, g, As, Bs);
    gemm_tile(x1, D, tok, row0, Wu + (size_t)e * D * DE, DE, col0, D, u, As, Bs);
    const int tx = threadIdx.x & 15, ty = threadIdx.x >> 4;
    for (int i = 0; i < 4; ++i) for (int j = 0; j < 4; ++j) { const float gv = g.c[i][j]; h[(size_t)(row0 + ty * 4 + i) * DE + col0 + tx * 4 + j] = gv / (1.f + expf(-gv)) * u.c[i][j]; }
}
__global__ void k_moe_down(const float* h, const int* tok, const float* wslot, const int* tile_expert, const float* Wd, float* ffn) {
    __shared__ float As[16][65], Bs[16][65];
    const int e = tile_expert[blockIdx.y]; if (e < 0) return;
    TileAcc acc; const int row0 = blockIdx.y * 64, col0 = blockIdx.x * 64;
    gemm_tile(h, DE, nullptr, row0, Wd + (size_t)e * DE * D, D, col0, DE, acc, As, Bs);
    const int tx = threadIdx.x & 15, ty = threadIdx.x >> 4;
    for (int i = 0; i < 4; ++i) { const int r = row0 + ty * 4 + i; const int t = tok[r]; if (t < 0) continue; const float w = wslot[r];
        for (int j = 0; j < 4; ++j) atomicAdd(&ffn[(size_t)t * D + col0 + tx * 4 + j], w * acc.c[i][j]); }
}
}
#endif
#if HYBRID
__global__ void k_axpy(const float* xn, const float* mix, float* pre, float a, size_t n) { const size_t i = (size_t)blockIdx.x * 256 + threadIdx.x; if (i < n) pre[i] = a * xn[i] + mix[i]; }
__global__ void k_f2b(const float* src, int lds_, unsigned short* dst, int ldd, int cols, size_t rows) {
    const size_t i = (size_t)blockIdx.x * 256 + threadIdx.x; if (i >= rows * cols) return; const size_t r = i / cols; const int c = (int)(i % cols);
    dst[r * ldd + c] = (unsigned short)f2bf(src[r * lds_ + c]); }
__global__ void k_f2b_mul(const float* a, const float* b, int lds_, unsigned short* dst, int ldd, int cols, size_t rows) {
    const size_t i = (size_t)blockIdx.x * 256 + threadIdx.x; if (i >= rows * cols) return; const size_t r = i / cols; const int c = (int)(i % cols);
    dst[r * ldd + c] = (unsigned short)f2bf(a[r * lds_ + c] * b[r * lds_ + c]); }
__global__ void k_f2b_sig(const float* a, const float* bias, int lds_, unsigned short* dst, int ldd, int cols, size_t rows) {
    const size_t i = (size_t)blockIdx.x * 256 + threadIdx.x; if (i >= rows * cols) return; const size_t r = i / cols; const int c = (int)(i % cols);
    dst[r * ldd + c] = (unsigned short)f2bf(1.f / (1.f + expf(-(a[r * lds_ + c] + bias[c])))); }
#endif
static void launch_mega(const Ptrs& p, int lo, int hi, int region, int flags, hipStream_t stream) {
    Args a{}; a.p = p; a.ph_lo = lo; a.ph_hi = hi; a.bar_region = region; a.flags = flags;
    hipLaunchKernelGGL(mega_fwd, dim3(256), dim3(NWAVES * 64), LDS_BYTES, stream, a);
}
extern "C" void kernel_launch(void* const* d_in, const int* in_sizes, int n_in, void* d_out, int out_size, void* d_ws, size_t ws_size, hipStream_t stream) {
    static int ready = 0;
    if (ready == 0) {
        ready = 1;
        if (n_in != 24 || out_size != T * D || ws_size < WS_END) { fprintf(stderr, "kernel_launch: unexpected shapes (n_in %d out %d ws %zu)\n", n_in, out_size, ws_size); ready = -1; }
        else if (hipFuncSetAttribute((const void*)mega_fwd, hipFuncAttributeMaxDynamicSharedMemorySize, LDS_BYTES) != hipSuccess) { fprintf(stderr, "kernel_launch: hipFuncSetAttribute failed\n"); ready = -1; }
        (void)hipGetLastError();
    }
    if (ready < 0) return;
    Ptrs p{};
    const float** pp = (const float**)&p;
    for (int i = 0; i < 24; ++i) pp[i] = (const float*)d_in[i];
    p.out = (float*)d_out; p.ws = (unsigned char*)d_ws;
    (void)hipMemsetAsync((char*)d_ws + WS_CTL, 0, CTL_ZERO_BYTES, stream);
#if HYBRID == 0
#ifdef SPLIT_AT
    launch_mega(p, 0, SPLIT_AT, 0, 0, stream); launch_mega(p, SPLIT_AT, N_PHASES, 1, 0, stream);
#else
    launch_mega(p, 0, N_PHASES, 0, 0, stream);
#endif
#else
    char* ws = (char*)d_ws; float* out = (float*)d_out;
    constexpr size_t NB = (HYBRID == 1 ? 330 : (HYBRID == 2 ? 90 : 410)) * MiB;
    float* Pb = (float*)(ws + NB); float* xnb = (float*)(ws + NB + 64 * MiB); float* ao = (float*)(ws + NB + 72 * MiB); float* ub = (float*)(ws + NB + 80 * MiB); float* yA = (float*)(ws + NB + 88 * MiB); float* yB = (float*)(ws + NB + 96 * MiB); float* mb = (float*)(ws + NB + 104 * MiB);
    float* pre = (float*)(ws + WS_PRE);
#ifndef TAKE_MASK
#define TAKE_MASK 0
#endif
#if HYBRID >= 2
    launch_mega(p, 0, TAKE_MASK ? 2 : 1, 0, 0, stream);
#endif
    for (int b = 0; b < BATCH; ++b) {
        const size_t r0 = (size_t)b * SEQ;
        nv::k_ln_rows<<<SEQ, 256, 0, stream>>>(p.x + r0 * D, 1.f, nullptr, p.ln_in_g, p.ln_in_b, xnb);
        nv::k_gemm<<<dim3(NIN / 64, SEQ / 64), 256, 0, stream>>>(xnb, D, p.w_in, NIN, Pb, NIN, D);
#if HYBRID == 3
        { const int nb = (int)(((size_t)SEQ * 1024 + 255) / 256);
          if (!(TAKE_MASK & 1)) k_f2b<<<nb, 256, 0, stream>>>(Pb, NIN, (unsigned short*)(ws + WS_Q) + r0 * D, D, 1024, SEQ);
          if (!(TAKE_MASK & 2)) k_f2b<<<nb, 256, 0, stream>>>(Pb + 1024, NIN, (unsigned short*)(ws + WS_K) + r0 * D, D, 1024, SEQ);
          if (!(TAKE_MASK & 4)) k_f2b<<<nb, 256, 0, stream>>>(Pb + 2048, NIN, (unsigned short*)(ws + WS_V) + r0 * D, D, 1024, SEQ);
          if (!(TAKE_MASK & 8)) k_f2b<<<nb, 256, 0, stream>>>(Pb + 3072, NIN, BUF_CB(p) + r0 * D, D, 1024, SEQ);
          if (!(TAKE_MASK & 16)) k_f2b_mul<<<nb, 256, 0, stream>>>(Pb + 4096, Pb + 5120, NIN, (unsigned short*)(ws + WS_Z) + r0 * D, D, 1024, SEQ);
          if (!(TAKE_MASK & 32)) k_f2b<<<nb, 256, 0, stream>>>(Pb + 6144, NIN, BUF_SGA(p) + r0 * D, D, 1024, SEQ);
          if (!(TAKE_MASK & 64)) k_f2b<<<nb, 256, 0, stream>>>(Pb + 7168, NIN, BUF_SGB(p) + r0 * D, D, 1024, SEQ); }
#else
        nv::k_attn<<<dim3(SEQ, nv::NH), 256, 0, stream>>>(Pb, p.rel_bias, p.lq, p.lk, p.subln_g, ao);
        nv::k_conv<<<SEQ, 256, 0, stream>>>(Pb, p.conv_w, ub);
#if HYBRID == 2
        { const int nb = (int)(((size_t)SEQ * 1024 + 255) / 256);
          k_f2b<<<nb, 256, 0, stream>>>(ao, D, (unsigned short*)(ws + WS_XN) + r0 * D, D, 1024, SEQ);
          k_f2b<<<nb, 256, 0, stream>>>(ub, D, BUF_CB(p) + r0 * D, D, 1024, SEQ);
          k_f2b<<<nb, 256, 0, stream>>>(Pb + 6144, NIN, BUF_SGA(p) + r0 * D, D, 1024, SEQ);
          k_f2b<<<nb, 256, 0, stream>>>(Pb + 7168, NIN, BUF_SGB(p) + r0 * D, D, 1024, SEQ); }
#else
        nv::k_gemm<<<dim3(D / 64, SEQ / 64), 256, 0, stream>>>(ao, D, p.w_a, D, yA, D, D);
        nv::k_gemm<<<dim3(D / 64, SEQ / 64), 256, 0, stream>>>(ub, D, p.w_b, D, yB, D, D);
        nv::k_merge<<<SEQ, 256, 0, stream>>>(Pb, p.b_gate, yA, yB, mb);
        nv::k_gemm<<<dim3(D / 64, SEQ / 64), 256, 0, stream>>>(mb, D, p.w_o, D, pre + r0 * D, D, D);
        k_axpy<<<(int)(((size_t)SEQ * D + 255) / 256), 256, 0, stream>>>(xnb, pre + r0 * D, pre + r0 * D, ALPHA, (size_t)SEQ * D);
#endif
#endif
    }
#if HYBRID == 1
    launch_mega(p, 3, 4, 1, 1, stream);
    launch_mega(p, 6, N_PHASES, 2, 0, stream);
#elif HYBRID == 2
    launch_mega(p, 3, 4, 1, 1, stream);
    launch_mega(p, 4, N_PHASES, 2, 0, stream);
#elif HYBRID == 3
    launch_mega(p, 2, N_PHASES, 1, 0, stream);
#endif
#endif
}
```

```cpp
#include <hip/hip_runtime.h>
#include <cstdio>
#include <cstdint>
#include <cmath>
#ifndef HYBRID
#define HYBRID 0
#endif
namespace pg8 {
#define PG8_LAS __attribute__((address_space(3)))
typedef unsigned short bf16_t;
typedef short bf16x8 __attribute__((ext_vector_type(8)));
typedef float f32x4 __attribute__((ext_vector_type(4)));
typedef unsigned u32x4 __attribute__((ext_vector_type(4)));
constexpr int BM = 256, BK = 64, HALF = 128, HTB = HALF * BK * 2  , STAGE_BYTES = 8 * HTB, NXCD = 8, WGM = 8;

__host__ __device__ __forceinline__ int lds_byte(int r, int c) { const int st = (r >> 4) * 2 + (c >> 5), rr = r & 15, cc = c & 31, ob = rr * 64 + cc * 2; return st * 1024 + (ob ^ (((ob >> 9) & 1) << 5)); }
__host__ __device__ __forceinline__ void stage_rc(int b, int& R, int& C) { const int st = b / 1024, sb = b % 1024, swz = sb ^ (((sb >> 9) & 1) << 5); R = (st >> 1) * 16 + swz / 64; C = (st & 1) * 32 + (swz % 64) / 2; }
__host__ __device__ __forceinline__ int perm32(int rho) { const int n = rho >> 4, i = rho & 15; return 8 * (i >> 2) + 4 * n + (i & 3); }

struct Unit { int pm, pn; };
struct Gemm { const bf16_t* A; const bf16_t* Bt; int M, N, K; };

struct StaticOrder {
    int nM, nN, nwg, G, c;
    __host__ __device__ void init(int M, int N, int G_, int c_) { nM = M / BM; nN = N / BM; nwg = nM * nN; G = G_; c = c_; }
    __host__ __device__ bool next(int i, Unit& u) const {
        const long L = (long)i * G + c; if (L >= nwg) return false;
        int wgid = (int)L; { const int q = nwg / NXCD, r = nwg % NXCD, xcd = wgid % NXCD, off = wgid / NXCD; wgid = (xcd < r ? xcd * (q + 1) : r * (q + 1) + (xcd - r) * q) + off; }
        const int nig = WGM * nN, gid = wgid / nig, fm = gid * WGM, gsz = (nM - fm) < WGM ? (nM - fm) : WGM;
        u.pm = fm + ((wgid % nig) % gsz); u.pn = (wgid % nig) / gsz; return true;
    }
    __device__ __forceinline__ void a_ready(const Unit&) const {}
    __device__ __forceinline__ void done(const Unit&) const {}
};

__device__ __forceinline__ unsigned cvt_pk_bf16(float lo, float hi) { unsigned r; asm volatile("v_cvt_pk_bf16_f32 %0, %1, %2" : "=v"(r) : "v"(lo), "v"(hi)); return r; }
typedef float f32x2 __attribute__((ext_vector_type(2)));
__device__ __forceinline__ u32x4 pack8f(const f32x4 a, const f32x4 b) { u32x4 w; w.x = cvt_pk_bf16(a[0], a[1]); w.y = cvt_pk_bf16(a[2], a[3]); w.z = cvt_pk_bf16(b[0], b[1]); w.w = cvt_pk_bf16(b[2], b[3]); return w; }
__device__ __forceinline__ void unpack8f(const u32x4 w, f32x4& a, f32x4& b) {
    a[0] = __uint_as_float(w.x << 16); a[1] = __uint_as_float(w.x & 0xffff0000u); a[2] = __uint_as_float(w.y << 16); a[3] = __uint_as_float(w.y & 0xffff0000u);
    b[0] = __uint_as_float(w.z << 16); b[1] = __uint_as_float(w.z & 0xffff0000u); b[2] = __uint_as_float(w.w << 16); b[3] = __uint_as_float(w.w & 0xffff0000u); }
__device__ __forceinline__ float sigmoidf_fast(float x) { return __builtin_amdgcn_rcpf(1.0f + __expf(-x)); }

struct EpiInProj {
    static constexpr bool PERM = true, AFTER_DRAIN = false;
    bf16_t* qkv; size_t stride;
    bf16_t* cb;
    bf16_t* z;
    bf16_t* sga; bf16_t* sgb;
    __device__ __forceinline__ void operator()(const f32x4 (&acc)[2][2][4][2], const Unit& u, int wr, int wc, int fr, int fq) const {
        const int row0 = u.pm * BM + wr * 64 + fr; const int pn = u.pn;
        if (pn < 16 || pn >= 24) {
            bf16_t* base = (pn < 12) ? qkv + (size_t)(pn >> 2) * stride : (pn < 16 ? cb : (pn < 28 ? sga : sgb)); const int col0 = (pn & 3) * BM + wc * 32 + 8 * fq;
#pragma unroll
            for (int ai = 0; ai < 2; ++ai)
#pragma unroll
                for (int m = 0; m < 4; ++m) { bf16_t* rowp = base + (size_t)(row0 + ai * HALF + m * 16) * 1024 + col0;
#pragma unroll
                    for (int bj = 0; bj < 2; ++bj) *(u32x4*)(rowp + bj * HALF) = pack8f(acc[ai][bj][m][0], acc[ai][bj][m][1]); }
        } else {
            const int col0 = (pn - 16) * HALF + wc * 32 + 8 * fq;
#pragma unroll
            for (int ai = 0; ai < 2; ++ai)
#pragma unroll
                for (int m = 0; m < 4; ++m) { bf16_t* rowp = z + (size_t)(row0 + ai * HALF + m * 16) * 1024 + col0;
                    *(u32x4*)rowp = pack8f(acc[ai][0][m][0] * acc[ai][1][m][0], acc[ai][0][m][1] * acc[ai][1][m][1]); }
        }
    }
};
template <bool SECOND> struct EpiGate {
    static constexpr bool PERM = true, AFTER_DRAIN = false;
    const bf16_t* gate; const bf16_t* prev; bf16_t* out; const float* gbias;
    __device__ __forceinline__ void operator()(const f32x4 (&acc)[2][2][4][2], const Unit& u, int wr, int wc, int fr, int fq) const {
        const int row0 = u.pm * BM + wr * 64 + fr; const int col0 = u.pn * BM + wc * 32 + 8 * fq;
        f32x4 bv[2][2];
#pragma unroll
        for (int bj = 0; bj < 2; ++bj)
#pragma unroll
            for (int n = 0; n < 2; ++n) bv[bj][n] = *(const f32x4*)(gbias + col0 + bj * HALF + 4 * n);
#pragma unroll
        for (int ai = 0; ai < 2; ++ai)
#pragma unroll
            for (int m = 0; m < 4; ++m) { const size_t off = (size_t)(row0 + ai * HALF + m * 16) * 1024 + col0;
#pragma unroll
                for (int bj = 0; bj < 2; ++bj) { f32x4 g0, g1; unpack8f(*(const u32x4*)(gate + off + bj * HALF), g0, g1); g0 += bv[bj][0]; g1 += bv[bj][1];
#pragma unroll
                    for (int i = 0; i < 4; ++i) { g0[i] = sigmoidf_fast(g0[i]); g1[i] = sigmoidf_fast(g1[i]); }
                    f32x4 v0 = acc[ai][bj][m][0] * g0, v1 = acc[ai][bj][m][1] * g1;
                    if (SECOND) { f32x4 p0, p1; unpack8f(*(const u32x4*)(prev + off + bj * HALF), p0, p1); v0 += p0; v1 += p1; }
                    *(u32x4*)(out + off + bj * HALF) = pack8f(v0, v1); } }
    }
};
struct EpiPre {
    static constexpr bool PERM = false, AFTER_DRAIN = false;
    const float* x; const float* stats; const float* g; const float* b; float* pre; float alpha;
    __device__ __forceinline__ void operator()(const f32x4 (&acc)[2][2][4][2], const Unit& u, int wr, int wc, int fr, int fq) const {
        const int row0 = u.pm * BM + wr * 64 + fr; const int col0 = u.pn * BM + wc * 32 + 4 * fq;
#pragma unroll
        for (int ai = 0; ai < 2; ++ai)
#pragma unroll
            for (int m = 0; m < 4; ++m) { const int row = row0 + ai * HALF + m * 16; const size_t off = (size_t)row * 1024 + col0;
                const float mu = stats[2 * row], rs = stats[2 * row + 1];
#pragma unroll
                for (int bj = 0; bj < 2; ++bj)
#pragma unroll
                    for (int n = 0; n < 2; ++n) { const int c = bj * HALF + n * 16; const f32x4 xv = *(const f32x4*)(x + off + c), gv = *(const f32x4*)(g + col0 + c), bv = *(const f32x4*)(b + col0 + c);
                        *(f32x4*)(pre + off + c) = ((xv - mu) * rs * gv + bv) * alpha + acc[ai][bj][m][n]; } }
    }
};
struct EpiMoeUp {
    static constexpr bool PERM = true, AFTER_DRAIN = false;
    bf16_t* h;
    __device__ __forceinline__ void operator()(const f32x4 (&acc)[2][2][4][2], const Unit& u, int wr, int wc, int fr, int fq) const {
        const int row0 = u.pm * BM + wr * 64 + fr; const int col0 = (u.pn & 3) * HALF + wc * 32 + 8 * fq;
#pragma unroll
        for (int ai = 0; ai < 2; ++ai)
#pragma unroll
            for (int m = 0; m < 4; ++m) { f32x4 v[2];
#pragma unroll
                for (int n = 0; n < 2; ++n)
#pragma unroll
                    for (int i = 0; i < 4; ++i) { const float gv = acc[ai][0][m][n][i]; v[n][i] = gv * sigmoidf_fast(gv) * acc[ai][1][m][n][i]; }
                *(u32x4*)(h + (size_t)(row0 + ai * HALF + m * 16) * 512 + col0) = pack8f(v[0], v[1]); }
    }
};
struct EpiMoeDown {
    static constexpr bool PERM = true, AFTER_DRAIN = false;
    bf16_t* y;
    __device__ __forceinline__ void operator()(const f32x4 (&acc)[2][2][4][2], const Unit& u, int wr, int wc, int fr, int fq) const {
        const int row0 = u.pm * BM + wr * 64 + fr; const int col0 = (u.pn & 3) * BM + wc * 32 + 8 * fq;
#pragma unroll
        for (int ai = 0; ai < 2; ++ai)
#pragma unroll
            for (int m = 0; m < 4; ++m) { bf16_t* rowp = y + (size_t)(row0 + ai * HALF + m * 16) * 1024 + col0;
#pragma unroll
                for (int bj = 0; bj < 2; ++bj) *(u32x4*)(rowp + bj * HALF) = pack8f(acc[ai][bj][m][0], acc[ai][bj][m][1]); }
    }
};
struct MoeOrder {
    const PG8_LAS int* tab; int G, c;
    __device__ __forceinline__ bool next(int i, Unit& u) const {
        const int nunits = (tab[32] >> 8) * 4; const int L = i * G + c; if (L >= nunits) return false;
        const int tile = L >> 2, s = tile << 8; int e = 0;
#pragma unroll 1
        for (int k = 1; k < 32; ++k) e = (tab[k] <= s) ? k : e;
        u.pm = __builtin_amdgcn_readfirstlane(tile); u.pn = __builtin_amdgcn_readfirstlane(e * 4 + (L & 3)); return true;
    }
    __device__ __forceinline__ void a_ready(const Unit&) const {}
    __device__ __forceinline__ void done(const Unit&) const {}
};
template <class Epi, class Sched, bool ALIGN_EPI = false, bool SP2 = false>
__device__ __forceinline__ void gemm_phase(PG8_LAS unsigned char* lds, const Gemm g, const Sched& S, const Epi& E) {
    const int tid = threadIdx.x, wid = __builtin_amdgcn_readfirstlane(tid >> 6), lane = tid & 63, wr = wid >> 2, wc = wid & 3, fr = lane & 15, fq = lane >> 4;
    const int K = g.K, nt = K / BK;
    unsigned voffA[2], voffB[2];
#pragma unroll
    for (int i = 0; i < 2; ++i) { int R, C; stage_rc(tid * 16 + i * 8192, R, C); const int Rb = Epi::PERM ? ((R & ~31) + perm32(R & 31)) : R;
        voffA[i] = (unsigned)(R * K + C) * 2u; voffB[i] = (unsigned)(Rb * K + C) * 2u; }
    const size_t kstep = (size_t)(BK * 2);
    const size_t hstep = (size_t)HALF * K * 2;
    const size_t tstep = 2 * hstep;
    const unsigned ldsw = (unsigned)wid * 1024u;
    const int aoff = lds_byte(wr * 64 + fr, fq * 8), boff = lds_byte(wc * 32 + fr, fq * 8);
#define PG8_SA(b, h) (((b) * 2 + (h)) * HTB)
#define PG8_SB(b, h) ((4 + (b) * 2 + (h)) * HTB)
#define PG8_STAGE(bufoff, gbase, voff) do { _Pragma("unroll") for (int _i = 0; _i < 2; ++_i) \
        __builtin_amdgcn_global_load_lds((const unsigned*)((const char*)(gbase) + (voff)[_i]), (PG8_LAS unsigned*)(lds + (bufoff) + ldsw + _i * 8192), 16, 0, 0); } while (0)
#define PG8_LDA(dst, b, h) do { _Pragma("unroll") for (int m = 0; m < 4; ++m) _Pragma("unroll") for (int k = 0; k < 2; ++k) dst[m][k] = *(const PG8_LAS bf16x8*)(lds + PG8_SA(b, h) + aoff + m * 2048 + k * 1024); } while (0)
#define PG8_LDB(dst, b, h) do { _Pragma("unroll") for (int n = 0; n < 2; ++n) _Pragma("unroll") for (int k = 0; k < 2; ++k) dst[n][k] = *(const PG8_LAS bf16x8*)(lds + PG8_SB(b, h) + boff + n * 2048 + k * 1024); } while (0)
#define PG8_MMA(ai, bj, At, Bt) do { __builtin_amdgcn_s_setprio(1); _Pragma("unroll") for (int m = 0; m < 4; ++m) _Pragma("unroll") for (int n = 0; n < 2; ++n) _Pragma("unroll") for (int k = 0; k < 2; ++k) \
        acc[ai][bj][m][n] = __builtin_amdgcn_mfma_f32_16x16x32_bf16(Bt[n][k], At[m][k], acc[ai][bj][m][n], 0, 0, 0); __builtin_amdgcn_s_setprio(0); } while (0)
#define PG8_WAIT_V(n) asm volatile("s_waitcnt vmcnt(" #n ")" ::: "memory")
#define PG8_WAIT_L(n) asm volatile("s_waitcnt lgkmcnt(" #n ")" ::: "memory")
#define PG8_BAR __builtin_amdgcn_s_barrier()
#define PG8_SCHED __builtin_amdgcn_sched_barrier(0)
    Unit cur, nxt; int ui = 0;
    if (!S.next(0, cur)) return;
    f32x4 acc[2][2][4][2];
#pragma unroll
    for (int a = 0; a < 2; ++a)
#pragma unroll
        for (int b = 0; b < 2; ++b)
#pragma unroll
            for (int m = 0; m < 4; ++m)
#pragma unroll
                for (int n = 0; n < 2; ++n) acc[a][b][m][n] = (f32x4){0.f, 0.f, 0.f, 0.f};
    bf16x8 At[4][2], B0[2][2], B1[2][2];
    const char* cA = (const char*)g.A + (size_t)cur.pm * tstep; const char* cB = (const char*)g.Bt + (size_t)cur.pn * tstep;
    S.a_ready(cur);
    if constexpr (SP2) {
        PG8_STAGE(PG8_SB(0, 0), cB, voffB); PG8_STAGE(PG8_SB(0, 1), cB + hstep, voffB); PG8_STAGE(PG8_SA(0, 0), cA, voffA); PG8_STAGE(PG8_SA(0, 1), cA + hstep, voffA);
        if (wr == 1) PG8_BAR;
        PG8_WAIT_V(2); PG8_BAR;
        PG8_STAGE(PG8_SB(1, 0), cB + kstep, voffB); PG8_STAGE(PG8_SA(1, 0), cA + kstep, voffA); PG8_STAGE(PG8_SB(1, 1), cB + hstep + kstep, voffB);
        PG8_WAIT_V(6); PG8_BAR;
    } else {
        PG8_STAGE(PG8_SB(0, 0), cB, voffB); PG8_STAGE(PG8_SA(0, 0), cA, voffA); PG8_STAGE(PG8_SB(0, 1), cB + hstep, voffB); PG8_STAGE(PG8_SA(0, 1), cA + hstep, voffA);
        if (wr == 1) PG8_BAR;
        PG8_WAIT_V(4); PG8_BAR;
        PG8_STAGE(PG8_SB(1, 0), cB + kstep, voffB); PG8_STAGE(PG8_SA(1, 0), cA + kstep, voffA); PG8_STAGE(PG8_SB(1, 1), cB + hstep + kstep, voffB);
        PG8_WAIT_V(6); PG8_BAR;
    }
    for (;;) {
        const bool has_next = S.next(ui + 1, nxt);
        const char* nA = has_next ? (const char*)g.A + (size_t)nxt.pm * tstep : cA; const char* nB = has_next ? (const char*)g.Bt + (size_t)nxt.pn * tstep : cB;
        for (int t = 0; t < nt; t += 2) {
            const bool last = (t == nt - 2);
            const char* a1 = cA + (size_t)(t + 1) * kstep;
            const char* a2 = last ? nA : cA + (size_t)(t + 2) * kstep; const char* b2 = last ? nB : cB + (size_t)(t + 2) * kstep;
            const char* a3 = a2 + kstep; const char* b3 = b2 + kstep;
            if (last && has_next) S.a_ready(nxt);
            if constexpr (SP2) {
            PG8_LDB(B0, 0, 0); PG8_LDB(B1, 0, 1); PG8_SCHED; PG8_LDA(At, 0, 0); PG8_STAGE(PG8_SA(1, 1), a1 + hstep, voffA);
            PG8_WAIT_V(8); PG8_WAIT_L(0); PG8_BAR; PG8_MMA(0, 0, At, B0); PG8_MMA(0, 1, At, B1); PG8_BAR; PG8_SCHED;
            PG8_LDA(At, 0, 1); PG8_STAGE(PG8_SB(0, 0), b2, voffB); PG8_STAGE(PG8_SB(0, 1), b2 + hstep, voffB); PG8_STAGE(PG8_SA(0, 0), a2, voffA);
            PG8_WAIT_V(8); PG8_WAIT_L(0); PG8_BAR; PG8_MMA(1, 0, At, B0); PG8_MMA(1, 1, At, B1); PG8_BAR; PG8_SCHED;
            PG8_LDB(B0, 1, 0); PG8_LDB(B1, 1, 1); PG8_SCHED; PG8_LDA(At, 1, 0); PG8_STAGE(PG8_SA(0, 1), a2 + hstep, voffA);
            PG8_WAIT_V(8); PG8_WAIT_L(0); PG8_BAR; PG8_MMA(0, 0, At, B0); PG8_MMA(0, 1, At, B1); PG8_BAR; PG8_SCHED;
            PG8_LDA(At, 1, 1); PG8_STAGE(PG8_SB(1, 0), b3, voffB); PG8_STAGE(PG8_SB(1, 1), b3 + hstep, voffB); PG8_STAGE(PG8_SA(1, 0), a3, voffA);
            PG8_WAIT_V(8); PG8_WAIT_L(0); PG8_BAR; PG8_MMA(1, 0, At, B0); PG8_MMA(1, 1, At, B1); PG8_BAR; PG8_SCHED;
            } else {
            PG8_LDB(B0, 0, 0); PG8_SCHED; PG8_LDA(At, 0, 0); PG8_STAGE(PG8_SA(1, 1), a1 + hstep, voffA);
            PG8_WAIT_L(8); PG8_BAR; PG8_WAIT_L(0); PG8_MMA(0, 0, At, B0); PG8_BAR; PG8_SCHED;
            PG8_LDB(B1, 0, 1); PG8_STAGE(PG8_SB(0, 0), b2, voffB);
            PG8_BAR; PG8_WAIT_L(0); PG8_MMA(0, 1, At, B1); PG8_BAR;
            PG8_LDA(At, 0, 1); PG8_STAGE(PG8_SA(0, 0), a2, voffA);
            PG8_BAR; PG8_WAIT_L(0); PG8_MMA(1, 0, At, B0); PG8_BAR; PG8_SCHED;
            PG8_STAGE(PG8_SB(0, 1), b2 + hstep, voffB);
            PG8_WAIT_V(6); PG8_BAR; PG8_MMA(1, 1, At, B1); PG8_BAR;
            PG8_LDB(B0, 1, 0); PG8_SCHED; PG8_LDA(At, 1, 0); PG8_STAGE(PG8_SA(0, 1), a2 + hstep, voffA);
            PG8_WAIT_L(8); PG8_BAR; PG8_WAIT_L(0); PG8_MMA(0, 0, At, B0); PG8_BAR; PG8_SCHED;
            PG8_LDB(B1, 1, 1); PG8_STAGE(PG8_SB(1, 0), b3, voffB);
            PG8_BAR; PG8_WAIT_L(0); PG8_MMA(0, 1, At, B1); PG8_BAR;
            PG8_LDA(At, 1, 1); PG8_STAGE(PG8_SA(1, 0), a3, voffA);
            PG8_BAR; PG8_WAIT_L(0); PG8_MMA(1, 0, At, B0); PG8_BAR; PG8_SCHED;
            PG8_STAGE(PG8_SB(1, 1), b3 + hstep, voffB);
            PG8_WAIT_V(6); PG8_BAR; PG8_MMA(1, 1, At, B1); PG8_BAR;
            }
        }
        if constexpr (ALIGN_EPI) { if (wr == 0) PG8_BAR; }
        if constexpr (!Epi::AFTER_DRAIN) { E(acc, cur, wr, wc, fr, fq); S.done(cur); }
        if (!has_next) break;
#pragma unroll
        for (int a = 0; a < 2; ++a)
#pragma unroll
            for (int b = 0; b < 2; ++b)
#pragma unroll
                for (int m = 0; m < 4; ++m)
#pragma unroll
                    for (int n = 0; n < 2; ++n) acc[a][b][m][n] = (f32x4){0.f, 0.f, 0.f, 0.f};
        cur = nxt; cA = nA; cB = nB; ++ui;
        if constexpr (ALIGN_EPI) { if (wr == 1) PG8_BAR; }
    }
    PG8_WAIT_V(0);
    if constexpr (!ALIGN_EPI) { if (wr == 0) PG8_BAR; }
    PG8_BAR;
    if constexpr (Epi::AFTER_DRAIN) { E.fused(acc, cur, wr, wc, fr, fq, lds, wid, lane); S.done(cur); }
#undef PG8_SA
#undef PG8_SB
#undef PG8_STAGE
#undef PG8_LDA
#undef PG8_LDB
#undef PG8_MMA
#undef PG8_WAIT_V
#undef PG8_WAIT_L
#undef PG8_BAR
#undef PG8_SCHED
}
}

namespace attn {
typedef short bf16x8 __attribute__((ext_vector_type(8)));
typedef short s16x4 __attribute__((ext_vector_type(4)));
typedef float f32x16 __attribute__((ext_vector_type(16)));
typedef unsigned u32x4 __attribute__((ext_vector_type(4)));
typedef unsigned short bf16;
constexpr int D = 128, PITCH = 1024, SEQ = 2048;
constexpr float SCALE = 0.08838834764831845f, THR = 8.f;
constexpr int NW = 8, QBLK = 32, KVBLK = 64, QB = NW * QBLK;
constexpr int SHM_V = KVBLK * D * 2, SHM_K = KVBLK * D * 2;
constexpr int BIAS_OFF = 2 * SHM_V + 2 * SHM_K + NW * 64 * 4, NBIAS = 320;
constexpr int LDS_BYTES = BIAS_OFF + NBIAS * 4;
#define KSWZ(row, colB) ((row) * 256 + ((colB) ^ (((row) & 7) << 4)))
#define SBAR() __builtin_amdgcn_sched_barrier(0)
__device__ __forceinline__ int v_st(int k, int c) { const int kk = (k & ~0xC) | ((k & 4) << 1) | ((k & 8) >> 1); return ((kk >> 3) * 4 + (c >> 5)) * 512 + ((kk & 7) * 32 + (c & 31)) * 2; }
__device__ __forceinline__ int v_rd_base(int lane) { return ((lane & 3) << 3) | (((lane >> 2) & 3) << 6) | (((lane >> 4) & 1) << 5) | (((lane >> 5) & 1) << 8); }
constexpr int v_rd_off(int d0, int ks, int half) { return d0 * 512 + ks * 4096 + half * 2048; }
__device__ __forceinline__ int crow(int r, int hi) { return (r & 3) + 8 * (r >> 2) + 4 * hi; }
__device__ __forceinline__ unsigned cvtpk(float lo, float hi) { unsigned r; asm volatile("v_cvt_pk_bf16_f32 %0, %1, %2" : "=v"(r) : "v"(lo), "v"(hi)); return r; }
__device__ __forceinline__ bf16x8 load8(const bf16* p) { return *reinterpret_cast<const bf16x8*>(p); }
__device__ __forceinline__ int t5_bucket(int rel) {
    const int b = rel > 0 ? 16 : 0; const int n = rel < 0 ? -rel : rel; int v;
    if (n < 8) v = n; else if (n < 12) v = 8; else if (n < 16) v = 9; else if (n < 23) v = 10; else if (n < 32) v = 11; else if (n < 46) v = 12; else if (n < 65) v = 13; else if (n < 91) v = 14; else v = 15;
    return b + v;
}
__device__ __forceinline__ void bias_tile(f32x16& p0, f32x16& p1, const float* tabp) {
#pragma unroll
    for (int r = 0; r < 16; ++r) { const int c = (r & 3) + 8 * (r >> 2); p0[r] += tabp[59 - c]; p1[r] += tabp[59 - c - 32]; }
}
__device__ __forceinline__ void partialSM(f32x16& p0, f32x16& p1, float& m_reg, float& mn, float& alpha) {
    float pmax = p0[0]; for (int r = 1; r < 16; ++r) pmax = fmaxf(pmax, p0[r]); for (int r = 0; r < 16; ++r) pmax = fmaxf(pmax, p1[r]);
    { auto rr = __builtin_amdgcn_permlane32_swap(__float_as_uint(pmax), __float_as_uint(pmax), false, false);
      pmax = fmaxf(__uint_as_float(rr[0]), __uint_as_float(rr[1])); }
    constexpr float C2 = 1.4426950408889634f * SCALE;
    if (__builtin_expect(__all((pmax - m_reg) * SCALE <= THR), 1)) { mn = m_reg; alpha = 1.f; }
    else { mn = fmaxf(m_reg, pmax); alpha = __builtin_amdgcn_exp2f((m_reg - mn) * C2); m_reg = mn; }
    const float mnL = -mn * C2;
    for (int r = 0; r < 16; ++r) p0[r] = fmaf(p0[r], C2, mnL); for (int r = 0; r < 16; ++r) p1[r] = fmaf(p1[r], C2, mnL);
    for (int r = 0; r < 16; ++r) p0[r] = __builtin_amdgcn_exp2f(p0[r]);
}
__device__ __forceinline__ void finishSM(f32x16& p0, f32x16& p1, float alpha, float& l_reg, bf16x8& pa0, bf16x8& pa1, bf16x8& pa2, bf16x8& pa3) {
    for (int r = 0; r < 16; ++r) p1[r] = __builtin_amdgcn_exp2f(p1[r]);
    float ps = 0; for (int r = 0; r < 16; ++r) ps += p0[r]; for (int r = 0; r < 16; ++r) ps += p1[r];
    { auto rr = __builtin_amdgcn_permlane32_swap(__float_as_uint(ps), __float_as_uint(ps), false, false);
      ps = __uint_as_float(rr[0]) + __uint_as_float(rr[1]); }
    l_reg = l_reg * alpha + ps;
#define PK4(P, B_, OUT) do { unsigned a0 = cvtpk(P[B_+0], P[B_+1]), a1 = cvtpk(P[B_+2], P[B_+3]);                          \
        unsigned b0 = cvtpk(P[B_+4], P[B_+5]), b1 = cvtpk(P[B_+6], P[B_+7]);                                             \
        auto r0 = __builtin_amdgcn_permlane32_swap(a0, b0, false, false); auto r1 = __builtin_amdgcn_permlane32_swap(a1, b1, false, false); \
        u32x4 w = {r0[0], r1[0], r0[1], r1[1]}; OUT = *reinterpret_cast<bf16x8*>(&w); } while (0)
    PK4(p0, 0, pa0); PK4(p0, 8, pa1); PK4(p1, 0, pa2); PK4(p1, 8, pa3);
#undef PK4
}
template <int KB>
__device__ __forceinline__ void qkt(f32x16& p0, f32x16& p1, const char* K_lds, int r32, int hi, const bf16x8* qr, bool act) {
    if (!act) { const float NEG = -__builtin_inff();
#pragma unroll
        for (int r = 0; r < 16; ++r) { p0[r] = NEG; p1[r] = NEG; } return; }
    p0 = f32x16{}; p1 = f32x16{};
    const char* kb[4];
#pragma unroll
    for (int dd = 0; dd < 4; ++dd) kb[dd] = K_lds + KB * SHM_K + KSWZ(r32, (dd * 16 + hi * 8) * 2);
#pragma unroll
    for (int d0 = 0; d0 < 8; ++d0) { const char* a = kb[d0 & 3] + (d0 >> 2) * 128;
        bf16x8 b0 = *reinterpret_cast<const bf16x8*>(a);
        bf16x8 b1 = *reinterpret_cast<const bf16x8*>(a + 32 * 256);
        p0 = __builtin_amdgcn_mfma_f32_32x32x16_bf16(b0, qr[d0], p0, 0, 0, 0);
        p1 = __builtin_amdgcn_mfma_f32_32x32x16_bf16(b1, qr[d0], p1, 0, 0, 0); }
}
template <int VB>
__device__ __forceinline__ void pv_tile(f32x16* o, int vb0, bf16x8 pa0, bf16x8 pa1, bf16x8 pa2, bf16x8 pa3, bool act) {
    if (!act) return;
#define TRRD(dst, off) asm volatile("ds_read_b64_tr_b16 %0, %1 offset:%2" : "=&v"(dst) : "v"(vb0), "i"(off) : "memory")
#define PV_D0(d0) do { s16x4 l0, l1, l2, l3, h0, h1, h2, h3; constexpr int b_ = VB * SHM_V + v_rd_off(d0, 0, 0); \
        TRRD(l0, b_); TRRD(h0, b_ + 2048); TRRD(l1, b_ + 4096); TRRD(h1, b_ + 6144); TRRD(l2, b_ + 8192); TRRD(h2, b_ + 10240); TRRD(l3, b_ + 12288); TRRD(h3, b_ + 14336); \
        asm volatile("s_waitcnt lgkmcnt(0)" ::: "memory"); SBAR();   \
        o[d0] = __builtin_amdgcn_mfma_f32_32x32x16_bf16(pa0, (bf16x8){l0[0], l0[1], l0[2], l0[3], h0[0], h0[1], h0[2], h0[3]}, o[d0], 0, 0, 0);   \
        o[d0] = __builtin_amdgcn_mfma_f32_32x32x16_bf16(pa1, (bf16x8){l1[0], l1[1], l1[2], l1[3], h1[0], h1[1], h1[2], h1[3]}, o[d0], 0, 0, 0);   \
        o[d0] = __builtin_amdgcn_mfma_f32_32x32x16_bf16(pa2, (bf16x8){l2[0], l2[1], l2[2], l2[3], h2[0], h2[1], h2[2], h2[3]}, o[d0], 0, 0, 0);   \
        o[d0] = __builtin_amdgcn_mfma_f32_32x32x16_bf16(pa3, (bf16x8){l3[0], l3[1], l3[2], l3[3], h3[0], h3[1], h3[2], h3[3]}, o[d0], 0, 0, 0); } while (0)
    PV_D0(0); PV_D0(1); PV_D0(2); PV_D0(3);
#undef PV_D0
#undef TRRD
}
struct BlockRef { const bf16* Q; const bf16* K; const bf16* V; bf16* O; int P0; };
struct Seam { bf16x8 qr[8]; bf16x8 st_v0, st_v1, st_k0, st_k1; };
#define ROW(p, k0, rr) ((p) + (size_t)((k0) + (rr)) * PITCH + sc)
#define VMW() asm volatile("s_waitcnt vmcnt(0)" ::: "memory")
#define VMWN(n) asm volatile("s_waitcnt vmcnt(%0)" :: "i"(n) : "memory")
#define SLOAD_H(Kp, Vp, k0) do { S.st_v0 = load8(ROW(Vp, k0, sr)); S.st_v1 = load8(ROW(Vp, k0, 32 + sr)); S.st_k0 = load8(ROW(Kp, k0, sr)); S.st_k1 = load8(ROW(Kp, k0, 32 + sr)); } while (0)
#define SWRITE_HK(bf) do { *(bf16x8*)(K_lds + (bf) * SHM_K + kws) = S.st_k0; *(bf16x8*)(K_lds + (bf) * SHM_K + kws + 32 * 256) = S.st_k1; } while (0)
#define SWRITE_HV(bf) do { *(bf16x8*)(V_lds + (bf) * SHM_V + vst0) = S.st_v0; *(bf16x8*)(V_lds + (bf) * SHM_V + vst1) = S.st_v1; } while (0)
#define SWRITE_H(bf) do { SWRITE_HV(bf); SWRITE_HK(bf); } while (0)
__device__ __forceinline__ void attn_prime(const BlockRef& cur, char* lds, Seam& S) {
    const int tid = threadIdx.x, wid = __builtin_amdgcn_readfirstlane(tid >> 6), lane = tid & 63, r32 = lane & 31, hi = lane >> 5;
    const int sr = tid >> 4, sc = (tid & 15) * 8, kws = KSWZ(sr, sc * 2); char* K_lds = lds + 2 * SHM_V;
#pragma unroll
    for (int d0 = 0; d0 < 8; ++d0) S.qr[d0] = load8(cur.Q + (size_t)(wid * QBLK + r32) * PITCH + d0 * 16 + hi * 8);
    SLOAD_H(cur.K, cur.V, 0); VMW(); SWRITE_HK(0);
    __syncthreads();
}
__device__ __forceinline__ void attn_block(const BlockRef& cur, const BlockRef& nxt, char* lds, Seam& S) {
    const int tid = threadIdx.x, wid = __builtin_amdgcn_readfirstlane(tid >> 6), lane = tid & 63, r32 = lane & 31, hi = lane >> 5;
    const int NT = cur.P0 / KVBLK + QB / KVBLK;
    const int qlo = cur.P0 + wid * QBLK, cw = qlo >> 6;
    char* V_lds = lds; char* K_lds = lds + 2 * SHM_V;
    float* ws = (float*)(lds + 2 * SHM_V + 2 * SHM_K) + wid * 64; float* li_l = ws, * al_l = ws + 32;
    const float* btab = (const float*)(lds + BIAS_OFF);
    float m_reg = -1e30f, l_reg = 0; f32x16 o[4] = {};
    const int sr = tid >> 4, sc = (tid & 15) * 8, vst0 = v_st(sr, sc), vst1 = v_st(32 + sr, sc), kws = KSWZ(sr, sc * 2);
    const int vb0 = (int)(uintptr_t)V_lds + v_rd_base(lane);
    const bf16* Kh = cur.K; const bf16* Vh = cur.V;
    const int bb0 = qlo + r32 - 4 * hi + 4;
#define RESC(a) do { if (__any((a) < 1.f)) { if (hi == 0) al_l[r32] = (a); asm volatile("s_waitcnt lgkmcnt(0)" ::: "memory");              \
                     for (int d_ = 0; d_ < 4; ++d_) for (int r = 0; r < 16; ++r) o[d_][r] *= al_l[crow(r, hi)]; } } while (0)
#define KBASE(t) ((t) * KVBLK)
#define ACT(t) ((t) <= cw)
#define BIAST(P0_, P1_, t) do { if ((t) <= cw && (t) + 2 >= cw) bias_tile(P0_, P1_, btab + (bb0 - KBASE(t))); } while (0)
    constexpr int NQL = 8;
#define SEAM_K0() do { VMWN(NQL); SWRITE_HK(0); SBAR(); } while (0)
    f32x16 pA0, pA1, pB0, pB1; float mnA, mnB, alA, alB; bf16x8 pa0, pa1, pa2, pa3;
    SWRITE_HV(0); SBAR();
    SLOAD_H(Kh, Vh, KBASE(1));
    SBAR(); qkt<0>(pA0, pA1, K_lds, r32, hi, S.qr, ACT(0));
    BIAST(pA0, pA1, 0); partialSM(pA0, pA1, m_reg, mnA, alA);
    VMW(); SWRITE_H(1);
    __syncthreads();
#define HALF_STEP(PX0, PX1, mnX, alX, PY0, PY1, alY, t, KB, VB, SB) do {                                                      \
        SBAR(); qkt<KB>(PX0, PX1, K_lds, r32, hi, S.qr, ACT(t));                                                 \
        finishSM(PY0, PY1, alY, l_reg, pa0, pa1, pa2, pa3); SBAR();                                                           \
        if ((t) + 1 < NT) { SLOAD_H(Kh, Vh, KBASE((t) + 1)); SBAR(); }                                                         \
        pv_tile<VB>(o, vb0, pa0, pa1, pa2, pa3, ACT((t) - 1)); BIAST(PX0, PX1, (t)); partialSM(PX0, PX1, m_reg, mnX, alX);    \
        __syncthreads();                                                                                                      \
        if ((t) + 1 < NT) { VMW(); SWRITE_H(SB); }                                                                             \
        RESC(alX); __syncthreads(); } while (0)
    for (int t = 1; t + 1 < NT; t += 2) {
        HALF_STEP(pB0, pB1, mnB, alB, pA0, pA1, alA, t, 1, 0, 0);
        HALF_STEP(pA0, pA1, mnA, alA, pB0, pB1, alB, t + 1, 0, 1, 1);
    }
    { SBAR(); qkt<1>(pB0, pB1, K_lds, r32, hi, S.qr, ACT(NT - 1)); SBAR(); }
    SLOAD_H(nxt.K, nxt.V, 0); SBAR();
#pragma unroll
    for (int d0 = 0; d0 < 8; ++d0) S.qr[d0] = load8(nxt.Q + (size_t)(wid * QBLK + r32) * PITCH + d0 * 16 + hi * 8);
    SBAR();
    finishSM(pA0, pA1, alA, l_reg, pa0, pa1, pa2, pa3); SBAR();
    pv_tile<0>(o, vb0, pa0, pa1, pa2, pa3, ACT(NT - 2));
    { BIAST(pB0, pB1, NT - 1); partialSM(pB0, pB1, m_reg, mnB, alB); __syncthreads(); RESC(alB);
      finishSM(pB0, pB1, alB, l_reg, pa0, pa1, pa2, pa3); SBAR(); pv_tile<1>(o, vb0, pa0, pa1, pa2, pa3, ACT(NT - 1)); }
    SBAR(); SEAM_K0();
    if (hi == 0) li_l[r32] = l_reg; asm volatile("s_waitcnt lgkmcnt(0)" ::: "memory");
    float rli[16];
#pragma unroll
    for (int r = 0; r < 16; ++r) rli[r] = __builtin_amdgcn_rcpf(li_l[crow(r, hi)]);
    bf16* Ow = cur.O + (size_t)(wid * QBLK) * PITCH;
#pragma unroll
    for (int r = 0; r < 16; ++r) { const int orow = crow(r, hi);
#pragma unroll
        for (int d0 = 0; d0 < 4; ++d0) { const float v = o[d0][r] * rli[r];
            const float vn = __shfl_xor(v, 1);
            if ((r32 & 1) == 0) *(unsigned*)(Ow + (size_t)orow * PITCH + d0 * 32 + r32) = cvtpk(v, vn); } }
    __syncthreads();
#undef RESC
#undef KBASE
#undef ACT
#undef BIAST
#undef SEAM_K0
#undef HALF_STEP
}
#undef ROW
#undef VMW
#undef VMWN
#undef SLOAD_H
#undef SWRITE_HK
#undef SWRITE_HV
#undef SWRITE_H
#undef KSWZ
}

constexpr int NWAVES = 8;
constexpr int BATCH = 16, SEQ = 2048, T = BATCH * SEQ, D = 1024, NIN = 8192, NE = 32, DE = 512;
constexpr int MAXT = 288, MAXS = MAXT * 256;
constexpr float LN_EPS = 1e-5f, RMS_EPS = 1e-6f, ALPHA = 1.189207115002721f, LAM_INIT = 0.2f;
constexpr size_t MiB = 1u << 20;
constexpr size_t WS_CTL = 0, CTL_ZERO_BYTES = 1 * MiB;
constexpr size_t WS_STATS = 1 * MiB, WS_EID = WS_STATS + 256 * 1024, WS_EW = WS_EID + 256 * 1024, WS_RANK = WS_EW + 256 * 1024, WS_SLOT = 2 * MiB, WS_CNTWG = WS_SLOT + 256 * 1024;
constexpr size_t WS_WA = 4 * MiB, WS_WB = 6 * MiB, WS_WO = 8 * MiB, WS_WIN = 10 * MiB;
constexpr size_t WS_XN = 26 * MiB, WS_Q = 90 * MiB, WS_K = 154 * MiB, WS_V = 218 * MiB, WS_CB = 282 * MiB, WS_Z = 346 * MiB, WS_O1 = 410 * MiB;
constexpr size_t WS_WGU = 90 * MiB, WS_WD = 154 * MiB, WS_PRE = 186 * MiB, WS_XG = 314 * MiB, WS_END = 458 * MiB;
constexpr int CW_TMO = 0, CW_CODE = 1, CW_BAR = 4096;
constexpr int RING_OFF = 0, RING_BYTES = 131072, RW_BYTES = 147456;
constexpr int LDSCTL_OFF = RW_BYTES, MISC_OFF = LDSCTL_OFF + 320, TAB_OFF = LDSCTL_OFF + 512, RSCR_OFF = LDSCTL_OFF + 1024;
constexpr int LDS_BYTES = 163840;
static_assert(RSCR_OFF + 8 * 128 * 4 + 1024 <= LDS_BYTES, "LDS map");

#define GAS __attribute__((address_space(1)))
#define LAS __attribute__((address_space(3)))
typedef unsigned short bf16;
#ifdef SWAP_CB_SGA
#define BUF_CB(P)  ((bf16*)(P).out)
#define BUF_SGA(P) ((bf16*)((P).ws + WS_CB))
#else
#define BUF_CB(P)  ((bf16*)((P).ws + WS_CB))
#define BUF_SGA(P) ((bf16*)(P).out)
#endif
#define BUF_SGB(P) ((bf16*)(P).out + (size_t)T * D)
typedef unsigned v4u __attribute__((ext_vector_type(4)));
typedef unsigned v2u __attribute__((ext_vector_type(2)));
typedef float f32x4 __attribute__((ext_vector_type(4)));
typedef GAS unsigned gu32;
#define RLX_AGENT __ATOMIC_RELAXED, __HIP_MEMORY_SCOPE_AGENT
#define LDS_WAIT() asm volatile("s_waitcnt lgkmcnt(0)" ::: "memory")
#define VM_WAIT() asm volatile("s_waitcnt vmcnt(0)" ::: "memory")
__device__ __forceinline__ unsigned f2bf(float f) { unsigned u = __builtin_bit_cast(unsigned, f); return (u + 0x7fffu + ((u >> 16) & 1u)) >> 16; }
__device__ __forceinline__ unsigned pk2(float lo, float hi) { return f2bf(lo) | (f2bf(hi) << 16); }
__device__ __forceinline__ float bflo(unsigned w) { return __uint_as_float(w << 16); }
__device__ __forceinline__ float bfhi(unsigned w) { return __uint_as_float(w & 0xffff0000u); }

#define XB_TMO      128
#define XB_XCNT(j)  (256  + 64 * (j))
#define XB_XSUB(j)  (1280 + 64 * (j))
#define XB_XGEN(j)  (2304 + 64 * (j))
#define XB_TOP      3328
#define XB_TOPGEN   3392
#define XCD_BAR_WORDS 3456
#define XB_SPIN_CAP (1u << 18)
__device__ __forceinline__ unsigned xb_ld(unsigned* p)              { return __hip_atomic_load(p, __ATOMIC_RELAXED, __HIP_MEMORY_SCOPE_AGENT); }
__device__ __forceinline__ unsigned xb_add(unsigned* p, unsigned v) { return __hip_atomic_fetch_add(p, v, __ATOMIC_RELAXED, __HIP_MEMORY_SCOPE_AGENT); }
__device__ __forceinline__ unsigned xb_xcc_id() { return (unsigned)__builtin_amdgcn_s_getreg((3 << 11) | 20) & 0xFu; }
#define XB_SPIN(cond, bar) do { unsigned _sp = 0; while (cond) { __builtin_amdgcn_s_sleep(1); \
    if ((++_sp & 255u) == 0u) { if (xb_ld(&(bar)[XB_TMO])) break; if (_sp > XB_SPIN_CAP) { atomicAdd(&(bar)[XB_TMO], 1u); break; } } } } while (0)
struct XcdBarrier { unsigned* bar; unsigned x; volatile LAS unsigned* st; };
__device__ __forceinline__ XcdBarrier xcd_barrier_post(unsigned* bar, volatile LAS unsigned* st) {
    XcdBarrier b; b.bar = bar; b.x = xb_xcc_id(); b.st = st;
    if (threadIdx.x == 0) (void)xb_add(&bar[XB_XCNT(b.x)], 1u);
    return b;
}
__device__ __forceinline__ void xcd_barrier_complete(unsigned* bar, unsigned x, unsigned& nloc, unsigned& nx) {
    const unsigned G = gridDim.x * gridDim.y * gridDim.z;
    unsigned sum, cnt, mine, sp = 0u;
    for (;;) {
        sum = 0u; cnt = 0u; mine = 0u;
#pragma unroll
        for (unsigned j = 0; j < 16; ++j) { const unsigned c = xb_ld(&bar[XB_XCNT(j)]); sum += c; cnt += (c > 0u) ? 1u : 0u; mine = (j == x) ? c : mine; }
        if (sum == G) break;
        __builtin_amdgcn_s_sleep(1);
        if ((++sp & 255u) == 0u) { if (xb_ld(&bar[XB_TMO])) break; if (sp > XB_SPIN_CAP) { atomicAdd(&bar[XB_TMO], 1u); break; } }
    }
    nloc = mine > 0u ? mine : 1u; nx = cnt > 0u ? cnt : 1u;
}
__device__ __forceinline__ void xcd_barrier(const XcdBarrier& b) {
    asm volatile("s_waitcnt vmcnt(0)" ::: "memory");
    __syncthreads();
    if (threadIdx.x == 0) {
        unsigned* bar = b.bar;
        __builtin_amdgcn_s_waitcnt(0);
        unsigned nloc = b.st[0], nx = b.st[1];
        if (nloc == 0u) { xcd_barrier_complete(bar, b.x, nloc, nx); b.st[0] = nloc; b.st[1] = nx; }
        const unsigned old = xb_add(&bar[XB_XSUB(b.x)], 1u);
        const unsigned gen = old / nloc;
        if (old + 1u == (gen + 1u) * nloc) {
            __builtin_amdgcn_fence(__ATOMIC_RELEASE, "agent");
            asm volatile("s_waitcnt vmcnt(0)" ::: "memory");
            const unsigned og = xb_add(&bar[XB_TOP], 1u);
            const unsigned tg = og / nx;
            if (og + 1u == (tg + 1u) * nx) xb_add(&bar[XB_TOPGEN], 1u);
            else XB_SPIN(xb_ld(&bar[XB_TOPGEN]) == tg, bar);
            __builtin_amdgcn_fence(__ATOMIC_ACQUIRE, "agent");
            xb_add(&bar[XB_XGEN(b.x)], 1u);
            asm volatile("s_waitcnt vmcnt(0)" ::: "memory");
        } else {
            XB_SPIN(xb_ld(&bar[XB_XGEN(b.x)]) == gen, bar);
            __builtin_amdgcn_fence(__ATOMIC_ACQUIRE, "agent");
            asm volatile("s_waitcnt vmcnt(0)" ::: "memory");
        }
    }
    __syncthreads();
}

struct Frame {
    LAS unsigned char* lds; volatile LAS unsigned* MISC; gu32* ctl;
    int tid, lane, wave, vcu, G;
};
__device__ __forceinline__ float wave_sum(float v) {
#pragma unroll
    for (int o = 1; o < 64; o <<= 1) v += __shfl_xor(v, o);
    return v;
}
__device__ __forceinline__ void transpose_item(const float* W, int K, int N, int k0, int n0, bf16* WT, int drow0, LAS float* scr, int lane) {
#pragma unroll 8
    for (int i = 0; i < 32; ++i) { const int kk = 2 * i + (lane >> 5); scr[kk * 33 + (lane & 31)] = W[(size_t)(k0 + kk) * N + n0 + (lane & 31)]; }
    LDS_WAIT(); asm volatile("" ::: "memory");
    const int c = lane & 7;
#pragma unroll
    for (int j = 0; j < 4; ++j) { const int n = (lane >> 3) + 8 * j; const LAS float* s = scr + (8 * c) * 33 + n;
        v4u o; o.x = pk2(s[0 * 33], s[1 * 33]); o.y = pk2(s[2 * 33], s[3 * 33]); o.z = pk2(s[4 * 33], s[5 * 33]); o.w = pk2(s[6 * 33], s[7 * 33]);
        *(GAS v4u*)(WT + (size_t)(drow0 + n) * K + k0 + 8 * c) = o; }
    LDS_WAIT(); asm volatile("" ::: "memory");
}
__device__ __forceinline__ int win_drow(int n0) {
    if (n0 < 4096 || n0 >= 6144) return n0;
    if (n0 < 5120) { const int r = n0 - 4096; return 4096 + 256 * (r >> 7) + (r & 127); }
    const int r = n0 - 5120; return 4096 + 256 * (r >> 7) + 128 + (r & 127);
}
struct Ptrs {
    const float *x, *ln_in_g, *ln_in_b, *w_in, *b_gate, *lq, *lk, *subln_g, *rel_bias, *conv_w, *w_a, *w_b, *w_o, *ln1_g, *ln1_b, *w_group, *b_group, *w_sub, *b_sub, *w_gate_e, *w_up_e, *w_down_e, *ln2_g, *ln2_b;
    float* out; unsigned char* ws;
};
__device__ __forceinline__ void p0_prologue(Frame& F, const Ptrs& P) {
    LAS float* scr = (LAS float*)(F.lds + RING_OFF + F.wave * 16384);
    const int gw = F.vcu * NWAVES + F.wave, NGW = F.G * NWAVES;
    constexpr int I_IN = (D / 64) * (NIN / 32), I_SQ = (D / 64) * (D / 32);
    bf16* Wt_in = (bf16*)(P.ws + WS_WIN); bf16* Wt_a = (bf16*)(P.ws + WS_WA); bf16* Wt_b = (bf16*)(P.ws + WS_WB); bf16* Wt_o = (bf16*)(P.ws + WS_WO);
    for (int it = gw; it < I_IN + 3 * I_SQ; it += NGW) {
        int r = it;
        if (r < I_IN) { const int kb = r / (NIN / 32), nb = r % (NIN / 32); transpose_item(P.w_in, D, NIN, 64 * kb, 32 * nb, Wt_in, win_drow(32 * nb), scr, F.lane); continue; } r -= I_IN;
        const int which = r / I_SQ; r -= which * I_SQ; const int kb = r / (D / 32), nb = r % (D / 32);
        const float* W = which == 0 ? P.w_a : (which == 1 ? P.w_b : P.w_o); bf16* WT = which == 0 ? Wt_a : (which == 1 ? Wt_b : Wt_o);
        transpose_item(W, D, D, 64 * kb, 32 * nb, WT, 32 * nb, scr, F.lane);
    }
    bf16* XN = (bf16*)(P.ws + WS_XN); float* stats = (float*)(P.ws + WS_STATS);
    for (int m = gw; m < T; m += NGW) {
        const GAS f32x4* xr = (const GAS f32x4*)(P.x + (size_t)m * D) + F.lane;
        f32x4 v[4]; float s = 0.f;
#pragma unroll
        for (int j = 0; j < 4; ++j) { v[j] = xr[64 * j]; s += (v[j].x + v[j].y) + (v[j].z + v[j].w); }
        const float mean = wave_sum(s) * (1.f / D); float s2 = 0.f;
#pragma unroll
        for (int j = 0; j < 4; ++j) { v[j] = v[j] - mean; s2 += (v[j].x * v[j].x + v[j].y * v[j].y) + (v[j].z * v[j].z + v[j].w * v[j].w); }
        const float rstd = 1.f / sqrtf(wave_sum(s2) * (1.f / D) + LN_EPS);
        GAS unsigned long long* o8 = (GAS unsigned long long*)(XN + (size_t)m * D) + F.lane;
#pragma unroll
        for (int j = 0; j < 4; ++j) { const f32x4 g = *((const GAS f32x4*)P.ln_in_g + F.lane + 64 * j), b = *((const GAS f32x4*)P.ln_in_b + F.lane + 64 * j); const f32x4 y = v[j] * rstd * g + b;
            o8[64 * j] = (unsigned long long)pk2(y.x, y.y) | ((unsigned long long)pk2(y.z, y.w) << 32); }
        if (F.lane == 0) { stats[2 * m] = mean; stats[2 * m + 1] = rstd; }
    }
}
__device__ __forceinline__ void p2_conv(Frame& F, const Ptrs& P) {
    bf16* CB = BUF_CB(P); const bf16* Z = (const bf16*)(P.ws + WS_Z);
    const int gw = F.vcu * NWAVES + F.wave, NGW = F.G * NWAVES, c0 = 16 * F.lane;
    float w0[16], w1[16], w2[16];
#pragma unroll
    for (int i = 0; i < 16; ++i) { w0[i] = P.conv_w[c0 + i]; w1[i] = P.conv_w[D + c0 + i]; w2[i] = P.conv_w[2 * D + c0 + i]; }
    for (int ch = gw; ch < T / 16; ch += NGW) {
        const int r0 = ch * 16; float z2[16], z1[16];
        if ((r0 & (SEQ - 1)) == 0) {
#pragma unroll
            for (int i = 0; i < 16; ++i) { z2[i] = 0.f; z1[i] = 0.f; }
        } else {
            const v4u a0 = *(const GAS v4u*)(Z + (size_t)(r0 - 2) * D + c0), a1 = *(const GAS v4u*)(Z + (size_t)(r0 - 2) * D + c0 + 8), b0 = *(const GAS v4u*)(Z + (size_t)(r0 - 1) * D + c0), b1 = *(const GAS v4u*)(Z + (size_t)(r0 - 1) * D + c0 + 8);
#pragma unroll
            for (int i = 0; i < 4; ++i) { z2[2 * i] = bflo(a0[i]); z2[2 * i + 1] = bfhi(a0[i]); z2[8 + 2 * i] = bflo(a1[i]); z2[8 + 2 * i + 1] = bfhi(a1[i]);
                                          z1[2 * i] = bflo(b0[i]); z1[2 * i + 1] = bfhi(b0[i]); z1[8 + 2 * i] = bflo(b1[i]); z1[8 + 2 * i + 1] = bfhi(b1[i]); }
        }
#pragma unroll 2
        for (int rr = 0; rr < 16; ++rr) { const size_t off = (size_t)(r0 + rr) * D + c0;
            const v4u za = *(const GAS v4u*)(Z + off), zb = *(const GAS v4u*)(Z + off + 8), ca = *(const GAS v4u*)(CB + off), cb = *(const GAS v4u*)(CB + off + 8);
            float zc[16], cv[16];
#pragma unroll
            for (int i = 0; i < 4; ++i) { zc[2 * i] = bflo(za[i]); zc[2 * i + 1] = bfhi(za[i]); zc[8 + 2 * i] = bflo(zb[i]); zc[8 + 2 * i + 1] = bfhi(zb[i]);
                                          cv[2 * i] = bflo(ca[i]); cv[2 * i + 1] = bfhi(ca[i]); cv[8 + 2 * i] = bflo(cb[i]); cv[8 + 2 * i + 1] = bfhi(cb[i]); }
            float u[16];
#pragma unroll
            for (int i = 0; i < 16; ++i) { u[i] = cv[i] * (z2[i] * w0[i] + z1[i] * w1[i] + zc[i] * w2[i]); z2[i] = z1[i]; z1[i] = zc[i]; }
            v4u oa, ob;
#pragma unroll
            for (int i = 0; i < 4; ++i) { oa[i] = pk2(u[2 * i], u[2 * i + 1]); ob[i] = pk2(u[8 + 2 * i], u[8 + 2 * i + 1]); }
            *(GAS v4u*)(CB + off) = oa; *(GAS v4u*)(CB + off + 8) = ob; }
    }
}
__device__ __forceinline__ attn::BlockRef attn_ref(const Ptrs& P, int s, int qb) {
    const int vh = s & 1, m = (s >> 1) & 1, h = (s >> 2) & 3, b = s >> 4;
    attn::BlockRef r; const size_t rowb = (size_t)b * SEQ * D;
    r.Q = (const bf16*)(P.ws + WS_Q) + rowb + (size_t)qb * 256 * D + h * 256 + m * 128;
    r.K = (const bf16*)(P.ws + WS_K) + rowb + h * 256 + m * 128;
    r.V = (const bf16*)(P.ws + WS_V) + rowb + h * 256 + vh * 128;
    r.O = (bf16*)(P.ws + (m ? WS_O1 : WS_XN)) + rowb + (size_t)qb * 256 * D + h * 256 + vh * 128;
    r.P0 = qb * 256; return r;
}
__device__ __forceinline__ void p2_attention(Frame& F, const Ptrs& P, char* lds) {
    float* btab = (float*)(lds + attn::BIAS_OFF);
    for (int s = F.vcu; s < BATCH * 16; s += F.G) {
        const int h = (s >> 2) & 3;
        __syncthreads();
        if (F.tid < attn::NBIAS) { const int rel = 63 - F.tid; btab[F.tid] = (P.rel_bias[attn::t5_bucket(rel) * 4 + h] - P.rel_bias[15 * 4 + h]) * (1.0f / attn::SCALE); }
        __syncthreads();
        attn::Seam S; attn::BlockRef cur = attn_ref(P, s, 0);
        attn::attn_prime(cur, lds, S);
#pragma unroll 1
        for (int qb = 0; qb < 8; ++qb) {
            const attn::BlockRef nxt = (qb < 7) ? attn_ref(P, s, qb + 1) : cur;
            attn::attn_block(cur, nxt, lds, S);
            cur = nxt;
        }
    }
}
__device__ __forceinline__ void p2b_combine(Frame& F, const Ptrs& P) {
    bf16* O0 = (bf16*)(P.ws + WS_XN); const bf16* O1 = (const bf16*)(P.ws + WS_O1);
    const int gw = F.vcu * NWAVES + F.wave, NGW = F.G * NWAVES, c0 = 16 * F.lane;
    const float l0 = wave_sum(P.lq[F.lane] * P.lk[F.lane] + P.lq[64 + F.lane] * P.lk[64 + F.lane]), l1 = wave_sum(P.lq[128 + F.lane] * P.lk[128 + F.lane] + P.lq[192 + F.lane] * P.lk[192 + F.lane]);
    const float lam = expf(l0) - expf(l1) + LAM_INIT;
    float g[16];
#pragma unroll
    for (int i = 0; i < 16; ++i) g[i] = P.subln_g[(c0 & 255) + i] * (1.f - LAM_INIT);
    for (int m = gw; m < T; m += NGW) { const size_t off = (size_t)m * D + c0;
        const v4u a0 = *(const GAS v4u*)(O0 + off), a1 = *(const GAS v4u*)(O0 + off + 8), b0 = *(const GAS v4u*)(O1 + off), b1 = *(const GAS v4u*)(O1 + off + 8);
        float d[16]; float ss = 0.f;
#pragma unroll
        for (int i = 0; i < 4; ++i) { d[2 * i] = bflo(a0[i]) - lam * bflo(b0[i]); d[2 * i + 1] = bfhi(a0[i]) - lam * bfhi(b0[i]); d[8 + 2 * i] = bflo(a1[i]) - lam * bflo(b1[i]); d[8 + 2 * i + 1] = bfhi(a1[i]) - lam * bfhi(b1[i]); }
#pragma unroll
        for (int i = 0; i < 16; ++i) ss += d[i] * d[i];
        ss += __shfl_xor(ss, 1); ss += __shfl_xor(ss, 2); ss += __shfl_xor(ss, 4); ss += __shfl_xor(ss, 8);
        const float rs = 1.f / sqrtf(ss * (1.f / 256.f) + RMS_EPS);
        v4u oa, ob;
#pragma unroll
        for (int i = 0; i < 4; ++i) { oa[i] = pk2(d[2 * i] * rs * g[2 * i], d[2 * i + 1] * rs * g[2 * i + 1]); ob[i] = pk2(d[8 + 2 * i] * rs * g[8 + 2 * i], d[8 + 2 * i + 1] * rs * g[8 + 2 * i + 1]); }
        *(GAS v4u*)(O0 + off) = oa; *(GAS v4u*)(O0 + off + 8) = ob; }
}
__device__ __forceinline__ void pe_experts(Frame& F, const Ptrs& P) {
    LAS float* scr = (LAS float*)(F.lds + RING_OFF + F.wave * 16384);
    const int gw = F.vcu * NWAVES + F.wave, NGW = F.G * NWAVES;
    bf16* Wgu = (bf16*)(P.ws + WS_WGU); bf16* Wd = (bf16*)(P.ws + WS_WD);
    constexpr int I_GU = (D / 64) * (DE / 32), I_DN = (DE / 64) * (D / 32);
    for (int it = gw; it < NE * (2 * I_GU + I_DN); it += NGW) {
        const int e = it / (2 * I_GU + I_DN); int r = it - e * (2 * I_GU + I_DN);
        if (r < 2 * I_GU) { const int up = r >= I_GU; r -= up * I_GU; const int kb = r / (DE / 32), nb = r % (DE / 32), n0 = 32 * nb;
            transpose_item((up ? P.w_up_e : P.w_gate_e) + (size_t)e * D * DE, D, DE, 64 * kb, n0, Wgu + (size_t)e * 1024 * D, 256 * (n0 >> 7) + 128 * up + (n0 & 127), scr, F.lane); }
        else { r -= 2 * I_GU; const int kb = r / (D / 32), nb = r % (D / 32);
            transpose_item(P.w_down_e + (size_t)e * DE * D, DE, D, 64 * kb, 32 * nb, Wd + (size_t)e * D * DE, 32 * nb, scr, F.lane); }
    }
}
__device__ __forceinline__ void p5_ln_route(Frame& F, const Ptrs& P) {
    LAS float* RW = (LAS float*)(F.lds + RING_OFF);
    LAS int* lcnt = (LAS int*)(F.lds + TAB_OFF);
    LAS float* rs = (LAS float*)(F.lds + RSCR_OFF) + F.wave * 128;
    for (int idx = F.tid; idx < D * 36; idx += NWAVES * 64) { const int d = idx / 36, o = idx - d * 36; float w;
        if (o < 4) w = P.w_group[d * 4 + o]; else { const int g = (o - 4) >> 3, e = (o - 4) & 7; w = P.w_sub[((size_t)g * D + d) * 8 + e]; }
        const int j = d >> 8, l = (d & 255) >> 2, i = d & 3, c = o >> 2, k = o & 3;
        RW[((((j * 4 + i) * 9 + c) * 64 + l) << 2) + k] = w; }
    if (F.tid < 32) lcnt[F.tid] = 0;
    __syncthreads();
    float* pre = (float*)(P.ws + WS_PRE); bf16* x1b = (bf16*)(P.ws + WS_XN);
    int* eid = (int*)(P.ws + WS_EID); float* ew = (float*)(P.ws + WS_EW); int* rank = (int*)(P.ws + WS_RANK);
    const int rows_per_wg = T / F.G, rbase = blockIdx.x * rows_per_wg;
    for (int rp = F.wave * 2; rp < rows_per_wg; rp += NWAVES * 2) {
        f32x4 xv[2][4];
#pragma unroll
        for (int r = 0; r < 2; ++r) { const int row = rbase + rp + r;
            GAS f32x4* pr = (GAS f32x4*)(pre + (size_t)row * D) + F.lane; f32x4 v[4]; float s = 0.f;
#pragma unroll
            for (int j = 0; j < 4; ++j) { v[j] = pr[64 * j]; s += (v[j].x + v[j].y) + (v[j].z + v[j].w); }
            const float mean = wave_sum(s) * (1.f / D); float s2 = 0.f;
#pragma unroll
            for (int j = 0; j < 4; ++j) { v[j] = v[j] - mean; s2 += (v[j].x * v[j].x + v[j].y * v[j].y) + (v[j].z * v[j].z + v[j].w * v[j].w); }
            const float rstd = 1.f / sqrtf(wave_sum(s2) * (1.f / D) + LN_EPS);
            GAS unsigned long long* o8 = (GAS unsigned long long*)(x1b + (size_t)row * D) + F.lane;
#pragma unroll
            for (int j = 0; j < 4; ++j) { const f32x4 g = *((const GAS f32x4*)P.ln1_g + F.lane + 64 * j), b = *((const GAS f32x4*)P.ln1_b + F.lane + 64 * j); const f32x4 y = v[j] * rstd * g + b;
                xv[r][j] = y; o8[64 * j] = (unsigned long long)pk2(y.x, y.y) | ((unsigned long long)pk2(y.z, y.w) << 32); } }
        f32x4 acc[2][9];
#pragma unroll
        for (int r = 0; r < 2; ++r)
#pragma unroll
            for (int c = 0; c < 9; ++c) acc[r][c] = (f32x4){0.f, 0.f, 0.f, 0.f};
        asm volatile("" ::: "memory"); __builtin_amdgcn_sched_barrier(0);
#pragma unroll
        for (int j = 0; j < 4; ++j)
#pragma unroll
            for (int i = 0; i < 4; ++i)
                { const LAS f32x4* wp = (const LAS f32x4*)(RW + (((j * 4 + i) * 9 * 64 + F.lane) << 2));
#pragma unroll
                  for (int c = 0; c < 9; ++c) { const f32x4 w = wp[c * 64]; acc[0][c] += w * xv[0][j][i]; acc[1][c] += w * xv[1][j][i]; }
                  asm volatile("" : "+v"(acc[0][0]), "+v"(acc[0][1]), "+v"(acc[0][2]), "+v"(acc[0][3]), "+v"(acc[0][4]), "+v"(acc[0][5]), "+v"(acc[0][6]), "+v"(acc[0][7]), "+v"(acc[0][8]) :: "memory");
                  asm volatile("" : "+v"(acc[1][0]), "+v"(acc[1][1]), "+v"(acc[1][2]), "+v"(acc[1][3]), "+v"(acc[1][4]), "+v"(acc[1][5]), "+v"(acc[1][6]), "+v"(acc[1][7]), "+v"(acc[1][8]) :: "memory");
                  __builtin_amdgcn_sched_barrier(0); }
        { float Y[36];
#pragma unroll
          for (int k = 0; k < 36; ++k) { const int i0 = 2 * k, i1 = 2 * k + 1;
              const auto rr = __builtin_amdgcn_permlane32_swap(__float_as_uint(acc[i0 / 36][(i0 % 36) >> 2][i0 & 3]), __float_as_uint(acc[i1 / 36][(i1 % 36) >> 2][i1 & 3]), false, false);
              Y[k] = __uint_as_float(rr[0]) + __uint_as_float(rr[1]); }
          float Z[18];
#pragma unroll
          for (int m = 0; m < 18; ++m) { const auto rr = __builtin_amdgcn_permlane16_swap(__float_as_uint(Y[2 * m]), __float_as_uint(Y[2 * m + 1]), false, false);
              Z[m] = __uint_as_float(rr[0]) + __uint_as_float(rr[1]); }
#pragma unroll
          for (int m = 0; m < 18; ++m) {
              Z[m] += __int_as_float(__builtin_amdgcn_update_dpp(0, __float_as_int(Z[m]), 0x128, 0xf, 0xf, false));
              Z[m] += __int_as_float(__builtin_amdgcn_update_dpp(0, __float_as_int(Z[m]), 0x124, 0xf, 0xf, false));
              Z[m] += __int_as_float(__builtin_amdgcn_update_dpp(0, __float_as_int(Z[m]), 0x122, 0xf, 0xf, false));
              Z[m] += __int_as_float(__builtin_amdgcn_update_dpp(0, __float_as_int(Z[m]), 0x121, 0xf, 0xf, false)); }
          const int rho = F.lane >> 4, pr = ((rho & 1) << 1) | (rho >> 1);
          if ((F.lane & 15) == 0) {
#pragma unroll
              for (int m = 0; m < 18; ++m) { const int idx = 4 * m + pr; rs[idx >= 36 ? idx + 28 : idx] = Z[m]; } } }
        LDS_WAIT(); asm volatile("" ::: "memory");
        if (F.lane < 2) { const int r = F.lane, row = rbase + rp + r; const LAS float* sa = rs + r * 64;
            float gmax = sa[0] + P.b_group[0]; int gi = 0;
            for (int g = 1; g < 4; ++g) { const float v = sa[g] + P.b_group[g]; if (v > gmax) { gmax = v; gi = g; } }
            float z = 0.f;
            for (int g = 0; g < 4; ++g) z += expf(sa[g] + P.b_group[g] - gmax);
            const float gp = 1.f / z;
            const LAS float* sl = sa + 4 + gi * 8; const float* bs = P.b_sub + gi * 8;
            float b0 = sl[0] + bs[0]; int i0 = 0;
            for (int e = 1; e < 8; ++e) { const float v = sl[e] + bs[e]; if (v > b0) { b0 = v; i0 = e; } }
            float b1 = -__builtin_inff(); int i1 = 0;
            for (int e = 0; e < 8; ++e) { const float v = sl[e] + bs[e]; if (e != i0 && v > b1) { b1 = v; i1 = e; } }
            const float e1 = expf(b1 - b0); const float w0 = gp / (1.f + e1), w1 = gp * e1 / (1.f + e1);
            const int ex0 = gi * 8 + i0, ex1 = gi * 8 + i1;
            eid[row * 2] = ex0; eid[row * 2 + 1] = ex1; ew[row * 2] = w0; ew[row * 2 + 1] = w1;
            rank[row * 2] = __hip_atomic_fetch_add(lcnt + ex0, 1, __ATOMIC_RELAXED, __HIP_MEMORY_SCOPE_WORKGROUP);
            rank[row * 2 + 1] = __hip_atomic_fetch_add(lcnt + ex1, 1, __ATOMIC_RELAXED, __HIP_MEMORY_SCOPE_WORKGROUP); }
        LDS_WAIT(); asm volatile("" ::: "memory");
    }
    __syncthreads();
    if (F.tid < 32) ((int*)(P.ws + WS_CNTWG))[blockIdx.x * 32 + F.tid] = lcnt[F.tid];
}
__device__ __forceinline__ void moe_tab(Frame& F, const Ptrs& P) {
    LAS int* tab = (LAS int*)(F.lds + TAB_OFF);
    const int* cntwg = (const int*)(P.ws + WS_CNTWG);
    __syncthreads();
    if (F.tid < 32) { int tot = 0, base = 0;
        for (int w = 0; w < F.G; ++w) { const int c = __hip_atomic_load(cntwg + w * 32 + F.tid, __ATOMIC_RELAXED, __HIP_MEMORY_SCOPE_AGENT); base += (w < (int)blockIdx.x) ? c : 0; tot += c; }
        tab[96 + F.tid] = tot; tab[64 + F.tid] = base; }
    __syncthreads();
    if (F.tid == 0) { int s = 0; for (int e = 0; e < 32; ++e) { tab[e] = s; s += (tab[96 + e] + 255) & ~255; } tab[32] = s; }
    __syncthreads();
}
__device__ __forceinline__ void p5b_place(Frame& F, const Ptrs& P) {
    LAS int* tab = (LAS int*)(F.lds + TAB_OFF);
    moe_tab(F, P);
    const int rows_per_wg = T / F.G, rbase = blockIdx.x * rows_per_wg;
    const int* eid = (const int*)(P.ws + WS_EID); const int* rank = (const int*)(P.ws + WS_RANK); int* slot = (int*)(P.ws + WS_SLOT);
    const bf16* x1b = (const bf16*)(P.ws + WS_XN); bf16* xg = (bf16*)(P.ws + WS_XG);
    for (int a = F.wave; a < rows_per_wg * 2; a += NWAVES) { const int ga = rbase * 2 + a, e = eid[ga]; const int s = tab[e] + tab[64 + e] + rank[ga];
        if (F.lane == 0) slot[ga] = s;
        const GAS v4u* src = (const GAS v4u*)(x1b + (size_t)(ga >> 1) * D) + F.lane; GAS v4u* dst = (GAS v4u*)(xg + (size_t)s * D) + F.lane;
        dst[0] = src[0]; dst[64] = src[64]; }
}
__device__ __forceinline__ void p8_final(Frame& F, const Ptrs& P, bool poison) {
    const bf16* x1 = (const bf16*)(P.ws + WS_XN); const bf16* y = (const bf16*)(P.ws + WS_XG);
    const int* slot = (const int*)(P.ws + WS_SLOT); const float* ew = (const float*)(P.ws + WS_EW);
    const int rows_per_wg = T / F.G, rbase = blockIdx.x * rows_per_wg;
    for (int rr = F.wave; rr < rows_per_wg; rr += NWAVES) { const int row = rbase + rr;
        const int s0 = slot[row * 2], s1 = slot[row * 2 + 1]; const float w0 = ew[row * 2], w1 = ew[row * 2 + 1];
        const GAS v2u* xr = (const GAS v2u*)(x1 + (size_t)row * D) + F.lane; const GAS v2u* y0 = (const GAS v2u*)(y + (size_t)s0 * D) + F.lane; const GAS v2u* y1 = (const GAS v2u*)(y + (size_t)s1 * D) + F.lane;
        f32x4 v[4]; float s = 0.f;
#pragma unroll
        for (int j = 0; j < 4; ++j) { const v2u xw = xr[64 * j]; const f32x4 xx = {bflo(xw.x), bfhi(xw.x), bflo(xw.y), bfhi(xw.y)}; const v2u a = y0[64 * j], b = y1[64 * j];
            v[j].x = ALPHA * xx.x + w0 * bflo(a.x) + w1 * bflo(b.x); v[j].y = ALPHA * xx.y + w0 * bfhi(a.x) + w1 * bfhi(b.x); v[j].z = ALPHA * xx.z + w0 * bflo(a.y) + w1 * bflo(b.y); v[j].w = ALPHA * xx.w + w0 * bfhi(a.y) + w1 * bfhi(b.y);
            s += (v[j].x + v[j].y) + (v[j].z + v[j].w); }
        const float mean = wave_sum(s) * (1.f / D); float s2 = 0.f;
#pragma unroll
        for (int j = 0; j < 4; ++j) { v[j] = v[j] - mean; s2 += (v[j].x * v[j].x + v[j].y * v[j].y) + (v[j].z * v[j].z + v[j].w * v[j].w); }
        const float rstd = 1.f / sqrtf(wave_sum(s2) * (1.f / D) + LN_EPS);
        GAS f32x4* o = (GAS f32x4*)(P.out + (size_t)row * D) + F.lane; const float qn = __builtin_nanf("");
#pragma unroll
        for (int j = 0; j < 4; ++j) { const f32x4 g = *((const GAS f32x4*)P.ln2_g + F.lane + 64 * j), b = *((const GAS f32x4*)P.ln2_b + F.lane + 64 * j); f32x4 yv = v[j] * rstd * g + b;
            if (poison) yv = (f32x4){qn, qn, qn, qn}; o[64 * j] = yv; }
    }
}

constexpr int N_PHASES = 11;
struct Args { Ptrs p; int ph_lo, ph_hi, bar_region, flags; };
__global__ void __launch_bounds__(NWAVES * 64, 2) mega_fwd(Args args) {
    extern __shared__ __attribute__((aligned(16))) unsigned char lds[];
    Frame F; const Ptrs& P = args.p;
    F.lds = (LAS unsigned char*)lds; F.MISC = (volatile LAS unsigned*)(F.lds + MISC_OFF);
    F.tid = threadIdx.x; F.lane = F.tid & 63; F.wave = __builtin_amdgcn_readfirstlane(F.tid >> 6);
    F.G = gridDim.x; { const int bx = blockIdx.x; F.vcu = (F.G % 8 == 0) ? (bx % 8) * (F.G / 8) + bx / 8 : bx; }
    F.ctl = (gu32*)(P.ws + WS_CTL);
    for (int u = F.tid; u < (LDS_BYTES - LDSCTL_OFF) / 4; u += NWAVES * 64) ((LAS unsigned*)(F.lds + LDSCTL_OFF))[u] = 0u;
    __syncthreads();
    XcdBarrier bar = xcd_barrier_post((unsigned*)(F.ctl + CW_BAR) + args.bar_region * XCD_BAR_WORDS, F.MISC + 8);
    const int lo = args.ph_lo, hi = args.ph_hi;
#ifndef PH_MASK
#define PH_MASK 0x7ff
#endif
#define IN(k) (((PH_MASK >> (k)) & 1) && lo <= (k) && (k) < hi)
#define BOTH(k) (IN(k) && IN((k) + 1))
#define GRID_BAR() xcd_barrier(bar)
    const bool grid_ok = (F.G == 256);

    if (IN(0)) { p0_prologue(F, P); if (BOTH(0)) GRID_BAR(); }
    if (IN(1)) {
        pg8::Gemm g{(const pg8::bf16_t*)(P.ws + WS_XN), (const pg8::bf16_t*)(P.ws + WS_WIN), T, NIN, D}; pg8::StaticOrder S; S.init(T, NIN, F.G, (int)blockIdx.x);
        pg8::EpiInProj E{(pg8::bf16_t*)(P.ws + WS_Q), (size_t)(WS_K - WS_Q) / 2, BUF_CB(P), (pg8::bf16_t*)(P.ws + WS_Z), BUF_SGA(P), BUF_SGB(P)};
        pg8::gemm_phase<pg8::EpiInProj, pg8::StaticOrder, true, true>(F.lds + RING_OFF, g, S, E);
        if (BOTH(1)) GRID_BAR();
    }
    if (IN(2)) { if (!(args.flags & 2)) p2_conv(F, P); p2_attention(F, P, (char*)lds + RING_OFF); if (BOTH(2)) GRID_BAR(); }
    if (IN(3)) { if (!(args.flags & 1)) p2b_combine(F, P); pe_experts(F, P); if (BOTH(3)) GRID_BAR(); }
    if (IN(4)) {
        { pg8::Gemm g{(const pg8::bf16_t*)(P.ws + WS_XN), (const pg8::bf16_t*)(P.ws + WS_WA), T, D, D}; pg8::StaticOrder S; S.init(T, D, F.G, (int)blockIdx.x);
          pg8::EpiGate<false> E{BUF_SGA(P), nullptr, (pg8::bf16_t*)(P.ws + WS_O1), P.b_gate};
          pg8::gemm_phase<pg8::EpiGate<false>, pg8::StaticOrder, true, true>(F.lds + RING_OFF, g, S, E); }
        __syncthreads();
        { pg8::Gemm g{BUF_CB(P), (const pg8::bf16_t*)(P.ws + WS_WB), T, D, D}; pg8::StaticOrder S; S.init(T, D, F.G, (int)blockIdx.x);
          pg8::EpiGate<true> E{BUF_SGB(P), (const pg8::bf16_t*)(P.ws + WS_O1), (pg8::bf16_t*)(P.ws + WS_Z), P.b_gate + 1024};
          pg8::gemm_phase<pg8::EpiGate<true>, pg8::StaticOrder, true, true>(F.lds + RING_OFF, g, S, E); }
        if (BOTH(4)) GRID_BAR();
    }
    if (IN(5)) {
        pg8::Gemm g{(const pg8::bf16_t*)(P.ws + WS_Z), (const pg8::bf16_t*)(P.ws + WS_WO), T, D, D}; pg8::StaticOrder S; S.init(T, D, F.G, (int)blockIdx.x);
        pg8::EpiPre E{P.x, (const float*)(P.ws + WS_STATS), P.ln_in_g, P.ln_in_b, (float*)(P.ws + WS_PRE), ALPHA};
        pg8::gemm_phase<pg8::EpiPre, pg8::StaticOrder, true, true>(F.lds + RING_OFF, g, S, E);
        if (BOTH(5)) GRID_BAR();
    }
    if (IN(6)) { if (grid_ok) p5_ln_route(F, P); if (BOTH(6)) GRID_BAR(); }
    if (IN(7)) { if (grid_ok) p5b_place(F, P); if (BOTH(7)) GRID_BAR(); }
    if (IN(8)) {
        if (grid_ok) { if (lo == 8) moe_tab(F, P); pg8::Gemm g{(const pg8::bf16_t*)(P.ws + WS_XG), (const pg8::bf16_t*)(P.ws + WS_WGU), MAXS, NE * 1024, D};
          pg8::MoeOrder S{(const PG8_LAS int*)(F.lds + TAB_OFF), F.G, F.vcu}; pg8::EpiMoeUp E{(pg8::bf16_t*)P.out};
          pg8::gemm_phase<pg8::EpiMoeUp, pg8::MoeOrder, true, true>(F.lds + RING_OFF, g, S, E); }
        if (BOTH(8)) GRID_BAR();
    }
    if (IN(9)) {
        if (grid_ok) { if (lo == 9) moe_tab(F, P); pg8::Gemm g{(const pg8::bf16_t*)P.out, (const pg8::bf16_t*)(P.ws + WS_WD), MAXS, NE * 1024, DE};
          pg8::MoeOrder S{(const PG8_LAS int*)(F.lds + TAB_OFF), F.G, F.vcu}; pg8::EpiMoeDown E{(pg8::bf16_t*)(P.ws + WS_XG)};
          pg8::gemm_phase<pg8::EpiMoeDown, pg8::MoeOrder, true, true>(F.lds + RING_OFF, g, S, E); }
        if (BOTH(9)) GRID_BAR();
    }
    if (IN(10)) {
        bool poison = !grid_ok || (__hip_atomic_load(F.ctl + CW_BAR + args.bar_region * XCD_BAR_WORDS + XB_TMO, RLX_AGENT) != 0u);
        if (grid_ok) p8_final(F, P, poison);
        else { const float qn = __builtin_nanf(""); for (size_t i = (size_t)blockIdx.x * 512 + F.tid; i < (size_t)T * D; i += (size_t)F.G * 512) P.out[i] = qn; }
    }
#undef IN
#undef BOTH
#undef GRID_BAR
}

#if HYBRID
namespace nv {
constexpr int D = 1024, BATCH = 16, SEQ = 2048, T = BATCH * SEQ, NIN = 8192, NH = 4, HD = 128, NE = 32, DE = 512;
constexpr float LN_EPS = 1e-5f, RMS_EPS = 1e-6f;
constexpr float ALPHA = 1.189207115002721f;
constexpr float LAM_INIT = 0.2f;
constexpr int MOE_PAD = 64;
constexpr int MAX_SLOTS = 2 * T + NE * MOE_PAD;
constexpr int MAX_TILES = MAX_SLOTS / MOE_PAD;

__device__ __forceinline__ float wave_sum(float v) {
#pragma unroll
    for (int o = 1; o < 64; o <<= 1) v += __shfl_xor(v, o);
    return v;
}
__device__ __forceinline__ float wave_max(float v) {
#pragma unroll
    for (int o = 1; o < 64; o <<= 1) v = fmaxf(v, __shfl_xor(v, o));
    return v;
}
__device__ __forceinline__ float block_sum(float v, float* scr) {
    v = wave_sum(v); __syncthreads();
    if ((threadIdx.x & 63) == 0) scr[threadIdx.x >> 6] = v; __syncthreads();
    float r = 0.f; for (int i = 0; i < (int)(blockDim.x >> 6); ++i) r += scr[i]; __syncthreads(); return r;
}
__device__ __forceinline__ float block_max(float v, float* scr) {
    v = wave_max(v); __syncthreads();
    if ((threadIdx.x & 63) == 0) scr[threadIdx.x >> 6] = v; __syncthreads();
    float r = -INFINITY; for (int i = 0; i < (int)(blockDim.x >> 6); ++i) r = fmaxf(r, scr[i]); __syncthreads(); return r;
}

__global__ void k_ln_rows(const float* x, float a, const float* add, const float* g, const float* b, float* y) {
    __shared__ float scr[8];
    const size_t row = blockIdx.x; const float* xr = x + row * D; const float* ar = add ? add + row * D : nullptr;
    float v[4]; float s = 0.f;
    for (int j = 0; j < 4; ++j) { const int c = threadIdx.x + 256 * j; v[j] = a * xr[c] + (ar ? ar[c] : 0.f); s += v[j]; }
    const float mean = block_sum(s, scr) * (1.f / D); float q = 0.f;
    for (int j = 0; j < 4; ++j) { v[j] -= mean; q += v[j] * v[j]; }
    const float rstd = 1.f / sqrtf(block_sum(q, scr) * (1.f / D) + LN_EPS);
    for (int j = 0; j < 4; ++j) { const int c = threadIdx.x + 256 * j; y[row * D + c] = v[j] * rstd * g[c] + b[c]; }
}

struct TileAcc { float c[4][4]; };
__device__ __forceinline__ void gemm_tile(const float* __restrict__ A, int lda, const int* rowidx, int row0, const float* __restrict__ B, int ldb, int col0, int K, TileAcc& acc, float (*As)[65], float (*Bs)[65]) {
    const int tid = threadIdx.x, tx = tid & 15, ty = tid >> 4;
    for (int i = 0; i < 4; ++i) for (int j = 0; j < 4; ++j) acc.c[i][j] = 0.f;
    for (int k0 = 0; k0 < K; k0 += 16) {
        for (int e = tid; e < 64 * 16; e += 256) { const int r = e >> 4, k = e & 15; int gr = row0 + r; float v = 0.f;
            if (rowidx) { const int t = rowidx[gr]; if (t >= 0) v = A[(size_t)t * lda + k0 + k]; } else v = A[(size_t)gr * lda + k0 + k];
            As[k][r] = v; }
        for (int e = tid; e < 16 * 64; e += 256) { const int k = e >> 6, c = e & 63; Bs[k][c] = B[(size_t)(k0 + k) * ldb + col0 + c]; }
        __syncthreads();
#pragma unroll
        for (int k = 0; k < 16; ++k) { float a[4], b[4];
            for (int i = 0; i < 4; ++i) a[i] = As[k][ty * 4 + i];
            for (int j = 0; j < 4; ++j) b[j] = Bs[k][tx * 4 + j];
            for (int i = 0; i < 4; ++i) for (int j = 0; j < 4; ++j) acc.c[i][j] += a[i] * b[j]; }
        __syncthreads();
    }
}
__global__ void k_gemm(const float* A, int lda, const float* B, int ldb, float* C, int ldc, int K) {
    __shared__ float As[16][65], Bs[16][65];
    TileAcc acc; const int row0 = blockIdx.y * 64, col0 = blockIdx.x * 64;
    gemm_tile(A, lda, nullptr, row0, B, ldb, col0, K, acc, As, Bs);
    const int tx = threadIdx.x & 15, ty = threadIdx.x >> 4;
    for (int i = 0; i < 4; ++i) for (int j = 0; j < 4; ++j) C[(size_t)(row0 + ty * 4 + i) * ldc + col0 + tx * 4 + j] = acc.c[i][j];
}

__device__ __forceinline__ int t5_bucket(int rel) {
    int b = rel > 0 ? 16 : 0; const int n = rel < 0 ? -rel : rel; int v;
    if (n < 8) v = n; else if (n < 12) v = 8; else if (n < 16) v = 9; else if (n < 23) v = 10; else if (n < 32) v = 11; else if (n < 46) v = 12; else if (n < 65) v = 13; else if (n < 91) v = 14; else v = 15;
    return b + v;
}
__global__ void k_attn(const float* P, const float* rel_bias, const float* lq, const float* lk, const float* subln_g, float* ao) {
    __shared__ float q1[128], q2[128], lg[2][SEQ], scr[8];
    const int q = blockIdx.x, h = blockIdx.y, tid = threadIdx.x;
    float l0 = 0.f, l1 = 0.f; for (int i = 0; i < 128; ++i) { l0 += lq[i] * lk[i]; l1 += lq[128 + i] * lk[128 + i]; }
    const float lam = expf(l0) - expf(l1) + LAM_INIT;
    if (tid < 128) q1[tid] = P[(size_t)q * NIN + h * 256 + tid]; else q2[tid - 128] = P[(size_t)q * NIN + h * 256 + tid];
    __syncthreads();
    const int nk = (q / 64 + 1) * 64; const float scale = 0.08838834764831845f;
    float m1 = -INFINITY, m2 = -INFINITY;
    for (int k = tid; k < nk; k += 256) { const float* kr = P + (size_t)k * NIN + 1024 + h * 256; float s1 = 0.f, s2 = 0.f;
        for (int d = 0; d < 128; ++d) { s1 += q1[d] * kr[d]; s2 += q2[d] * kr[128 + d]; }
        const float bias = rel_bias[t5_bucket(k - q) * NH + h];
        s1 = s1 * scale + bias; s2 = s2 * scale + bias; lg[0][k] = s1; lg[1][k] = s2; m1 = fmaxf(m1, s1); m2 = fmaxf(m2, s2); }
    m1 = block_max(m1, scr); m2 = block_max(m2, scr);
    float z1 = 0.f, z2 = 0.f;
    for (int k = tid; k < nk; k += 256) { const float e1 = expf(lg[0][k] - m1), e2 = expf(lg[1][k] - m2); lg[0][k] = e1; lg[1][k] = e2; z1 += e1; z2 += e2; }
    z1 = block_sum(z1, scr); z2 = block_sum(z2, scr);
    for (int k = tid; k < nk; k += 256) lg[0][k] = lg[0][k] / z1 - lam * (lg[1][k] / z2);
    __syncthreads();
    float o = 0.f; const float* vb = P + 2048 + h * 256 + tid;
    for (int k = 0; k < nk; ++k) o += lg[0][k] * vb[(size_t)k * NIN];
    const float ms = block_sum(o * o, scr) * (1.f / 256.f);
    ao[(size_t)q * D + h * 256 + tid] = o * (1.f / sqrtf(ms + RMS_EPS)) * subln_g[tid] * (1.f - LAM_INIT);
}
__global__ void k_conv(const float* P, const float* cw, float* u) {
    const int t = blockIdx.x;
    for (int c = threadIdx.x; c < D; c += 256) { float z = 0.f;
        for (int w = 0; w < 3; ++w) { const int tt = t + w - 2; if (tt >= 0) z += P[(size_t)tt * NIN + 4096 + c] * P[(size_t)tt * NIN + 5120 + c] * cw[w * D + c]; }
        u[(size_t)t * D + c] = P[(size_t)t * NIN + 3072 + c] * z; }
}
__global__ void k_merge(const float* P, const float* bg, const float* yA, const float* yB, float* m) {
    const int t = blockIdx.x;
    for (int c = threadIdx.x; c < D; c += 256) { const float ga = 1.f / (1.f + expf(-(P[(size_t)t * NIN + 6144 + c] + bg[c]))), gb = 1.f / (1.f + expf(-(P[(size_t)t * NIN + 7168 + c] + bg[D + c])));
        m[(size_t)t * D + c] = ga * yA[(size_t)t * D + c] + gb * yB[(size_t)t * D + c]; }
}
__global__ void k_route(const float* x1, const float* wg, const float* bg, const float* wsub, const float* bsub, int* eid, float* ew, int* rank, int* cnt) {
    const int t = blockIdx.x * 4 + (threadIdx.x >> 6), lane = threadIdx.x & 63;
    float acc[36];
#pragma unroll
    for (int i = 0; i < 36; ++i) acc[i] = 0.f;
    for (int j = 0; j < 16; ++j) { const int d = lane + 64 * j; const float xv = x1[(size_t)t * D + d];
#pragma unroll
        for (int g = 0; g < 4; ++g) acc[g] += xv * wg[d * 4 + g];
#pragma unroll
        for (int g = 0; g < 4; ++g) {
#pragma unroll
            for (int e = 0; e < 8; ++e) acc[4 + g * 8 + e] += xv * wsub[((size_t)g * D + d) * 8 + e]; } }
#pragma unroll
    for (int i = 0; i < 36; ++i) acc[i] = wave_sum(acc[i]);
    __shared__ float sacc[4][36];
    const int wv = threadIdx.x >> 6;
#pragma unroll
    for (int i = 0; i < 36; ++i) if (lane == 0) sacc[wv][i] = acc[i];
    __syncthreads();
    if (lane == 0) {
        const float* sa = sacc[wv];
        float gmax = sa[0] + bg[0]; int gi = 0;
        for (int g = 1; g < 4; ++g) { const float v = sa[g] + bg[g]; if (v > gmax) { gmax = v; gi = g; } }
        float z = 0.f;
        for (int g = 0; g < 4; ++g) z += expf(sa[g] + bg[g] - gmax);
        const float gp = 1.f / z;
        const float* sl = sa + 4 + gi * 8; const float* bs = bsub + gi * 8;
        float b0 = sl[0] + bs[0]; int i0 = 0;
        for (int e = 1; e < 8; ++e) { const float v = sl[e] + bs[e]; if (v > b0) { b0 = v; i0 = e; } }
        float b1 = -INFINITY; int i1 = 0;
        for (int e = 0; e < 8; ++e) { const float v = sl[e] + bs[e]; if (e != i0 && v > b1) { b1 = v; i1 = e; } }
        const float e1 = expf(b1 - b0); const float w0 = gp / (1.f + e1), w1 = gp * e1 / (1.f + e1);
        const int ex0 = gi * 8 + i0, ex1 = gi * 8 + i1;
        eid[t * 2] = ex0; eid[t * 2 + 1] = ex1; ew[t * 2] = w0; ew[t * 2 + 1] = w1;
        rank[t * 2] = atomicAdd(&cnt[ex0], 1); rank[t * 2 + 1] = atomicAdd(&cnt[ex1], 1);
    }
}
__global__ void k_offsets(const int* cnt, int* pad_start, int* tile_expert) {
    if (threadIdx.x == 0) { int s = 0; for (int e = 0; e < NE; ++e) { pad_start[e] = s; const int p = (cnt[e] + MOE_PAD - 1) / MOE_PAD * MOE_PAD; for (int i = 0; i < p / MOE_PAD; ++i) tile_expert[s / MOE_PAD + i] = e; s += p; }
        pad_start[NE] = s; for (int i = s / MOE_PAD; i < MAX_TILES; ++i) tile_expert[i] = -1; }
}
__global__ void k_place(const int* eid, const float* ew, const int* rank, const int* pad_start, int* tok, float* wslot) {
    const int a = blockIdx.x * 256 + threadIdx.x; if (a >= 2 * T) return;
    const int s = pad_start[eid[a]] + rank[a]; tok[s] = a >> 1; wslot[s] = ew[a];
}
__global__ void k_moe_up(const float* x1, const int* tok, const int* tile_expert, const float* Wg, const float* Wu, float* h) {
    __shared__ float As[16][65], Bs[16][65];
    const int e = tile_expert[blockIdx.y]; if (e < 0) return;
    TileAcc g, u; const int row0 = blockIdx.y * 64, col0 = blockIdx.x * 64;
    gemm_tile(x1, D, tok, row0, Wg + (size_t)e * D * DE, DE, col0, D, g, As, Bs);
    gemm_tile(x1, D, tok, row0, Wu + (size_t)e * D * DE, DE, col0, D, u, As, Bs);
    const int tx = threadIdx.x & 15, ty = threadIdx.x >> 4;
    for (int i = 0; i < 4; ++i) for (int j = 0; j < 4; ++j) { const float gv = g.c[i][j]; h[(size_t)(row0 + ty * 4 + i) * DE + col0 + tx * 4 + j] = gv / (1.f + expf(-gv)) * u.c[i][j]; }
}
__global__ void k_moe_down(const float* h, const int* tok, const float* wslot, const int* tile_expert, const float* Wd, float* ffn) {
    __shared__ float As[16][65], Bs[16][65];
    const int e = tile_expert[blockIdx.y]; if (e < 0) return;
    TileAcc acc; const int row0 = blockIdx.y * 64, col0 = blockIdx.x * 64;
    gemm_tile(h, DE, nullptr, row0, Wd + (size_t)e * DE * D, D, col0, DE, acc, As, Bs);
    const int tx = threadIdx.x & 15, ty = threadIdx.x >> 4;
    for (int i = 0; i < 4; ++i) { const int r = row0 + ty * 4 + i; const int t = tok[r]; if (t < 0) continue; const float w = wslot[r];
        for (int j = 0; j < 4; ++j) atomicAdd(&ffn[(size_t)t * D + col0 + tx * 4 + j], w * acc.c[i][j]); }
}
}
#endif
#if HYBRID
__global__ void k_axpy(const float* xn, const float* mix, float* pre, float a, size_t n) { const size_t i = (size_t)blockIdx.x * 256 + threadIdx.x; if (i < n) pre[i] = a * xn[i] + mix[i]; }
__global__ void k_f2b(const float* src, int lds_, unsigned short* dst, int ldd, int cols, size_t rows) {
    const size_t i = (size_t)blockIdx.x * 256 + threadIdx.x; if (i >= rows * cols) return; const size_t r = i / cols; const int c = (int)(i % cols);
    dst[r * ldd + c] = (unsigned short)f2bf(src[r * lds_ + c]); }
__global__ void k_f2b_mul(const float* a, const float* b, int lds_, unsigned short* dst, int ldd, int cols, size_t rows) {
    const size_t i = (size_t)blockIdx.x * 256 + threadIdx.x; if (i >= rows * cols) return; const size_t r = i / cols; const int c = (int)(i % cols);
    dst[r * ldd + c] = (unsigned short)f2bf(a[r * lds_ + c] * b[r * lds_ + c]); }
__global__ void k_f2b_sig(const float* a, const float* bias, int lds_, unsigned short* dst, int ldd, int cols, size_t rows) {
    const size_t i = (size_t)blockIdx.x * 256 + threadIdx.x; if (i >= rows * cols) return; const size_t r = i / cols; const int c = (int)(i % cols);
    dst[r * ldd + c] = (unsigned short)f2bf(1.f / (1.f + expf(-(a[r * lds_ + c] + bias[c])))); }
#endif
static void launch_mega(const Ptrs& p, int lo, int hi, int region, int flags, hipStream_t stream) {
    Args a{}; a.p = p; a.ph_lo = lo; a.ph_hi = hi; a.bar_region = region; a.flags = flags;
    hipLaunchKernelGGL(mega_fwd, dim3(256), dim3(NWAVES * 64), LDS_BYTES, stream, a);
}
extern "C" void kernel_launch(void* const* d_in, const int* in_sizes, int n_in, void* d_out, int out_size, void* d_ws, size_t ws_size, hipStream_t stream) {
    static int ready = 0;
    if (ready == 0) {
        ready = 1;
        if (n_in != 24 || out_size != T * D || ws_size < WS_END) { fprintf(stderr, "kernel_launch: unexpected shapes (n_in %d out %d ws %zu)\n", n_in, out_size, ws_size); ready = -1; }
        else if (hipFuncSetAttribute((const void*)mega_fwd, hipFuncAttributeMaxDynamicSharedMemorySize, LDS_BYTES) != hipSuccess) { fprintf(stderr, "kernel_launch: hipFuncSetAttribute failed\n"); ready = -1; }
        (void)hipGetLastError();
    }
    if (ready < 0) return;
    Ptrs p{};
    const float** pp = (const float**)&p;
    for (int i = 0; i < 24; ++i) pp[i] = (const float*)d_in[i];
    p.out = (float*)d_out; p.ws = (unsigned char*)d_ws;
    (void)hipMemsetAsync((char*)d_ws + WS_CTL, 0, CTL_ZERO_BYTES, stream);
#if HYBRID == 0
#if defined(TIME_PHASE)
    launch_mega(p, 0, TIME_PHASE + 1, 0, 0, stream); launch_mega(p, TIME_PHASE, TIME_PHASE + 1, 1, 3, stream); if (TIME_PHASE + 1 < N_PHASES) launch_mega(p, TIME_PHASE + 1, N_PHASES, 2, 0, stream);
#elif defined(SPLIT_AT)
    launch_mega(p, 0, SPLIT_AT, 0, 0, stream); launch_mega(p, SPLIT_AT, N_PHASES, 1, 0, stream);
#else
    launch_mega(p, 0, N_PHASES, 0, 0, stream);
#endif
#else
    char* ws = (char*)d_ws; float* out = (float*)d_out;
    constexpr size_t NB = (HYBRID == 1 ? 330 : (HYBRID == 2 ? 90 : 410)) * MiB;
    float* Pb = (float*)(ws + NB); float* xnb = (float*)(ws + NB + 64 * MiB); float* ao = (float*)(ws + NB + 72 * MiB); float* ub = (float*)(ws + NB + 80 * MiB); float* yA = (float*)(ws + NB + 88 * MiB); float* yB = (float*)(ws + NB + 96 * MiB); float* mb = (float*)(ws + NB + 104 * MiB);
    float* pre = (float*)(ws + WS_PRE);
#ifndef TAKE_MASK
#define TAKE_MASK 0
#endif
#if HYBRID >= 2
    launch_mega(p, 0, TAKE_MASK ? 2 : 1, 0, 0, stream);
#endif
    for (int b = 0; b < BATCH; ++b) {
        const size_t r0 = (size_t)b * SEQ;
        nv::k_ln_rows<<<SEQ, 256, 0, stream>>>(p.x + r0 * D, 1.f, nullptr, p.ln_in_g, p.ln_in_b, xnb);
        nv::k_gemm<<<dim3(NIN / 64, SEQ / 64), 256, 0, stream>>>(xnb, D, p.w_in, NIN, Pb, NIN, D);
#if HYBRID == 3
        { const int nb = (int)(((size_t)SEQ * 1024 + 255) / 256);
          if (!(TAKE_MASK & 1)) k_f2b<<<nb, 256, 0, stream>>>(Pb, NIN, (unsigned short*)(ws + WS_Q) + r0 * D, D, 1024, SEQ);
          if (!(TAKE_MASK & 2)) k_f2b<<<nb, 256, 0, stream>>>(Pb + 1024, NIN, (unsigned short*)(ws + WS_K) + r0 * D, D, 1024, SEQ);
          if (!(TAKE_MASK & 4)) k_f2b<<<nb, 256, 0, stream>>>(Pb + 2048, NIN, (unsigned short*)(ws + WS_V) + r0 * D, D, 1024, SEQ);
          if (!(TAKE_MASK & 8)) k_f2b<<<nb, 256, 0, stream>>>(Pb + 3072, NIN, BUF_CB(p) + r0 * D, D, 1024, SEQ);
          if (!(TAKE_MASK & 16)) k_f2b_mul<<<nb, 256, 0, stream>>>(Pb + 4096, Pb + 5120, NIN, (unsigned short*)(ws + WS_Z) + r0 * D, D, 1024, SEQ);
          if (!(TAKE_MASK & 32)) k_f2b<<<nb, 256, 0, stream>>>(Pb + 6144, NIN, BUF_SGA(p) + r0 * D, D, 1024, SEQ);
          if (!(TAKE_MASK & 64)) k_f2b<<<nb, 256, 0, stream>>>(Pb + 7168, NIN, BUF_SGB(p) + r0 * D, D, 1024, SEQ); }
#else
        nv::k_attn<<<dim3(SEQ, nv::NH), 256, 0, stream>>>(Pb, p.rel_bias, p.lq, p.lk, p.subln_g, ao);
        nv::k_conv<<<SEQ, 256, 0, stream>>>(Pb, p.conv_w, ub);
#if HYBRID == 2
        { const int nb = (int)(((size_t)SEQ * 1024 + 255) / 256);
          k_f2b<<<nb, 256, 0, stream>>>(ao, D, (unsigned short*)(ws + WS_XN) + r0 * D, D, 1024, SEQ);
          k_f2b<<<nb, 256, 0, stream>>>(ub, D, BUF_CB(p) + r0 * D, D, 1024, SEQ);
          k_f2b<<<nb, 256, 0, stream>>>(Pb + 6144, NIN, BUF_SGA(p) + r0 * D, D, 1024, SEQ);
          k_f2b<<<nb, 256, 0, stream>>>(Pb + 7168, NIN, BUF_SGB(p) + r0 * D, D, 1024, SEQ); }
#else
        nv::k_gemm<<<dim3(D / 64, SEQ / 64), 256, 0, stream>>>(ao, D, p.w_a, D, yA, D, D);
        nv::k_gemm<<<dim3(D / 64, SEQ / 64), 256, 0, stream>>>(ub, D, p.w_b, D, yB, D, D);
        nv::k_merge<<<SEQ, 256, 0, stream>>>(Pb, p.b_gate, yA, yB, mb);
        nv::k_gemm<<<dim3(D / 64, SEQ / 64), 256, 0, stream>>>(mb, D, p.w_o, D, pre + r0 * D, D, D);
        k_axpy<<<(int)(((size_t)SEQ * D + 255) / 256), 256, 0, stream>>>(xnb, pre + r0 * D, pre + r0 * D, ALPHA, (size_t)SEQ * D);
#endif
#endif
    }
#if HYBRID == 1
    launch_mega(p, 3, 4, 1, 1, stream);
    launch_mega(p, 6, N_PHASES, 2, 0, stream);
#elif HYBRID == 2
    launch_mega(p, 3, 4, 1, 1, stream);
    launch_mega(p, 4, N_PHASES, 2, 0, stream);
#elif HYBRID == 3
    launch_mega(p, 2, N_PHASES, 1, 0, stream);
#endif
#endif
}
```

```cpp
#include <hip/hip_runtime.h>
#include <cstdio>
#include <cstdint>
#include <cmath>
#ifndef HYBRID
#define HYBRID 0
#endif
namespace pg8 {
#define PG8_LAS __attribute__((address_space(3)))
typedef unsigned short bf16_t;
typedef short bf16x8 __attribute__((ext_vector_type(8)));
typedef float f32x4 __attribute__((ext_vector_type(4)));
typedef unsigned u32x4 __attribute__((ext_vector_type(4)));
constexpr int BM = 256, BK = 64, HALF = 128, HTB = HALF * BK * 2  , STAGE_BYTES = 8 * HTB, NXCD = 8, WGM = 8;

__host__ __device__ __forceinline__ int lds_byte(int r, int c) { const int st = (r >> 4) * 2 + (c >> 5), rr = r & 15, cc = c & 31, ob = rr * 64 + cc * 2; return st * 1024 + (ob ^ (((ob >> 9) & 1) << 5)); }
__host__ __device__ __forceinline__ void stage_rc(int b, int& R, int& C) { const int st = b / 1024, sb = b % 1024, swz = sb ^ (((sb >> 9) & 1) << 5); R = (st >> 1) * 16 + swz / 64; C = (st & 1) * 32 + (swz % 64) / 2; }
__host__ __device__ __forceinline__ int perm32(int rho) { const int n = rho >> 4, i = rho & 15; return 8 * (i >> 2) + 4 * n + (i & 3); }

struct Unit { int pm, pn; };
struct Gemm { const bf16_t* A; const bf16_t* Bt; int M, N, K; };

struct StaticOrder {
    int nM, nN, nwg, G, c;
    __host__ __device__ void init(int M, int N, int G_, int c_) { nM = M / BM; nN = N / BM; nwg = nM * nN; G = G_; c = c_; }
    __host__ __device__ bool next(int i, Unit& u) const {
        const long L = (long)i * G + c; if (L >= nwg) return false;
        int wgid = (int)L; { const int q = nwg / NXCD, r = nwg % NXCD, xcd = wgid % NXCD, off = wgid / NXCD; wgid = (xcd < r ? xcd * (q + 1) : r * (q + 1) + (xcd - r) * q) + off; }
        const int nig = WGM * nN, gid = wgid / nig, fm = gid * WGM, gsz = (nM - fm) < WGM ? (nM - fm) : WGM;
        u.pm = fm + ((wgid % nig) % gsz); u.pn = (wgid % nig) / gsz; return true;
    }
    __device__ __forceinline__ void a_ready(const Unit&) const {}
    __device__ __forceinline__ void done(const Unit&) const {}
};

__device__ __forceinline__ unsigned cvt_pk_bf16(float lo, float hi) { unsigned r; asm volatile("v_cvt_pk_bf16_f32 %0, %1, %2" : "=v"(r) : "v"(lo), "v"(hi)); return r; }
typedef float f32x2 __attribute__((ext_vector_type(2)));
__device__ __forceinline__ u32x4 pack8f(const f32x4 a, const f32x4 b) { u32x4 w; w.x = cvt_pk_bf16(a[0], a[1]); w.y = cvt_pk_bf16(a[2], a[3]); w.z = cvt_pk_bf16(b[0], b[1]); w.w = cvt_pk_bf16(b[2], b[3]); return w; }
__device__ __forceinline__ void unpack8f(const u32x4 w, f32x4& a, f32x4& b) {
    a[0] = __uint_as_float(w.x << 16); a[1] = __uint_as_float(w.x & 0xffff0000u); a[2] = __uint_as_float(w.y << 16); a[3] = __uint_as_float(w.y & 0xffff0000u);
    b[0] = __uint_as_float(w.z << 16); b[1] = __uint_as_float(w.z & 0xffff0000u); b[2] = __uint_as_float(w.w << 16); b[3] = __uint_as_float(w.w & 0xffff0000u); }
__device__ __forceinline__ float sigmoidf_fast(float x) { return __builtin_amdgcn_rcpf(1.0f + __expf(-x)); }

struct EpiInProj {
    static constexpr bool PERM = true, AFTER_DRAIN = false;
    bf16_t* qkv; size_t stride;
    bf16_t* cb;
    bf16_t* z;
    bf16_t* sga; bf16_t* sgb;
    __device__ __forceinline__ void operator()(const f32x4 (&acc)[2][2][4][2], const Unit& u, int wr, int wc, int fr, int fq) const {
        const int row0 = u.pm * BM + wr * 64 + fr; const int pn = u.pn;
        if (pn < 16 || pn >= 24) {
            bf16_t* base = (pn < 12) ? qkv + (size_t)(pn >> 2) * stride : (pn < 16 ? cb : (pn < 28 ? sga : sgb)); const int col0 = (pn & 3) * BM + wc * 32 + 8 * fq;
#pragma unroll
            for (int ai = 0; ai < 2; ++ai)
#pragma unroll
                for (int m = 0; m < 4; ++m) { bf16_t* rowp = base + (size_t)(row0 + ai * HALF + m * 16) * 1024 + col0;
#pragma unroll
                    for (int bj = 0; bj < 2; ++bj) *(u32x4*)(rowp + bj * HALF) = pack8f(acc[ai][bj][m][0], acc[ai][bj][m][1]); }
        } else {
            const int col0 = (pn - 16) * HALF + wc * 32 + 8 * fq;
#pragma unroll
            for (int ai = 0; ai < 2; ++ai)
#pragma unroll
                for (int m = 0; m < 4; ++m) { bf16_t* rowp = z + (size_t)(row0 + ai * HALF + m * 16) * 1024 + col0;
                    *(u32x4*)rowp = pack8f(acc[ai][0][m][0] * acc[ai][1][m][0], acc[ai][0][m][1] * acc[ai][1][m][1]); }
        }
    }
};
template <bool SECOND> struct EpiGate {
    static constexpr bool PERM = true, AFTER_DRAIN = false;
    const bf16_t* gate; const bf16_t* prev; bf16_t* out; const float* gbias;
    __device__ __forceinline__ void operator()(const f32x4 (&acc)[2][2][4][2], const Unit& u, int wr, int wc, int fr, int fq) const {
        const int row0 = u.pm * BM + wr * 64 + fr; const int col0 = u.pn * BM + wc * 32 + 8 * fq;
        f32x4 bv[2][2];
#pragma unroll
        for (int bj = 0; bj < 2; ++bj)
#pragma unroll
            for (int n = 0; n < 2; ++n) bv[bj][n] = *(const f32x4*)(gbias + col0 + bj * HALF + 4 * n);
#pragma unroll
        for (int ai = 0; ai < 2; ++ai)
#pragma unroll
            for (int m = 0; m < 4; ++m) { const size_t off = (size_t)(row0 + ai * HALF + m * 16) * 1024 + col0;
#pragma unroll
                for (int bj = 0; bj < 2; ++bj) { f32x4 g0, g1; unpack8f(*(const u32x4*)(gate + off + bj * HALF), g0, g1); g0 += bv[bj][0]; g1 += bv[bj][1];
#pragma unroll
                    for (int i = 0; i < 4; ++i) { g0[i] = sigmoidf_fast(g0[i]); g1[i] = sigmoidf_fast(g1[i]); }
                    f32x4 v0 = acc[ai][bj][m][0] * g0, v1 = acc[ai][bj][m][1] * g1;
                    if (SECOND) { f32x4 p0, p1; unpack8f(*(const u32x4*)(prev + off + bj * HALF), p0, p1); v0 += p0; v1 += p1; }
                    *(u32x4*)(out + off + bj * HALF) = pack8f(v0, v1); } }
    }
};
typedef unsigned u32x2 __attribute__((ext_vector_type(2)));
#ifndef PRE_BF16_KNOB
#define PRE_BF16_KNOB 1
#endif
constexpr bool PRE_BF16 = PRE_BF16_KNOB;
struct EpiPre {
    static constexpr bool PERM = false, AFTER_DRAIN = false;
    const float* x; const float* stats; const float* g; const float* b; float* pre; float alpha;
    __device__ __forceinline__ void operator()(const f32x4 (&acc)[2][2][4][2], const Unit& u, int wr, int wc, int fr, int fq) const {
        const int row0 = u.pm * BM + wr * 64 + fr; const int col0 = u.pn * BM + wc * 32 + 4 * fq;
#pragma unroll
        for (int ai = 0; ai < 2; ++ai)
#pragma unroll
            for (int m = 0; m < 4; ++m) { const int row = row0 + ai * HALF + m * 16; const size_t off = (size_t)row * 1024 + col0;
                const float mu = stats[2 * row], rs = stats[2 * row + 1];
#pragma unroll
                for (int bj = 0; bj < 2; ++bj)
#pragma unroll
                    for (int n = 0; n < 2; ++n) { const int c = bj * HALF + n * 16; const f32x4 xv = *(const f32x4*)(x + off + c), gv = *(const f32x4*)(g + col0 + c), bv = *(const f32x4*)(b + col0 + c);
                        const f32x4 o = ((xv - mu) * rs * gv + bv) * alpha + acc[ai][bj][m][n];
                        if constexpr (PRE_BF16) { u32x2 w; w.x = cvt_pk_bf16(o[0], o[1]); w.y = cvt_pk_bf16(o[2], o[3]); *(u32x2*)((bf16_t*)pre + off + c) = w; } else *(f32x4*)(pre + off + c) = o; } }
    }
};
struct EpiMoeUp {
    static constexpr bool PERM = true, AFTER_DRAIN = false;
    bf16_t* h;
    __device__ __forceinline__ void operator()(const f32x4 (&acc)[2][2][4][2], const Unit& u, int wr, int wc, int fr, int fq) const {
        const int row0 = u.pm * BM + wr * 64 + fr; const int col0 = (u.pn & 3) * HALF + wc * 32 + 8 * fq;
#pragma unroll
        for (int ai = 0; ai < 2; ++ai)
#pragma unroll
            for (int m = 0; m < 4; ++m) { f32x4 v[2];
#pragma unroll
                for (int n = 0; n < 2; ++n)
#pragma unroll
                    for (int i = 0; i < 4; ++i) { const float gv = acc[ai][0][m][n][i]; v[n][i] = gv * sigmoidf_fast(gv) * acc[ai][1][m][n][i]; }
                *(u32x4*)(h + (size_t)(row0 + ai * HALF + m * 16) * 512 + col0) = pack8f(v[0], v[1]); }
    }
};
struct EpiMoeDown {
    static constexpr bool PERM = true, AFTER_DRAIN = false;
    bf16_t* y;
    __device__ __forceinline__ void operator()(const f32x4 (&acc)[2][2][4][2], const Unit& u, int wr, int wc, int fr, int fq) const {
        const int row0 = u.pm * BM + wr * 64 + fr; const int col0 = (u.pn & 3) * BM + wc * 32 + 8 * fq;
#pragma unroll
        for (int ai = 0; ai < 2; ++ai)
#pragma unroll
            for (int m = 0; m < 4; ++m) { bf16_t* rowp = y + (size_t)(row0 + ai * HALF + m * 16) * 1024 + col0;
#pragma unroll
                for (int bj = 0; bj < 2; ++bj) *(u32x4*)(rowp + bj * HALF) = pack8f(acc[ai][bj][m][0], acc[ai][bj][m][1]); }
    }
};
struct MoeOrder {
    const PG8_LAS int* tab; int G, c;
    __device__ __forceinline__ bool next(int i, Unit& u) const {
        const int nunits = (tab[32] >> 8) * 4; const int L = i * G + c; if (L >= nunits) return false;
        const int tile = L >> 2, s = tile << 8; int e = 0;
#pragma unroll 1
        for (int k = 1; k < 32; ++k) e = (tab[k] <= s) ? k : e;
        u.pm = __builtin_amdgcn_readfirstlane(tile); u.pn = __builtin_amdgcn_readfirstlane(e * 4 + (L & 3)); return true;
    }
    __device__ __forceinline__ void a_ready(const Unit&) const {}
    __device__ __forceinline__ void done(const Unit&) const {}
};
template <class Epi, class Sched, bool ALIGN_EPI = false, bool SP2 = false, bool GATHER = false>
__device__ __forceinline__ void gemm_phase(PG8_LAS unsigned char* lds, const Gemm g, const Sched& S, const Epi& E, const int* tok = nullptr) {
    static_assert(!GATHER || SP2, "GATHER is written for the SP2 loop only");
    const int tid = threadIdx.x, wid = __builtin_amdgcn_readfirstlane(tid >> 6), lane = tid & 63, wr = wid >> 2, wc = wid & 3, fr = lane & 15, fq = lane >> 4;
    const int K = g.K, nt = K / BK;
    unsigned voffA[2], voffB[2]; int gR[2], gC[2];
#pragma unroll
    for (int i = 0; i < 2; ++i) { int R, C; stage_rc(tid * 16 + i * 8192, R, C); const int Rb = Epi::PERM ? ((R & ~31) + perm32(R & 31)) : R; gR[i] = R; gC[i] = C;
        voffA[i] = (unsigned)(R * K + C) * 2u; voffB[i] = (unsigned)(Rb * K + C) * 2u; }
    unsigned vc0[2] = {0u, 0u}, vc1[2] = {0u, 0u}, vn0[2] = {0u, 0u}, vn1[2] = {0u, 0u};
#define PG8_GROWS(pm_, o0, o1) do { _Pragma("unroll") for (int _i = 0; _i < 2; ++_i) { o0[_i] = (unsigned)(tok[(pm_) * BM + gR[_i]] * K + gC[_i]) * 2u; o1[_i] = (unsigned)(tok[(pm_) * BM + HALF + gR[_i]] * K + gC[_i]) * 2u; } } while (0)
#define PG8_STAGE_A(bufoff, gbase, h, usenext) do { if constexpr (GATHER) { const unsigned _o0 = (usenext) ? ((h) ? vn1[0] : vn0[0]) : ((h) ? vc1[0] : vc0[0]), _o1 = (usenext) ? ((h) ? vn1[1] : vn0[1]) : ((h) ? vc1[1] : vc0[1]); \
        __builtin_amdgcn_global_load_lds((const unsigned*)((const char*)(gbase) + _o0), (PG8_LAS unsigned*)(lds + (bufoff) + ldsw), 16, 0, 0); \
        __builtin_amdgcn_global_load_lds((const unsigned*)((const char*)(gbase) + _o1), (PG8_LAS unsigned*)(lds + (bufoff) + ldsw + 8192), 16, 0, 0); } \
    else { PG8_STAGE(bufoff, (gbase) + (h) * hstep, voffA); } } while (0)
    const size_t kstep = (size_t)(BK * 2);
    const size_t hstep = (size_t)HALF * K * 2;
    const size_t tstep = 2 * hstep;
    const unsigned ldsw = (unsigned)wid * 1024u;
    const int aoff = lds_byte(wr * 64 + fr, fq * 8), boff = lds_byte(wc * 32 + fr, fq * 8);
#define PG8_SA(b, h) (((b) * 2 + (h)) * HTB)
#define PG8_SB(b, h) ((4 + (b) * 2 + (h)) * HTB)
#define PG8_STAGE(bufoff, gbase, voff) do { _Pragma("unroll") for (int _i = 0; _i < 2; ++_i) \
        __builtin_amdgcn_global_load_lds((const unsigned*)((const char*)(gbase) + (voff)[_i]), (PG8_LAS unsigned*)(lds + (bufoff) + ldsw + _i * 8192), 16, 0, 0); } while (0)
#define PG8_LDA(dst, b, h) do { _Pragma("unroll") for (int m = 0; m < 4; ++m) _Pragma("unroll") for (int k = 0; k < 2; ++k) dst[m][k] = *(const PG8_LAS bf16x8*)(lds + PG8_SA(b, h) + aoff + m * 2048 + k * 1024); } while (0)
#define PG8_LDB(dst, b, h) do { _Pragma("unroll") for (int n = 0; n < 2; ++n) _Pragma("unroll") for (int k = 0; k < 2; ++k) dst[n][k] = *(const PG8_LAS bf16x8*)(lds + PG8_SB(b, h) + boff + n * 2048 + k * 1024); } while (0)
#define PG8_MMA(ai, bj, At, Bt) do { __builtin_amdgcn_s_setprio(1); _Pragma("unroll") for (int m = 0; m < 4; ++m) _Pragma("unroll") for (int n = 0; n < 2; ++n) _Pragma("unroll") for (int k = 0; k < 2; ++k) \
        acc[ai][bj][m][n] = __builtin_amdgcn_mfma_f32_16x16x32_bf16(Bt[n][k], At[m][k], acc[ai][bj][m][n], 0, 0, 0); __builtin_amdgcn_s_setprio(0); } while (0)
#define PG8_WAIT_V(n) asm volatile("s_waitcnt vmcnt(" #n ")" ::: "memory")
#define PG8_WAIT_L(n) asm volatile("s_waitcnt lgkmcnt(" #n ")" ::: "memory")
#define PG8_BAR __builtin_amdgcn_s_barrier()
#define PG8_SCHED __builtin_amdgcn_sched_barrier(0)
    Unit cur, nxt; int ui = 0;
    if (!S.next(0, cur)) return;
    f32x4 acc[2][2][4][2];
#pragma unroll
    for (int a = 0; a < 2; ++a)
#pragma unroll
        for (int b = 0; b < 2; ++b)
#pragma unroll
            for (int m = 0; m < 4; ++m)
#pragma unroll
                for (int n = 0; n < 2; ++n) acc[a][b][m][n] = (f32x4){0.f, 0.f, 0.f, 0.f};
    bf16x8 At[4][2], B0[2][2], B1[2][2];
    const char* cA = GATHER ? (const char*)g.A : (const char*)g.A + (size_t)cur.pm * tstep; const char* cB = (const char*)g.Bt + (size_t)cur.pn * tstep;
    S.a_ready(cur);
    if constexpr (GATHER) PG8_GROWS(cur.pm, vc0, vc1);
    if constexpr (SP2) {
        PG8_STAGE(PG8_SB(0, 0), cB, voffB); PG8_STAGE(PG8_SB(0, 1), cB + hstep, voffB); PG8_STAGE_A(PG8_SA(0, 0), cA, 0, false); PG8_STAGE_A(PG8_SA(0, 1), cA, 1, false);
        if (wr == 1) PG8_BAR;
        PG8_WAIT_V(2); PG8_BAR;
        PG8_STAGE(PG8_SB(1, 0), cB + kstep, voffB); PG8_STAGE_A(PG8_SA(1, 0), cA + kstep, 0, false); PG8_STAGE(PG8_SB(1, 1), cB + hstep + kstep, voffB);
        PG8_WAIT_V(6); PG8_BAR;
    } else {
        PG8_STAGE(PG8_SB(0, 0), cB, voffB); PG8_STAGE(PG8_SA(0, 0), cA, voffA); PG8_STAGE(PG8_SB(0, 1), cB + hstep, voffB); PG8_STAGE(PG8_SA(0, 1), cA + hstep, voffA);
        if (wr == 1) PG8_BAR;
        PG8_WAIT_V(4); PG8_BAR;
        PG8_STAGE(PG8_SB(1, 0), cB + kstep, voffB); PG8_STAGE(PG8_SA(1, 0), cA + kstep, voffA); PG8_STAGE(PG8_SB(1, 1), cB + hstep + kstep, voffB);
        PG8_WAIT_V(6); PG8_BAR;
    }
    for (;;) {
        const bool has_next = S.next(ui + 1, nxt);
        const char* nA = GATHER ? (const char*)g.A : (has_next ? (const char*)g.A + (size_t)nxt.pm * tstep : cA); const char* nB = has_next ? (const char*)g.Bt + (size_t)nxt.pn * tstep : cB;
        if constexpr (GATHER) { if (has_next) PG8_GROWS(nxt.pm, vn0, vn1); else { vn0[0] = vc0[0]; vn0[1] = vc0[1]; vn1[0] = vc1[0]; vn1[1] = vc1[1]; } }
        for (int t = 0; t < nt; t += 2) {
            const bool last = (t == nt - 2);
            const char* a1 = cA + (size_t)(t + 1) * kstep;
            const char* a2 = last ? nA : cA + (size_t)(t + 2) * kstep; const char* b2 = last ? nB : cB + (size_t)(t + 2) * kstep;
            const char* a3 = a2 + kstep; const char* b3 = b2 + kstep;
            if (last && has_next) S.a_ready(nxt);
            if constexpr (SP2) {
            PG8_LDB(B0, 0, 0); PG8_LDB(B1, 0, 1); PG8_SCHED; PG8_LDA(At, 0, 0); PG8_STAGE_A(PG8_SA(1, 1), a1, 1, false);
            PG8_WAIT_V(8); PG8_WAIT_L(0); PG8_BAR; PG8_MMA(0, 0, At, B0); PG8_MMA(0, 1, At, B1); PG8_BAR; PG8_SCHED;
            PG8_LDA(At, 0, 1); PG8_STAGE(PG8_SB(0, 0), b2, voffB); PG8_STAGE(PG8_SB(0, 1), b2 + hstep, voffB); PG8_STAGE_A(PG8_SA(0, 0), a2, 0, last);
            PG8_WAIT_V(8); PG8_WAIT_L(0); PG8_BAR; PG8_MMA(1, 0, At, B0); PG8_MMA(1, 1, At, B1); PG8_BAR; PG8_SCHED;
            PG8_LDB(B0, 1, 0); PG8_LDB(B1, 1, 1); PG8_SCHED; PG8_LDA(At, 1, 0); PG8_STAGE_A(PG8_SA(0, 1), a2, 1, last);
            PG8_WAIT_V(8); PG8_WAIT_L(0); PG8_BAR; PG8_MMA(0, 0, At, B0); PG8_MMA(0, 1, At, B1); PG8_BAR; PG8_SCHED;
            PG8_LDA(At, 1, 1); PG8_STAGE(PG8_SB(1, 0), b3, voffB); PG8_STAGE(PG8_SB(1, 1), b3 + hstep, voffB); PG8_STAGE_A(PG8_SA(1, 0), a3, 0, last);
            PG8_WAIT_V(8); PG8_WAIT_L(0); PG8_BAR; PG8_MMA(1, 0, At, B0); PG8_MMA(1, 1, At, B1); PG8_BAR; PG8_SCHED;
            } else {
            PG8_LDB(B0, 0, 0); PG8_SCHED; PG8_LDA(At, 0, 0); PG8_STAGE(PG8_SA(1, 1), a1 + hstep, voffA);
            PG8_WAIT_L(8); PG8_BAR; PG8_WAIT_L(0); PG8_MMA(0, 0, At, B0); PG8_BAR; PG8_SCHED;
            PG8_LDB(B1, 0, 1); PG8_STAGE(PG8_SB(0, 0), b2, voffB);
            PG8_BAR; PG8_WAIT_L(0); PG8_MMA(0, 1, At, B1); PG8_BAR;
            PG8_LDA(At, 0, 1); PG8_STAGE(PG8_SA(0, 0), a2, voffA);
            PG8_BAR; PG8_WAIT_L(0); PG8_MMA(1, 0, At, B0); PG8_BAR; PG8_SCHED;
            PG8_STAGE(PG8_SB(0, 1), b2 + hstep, voffB);
            PG8_WAIT_V(6); PG8_BAR; PG8_MMA(1, 1, At, B1); PG8_BAR;
            PG8_LDB(B0, 1, 0); PG8_SCHED; PG8_LDA(At, 1, 0); PG8_STAGE(PG8_SA(0, 1), a2 + hstep, voffA);
            PG8_WAIT_L(8); PG8_BAR; PG8_WAIT_L(0); PG8_MMA(0, 0, At, B0); PG8_BAR; PG8_SCHED;
            PG8_LDB(B1, 1, 1); PG8_STAGE(PG8_SB(1, 0), b3, voffB);
            PG8_BAR; PG8_WAIT_L(0); PG8_MMA(0, 1, At, B1); PG8_BAR;
            PG8_LDA(At, 1, 1); PG8_STAGE(PG8_SA(1, 0), a3, voffA);
            PG8_BAR; PG8_WAIT_L(0); PG8_MMA(1, 0, At, B0); PG8_BAR; PG8_SCHED;
            PG8_STAGE(PG8_SB(1, 1), b3 + hstep, voffB);
            PG8_WAIT_V(6); PG8_BAR; PG8_MMA(1, 1, At, B1); PG8_BAR;
            }
        }
        if constexpr (ALIGN_EPI) { if (wr == 0) PG8_BAR; }
        if constexpr (!Epi::AFTER_DRAIN) { E(acc, cur, wr, wc, fr, fq); S.done(cur); }
        if (!has_next) break;
#pragma unroll
        for (int a = 0; a < 2; ++a)
#pragma unroll
            for (int b = 0; b < 2; ++b)
#pragma unroll
                for (int m = 0; m < 4; ++m)
#pragma unroll
                    for (int n = 0; n < 2; ++n) acc[a][b][m][n] = (f32x4){0.f, 0.f, 0.f, 0.f};
        cur = nxt; cA = nA; cB = nB; ++ui;
        if constexpr (GATHER) { vc0[0] = vn0[0]; vc0[1] = vn0[1]; vc1[0] = vn1[0]; vc1[1] = vn1[1]; }
        if constexpr (ALIGN_EPI) { if (wr == 1) PG8_BAR; }
    }
    PG8_WAIT_V(0);
    if constexpr (!ALIGN_EPI) { if (wr == 0) PG8_BAR; }
    PG8_BAR;
    if constexpr (Epi::AFTER_DRAIN) { E.fused(acc, cur, wr, wc, fr, fq, lds, wid, lane); S.done(cur); }
#undef PG8_SA
#undef PG8_SB
#undef PG8_STAGE
#undef PG8_STAGE_A
#undef PG8_GROWS
#undef PG8_LDA
#undef PG8_LDB
#undef PG8_MMA
#undef PG8_WAIT_V
#undef PG8_WAIT_L
#undef PG8_BAR
#undef PG8_SCHED
}
}

namespace attn {
typedef short bf16x8 __attribute__((ext_vector_type(8)));
typedef short s16x4 __attribute__((ext_vector_type(4)));
typedef float f32x16 __attribute__((ext_vector_type(16)));
typedef unsigned u32x4 __attribute__((ext_vector_type(4)));
typedef unsigned short bf16;
constexpr int D = 128, PITCH = 1024, SEQ = 2048;
constexpr float SCALE = 0.08838834764831845f, THR = 8.f;
constexpr int NW = 8, QBLK = 32, KVBLK = 64, QB = NW * QBLK;
constexpr int SHM_V = KVBLK * D * 2, SHM_K = KVBLK * D * 2;
constexpr int BIAS_OFF = 2 * SHM_V + 2 * SHM_K + NW * 64 * 4, NBIAS = 320;
constexpr int LDS_BYTES = BIAS_OFF + NBIAS * 4;
#define KSWZ(row, colB) ((row) * 256 + ((colB) ^ (((row) & 7) << 4)))
#define SBAR() __builtin_amdgcn_sched_barrier(0)
__device__ __forceinline__ int v_st(int k, int c) { const int kk = (k & ~0xC) | ((k & 4) << 1) | ((k & 8) >> 1); return ((kk >> 3) * 4 + (c >> 5)) * 512 + ((kk & 7) * 32 + (c & 31)) * 2; }
__device__ __forceinline__ int v_rd_base(int lane) { return ((lane & 3) << 3) | (((lane >> 2) & 3) << 6) | (((lane >> 4) & 1) << 5) | (((lane >> 5) & 1) << 8); }
constexpr int v_rd_off(int d0, int ks, int half) { return d0 * 512 + ks * 4096 + half * 2048; }
__device__ __forceinline__ int crow(int r, int hi) { return (r & 3) + 8 * (r >> 2) + 4 * hi; }
__device__ __forceinline__ unsigned cvtpk(float lo, float hi) { unsigned r; asm volatile("v_cvt_pk_bf16_f32 %0, %1, %2" : "=v"(r) : "v"(lo), "v"(hi)); return r; }
__device__ __forceinline__ bf16x8 load8(const bf16* p) { return *reinterpret_cast<const bf16x8*>(p); }
__device__ __forceinline__ int t5_bucket(int rel) {
    const int b = rel > 0 ? 16 : 0; const int n = rel < 0 ? -rel : rel; int v;
    if (n < 8) v = n; else if (n < 12) v = 8; else if (n < 16) v = 9; else if (n < 23) v = 10; else if (n < 32) v = 11; else if (n < 46) v = 12; else if (n < 65) v = 13; else if (n < 91) v = 14; else v = 15;
    return b + v;
}
__device__ __forceinline__ void bias_tile(f32x16& p0, f32x16& p1, const float* tabp) {
#pragma unroll
    for (int r = 0; r < 16; ++r) { const int c = (r & 3) + 8 * (r >> 2); p0[r] += tabp[59 - c]; p1[r] += tabp[59 - c - 32]; }
}
__device__ __forceinline__ void partialSM(f32x16& p0, f32x16& p1, float& m_reg, float& mn, float& alpha) {
    float pmax = p0[0]; for (int r = 1; r < 16; ++r) pmax = fmaxf(pmax, p0[r]); for (int r = 0; r < 16; ++r) pmax = fmaxf(pmax, p1[r]);
    { auto rr = __builtin_amdgcn_permlane32_swap(__float_as_uint(pmax), __float_as_uint(pmax), false, false);
      pmax = fmaxf(__uint_as_float(rr[0]), __uint_as_float(rr[1])); }
    constexpr float C2 = 1.4426950408889634f * SCALE;
    if (__builtin_expect(__all((pmax - m_reg) * SCALE <= THR), 1)) { mn = m_reg; alpha = 1.f; }
    else { mn = fmaxf(m_reg, pmax); alpha = __builtin_amdgcn_exp2f((m_reg - mn) * C2); m_reg = mn; }
    const float mnL = -mn * C2;
    for (int r = 0; r < 16; ++r) p0[r] = fmaf(p0[r], C2, mnL); for (int r = 0; r < 16; ++r) p1[r] = fmaf(p1[r], C2, mnL);
    for (int r = 0; r < 16; ++r) p0[r] = __builtin_amdgcn_exp2f(p0[r]);
}
__device__ __forceinline__ void finishSM(f32x16& p0, f32x16& p1, float alpha, float& l_reg, bf16x8& pa0, bf16x8& pa1, bf16x8& pa2, bf16x8& pa3) {
    for (int r = 0; r < 16; ++r) p1[r] = __builtin_amdgcn_exp2f(p1[r]);
    float ps = 0; for (int r = 0; r < 16; ++r) ps += p0[r]; for (int r = 0; r < 16; ++r) ps += p1[r];
    { auto rr = __builtin_amdgcn_permlane32_swap(__float_as_uint(ps), __float_as_uint(ps), false, false);
      ps = __uint_as_float(rr[0]) + __uint_as_float(rr[1]); }
    l_reg = l_reg * alpha + ps;
#define PK4(P, B_, OUT) do { unsigned a0 = cvtpk(P[B_+0], P[B_+1]), a1 = cvtpk(P[B_+2], P[B_+3]);                          \
        unsigned b0 = cvtpk(P[B_+4], P[B_+5]), b1 = cvtpk(P[B_+6], P[B_+7]);                                             \
        auto r0 = __builtin_amdgcn_permlane32_swap(a0, b0, false, false); auto r1 = __builtin_amdgcn_permlane32_swap(a1, b1, false, false); \
        u32x4 w = {r0[0], r1[0], r0[1], r1[1]}; OUT = *reinterpret_cast<bf16x8*>(&w); } while (0)
    PK4(p0, 0, pa0); PK4(p0, 8, pa1); PK4(p1, 0, pa2); PK4(p1, 8, pa3);
#undef PK4
}
template <int KB>
__device__ __forceinline__ void qkt(f32x16& p0, f32x16& p1, const char* K_lds, int r32, int hi, const bf16x8* qr, bool act) {
    if (!act) { const float NEG = -__builtin_inff();
#pragma unroll
        for (int r = 0; r < 16; ++r) { p0[r] = NEG; p1[r] = NEG; } return; }
    p0 = f32x16{}; p1 = f32x16{};
    const char* kb[4];
#pragma unroll
    for (int dd = 0; dd < 4; ++dd) kb[dd] = K_lds + KB * SHM_K + KSWZ(r32, (dd * 16 + hi * 8) * 2);
#pragma unroll
    for (int d0 = 0; d0 < 8; ++d0) { const char* a = kb[d0 & 3] + (d0 >> 2) * 128;
        bf16x8 b0 = *reinterpret_cast<const bf16x8*>(a);
        bf16x8 b1 = *reinterpret_cast<const bf16x8*>(a + 32 * 256);
        p0 = __builtin_amdgcn_mfma_f32_32x32x16_bf16(b0, qr[d0], p0, 0, 0, 0);
        p1 = __builtin_amdgcn_mfma_f32_32x32x16_bf16(b1, qr[d0], p1, 0, 0, 0); }
}
template <int VB>
__device__ __forceinline__ void pv_tile(f32x16* o, int vb0, bf16x8 pa0, bf16x8 pa1, bf16x8 pa2, bf16x8 pa3, bool act) {
    if (!act) return;
#define TRRD(dst, off) asm volatile("ds_read_b64_tr_b16 %0, %1 offset:%2" : "=&v"(dst) : "v"(vb0), "i"(off) : "memory")
#define PV_D0(d0) do { s16x4 l0, l1, l2, l3, h0, h1, h2, h3; constexpr int b_ = VB * SHM_V + v_rd_off(d0, 0, 0); \
        TRRD(l0, b_); TRRD(h0, b_ + 2048); TRRD(l1, b_ + 4096); TRRD(h1, b_ + 6144); TRRD(l2, b_ + 8192); TRRD(h2, b_ + 10240); TRRD(l3, b_ + 12288); TRRD(h3, b_ + 14336); \
        asm volatile("s_waitcnt lgkmcnt(0)" ::: "memory"); SBAR();   \
        o[d0] = __builtin_amdgcn_mfma_f32_32x32x16_bf16(pa0, (bf16x8){l0[0], l0[1], l0[2], l0[3], h0[0], h0[1], h0[2], h0[3]}, o[d0], 0, 0, 0);   \
        o[d0] = __builtin_amdgcn_mfma_f32_32x32x16_bf16(pa1, (bf16x8){l1[0], l1[1], l1[2], l1[3], h1[0], h1[1], h1[2], h1[3]}, o[d0], 0, 0, 0);   \
        o[d0] = __builtin_amdgcn_mfma_f32_32x32x16_bf16(pa2, (bf16x8){l2[0], l2[1], l2[2], l2[3], h2[0], h2[1], h2[2], h2[3]}, o[d0], 0, 0, 0);   \
        o[d0] = __builtin_amdgcn_mfma_f32_32x32x16_bf16(pa3, (bf16x8){l3[0], l3[1], l3[2], l3[3], h3[0], h3[1], h3[2], h3[3]}, o[d0], 0, 0, 0); } while (0)
    PV_D0(0); PV_D0(1); PV_D0(2); PV_D0(3);
#undef PV_D0
#undef TRRD
}
struct BlockRef { const bf16* Q; const bf16* K; const bf16* V; bf16* O; int P0; };
struct Seam { bf16x8 qr[8]; bf16x8 st_v0, st_v1, st_k0, st_k1; };
#define ROW(p, k0, rr) ((p) + (size_t)((k0) + (rr)) * PITCH + sc)
#define VMW() asm volatile("s_waitcnt vmcnt(0)" ::: "memory")
#define VMWN(n) asm volatile("s_waitcnt vmcnt(%0)" :: "i"(n) : "memory")
#define SLOAD_H(Kp, Vp, k0) do { S.st_v0 = load8(ROW(Vp, k0, sr)); S.st_v1 = load8(ROW(Vp, k0, 32 + sr)); S.st_k0 = load8(ROW(Kp, k0, sr)); S.st_k1 = load8(ROW(Kp, k0, 32 + sr)); } while (0)
#define SWRITE_HK(bf) do { *(bf16x8*)(K_lds + (bf) * SHM_K + kws) = S.st_k0; *(bf16x8*)(K_lds + (bf) * SHM_K + kws + 32 * 256) = S.st_k1; } while (0)
#define SWRITE_HV(bf) do { *(bf16x8*)(V_lds + (bf) * SHM_V + vst0) = S.st_v0; *(bf16x8*)(V_lds + (bf) * SHM_V + vst1) = S.st_v1; } while (0)
#define SWRITE_H(bf) do { SWRITE_HV(bf); SWRITE_HK(bf); } while (0)
__device__ __forceinline__ void attn_prime(const BlockRef& cur, char* lds, Seam& S) {
    const int tid = threadIdx.x, wid = __builtin_amdgcn_readfirstlane(tid >> 6), lane = tid & 63, r32 = lane & 31, hi = lane >> 5;
    const int sr = tid >> 4, sc = (tid & 15) * 8, kws = KSWZ(sr, sc * 2); char* K_lds = lds + 2 * SHM_V;
#pragma unroll
    for (int d0 = 0; d0 < 8; ++d0) S.qr[d0] = load8(cur.Q + (size_t)(wid * QBLK + r32) * PITCH + d0 * 16 + hi * 8);
    SLOAD_H(cur.K, cur.V, 0); VMW(); SWRITE_HK(0);
    __syncthreads();
}
__device__ __forceinline__ void attn_block(const BlockRef& cur, const BlockRef& nxt, char* lds, Seam& S) {
    const int tid = threadIdx.x, wid = __builtin_amdgcn_readfirstlane(tid >> 6), lane = tid & 63, r32 = lane & 31, hi = lane >> 5;
    const int NT = cur.P0 / KVBLK + QB / KVBLK;
    const int qlo = cur.P0 + wid * QBLK, cw = qlo >> 6;
    char* V_lds = lds; char* K_lds = lds + 2 * SHM_V;
    float* ws = (float*)(lds + 2 * SHM_V + 2 * SHM_K) + wid * 64; float* li_l = ws, * al_l = ws + 32;
    const float* btab = (const float*)(lds + BIAS_OFF);
    float m_reg = -1e30f, l_reg = 0; f32x16 o[4] = {};
    const int sr = tid >> 4, sc = (tid & 15) * 8, vst0 = v_st(sr, sc), vst1 = v_st(32 + sr, sc), kws = KSWZ(sr, sc * 2);
    const int vb0 = (int)(uintptr_t)V_lds + v_rd_base(lane);
    const bf16* Kh = cur.K; const bf16* Vh = cur.V;
    const int bb0 = qlo + r32 - 4 * hi + 4;
#define RESC(a) do { if (__any((a) < 1.f)) { if (hi == 0) al_l[r32] = (a); asm volatile("s_waitcnt lgkmcnt(0)" ::: "memory");              \
                     for (int d_ = 0; d_ < 4; ++d_) for (int r = 0; r < 16; ++r) o[d_][r] *= al_l[crow(r, hi)]; } } while (0)
#define KBASE(t) ((t) * KVBLK)
#define ACT(t) ((t) <= cw)
#define BIAST(P0_, P1_, t) do { if ((t) <= cw && (t) + 2 >= cw) bias_tile(P0_, P1_, btab + (bb0 - KBASE(t))); } while (0)
    constexpr int NQL = 8;
#define SEAM_K0() do { VMWN(NQL); SWRITE_HK(0); SBAR(); } while (0)
    f32x16 pA0, pA1, pB0, pB1; float mnA, mnB, alA, alB; bf16x8 pa0, pa1, pa2, pa3;
    SWRITE_HV(0); SBAR();
    SLOAD_H(Kh, Vh, KBASE(1));
    SBAR(); qkt<0>(pA0, pA1, K_lds, r32, hi, S.qr, ACT(0));
    BIAST(pA0, pA1, 0); partialSM(pA0, pA1, m_reg, mnA, alA);
    VMW(); SWRITE_H(1);
    __syncthreads();
#define HALF_STEP(PX0, PX1, mnX, alX, PY0, PY1, alY, t, KB, VB, SB) do {                                                      \
        SBAR(); qkt<KB>(PX0, PX1, K_lds, r32, hi, S.qr, ACT(t));                                                 \
        finishSM(PY0, PY1, alY, l_reg, pa0, pa1, pa2, pa3); SBAR();                                                           \
        if ((t) + 1 < NT) { SLOAD_H(Kh, Vh, KBASE((t) + 1)); SBAR(); }                                                         \
        pv_tile<VB>(o, vb0, pa0, pa1, pa2, pa3, ACT((t) - 1)); BIAST(PX0, PX1, (t)); partialSM(PX0, PX1, m_reg, mnX, alX);    \
        __syncthreads();                                                                                                      \
        if ((t) + 1 < NT) { VMW(); SWRITE_H(SB); }                                                                             \
        RESC(alX); __syncthreads(); } while (0)
    for (int t = 1; t + 1 < NT; t += 2) {
        HALF_STEP(pB0, pB1, mnB, alB, pA0, pA1, alA, t, 1, 0, 0);
        HALF_STEP(pA0, pA1, mnA, alA, pB0, pB1, alB, t + 1, 0, 1, 1);
    }
    { SBAR(); qkt<1>(pB0, pB1, K_lds, r32, hi, S.qr, ACT(NT - 1)); SBAR(); }
    SLOAD_H(nxt.K, nxt.V, 0); SBAR();
#pragma unroll
    for (int d0 = 0; d0 < 8; ++d0) S.qr[d0] = load8(nxt.Q + (size_t)(wid * QBLK + r32) * PITCH + d0 * 16 + hi * 8);
    SBAR();
    finishSM(pA0, pA1, alA, l_reg, pa0, pa1, pa2, pa3); SBAR();
    pv_tile<0>(o, vb0, pa0, pa1, pa2, pa3, ACT(NT - 2));
    { BIAST(pB0, pB1, NT - 1); partialSM(pB0, pB1, m_reg, mnB, alB); __syncthreads(); RESC(alB);
      finishSM(pB0, pB1, alB, l_reg, pa0, pa1, pa2, pa3); SBAR(); pv_tile<1>(o, vb0, pa0, pa1, pa2, pa3, ACT(NT - 1)); }
    SBAR(); SEAM_K0();
    if (hi == 0) li_l[r32] = l_reg; asm volatile("s_waitcnt lgkmcnt(0)" ::: "memory");
    float rli[16];
#pragma unroll
    for (int r = 0; r < 16; ++r) rli[r] = __builtin_amdgcn_rcpf(li_l[crow(r, hi)]);
    bf16* Ow = cur.O + (size_t)(wid * QBLK) * PITCH;
#pragma unroll
    for (int r = 0; r < 16; ++r) { const int orow = crow(r, hi);
#pragma unroll
        for (int d0 = 0; d0 < 4; ++d0) { const float v = o[d0][r] * rli[r];
            const float vn = __shfl_xor(v, 1);
            if ((r32 & 1) == 0) *(unsigned*)(Ow + (size_t)orow * PITCH + d0 * 32 + r32) = cvtpk(v, vn); } }
    __syncthreads();
#undef RESC
#undef KBASE
#undef ACT
#undef BIAST
#undef SEAM_K0
#undef HALF_STEP
}
#undef ROW
#undef VMW
#undef VMWN
#undef SLOAD_H
#undef SWRITE_HK
#undef SWRITE_HV
#undef SWRITE_H
#undef KSWZ
}

namespace attn2 {
using attn::bf16x8; using attn::s16x4; using attn::f32x16; using attn::u32x4; using attn::bf16;
using attn::v_st; using attn::v_rd_base; using attn::crow; using attn::cvtpk; using attn::load8; using attn::t5_bucket;
constexpr int D = 128, PITCH = 1024;
constexpr float SCALE = 0.08838834764831845f, THR = 8.f;
constexpr int NW = 8, QBLK = 32, KVBLK = 64, QB = 4 * QBLK;
constexpr int IMG = KVBLK * D * 2, SHM_V = 2 * IMG, SHM_K = KVBLK * D * 2;
constexpr int OFF_V = 0, OFF_K = 2 * SHM_V, OFF_PX = OFF_K + 2 * SHM_K, OFF_WS = OFF_PX + NW * 2048, OFF_MX = OFF_WS + NW * 64 * 4, BIAS_OFF = OFF_MX + NW * 32 * 4, NBIAS = 320;
constexpr int LDS_BYTES = BIAS_OFF + NBIAS * 4;
#define KSWZ(row, colB) ((row) * 256 + ((colB) ^ (((row) & 7) << 4)))
#define SBAR() __builtin_amdgcn_sched_barrier(0)
#define L3 __attribute__((address_space(3)))
#define LP(T, byteoff) ((L3 T*)(uintptr_t)(unsigned)(byteoff))
__device__ __forceinline__ void bias_half(f32x16& p, const L3 float* tabp) {
#pragma unroll
    for (int r = 0; r < 16; ++r) { const int c = (r & 3) + 8 * (r >> 2); p[r] += tabp[59 - c]; }
}
__device__ __forceinline__ float rowmax_half(const f32x16& p) {
    float pmax = p[0];
#pragma unroll
    for (int r = 1; r < 16; ++r) pmax = fmaxf(pmax, p[r]);
    const auto rr = __builtin_amdgcn_permlane32_swap(__float_as_uint(pmax), __float_as_uint(pmax), false, false);
    return fmaxf(__uint_as_float(rr[0]), __uint_as_float(rr[1]));
}
__device__ __forceinline__ void partialSM(f32x16& p, float pmax, float& m_reg, float& alpha) {
    constexpr float C2 = 1.4426950408889634f * SCALE; float mn;
    if (__builtin_expect(__all((pmax - m_reg) * SCALE <= THR), 1)) { mn = m_reg; alpha = 1.f; }
    else { mn = fmaxf(m_reg, pmax); alpha = __builtin_amdgcn_exp2f((m_reg - mn) * C2); m_reg = mn; }
    const float mnL = -mn * C2;
#pragma unroll
    for (int r = 0; r < 16; ++r) p[r] = fmaf(p[r], C2, mnL);
#pragma unroll
    for (int r = 0; r < 8; ++r) p[r] = __builtin_amdgcn_exp2f(p[r]);
}
__device__ __forceinline__ void finishSM(f32x16& p, float alpha, float& l_reg, bf16x8& pa0, bf16x8& pa1) {
#pragma unroll
    for (int r = 8; r < 16; ++r) p[r] = __builtin_amdgcn_exp2f(p[r]);
    float ps = 0;
#pragma unroll
    for (int r = 0; r < 16; ++r) ps += p[r];
    { const auto rr = __builtin_amdgcn_permlane32_swap(__float_as_uint(ps), __float_as_uint(ps), false, false); ps = __uint_as_float(rr[0]) + __uint_as_float(rr[1]); }
    l_reg = l_reg * alpha + ps;
#define PK4(P, B_, OUT) do { unsigned a0 = cvtpk(P[B_+0], P[B_+1]), a1 = cvtpk(P[B_+2], P[B_+3]);                          \
        unsigned b0 = cvtpk(P[B_+4], P[B_+5]), b1 = cvtpk(P[B_+6], P[B_+7]);                                             \
        auto r0 = __builtin_amdgcn_permlane32_swap(a0, b0, false, false); auto r1 = __builtin_amdgcn_permlane32_swap(a1, b1, false, false); \
        u32x4 w = {r0[0], r1[0], r0[1], r1[1]}; OUT = *reinterpret_cast<bf16x8*>(&w); } while (0)
    PK4(p, 0, pa0); PK4(p, 8, pa1);
#undef PK4
}
template <int KB>
__device__ __forceinline__ void qkt(f32x16& p, unsigned K_lds, int krow, int hi, const bf16x8* qr, bool act) {
    if (!act) { const float NEG = -__builtin_inff();
#pragma unroll
        for (int r = 0; r < 16; ++r) p[r] = NEG; return; }
    p = f32x16{};
    unsigned kb[4];
#pragma unroll
    for (int dd = 0; dd < 4; ++dd) kb[dd] = K_lds + KB * SHM_K + KSWZ(krow, (dd * 16 + hi * 8) * 2);
#pragma unroll
    for (int d0 = 0; d0 < 8; ++d0) { const bf16x8 b = *LP(const bf16x8, kb[d0 & 3] + (d0 >> 2) * 128); p = __builtin_amdgcn_mfma_f32_32x32x16_bf16(b, qr[d0], p, 0, 0, 0); }
}
template <int VB>
__device__ __forceinline__ void pv_tile(f32x16* o, int vbo, int vbp, bf16x8 po0, bf16x8 po1, bf16x8 pp0, bf16x8 pp1, bool act) {
    if (!act) return;
#define TRRD(dst, base, off) asm volatile("ds_read_b64_tr_b16 %0, %1 offset:%2" : "=&v"(dst) : "v"(base), "i"(off) : "memory")
#define PV_D0(d0) do { s16x4 l0, l1, l2, l3, h0, h1, h2, h3; constexpr int b_ = VB * SHM_V + (d0) * 512; \
        TRRD(l0, vbo, b_); TRRD(h0, vbo, b_ + 2048); TRRD(l1, vbo, b_ + 4096); TRRD(h1, vbo, b_ + 6144); TRRD(l2, vbp, b_); TRRD(h2, vbp, b_ + 2048); TRRD(l3, vbp, b_ + 4096); TRRD(h3, vbp, b_ + 6144); \
        asm volatile("s_waitcnt lgkmcnt(0)" ::: "memory"); SBAR();   \
        o[d0] = __builtin_amdgcn_mfma_f32_32x32x16_bf16(po0, (bf16x8){l0[0], l0[1], l0[2], l0[3], h0[0], h0[1], h0[2], h0[3]}, o[d0], 0, 0, 0);   \
        o[d0] = __builtin_amdgcn_mfma_f32_32x32x16_bf16(po1, (bf16x8){l1[0], l1[1], l1[2], l1[3], h1[0], h1[1], h1[2], h1[3]}, o[d0], 0, 0, 0);   \
        o[d0] = __builtin_amdgcn_mfma_f32_32x32x16_bf16(pp0, (bf16x8){l2[0], l2[1], l2[2], l2[3], h2[0], h2[1], h2[2], h2[3]}, o[d0], 0, 0, 0);   \
        o[d0] = __builtin_amdgcn_mfma_f32_32x32x16_bf16(pp1, (bf16x8){l3[0], l3[1], l3[2], l3[3], h3[0], h3[1], h3[2], h3[3]}, o[d0], 0, 0, 0); } while (0)
    PV_D0(0); PV_D0(1); PV_D0(2); PV_D0(3);
#undef PV_D0
#undef TRRD
}
struct BlockRef { const bf16* Q; const bf16* K; const bf16* V; bf16* O; int P0; };
struct Seam { bf16x8 qr[8]; bf16x8 st_k0, st_k1, st_v0, st_v1, st_v2, st_v3; };
#define ROW(p, k0, rr) ((p) + (((k0) + (rr)) * PITCH + sc))
#define VMW() asm volatile("s_waitcnt vmcnt(0)" ::: "memory")
#define VMWN(n) asm volatile("s_waitcnt vmcnt(%0)" :: "i"(n) : "memory")
#define SLOAD(Kp, Vp, k0) do { S.st_k0 = load8(ROW(Kp, k0, sr)); S.st_k1 = load8(ROW(Kp, k0, 32 + sr)); S.st_v0 = load8(ROW(Vp, k0, sr)); S.st_v1 = load8(ROW(Vp, k0, 32 + sr)); \
                               S.st_v2 = load8(ROW(Vp, k0, sr) + 128); S.st_v3 = load8(ROW(Vp, k0, 32 + sr) + 128); } while (0)
#define SWRITE_K(bf) do { *LP(bf16x8, K_lds + (bf) * SHM_K + kws) = S.st_k0; *LP(bf16x8, K_lds + (bf) * SHM_K + kws + 32 * 256) = S.st_k1; } while (0)
#define SWRITE_V(bf) do { *LP(bf16x8, V_lds + (bf) * SHM_V + vst0) = S.st_v0; *LP(bf16x8, V_lds + (bf) * SHM_V + vst0 + VST1) = S.st_v1; *LP(bf16x8, V_lds + (bf) * SHM_V + IMG + vst0) = S.st_v2; *LP(bf16x8, V_lds + (bf) * SHM_V + IMG + vst0 + VST1) = S.st_v3; } while (0)
__device__ __forceinline__ void attn_prime(const BlockRef& cur, char* lds, Seam& S) {
    const int tid = threadIdx.x, wid = __builtin_amdgcn_readfirstlane(tid >> 6), lane = tid & 63, r32 = lane & 31, hi = lane >> 5, pj = wid & 3;
    const int sr = tid >> 4, sc = (tid & 15) * 8, kws = KSWZ(sr, sc * 2); const unsigned K_lds = (unsigned)(uintptr_t)lds + OFF_K;
#pragma unroll
    for (int d0 = 0; d0 < 8; ++d0) S.qr[d0] = load8(cur.Q + ((pj * QBLK + r32) * PITCH + d0 * 16 + hi * 8));
    SLOAD(cur.K, cur.V, 0); VMW(); SWRITE_K(0);
    __syncthreads();
}
__device__ __forceinline__ void attn_block(const BlockRef& cur, const BlockRef& nxt, char* lds, Seam& S) {
    const int tid = threadIdx.x, wid = __builtin_amdgcn_readfirstlane(tid >> 6), lane = tid & 63, r32 = lane & 31, hi = lane >> 5, pj = wid & 3, kh = wid >> 2, pw = wid ^ 4;
    const int NT = cur.P0 / KVBLK + QB / KVBLK;
    const int qlo = cur.P0 + pj * QBLK, cw = qlo >> 6;
    const unsigned L = (unsigned)(uintptr_t)lds, V_lds = L + OFF_V, K_lds = L + OFF_K;
    L3 float* li_l = LP(float, L + OFF_WS + wid * 256); L3 float* al_l = li_l + 32; const L3 float* li_p = LP(const float, L + OFF_WS + pw * 256);
    L3 float* mx_o = LP(float, L + OFF_MX + wid * 128); const L3 float* mx_p = LP(const float, L + OFF_MX + pw * 128);
    const unsigned px_o = L + OFF_PX + wid * 2048 + lane * 16, px_p = L + OFF_PX + pw * 2048 + lane * 16;
    const L3 float* btab = LP(const float, L + BIAS_OFF);
    float m_reg = -1e30f, l_reg = 0; f32x16 o[4] = {};
    const int sr = tid >> 4, sc = (tid & 15) * 8, vst0 = v_st(sr, sc), kws = KSWZ(sr, sc * 2); constexpr int VST1 = 8192;
    const int vbase = (int)V_lds + v_rd_base(lane) + kh * IMG, vbo = vbase + kh * 8192, vbp = vbase + (1 - kh) * 8192;
    const int krow = kh * 32 + r32;
    const bf16* Kh = cur.K; const bf16* Vh = cur.V;
    const int bb0 = qlo + r32 - 4 * hi + 4 - 32 * kh;
#define RESC(a) do { if (__any((a) < 1.f)) { if (hi == 0) al_l[r32] = (a); asm volatile("s_waitcnt lgkmcnt(0)" ::: "memory");              \
                     for (int d_ = 0; d_ < 4; ++d_) for (int r = 0; r < 16; ++r) o[d_][r] *= al_l[crow(r, hi)]; } } while (0)
#define KBASE(t) ((t) * KVBLK)
#define ACT(t) ((t) <= cw)
#define BIAST(P_, t) do { if ((t) <= cw && (t) + 2 >= cw) bias_half(P_, btab + (bb0 - KBASE(t))); } while (0)
#define PUTMAX(P_) do { const float pm_ = rowmax_half(P_); if (hi == 0) mx_o[r32] = pm_; pmx = pm_; } while (0)
#define GETMAX() fmaxf(pmx, mx_p[r32])
    f32x16 pA, pB; float alA, alB, pmx; bf16x8 po0, po1, pp0, pp1;
    SWRITE_V(0); SBAR();
    SLOAD(Kh, Vh, KBASE(1));
    SBAR(); qkt<0>(pA, K_lds, krow, hi, S.qr, ACT(0));
    BIAST(pA, 0); PUTMAX(pA);
    __syncthreads();
    partialSM(pA, GETMAX(), m_reg, alA);
    VMW(); SWRITE_K(1);
    __syncthreads();
#define STEP(PX_, alX, PY_, alY, t, KB, VBP) do {                                                                                  \
        SBAR(); SWRITE_V(KB); SBAR();                                                                                              \
        if ((t) + 1 < NT) { SLOAD(Kh, Vh, KBASE((t) + 1)); SBAR(); }                                                                \
        qkt<KB>(PX_, K_lds, krow, hi, S.qr, ACT(t));                                                                               \
        finishSM(PY_, alY, l_reg, po0, po1); *LP(bf16x8, px_o) = po0; *LP(bf16x8, px_o + 1024) = po1; SBAR();                           \
        BIAST(PX_, (t)); PUTMAX(PX_);                                                                                               \
        __syncthreads();                                                                                                           \
        pp0 = *LP(const bf16x8, px_p); pp1 = *LP(const bf16x8, px_p + 1024);                                                        \
        partialSM(PX_, GETMAX(), m_reg, alX);                                                                                      \
        pv_tile<VBP>(o, vbo, vbp, po0, po1, pp0, pp1, ACT((t) - 1));                                                               \
        if ((t) + 1 < NT) { VMWN(4); SWRITE_K(VBP); }                                                                               \
        RESC(alX); __syncthreads(); } while (0)
    for (int t = 1; t + 1 < NT; t += 2) {
        STEP(pB, alB, pA, alA, t, 1, 0);
        STEP(pA, alA, pB, alB, t + 1, 0, 1);
    }
    STEP(pB, alB, pA, alA, NT - 1, 1, 0);
    SLOAD(nxt.K, nxt.V, 0); SBAR();
#pragma unroll
    for (int d0 = 0; d0 < 8; ++d0) S.qr[d0] = load8(nxt.Q + ((pj * QBLK + r32) * PITCH + d0 * 16 + hi * 8));
    SBAR();
    finishSM(pB, alB, l_reg, po0, po1); *LP(bf16x8, px_o) = po0; *LP(bf16x8, px_o + 1024) = po1;
    if (hi == 0) li_l[r32] = l_reg;
    __syncthreads();
    pp0 = *LP(const bf16x8, px_p); pp1 = *LP(const bf16x8, px_p + 1024);
    pv_tile<1>(o, vbo, vbp, po0, po1, pp0, pp1, ACT(NT - 1));
    SBAR(); VMWN(8); SWRITE_K(0); SBAR();
    float rli[16];
#pragma unroll
    for (int r = 0; r < 16; ++r) rli[r] = __builtin_amdgcn_rcpf(li_l[crow(r, hi)] + li_p[crow(r, hi)]);
    int lane_off = hi * 4 * PITCH + r32; asm volatile("" : "+v"(lane_off));
    bf16* Ow = cur.O + ((pj * QBLK) * PITCH + kh * 128 + lane_off);
#pragma unroll
    for (int r = 0; r < 16; ++r) { constexpr int dummy = 0; const int orow = (r & 3) + 8 * (r >> 2) + dummy;
#pragma unroll
        for (int d0 = 0; d0 < 4; ++d0) { const float v = o[d0][r] * rli[r];
            const float vn = __shfl_xor(v, 1);
            if ((r32 & 1) == 0) *(unsigned*)(Ow + (orow * PITCH + d0 * 32)) = cvtpk(v, vn); } }
    __syncthreads();
#undef RESC
#undef KBASE
#undef ACT
#undef BIAST
#undef PUTMAX
#undef GETMAX
#undef STEP
}
#undef ROW
#undef VMW
#undef VMWN
#undef SLOAD
#undef SWRITE_K
#undef SWRITE_V
#undef KSWZ
#undef L3
#undef LP
}


constexpr int NWAVES = 8;
constexpr int BATCH = 16, SEQ = 2048, T = BATCH * SEQ, D = 1024, NIN = 8192, NE = 32, DE = 512;
constexpr int MAXT = 288, MAXS = MAXT * 256;
constexpr float LN_EPS = 1e-5f, RMS_EPS = 1e-6f, ALPHA = 1.189207115002721f, LAM_INIT = 0.2f;
constexpr size_t MiB = 1u << 20;
constexpr size_t WS_CTL = 0, CTL_ZERO_BYTES = 1 * MiB;
constexpr size_t WS_STATS = 1 * MiB, WS_EID = WS_STATS + 256 * 1024, WS_EW = WS_EID + 256 * 1024, WS_RANK = WS_EW + 256 * 1024, WS_SLOT = 2 * MiB, WS_CNTWG = WS_SLOT + 256 * 1024, WS_TOK = 3 * MiB;
constexpr size_t WS_WA = 4 * MiB, WS_WB = 6 * MiB, WS_WO = 8 * MiB, WS_WIN = 10 * MiB;
constexpr size_t WS_XN = 26 * MiB, WS_Q = 90 * MiB, WS_K = 154 * MiB, WS_V = 218 * MiB, WS_CB = 282 * MiB, WS_Z = 346 * MiB, WS_O1 = 410 * MiB;
constexpr size_t WS_WGU = 90 * MiB, WS_WD = 154 * MiB, WS_PRE = 186 * MiB, WS_XG = 314 * MiB, WS_END = 458 * MiB;
constexpr int CW_TMO = 0, CW_CODE = 1, CW_BAR = 4096;
constexpr int RING_OFF = 0, RING_BYTES = 131072, RW_BYTES = 147456;
constexpr int LDSCTL_OFF = RW_BYTES, MISC_OFF = LDSCTL_OFF + 320, TAB_OFF = LDSCTL_OFF + 512, RSCR_OFF = LDSCTL_OFF + 1024;
constexpr int LDS_BYTES = 163840;
static_assert(RSCR_OFF + 8 * 128 * 4 + 1024 <= LDS_BYTES, "LDS map");

#define GAS __attribute__((address_space(1)))
#define LAS __attribute__((address_space(3)))
typedef unsigned short bf16;
#ifdef SWAP_CB_SGA
#define BUF_CB(P)  ((bf16*)(P).out)
#define BUF_SGA(P) ((bf16*)((P).ws + WS_CB))
#else
#define BUF_CB(P)  ((bf16*)((P).ws + WS_CB))
#define BUF_SGA(P) ((bf16*)(P).out)
#endif
#define BUF_SGB(P) ((bf16*)(P).out + (size_t)T * D)
typedef unsigned v4u __attribute__((ext_vector_type(4)));
typedef unsigned v2u __attribute__((ext_vector_type(2)));
typedef float f32x4 __attribute__((ext_vector_type(4)));
typedef GAS unsigned gu32;
#define RLX_AGENT __ATOMIC_RELAXED, __HIP_MEMORY_SCOPE_AGENT
#define LDS_WAIT() asm volatile("s_waitcnt lgkmcnt(0)" ::: "memory")
#define VM_WAIT() asm volatile("s_waitcnt vmcnt(0)" ::: "memory")
__device__ __forceinline__ unsigned f2bf(float f) { unsigned u = __builtin_bit_cast(unsigned, f); return (u + 0x7fffu + ((u >> 16) & 1u)) >> 16; }
__device__ __forceinline__ unsigned pk2(float lo, float hi) { return f2bf(lo) | (f2bf(hi) << 16); }
__device__ __forceinline__ float bflo(unsigned w) { return __uint_as_float(w << 16); }
__device__ __forceinline__ float bfhi(unsigned w) { return __uint_as_float(w & 0xffff0000u); }

#define XB_TMO      128
#define XB_XCNT(j)  (256  + 64 * (j))
#define XB_XSUB(j)  (1280 + 64 * (j))
#define XB_XGEN(j)  (2304 + 64 * (j))
#define XB_TOP      3328
#define XB_TOPGEN   3392
#define XCD_BAR_WORDS 3456
#define XB_SPIN_CAP (1u << 18)
__device__ __forceinline__ unsigned xb_ld(unsigned* p)              { return __hip_atomic_load(p, __ATOMIC_RELAXED, __HIP_MEMORY_SCOPE_AGENT); }
__device__ __forceinline__ unsigned xb_add(unsigned* p, unsigned v) { return __hip_atomic_fetch_add(p, v, __ATOMIC_RELAXED, __HIP_MEMORY_SCOPE_AGENT); }
__device__ __forceinline__ unsigned xb_xcc_id() { return (unsigned)__builtin_amdgcn_s_getreg((3 << 11) | 20) & 0xFu; }
#define XB_SPIN(cond, bar) do { unsigned _sp = 0; while (cond) { __builtin_amdgcn_s_sleep(1); \
    if ((++_sp & 255u) == 0u) { if (xb_ld(&(bar)[XB_TMO])) break; if (_sp > XB_SPIN_CAP) { atomicAdd(&(bar)[XB_TMO], 1u); break; } } } } while (0)
struct XcdBarrier { unsigned* bar; unsigned x; volatile LAS unsigned* st; };
__device__ __forceinline__ XcdBarrier xcd_barrier_post(unsigned* bar, volatile LAS unsigned* st) {
    XcdBarrier b; b.bar = bar; b.x = xb_xcc_id(); b.st = st;
    if (threadIdx.x == 0) (void)xb_add(&bar[XB_XCNT(b.x)], 1u);
    return b;
}
__device__ __forceinline__ void xcd_barrier_complete(unsigned* bar, unsigned x, unsigned& nloc, unsigned& nx) {
    const unsigned G = gridDim.x * gridDim.y * gridDim.z;
    unsigned sum, cnt, mine, sp = 0u;
    for (;;) {
        sum = 0u; cnt = 0u; mine = 0u;
#pragma unroll
        for (unsigned j = 0; j < 16; ++j) { const unsigned c = xb_ld(&bar[XB_XCNT(j)]); sum += c; cnt += (c > 0u) ? 1u : 0u; mine = (j == x) ? c : mine; }
        if (sum == G) break;
        __builtin_amdgcn_s_sleep(1);
        if ((++sp & 255u) == 0u) { if (xb_ld(&bar[XB_TMO])) break; if (sp > XB_SPIN_CAP) { atomicAdd(&bar[XB_TMO], 1u); break; } }
    }
    nloc = mine > 0u ? mine : 1u; nx = cnt > 0u ? cnt : 1u;
}
__device__ __forceinline__ void xcd_barrier(const XcdBarrier& b) {
    asm volatile("s_waitcnt vmcnt(0)" ::: "memory");
    __syncthreads();
    if (threadIdx.x == 0) {
        unsigned* bar = b.bar;
        __builtin_amdgcn_s_waitcnt(0);
        unsigned nloc = b.st[0], nx = b.st[1];
        if (nloc == 0u) { xcd_barrier_complete(bar, b.x, nloc, nx); b.st[0] = nloc; b.st[1] = nx; }
        const unsigned old = xb_add(&bar[XB_XSUB(b.x)], 1u);
        const unsigned gen = old / nloc;
        if (old + 1u == (gen + 1u) * nloc) {
            __builtin_amdgcn_fence(__ATOMIC_RELEASE, "agent");
            asm volatile("s_waitcnt vmcnt(0)" ::: "memory");
            const unsigned og = xb_add(&bar[XB_TOP], 1u);
            const unsigned tg = og / nx;
            if (og + 1u == (tg + 1u) * nx) xb_add(&bar[XB_TOPGEN], 1u);
            else XB_SPIN(xb_ld(&bar[XB_TOPGEN]) == tg, bar);
            __builtin_amdgcn_fence(__ATOMIC_ACQUIRE, "agent");
            xb_add(&bar[XB_XGEN(b.x)], 1u);
            asm volatile("s_waitcnt vmcnt(0)" ::: "memory");
        } else {
            XB_SPIN(xb_ld(&bar[XB_XGEN(b.x)]) == gen, bar);
            __builtin_amdgcn_fence(__ATOMIC_ACQUIRE, "agent");
            asm volatile("s_waitcnt vmcnt(0)" ::: "memory");
        }
    }
    __syncthreads();
}

struct Frame {
    LAS unsigned char* lds; volatile LAS unsigned* MISC; gu32* ctl;
    int tid, lane, wave, vcu, G;
};
__device__ __forceinline__ float wave_sum(float v) {
#pragma unroll
    for (int o = 1; o < 64; o <<= 1) v += __shfl_xor(v, o);
    return v;
}
__device__ __forceinline__ void transpose_item(const float* W, int K, int N, int k0, int n0, bf16* WT, int drow0, LAS float* scr, int lane) {
#pragma unroll 8
    for (int i = 0; i < 32; ++i) { const int kk = 2 * i + (lane >> 5); scr[kk * 33 + (lane & 31)] = W[(size_t)(k0 + kk) * N + n0 + (lane & 31)]; }
    LDS_WAIT(); asm volatile("" ::: "memory");
    const int c = lane & 7;
#pragma unroll
    for (int j = 0; j < 4; ++j) { const int n = (lane >> 3) + 8 * j; const LAS float* s = scr + (8 * c) * 33 + n;
        v4u o; o.x = pk2(s[0 * 33], s[1 * 33]); o.y = pk2(s[2 * 33], s[3 * 33]); o.z = pk2(s[4 * 33], s[5 * 33]); o.w = pk2(s[6 * 33], s[7 * 33]);
        *(GAS v4u*)(WT + (size_t)(drow0 + n) * K + k0 + 8 * c) = o; }
    LDS_WAIT(); asm volatile("" ::: "memory");
}
__device__ __forceinline__ int win_drow(int n0) {
    if (n0 < 4096 || n0 >= 6144) return n0;
    if (n0 < 5120) { const int r = n0 - 4096; return 4096 + 256 * (r >> 7) + (r & 127); }
    const int r = n0 - 5120; return 4096 + 256 * (r >> 7) + 128 + (r & 127);
}
struct Ptrs {
    const float *x, *ln_in_g, *ln_in_b, *w_in, *b_gate, *lq, *lk, *subln_g, *rel_bias, *conv_w, *w_a, *w_b, *w_o, *ln1_g, *ln1_b, *w_group, *b_group, *w_sub, *b_sub, *w_gate_e, *w_up_e, *w_down_e, *ln2_g, *ln2_b;
    float* out; unsigned char* ws;
};
__device__ __forceinline__ void p0_prologue(Frame& F, const Ptrs& P) {
    LAS float* scr = (LAS float*)(F.lds + RING_OFF + F.wave * 16384);
    const int gw = F.vcu * NWAVES + F.wave, NGW = F.G * NWAVES;
    constexpr int I_IN = (D / 64) * (NIN / 32), I_SQ = (D / 64) * (D / 32);
    bf16* Wt_in = (bf16*)(P.ws + WS_WIN); bf16* Wt_a = (bf16*)(P.ws + WS_WA); bf16* Wt_b = (bf16*)(P.ws + WS_WB); bf16* Wt_o = (bf16*)(P.ws + WS_WO);
    for (int it = gw; it < I_IN + 3 * I_SQ; it += NGW) {
        int r = it;
        if (r < I_IN) { const int kb = r / (NIN / 32), nb = r % (NIN / 32); transpose_item(P.w_in, D, NIN, 64 * kb, 32 * nb, Wt_in, win_drow(32 * nb), scr, F.lane); continue; } r -= I_IN;
        const int which = r / I_SQ; r -= which * I_SQ; const int kb = r / (D / 32), nb = r % (D / 32);
        const float* W = which == 0 ? P.w_a : (which == 1 ? P.w_b : P.w_o); bf16* WT = which == 0 ? Wt_a : (which == 1 ? Wt_b : Wt_o);
        transpose_item(W, D, D, 64 * kb, 32 * nb, WT, 32 * nb, scr, F.lane);
    }
    bf16* XN = (bf16*)(P.ws + WS_XN); float* stats = (float*)(P.ws + WS_STATS);
    for (int m = gw; m < T; m += NGW) {
        const GAS f32x4* xr = (const GAS f32x4*)(P.x + (size_t)m * D) + F.lane;
        f32x4 v[4]; float s = 0.f;
#pragma unroll
        for (int j = 0; j < 4; ++j) { v[j] = xr[64 * j]; s += (v[j].x + v[j].y) + (v[j].z + v[j].w); }
        const float mean = wave_sum(s) * (1.f / D); float s2 = 0.f;
#pragma unroll
        for (int j = 0; j < 4; ++j) { v[j] = v[j] - mean; s2 += (v[j].x * v[j].x + v[j].y * v[j].y) + (v[j].z * v[j].z + v[j].w * v[j].w); }
        const float rstd = 1.f / sqrtf(wave_sum(s2) * (1.f / D) + LN_EPS);
        GAS unsigned long long* o8 = (GAS unsigned long long*)(XN + (size_t)m * D) + F.lane;
#pragma unroll
        for (int j = 0; j < 4; ++j) { const f32x4 g = *((const GAS f32x4*)P.ln_in_g + F.lane + 64 * j), b = *((const GAS f32x4*)P.ln_in_b + F.lane + 64 * j); const f32x4 y = v[j] * rstd * g + b;
            o8[64 * j] = (unsigned long long)pk2(y.x, y.y) | ((unsigned long long)pk2(y.z, y.w) << 32); }
        if (F.lane == 0) { stats[2 * m] = mean; stats[2 * m + 1] = rstd; }
    }
}
__device__ __forceinline__ void p2_conv(Frame& F, const Ptrs& P) {
    bf16* CB = BUF_CB(P); const bf16* Z = (const bf16*)(P.ws + WS_Z);
    const int gw = F.vcu * NWAVES + F.wave, NGW = F.G * NWAVES, c0 = 16 * F.lane;
    float w0[16], w1[16], w2[16];
#pragma unroll
    for (int i = 0; i < 16; ++i) { w0[i] = P.conv_w[c0 + i]; w1[i] = P.conv_w[D + c0 + i]; w2[i] = P.conv_w[2 * D + c0 + i]; }
    for (int ch = gw; ch < T / 16; ch += NGW) {
        const int r0 = ch * 16; float z2[16], z1[16];
        if ((r0 & (SEQ - 1)) == 0) {
#pragma unroll
            for (int i = 0; i < 16; ++i) { z2[i] = 0.f; z1[i] = 0.f; }
        } else {
            const v4u a0 = *(const GAS v4u*)(Z + (size_t)(r0 - 2) * D + c0), a1 = *(const GAS v4u*)(Z + (size_t)(r0 - 2) * D + c0 + 8), b0 = *(const GAS v4u*)(Z + (size_t)(r0 - 1) * D + c0), b1 = *(const GAS v4u*)(Z + (size_t)(r0 - 1) * D + c0 + 8);
#pragma unroll
            for (int i = 0; i < 4; ++i) { z2[2 * i] = bflo(a0[i]); z2[2 * i + 1] = bfhi(a0[i]); z2[8 + 2 * i] = bflo(a1[i]); z2[8 + 2 * i + 1] = bfhi(a1[i]);
                                          z1[2 * i] = bflo(b0[i]); z1[2 * i + 1] = bfhi(b0[i]); z1[8 + 2 * i] = bflo(b1[i]); z1[8 + 2 * i + 1] = bfhi(b1[i]); }
        }
#pragma unroll 2
        for (int rr = 0; rr < 16; ++rr) { const size_t off = (size_t)(r0 + rr) * D + c0;
            const v4u za = *(const GAS v4u*)(Z + off), zb = *(const GAS v4u*)(Z + off + 8), ca = *(const GAS v4u*)(CB + off), cb = *(const GAS v4u*)(CB + off + 8);
            float zc[16], cv[16];
#pragma unroll
            for (int i = 0; i < 4; ++i) { zc[2 * i] = bflo(za[i]); zc[2 * i + 1] = bfhi(za[i]); zc[8 + 2 * i] = bflo(zb[i]); zc[8 + 2 * i + 1] = bfhi(zb[i]);
                                          cv[2 * i] = bflo(ca[i]); cv[2 * i + 1] = bfhi(ca[i]); cv[8 + 2 * i] = bflo(cb[i]); cv[8 + 2 * i + 1] = bfhi(cb[i]); }
            float u[16];
#pragma unroll
            for (int i = 0; i < 16; ++i) { u[i] = cv[i] * (z2[i] * w0[i] + z1[i] * w1[i] + zc[i] * w2[i]); z2[i] = z1[i]; z1[i] = zc[i]; }
            v4u oa, ob;
#pragma unroll
            for (int i = 0; i < 4; ++i) { oa[i] = pk2(u[2 * i], u[2 * i + 1]); ob[i] = pk2(u[8 + 2 * i], u[8 + 2 * i + 1]); }
            *(GAS v4u*)(CB + off) = oa; *(GAS v4u*)(CB + off + 8) = ob; }
    }
}
__device__ __forceinline__ attn::BlockRef attn_ref(const Ptrs& P, int s, int qb) {
    const int vh = s & 1, m = (s >> 1) & 1, h = (s >> 2) & 3, b = s >> 4;
    attn::BlockRef r; const size_t rowb = (size_t)b * SEQ * D;
    r.Q = (const bf16*)(P.ws + WS_Q) + rowb + (size_t)qb * 256 * D + h * 256 + m * 128;
    r.K = (const bf16*)(P.ws + WS_K) + rowb + h * 256 + m * 128;
    r.V = (const bf16*)(P.ws + WS_V) + rowb + h * 256 + vh * 128;
    r.O = (bf16*)(P.ws + (m ? WS_O1 : WS_XN)) + rowb + (size_t)qb * 256 * D + h * 256 + vh * 128;
    r.P0 = qb * 256; return r;
}
#ifndef ATTN_PAIR
#define ATTN_PAIR 1
#endif
__device__ __forceinline__ attn2::BlockRef attn2_ref(const Ptrs& P, int st, int qb) {
    const int m = st & 1, h = (st >> 1) & 3, b = st >> 3;
    attn2::BlockRef r; const size_t rowb = (size_t)b * SEQ * D;
    r.Q = (const bf16*)(P.ws + WS_Q) + rowb + (size_t)qb * 128 * D + h * 256 + m * 128;
    r.K = (const bf16*)(P.ws + WS_K) + rowb + h * 256 + m * 128;
    r.V = (const bf16*)(P.ws + WS_V) + rowb + h * 256;
    r.O = (bf16*)(P.ws + (m ? WS_O1 : WS_XN)) + rowb + (size_t)qb * 128 * D + h * 256;
    r.P0 = qb * 128; return r;
}
__device__ __forceinline__ void p2_attention2(Frame& F, const Ptrs& P, char* lds) {
    float* btab = (float*)(lds + attn2::BIAS_OFF);
    for (int s2 = F.vcu; s2 < BATCH * 16; s2 += F.G) {
        const int st = s2 >> 1, half = s2 & 1, h = (st >> 1) & 3;
        __syncthreads();
        if (F.tid < attn2::NBIAS) { const int rel = 63 - F.tid; btab[F.tid] = (P.rel_bias[attn2::t5_bucket(rel) * 4 + h] - P.rel_bias[15 * 4 + h]) * (1.0f / attn2::SCALE); }
        __syncthreads();
#define QB_OF(i) (2 * (7 - (i)) + (((7 - (i)) & 1) ^ half))
        attn2::Seam S; attn2::BlockRef cur = attn2_ref(P, st, QB_OF(0));
        attn2::attn_prime(cur, lds, S);
#pragma unroll 1
        for (int i = 0; i < 8; ++i) {
            const attn2::BlockRef nxt = (i < 7) ? attn2_ref(P, st, QB_OF(i + 1)) : cur;
            attn2::attn_block(cur, nxt, lds, S);
            cur = nxt;
        }
#undef QB_OF
    }
}
__device__ __forceinline__ void p2_attention(Frame& F, const Ptrs& P, char* lds) {
    float* btab = (float*)(lds + attn::BIAS_OFF);
    for (int s = F.vcu; s < BATCH * 16; s += F.G) {
        const int h = (s >> 2) & 3;
        __syncthreads();
        if (F.tid < attn::NBIAS) { const int rel = 63 - F.tid; btab[F.tid] = (P.rel_bias[attn::t5_bucket(rel) * 4 + h] - P.rel_bias[15 * 4 + h]) * (1.0f / attn::SCALE); }
        __syncthreads();
        attn::Seam S; attn::BlockRef cur = attn_ref(P, s, 0);
        attn::attn_prime(cur, lds, S);
#pragma unroll 1
        for (int qb = 0; qb < 8; ++qb) {
            const attn::BlockRef nxt = (qb < 7) ? attn_ref(P, s, qb + 1) : cur;
            attn::attn_block(cur, nxt, lds, S);
            cur = nxt;
        }
    }
}
__device__ __forceinline__ void p2b_combine(Frame& F, const Ptrs& P) {
    bf16* O0 = (bf16*)(P.ws + WS_XN); const bf16* O1 = (const bf16*)(P.ws + WS_O1);
    const int gw = F.vcu * NWAVES + F.wave, NGW = F.G * NWAVES, c0 = 16 * F.lane;
    const float l0 = wave_sum(P.lq[F.lane] * P.lk[F.lane] + P.lq[64 + F.lane] * P.lk[64 + F.lane]), l1 = wave_sum(P.lq[128 + F.lane] * P.lk[128 + F.lane] + P.lq[192 + F.lane] * P.lk[192 + F.lane]);
    const float lam = expf(l0) - expf(l1) + LAM_INIT;
    float g[16];
#pragma unroll
    for (int i = 0; i < 16; ++i) g[i] = P.subln_g[(c0 & 255) + i] * (1.f - LAM_INIT);
    for (int m = gw; m < T; m += NGW) { const size_t off = (size_t)m * D + c0;
        const v4u a0 = *(const GAS v4u*)(O0 + off), a1 = *(const GAS v4u*)(O0 + off + 8), b0 = *(const GAS v4u*)(O1 + off), b1 = *(const GAS v4u*)(O1 + off + 8);
        float d[16]; float ss = 0.f;
#pragma unroll
        for (int i = 0; i < 4; ++i) { d[2 * i] = bflo(a0[i]) - lam * bflo(b0[i]); d[2 * i + 1] = bfhi(a0[i]) - lam * bfhi(b0[i]); d[8 + 2 * i] = bflo(a1[i]) - lam * bflo(b1[i]); d[8 + 2 * i + 1] = bfhi(a1[i]) - lam * bfhi(b1[i]); }
#pragma unroll
        for (int i = 0; i < 16; ++i) ss += d[i] * d[i];
        ss += __shfl_xor(ss, 1); ss += __shfl_xor(ss, 2); ss += __shfl_xor(ss, 4); ss += __shfl_xor(ss, 8);
        const float rs = 1.f / sqrtf(ss * (1.f / 256.f) + RMS_EPS);
        v4u oa, ob;
#pragma unroll
        for (int i = 0; i < 4; ++i) { oa[i] = pk2(d[2 * i] * rs * g[2 * i], d[2 * i + 1] * rs * g[2 * i + 1]); ob[i] = pk2(d[8 + 2 * i] * rs * g[8 + 2 * i], d[8 + 2 * i + 1] * rs * g[8 + 2 * i + 1]); }
        *(GAS v4u*)(O0 + off) = oa; *(GAS v4u*)(O0 + off + 8) = ob; }
}
__device__ __forceinline__ void pe_experts(Frame& F, const Ptrs& P) {
    LAS float* scr = (LAS float*)(F.lds + RING_OFF + F.wave * 16384);
    const int gw = F.vcu * NWAVES + F.wave, NGW = F.G * NWAVES;
    bf16* Wgu = (bf16*)(P.ws + WS_WGU); bf16* Wd = (bf16*)(P.ws + WS_WD);
    constexpr int I_GU = (D / 64) * (DE / 32), I_DN = (DE / 64) * (D / 32);
    for (int it = gw; it < NE * (2 * I_GU + I_DN); it += NGW) {
        const int e = it / (2 * I_GU + I_DN); int r = it - e * (2 * I_GU + I_DN);
        if (r < 2 * I_GU) { const int up = r >= I_GU; r -= up * I_GU; const int kb = r / (DE / 32), nb = r % (DE / 32), n0 = 32 * nb;
            transpose_item((up ? P.w_up_e : P.w_gate_e) + (size_t)e * D * DE, D, DE, 64 * kb, n0, Wgu + (size_t)e * 1024 * D, 256 * (n0 >> 7) + 128 * up + (n0 & 127), scr, F.lane); }
        else { r -= 2 * I_GU; const int kb = r / (D / 32), nb = r % (D / 32);
            transpose_item(P.w_down_e + (size_t)e * DE * D, DE, D, 64 * kb, 32 * nb, Wd + (size_t)e * D * DE, 32 * nb, scr, F.lane); }
    }
}
__device__ __forceinline__ void p5_ln_route(Frame& F, const Ptrs& P) {
    LAS float* RW = (LAS float*)(F.lds + RING_OFF);
    LAS int* lcnt = (LAS int*)(F.lds + TAB_OFF);
    LAS float* rs = (LAS float*)(F.lds + RSCR_OFF) + F.wave * 128;
    for (int idx = F.tid; idx < D * 36; idx += NWAVES * 64) { const int d = idx / 36, o = idx - d * 36; float w;
        if (o < 4) w = P.w_group[d * 4 + o]; else { const int g = (o - 4) >> 3, e = (o - 4) & 7; w = P.w_sub[((size_t)g * D + d) * 8 + e]; }
        const int j = d >> 8, l = (d & 255) >> 2, i = d & 3, c = o >> 2, k = o & 3;
        RW[((((j * 4 + i) * 9 + c) * 64 + l) << 2) + k] = w; }
    if (F.tid < 32) lcnt[F.tid] = 0;
    __syncthreads();
    float* pre = (float*)(P.ws + WS_PRE); bf16* x1b = (bf16*)(P.ws + WS_XN);
    int* eid = (int*)(P.ws + WS_EID); float* ew = (float*)(P.ws + WS_EW); int* rank = (int*)(P.ws + WS_RANK);
    const int rows_per_wg = T / F.G, rbase = blockIdx.x * rows_per_wg;
    for (int rp = F.wave * 2; rp < rows_per_wg; rp += NWAVES * 2) {
        f32x4 xv[2][4];
#pragma unroll
        for (int r = 0; r < 2; ++r) { const int row = rbase + rp + r;
            f32x4 v[4]; float s = 0.f;
            if constexpr (pg8::PRE_BF16) { const GAS v2u* pr = (const GAS v2u*)((const bf16*)pre + (size_t)row * D) + F.lane;
#pragma unroll
                for (int j = 0; j < 4; ++j) { const v2u w = pr[64 * j]; v[j] = (f32x4){bflo(w.x), bfhi(w.x), bflo(w.y), bfhi(w.y)}; s += (v[j].x + v[j].y) + (v[j].z + v[j].w); } }
            else { const GAS f32x4* pr = (const GAS f32x4*)(pre + (size_t)row * D) + F.lane;
#pragma unroll
                for (int j = 0; j < 4; ++j) { v[j] = pr[64 * j]; s += (v[j].x + v[j].y) + (v[j].z + v[j].w); } }
            const float mean = wave_sum(s) * (1.f / D); float s2 = 0.f;
#pragma unroll
            for (int j = 0; j < 4; ++j) { v[j] = v[j] - mean; s2 += (v[j].x * v[j].x + v[j].y * v[j].y) + (v[j].z * v[j].z + v[j].w * v[j].w); }
            const float rstd = 1.f / sqrtf(wave_sum(s2) * (1.f / D) + LN_EPS);
            GAS unsigned long long* o8 = (GAS unsigned long long*)(x1b + (size_t)row * D) + F.lane;
#pragma unroll
            for (int j = 0; j < 4; ++j) { const f32x4 g = *((const GAS f32x4*)P.ln1_g + F.lane + 64 * j), b = *((const GAS f32x4*)P.ln1_b + F.lane + 64 * j); const f32x4 y = v[j] * rstd * g + b;
                xv[r][j] = y; o8[64 * j] = (unsigned long long)pk2(y.x, y.y) | ((unsigned long long)pk2(y.z, y.w) << 32); } }
        f32x4 acc[2][9];
#pragma unroll
        for (int r = 0; r < 2; ++r)
#pragma unroll
            for (int c = 0; c < 9; ++c) acc[r][c] = (f32x4){0.f, 0.f, 0.f, 0.f};
        asm volatile("" ::: "memory"); __builtin_amdgcn_sched_barrier(0);
#pragma unroll
        for (int j = 0; j < 4; ++j)
#pragma unroll
            for (int i = 0; i < 4; ++i)
                { const LAS f32x4* wp = (const LAS f32x4*)(RW + (((j * 4 + i) * 9 * 64 + F.lane) << 2));
#pragma unroll
                  for (int c = 0; c < 9; ++c) { const f32x4 w = wp[c * 64]; acc[0][c] += w * xv[0][j][i]; acc[1][c] += w * xv[1][j][i]; }
                  asm volatile("" : "+v"(acc[0][0]), "+v"(acc[0][1]), "+v"(acc[0][2]), "+v"(acc[0][3]), "+v"(acc[0][4]), "+v"(acc[0][5]), "+v"(acc[0][6]), "+v"(acc[0][7]), "+v"(acc[0][8]) :: "memory");
                  asm volatile("" : "+v"(acc[1][0]), "+v"(acc[1][1]), "+v"(acc[1][2]), "+v"(acc[1][3]), "+v"(acc[1][4]), "+v"(acc[1][5]), "+v"(acc[1][6]), "+v"(acc[1][7]), "+v"(acc[1][8]) :: "memory");
                  __builtin_amdgcn_sched_barrier(0); }
        { float Y[36];
#pragma unroll
          for (int k = 0; k < 36; ++k) { const int i0 = 2 * k, i1 = 2 * k + 1;
              const auto rr = __builtin_amdgcn_permlane32_swap(__float_as_uint(acc[i0 / 36][(i0 % 36) >> 2][i0 & 3]), __float_as_uint(acc[i1 / 36][(i1 % 36) >> 2][i1 & 3]), false, false);
              Y[k] = __uint_as_float(rr[0]) + __uint_as_float(rr[1]); }
          float Z[18];
#pragma unroll
          for (int m = 0; m < 18; ++m) { const auto rr = __builtin_amdgcn_permlane16_swap(__float_as_uint(Y[2 * m]), __float_as_uint(Y[2 * m + 1]), false, false);
              Z[m] = __uint_as_float(rr[0]) + __uint_as_float(rr[1]); }
#pragma unroll
          for (int m = 0; m < 18; ++m) {
              Z[m] += __int_as_float(__builtin_amdgcn_update_dpp(0, __float_as_int(Z[m]), 0x128, 0xf, 0xf, false));
              Z[m] += __int_as_float(__builtin_amdgcn_update_dpp(0, __float_as_int(Z[m]), 0x124, 0xf, 0xf, false));
              Z[m] += __int_as_float(__builtin_amdgcn_update_dpp(0, __float_as_int(Z[m]), 0x122, 0xf, 0xf, false));
              Z[m] += __int_as_float(__builtin_amdgcn_update_dpp(0, __float_as_int(Z[m]), 0x121, 0xf, 0xf, false)); }
          const int rho = F.lane >> 4, pr = ((rho & 1) << 1) | (rho >> 1);
          if ((F.lane & 15) == 0) {
#pragma unroll
              for (int m = 0; m < 18; ++m) { const int idx = 4 * m + pr; rs[idx >= 36 ? idx + 28 : idx] = Z[m]; } } }
        LDS_WAIT(); asm volatile("" ::: "memory");
        if (F.lane < 2) { const int r = F.lane, row = rbase + rp + r; const LAS float* sa = rs + r * 64;
            float gmax = sa[0] + P.b_group[0]; int gi = 0;
            for (int g = 1; g < 4; ++g) { const float v = sa[g] + P.b_group[g]; if (v > gmax) { gmax = v; gi = g; } }
            float z = 0.f;
            for (int g = 0; g < 4; ++g) z += expf(sa[g] + P.b_group[g] - gmax);
            const float gp = 1.f / z;
            const LAS float* sl = sa + 4 + gi * 8; const float* bs = P.b_sub + gi * 8;
            float b0 = sl[0] + bs[0]; int i0 = 0;
            for (int e = 1; e < 8; ++e) { const float v = sl[e] + bs[e]; if (v > b0) { b0 = v; i0 = e; } }
            float b1 = -__builtin_inff(); int i1 = 0;
            for (int e = 0; e < 8; ++e) { const float v = sl[e] + bs[e]; if (e != i0 && v > b1) { b1 = v; i1 = e; } }
            const float e1 = expf(b1 - b0); const float w0 = gp / (1.f + e1), w1 = gp * e1 / (1.f + e1);
            const int ex0 = gi * 8 + i0, ex1 = gi * 8 + i1;
            eid[row * 2] = ex0; eid[row * 2 + 1] = ex1; ew[row * 2] = w0; ew[row * 2 + 1] = w1;
            rank[row * 2] = __hip_atomic_fetch_add(lcnt + ex0, 1, __ATOMIC_RELAXED, __HIP_MEMORY_SCOPE_WORKGROUP);
            rank[row * 2 + 1] = __hip_atomic_fetch_add(lcnt + ex1, 1, __ATOMIC_RELAXED, __HIP_MEMORY_SCOPE_WORKGROUP); }
        LDS_WAIT(); asm volatile("" ::: "memory");
    }
    __syncthreads();
    if (F.tid < 32) ((int*)(P.ws + WS_CNTWG))[blockIdx.x * 32 + F.tid] = lcnt[F.tid];
}
__device__ __forceinline__ void moe_tab(Frame& F, const Ptrs& P) {
    LAS int* tab = (LAS int*)(F.lds + TAB_OFF);
    const int* cntwg = (const int*)(P.ws + WS_CNTWG);
    __syncthreads();
    if (F.tid < 32) { int tot = 0, base = 0;
        for (int w = 0; w < F.G; ++w) { const int c = __hip_atomic_load(cntwg + w * 32 + F.tid, __ATOMIC_RELAXED, __HIP_MEMORY_SCOPE_AGENT); base += (w < (int)blockIdx.x) ? c : 0; tot += c; }
        tab[96 + F.tid] = tot; tab[64 + F.tid] = base; }
    __syncthreads();
    if (F.tid == 0) { int s = 0; for (int e = 0; e < 32; ++e) { tab[e] = s; s += (tab[96 + e] + 255) & ~255; } tab[32] = s; }
    __syncthreads();
}
__device__ __forceinline__ void p5b_place(Frame& F, const Ptrs& P) {
    LAS int* tab = (LAS int*)(F.lds + TAB_OFF);
    moe_tab(F, P);
    const int rows_per_wg = T / F.G, rbase = blockIdx.x * rows_per_wg;
    const int* eid = (const int*)(P.ws + WS_EID); const int* rank = (const int*)(P.ws + WS_RANK); int* slot = (int*)(P.ws + WS_SLOT);
    int* tokl = (int*)(P.ws + WS_TOK);
    for (int a = F.tid; a < rows_per_wg * 2; a += NWAVES * 64) { const int ga = rbase * 2 + a, e = eid[ga]; const int s = tab[e] + tab[64 + e] + rank[ga]; slot[ga] = s; tokl[s] = ga >> 1; }
    if (blockIdx.x < 32) { const int e = blockIdx.x; for (int s = tab[e] + tab[96 + e] + F.tid; s < tab[e + 1]; s += NWAVES * 64) tokl[s] = 0; }
}
__device__ __forceinline__ void p8_final(Frame& F, const Ptrs& P, bool poison) {
    const bf16* x1 = (const bf16*)(P.ws + WS_XN); const bf16* y = (const bf16*)(P.ws + WS_XG);
    const int* slot = (const int*)(P.ws + WS_SLOT); const float* ew = (const float*)(P.ws + WS_EW);
    const int rows_per_wg = T / F.G, rbase = blockIdx.x * rows_per_wg;
    for (int rr = F.wave; rr < rows_per_wg; rr += NWAVES) { const int row = rbase + rr;
        const int s0 = slot[row * 2], s1 = slot[row * 2 + 1]; const float w0 = ew[row * 2], w1 = ew[row * 2 + 1];
        const GAS v2u* xr = (const GAS v2u*)(x1 + (size_t)row * D) + F.lane; const GAS v2u* y0 = (const GAS v2u*)(y + (size_t)s0 * D) + F.lane; const GAS v2u* y1 = (const GAS v2u*)(y + (size_t)s1 * D) + F.lane;
        f32x4 v[4]; float s = 0.f;
#pragma unroll
        for (int j = 0; j < 4; ++j) { const v2u xw = xr[64 * j]; const f32x4 xx = {bflo(xw.x), bfhi(xw.x), bflo(xw.y), bfhi(xw.y)}; const v2u a = y0[64 * j], b = y1[64 * j];
            v[j].x = ALPHA * xx.x + w0 * bflo(a.x) + w1 * bflo(b.x); v[j].y = ALPHA * xx.y + w0 * bfhi(a.x) + w1 * bfhi(b.x); v[j].z = ALPHA * xx.z + w0 * bflo(a.y) + w1 * bflo(b.y); v[j].w = ALPHA * xx.w + w0 * bfhi(a.y) + w1 * bfhi(b.y);
            s += (v[j].x + v[j].y) + (v[j].z + v[j].w); }
        const float mean = wave_sum(s) * (1.f / D); float s2 = 0.f;
#pragma unroll
        for (int j = 0; j < 4; ++j) { v[j] = v[j] - mean; s2 += (v[j].x * v[j].x + v[j].y * v[j].y) + (v[j].z * v[j].z + v[j].w * v[j].w); }
        const float rstd = 1.f / sqrtf(wave_sum(s2) * (1.f / D) + LN_EPS);
        GAS f32x4* o = (GAS f32x4*)(P.out + (size_t)row * D) + F.lane; const float qn = __builtin_nanf("");
#pragma unroll
        for (int j = 0; j < 4; ++j) { const f32x4 g = *((const GAS f32x4*)P.ln2_g + F.lane + 64 * j), b = *((const GAS f32x4*)P.ln2_b + F.lane + 64 * j); f32x4 yv = v[j] * rstd * g + b;
            if (poison) yv = (f32x4){qn, qn, qn, qn}; o[64 * j] = yv; }
    }
}

constexpr int N_PHASES = 11;
struct Args { Ptrs p; int ph_lo, ph_hi, bar_region, flags; };
__global__ void __launch_bounds__(NWAVES * 64, 2) mega_fwd(Args args) {
    extern __shared__ __attribute__((aligned(16))) unsigned char lds[];
    Frame F; const Ptrs& P = args.p;
    F.lds = (LAS unsigned char*)lds; F.MISC = (volatile LAS unsigned*)(F.lds + MISC_OFF);
    F.tid = threadIdx.x; F.lane = F.tid & 63; F.wave = __builtin_amdgcn_readfirstlane(F.tid >> 6);
    F.G = gridDim.x; { const int bx = blockIdx.x; F.vcu = (F.G % 8 == 0) ? (bx % 8) * (F.G / 8) + bx / 8 : bx; }
    F.ctl = (gu32*)(P.ws + WS_CTL);
    for (int u = F.tid; u < (LDS_BYTES - LDSCTL_OFF) / 4; u += NWAVES * 64) ((LAS unsigned*)(F.lds + LDSCTL_OFF))[u] = 0u;
    __syncthreads();
    XcdBarrier bar = xcd_barrier_post((unsigned*)(F.ctl + CW_BAR) + args.bar_region * XCD_BAR_WORDS, F.MISC + 8);
    const int lo = args.ph_lo, hi = args.ph_hi;
#ifndef PH_MASK
#define PH_MASK 0x7ff
#endif
#define IN(k) (((PH_MASK >> (k)) & 1) && lo <= (k) && (k) < hi)
#define BOTH(k) (IN(k) && IN((k) + 1))
#define GRID_BAR() xcd_barrier(bar)
    const bool grid_ok = (F.G == 256);

    if (IN(0)) { p0_prologue(F, P); if (BOTH(0)) GRID_BAR(); }
    if (IN(1)) {
        pg8::Gemm g{(const pg8::bf16_t*)(P.ws + WS_XN), (const pg8::bf16_t*)(P.ws + WS_WIN), T, NIN, D}; pg8::StaticOrder S; S.init(T, NIN, F.G, (int)blockIdx.x);
        pg8::EpiInProj E{(pg8::bf16_t*)(P.ws + WS_Q), (size_t)(WS_K - WS_Q) / 2, BUF_CB(P), (pg8::bf16_t*)(P.ws + WS_Z), BUF_SGA(P), BUF_SGB(P)};
        pg8::gemm_phase<pg8::EpiInProj, pg8::StaticOrder, true, true>(F.lds + RING_OFF, g, S, E);
        if (BOTH(1)) GRID_BAR();
    }
    if (IN(2)) { if (!(args.flags & 2)) p2_conv(F, P); if (ATTN_PAIR) p2_attention2(F, P, (char*)lds + RING_OFF); else p2_attention(F, P, (char*)lds + RING_OFF); if (BOTH(2)) GRID_BAR(); }
    if (IN(3)) { if (!(args.flags & 1)) p2b_combine(F, P); pe_experts(F, P); if (BOTH(3)) GRID_BAR(); }
    if (IN(4)) {
        { pg8::Gemm g{(const pg8::bf16_t*)(P.ws + WS_XN), (const pg8::bf16_t*)(P.ws + WS_WA), T, D, D}; pg8::StaticOrder S; S.init(T, D, F.G, (int)blockIdx.x);
          pg8::EpiGate<false> E{BUF_SGA(P), nullptr, (pg8::bf16_t*)(P.ws + WS_O1), P.b_gate};
          pg8::gemm_phase<pg8::EpiGate<false>, pg8::StaticOrder, true, true>(F.lds + RING_OFF, g, S, E); }
        __syncthreads();
        { pg8::Gemm g{BUF_CB(P), (const pg8::bf16_t*)(P.ws + WS_WB), T, D, D}; pg8::StaticOrder S; S.init(T, D, F.G, (int)blockIdx.x);
          pg8::EpiGate<true> E{BUF_SGB(P), (const pg8::bf16_t*)(P.ws + WS_O1), (pg8::bf16_t*)(P.ws + WS_Z), P.b_gate + 1024};
          pg8::gemm_phase<pg8::EpiGate<true>, pg8::StaticOrder, true, true>(F.lds + RING_OFF, g, S, E); }
        if (BOTH(4)) GRID_BAR();
    }
    if (IN(5)) {
        pg8::Gemm g{(const pg8::bf16_t*)(P.ws + WS_Z), (const pg8::bf16_t*)(P.ws + WS_WO), T, D, D}; pg8::StaticOrder S; S.init(T, D, F.G, (int)blockIdx.x);
        pg8::EpiPre E{P.x, (const float*)(P.ws + WS_STATS), P.ln_in_g, P.ln_in_b, (float*)(P.ws + WS_PRE), ALPHA};
        pg8::gemm_phase<pg8::EpiPre, pg8::StaticOrder, true, true>(F.lds + RING_OFF, g, S, E);
        if (BOTH(5)) GRID_BAR();
    }
    if (IN(6)) { if (grid_ok) p5_ln_route(F, P); if (BOTH(6)) GRID_BAR(); }
    if (IN(7)) { if (grid_ok) p5b_place(F, P); if (BOTH(7)) GRID_BAR(); }
    if (IN(8)) {
        if (grid_ok) { if (lo == 8) moe_tab(F, P); pg8::Gemm g{(const pg8::bf16_t*)(P.ws + WS_XN), (const pg8::bf16_t*)(P.ws + WS_WGU), MAXS, NE * 1024, D};
          pg8::MoeOrder S{(const PG8_LAS int*)(F.lds + TAB_OFF), F.G, F.vcu}; pg8::EpiMoeUp E{(pg8::bf16_t*)P.out};
          pg8::gemm_phase<pg8::EpiMoeUp, pg8::MoeOrder, true, true, true>(F.lds + RING_OFF, g, S, E, (const int*)(P.ws + WS_TOK)); }
        if (BOTH(8)) GRID_BAR();
    }
    if (IN(9)) {
        if (grid_ok) { if (lo == 9) moe_tab(F, P); pg8::Gemm g{(const pg8::bf16_t*)P.out, (const pg8::bf16_t*)(P.ws + WS_WD), MAXS, NE * 1024, DE};
          pg8::MoeOrder S{(const PG8_LAS int*)(F.lds + TAB_OFF), F.G, F.vcu}; pg8::EpiMoeDown E{(pg8::bf16_t*)(P.ws + WS_XG)};
          pg8::gemm_phase<pg8::EpiMoeDown, pg8::MoeOrder, true, true>(F.lds + RING_OFF, g, S, E); }
        if (BOTH(9)) GRID_BAR();
    }
    if (IN(10)) {
        bool poison = !grid_ok || (__hip_atomic_load(F.ctl + CW_BAR + args.bar_region * XCD_BAR_WORDS + XB_TMO, RLX_AGENT) != 0u);
        if (grid_ok) p8_final(F, P, poison);
        else { const float qn = __builtin_nanf(""); for (size_t i = (size_t)blockIdx.x * 512 + F.tid; i < (size_t)T * D; i += (size_t)F.G * 512) P.out[i] = qn; }
    }
#undef IN
#undef BOTH
#undef GRID_BAR
}

#if HYBRID
namespace nv {
constexpr int D = 1024, BATCH = 16, SEQ = 2048, T = BATCH * SEQ, NIN = 8192, NH = 4, HD = 128, NE = 32, DE = 512;
constexpr float LN_EPS = 1e-5f, RMS_EPS = 1e-6f;
constexpr float ALPHA = 1.189207115002721f;
constexpr float LAM_INIT = 0.2f;
constexpr int MOE_PAD = 64;
constexpr int MAX_SLOTS = 2 * T + NE * MOE_PAD;
constexpr int MAX_TILES = MAX_SLOTS / MOE_PAD;

__device__ __forceinline__ float wave_sum(float v) {
#pragma unroll
    for (int o = 1; o < 64; o <<= 1) v += __shfl_xor(v, o);
    return v;
}
__device__ __forceinline__ float wave_max(float v) {
#pragma unroll
    for (int o = 1; o < 64; o <<= 1) v = fmaxf(v, __shfl_xor(v, o));
    return v;
}
__device__ __forceinline__ float block_sum(float v, float* scr) {
    v = wave_sum(v); __syncthreads();
    if ((threadIdx.x & 63) == 0) scr[threadIdx.x >> 6] = v; __syncthreads();
    float r = 0.f; for (int i = 0; i < (int)(blockDim.x >> 6); ++i) r += scr[i]; __syncthreads(); return r;
}
__device__ __forceinline__ float block_max(float v, float* scr) {
    v = wave_max(v); __syncthreads();
    if ((threadIdx.x & 63) == 0) scr[threadIdx.x >> 6] = v; __syncthreads();
    float r = -INFINITY; for (int i = 0; i < (int)(blockDim.x >> 6); ++i) r = fmaxf(r, scr[i]); __syncthreads(); return r;
}

__global__ void k_ln_rows(const float* x, float a, const float* add, const float* g, const float* b, float* y) {
    __shared__ float scr[8];
    const size_t row = blockIdx.x; const float* xr = x + row * D; const float* ar = add ? add + row * D : nullptr;
    float v[4]; float s = 0.f;
    for (int j = 0; j < 4; ++j) { const int c = threadIdx.x + 256 * j; v[j] = a * xr[c] + (ar ? ar[c] : 0.f); s += v[j]; }
    const float mean = block_sum(s, scr) * (1.f / D); float q = 0.f;
    for (int j = 0; j < 4; ++j) { v[j] -= mean; q += v[j] * v[j]; }
    const float rstd = 1.f / sqrtf(block_sum(q, scr) * (1.f / D) + LN_EPS);
    for (int j = 0; j < 4; ++j) { const int c = threadIdx.x + 256 * j; y[row * D + c] = v[j] * rstd * g[c] + b[c]; }
}

struct TileAcc { float c[4][4]; };
__device__ __forceinline__ void gemm_tile(const float* __restrict__ A, int lda, const int* rowidx, int row0, const float* __restrict__ B, int ldb, int col0, int K, TileAcc& acc, float (*As)[65], float (*Bs)[65]) {
    const int tid = threadIdx.x, tx = tid & 15, ty = tid >> 4;
    for (int i = 0; i < 4; ++i) for (int j = 0; j < 4; ++j) acc.c[i][j] = 0.f;
    for (int k0 = 0; k0 < K; k0 += 16) {
        for (int e = tid; e < 64 * 16; e += 256) { const int r = e >> 4, k = e & 15; int gr = row0 + r; float v = 0.f;
            if (rowidx) { const int t = rowidx[gr]; if (t >= 0) v = A[(size_t)t * lda + k0 + k]; } else v = A[(size_t)gr * lda + k0 + k];
            As[k][r] = v; }
        for (int e = tid; e < 16 * 64; e += 256) { const int k = e >> 6, c = e & 63; Bs[k][c] = B[(size_t)(k0 + k) * ldb + col0 + c]; }
        __syncthreads();
#pragma unroll
        for (int k = 0; k < 16; ++k) { float a[4], b[4];
            for (int i = 0; i < 4; ++i) a[i] = As[k][ty * 4 + i];
            for (int j = 0; j < 4; ++j) b[j] = Bs[k][tx * 4 + j];
            for (int i = 0; i < 4; ++i) for (int j = 0; j < 4; ++j) acc.c[i][j] += a[i] * b[j]; }
        __syncthreads();
    }
}
__global__ void k_gemm(const float* A, int lda, const float* B, int ldb, float* C, int ldc, int K) {
    __shared__ float As[16][65], Bs[16][65];
    TileAcc acc; const int row0 = blockIdx.y * 64, col0 = blockIdx.x * 64;
    gemm_tile(A, lda, nullptr, row0, B, ldb, col0, K, acc, As, Bs);
    const int tx = threadIdx.x & 15, ty = threadIdx.x >> 4;
    for (int i = 0; i < 4; ++i) for (int j = 0; j < 4; ++j) C[(size_t)(row0 + ty * 4 + i) * ldc + col0 + tx * 4 + j] = acc.c[i][j];
}

__device__ __forceinline__ int t5_bucket(int rel) {
    int b = rel > 0 ? 16 : 0; const int n = rel < 0 ? -rel : rel; int v;
    if (n < 8) v = n; else if (n < 12) v = 8; else if (n < 16) v = 9; else if (n < 23) v = 10; else if (n < 32) v = 11; else if (n < 46) v = 12; else if (n < 65) v = 13; else if (n < 91) v = 14; else v = 15;
    return b + v;
}
__global__ void k_attn(const float* P, const float* rel_bias, const float* lq, const float* lk, const float* subln_g, float* ao) {
    __shared__ float q1[128], q2[128], lg[2][SEQ], scr[8];
    const int q = blockIdx.x, h = blockIdx.y, tid = threadIdx.x;
    float l0 = 0.f, l1 = 0.f; for (int i = 0; i < 128; ++i) { l0 += lq[i] * lk[i]; l1 += lq[128 + i] * lk[128 + i]; }
    const float lam = expf(l0) - expf(l1) + LAM_INIT;
    if (tid < 128) q1[tid] = P[(size_t)q * NIN + h * 256 + tid]; else q2[tid - 128] = P[(size_t)q * NIN + h * 256 + tid];
    __syncthreads();
    const int nk = (q / 64 + 1) * 64; const float scale = 0.08838834764831845f;
    float m1 = -INFINITY, m2 = -INFINITY;
    for (int k = tid; k < nk; k += 256) { const float* kr = P + (size_t)k * NIN + 1024 + h * 256; float s1 = 0.f, s2 = 0.f;
        for (int d = 0; d < 128; ++d) { s1 += q1[d] * kr[d]; s2 += q2[d] * kr[128 + d]; }
        const float bias = rel_bias[t5_bucket(k - q) * NH + h];
        s1 = s1 * scale + bias; s2 = s2 * scale + bias; lg[0][k] = s1; lg[1][k] = s2; m1 = fmaxf(m1, s1); m2 = fmaxf(m2, s2); }
    m1 = block_max(m1, scr); m2 = block_max(m2, scr);
    float z1 = 0.f, z2 = 0.f;
    for (int k = tid; k < nk; k += 256) { const float e1 = expf(lg[0][k] - m1), e2 = expf(lg[1][k] - m2); lg[0][k] = e1; lg[1][k] = e2; z1 += e1; z2 += e2; }
    z1 = block_sum(z1, scr); z2 = block_sum(z2, scr);
    for (int k = tid; k < nk; k += 256) lg[0][k] = lg[0][k] / z1 - lam * (lg[1][k] / z2);
    __syncthreads();
    float o = 0.f; const float* vb = P + 2048 + h * 256 + tid;
    for (int k = 0; k < nk; ++k) o += lg[0][k] * vb[(size_t)k * NIN];
    const float ms = block_sum(o * o, scr) * (1.f / 256.f);
    ao[(size_t)q * D + h * 256 + tid] = o * (1.f / sqrtf(ms + RMS_EPS)) * subln_g[tid] * (1.f - LAM_INIT);
}
__global__ void k_conv(const float* P, const float* cw, float* u) {
    const int t = blockIdx.x;
    for (int c = threadIdx.x; c < D; c += 256) { float z = 0.f;
        for (int w = 0; w < 3; ++w) { const int tt = t + w - 2; if (tt >= 0) z += P[(size_t)tt * NIN + 4096 + c] * P[(size_t)tt * NIN + 5120 + c] * cw[w * D + c]; }
        u[(size_t)t * D + c] = P[(size_t)t * NIN + 3072 + c] * z; }
}
__global__ void k_merge(const float* P, const float* bg, const float* yA, const float* yB, float* m) {
    const int t = blockIdx.x;
    for (int c = threadIdx.x; c < D; c += 256) { const float ga = 1.f / (1.f + expf(-(P[(size_t)t * NIN + 6144 + c] + bg[c]))), gb = 1.f / (1.f + expf(-(P[(size_t)t * NIN + 7168 + c] + bg[D + c])));
        m[(size_t)t * D + c] = ga * yA[(size_t)t * D + c] + gb * yB[(size_t)t * D + c]; }
}
__global__ void k_route(const float* x1, const float* wg, const float* bg, const float* wsub, const float* bsub, int* eid, float* ew, int* rank, int* cnt) {
    const int t = blockIdx.x * 4 + (threadIdx.x >> 6), lane = threadIdx.x & 63;
    float acc[36];
#pragma unroll
    for (int i = 0; i < 36; ++i) acc[i] = 0.f;
    for (int j = 0; j < 16; ++j) { const int d = lane + 64 * j; const float xv = x1[(size_t)t * D + d];
#pragma unroll
        for (int g = 0; g < 4; ++g) acc[g] += xv * wg[d * 4 + g];
#pragma unroll
        for (int g = 0; g < 4; ++g) {
#pragma unroll
            for (int e = 0; e < 8; ++e) acc[4 + g * 8 + e] += xv * wsub[((size_t)g * D + d) * 8 + e]; } }
#pragma unroll
    for (int i = 0; i < 36; ++i) acc[i] = wave_sum(acc[i]);
    __shared__ float sacc[4][36];
    const int wv = threadIdx.x >> 6;
#pragma unroll
    for (int i = 0; i < 36; ++i) if (lane == 0) sacc[wv][i] = acc[i];
    __syncthreads();
    if (lane == 0) {
        const float* sa = sacc[wv];
        float gmax = sa[0] + bg[0]; int gi = 0;
        for (int g = 1; g < 4; ++g) { const float v = sa[g] + bg[g]; if (v > gmax) { gmax = v; gi = g; } }
        float z = 0.f;
        for (int g = 0; g < 4; ++g) z += expf(sa[g] + bg[g] - gmax);
        const float gp = 1.f / z;
        const float* sl = sa + 4 + gi * 8; const float* bs = bsub + gi * 8;
        float b0 = sl[0] + bs[0]; int i0 = 0;
        for (int e = 1; e < 8; ++e) { const float v = sl[e] + bs[e]; if (v > b0) { b0 = v; i0 = e; } }
        float b1 = -INFINITY; int i1 = 0;
        for (int e = 0; e < 8; ++e) { const float v = sl[e] + bs[e]; if (e != i0 && v > b1) { b1 = v; i1 = e; } }
        const float e1 = expf(b1 - b0); const float w0 = gp / (1.f + e1), w1 = gp * e1 / (1.f + e1);
        const int ex0 = gi * 8 + i0, ex1 = gi * 8 + i1;
        eid[t * 2] = ex0; eid[t * 2 + 1] = ex1; ew[t * 2] = w0; ew[t * 2 + 1] = w1;
        rank[t * 2] = atomicAdd(&cnt[ex0], 1); rank[t * 2 + 1] = atomicAdd(&cnt[ex1], 1);
    }
}
__global__ void k_offsets(const int* cnt, int* pad_start, int* tile_expert) {
    if (threadIdx.x == 0) { int s = 0; for (int e = 0; e < NE; ++e) { pad_start[e] = s; const int p = (cnt[e] + MOE_PAD - 1) / MOE_PAD * MOE_PAD; for (int i = 0; i < p / MOE_PAD; ++i) tile_expert[s / MOE_PAD + i] = e; s += p; }
        pad_start[NE] = s; for (int i = s / MOE_PAD; i < MAX_TILES; ++i) tile_expert[i] = -1; }
}
__global__ void k_place(const int* eid, const float* ew, const int* rank, const int* pad_start, int* tok, float* wslot) {
    const int a = blockIdx.x * 256 + threadIdx.x; if (a >= 2 * T) return;
    const int s = pad_start[eid[a]] + rank[a]; tok[s] = a >> 1; wslot[s] = ew[a];
}
__global__ void k_moe_up(const float* x1, const int* tok, const int* tile_expert, const float* Wg, const float* Wu, float* h) {
    __shared__ float As[16][65], Bs[16][65];
    const int e = tile_expert[blockIdx.y]; if (e < 0) return;
    TileAcc g, u; const int row0 = blockIdx.y * 64, col0 = blockIdx.x * 64;
    gemm_tile(x1, D, tok, row0, Wg + (size_t)e * D * DE, DE, col0, D, g, As, Bs);
    gemm_tile(x1, D, tok, row0, Wu + (size_t)e * D * DE, DE, col0, D, u, As, Bs);
    const int tx = threadIdx.x & 15, ty = threadIdx.x >> 4;
    for (int i = 0; i < 4; ++i) for (int j = 0; j < 4; ++j) { const float gv = g.c[i][j]; h[(size_t)(row0 + ty * 4 + i) * DE + col0 + tx * 4 + j] = gv / (1.f + expf(-gv)) * u.c[i][j]; }
}
__global__ void k_moe_down(const float* h, const int* tok, const float* wslot, const int* tile_expert, const float* Wd, float* ffn) {
    __shared__ float As[16][65], Bs[16][65];
    const int e = tile_expert[blockIdx.y]; if (e < 0) return;
    TileAcc acc; const int row0 = blockIdx.y * 64, col0 = blockIdx.x * 64;
    gemm_tile(h, DE, nullptr, row0, Wd + (size_t)e * DE * D, D, col0, DE, acc, As, Bs);
    const int tx = threadIdx.x & 15, ty = threadIdx.x >> 4;
    for (int i = 0; i < 4; ++i) { const int r = row0 + ty * 4 + i; const int t = tok[r]; if (t < 0) continue; const float w = wslot[r];
        for (int j = 0; j < 4; ++j) atomicAdd(&ffn[(size_t)t * D + col0 + tx * 4 + j], w * acc.c[i][j]); }
}
}
#endif
#if HYBRID
__global__ void k_axpy(const float* xn, const float* mix, float* pre, float a, size_t n) { const size_t i = (size_t)blockIdx.x * 256 + threadIdx.x; if (i < n) pre[i] = a * xn[i] + mix[i]; }
__global__ void k_f2b(const float* src, int lds_, unsigned short* dst, int ldd, int cols, size_t rows) {
    const size_t i = (size_t)blockIdx.x * 256 + threadIdx.x; if (i >= rows * cols) return; const size_t r = i / cols; const int c = (int)(i % cols);
    dst[r * ldd + c] = (unsigned short)f2bf(src[r * lds_ + c]); }
__global__ void k_f2b_mul(const float* a, const float* b, int lds_, unsigned short* dst, int ldd, int cols, size_t rows) {
    const size_t i = (size_t)blockIdx.x * 256 + threadIdx.x; if (i >= rows * cols) return; const size_t r = i / cols; const int c = (int)(i % cols);
    dst[r * ldd + c] = (unsigned short)f2bf(a[r * lds_ + c] * b[r * lds_ + c]); }
__global__ void k_f2b_sig(const float* a, const float* bias, int lds_, unsigned short* dst, int ldd, int cols, size_t rows) {
    const size_t i = (size_t)blockIdx.x * 256 + threadIdx.x; if (i >= rows * cols) return; const size_t r = i / cols; const int c = (int)(i % cols);
    dst[r * ldd + c] = (unsigned short)f2bf(1.f / (1.f + expf(-(a[r * lds_ + c] + bias[c])))); }
#endif
static void launch_mega(const Ptrs& p, int lo, int hi, int region, int flags, hipStream_t stream) {
    Args a{}; a.p = p; a.ph_lo = lo; a.ph_hi = hi; a.bar_region = region; a.flags = flags;
    hipLaunchKernelGGL(mega_fwd, dim3(256), dim3(NWAVES * 64), LDS_BYTES, stream, a);
}
extern "C" void kernel_launch(void* const* d_in, const int* in_sizes, int n_in, void* d_out, int out_size, void* d_ws, size_t ws_size, hipStream_t stream) {
    static int ready = 0;
    if (ready == 0) {
        ready = 1;
        if (n_in != 24 || out_size != T * D || ws_size < WS_END) { fprintf(stderr, "kernel_launch: unexpected shapes (n_in %d out %d ws %zu)\n", n_in, out_size, ws_size); ready = -1; }
        else if (hipFuncSetAttribute((const void*)mega_fwd, hipFuncAttributeMaxDynamicSharedMemorySize, LDS_BYTES) != hipSuccess) { fprintf(stderr, "kernel_launch: hipFuncSetAttribute failed\n"); ready = -1; }
        (void)hipGetLastError();
    }
    if (ready < 0) return;
    Ptrs p{};
    const float** pp = (const float**)&p;
    for (int i = 0; i < 24; ++i) pp[i] = (const float*)d_in[i];
    p.out = (float*)d_out; p.ws = (unsigned char*)d_ws;
    (void)hipMemsetAsync((char*)d_ws + WS_CTL, 0, CTL_ZERO_BYTES, stream);
#if HYBRID == 0
#if defined(TIME_PHASE)
    launch_mega(p, 0, TIME_PHASE + 1, 0, 0, stream); launch_mega(p, TIME_PHASE, TIME_PHASE + 1, 1, 3, stream); if (TIME_PHASE + 1 < N_PHASES) launch_mega(p, TIME_PHASE + 1, N_PHASES, 2, 0, stream);
#elif defined(SPLIT_AT)
    launch_mega(p, 0, SPLIT_AT, 0, 0, stream); launch_mega(p, SPLIT_AT, N_PHASES, 1, 0, stream);
#else
    launch_mega(p, 0, N_PHASES, 0, 0, stream);
#endif
#else
    char* ws = (char*)d_ws; float* out = (float*)d_out;
    constexpr size_t NB = (HYBRID == 1 ? 330 : (HYBRID == 2 ? 90 : 410)) * MiB;
    float* Pb = (float*)(ws + NB); float* xnb = (float*)(ws + NB + 64 * MiB); float* ao = (float*)(ws + NB + 72 * MiB); float* ub = (float*)(ws + NB + 80 * MiB); float* yA = (float*)(ws + NB + 88 * MiB); float* yB = (float*)(ws + NB + 96 * MiB); float* mb = (float*)(ws + NB + 104 * MiB);
    float* pre = (float*)(ws + WS_PRE);
#ifndef TAKE_MASK
#define TAKE_MASK 0
#endif
#if HYBRID >= 2
    launch_mega(p, 0, TAKE_MASK ? 2 : 1, 0, 0, stream);
#endif
    for (int b = 0; b < BATCH; ++b) {
        const size_t r0 = (size_t)b * SEQ;
        nv::k_ln_rows<<<SEQ, 256, 0, stream>>>(p.x + r0 * D, 1.f, nullptr, p.ln_in_g, p.ln_in_b, xnb);
        nv::k_gemm<<<dim3(NIN / 64, SEQ / 64), 256, 0, stream>>>(xnb, D, p.w_in, NIN, Pb, NIN, D);
#if HYBRID == 3
        { const int nb = (int)(((size_t)SEQ * 1024 + 255) / 256);
          if (!(TAKE_MASK & 1)) k_f2b<<<nb, 256, 0, stream>>>(Pb, NIN, (unsigned short*)(ws + WS_Q) + r0 * D, D, 1024, SEQ);
          if (!(TAKE_MASK & 2)) k_f2b<<<nb, 256, 0, stream>>>(Pb + 1024, NIN, (unsigned short*)(ws + WS_K) + r0 * D, D, 1024, SEQ);
          if (!(TAKE_MASK & 4)) k_f2b<<<nb, 256, 0, stream>>>(Pb + 2048, NIN, (unsigned short*)(ws + WS_V) + r0 * D, D, 1024, SEQ);
          if (!(TAKE_MASK & 8)) k_f2b<<<nb, 256, 0, stream>>>(Pb + 3072, NIN, BUF_CB(p) + r0 * D, D, 1024, SEQ);
          if (!(TAKE_MASK & 16)) k_f2b_mul<<<nb, 256, 0, stream>>>(Pb + 4096, Pb + 5120, NIN, (unsigned short*)(ws + WS_Z) + r0 * D, D, 1024, SEQ);
          if (!(TAKE_MASK & 32)) k_f2b<<<nb, 256, 0, stream>>>(Pb + 6144, NIN, BUF_SGA(p) + r0 * D, D, 1024, SEQ);
          if (!(TAKE_MASK & 64)) k_f2b<<<nb, 256, 0, stream>>>(Pb + 7168, NIN, BUF_SGB(p) + r0 * D, D, 1024, SEQ); }
#else
        nv::k_attn<<<dim3(SEQ, nv::NH), 256, 0, stream>>>(Pb, p.rel_bias, p.lq, p.lk, p.subln_g, ao);
        nv::k_conv<<<SEQ, 256, 0, stream>>>(Pb, p.conv_w, ub);
#if HYBRID == 2
        { const int nb = (int)(((size_t)SEQ * 1024 + 255) / 256);
          k_f2b<<<nb, 256, 0, stream>>>(ao, D, (unsigned short*)(ws + WS_XN) + r0 * D, D, 1024, SEQ);
          k_f2b<<<nb, 256, 0, stream>>>(ub, D, BUF_CB(p) + r0 * D, D, 1024, SEQ);
          k_f2b<<<nb, 256, 0, stream>>>(Pb + 6144, NIN, BUF_SGA(p) + r0 * D, D, 1024, SEQ);
          k_f2b<<<nb, 256, 0, stream>>>(Pb + 7168, NIN, BUF_SGB(p) + r0 * D, D, 1024, SEQ); }
#else
        nv::k_gemm<<<dim3(D / 64, SEQ / 64), 256, 0, stream>>>(ao, D, p.w_a, D, yA, D, D);
        nv::k_gemm<<<dim3(D / 64, SEQ / 64), 256, 0, stream>>>(ub, D, p.w_b, D, yB, D, D);
        nv::k_merge<<<SEQ, 256, 0, stream>>>(Pb, p.b_gate, yA, yB, mb);
        nv::k_gemm<<<dim3(D / 64, SEQ / 64), 256, 0, stream>>>(mb, D, p.w_o, D, pre + r0 * D, D, D);
        k_axpy<<<(int)(((size_t)SEQ * D + 255) / 256), 256, 0, stream>>>(xnb, pre + r0 * D, pre + r0 * D, ALPHA, (size_t)SEQ * D);
#endif
#endif
    }
#if HYBRID == 1
    launch_mega(p, 3, 4, 1, 1, stream);
    launch_mega(p, 6, N_PHASES, 2, 0, stream);
#elif HYBRID == 2
    launch_mega(p, 3, 4, 1, 1, stream);
    launch_mega(p, 4, N_PHASES, 2, 0, stream);
#elif HYBRID == 3
    launch_mega(p, 2, N_PHASES, 1, 0, stream);
#endif
#endif
}
```

```cpp
#include <hip/hip_runtime.h>
#include <cstdio>
#include <cstdint>
#include <cmath>
#ifndef HYBRID
#define HYBRID 0
#endif
namespace pg8 {
#define PG8_LAS __attribute__((address_space(3)))
typedef unsigned short bf16_t;
typedef short bf16x8 __attribute__((ext_vector_type(8)));
typedef float f32x4 __attribute__((ext_vector_type(4)));
typedef unsigned u32x4 __attribute__((ext_vector_type(4)));
constexpr int BM = 256, BK = 64, HALF = 128, HTB = HALF * BK * 2  , STAGE_BYTES = 8 * HTB, NXCD = 8, WGM = 8;

__host__ __device__ __forceinline__ int lds_byte(int r, int c) { const int st = (r >> 4) * 2 + (c >> 5), rr = r & 15, cc = c & 31, ob = rr * 64 + cc * 2; return st * 1024 + (ob ^ (((ob >> 9) & 1) << 5)); }
__host__ __device__ __forceinline__ void stage_rc(int b, int& R, int& C) { const int st = b / 1024, sb = b % 1024, swz = sb ^ (((sb >> 9) & 1) << 5); R = (st >> 1) * 16 + swz / 64; C = (st & 1) * 32 + (swz % 64) / 2; }
__host__ __device__ __forceinline__ int perm32(int rho) { const int n = rho >> 4, i = rho & 15; return 8 * (i >> 2) + 4 * n + (i & 3); }

struct Unit { int pm, pn; };
struct Gemm { const bf16_t* A; const bf16_t* Bt; int M, N, K; };

struct StaticOrder {
    int nM, nN, nwg, G, c;
    __host__ __device__ void init(int M, int N, int G_, int c_) { nM = M / BM; nN = N / BM; nwg = nM * nN; G = G_; c = c_; }
    __host__ __device__ bool next(int i, Unit& u) const {
        const long L = (long)i * G + c; if (L >= nwg) return false;
        int wgid = (int)L; { const int q = nwg / NXCD, r = nwg % NXCD, xcd = wgid % NXCD, off = wgid / NXCD; wgid = (xcd < r ? xcd * (q + 1) : r * (q + 1) + (xcd - r) * q) + off; }
        const int nig = WGM * nN, gid = wgid / nig, fm = gid * WGM, gsz = (nM - fm) < WGM ? (nM - fm) : WGM;
        u.pm = fm + ((wgid % nig) % gsz); u.pn = (wgid % nig) / gsz; return true;
    }
    __device__ __forceinline__ void a_ready(const Unit&) const {}
    __device__ __forceinline__ void done(const Unit&) const {}
};

__device__ __forceinline__ unsigned cvt_pk_bf16(float lo, float hi) { unsigned r; asm volatile("v_cvt_pk_bf16_f32 %0, %1, %2" : "=v"(r) : "v"(lo), "v"(hi)); return r; }
typedef float f32x2 __attribute__((ext_vector_type(2)));
__device__ __forceinline__ u32x4 pack8f(const f32x4 a, const f32x4 b) { u32x4 w; w.x = cvt_pk_bf16(a[0], a[1]); w.y = cvt_pk_bf16(a[2], a[3]); w.z = cvt_pk_bf16(b[0], b[1]); w.w = cvt_pk_bf16(b[2], b[3]); return w; }
__device__ __forceinline__ void unpack8f(const u32x4 w, f32x4& a, f32x4& b) {
    a[0] = __uint_as_float(w.x << 16); a[1] = __uint_as_float(w.x & 0xffff0000u); a[2] = __uint_as_float(w.y << 16); a[3] = __uint_as_float(w.y & 0xffff0000u);
    b[0] = __uint_as_float(w.z << 16); b[1] = __uint_as_float(w.z & 0xffff0000u); b[2] = __uint_as_float(w.w << 16); b[3] = __uint_as_float(w.w & 0xffff0000u); }
__device__ __forceinline__ float sigmoidf_fast(float x) { return __builtin_amdgcn_rcpf(1.0f + __expf(-x)); }

struct EpiInProj {
    static constexpr bool PERM = true, AFTER_DRAIN = false;
    bf16_t* qkv; size_t stride;
    bf16_t* cb;
    bf16_t* z;
    bf16_t* sga; bf16_t* sgb;
    __device__ __forceinline__ void operator()(const f32x4 (&acc)[2][2][4][2], const Unit& u, int wr, int wc, int fr, int fq) const {
        const int row0 = u.pm * BM + wr * 64 + fr; const int pn = u.pn;
        if (pn < 16 || pn >= 24) {
            bf16_t* base = (pn < 12) ? qkv + (size_t)(pn >> 2) * stride : (pn < 16 ? cb : (pn < 28 ? sga : sgb)); const int col0 = (pn & 3) * BM + wc * 32 + 8 * fq;
#pragma unroll
            for (int ai = 0; ai < 2; ++ai)
#pragma unroll
                for (int m = 0; m < 4; ++m) { bf16_t* rowp = base + (size_t)(row0 + ai * HALF + m * 16) * 1024 + col0;
#pragma unroll
                    for (int bj = 0; bj < 2; ++bj) *(u32x4*)(rowp + bj * HALF) = pack8f(acc[ai][bj][m][0], acc[ai][bj][m][1]); }
        } else {
            const int col0 = (pn - 16) * HALF + wc * 32 + 8 * fq;
#pragma unroll
            for (int ai = 0; ai < 2; ++ai)
#pragma unroll
                for (int m = 0; m < 4; ++m) { bf16_t* rowp = z + (size_t)(row0 + ai * HALF + m * 16) * 1024 + col0;
                    *(u32x4*)rowp = pack8f(acc[ai][0][m][0] * acc[ai][1][m][0], acc[ai][0][m][1] * acc[ai][1][m][1]); }
        }
    }
};
template <bool SECOND> struct EpiGate {
    static constexpr bool PERM = true, AFTER_DRAIN = false;
    const bf16_t* gate; const bf16_t* prev; bf16_t* out; const float* gbias;
    __device__ __forceinline__ void operator()(const f32x4 (&acc)[2][2][4][2], const Unit& u, int wr, int wc, int fr, int fq) const {
        const int row0 = u.pm * BM + wr * 64 + fr; const int col0 = u.pn * BM + wc * 32 + 8 * fq;
        f32x4 bv[2][2];
#pragma unroll
        for (int bj = 0; bj < 2; ++bj)
#pragma unroll
            for (int n = 0; n < 2; ++n) bv[bj][n] = *(const f32x4*)(gbias + col0 + bj * HALF + 4 * n);
#pragma unroll
        for (int ai = 0; ai < 2; ++ai)
#pragma unroll
            for (int m = 0; m < 4; ++m) { const size_t off = (size_t)(row0 + ai * HALF + m * 16) * 1024 + col0;
#pragma unroll
                for (int bj = 0; bj < 2; ++bj) { f32x4 g0, g1; unpack8f(*(const u32x4*)(gate + off + bj * HALF), g0, g1); g0 += bv[bj][0]; g1 += bv[bj][1];
#pragma unroll
                    for (int i = 0; i < 4; ++i) { g0[i] = sigmoidf_fast(g0[i]); g1[i] = sigmoidf_fast(g1[i]); }
                    f32x4 v0 = acc[ai][bj][m][0] * g0, v1 = acc[ai][bj][m][1] * g1;
                    if (SECOND) { f32x4 p0, p1; unpack8f(*(const u32x4*)(prev + off + bj * HALF), p0, p1); v0 += p0; v1 += p1; }
                    *(u32x4*)(out + off + bj * HALF) = pack8f(v0, v1); } }
    }
};
typedef unsigned u32x2 __attribute__((ext_vector_type(2)));
#ifndef PRE_BF16_KNOB
#define PRE_BF16_KNOB 1
#endif
constexpr bool PRE_BF16 = PRE_BF16_KNOB;
struct EpiPre {
    static constexpr bool PERM = false, AFTER_DRAIN = false;
    const float* x; const float* stats; const float* g; const float* b; float* pre; float alpha;
    __device__ __forceinline__ void operator()(const f32x4 (&acc)[2][2][4][2], const Unit& u, int wr, int wc, int fr, int fq) const {
        const int row0 = u.pm * BM + wr * 64 + fr; const int col0 = u.pn * BM + wc * 32 + 4 * fq;
#pragma unroll
        for (int ai = 0; ai < 2; ++ai)
#pragma unroll
            for (int m = 0; m < 4; ++m) { const int row = row0 + ai * HALF + m * 16; const size_t off = (size_t)row * 1024 + col0;
                const float mu = stats[2 * row], rs = stats[2 * row + 1];
#pragma unroll
                for (int bj = 0; bj < 2; ++bj)
#pragma unroll
                    for (int n = 0; n < 2; ++n) { const int c = bj * HALF + n * 16; const f32x4 xv = *(const f32x4*)(x + off + c), gv = *(const f32x4*)(g + col0 + c), bv = *(const f32x4*)(b + col0 + c);
                        const f32x4 o = ((xv - mu) * rs * gv + bv) * alpha + acc[ai][bj][m][n];
                        if constexpr (PRE_BF16) { u32x2 w; w.x = cvt_pk_bf16(o[0], o[1]); w.y = cvt_pk_bf16(o[2], o[3]); *(u32x2*)((bf16_t*)pre + off + c) = w; } else *(f32x4*)(pre + off + c) = o; } }
    }
};
#ifndef MOE_HANDOFF
#define MOE_HANDOFF 0
#endif
struct EpiMoeUp {
    static constexpr bool PERM = true, AFTER_DRAIN = false;
    bf16_t* h;
    __device__ __forceinline__ void operator()(const f32x4 (&acc)[2][2][4][2], const Unit& u, int wr, int wc, int fr, int fq) const {
        const int row0 = u.pm * BM + wr * 64 + fr; const int col0 = (u.pn & 3) * HALF + wc * 32 + 8 * fq;
#pragma unroll
        for (int ai = 0; ai < 2; ++ai)
#pragma unroll
            for (int m = 0; m < 4; ++m) { f32x4 v[2];
#pragma unroll
                for (int n = 0; n < 2; ++n)
#pragma unroll
                    for (int i = 0; i < 4; ++i) { const float gv = acc[ai][0][m][n][i]; v[n][i] = gv * sigmoidf_fast(gv) * acc[ai][1][m][n][i]; }
                bf16_t* dst = h + (size_t)(row0 + ai * HALF + m * 16) * 512 + col0; const u32x4 w = pack8f(v[0], v[1]);
                if (MOE_HANDOFF) asm volatile("global_store_dwordx4 %0, %1, off sc1\n\ts_nop 1" :: "v"(dst), "v"(w) : "memory"); else *(u32x4*)dst = w; }
    }
};
struct EpiMoeDown {
    static constexpr bool PERM = true, AFTER_DRAIN = false;
    bf16_t* y;
    __device__ __forceinline__ void operator()(const f32x4 (&acc)[2][2][4][2], const Unit& u, int wr, int wc, int fr, int fq) const {
        const int row0 = u.pm * BM + wr * 64 + fr; const int col0 = (u.pn & 3) * BM + wc * 32 + 8 * fq;
#pragma unroll
        for (int ai = 0; ai < 2; ++ai)
#pragma unroll
            for (int m = 0; m < 4; ++m) { bf16_t* rowp = y + (size_t)(row0 + ai * HALF + m * 16) * 1024 + col0;
#pragma unroll
                for (int bj = 0; bj < 2; ++bj) *(u32x4*)(rowp + bj * HALF) = pack8f(acc[ai][bj][m][0], acc[ai][bj][m][1]); }
    }
};
struct MoeOrder {
    const PG8_LAS int* tab; int G, c;
    unsigned* cnt;
    unsigned need;
    bool publish; unsigned* tmo;
    __device__ __forceinline__ bool next(int i, Unit& u) const {
        const int nunits = (tab[32] >> 8) * 4; const int L = i * G + c; if (L >= nunits) return false;
        const int tile = L >> 2, s = tile << 8; int e = 0;
#pragma unroll 1
        for (int k = 1; k < 32; ++k) e = (tab[k] <= s) ? k : e;
        u.pm = __builtin_amdgcn_readfirstlane(tile); u.pn = __builtin_amdgcn_readfirstlane(e * 4 + (L & 3)); return true;
    }
    mutable int calls;
    __device__ __forceinline__ void a_ready(const Unit& u) const {
        const int k = calls++;
        if (need == 0u || (k >= 1 && k < 4)) return;
        if (threadIdx.x < 64) {
            const int lane = threadIdx.x, nunits = (tab[32] >> 8) * 4;
            int tile = u.pm; bool mine = (lane == 0);
            if (k == 0) { const int L = lane * G + c; mine = (lane < 4) && (L < nunits); tile = mine ? (L >> 2) : u.pm; }
            const unsigned long long t0 = __builtin_amdgcn_s_memrealtime(); unsigned polls = 0;
            for (;;) {
                const bool ok = !mine || __hip_atomic_load(cnt + 64 * tile, __ATOMIC_RELAXED, __HIP_MEMORY_SCOPE_AGENT) >= need;
                if (__all(ok)) break;
                if ((++polls & 255u) == 0u && __builtin_amdgcn_readfirstlane(__hip_atomic_load(tmo, __ATOMIC_RELAXED, __HIP_MEMORY_SCOPE_AGENT)) != 0u) break;
                if (__builtin_amdgcn_s_memrealtime() - t0 > 2000000ull) { if (threadIdx.x == 0) __hip_atomic_store(tmo, 1u, __ATOMIC_RELAXED, __HIP_MEMORY_SCOPE_AGENT); break; }
                __builtin_amdgcn_s_sleep(2); }
            __builtin_amdgcn_fence(__ATOMIC_ACQUIRE, "agent");
            asm volatile("s_waitcnt vmcnt(0)" ::: "memory");
        }
        asm volatile("" ::: "memory"); __builtin_amdgcn_s_barrier(); asm volatile("" ::: "memory");
    }
    mutable int pend;
    __device__ __forceinline__ void done(const Unit& u) const {
        if (!publish) return;
        if (pend >= 0 && (threadIdx.x & 63) == 0) __hip_atomic_fetch_add(cnt + 64 * pend, 1u, __ATOMIC_RELAXED, __HIP_MEMORY_SCOPE_AGENT);
        pend = u.pm;
    }
    __device__ __forceinline__ void flush() const {
        if (!publish) return;
        asm volatile("s_waitcnt vmcnt(0)" ::: "memory");
        if (pend >= 0 && (threadIdx.x & 63) == 0) __hip_atomic_fetch_add(cnt + 64 * pend, 1u, __ATOMIC_RELAXED, __HIP_MEMORY_SCOPE_AGENT);
        pend = -1;
    }
};
template <class Epi, class Sched, bool ALIGN_EPI = false, bool SP2 = false, bool GATHER = false>
__device__ __forceinline__ void gemm_phase(PG8_LAS unsigned char* lds, const Gemm g, const Sched& S, const Epi& E, const int* tok = nullptr) {
    static_assert(!GATHER || SP2, "GATHER is written for the SP2 loop only");
    const int tid = threadIdx.x, wid = __builtin_amdgcn_readfirstlane(tid >> 6), lane = tid & 63, wr = wid >> 2, wc = wid & 3, fr = lane & 15, fq = lane >> 4;
    const int K = g.K, nt = K / BK;
    unsigned voffA[2], voffB[2]; int gR[2], gC[2];
#pragma unroll
    for (int i = 0; i < 2; ++i) { int R, C; stage_rc(tid * 16 + i * 8192, R, C); const int Rb = Epi::PERM ? ((R & ~31) + perm32(R & 31)) : R; gR[i] = R; gC[i] = C;
        voffA[i] = (unsigned)(R * K + C) * 2u; voffB[i] = (unsigned)(Rb * K + C) * 2u; }
    unsigned vc0[2] = {0u, 0u}, vc1[2] = {0u, 0u}, vn0[2] = {0u, 0u}, vn1[2] = {0u, 0u};
#define PG8_GROWS(pm_, o0, o1) do { _Pragma("unroll") for (int _i = 0; _i < 2; ++_i) { o0[_i] = (unsigned)(tok[(pm_) * BM + gR[_i]] * K + gC[_i]) * 2u; o1[_i] = (unsigned)(tok[(pm_) * BM + HALF + gR[_i]] * K + gC[_i]) * 2u; } } while (0)
#define PG8_STAGE_A(bufoff, gbase, h, usenext) do { if constexpr (GATHER) { const unsigned _o0 = (usenext) ? ((h) ? vn1[0] : vn0[0]) : ((h) ? vc1[0] : vc0[0]), _o1 = (usenext) ? ((h) ? vn1[1] : vn0[1]) : ((h) ? vc1[1] : vc0[1]); \
        __builtin_amdgcn_global_load_lds((const unsigned*)((const char*)(gbase) + _o0), (PG8_LAS unsigned*)(lds + (bufoff) + ldsw), 16, 0, 0); \
        __builtin_amdgcn_global_load_lds((const unsigned*)((const char*)(gbase) + _o1), (PG8_LAS unsigned*)(lds + (bufoff) + ldsw + 8192), 16, 0, 0); } \
    else { PG8_STAGE(bufoff, (gbase) + (h) * hstep, voffA); } } while (0)
    const size_t kstep = (size_t)(BK * 2);
    const size_t hstep = (size_t)HALF * K * 2;
    const size_t tstep = 2 * hstep;
    const unsigned ldsw = (unsigned)wid * 1024u;
    const int aoff = lds_byte(wr * 64 + fr, fq * 8), boff = lds_byte(wc * 32 + fr, fq * 8);
#define PG8_SA(b, h) (((b) * 2 + (h)) * HTB)
#define PG8_SB(b, h) ((4 + (b) * 2 + (h)) * HTB)
#define PG8_STAGE(bufoff, gbase, voff) do { _Pragma("unroll") for (int _i = 0; _i < 2; ++_i) \
        __builtin_amdgcn_global_load_lds((const unsigned*)((const char*)(gbase) + (voff)[_i]), (PG8_LAS unsigned*)(lds + (bufoff) + ldsw + _i * 8192), 16, 0, 0); } while (0)
#define PG8_LDA(dst, b, h) do { _Pragma("unroll") for (int m = 0; m < 4; ++m) _Pragma("unroll") for (int k = 0; k < 2; ++k) dst[m][k] = *(const PG8_LAS bf16x8*)(lds + PG8_SA(b, h) + aoff + m * 2048 + k * 1024); } while (0)
#define PG8_LDB(dst, b, h) do { _Pragma("unroll") for (int n = 0; n < 2; ++n) _Pragma("unroll") for (int k = 0; k < 2; ++k) dst[n][k] = *(const PG8_LAS bf16x8*)(lds + PG8_SB(b, h) + boff + n * 2048 + k * 1024); } while (0)
#define PG8_MMA(ai, bj, At, Bt) do { __builtin_amdgcn_s_setprio(1); _Pragma("unroll") for (int m = 0; m < 4; ++m) _Pragma("unroll") for (int n = 0; n < 2; ++n) _Pragma("unroll") for (int k = 0; k < 2; ++k) \
        acc[ai][bj][m][n] = __builtin_amdgcn_mfma_f32_16x16x32_bf16(Bt[n][k], At[m][k], acc[ai][bj][m][n], 0, 0, 0); __builtin_amdgcn_s_setprio(0); } while (0)
#define PG8_WAIT_V(n) asm volatile("s_waitcnt vmcnt(" #n ")" ::: "memory")
#define PG8_WAIT_L(n) asm volatile("s_waitcnt lgkmcnt(" #n ")" ::: "memory")
#define PG8_BAR __builtin_amdgcn_s_barrier()
#define PG8_SCHED __builtin_amdgcn_sched_barrier(0)
    Unit cur, nxt; int ui = 0;
    if (!S.next(0, cur)) return;
    f32x4 acc[2][2][4][2];
#pragma unroll
    for (int a = 0; a < 2; ++a)
#pragma unroll
        for (int b = 0; b < 2; ++b)
#pragma unroll
            for (int m = 0; m < 4; ++m)
#pragma unroll
                for (int n = 0; n < 2; ++n) acc[a][b][m][n] = (f32x4){0.f, 0.f, 0.f, 0.f};
    bf16x8 At[4][2], B0[2][2], B1[2][2];
    const char* cA = GATHER ? (const char*)g.A : (const char*)g.A + (size_t)cur.pm * tstep; const char* cB = (const char*)g.Bt + (size_t)cur.pn * tstep;
    S.a_ready(cur);
    if constexpr (GATHER) PG8_GROWS(cur.pm, vc0, vc1);
    if constexpr (SP2) {
        PG8_STAGE(PG8_SB(0, 0), cB, voffB); PG8_STAGE(PG8_SB(0, 1), cB + hstep, voffB); PG8_STAGE_A(PG8_SA(0, 0), cA, 0, false); PG8_STAGE_A(PG8_SA(0, 1), cA, 1, false);
        if (wr == 1) PG8_BAR;
        PG8_WAIT_V(2); PG8_BAR;
        PG8_STAGE(PG8_SB(1, 0), cB + kstep, voffB); PG8_STAGE_A(PG8_SA(1, 0), cA + kstep, 0, false); PG8_STAGE(PG8_SB(1, 1), cB + hstep + kstep, voffB);
        PG8_WAIT_V(6); PG8_BAR;
    } else {
        PG8_STAGE(PG8_SB(0, 0), cB, voffB); PG8_STAGE(PG8_SA(0, 0), cA, voffA); PG8_STAGE(PG8_SB(0, 1), cB + hstep, voffB); PG8_STAGE(PG8_SA(0, 1), cA + hstep, voffA);
        if (wr == 1) PG8_BAR;
        PG8_WAIT_V(4); PG8_BAR;
        PG8_STAGE(PG8_SB(1, 0), cB + kstep, voffB); PG8_STAGE(PG8_SA(1, 0), cA + kstep, voffA); PG8_STAGE(PG8_SB(1, 1), cB + hstep + kstep, voffB);
        PG8_WAIT_V(6); PG8_BAR;
    }
    for (;;) {
        const bool has_next = S.next(ui + 1, nxt);
        const char* nA = GATHER ? (const char*)g.A : (has_next ? (const char*)g.A + (size_t)nxt.pm * tstep : cA); const char* nB = has_next ? (const char*)g.Bt + (size_t)nxt.pn * tstep : cB;
        if constexpr (GATHER) { if (has_next) PG8_GROWS(nxt.pm, vn0, vn1); else { vn0[0] = vc0[0]; vn0[1] = vc0[1]; vn1[0] = vc1[0]; vn1[1] = vc1[1]; } }
        for (int t = 0; t < nt; t += 2) {
            const bool last = (t == nt - 2);
            const char* a1 = cA + (size_t)(t + 1) * kstep;
            const char* a2 = last ? nA : cA + (size_t)(t + 2) * kstep; const char* b2 = last ? nB : cB + (size_t)(t + 2) * kstep;
            const char* a3 = a2 + kstep; const char* b3 = b2 + kstep;
            if (last && has_next) S.a_ready(nxt);
            if constexpr (SP2) {
            PG8_LDB(B0, 0, 0); PG8_LDB(B1, 0, 1); PG8_SCHED; PG8_LDA(At, 0, 0); PG8_STAGE_A(PG8_SA(1, 1), a1, 1, false);
            PG8_WAIT_V(8); PG8_WAIT_L(0); PG8_BAR; PG8_MMA(0, 0, At, B0); PG8_MMA(0, 1, At, B1); PG8_BAR; PG8_SCHED;
            PG8_LDA(At, 0, 1); PG8_STAGE(PG8_SB(0, 0), b2, voffB); PG8_STAGE(PG8_SB(0, 1), b2 + hstep, voffB); PG8_STAGE_A(PG8_SA(0, 0), a2, 0, last);
            PG8_WAIT_V(8); PG8_WAIT_L(0); PG8_BAR; PG8_MMA(1, 0, At, B0); PG8_MMA(1, 1, At, B1); PG8_BAR; PG8_SCHED;
            PG8_LDB(B0, 1, 0); PG8_LDB(B1, 1, 1); PG8_SCHED; PG8_LDA(At, 1, 0); PG8_STAGE_A(PG8_SA(0, 1), a2, 1, last);
            PG8_WAIT_V(8); PG8_WAIT_L(0); PG8_BAR; PG8_MMA(0, 0, At, B0); PG8_MMA(0, 1, At, B1); PG8_BAR; PG8_SCHED;
            PG8_LDA(At, 1, 1); PG8_STAGE(PG8_SB(1, 0), b3, voffB); PG8_STAGE(PG8_SB(1, 1), b3 + hstep, voffB); PG8_STAGE_A(PG8_SA(1, 0), a3, 0, last);
            PG8_WAIT_V(8); PG8_WAIT_L(0); PG8_BAR; PG8_MMA(1, 0, At, B0); PG8_MMA(1, 1, At, B1); PG8_BAR; PG8_SCHED;
            } else {
            PG8_LDB(B0, 0, 0); PG8_SCHED; PG8_LDA(At, 0, 0); PG8_STAGE(PG8_SA(1, 1), a1 + hstep, voffA);
            PG8_WAIT_L(8); PG8_BAR; PG8_WAIT_L(0); PG8_MMA(0, 0, At, B0); PG8_BAR; PG8_SCHED;
            PG8_LDB(B1, 0, 1); PG8_STAGE(PG8_SB(0, 0), b2, voffB);
            PG8_BAR; PG8_WAIT_L(0); PG8_MMA(0, 1, At, B1); PG8_BAR;
            PG8_LDA(At, 0, 1); PG8_STAGE(PG8_SA(0, 0), a2, voffA);
            PG8_BAR; PG8_WAIT_L(0); PG8_MMA(1, 0, At, B0); PG8_BAR; PG8_SCHED;
            PG8_STAGE(PG8_SB(0, 1), b2 + hstep, voffB);
            PG8_WAIT_V(6); PG8_BAR; PG8_MMA(1, 1, At, B1); PG8_BAR;
            PG8_LDB(B0, 1, 0); PG8_SCHED; PG8_LDA(At, 1, 0); PG8_STAGE(PG8_SA(0, 1), a2 + hstep, voffA);
            PG8_WAIT_L(8); PG8_BAR; PG8_WAIT_L(0); PG8_MMA(0, 0, At, B0); PG8_BAR; PG8_SCHED;
            PG8_LDB(B1, 1, 1); PG8_STAGE(PG8_SB(1, 0), b3, voffB);
            PG8_BAR; PG8_WAIT_L(0); PG8_MMA(0, 1, At, B1); PG8_BAR;
            PG8_LDA(At, 1, 1); PG8_STAGE(PG8_SA(1, 0), a3, voffA);
            PG8_BAR; PG8_WAIT_L(0); PG8_MMA(1, 0, At, B0); PG8_BAR; PG8_SCHED;
            PG8_STAGE(PG8_SB(1, 1), b3 + hstep, voffB);
            PG8_WAIT_V(6); PG8_BAR; PG8_MMA(1, 1, At, B1); PG8_BAR;
            }
        }
        if constexpr (ALIGN_EPI) { if (wr == 0) PG8_BAR; }
        if constexpr (!Epi::AFTER_DRAIN) { E(acc, cur, wr, wc, fr, fq); S.done(cur); }
        if (!has_next) break;
#pragma unroll
        for (int a = 0; a < 2; ++a)
#pragma unroll
            for (int b = 0; b < 2; ++b)
#pragma unroll
                for (int m = 0; m < 4; ++m)
#pragma unroll
                    for (int n = 0; n < 2; ++n) acc[a][b][m][n] = (f32x4){0.f, 0.f, 0.f, 0.f};
        cur = nxt; cA = nA; cB = nB; ++ui;
        if constexpr (GATHER) { vc0[0] = vn0[0]; vc0[1] = vn0[1]; vc1[0] = vn1[0]; vc1[1] = vn1[1]; }
        if constexpr (ALIGN_EPI) { if (wr == 1) PG8_BAR; }
    }
    PG8_WAIT_V(0);
    if constexpr (!ALIGN_EPI) { if (wr == 0) PG8_BAR; }
    PG8_BAR;
    if constexpr (Epi::AFTER_DRAIN) { E.fused(acc, cur, wr, wc, fr, fq, lds, wid, lane); S.done(cur); }
#undef PG8_SA
#undef PG8_SB
#undef PG8_STAGE
#undef PG8_STAGE_A
#undef PG8_GROWS
#undef PG8_LDA
#undef PG8_LDB
#undef PG8_MMA
#undef PG8_WAIT_V
#undef PG8_WAIT_L
#undef PG8_BAR
#undef PG8_SCHED
}
}

namespace attn {
typedef short bf16x8 __attribute__((ext_vector_type(8)));
typedef short s16x4 __attribute__((ext_vector_type(4)));
typedef float f32x16 __attribute__((ext_vector_type(16)));
typedef unsigned u32x4 __attribute__((ext_vector_type(4)));
typedef unsigned short bf16;
constexpr int D = 128, PITCH = 1024, SEQ = 2048;
constexpr float SCALE = 0.08838834764831845f, THR = 8.f;
constexpr int NW = 8, QBLK = 32, KVBLK = 64, QB = NW * QBLK;
constexpr int SHM_V = KVBLK * D * 2, SHM_K = KVBLK * D * 2;
constexpr int BIAS_OFF = 2 * SHM_V + 2 * SHM_K + NW * 64 * 4, NBIAS = 320;
constexpr int LDS_BYTES = BIAS_OFF + NBIAS * 4;
#define KSWZ(row, colB) ((row) * 256 + ((colB) ^ (((row) & 7) << 4)))
#define SBAR() __builtin_amdgcn_sched_barrier(0)
__device__ __forceinline__ int v_st(int k, int c) { const int kk = (k & ~0xC) | ((k & 4) << 1) | ((k & 8) >> 1); return ((kk >> 3) * 4 + (c >> 5)) * 512 + ((kk & 7) * 32 + (c & 31)) * 2; }
__device__ __forceinline__ int v_rd_base(int lane) { return ((lane & 3) << 3) | (((lane >> 2) & 3) << 6) | (((lane >> 4) & 1) << 5) | (((lane >> 5) & 1) << 8); }
constexpr int v_rd_off(int d0, int ks, int half) { return d0 * 512 + ks * 4096 + half * 2048; }
__device__ __forceinline__ int crow(int r, int hi) { return (r & 3) + 8 * (r >> 2) + 4 * hi; }
__device__ __forceinline__ unsigned cvtpk(float lo, float hi) { unsigned r; asm volatile("v_cvt_pk_bf16_f32 %0, %1, %2" : "=v"(r) : "v"(lo), "v"(hi)); return r; }
__device__ __forceinline__ bf16x8 load8(const bf16* p) { return *reinterpret_cast<const bf16x8*>(p); }
__device__ __forceinline__ int t5_bucket(int rel) {
    const int b = rel > 0 ? 16 : 0; const int n = rel < 0 ? -rel : rel; int v;
    if (n < 8) v = n; else if (n < 12) v = 8; else if (n < 16) v = 9; else if (n < 23) v = 10; else if (n < 32) v = 11; else if (n < 46) v = 12; else if (n < 65) v = 13; else if (n < 91) v = 14; else v = 15;
    return b + v;
}
__device__ __forceinline__ void bias_tile(f32x16& p0, f32x16& p1, const float* tabp) {
#pragma unroll
    for (int r = 0; r < 16; ++r) { const int c = (r & 3) + 8 * (r >> 2); p0[r] += tabp[59 - c]; p1[r] += tabp[59 - c - 32]; }
}
__device__ __forceinline__ void partialSM(f32x16& p0, f32x16& p1, float& m_reg, float& mn, float& alpha) {
    float pmax = p0[0]; for (int r = 1; r < 16; ++r) pmax = fmaxf(pmax, p0[r]); for (int r = 0; r < 16; ++r) pmax = fmaxf(pmax, p1[r]);
    { auto rr = __builtin_amdgcn_permlane32_swap(__float_as_uint(pmax), __float_as_uint(pmax), false, false);
      pmax = fmaxf(__uint_as_float(rr[0]), __uint_as_float(rr[1])); }
    constexpr float C2 = 1.4426950408889634f * SCALE;
    if (__builtin_expect(__all((pmax - m_reg) * SCALE <= THR), 1)) { mn = m_reg; alpha = 1.f; }
    else { mn = fmaxf(m_reg, pmax); alpha = __builtin_amdgcn_exp2f((m_reg - mn) * C2); m_reg = mn; }
    const float mnL = -mn * C2;
    for (int r = 0; r < 16; ++r) p0[r] = fmaf(p0[r], C2, mnL); for (int r = 0; r < 16; ++r) p1[r] = fmaf(p1[r], C2, mnL);
    for (int r = 0; r < 16; ++r) p0[r] = __builtin_amdgcn_exp2f(p0[r]);
}
__device__ __forceinline__ void finishSM(f32x16& p0, f32x16& p1, float alpha, float& l_reg, bf16x8& pa0, bf16x8& pa1, bf16x8& pa2, bf16x8& pa3) {
    for (int r = 0; r < 16; ++r) p1[r] = __builtin_amdgcn_exp2f(p1[r]);
    float ps = 0; for (int r = 0; r < 16; ++r) ps += p0[r]; for (int r = 0; r < 16; ++r) ps += p1[r];
    { auto rr = __builtin_amdgcn_permlane32_swap(__float_as_uint(ps), __float_as_uint(ps), false, false);
      ps = __uint_as_float(rr[0]) + __uint_as_float(rr[1]); }
    l_reg = l_reg * alpha + ps;
#define PK4(P, B_, OUT) do { unsigned a0 = cvtpk(P[B_+0], P[B_+1]), a1 = cvtpk(P[B_+2], P[B_+3]);                          \
        unsigned b0 = cvtpk(P[B_+4], P[B_+5]), b1 = cvtpk(P[B_+6], P[B_+7]);                                             \
        auto r0 = __builtin_amdgcn_permlane32_swap(a0, b0, false, false); auto r1 = __builtin_amdgcn_permlane32_swap(a1, b1, false, false); \
        u32x4 w = {r0[0], r1[0], r0[1], r1[1]}; OUT = *reinterpret_cast<bf16x8*>(&w); } while (0)
    PK4(p0, 0, pa0); PK4(p0, 8, pa1); PK4(p1, 0, pa2); PK4(p1, 8, pa3);
#undef PK4
}
template <int KB>
__device__ __forceinline__ void qkt(f32x16& p0, f32x16& p1, const char* K_lds, int r32, int hi, const bf16x8* qr, bool act) {
    if (!act) { const float NEG = -__builtin_inff();
#pragma unroll
        for (int r = 0; r < 16; ++r) { p0[r] = NEG; p1[r] = NEG; } return; }
    p0 = f32x16{}; p1 = f32x16{};
    const char* kb[4];
#pragma unroll
    for (int dd = 0; dd < 4; ++dd) kb[dd] = K_lds + KB * SHM_K + KSWZ(r32, (dd * 16 + hi * 8) * 2);
#pragma unroll
    for (int d0 = 0; d0 < 8; ++d0) { const char* a = kb[d0 & 3] + (d0 >> 2) * 128;
        bf16x8 b0 = *reinterpret_cast<const bf16x8*>(a);
        bf16x8 b1 = *reinterpret_cast<const bf16x8*>(a + 32 * 256);
        p0 = __builtin_amdgcn_mfma_f32_32x32x16_bf16(b0, qr[d0], p0, 0, 0, 0);
        p1 = __builtin_amdgcn_mfma_f32_32x32x16_bf16(b1, qr[d0], p1, 0, 0, 0); }
}
template <int VB>
__device__ __forceinline__ void pv_tile(f32x16* o, int vb0, bf16x8 pa0, bf16x8 pa1, bf16x8 pa2, bf16x8 pa3, bool act) {
    if (!act) return;
#define TRRD(dst, off) asm volatile("ds_read_b64_tr_b16 %0, %1 offset:%2" : "=&v"(dst) : "v"(vb0), "i"(off) : "memory")
#define PV_D0(d0) do { s16x4 l0, l1, l2, l3, h0, h1, h2, h3; constexpr int b_ = VB * SHM_V + v_rd_off(d0, 0, 0); \
        TRRD(l0, b_); TRRD(h0, b_ + 2048); TRRD(l1, b_ + 4096); TRRD(h1, b_ + 6144); TRRD(l2, b_ + 8192); TRRD(h2, b_ + 10240); TRRD(l3, b_ + 12288); TRRD(h3, b_ + 14336); \
        asm volatile("s_waitcnt lgkmcnt(0)" ::: "memory"); SBAR();   \
        o[d0] = __builtin_amdgcn_mfma_f32_32x32x16_bf16(pa0, (bf16x8){l0[0], l0[1], l0[2], l0[3], h0[0], h0[1], h0[2], h0[3]}, o[d0], 0, 0, 0);   \
        o[d0] = __builtin_amdgcn_mfma_f32_32x32x16_bf16(pa1, (bf16x8){l1[0], l1[1], l1[2], l1[3], h1[0], h1[1], h1[2], h1[3]}, o[d0], 0, 0, 0);   \
        o[d0] = __builtin_amdgcn_mfma_f32_32x32x16_bf16(pa2, (bf16x8){l2[0], l2[1], l2[2], l2[3], h2[0], h2[1], h2[2], h2[3]}, o[d0], 0, 0, 0);   \
        o[d0] = __builtin_amdgcn_mfma_f32_32x32x16_bf16(pa3, (bf16x8){l3[0], l3[1], l3[2], l3[3], h3[0], h3[1], h3[2], h3[3]}, o[d0], 0, 0, 0); } while (0)
    PV_D0(0); PV_D0(1); PV_D0(2); PV_D0(3);
#undef PV_D0
#undef TRRD
}
struct BlockRef { const bf16* Q; const bf16* K; const bf16* V; bf16* O; int P0; };
struct Seam { bf16x8 qr[8]; bf16x8 st_v0, st_v1, st_k0, st_k1; };
#define ROW(p, k0, rr) ((p) + (size_t)((k0) + (rr)) * PITCH + sc)
#define VMW() asm volatile("s_waitcnt vmcnt(0)" ::: "memory")
#define VMWN(n) asm volatile("s_waitcnt vmcnt(%0)" :: "i"(n) : "memory")
#define SLOAD_H(Kp, Vp, k0) do { S.st_v0 = load8(ROW(Vp, k0, sr)); S.st_v1 = load8(ROW(Vp, k0, 32 + sr)); S.st_k0 = load8(ROW(Kp, k0, sr)); S.st_k1 = load8(ROW(Kp, k0, 32 + sr)); } while (0)
#define SWRITE_HK(bf) do { *(bf16x8*)(K_lds + (bf) * SHM_K + kws) = S.st_k0; *(bf16x8*)(K_lds + (bf) * SHM_K + kws + 32 * 256) = S.st_k1; } while (0)
#define SWRITE_HV(bf) do { *(bf16x8*)(V_lds + (bf) * SHM_V + vst0) = S.st_v0; *(bf16x8*)(V_lds + (bf) * SHM_V + vst1) = S.st_v1; } while (0)
#define SWRITE_H(bf) do { SWRITE_HV(bf); SWRITE_HK(bf); } while (0)
__device__ __forceinline__ void attn_prime(const BlockRef& cur, char* lds, Seam& S) {
    const int tid = threadIdx.x, wid = __builtin_amdgcn_readfirstlane(tid >> 6), lane = tid & 63, r32 = lane & 31, hi = lane >> 5;
    const int sr = tid >> 4, sc = (tid & 15) * 8, kws = KSWZ(sr, sc * 2); char* K_lds = lds + 2 * SHM_V;
#pragma unroll
    for (int d0 = 0; d0 < 8; ++d0) S.qr[d0] = load8(cur.Q + (size_t)(wid * QBLK + r32) * PITCH + d0 * 16 + hi * 8);
    SLOAD_H(cur.K, cur.V, 0); VMW(); SWRITE_HK(0);
    __syncthreads();
}
__device__ __forceinline__ void attn_block(const BlockRef& cur, const BlockRef& nxt, char* lds, Seam& S) {
    const int tid = threadIdx.x, wid = __builtin_amdgcn_readfirstlane(tid >> 6), lane = tid & 63, r32 = lane & 31, hi = lane >> 5;
    const int NT = cur.P0 / KVBLK + QB / KVBLK;
    const int qlo = cur.P0 + wid * QBLK, cw = qlo >> 6;
    char* V_lds = lds; char* K_lds = lds + 2 * SHM_V;
    float* ws = (float*)(lds + 2 * SHM_V + 2 * SHM_K) + wid * 64; float* li_l = ws, * al_l = ws + 32;
    const float* btab = (const float*)(lds + BIAS_OFF);
    float m_reg = -1e30f, l_reg = 0; f32x16 o[4] = {};
    const int sr = tid >> 4, sc = (tid & 15) * 8, vst0 = v_st(sr, sc), vst1 = v_st(32 + sr, sc), kws = KSWZ(sr, sc * 2);
    const int vb0 = (int)(uintptr_t)V_lds + v_rd_base(lane);
    const bf16* Kh = cur.K; const bf16* Vh = cur.V;
    const int bb0 = qlo + r32 - 4 * hi + 4;
#define RESC(a) do { if (__any((a) < 1.f)) { if (hi == 0) al_l[r32] = (a); asm volatile("s_waitcnt lgkmcnt(0)" ::: "memory");              \
                     for (int d_ = 0; d_ < 4; ++d_) for (int r = 0; r < 16; ++r) o[d_][r] *= al_l[crow(r, hi)]; } } while (0)
#define KBASE(t) ((t) * KVBLK)
#define ACT(t) ((t) <= cw)
#define BIAST(P0_, P1_, t) do { if ((t) <= cw && (t) + 2 >= cw) bias_tile(P0_, P1_, btab + (bb0 - KBASE(t))); } while (0)
    constexpr int NQL = 8;
#define SEAM_K0() do { VMWN(NQL); SWRITE_HK(0); SBAR(); } while (0)
    f32x16 pA0, pA1, pB0, pB1; float mnA, mnB, alA, alB; bf16x8 pa0, pa1, pa2, pa3;
    SWRITE_HV(0); SBAR();
    SLOAD_H(Kh, Vh, KBASE(1));
    SBAR(); qkt<0>(pA0, pA1, K_lds, r32, hi, S.qr, ACT(0));
    BIAST(pA0, pA1, 0); partialSM(pA0, pA1, m_reg, mnA, alA);
    VMW(); SWRITE_H(1);
    __syncthreads();
#define HALF_STEP(PX0, PX1, mnX, alX, PY0, PY1, alY, t, KB, VB, SB) do {                                                      \
        SBAR(); qkt<KB>(PX0, PX1, K_lds, r32, hi, S.qr, ACT(t));                                                 \
        finishSM(PY0, PY1, alY, l_reg, pa0, pa1, pa2, pa3); SBAR();                                                           \
        if ((t) + 1 < NT) { SLOAD_H(Kh, Vh, KBASE((t) + 1)); SBAR(); }                                                         \
        pv_tile<VB>(o, vb0, pa0, pa1, pa2, pa3, ACT((t) - 1)); BIAST(PX0, PX1, (t)); partialSM(PX0, PX1, m_reg, mnX, alX);    \
        __syncthreads();                                                                                                      \
        if ((t) + 1 < NT) { VMW(); SWRITE_H(SB); }                                                                             \
        RESC(alX); __syncthreads(); } while (0)
    for (int t = 1; t + 1 < NT; t += 2) {
        HALF_STEP(pB0, pB1, mnB, alB, pA0, pA1, alA, t, 1, 0, 0);
        HALF_STEP(pA0, pA1, mnA, alA, pB0, pB1, alB, t + 1, 0, 1, 1);
    }
    { SBAR(); qkt<1>(pB0, pB1, K_lds, r32, hi, S.qr, ACT(NT - 1)); SBAR(); }
    SLOAD_H(nxt.K, nxt.V, 0); SBAR();
#pragma unroll
    for (int d0 = 0; d0 < 8; ++d0) S.qr[d0] = load8(nxt.Q + (size_t)(wid * QBLK + r32) * PITCH + d0 * 16 + hi * 8);
    SBAR();
    finishSM(pA0, pA1, alA, l_reg, pa0, pa1, pa2, pa3); SBAR();
    pv_tile<0>(o, vb0, pa0, pa1, pa2, pa3, ACT(NT - 2));
    { BIAST(pB0, pB1, NT - 1); partialSM(pB0, pB1, m_reg, mnB, alB); __syncthreads(); RESC(alB);
      finishSM(pB0, pB1, alB, l_reg, pa0, pa1, pa2, pa3); SBAR(); pv_tile<1>(o, vb0, pa0, pa1, pa2, pa3, ACT(NT - 1)); }
    SBAR(); SEAM_K0();
    if (hi == 0) li_l[r32] = l_reg; asm volatile("s_waitcnt lgkmcnt(0)" ::: "memory");
    float rli[16];
#pragma unroll
    for (int r = 0; r < 16; ++r) rli[r] = __builtin_amdgcn_rcpf(li_l[crow(r, hi)]);
    bf16* Ow = cur.O + (size_t)(wid * QBLK) * PITCH;
#pragma unroll
    for (int r = 0; r < 16; ++r) { const int orow = crow(r, hi);
#pragma unroll
        for (int d0 = 0; d0 < 4; ++d0) { const float v = o[d0][r] * rli[r];
            const float vn = __shfl_xor(v, 1);
            if ((r32 & 1) == 0) *(unsigned*)(Ow + (size_t)orow * PITCH + d0 * 32 + r32) = cvtpk(v, vn); } }
    __syncthreads();
#undef RESC
#undef KBASE
#undef ACT
#undef BIAST
#undef SEAM_K0
#undef HALF_STEP
}
#undef ROW
#undef VMW
#undef VMWN
#undef SLOAD_H
#undef SWRITE_HK
#undef SWRITE_HV
#undef SWRITE_H
#undef KSWZ
}

namespace attn2 {
using attn::bf16x8; using attn::s16x4; using attn::f32x16; using attn::u32x4; using attn::bf16;
using attn::v_st; using attn::v_rd_base; using attn::crow; using attn::cvtpk; using attn::load8; using attn::t5_bucket;
constexpr int D = 128, PITCH = 1024;
constexpr float SCALE = 0.08838834764831845f, THR = 8.f;
constexpr int NW = 8, QBLK = 32, KVBLK = 64, QB = 4 * QBLK;
constexpr int IMG = KVBLK * D * 2, SHM_V = 2 * IMG, SHM_K = KVBLK * D * 2;
constexpr int OFF_V = 0, OFF_K = 2 * SHM_V, OFF_PX = OFF_K + 2 * SHM_K, OFF_WS = OFF_PX + NW * 2048, OFF_MX = OFF_WS + NW * 64 * 4, BIAS_OFF = OFF_MX + NW * 32 * 4, NBIAS = 320;
constexpr int LDS_BYTES = BIAS_OFF + NBIAS * 4;
#define KSWZ(row, colB) ((row) * 256 + ((colB) ^ (((row) & 7) << 4)))
#define SBAR() __builtin_amdgcn_sched_barrier(0)
#define L3 __attribute__((address_space(3)))
#define LP(T, byteoff) ((L3 T*)(uintptr_t)(unsigned)(byteoff))
__device__ __forceinline__ void bias_half(f32x16& p, const L3 float* tabp) {
#pragma unroll
    for (int r = 0; r < 16; ++r) { const int c = (r & 3) + 8 * (r >> 2); p[r] += tabp[59 - c]; }
}
__device__ __forceinline__ float rowmax_half(const f32x16& p) {
    float pmax = p[0];
#pragma unroll
    for (int r = 1; r < 16; ++r) pmax = fmaxf(pmax, p[r]);
    const auto rr = __builtin_amdgcn_permlane32_swap(__float_as_uint(pmax), __float_as_uint(pmax), false, false);
    return fmaxf(__uint_as_float(rr[0]), __uint_as_float(rr[1]));
}
__device__ __forceinline__ void partialSM(f32x16& p, float pmax, float& m_reg, float& alpha) {
    constexpr float C2 = 1.4426950408889634f * SCALE; float mn;
    if (__builtin_expect(__all((pmax - m_reg) * SCALE <= THR), 1)) { mn = m_reg; alpha = 1.f; }
    else { mn = fmaxf(m_reg, pmax); alpha = __builtin_amdgcn_exp2f((m_reg - mn) * C2); m_reg = mn; }
    const float mnL = -mn * C2;
#pragma unroll
    for (int r = 0; r < 16; ++r) p[r] = fmaf(p[r], C2, mnL);
#pragma unroll
    for (int r = 0; r < 8; ++r) p[r] = __builtin_amdgcn_exp2f(p[r]);
}
__device__ __forceinline__ void finishSM(f32x16& p, float alpha, float& l_reg, bf16x8& pa0, bf16x8& pa1) {
#pragma unroll
    for (int r = 8; r < 16; ++r) p[r] = __builtin_amdgcn_exp2f(p[r]);
    float ps = 0;
#pragma unroll
    for (int r = 0; r < 16; ++r) ps += p[r];
    { const auto rr = __builtin_amdgcn_permlane32_swap(__float_as_uint(ps), __float_as_uint(ps), false, false); ps = __uint_as_float(rr[0]) + __uint_as_float(rr[1]); }
    l_reg = l_reg * alpha + ps;
#define PK4(P, B_, OUT) do { unsigned a0 = cvtpk(P[B_+0], P[B_+1]), a1 = cvtpk(P[B_+2], P[B_+3]);                          \
        unsigned b0 = cvtpk(P[B_+4], P[B_+5]), b1 = cvtpk(P[B_+6], P[B_+7]);                                             \
        auto r0 = __builtin_amdgcn_permlane32_swap(a0, b0, false, false); auto r1 = __builtin_amdgcn_permlane32_swap(a1, b1, false, false); \
        u32x4 w = {r0[0], r1[0], r0[1], r1[1]}; OUT = *reinterpret_cast<bf16x8*>(&w); } while (0)
    PK4(p, 0, pa0); PK4(p, 8, pa1);
#undef PK4
}
template <int KB>
__device__ __forceinline__ void qkt(f32x16& p, unsigned K_lds, int krow, int hi, const bf16x8* qr, bool act) {
    if (!act) { const float NEG = -__builtin_inff();
#pragma unroll
        for (int r = 0; r < 16; ++r) p[r] = NEG; return; }
    p = f32x16{};
    unsigned kb[4];
#pragma unroll
    for (int dd = 0; dd < 4; ++dd) kb[dd] = K_lds + KB * SHM_K + KSWZ(krow, (dd * 16 + hi * 8) * 2);
#pragma unroll
    for (int d0 = 0; d0 < 8; ++d0) { const bf16x8 b = *LP(const bf16x8, kb[d0 & 3] + (d0 >> 2) * 128); p = __builtin_amdgcn_mfma_f32_32x32x16_bf16(b, qr[d0], p, 0, 0, 0); }
}
template <int VB>
__device__ __forceinline__ void pv_tile(f32x16* o, int vbo, int vbp, bf16x8 po0, bf16x8 po1, bf16x8 pp0, bf16x8 pp1, bool act) {
    if (!act) return;
#define TRRD(dst, base, off) asm volatile("ds_read_b64_tr_b16 %0, %1 offset:%2" : "=&v"(dst) : "v"(base), "i"(off) : "memory")
#define PV_D0(d0) do { s16x4 l0, l1, l2, l3, h0, h1, h2, h3; constexpr int b_ = VB * SHM_V + (d0) * 512; \
        TRRD(l0, vbo, b_); TRRD(h0, vbo, b_ + 2048); TRRD(l1, vbo, b_ + 4096); TRRD(h1, vbo, b_ + 6144); TRRD(l2, vbp, b_); TRRD(h2, vbp, b_ + 2048); TRRD(l3, vbp, b_ + 4096); TRRD(h3, vbp, b_ + 6144); \
        asm volatile("s_waitcnt lgkmcnt(0)" ::: "memory"); SBAR();   \
        o[d0] = __builtin_amdgcn_mfma_f32_32x32x16_bf16(po0, (bf16x8){l0[0], l0[1], l0[2], l0[3], h0[0], h0[1], h0[2], h0[3]}, o[d0], 0, 0, 0);   \
        o[d0] = __builtin_amdgcn_mfma_f32_32x32x16_bf16(po1, (bf16x8){l1[0], l1[1], l1[2], l1[3], h1[0], h1[1], h1[2], h1[3]}, o[d0], 0, 0, 0);   \
        o[d0] = __builtin_amdgcn_mfma_f32_32x32x16_bf16(pp0, (bf16x8){l2[0], l2[1], l2[2], l2[3], h2[0], h2[1], h2[2], h2[3]}, o[d0], 0, 0, 0);   \
        o[d0] = __builtin_amdgcn_mfma_f32_32x32x16_bf16(pp1, (bf16x8){l3[0], l3[1], l3[2], l3[3], h3[0], h3[1], h3[2], h3[3]}, o[d0], 0, 0, 0); } while (0)
    PV_D0(0); PV_D0(1); PV_D0(2); PV_D0(3);
#undef PV_D0
#undef TRRD
}
struct BlockRef { const bf16* Q; const bf16* K; const bf16* V; bf16* O; int P0; };
struct Seam { bf16x8 qr[8]; bf16x8 st_k0, st_k1, st_v0, st_v1, st_v2, st_v3; };
#define ROW(p, k0, rr) ((p) + (((k0) + (rr)) * PITCH + sc))
#define VMW() asm volatile("s_waitcnt vmcnt(0)" ::: "memory")
#define VMWN(n) asm volatile("s_waitcnt vmcnt(%0)" :: "i"(n) : "memory")
#define SLOAD(Kp, Vp, k0) do { S.st_k0 = load8(ROW(Kp, k0, sr)); S.st_k1 = load8(ROW(Kp, k0, 32 + sr)); S.st_v0 = load8(ROW(Vp, k0, sr)); S.st_v1 = load8(ROW(Vp, k0, 32 + sr)); \
                               S.st_v2 = load8(ROW(Vp, k0, sr) + 128); S.st_v3 = load8(ROW(Vp, k0, 32 + sr) + 128); } while (0)
#define SWRITE_K(bf) do { *LP(bf16x8, K_lds + (bf) * SHM_K + kws) = S.st_k0; *LP(bf16x8, K_lds + (bf) * SHM_K + kws + 32 * 256) = S.st_k1; } while (0)
#define SWRITE_V(bf) do { *LP(bf16x8, V_lds + (bf) * SHM_V + vst0) = S.st_v0; *LP(bf16x8, V_lds + (bf) * SHM_V + vst0 + VST1) = S.st_v1; *LP(bf16x8, V_lds + (bf) * SHM_V + IMG + vst0) = S.st_v2; *LP(bf16x8, V_lds + (bf) * SHM_V + IMG + vst0 + VST1) = S.st_v3; } while (0)
__device__ __forceinline__ void attn_prime(const BlockRef& cur, char* lds, Seam& S) {
    const int tid = threadIdx.x, wid = __builtin_amdgcn_readfirstlane(tid >> 6), lane = tid & 63, r32 = lane & 31, hi = lane >> 5, pj = wid & 3;
    const int sr = tid >> 4, sc = (tid & 15) * 8, kws = KSWZ(sr, sc * 2); const unsigned K_lds = (unsigned)(uintptr_t)lds + OFF_K;
#pragma unroll
    for (int d0 = 0; d0 < 8; ++d0) S.qr[d0] = load8(cur.Q + ((pj * QBLK + r32) * PITCH + d0 * 16 + hi * 8));
    SLOAD(cur.K, cur.V, 0); VMW(); SWRITE_K(0);
    __syncthreads();
}
__device__ __forceinline__ void attn_block(const BlockRef& cur, const BlockRef& nxt, char* lds, Seam& S) {
    const int tid = threadIdx.x, wid = __builtin_amdgcn_readfirstlane(tid >> 6), lane = tid & 63, r32 = lane & 31, hi = lane >> 5, pj = wid & 3, kh = wid >> 2, pw = wid ^ 4;
    const int NT = cur.P0 / KVBLK + QB / KVBLK;
    const int qlo = cur.P0 + pj * QBLK, cw = qlo >> 6;
    const unsigned L = (unsigned)(uintptr_t)lds, V_lds = L + OFF_V, K_lds = L + OFF_K;
    L3 float* li_l = LP(float, L + OFF_WS + wid * 256); L3 float* al_l = li_l + 32; const L3 float* li_p = LP(const float, L + OFF_WS + pw * 256);
    L3 float* mx_o = LP(float, L + OFF_MX + wid * 128); const L3 float* mx_p = LP(const float, L + OFF_MX + pw * 128);
    const unsigned px_o = L + OFF_PX + wid * 2048 + lane * 16, px_p = L + OFF_PX + pw * 2048 + lane * 16;
    const L3 float* btab = LP(const float, L + BIAS_OFF);
    float m_reg = -1e30f, l_reg = 0; f32x16 o[4] = {};
    const int sr = tid >> 4, sc = (tid & 15) * 8, vst0 = v_st(sr, sc), kws = KSWZ(sr, sc * 2); constexpr int VST1 = 8192;
    const int vbase = (int)V_lds + v_rd_base(lane) + kh * IMG, vbo = vbase + kh * 8192, vbp = vbase + (1 - kh) * 8192;
    const int krow = kh * 32 + r32;
    const bf16* Kh = cur.K; const bf16* Vh = cur.V;
    const int bb0 = qlo + r32 - 4 * hi + 4 - 32 * kh;
#define RESC(a) do { if (__any((a) < 1.f)) { if (hi == 0) al_l[r32] = (a); asm volatile("s_waitcnt lgkmcnt(0)" ::: "memory");              \
                     for (int d_ = 0; d_ < 4; ++d_) for (int r = 0; r < 16; ++r) o[d_][r] *= al_l[crow(r, hi)]; } } while (0)
#define KBASE(t) ((t) * KVBLK)
#define ACT(t) ((t) <= cw)
#define BIAST(P_, t) do { if ((t) <= cw && (t) + 2 >= cw) bias_half(P_, btab + (bb0 - KBASE(t))); } while (0)
#define PUTMAX(P_) do { const float pm_ = rowmax_half(P_); if (hi == 0) mx_o[r32] = pm_; pmx = pm_; } while (0)
#define GETMAX() fmaxf(pmx, mx_p[r32])
    f32x16 pA, pB; float alA, alB, pmx; bf16x8 po0, po1, pp0, pp1;
    SWRITE_V(0); SBAR();
    SLOAD(Kh, Vh, KBASE(1));
    SBAR(); qkt<0>(pA, K_lds, krow, hi, S.qr, ACT(0));
    BIAST(pA, 0); PUTMAX(pA);
    __syncthreads();
    partialSM(pA, GETMAX(), m_reg, alA);
    VMW(); SWRITE_K(1);
    __syncthreads();
#define STEP(PX_, alX, PY_, alY, t, KB, VBP) do {                                                                                  \
        SBAR(); SWRITE_V(KB); SBAR();                                                                                              \
        if ((t) + 1 < NT) { SLOAD(Kh, Vh, KBASE((t) + 1)); SBAR(); }                                                                \
        qkt<KB>(PX_, K_lds, krow, hi, S.qr, ACT(t));                                                                               \
        finishSM(PY_, alY, l_reg, po0, po1); *LP(bf16x8, px_o) = po0; *LP(bf16x8, px_o + 1024) = po1; SBAR();                           \
        BIAST(PX_, (t)); PUTMAX(PX_);                                                                                               \
        __syncthreads();                                                                                                           \
        pp0 = *LP(const bf16x8, px_p); pp1 = *LP(const bf16x8, px_p + 1024);                                                        \
        partialSM(PX_, GETMAX(), m_reg, alX);                                                                                      \
        pv_tile<VBP>(o, vbo, vbp, po0, po1, pp0, pp1, ACT((t) - 1));                                                               \
        if ((t) + 1 < NT) { VMWN(4); SWRITE_K(VBP); }                                                                               \
        RESC(alX); __syncthreads(); } while (0)
    for (int t = 1; t + 1 < NT; t += 2) {
        STEP(pB, alB, pA, alA, t, 1, 0);
        STEP(pA, alA, pB, alB, t + 1, 0, 1);
    }
    STEP(pB, alB, pA, alA, NT - 1, 1, 0);
    SLOAD(nxt.K, nxt.V, 0); SBAR();
#pragma unroll
    for (int d0 = 0; d0 < 8; ++d0) S.qr[d0] = load8(nxt.Q + ((pj * QBLK + r32) * PITCH + d0 * 16 + hi * 8));
    SBAR();
    finishSM(pB, alB, l_reg, po0, po1); *LP(bf16x8, px_o) = po0; *LP(bf16x8, px_o + 1024) = po1;
    if (hi == 0) li_l[r32] = l_reg;
    __syncthreads();
    pp0 = *LP(const bf16x8, px_p); pp1 = *LP(const bf16x8, px_p + 1024);
    pv_tile<1>(o, vbo, vbp, po0, po1, pp0, pp1, ACT(NT - 1));
    SBAR(); VMWN(8); SWRITE_K(0); SBAR();
    float rli[16];
#pragma unroll
    for (int r = 0; r < 16; ++r) rli[r] = __builtin_amdgcn_rcpf(li_l[crow(r, hi)] + li_p[crow(r, hi)]);
    int lane_off = hi * 4 * PITCH + r32; asm volatile("" : "+v"(lane_off));
    bf16* Ow = cur.O + ((pj * QBLK) * PITCH + kh * 128 + lane_off);
#pragma unroll
    for (int r = 0; r < 16; ++r) { constexpr int dummy = 0; const int orow = (r & 3) + 8 * (r >> 2) + dummy;
#pragma unroll
        for (int d0 = 0; d0 < 4; ++d0) { const float v = o[d0][r] * rli[r];
            const float vn = __shfl_xor(v, 1);
            if ((r32 & 1) == 0) *(unsigned*)(Ow + (orow * PITCH + d0 * 32)) = cvtpk(v, vn); } }
    __syncthreads();
#undef RESC
#undef KBASE
#undef ACT
#undef BIAST
#undef PUTMAX
#undef GETMAX
#undef STEP
}
#undef ROW
#undef VMW
#undef VMWN
#undef SLOAD
#undef SWRITE_K
#undef SWRITE_V
#undef KSWZ
#undef L3
#undef LP
}


constexpr int NWAVES = 8;
constexpr int BATCH = 16, SEQ = 2048, T = BATCH * SEQ, D = 1024, NIN = 8192, NE = 32, DE = 512;
constexpr int MAXT = 288, MAXS = MAXT * 256;
constexpr float LN_EPS = 1e-5f, RMS_EPS = 1e-6f, ALPHA = 1.189207115002721f, LAM_INIT = 0.2f;
constexpr size_t MiB = 1u << 20;
constexpr size_t WS_CTL = 0, CTL_ZERO_BYTES = 1 * MiB;
constexpr size_t WS_STATS = 1 * MiB, WS_EID = WS_STATS + 256 * 1024, WS_EW = WS_EID + 256 * 1024, WS_RANK = WS_EW + 256 * 1024, WS_SLOT = 2 * MiB, WS_CNTWG = WS_SLOT + 256 * 1024, WS_TOK = 3 * MiB;
constexpr size_t WS_WA = 4 * MiB, WS_WB = 6 * MiB, WS_WO = 8 * MiB, WS_WIN = 10 * MiB;
constexpr size_t WS_XN = 26 * MiB, WS_Q = 90 * MiB, WS_K = 154 * MiB, WS_V = 218 * MiB, WS_CB = 282 * MiB, WS_Z = 346 * MiB, WS_O1 = 410 * MiB;
constexpr size_t WS_WGU = 90 * MiB, WS_WD = 154 * MiB, WS_PRE = 186 * MiB, WS_XG = 314 * MiB, WS_END = 458 * MiB;
constexpr int CW_TMO = 0, CW_CODE = 1, CW_BAR = 4096, CW_MOE = 65536;
constexpr int RING_OFF = 0, RING_BYTES = 131072, RW_BYTES = 147456;
constexpr int LDSCTL_OFF = RW_BYTES, MISC_OFF = LDSCTL_OFF + 320, TAB_OFF = LDSCTL_OFF + 512, RSCR_OFF = LDSCTL_OFF + 1024;
constexpr int LDS_BYTES = 163840;
static_assert(RSCR_OFF + 8 * 128 * 4 + 1024 <= LDS_BYTES, "LDS map");

#define GAS __attribute__((address_space(1)))
#define LAS __attribute__((address_space(3)))
typedef unsigned short bf16;
#ifdef SWAP_CB_SGA
#define BUF_CB(P)  ((bf16*)(P).out)
#define BUF_SGA(P) ((bf16*)((P).ws + WS_CB))
#else
#define BUF_CB(P)  ((bf16*)((P).ws + WS_CB))
#define BUF_SGA(P) ((bf16*)(P).out)
#endif
#define BUF_SGB(P) ((bf16*)(P).out + (size_t)T * D)
typedef unsigned v4u __attribute__((ext_vector_type(4)));
typedef unsigned v2u __attribute__((ext_vector_type(2)));
typedef float f32x4 __attribute__((ext_vector_type(4)));
typedef GAS unsigned gu32;
#define RLX_AGENT __ATOMIC_RELAXED, __HIP_MEMORY_SCOPE_AGENT
#define LDS_WAIT() asm volatile("s_waitcnt lgkmcnt(0)" ::: "memory")
#define VM_WAIT() asm volatile("s_waitcnt vmcnt(0)" ::: "memory")
__device__ __forceinline__ unsigned f2bf(float f) { unsigned u = __builtin_bit_cast(unsigned, f); return (u + 0x7fffu + ((u >> 16) & 1u)) >> 16; }
__device__ __forceinline__ unsigned pk2(float lo, float hi) { return f2bf(lo) | (f2bf(hi) << 16); }
__device__ __forceinline__ float bflo(unsigned w) { return __uint_as_float(w << 16); }
__device__ __forceinline__ float bfhi(unsigned w) { return __uint_as_float(w & 0xffff0000u); }

#define XB_TMO      128
#define XB_XCNT(j)  (256  + 64 * (j))
#define XB_XSUB(j)  (1280 + 64 * (j))
#define XB_XGEN(j)  (2304 + 64 * (j))
#define XB_TOP      3328
#define XB_TOPGEN   3392
#define XCD_BAR_WORDS 3456
#define XB_SPIN_CAP (1u << 18)
__device__ __forceinline__ unsigned xb_ld(unsigned* p)              { return __hip_atomic_load(p, __ATOMIC_RELAXED, __HIP_MEMORY_SCOPE_AGENT); }
__device__ __forceinline__ unsigned xb_add(unsigned* p, unsigned v) { return __hip_atomic_fetch_add(p, v, __ATOMIC_RELAXED, __HIP_MEMORY_SCOPE_AGENT); }
__device__ __forceinline__ unsigned xb_xcc_id() { return (unsigned)__builtin_amdgcn_s_getreg((3 << 11) | 20) & 0xFu; }
#define XB_SPIN(cond, bar) do { unsigned _sp = 0; while (cond) { __builtin_amdgcn_s_sleep(1); \
    if ((++_sp & 255u) == 0u) { if (xb_ld(&(bar)[XB_TMO])) break; if (_sp > XB_SPIN_CAP) { atomicAdd(&(bar)[XB_TMO], 1u); break; } } } } while (0)
struct XcdBarrier { unsigned* bar; unsigned x; volatile LAS unsigned* st; };
__device__ __forceinline__ XcdBarrier xcd_barrier_post(unsigned* bar, volatile LAS unsigned* st) {
    XcdBarrier b; b.bar = bar; b.x = xb_xcc_id(); b.st = st;
    if (threadIdx.x == 0) (void)xb_add(&bar[XB_XCNT(b.x)], 1u);
    return b;
}
__device__ __forceinline__ void xcd_barrier_complete(unsigned* bar, unsigned x, unsigned& nloc, unsigned& nx) {
    const unsigned G = gridDim.x * gridDim.y * gridDim.z;
    unsigned sum, cnt, mine, sp = 0u;
    for (;;) {
        sum = 0u; cnt = 0u; mine = 0u;
#pragma unroll
        for (unsigned j = 0; j < 16; ++j) { const unsigned c = xb_ld(&bar[XB_XCNT(j)]); sum += c; cnt += (c > 0u) ? 1u : 0u; mine = (j == x) ? c : mine; }
        if (sum == G) break;
        __builtin_amdgcn_s_sleep(1);
        if ((++sp & 255u) == 0u) { if (xb_ld(&bar[XB_TMO])) break; if (sp > XB_SPIN_CAP) { atomicAdd(&bar[XB_TMO], 1u); break; } }
    }
    nloc = mine > 0u ? mine : 1u; nx = cnt > 0u ? cnt : 1u;
}
__device__ __forceinline__ void xcd_barrier(const XcdBarrier& b) {
    asm volatile("s_waitcnt vmcnt(0)" ::: "memory");
    __syncthreads();
    if (threadIdx.x == 0) {
        unsigned* bar = b.bar;
        __builtin_amdgcn_s_waitcnt(0);
        unsigned nloc = b.st[0], nx = b.st[1];
        if (nloc == 0u) { xcd_barrier_complete(bar, b.x, nloc, nx); b.st[0] = nloc; b.st[1] = nx; }
        const unsigned old = xb_add(&bar[XB_XSUB(b.x)], 1u);
        const unsigned gen = old / nloc;
        if (old + 1u == (gen + 1u) * nloc) {
            __builtin_amdgcn_fence(__ATOMIC_RELEASE, "agent");
            asm volatile("s_waitcnt vmcnt(0)" ::: "memory");
            const unsigned og = xb_add(&bar[XB_TOP], 1u);
            const unsigned tg = og / nx;
            if (og + 1u == (tg + 1u) * nx) xb_add(&bar[XB_TOPGEN], 1u);
            else XB_SPIN(xb_ld(&bar[XB_TOPGEN]) == tg, bar);
            __builtin_amdgcn_fence(__ATOMIC_ACQUIRE, "agent");
            xb_add(&bar[XB_XGEN(b.x)], 1u);
            asm volatile("s_waitcnt vmcnt(0)" ::: "memory");
        } else {
            XB_SPIN(xb_ld(&bar[XB_XGEN(b.x)]) == gen, bar);
            __builtin_amdgcn_fence(__ATOMIC_ACQUIRE, "agent");
            asm volatile("s_waitcnt vmcnt(0)" ::: "memory");
        }
    }
    __syncthreads();
}

struct Frame {
    LAS unsigned char* lds; volatile LAS unsigned* MISC; gu32* ctl;
    int tid, lane, wave, vcu, G;
};
__device__ __forceinline__ float wave_sum(float v) {
#pragma unroll
    for (int o = 1; o < 64; o <<= 1) v += __shfl_xor(v, o);
    return v;
}
__device__ __forceinline__ float wave_sum_fast(float v) {
    v += __int_as_float(__builtin_amdgcn_update_dpp(0, __float_as_int(v), 0x128, 0xf, 0xf, false));
    v += __int_as_float(__builtin_amdgcn_update_dpp(0, __float_as_int(v), 0x124, 0xf, 0xf, false));
    v += __int_as_float(__builtin_amdgcn_update_dpp(0, __float_as_int(v), 0x122, 0xf, 0xf, false));
    v += __int_as_float(__builtin_amdgcn_update_dpp(0, __float_as_int(v), 0x121, 0xf, 0xf, false));
    const int vi = __float_as_int(v);
    return (__int_as_float(__builtin_amdgcn_readlane(vi, 0)) + __int_as_float(__builtin_amdgcn_readlane(vi, 16))) + (__int_as_float(__builtin_amdgcn_readlane(vi, 32)) + __int_as_float(__builtin_amdgcn_readlane(vi, 48)));
}
__device__ __forceinline__ void transpose_item(const float* W, int K, int N, int k0, int n0, bf16* WT, int drow0, LAS float* scr, int lane) {
#pragma unroll 8
    for (int i = 0; i < 32; ++i) { const int kk = 2 * i + (lane >> 5); scr[kk * 33 + (lane & 31)] = W[(size_t)(k0 + kk) * N + n0 + (lane & 31)]; }
    LDS_WAIT(); asm volatile("" ::: "memory");
    const int c = lane & 7;
#pragma unroll
    for (int j = 0; j < 4; ++j) { const int n = (lane >> 3) + 8 * j; const LAS float* s = scr + (8 * c) * 33 + n;
        v4u o; o.x = pk2(s[0 * 33], s[1 * 33]); o.y = pk2(s[2 * 33], s[3 * 33]); o.z = pk2(s[4 * 33], s[5 * 33]); o.w = pk2(s[6 * 33], s[7 * 33]);
        *(GAS v4u*)(WT + (size_t)(drow0 + n) * K + k0 + 8 * c) = o; }
    LDS_WAIT(); asm volatile("" ::: "memory");
}
__device__ __forceinline__ int win_drow(int n0) {
    if (n0 < 4096 || n0 >= 6144) return n0;
    if (n0 < 5120) { const int r = n0 - 4096; return 4096 + 256 * (r >> 7) + (r & 127); }
    const int r = n0 - 5120; return 4096 + 256 * (r >> 7) + 128 + (r & 127);
}
struct Ptrs {
    const float *x, *ln_in_g, *ln_in_b, *w_in, *b_gate, *lq, *lk, *subln_g, *rel_bias, *conv_w, *w_a, *w_b, *w_o, *ln1_g, *ln1_b, *w_group, *b_group, *w_sub, *b_sub, *w_gate_e, *w_up_e, *w_down_e, *ln2_g, *ln2_b;
    float* out; unsigned char* ws;
};
__device__ __forceinline__ void p0_prologue(Frame& F, const Ptrs& P) {
    LAS float* scr = (LAS float*)(F.lds + RING_OFF + F.wave * 16384);
    const int gw = F.vcu * NWAVES + F.wave, NGW = F.G * NWAVES;
    constexpr int I_IN = (D / 64) * (NIN / 32), I_SQ = (D / 64) * (D / 32);
    bf16* Wt_in = (bf16*)(P.ws + WS_WIN); bf16* Wt_a = (bf16*)(P.ws + WS_WA); bf16* Wt_b = (bf16*)(P.ws + WS_WB); bf16* Wt_o = (bf16*)(P.ws + WS_WO);
    for (int it = gw; it < I_IN + 3 * I_SQ; it += NGW) {
        int r = it;
        if (r < I_IN) { const int kb = r / (NIN / 32), nb = r % (NIN / 32); transpose_item(P.w_in, D, NIN, 64 * kb, 32 * nb, Wt_in, win_drow(32 * nb), scr, F.lane); continue; } r -= I_IN;
        const int which = r / I_SQ; r -= which * I_SQ; const int kb = r / (D / 32), nb = r % (D / 32);
        const float* W = which == 0 ? P.w_a : (which == 1 ? P.w_b : P.w_o); bf16* WT = which == 0 ? Wt_a : (which == 1 ? Wt_b : Wt_o);
        transpose_item(W, D, D, 64 * kb, 32 * nb, WT, 32 * nb, scr, F.lane);
    }
    bf16* XN = (bf16*)(P.ws + WS_XN); float* stats = (float*)(P.ws + WS_STATS);
    for (int m = gw; m < T; m += NGW) {
        const GAS f32x4* xr = (const GAS f32x4*)(P.x + (size_t)m * D) + F.lane;
        f32x4 v[4]; float s = 0.f;
#pragma unroll
        for (int j = 0; j < 4; ++j) { v[j] = xr[64 * j]; s += (v[j].x + v[j].y) + (v[j].z + v[j].w); }
        const float mean = wave_sum(s) * (1.f / D); float s2 = 0.f;
#pragma unroll
        for (int j = 0; j < 4; ++j) { v[j] = v[j] - mean; s2 += (v[j].x * v[j].x + v[j].y * v[j].y) + (v[j].z * v[j].z + v[j].w * v[j].w); }
        const float rstd = 1.f / sqrtf(wave_sum(s2) * (1.f / D) + LN_EPS);
        GAS unsigned long long* o8 = (GAS unsigned long long*)(XN + (size_t)m * D) + F.lane;
#pragma unroll
        for (int j = 0; j < 4; ++j) { const f32x4 g = *((const GAS f32x4*)P.ln_in_g + F.lane + 64 * j), b = *((const GAS f32x4*)P.ln_in_b + F.lane + 64 * j); const f32x4 y = v[j] * rstd * g + b;
            o8[64 * j] = (unsigned long long)pk2(y.x, y.y) | ((unsigned long long)pk2(y.z, y.w) << 32); }
        if (F.lane == 0) { stats[2 * m] = mean; stats[2 * m + 1] = rstd; }
    }
}
__device__ __forceinline__ void p2_conv(Frame& F, const Ptrs& P) {
    bf16* CB = BUF_CB(P); const bf16* Z = (const bf16*)(P.ws + WS_Z);
    const int gw = F.vcu * NWAVES + F.wave, NGW = F.G * NWAVES, c0 = 16 * F.lane;
    float w0[16], w1[16], w2[16];
#pragma unroll
    for (int i = 0; i < 16; ++i) { w0[i] = P.conv_w[c0 + i]; w1[i] = P.conv_w[D + c0 + i]; w2[i] = P.conv_w[2 * D + c0 + i]; }
    for (int ch = gw; ch < T / 16; ch += NGW) {
        const int r0 = ch * 16; float z2[16], z1[16];
        if ((r0 & (SEQ - 1)) == 0) {
#pragma unroll
            for (int i = 0; i < 16; ++i) { z2[i] = 0.f; z1[i] = 0.f; }
        } else {
            const v4u a0 = *(const GAS v4u*)(Z + (size_t)(r0 - 2) * D + c0), a1 = *(const GAS v4u*)(Z + (size_t)(r0 - 2) * D + c0 + 8), b0 = *(const GAS v4u*)(Z + (size_t)(r0 - 1) * D + c0), b1 = *(const GAS v4u*)(Z + (size_t)(r0 - 1) * D + c0 + 8);
#pragma unroll
            for (int i = 0; i < 4; ++i) { z2[2 * i] = bflo(a0[i]); z2[2 * i + 1] = bfhi(a0[i]); z2[8 + 2 * i] = bflo(a1[i]); z2[8 + 2 * i + 1] = bfhi(a1[i]);
                                          z1[2 * i] = bflo(b0[i]); z1[2 * i + 1] = bfhi(b0[i]); z1[8 + 2 * i] = bflo(b1[i]); z1[8 + 2 * i + 1] = bfhi(b1[i]); }
        }
#pragma unroll 2
        for (int rr = 0; rr < 16; ++rr) { const size_t off = (size_t)(r0 + rr) * D + c0;
            const v4u za = *(const GAS v4u*)(Z + off), zb = *(const GAS v4u*)(Z + off + 8), ca = *(const GAS v4u*)(CB + off), cb = *(const GAS v4u*)(CB + off + 8);
            float zc[16], cv[16];
#pragma unroll
            for (int i = 0; i < 4; ++i) { zc[2 * i] = bflo(za[i]); zc[2 * i + 1] = bfhi(za[i]); zc[8 + 2 * i] = bflo(zb[i]); zc[8 + 2 * i + 1] = bfhi(zb[i]);
                                          cv[2 * i] = bflo(ca[i]); cv[2 * i + 1] = bfhi(ca[i]); cv[8 + 2 * i] = bflo(cb[i]); cv[8 + 2 * i + 1] = bfhi(cb[i]); }
            float u[16];
#pragma unroll
            for (int i = 0; i < 16; ++i) { u[i] = cv[i] * (z2[i] * w0[i] + z1[i] * w1[i] + zc[i] * w2[i]); z2[i] = z1[i]; z1[i] = zc[i]; }
            v4u oa, ob;
#pragma unroll
            for (int i = 0; i < 4; ++i) { oa[i] = pk2(u[2 * i], u[2 * i + 1]); ob[i] = pk2(u[8 + 2 * i], u[8 + 2 * i + 1]); }
            *(GAS v4u*)(CB + off) = oa; *(GAS v4u*)(CB + off + 8) = ob; }
    }
}
__device__ __forceinline__ attn::BlockRef attn_ref(const Ptrs& P, int s, int qb) {
    const int vh = s & 1, m = (s >> 1) & 1, h = (s >> 2) & 3, b = s >> 4;
    attn::BlockRef r; const size_t rowb = (size_t)b * SEQ * D;
    r.Q = (const bf16*)(P.ws + WS_Q) + rowb + (size_t)qb * 256 * D + h * 256 + m * 128;
    r.K = (const bf16*)(P.ws + WS_K) + rowb + h * 256 + m * 128;
    r.V = (const bf16*)(P.ws + WS_V) + rowb + h * 256 + vh * 128;
    r.O = (bf16*)(P.ws + (m ? WS_O1 : WS_XN)) + rowb + (size_t)qb * 256 * D + h * 256 + vh * 128;
    r.P0 = qb * 256; return r;
}
#ifndef P1_ALIGN
#define P1_ALIGN true
#endif
#ifndef P1_SP2
#define P1_SP2 true
#endif
#ifndef ATTN_PAIR
#define ATTN_PAIR 1
#endif
__device__ __forceinline__ attn2::BlockRef attn2_ref(const Ptrs& P, int st, int qb) {
    const int m = st & 1, h = (st >> 1) & 3, b = st >> 3;
    attn2::BlockRef r; const size_t rowb = (size_t)b * SEQ * D;
    r.Q = (const bf16*)(P.ws + WS_Q) + rowb + (size_t)qb * 128 * D + h * 256 + m * 128;
    r.K = (const bf16*)(P.ws + WS_K) + rowb + h * 256 + m * 128;
    r.V = (const bf16*)(P.ws + WS_V) + rowb + h * 256;
    r.O = (bf16*)(P.ws + (m ? WS_O1 : WS_XN)) + rowb + (size_t)qb * 128 * D + h * 256;
    r.P0 = qb * 128; return r;
}
__device__ __forceinline__ void p2_attention2(Frame& F, const Ptrs& P, char* lds) {
    float* btab = (float*)(lds + attn2::BIAS_OFF);
    for (int s2 = F.vcu; s2 < BATCH * 16; s2 += F.G) {
        const int st = s2 >> 1, half = s2 & 1, h = (st >> 1) & 3;
        __syncthreads();
        if (F.tid < attn2::NBIAS) { const int rel = 63 - F.tid; btab[F.tid] = (P.rel_bias[attn2::t5_bucket(rel) * 4 + h] - P.rel_bias[15 * 4 + h]) * (1.0f / attn2::SCALE); }
        __syncthreads();
#define QB_OF(i) (2 * (7 - (i)) + (((7 - (i)) & 1) ^ half))
        attn2::Seam S; attn2::BlockRef cur = attn2_ref(P, st, QB_OF(0));
        attn2::attn_prime(cur, lds, S);
#pragma unroll 1
        for (int i = 0; i < 8; ++i) {
            const attn2::BlockRef nxt = (i < 7) ? attn2_ref(P, st, QB_OF(i + 1)) : cur;
            attn2::attn_block(cur, nxt, lds, S);
            cur = nxt;
        }
#undef QB_OF
    }
}
__device__ __forceinline__ void p2_attention(Frame& F, const Ptrs& P, char* lds) {
    float* btab = (float*)(lds + attn::BIAS_OFF);
    for (int s = F.vcu; s < BATCH * 16; s += F.G) {
        const int h = (s >> 2) & 3;
        __syncthreads();
        if (F.tid < attn::NBIAS) { const int rel = 63 - F.tid; btab[F.tid] = (P.rel_bias[attn::t5_bucket(rel) * 4 + h] - P.rel_bias[15 * 4 + h]) * (1.0f / attn::SCALE); }
        __syncthreads();
        attn::Seam S; attn::BlockRef cur = attn_ref(P, s, 0);
        attn::attn_prime(cur, lds, S);
#pragma unroll 1
        for (int qb = 0; qb < 8; ++qb) {
            const attn::BlockRef nxt = (qb < 7) ? attn_ref(P, s, qb + 1) : cur;
            attn::attn_block(cur, nxt, lds, S);
            cur = nxt;
        }
    }
}
__device__ __forceinline__ void p2b_combine(Frame& F, const Ptrs& P) {
    bf16* O0 = (bf16*)(P.ws + WS_XN); const bf16* O1 = (const bf16*)(P.ws + WS_O1);
    const int gw = F.vcu * NWAVES + F.wave, NGW = F.G * NWAVES, c0 = 16 * F.lane;
    const float l0 = wave_sum(P.lq[F.lane] * P.lk[F.lane] + P.lq[64 + F.lane] * P.lk[64 + F.lane]), l1 = wave_sum(P.lq[128 + F.lane] * P.lk[128 + F.lane] + P.lq[192 + F.lane] * P.lk[192 + F.lane]);
    const float lam = expf(l0) - expf(l1) + LAM_INIT;
    float g[16];
#pragma unroll
    for (int i = 0; i < 16; ++i) g[i] = P.subln_g[(c0 & 255) + i] * (1.f - LAM_INIT);
    for (int m = gw; m < T; m += NGW) { const size_t off = (size_t)m * D + c0;
        const v4u a0 = *(const GAS v4u*)(O0 + off), a1 = *(const GAS v4u*)(O0 + off + 8), b0 = *(const GAS v4u*)(O1 + off), b1 = *(const GAS v4u*)(O1 + off + 8);
        float d[16]; float ss = 0.f;
#pragma unroll
        for (int i = 0; i < 4; ++i) { d[2 * i] = bflo(a0[i]) - lam * bflo(b0[i]); d[2 * i + 1] = bfhi(a0[i]) - lam * bfhi(b0[i]); d[8 + 2 * i] = bflo(a1[i]) - lam * bflo(b1[i]); d[8 + 2 * i + 1] = bfhi(a1[i]) - lam * bfhi(b1[i]); }
#pragma unroll
        for (int i = 0; i < 16; ++i) ss += d[i] * d[i];
        ss += __shfl_xor(ss, 1); ss += __shfl_xor(ss, 2); ss += __shfl_xor(ss, 4); ss += __shfl_xor(ss, 8);
        const float rs = 1.f / sqrtf(ss * (1.f / 256.f) + RMS_EPS);
        v4u oa, ob;
#pragma unroll
        for (int i = 0; i < 4; ++i) { oa[i] = pk2(d[2 * i] * rs * g[2 * i], d[2 * i + 1] * rs * g[2 * i + 1]); ob[i] = pk2(d[8 + 2 * i] * rs * g[8 + 2 * i], d[8 + 2 * i + 1] * rs * g[8 + 2 * i + 1]); }
        *(GAS v4u*)(O0 + off) = oa; *(GAS v4u*)(O0 + off + 8) = ob; }
}
__device__ __forceinline__ void pe_experts(Frame& F, const Ptrs& P) {
    LAS float* scr = (LAS float*)(F.lds + RING_OFF + F.wave * 16384);
    const int gw = F.vcu * NWAVES + F.wave, NGW = F.G * NWAVES;
    bf16* Wgu = (bf16*)(P.ws + WS_WGU); bf16* Wd = (bf16*)(P.ws + WS_WD);
    constexpr int I_GU = (D / 64) * (DE / 32), I_DN = (DE / 64) * (D / 32);
    for (int it = gw; it < NE * (2 * I_GU + I_DN); it += NGW) {
        const int e = it / (2 * I_GU + I_DN); int r = it - e * (2 * I_GU + I_DN);
        if (r < 2 * I_GU) { const int up = r >= I_GU; r -= up * I_GU; const int kb = r / (DE / 32), nb = r % (DE / 32), n0 = 32 * nb;
            transpose_item((up ? P.w_up_e : P.w_gate_e) + (size_t)e * D * DE, D, DE, 64 * kb, n0, Wgu + (size_t)e * 1024 * D, 256 * (n0 >> 7) + 128 * up + (n0 & 127), scr, F.lane); }
        else { r -= 2 * I_GU; const int kb = r / (D / 32), nb = r % (D / 32);
            transpose_item(P.w_down_e + (size_t)e * DE * D, DE, D, 64 * kb, 32 * nb, Wd + (size_t)e * D * DE, 32 * nb, scr, F.lane); }
    }
}
__device__ __forceinline__ void p5_ln_route(Frame& F, const Ptrs& P) {
    LAS float* RW = (LAS float*)(F.lds + RING_OFF);
    LAS int* lcnt = (LAS int*)(F.lds + TAB_OFF);
    LAS float* rs = (LAS float*)(F.lds + RSCR_OFF) + F.wave * 128;
    for (int idx = F.tid; idx < D * 36; idx += NWAVES * 64) { const int d = idx / 36, o = idx - d * 36; float w;
        if (o < 4) w = P.w_group[d * 4 + o]; else { const int g = (o - 4) >> 3, e = (o - 4) & 7; w = P.w_sub[((size_t)g * D + d) * 8 + e]; }
        const int j = d >> 8, l = (d & 255) >> 2, i = d & 3, c = o >> 2, k = o & 3;
        RW[((((j * 4 + i) * 9 + c) * 64 + l) << 2) + k] = w; }
    if (F.tid < 32) lcnt[F.tid] = 0;
    __syncthreads();
    float* pre = (float*)(P.ws + WS_PRE); bf16* x1b = (bf16*)(P.ws + WS_XN);
    int* eid = (int*)(P.ws + WS_EID); float* ew = (float*)(P.ws + WS_EW); int* rank = (int*)(P.ws + WS_RANK);
    const int rows_per_wg = T / F.G, rbase = blockIdx.x * rows_per_wg;
    static_assert(pg8::PRE_BF16, "the pipelined LN1/routing loop reads bf16 pre");
    v2u raw[2][4];
#define P5_LOADPAIR(rp_) do { _Pragma("unroll") for (int r = 0; r < 2; ++r) { const GAS v2u* pr = (const GAS v2u*)((const bf16*)pre + (size_t)(rbase + (rp_) + r) * D) + F.lane; \
        _Pragma("unroll") for (int j = 0; j < 4; ++j) raw[r][j] = pr[64 * j]; } } while (0)
    if (F.wave * 2 < rows_per_wg) P5_LOADPAIR(F.wave * 2);
    for (int rp = F.wave * 2; rp < rows_per_wg; rp += NWAVES * 2) {
        f32x4 xv[2][4];
#pragma unroll
        for (int r = 0; r < 2; ++r) { const int row = rbase + rp + r;
            f32x4 v[4]; float s = 0.f;
#pragma unroll
            for (int j = 0; j < 4; ++j) { const v2u w = raw[r][j]; v[j] = (f32x4){bflo(w.x), bfhi(w.x), bflo(w.y), bfhi(w.y)}; s += (v[j].x + v[j].y) + (v[j].z + v[j].w); }
            const float mean = wave_sum_fast(s) * (1.f / D); float s2 = 0.f;
#pragma unroll
            for (int j = 0; j < 4; ++j) { v[j] = v[j] - mean; s2 += (v[j].x * v[j].x + v[j].y * v[j].y) + (v[j].z * v[j].z + v[j].w * v[j].w); }
            const float rstd = 1.f / sqrtf(wave_sum_fast(s2) * (1.f / D) + LN_EPS);
            GAS unsigned long long* o8 = (GAS unsigned long long*)(x1b + (size_t)row * D) + F.lane;
#pragma unroll
            for (int j = 0; j < 4; ++j) { const f32x4 g = *((const GAS f32x4*)P.ln1_g + F.lane + 64 * j), b = *((const GAS f32x4*)P.ln1_b + F.lane + 64 * j); const f32x4 y = v[j] * rstd * g + b;
                xv[r][j] = y; o8[64 * j] = (unsigned long long)pk2(y.x, y.y) | ((unsigned long long)pk2(y.z, y.w) << 32); } }
        if (rp + NWAVES * 2 < rows_per_wg) P5_LOADPAIR(rp + NWAVES * 2);
        f32x4 acc[2][9];
#pragma unroll
        for (int r = 0; r < 2; ++r)
#pragma unroll
            for (int c = 0; c < 9; ++c) acc[r][c] = (f32x4){0.f, 0.f, 0.f, 0.f};
        asm volatile("" ::: "memory"); __builtin_amdgcn_sched_barrier(0);
#pragma unroll
        for (int j = 0; j < 4; ++j)
#pragma unroll
            for (int i = 0; i < 4; ++i)
                { const LAS f32x4* wp = (const LAS f32x4*)(RW + (((j * 4 + i) * 9 * 64 + F.lane) << 2));
#pragma unroll
                  for (int c = 0; c < 9; ++c) { const f32x4 w = wp[c * 64]; acc[0][c] += w * xv[0][j][i]; acc[1][c] += w * xv[1][j][i]; }
                  asm volatile("" : "+v"(acc[0][0]), "+v"(acc[0][1]), "+v"(acc[0][2]), "+v"(acc[0][3]), "+v"(acc[0][4]), "+v"(acc[0][5]), "+v"(acc[0][6]), "+v"(acc[0][7]), "+v"(acc[0][8]) :: "memory");
                  asm volatile("" : "+v"(acc[1][0]), "+v"(acc[1][1]), "+v"(acc[1][2]), "+v"(acc[1][3]), "+v"(acc[1][4]), "+v"(acc[1][5]), "+v"(acc[1][6]), "+v"(acc[1][7]), "+v"(acc[1][8]) :: "memory");
                  __builtin_amdgcn_sched_barrier(0); }
        { float Y[36];
#pragma unroll
          for (int k = 0; k < 36; ++k) { const int i0 = 2 * k, i1 = 2 * k + 1;
              const auto rr = __builtin_amdgcn_permlane32_swap(__float_as_uint(acc[i0 / 36][(i0 % 36) >> 2][i0 & 3]), __float_as_uint(acc[i1 / 36][(i1 % 36) >> 2][i1 & 3]), false, false);
              Y[k] = __uint_as_float(rr[0]) + __uint_as_float(rr[1]); }
          float Z[18];
#pragma unroll
          for (int m = 0; m < 18; ++m) { const auto rr = __builtin_amdgcn_permlane16_swap(__float_as_uint(Y[2 * m]), __float_as_uint(Y[2 * m + 1]), false, false);
              Z[m] = __uint_as_float(rr[0]) + __uint_as_float(rr[1]); }
#pragma unroll
          for (int m = 0; m < 18; ++m) {
              Z[m] += __int_as_float(__builtin_amdgcn_update_dpp(0, __float_as_int(Z[m]), 0x128, 0xf, 0xf, false));
              Z[m] += __int_as_float(__builtin_amdgcn_update_dpp(0, __float_as_int(Z[m]), 0x124, 0xf, 0xf, false));
              Z[m] += __int_as_float(__builtin_amdgcn_update_dpp(0, __float_as_int(Z[m]), 0x122, 0xf, 0xf, false));
              Z[m] += __int_as_float(__builtin_amdgcn_update_dpp(0, __float_as_int(Z[m]), 0x121, 0xf, 0xf, false)); }
          const int rho = F.lane >> 4, pr = ((rho & 1) << 1) | (rho >> 1);
          if ((F.lane & 15) == 0) {
#pragma unroll
              for (int m = 0; m < 18; ++m) { const int idx = 4 * m + pr; rs[idx >= 36 ? idx + 28 : idx] = Z[m]; } } }
        LDS_WAIT(); asm volatile("" ::: "memory");
        if (F.lane < 2) { const int r = F.lane, row = rbase + rp + r; const LAS float* sa = rs + r * 64;
            float gmax = sa[0] + P.b_group[0]; int gi = 0;
            for (int g = 1; g < 4; ++g) { const float v = sa[g] + P.b_group[g]; if (v > gmax) { gmax = v; gi = g; } }
            float z = 0.f;
            for (int g = 0; g < 4; ++g) z += expf(sa[g] + P.b_group[g] - gmax);
            const float gp = 1.f / z;
            const LAS float* sl = sa + 4 + gi * 8; const float* bs = P.b_sub + gi * 8;
            float b0 = sl[0] + bs[0]; int i0 = 0;
            for (int e = 1; e < 8; ++e) { const float v = sl[e] + bs[e]; if (v > b0) { b0 = v; i0 = e; } }
            float b1 = -__builtin_inff(); int i1 = 0;
            for (int e = 0; e < 8; ++e) { const float v = sl[e] + bs[e]; if (e != i0 && v > b1) { b1 = v; i1 = e; } }
            const float e1 = expf(b1 - b0); const float w0 = gp / (1.f + e1), w1 = gp * e1 / (1.f + e1);
            const int ex0 = gi * 8 + i0, ex1 = gi * 8 + i1;
            eid[row * 2] = ex0; eid[row * 2 + 1] = ex1; ew[row * 2] = w0; ew[row * 2 + 1] = w1;
            rank[row * 2] = __hip_atomic_fetch_add(lcnt + ex0, 1, __ATOMIC_RELAXED, __HIP_MEMORY_SCOPE_WORKGROUP);
            rank[row * 2 + 1] = __hip_atomic_fetch_add(lcnt + ex1, 1, __ATOMIC_RELAXED, __HIP_MEMORY_SCOPE_WORKGROUP); }
        LDS_WAIT(); asm volatile("" ::: "memory");
    }
    __syncthreads();
    if (F.tid < 32) ((int*)(P.ws + WS_CNTWG))[blockIdx.x * 32 + F.tid] = lcnt[F.tid];
}
__device__ __forceinline__ void moe_tab(Frame& F, const Ptrs& P) {
    LAS int* tab = (LAS int*)(F.lds + TAB_OFF);
    const int* cntwg = (const int*)(P.ws + WS_CNTWG);
    __syncthreads();
    if (F.tid < 32) { int tot = 0, base = 0;
        for (int w = 0; w < F.G; ++w) { const int c = __hip_atomic_load(cntwg + w * 32 + F.tid, __ATOMIC_RELAXED, __HIP_MEMORY_SCOPE_AGENT); base += (w < (int)blockIdx.x) ? c : 0; tot += c; }
        tab[96 + F.tid] = tot; tab[64 + F.tid] = base; }
    __syncthreads();
    if (F.tid == 0) { int s = 0; for (int e = 0; e < 32; ++e) { tab[e] = s; s += (tab[96 + e] + 255) & ~255; } tab[32] = s; }
    __syncthreads();
}
__device__ __forceinline__ void p5b_place(Frame& F, const Ptrs& P) {
    LAS int* tab = (LAS int*)(F.lds + TAB_OFF);
    moe_tab(F, P);
    const int rows_per_wg = T / F.G, rbase = blockIdx.x * rows_per_wg;
    const int* eid = (const int*)(P.ws + WS_EID); const int* rank = (const int*)(P.ws + WS_RANK); int* slot = (int*)(P.ws + WS_SLOT);
    int* tokl = (int*)(P.ws + WS_TOK);
    for (int a = F.tid; a < rows_per_wg * 2; a += NWAVES * 64) { const int ga = rbase * 2 + a, e = eid[ga]; const int s = tab[e] + tab[64 + e] + rank[ga]; slot[ga] = s; tokl[s] = ga >> 1; }
    if (blockIdx.x < 32) { const int e = blockIdx.x; for (int s = tab[e] + tab[96 + e] + F.tid; s < tab[e + 1]; s += NWAVES * 64) tokl[s] = 0; }
}
struct P8Row { v4u x[2], y0[2], y1[2]; float w0, w1; };
__device__ __forceinline__ void p8_load(P8Row& R, const bf16* x1, const bf16* y, const int* slot, const float* ew, int row, int lane) {
    const int s0 = slot[row * 2], s1 = slot[row * 2 + 1]; R.w0 = ew[row * 2]; R.w1 = ew[row * 2 + 1];
    const GAS v4u* xr = (const GAS v4u*)(x1 + (size_t)row * D) + lane; const GAS v4u* a = (const GAS v4u*)(y + (size_t)s0 * D) + lane; const GAS v4u* b = (const GAS v4u*)(y + (size_t)s1 * D) + lane;
    R.x[0] = xr[0]; R.x[1] = xr[64]; R.y0[0] = a[0]; R.y0[1] = a[64]; R.y1[0] = b[0]; R.y1[1] = b[64];
}
__device__ __forceinline__ void p8_finish(const P8Row& R, const Ptrs& P, int row, int lane, bool poison) {
    float v[16]; float s = 0.f;
#pragma unroll
    for (int h = 0; h < 2; ++h)
#pragma unroll
        for (int i = 0; i < 4; ++i) { v[8 * h + 2 * i] = ALPHA * bflo(R.x[h][i]) + R.w0 * bflo(R.y0[h][i]) + R.w1 * bflo(R.y1[h][i]); v[8 * h + 2 * i + 1] = ALPHA * bfhi(R.x[h][i]) + R.w0 * bfhi(R.y0[h][i]) + R.w1 * bfhi(R.y1[h][i]); }
#pragma unroll
    for (int i = 0; i < 16; ++i) s += v[i];
    const float mean = wave_sum_fast(s) * (1.f / D); float s2 = 0.f;
#pragma unroll
    for (int i = 0; i < 16; ++i) { v[i] -= mean; s2 += v[i] * v[i]; }
    const float rstd = 1.f / sqrtf(wave_sum_fast(s2) * (1.f / D) + LN_EPS);
    const float qn = __builtin_nanf("");
#pragma unroll
    for (int h = 0; h < 2; ++h)
#pragma unroll
        for (int q = 0; q < 2; ++q) { const int c = 512 * h + 8 * lane + 4 * q; const f32x4 g = *(const GAS f32x4*)(P.ln2_g + c), b = *(const GAS f32x4*)(P.ln2_b + c);
            f32x4 o = {v[8 * h + 4 * q] * rstd * g.x + b.x, v[8 * h + 4 * q + 1] * rstd * g.y + b.y, v[8 * h + 4 * q + 2] * rstd * g.z + b.z, v[8 * h + 4 * q + 3] * rstd * g.w + b.w};
            if (poison) o = (f32x4){qn, qn, qn, qn};
            *(GAS f32x4*)(P.out + (size_t)row * D + c) = o; }
}
__device__ __forceinline__ void p8_final(Frame& F, const Ptrs& P, bool poison) {
    const bf16* x1 = (const bf16*)(P.ws + WS_XN); const bf16* y = (const bf16*)(P.ws + WS_XG);
    const int* slot = (const int*)(P.ws + WS_SLOT); const float* ew = (const float*)(P.ws + WS_EW);
    const int rows_per_wg = T / F.G, rbase = blockIdx.x * rows_per_wg;
    P8Row A, B;
    int rr = F.wave; if (rr < rows_per_wg) p8_load(A, x1, y, slot, ew, rbase + rr, F.lane);
    for (; rr < rows_per_wg; rr += 2 * NWAVES) {
        const bool hasB = rr + NWAVES < rows_per_wg; if (hasB) p8_load(B, x1, y, slot, ew, rbase + rr + NWAVES, F.lane);
        p8_finish(A, P, rbase + rr, F.lane, poison);
        if (hasB) { if (rr + 2 * NWAVES < rows_per_wg) p8_load(A, x1, y, slot, ew, rbase + rr + 2 * NWAVES, F.lane); p8_finish(B, P, rbase + rr + NWAVES, F.lane, poison); }
    }
}

constexpr int N_PHASES = 11;
struct Args { Ptrs p; int ph_lo, ph_hi, bar_region, flags; };
__global__ void __launch_bounds__(NWAVES * 64, 2) mega_fwd(Args args) {
    extern __shared__ __attribute__((aligned(16))) unsigned char lds[];
    Frame F; const Ptrs& P = args.p;
    F.lds = (LAS unsigned char*)lds; F.MISC = (volatile LAS unsigned*)(F.lds + MISC_OFF);
    F.tid = threadIdx.x; F.lane = F.tid & 63; F.wave = __builtin_amdgcn_readfirstlane(F.tid >> 6);
    F.G = gridDim.x; { const int bx = blockIdx.x; F.vcu = (F.G % 8 == 0) ? (bx % 8) * (F.G / 8) + bx / 8 : bx; }
    F.ctl = (gu32*)(P.ws + WS_CTL);
    for (int u = F.tid; u < (LDS_BYTES - LDSCTL_OFF) / 4; u += NWAVES * 64) ((LAS unsigned*)(F.lds + LDSCTL_OFF))[u] = 0u;
    __syncthreads();
    XcdBarrier bar = xcd_barrier_post((unsigned*)(F.ctl + CW_BAR) + args.bar_region * XCD_BAR_WORDS, F.MISC + 8);
    const int lo = args.ph_lo, hi = args.ph_hi;
#ifndef PH_MASK
#define PH_MASK 0x7ff
#endif
#define IN(k) (((PH_MASK >> (k)) & 1) && lo <= (k) && (k) < hi)
#define BOTH(k) (IN(k) && IN((k) + 1))
#define GRID_BAR() xcd_barrier(bar)
    const bool grid_ok = (F.G == 256);

    if (IN(0)) { p0_prologue(F, P); if (BOTH(0)) GRID_BAR(); }
    if (IN(1)) {
        pg8::Gemm g{(const pg8::bf16_t*)(P.ws + WS_XN), (const pg8::bf16_t*)(P.ws + WS_WIN), T, NIN, D}; pg8::StaticOrder S; S.init(T, NIN, F.G, (int)blockIdx.x);
        pg8::EpiInProj E{(pg8::bf16_t*)(P.ws + WS_Q), (size_t)(WS_K - WS_Q) / 2, BUF_CB(P), (pg8::bf16_t*)(P.ws + WS_Z), BUF_SGA(P), BUF_SGB(P)};
        pg8::gemm_phase<pg8::EpiInProj, pg8::StaticOrder, P1_ALIGN, P1_SP2>(F.lds + RING_OFF, g, S, E);
        if (BOTH(1)) GRID_BAR();
    }
    if (IN(2)) { if (!(args.flags & 2)) p2_conv(F, P); if (ATTN_PAIR) p2_attention2(F, P, (char*)lds + RING_OFF); else p2_attention(F, P, (char*)lds + RING_OFF); if (BOTH(2)) GRID_BAR(); }
    if (IN(3)) { if (!(args.flags & 1)) p2b_combine(F, P); pe_experts(F, P); if (BOTH(3)) GRID_BAR(); }
    if (IN(4)) {
        { pg8::Gemm g{(const pg8::bf16_t*)(P.ws + WS_XN), (const pg8::bf16_t*)(P.ws + WS_WA), T, D, D}; pg8::StaticOrder S; S.init(T, D, F.G, (int)blockIdx.x);
          pg8::EpiGate<false> E{BUF_SGA(P), nullptr, (pg8::bf16_t*)(P.ws + WS_O1), P.b_gate};
          pg8::gemm_phase<pg8::EpiGate<false>, pg8::StaticOrder, true, true>(F.lds + RING_OFF, g, S, E); }
        __syncthreads();
        { pg8::Gemm g{BUF_CB(P), (const pg8::bf16_t*)(P.ws + WS_WB), T, D, D}; pg8::StaticOrder S; S.init(T, D, F.G, (int)blockIdx.x);
          pg8::EpiGate<true> E{BUF_SGB(P), (const pg8::bf16_t*)(P.ws + WS_O1), (pg8::bf16_t*)(P.ws + WS_Z), P.b_gate + 1024};
          pg8::gemm_phase<pg8::EpiGate<true>, pg8::StaticOrder, true, true>(F.lds + RING_OFF, g, S, E); }
        if (BOTH(4)) GRID_BAR();
    }
    if (IN(5)) {
        pg8::Gemm g{(const pg8::bf16_t*)(P.ws + WS_Z), (const pg8::bf16_t*)(P.ws + WS_WO), T, D, D}; pg8::StaticOrder S; S.init(T, D, F.G, (int)blockIdx.x);
        pg8::EpiPre E{P.x, (const float*)(P.ws + WS_STATS), P.ln_in_g, P.ln_in_b, (float*)(P.ws + WS_PRE), ALPHA};
        pg8::gemm_phase<pg8::EpiPre, pg8::StaticOrder, true, true>(F.lds + RING_OFF, g, S, E);
        if (BOTH(5)) GRID_BAR();
    }
    if (IN(6)) { if (grid_ok) p5_ln_route(F, P); if (BOTH(6)) GRID_BAR(); }
    if (IN(7)) { if (grid_ok) p5b_place(F, P); if (BOTH(7)) GRID_BAR(); }
    if (IN(8)) {
        if (grid_ok) { if (lo == 8) moe_tab(F, P); pg8::Gemm g{(const pg8::bf16_t*)(P.ws + WS_XN), (const pg8::bf16_t*)(P.ws + WS_WGU), MAXS, NE * 1024, D};
          pg8::MoeOrder S{(const PG8_LAS int*)(F.lds + TAB_OFF), F.G, F.vcu, (unsigned*)(F.ctl + CW_MOE), 0u, MOE_HANDOFF != 0, (unsigned*)(F.ctl + CW_TMO), 0, -1}; pg8::EpiMoeUp E{(pg8::bf16_t*)P.out};
          pg8::gemm_phase<pg8::EpiMoeUp, pg8::MoeOrder, true, true, true>(F.lds + RING_OFF, g, S, E, (const int*)(P.ws + WS_TOK)); S.flush(); }
        if (BOTH(8)) { if (MOE_HANDOFF) __syncthreads(); else GRID_BAR(); }
    }
    if (IN(9)) {
        if (grid_ok) { if (lo == 9) moe_tab(F, P); pg8::Gemm g{(const pg8::bf16_t*)P.out, (const pg8::bf16_t*)(P.ws + WS_WD), MAXS, NE * 1024, DE};
          const bool ho = MOE_HANDOFF && lo <= 8;
          pg8::MoeOrder S{(const PG8_LAS int*)(F.lds + TAB_OFF), F.G, ho ? (F.vcu + F.G / 2) % F.G : F.vcu, (unsigned*)(F.ctl + CW_MOE), ho ? 32u : 0u, false, (unsigned*)(F.ctl + CW_TMO), 0, -1}; pg8::EpiMoeDown E{(pg8::bf16_t*)(P.ws + WS_XG)};
          pg8::gemm_phase<pg8::EpiMoeDown, pg8::MoeOrder, true, true>(F.lds + RING_OFF, g, S, E); }
        if (BOTH(9)) GRID_BAR();
    }
    if (IN(10)) {
        bool poison = !grid_ok || (__hip_atomic_load(F.ctl + CW_BAR + args.bar_region * XCD_BAR_WORDS + XB_TMO, RLX_AGENT) != 0u) || (__hip_atomic_load(F.ctl + CW_TMO, RLX_AGENT) != 0u);
        if (grid_ok) p8_final(F, P, poison);
        else { const float qn = __builtin_nanf(""); for (size_t i = (size_t)blockIdx.x * 512 + F.tid; i < (size_t)T * D; i += (size_t)F.G * 512) P.out[i] = qn; }
    }
#undef IN
#undef BOTH
#undef GRID_BAR
}

#if HYBRID
namespace nv {
constexpr int D = 1024, BATCH = 16, SEQ = 2048, T = BATCH * SEQ, NIN = 8192, NH = 4, HD = 128, NE = 32, DE = 512;
constexpr float LN_EPS = 1e-5f, RMS_EPS = 1e-6f;
constexpr float ALPHA = 1.189207115002721f;
constexpr float LAM_INIT = 0.2f;
constexpr int MOE_PAD = 64;
constexpr int MAX_SLOTS = 2 * T + NE * MOE_PAD;
constexpr int MAX_TILES = MAX_SLOTS / MOE_PAD;

__device__ __forceinline__ float wave_sum(float v) {
#pragma unroll
    for (int o = 1; o < 64; o <<= 1) v += __shfl_xor(v, o);
    return v;
}
__device__ __forceinline__ float wave_max(float v) {
#pragma unroll
    for (int o = 1; o < 64; o <<= 1) v = fmaxf(v, __shfl_xor(v, o));
    return v;
}
__device__ __forceinline__ float block_sum(float v, float* scr) {
    v = wave_sum(v); __syncthreads();
    if ((threadIdx.x & 63) == 0) scr[threadIdx.x >> 6] = v; __syncthreads();
    float r = 0.f; for (int i = 0; i < (int)(blockDim.x >> 6); ++i) r += scr[i]; __syncthreads(); return r;
}
__device__ __forceinline__ float block_max(float v, float* scr) {
    v = wave_max(v); __syncthreads();
    if ((threadIdx.x & 63) == 0) scr[threadIdx.x >> 6] = v; __syncthreads();
    float r = -INFINITY; for (int i = 0; i < (int)(blockDim.x >> 6); ++i) r = fmaxf(r, scr[i]); __syncthreads(); return r;
}

__global__ void k_ln_rows(const float* x, float a, const float* add, const float* g, const float* b, float* y) {
    __shared__ float scr[8];
    const size_t row = blockIdx.x; const float* xr = x + row * D; const float* ar = add ? add + row * D : nullptr;
    float v[4]; float s = 0.f;
    for (int j = 0; j < 4; ++j) { const int c = threadIdx.x + 256 * j; v[j] = a * xr[c] + (ar ? ar[c] : 0.f); s += v[j]; }
    const float mean = block_sum(s, scr) * (1.f / D); float q = 0.f;
    for (int j = 0; j < 4; ++j) { v[j] -= mean; q += v[j] * v[j]; }
    const float rstd = 1.f / sqrtf(block_sum(q, scr) * (1.f / D) + LN_EPS);
    for (int j = 0; j < 4; ++j) { const int c = threadIdx.x + 256 * j; y[row * D + c] = v[j] * rstd * g[c] + b[c]; }
}

struct TileAcc { float c[4][4]; };
__device__ __forceinline__ void gemm_tile(const float* __restrict__ A, int lda, const int* rowidx, int row0, const float* __restrict__ B, int ldb, int col0, int K, TileAcc& acc, float (*As)[65], float (*Bs)[65]) {
    const int tid = threadIdx.x, tx = tid & 15, ty = tid >> 4;
    for (int i = 0; i < 4; ++i) for (int j = 0; j < 4; ++j) acc.c[i][j] = 0.f;
    for (int k0 = 0; k0 < K; k0 += 16) {
        for (int e = tid; e < 64 * 16; e += 256) { const int r = e >> 4, k = e & 15; int gr = row0 + r; float v = 0.f;
            if (rowidx) { const int t = rowidx[gr]; if (t >= 0) v = A[(size_t)t * lda + k0 + k]; } else v = A[(size_t)gr * lda + k0 + k];
            As[k][r] = v; }
        for (int e = tid; e < 16 * 64; e += 256) { const int k = e >> 6, c = e & 63; Bs[k][c] = B[(size_t)(k0 + k) * ldb + col0 + c]; }
        __syncthreads();
#pragma unroll
        for (int k = 0; k < 16; ++k) { float a[4], b[4];
            for (int i = 0; i < 4; ++i) a[i] = As[k][ty * 4 + i];
            for (int j = 0; j < 4; ++j) b[j] = Bs[k][tx * 4 + j];
            for (int i = 0; i < 4; ++i) for (int j = 0; j < 4; ++j) acc.c[i][j] += a[i] * b[j]; }
        __syncthreads();
    }
}
__global__ void k_gemm(const float* A, int lda, const float* B, int ldb, float* C, int ldc, int K) {
    __shared__ float As[16][65], Bs[16][65];
    TileAcc acc; const int row0 = blockIdx.y * 64, col0 = blockIdx.x * 64;
    gemm_tile(A, lda, nullptr, row0, B, ldb, col0, K, acc, As, Bs);
    const int tx = threadIdx.x & 15, ty = threadIdx.x >> 4;
    for (int i = 0; i < 4; ++i) for (int j = 0; j < 4; ++j) C[(size_t)(row0 + ty * 4 + i) * ldc + col0 + tx * 4 + j] = acc.c[i][j];
}

__device__ __forceinline__ int t5_bucket(int rel) {
    int b = rel > 0 ? 16 : 0; const int n = rel < 0 ? -rel : rel; int v;
    if (n < 8) v = n; else if (n < 12) v = 8; else if (n < 16) v = 9; else if (n < 23) v = 10; else if (n < 32) v = 11; else if (n < 46) v = 12; else if (n < 65) v = 13; else if (n < 91) v = 14; else v = 15;
    return b + v;
}
__global__ void k_attn(const float* P, const float* rel_bias, const float* lq, const float* lk, const float* subln_g, float* ao) {
    __shared__ float q1[128], q2[128], lg[2][SEQ], scr[8];
    const int q = blockIdx.x, h = blockIdx.y, tid = threadIdx.x;
    float l0 = 0.f, l1 = 0.f; for (int i = 0; i < 128; ++i) { l0 += lq[i] * lk[i]; l1 += lq[128 + i] * lk[128 + i]; }
    const float lam = expf(l0) - expf(l1) + LAM_INIT;
    if (tid < 128) q1[tid] = P[(size_t)q * NIN + h * 256 + tid]; else q2[tid - 128] = P[(size_t)q * NIN + h * 256 + tid];
    __syncthreads();
    const int nk = (q / 64 + 1) * 64; const float scale = 0.08838834764831845f;
    float m1 = -INFINITY, m2 = -INFINITY;
    for (int k = tid; k < nk; k += 256) { const float* kr = P + (size_t)k * NIN + 1024 + h * 256; float s1 = 0.f, s2 = 0.f;
        for (int d = 0; d < 128; ++d) { s1 += q1[d] * kr[d]; s2 += q2[d] * kr[128 + d]; }
        const float bias = rel_bias[t5_bucket(k - q) * NH + h];
        s1 = s1 * scale + bias; s2 = s2 * scale + bias; lg[0][k] = s1; lg[1][k] = s2; m1 = fmaxf(m1, s1); m2 = fmaxf(m2, s2); }
    m1 = block_max(m1, scr); m2 = block_max(m2, scr);
    float z1 = 0.f, z2 = 0.f;
    for (int k = tid; k < nk; k += 256) { const float e1 = expf(lg[0][k] - m1), e2 = expf(lg[1][k] - m2); lg[0][k] = e1; lg[1][k] = e2; z1 += e1; z2 += e2; }
    z1 = block_sum(z1, scr); z2 = block_sum(z2, scr);
    for (int k = tid; k < nk; k += 256) lg[0][k] = lg[0][k] / z1 - lam * (lg[1][k] / z2);
    __syncthreads();
    float o = 0.f; const float* vb = P + 2048 + h * 256 + tid;
    for (int k = 0; k < nk; ++k) o += lg[0][k] * vb[(size_t)k * NIN];
    const float ms = block_sum(o * o, scr) * (1.f / 256.f);
    ao[(size_t)q * D + h * 256 + tid] = o * (1.f / sqrtf(ms + RMS_EPS)) * subln_g[tid] * (1.f - LAM_INIT);
}
__global__ void k_conv(const float* P, const float* cw, float* u) {
    const int t = blockIdx.x;
    for (int c = threadIdx.x; c < D; c += 256) { float z = 0.f;
        for (int w = 0; w < 3; ++w) { const int tt = t + w - 2; if (tt >= 0) z += P[(size_t)tt * NIN + 4096 + c] * P[(size_t)tt * NIN + 5120 + c] * cw[w * D + c]; }
        u[(size_t)t * D + c] = P[(size_t)t * NIN + 3072 + c] * z; }
}
__global__ void k_merge(const float* P, const float* bg, const float* yA, const float* yB, float* m) {
    const int t = blockIdx.x;
    for (int c = threadIdx.x; c < D; c += 256) { const float ga = 1.f / (1.f + expf(-(P[(size_t)t * NIN + 6144 + c] + bg[c]))), gb = 1.f / (1.f + expf(-(P[(size_t)t * NIN + 7168 + c] + bg[D + c])));
        m[(size_t)t * D + c] = ga * yA[(size_t)t * D + c] + gb * yB[(size_t)t * D + c]; }
}
__global__ void k_route(const float* x1, const float* wg, const float* bg, const float* wsub, const float* bsub, int* eid, float* ew, int* rank, int* cnt) {
    const int t = blockIdx.x * 4 + (threadIdx.x >> 6), lane = threadIdx.x & 63;
    float acc[36];
#pragma unroll
    for (int i = 0; i < 36; ++i) acc[i] = 0.f;
    for (int j = 0; j < 16; ++j) { const int d = lane + 64 * j; const float xv = x1[(size_t)t * D + d];
#pragma unroll
        for (int g = 0; g < 4; ++g) acc[g] += xv * wg[d * 4 + g];
#pragma unroll
        for (int g = 0; g < 4; ++g) {
#pragma unroll
            for (int e = 0; e < 8; ++e) acc[4 + g * 8 + e] += xv * wsub[((size_t)g * D + d) * 8 + e]; } }
#pragma unroll
    for (int i = 0; i < 36; ++i) acc[i] = wave_sum(acc[i]);
    __shared__ float sacc[4][36];
    const int wv = threadIdx.x >> 6;
#pragma unroll
    for (int i = 0; i < 36; ++i) if (lane == 0) sacc[wv][i] = acc[i];
    __syncthreads();
    if (lane == 0) {
        const float* sa = sacc[wv];
        float gmax = sa[0] + bg[0]; int gi = 0;
        for (int g = 1; g < 4; ++g) { const float v = sa[g] + bg[g]; if (v > gmax) { gmax = v; gi = g; } }
        float z = 0.f;
        for (int g = 0; g < 4; ++g) z += expf(sa[g] + bg[g] - gmax);
        const float gp = 1.f / z;
        const float* sl = sa + 4 + gi * 8; const float* bs = bsub + gi * 8;
        float b0 = sl[0] + bs[0]; int i0 = 0;
        for (int e = 1; e < 8; ++e) { const float v = sl[e] + bs[e]; if (v > b0) { b0 = v; i0 = e; } }
        float b1 = -INFINITY; int i1 = 0;
        for (int e = 0; e < 8; ++e) { const float v = sl[e] + bs[e]; if (e != i0 && v > b1) { b1 = v; i1 = e; } }
        const float e1 = expf(b1 - b0); const float w0 = gp / (1.f + e1), w1 = gp * e1 / (1.f + e1);
        const int ex0 = gi * 8 + i0, ex1 = gi * 8 + i1;
        eid[t * 2] = ex0; eid[t * 2 + 1] = ex1; ew[t * 2] = w0; ew[t * 2 + 1] = w1;
        rank[t * 2] = atomicAdd(&cnt[ex0], 1); rank[t * 2 + 1] = atomicAdd(&cnt[ex1], 1);
    }
}
__global__ void k_offsets(const int* cnt, int* pad_start, int* tile_expert) {
    if (threadIdx.x == 0) { int s = 0; for (int e = 0; e < NE; ++e) { pad_start[e] = s; const int p = (cnt[e] + MOE_PAD - 1) / MOE_PAD * MOE_PAD; for (int i = 0; i < p / MOE_PAD; ++i) tile_expert[s / MOE_PAD + i] = e; s += p; }
        pad_start[NE] = s; for (int i = s / MOE_PAD; i < MAX_TILES; ++i) tile_expert[i] = -1; }
}
__global__ void k_place(const int* eid, const float* ew, const int* rank, const int* pad_start, int* tok, float* wslot) {
    const int a = blockIdx.x * 256 + threadIdx.x; if (a >= 2 * T) return;
    const int s = pad_start[eid[a]] + rank[a]; tok[s] = a >> 1; wslot[s] = ew[a];
}
__global__ void k_moe_up(const float* x1, const int* tok, const int* tile_expert, const float* Wg, const float* Wu, float* h) {
    __shared__ float As[16][65], Bs[16][65];
    const int e = tile_expert[blockIdx.y]; if (e < 0) return;
    TileAcc g, u; const int row0 = blockIdx.y * 64, col0 = blockIdx.x * 64;
    gemm_tile(x1, D, tok, row0, Wg + (size_t)e * D * DE, DE, col0, D, g, As, Bs);
    gemm_tile(x1, D, tok, row0, Wu + (size_t)e * D * DE, DE, col0, D, u, As, Bs);
    const int tx = threadIdx.x & 15, ty = threadIdx.x >> 4;
    for (int i = 0; i < 4; ++i) for (int j = 0; j < 4; ++j) { const float gv = g.c[i][j]; h[(size_t)(row0 + ty * 4 + i) * DE + col0 + tx * 4 + j] = gv / (1.f + expf(-gv)) * u.c[i][j]; }
}
__global__ void k_moe_down(const float* h, const int* tok, const float* wslot, const int* tile_expert, const float* Wd, float* ffn) {
    __shared__ float As[16][65], Bs[16][65];
    const int e = tile_expert[blockIdx.y]; if (e < 0) return;
    TileAcc acc; const int row0 = blockIdx.y * 64, col0 = blockIdx.x * 64;
    gemm_tile(h, DE, nullptr, row0, Wd + (size_t)e * DE * D, D, col0, DE, acc, As, Bs);
    const int tx = threadIdx.x & 15, ty = threadIdx.x >> 4;
    for (int i = 0; i < 4; ++i) { const int r = row0 + ty * 4 + i; const int t = tok[r]; if (t < 0) continue; const float w = wslot[r];
        for (int j = 0; j < 4; ++j) atomicAdd(&ffn[(size_t)t * D + col0 + tx * 4 + j], w * acc.c[i][j]); }
}
}
#endif
#if HYBRID
__global__ void k_axpy(const float* xn, const float* mix, float* pre, float a, size_t n) { const size_t i = (size_t)blockIdx.x * 256 + threadIdx.x; if (i < n) pre[i] = a * xn[i] + mix[i]; }
__global__ void k_f2b(const float* src, int lds_, unsigned short* dst, int ldd, int cols, size_t rows) {
    const size_t i = (size_t)blockIdx.x * 256 + threadIdx.x; if (i >= rows * cols) return; const size_t r = i / cols; const int c = (int)(i % cols);
    dst[r * ldd + c] = (unsigned short)f2bf(src[r * lds_ + c]); }
__global__ void k_f2b_mul(const float* a, const float* b, int lds_, unsigned short* dst, int ldd, int cols, size_t rows) {
    const size_t i = (size_t)blockIdx.x * 256 + threadIdx.x; if (i >= rows * cols) return; const size_t r = i / cols; const int c = (int)(i % cols);
    dst[r * ldd + c] = (unsigned short)f2bf(a[r * lds_ + c] * b[r * lds_ + c]); }
__global__ void k_f2b_sig(const float* a, const float* bias, int lds_, unsigned short* dst, int ldd, int cols, size_t rows) {
    const size_t i = (size_t)blockIdx.x * 256 + threadIdx.x; if (i >= rows * cols) return; const size_t r = i / cols; const int c = (int)(i % cols);
    dst[r * ldd + c] = (unsigned short)f2bf(1.f / (1.f + expf(-(a[r * lds_ + c] + bias[c])))); }
#endif
static void launch_mega(const Ptrs& p, int lo, int hi, int region, int flags, hipStream_t stream) {
    Args a{}; a.p = p; a.ph_lo = lo; a.ph_hi = hi; a.bar_region = region; a.flags = flags;
    hipLaunchKernelGGL(mega_fwd, dim3(256), dim3(NWAVES * 64), LDS_BYTES, stream, a);
}
extern "C" void kernel_launch(void* const* d_in, const int* in_sizes, int n_in, void* d_out, int out_size, void* d_ws, size_t ws_size, hipStream_t stream) {
    static int ready = 0;
    if (ready == 0) {
        ready = 1;
        if (n_in != 24 || out_size != T * D || ws_size < WS_END) { fprintf(stderr, "kernel_launch: unexpected shapes (n_in %d out %d ws %zu)\n", n_in, out_size, ws_size); ready = -1; }
        else if (hipFuncSetAttribute((const void*)mega_fwd, hipFuncAttributeMaxDynamicSharedMemorySize, LDS_BYTES) != hipSuccess) { fprintf(stderr, "kernel_launch: hipFuncSetAttribute failed\n"); ready = -1; }
        (void)hipGetLastError();
    }
    if (ready < 0) return;
    Ptrs p{};
    const float** pp = (const float**)&p;
    for (int i = 0; i < 24; ++i) pp[i] = (const float*)d_in[i];
    p.out = (float*)d_out; p.ws = (unsigned char*)d_ws;
    (void)hipMemsetAsync((char*)d_ws + WS_CTL, 0, CTL_ZERO_BYTES, stream);
#if HYBRID == 0
#if defined(TIME_PHASE)
    launch_mega(p, 0, TIME_PHASE + 1, 0, 0, stream); launch_mega(p, TIME_PHASE, TIME_PHASE + 1, 1, 3, stream); if (TIME_PHASE + 1 < N_PHASES) launch_mega(p, TIME_PHASE + 1, N_PHASES, 2, 0, stream);
#elif defined(SPLIT_AT)
    launch_mega(p, 0, SPLIT_AT, 0, 0, stream); launch_mega(p, SPLIT_AT, N_PHASES, 1, 0, stream);
#else
    launch_mega(p, 0, N_PHASES, 0, 0, stream);
#endif
#else
    char* ws = (char*)d_ws; float* out = (float*)d_out;
    constexpr size_t NB = (HYBRID == 1 ? 330 : (HYBRID == 2 ? 90 : 410)) * MiB;
    float* Pb = (float*)(ws + NB); float* xnb = (float*)(ws + NB + 64 * MiB); float* ao = (float*)(ws + NB + 72 * MiB); float* ub = (float*)(ws + NB + 80 * MiB); float* yA = (float*)(ws + NB + 88 * MiB); float* yB = (float*)(ws + NB + 96 * MiB); float* mb = (float*)(ws + NB + 104 * MiB);
    float* pre = (float*)(ws + WS_PRE);
#ifndef TAKE_MASK
#define TAKE_MASK 0
#endif
#if HYBRID >= 2
    launch_mega(p, 0, TAKE_MASK ? 2 : 1, 0, 0, stream);
#endif
    for (int b = 0; b < BATCH; ++b) {
        const size_t r0 = (size_t)b * SEQ;
        nv::k_ln_rows<<<SEQ, 256, 0, stream>>>(p.x + r0 * D, 1.f, nullptr, p.ln_in_g, p.ln_in_b, xnb);
        nv::k_gemm<<<dim3(NIN / 64, SEQ / 64), 256, 0, stream>>>(xnb, D, p.w_in, NIN, Pb, NIN, D);
#if HYBRID == 3
        { const int nb = (int)(((size_t)SEQ * 1024 + 255) / 256);
          if (!(TAKE_MASK & 1)) k_f2b<<<nb, 256, 0, stream>>>(Pb, NIN, (unsigned short*)(ws + WS_Q) + r0 * D, D, 1024, SEQ);
          if (!(TAKE_MASK & 2)) k_f2b<<<nb, 256, 0, stream>>>(Pb + 1024, NIN, (unsigned short*)(ws + WS_K) + r0 * D, D, 1024, SEQ);
          if (!(TAKE_MASK & 4)) k_f2b<<<nb, 256, 0, stream>>>(Pb + 2048, NIN, (unsigned short*)(ws + WS_V) + r0 * D, D, 1024, SEQ);
          if (!(TAKE_MASK & 8)) k_f2b<<<nb, 256, 0, stream>>>(Pb + 3072, NIN, BUF_CB(p) + r0 * D, D, 1024, SEQ);
          if (!(TAKE_MASK & 16)) k_f2b_mul<<<nb, 256, 0, stream>>>(Pb + 4096, Pb + 5120, NIN, (unsigned short*)(ws + WS_Z) + r0 * D, D, 1024, SEQ);
          if (!(TAKE_MASK & 32)) k_f2b<<<nb, 256, 0, stream>>>(Pb + 6144, NIN, BUF_SGA(p) + r0 * D, D, 1024, SEQ);
          if (!(TAKE_MASK & 64)) k_f2b<<<nb, 256, 0, stream>>>(Pb + 7168, NIN, BUF_SGB(p) + r0 * D, D, 1024, SEQ); }
#else
        nv::k_attn<<<dim3(SEQ, nv::NH), 256, 0, stream>>>(Pb, p.rel_bias, p.lq, p.lk, p.subln_g, ao);
        nv::k_conv<<<SEQ, 256, 0, stream>>>(Pb, p.conv_w, ub);
#if HYBRID == 2
        { const int nb = (int)(((size_t)SEQ * 1024 + 255) / 256);
          k_f2b<<<nb, 256, 0, stream>>>(ao, D, (unsigned short*)(ws + WS_XN) + r0 * D, D, 1024, SEQ);
          k_f2b<<<nb, 256, 0, stream>>>(ub, D, BUF_CB(p) + r0 * D, D, 1024, SEQ);
          k_f2b<<<nb, 256, 0, stream>>>(Pb + 6144, NIN, BUF_SGA(p) + r0 * D, D, 1024, SEQ);
          k_f2b<<<nb, 256, 0, stream>>>(Pb + 7168, NIN, BUF_SGB(p) + r0 * D, D, 1024, SEQ); }
#else
        nv::k_gemm<<<dim3(D / 64, SEQ / 64), 256, 0, stream>>>(ao, D, p.w_a, D, yA, D, D);
        nv::k_gemm<<<dim3(D / 64, SEQ / 64), 256, 0, stream>>>(ub, D, p.w_b, D, yB, D, D);
        nv::k_merge<<<SEQ, 256, 0, stream>>>(Pb, p.b_gate, yA, yB, mb);
        nv::k_gemm<<<dim3(D / 64, SEQ / 64), 256, 0, stream>>>(mb, D, p.w_o, D, pre + r0 * D, D, D);
        k_axpy<<<(int)(((size_t)SEQ * D + 255) / 256), 256, 0, stream>>>(xnb, pre + r0 * D, pre + r0 * D, ALPHA, (size_t)SEQ * D);
#endif
#endif
    }
#if HYBRID == 1
    launch_mega(p, 3, 4, 1, 1, stream);
    launch_mega(p, 6, N_PHASES, 2, 0, stream);
#elif HYBRID == 2
    launch_mega(p, 3, 4, 1, 1, stream);
    launch_mega(p, 4, N_PHASES, 2, 0, stream);
#elif HYBRID == 3
    launch_mega(p, 2, N_PHASES, 1, 0, stream);
#endif
#endif
}
```

```cpp
#include <hip/hip_runtime.h>
#include <cstdio>
#include <cstdint>
#include <cmath>
#ifndef HYBRID
#define HYBRID 0
#endif
namespace pg8 {
#define PG8_LAS __attribute__((address_space(3)))
typedef unsigned short bf16_t;
typedef short bf16x8 __attribute__((ext_vector_type(8)));
typedef float f32x4 __attribute__((ext_vector_type(4)));
typedef unsigned u32x4 __attribute__((ext_vector_type(4)));
constexpr int BM = 256, BK = 64, HALF = 128, HTB = HALF * BK * 2  , STAGE_BYTES = 8 * HTB, NXCD = 8, WGM = 8;

__host__ __device__ __forceinline__ int lds_byte(int r, int c) { const int st = (r >> 4) * 2 + (c >> 5), rr = r & 15, cc = c & 31, ob = rr * 64 + cc * 2; return st * 1024 + (ob ^ (((ob >> 9) & 1) << 5)); }
__host__ __device__ __forceinline__ void stage_rc(int b, int& R, int& C) { const int st = b / 1024, sb = b % 1024, swz = sb ^ (((sb >> 9) & 1) << 5); R = (st >> 1) * 16 + swz / 64; C = (st & 1) * 32 + (swz % 64) / 2; }
__host__ __device__ __forceinline__ int perm32(int rho) { const int n = rho >> 4, i = rho & 15; return 8 * (i >> 2) + 4 * n + (i & 3); }

struct Unit { int pm, pn; };
struct Gemm { const bf16_t* A; const bf16_t* Bt; int M, N, K; };

struct StaticOrder {
    int nM, nN, nwg, G, c;
    __host__ __device__ void init(int M, int N, int G_, int c_) { nM = M / BM; nN = N / BM; nwg = nM * nN; G = G_; c = c_; }
    __host__ __device__ bool next(int i, Unit& u) const {
        const long L = (long)i * G + c; if (L >= nwg) return false;
        int wgid = (int)L; { const int q = nwg / NXCD, r = nwg % NXCD, xcd = wgid % NXCD, off = wgid / NXCD; wgid = (xcd < r ? xcd * (q + 1) : r * (q + 1) + (xcd - r) * q) + off; }
        const int nig = WGM * nN, gid = wgid / nig, fm = gid * WGM, gsz = (nM - fm) < WGM ? (nM - fm) : WGM;
        u.pm = fm + ((wgid % nig) % gsz); u.pn = (wgid % nig) / gsz; return true;
    }
    __device__ __forceinline__ void a_ready(const Unit&) const {}
    __device__ __forceinline__ void done(const Unit&) const {}
};

__device__ __forceinline__ unsigned cvt_pk_bf16(float lo, float hi) { unsigned r; asm volatile("v_cvt_pk_bf16_f32 %0, %1, %2" : "=v"(r) : "v"(lo), "v"(hi)); return r; }
typedef float f32x2 __attribute__((ext_vector_type(2)));
__device__ __forceinline__ u32x4 pack8f(const f32x4 a, const f32x4 b) { u32x4 w; w.x = cvt_pk_bf16(a[0], a[1]); w.y = cvt_pk_bf16(a[2], a[3]); w.z = cvt_pk_bf16(b[0], b[1]); w.w = cvt_pk_bf16(b[2], b[3]); return w; }
__device__ __forceinline__ void unpack8f(const u32x4 w, f32x4& a, f32x4& b) {
    a[0] = __uint_as_float(w.x << 16); a[1] = __uint_as_float(w.x & 0xffff0000u); a[2] = __uint_as_float(w.y << 16); a[3] = __uint_as_float(w.y & 0xffff0000u);
    b[0] = __uint_as_float(w.z << 16); b[1] = __uint_as_float(w.z & 0xffff0000u); b[2] = __uint_as_float(w.w << 16); b[3] = __uint_as_float(w.w & 0xffff0000u); }
__device__ __forceinline__ float sigmoidf_fast(float x) { return __builtin_amdgcn_rcpf(1.0f + __expf(-x)); }

struct EpiInProj {
    static constexpr bool PERM = true, AFTER_DRAIN = false;
    bf16_t* qkv; size_t stride;
    bf16_t* cb;
    bf16_t* z;
    bf16_t* sga; bf16_t* sgb;
    __device__ __forceinline__ void operator()(const f32x4 (&acc)[2][2][4][2], const Unit& u, int wr, int wc, int fr, int fq) const {
        const int row0 = u.pm * BM + wr * 64 + fr; const int pn = u.pn;
        if (pn < 16 || pn >= 24) {
            bf16_t* base = (pn < 12) ? qkv + (size_t)(pn >> 2) * stride : (pn < 16 ? cb : (pn < 28 ? sga : sgb)); const int col0 = (pn & 3) * BM + wc * 32 + 8 * fq;
#pragma unroll
            for (int ai = 0; ai < 2; ++ai)
#pragma unroll
                for (int m = 0; m < 4; ++m) { bf16_t* rowp = base + (size_t)(row0 + ai * HALF + m * 16) * 1024 + col0;
#pragma unroll
                    for (int bj = 0; bj < 2; ++bj) *(u32x4*)(rowp + bj * HALF) = pack8f(acc[ai][bj][m][0], acc[ai][bj][m][1]); }
        } else {
            const int col0 = (pn - 16) * HALF + wc * 32 + 8 * fq;
#pragma unroll
            for (int ai = 0; ai < 2; ++ai)
#pragma unroll
                for (int m = 0; m < 4; ++m) { bf16_t* rowp = z + (size_t)(row0 + ai * HALF + m * 16) * 1024 + col0;
                    *(u32x4*)rowp = pack8f(acc[ai][0][m][0] * acc[ai][1][m][0], acc[ai][0][m][1] * acc[ai][1][m][1]); }
        }
    }
};
template <bool SECOND> struct EpiGate {
    static constexpr bool PERM = true, AFTER_DRAIN = false;
    const bf16_t* gate; const bf16_t* prev; bf16_t* out; const float* gbias;
    __device__ __forceinline__ void operator()(const f32x4 (&acc)[2][2][4][2], const Unit& u, int wr, int wc, int fr, int fq) const {
        const int row0 = u.pm * BM + wr * 64 + fr; const int col0 = u.pn * BM + wc * 32 + 8 * fq;
        f32x4 bv[2][2];
#pragma unroll
        for (int bj = 0; bj < 2; ++bj)
#pragma unroll
            for (int n = 0; n < 2; ++n) bv[bj][n] = *(const f32x4*)(gbias + col0 + bj * HALF + 4 * n);
#pragma unroll
        for (int ai = 0; ai < 2; ++ai)
#pragma unroll
            for (int m = 0; m < 4; ++m) { const size_t off = (size_t)(row0 + ai * HALF + m * 16) * 1024 + col0;
#pragma unroll
                for (int bj = 0; bj < 2; ++bj) { f32x4 g0, g1; unpack8f(*(const u32x4*)(gate + off + bj * HALF), g0, g1); g0 += bv[bj][0]; g1 += bv[bj][1];
#pragma unroll
                    for (int i = 0; i < 4; ++i) { g0[i] = sigmoidf_fast(g0[i]); g1[i] = sigmoidf_fast(g1[i]); }
                    f32x4 v0 = acc[ai][bj][m][0] * g0, v1 = acc[ai][bj][m][1] * g1;
                    if (SECOND) { f32x4 p0, p1; unpack8f(*(const u32x4*)(prev + off + bj * HALF), p0, p1); v0 += p0; v1 += p1; }
                    *(u32x4*)(out + off + bj * HALF) = pack8f(v0, v1); } }
    }
};
typedef unsigned u32x2 __attribute__((ext_vector_type(2)));
#ifndef PRE_BF16_KNOB
#define PRE_BF16_KNOB 1
#endif
constexpr bool PRE_BF16 = PRE_BF16_KNOB;
struct EpiPre {
    static constexpr bool PERM = false, AFTER_DRAIN = false;
    const float* x; const float* stats; const float* g; const float* b; float* pre; float alpha;
    __device__ __forceinline__ void operator()(const f32x4 (&acc)[2][2][4][2], const Unit& u, int wr, int wc, int fr, int fq) const {
        const int row0 = u.pm * BM + wr * 64 + fr; const int col0 = u.pn * BM + wc * 32 + 4 * fq;
#pragma unroll
        for (int ai = 0; ai < 2; ++ai)
#pragma unroll
            for (int m = 0; m < 4; ++m) { const int row = row0 + ai * HALF + m * 16; const size_t off = (size_t)row * 1024 + col0;
                const float mu = stats[2 * row], rs = stats[2 * row + 1];
#pragma unroll
                for (int bj = 0; bj < 2; ++bj)
#pragma unroll
                    for (int n = 0; n < 2; ++n) { const int c = bj * HALF + n * 16; const f32x4 xv = *(const f32x4*)(x + off + c), gv = *(const f32x4*)(g + col0 + c), bv = *(const f32x4*)(b + col0 + c);
                        const f32x4 o = ((xv - mu) * rs * gv + bv) * alpha + acc[ai][bj][m][n];
                        if constexpr (PRE_BF16) { u32x2 w; w.x = cvt_pk_bf16(o[0], o[1]); w.y = cvt_pk_bf16(o[2], o[3]); *(u32x2*)((bf16_t*)pre + off + c) = w; } else *(f32x4*)(pre + off + c) = o; } }
    }
};
#ifndef MOE_HANDOFF
#define MOE_HANDOFF 0
#endif
struct EpiMoeUp {
    static constexpr bool PERM = true, AFTER_DRAIN = false;
    bf16_t* h;
    __device__ __forceinline__ void operator()(const f32x4 (&acc)[2][2][4][2], const Unit& u, int wr, int wc, int fr, int fq) const {
        const int row0 = u.pm * BM + wr * 64 + fr; const int col0 = (u.pn & 3) * HALF + wc * 32 + 8 * fq;
#pragma unroll
        for (int ai = 0; ai < 2; ++ai)
#pragma unroll
            for (int m = 0; m < 4; ++m) { f32x4 v[2];
#pragma unroll
                for (int n = 0; n < 2; ++n)
#pragma unroll
                    for (int i = 0; i < 4; ++i) { const float gv = acc[ai][0][m][n][i]; v[n][i] = gv * sigmoidf_fast(gv) * acc[ai][1][m][n][i]; }
                bf16_t* dst = h + (size_t)(row0 + ai * HALF + m * 16) * 512 + col0; const u32x4 w = pack8f(v[0], v[1]);
                if (MOE_HANDOFF) asm volatile("global_store_dwordx4 %0, %1, off sc1\n\ts_nop 1" :: "v"(dst), "v"(w) : "memory"); else *(u32x4*)dst = w; }
    }
};
struct EpiMoeDown {
    static constexpr bool PERM = true, AFTER_DRAIN = false;
    bf16_t* y;
    __device__ __forceinline__ void operator()(const f32x4 (&acc)[2][2][4][2], const Unit& u, int wr, int wc, int fr, int fq) const {
        const int row0 = u.pm * BM + wr * 64 + fr; const int col0 = (u.pn & 3) * BM + wc * 32 + 8 * fq;
#pragma unroll
        for (int ai = 0; ai < 2; ++ai)
#pragma unroll
            for (int m = 0; m < 4; ++m) { bf16_t* rowp = y + (size_t)(row0 + ai * HALF + m * 16) * 1024 + col0;
#pragma unroll
                for (int bj = 0; bj < 2; ++bj) *(u32x4*)(rowp + bj * HALF) = pack8f(acc[ai][bj][m][0], acc[ai][bj][m][1]); }
    }
};
struct MoeOrder {
    const PG8_LAS int* tab; int G, c;
    unsigned* cnt;
    unsigned need;
    bool publish; unsigned* tmo;
    __device__ __forceinline__ bool next(int i, Unit& u) const {
        const int nunits = (tab[32] >> 8) * 4; const int L = i * G + c; if (L >= nunits) return false;
        const int tile = L >> 2, s = tile << 8; int e = 0;
#pragma unroll 1
        for (int k = 1; k < 32; ++k) e = (tab[k] <= s) ? k : e;
        u.pm = __builtin_amdgcn_readfirstlane(tile); u.pn = __builtin_amdgcn_readfirstlane(e * 4 + (L & 3)); return true;
    }
    mutable int calls;
    __device__ __forceinline__ void a_ready(const Unit& u) const {
        const int k = calls++;
        if (need == 0u || (k >= 1 && k < 4)) return;
        if (threadIdx.x < 64) {
            const int lane = threadIdx.x, nunits = (tab[32] >> 8) * 4;
            int tile = u.pm; bool mine = (lane == 0);
            if (k == 0) { const int L = lane * G + c; mine = (lane < 4) && (L < nunits); tile = mine ? (L >> 2) : u.pm; }
            const unsigned long long t0 = __builtin_amdgcn_s_memrealtime(); unsigned polls = 0;
            for (;;) {
                const bool ok = !mine || __hip_atomic_load(cnt + 64 * tile, __ATOMIC_RELAXED, __HIP_MEMORY_SCOPE_AGENT) >= need;
                if (__all(ok)) break;
                if ((++polls & 255u) == 0u && __builtin_amdgcn_readfirstlane(__hip_atomic_load(tmo, __ATOMIC_RELAXED, __HIP_MEMORY_SCOPE_AGENT)) != 0u) break;
                if (__builtin_amdgcn_s_memrealtime() - t0 > 2000000ull) { if (threadIdx.x == 0) __hip_atomic_store(tmo, 1u, __ATOMIC_RELAXED, __HIP_MEMORY_SCOPE_AGENT); break; }
                __builtin_amdgcn_s_sleep(2); }
            __builtin_amdgcn_fence(__ATOMIC_ACQUIRE, "agent");
            asm volatile("s_waitcnt vmcnt(0)" ::: "memory");
        }
        asm volatile("" ::: "memory"); __builtin_amdgcn_s_barrier(); asm volatile("" ::: "memory");
    }
    mutable int pend;
    __device__ __forceinline__ void done(const Unit& u) const {
        if (!publish) return;
        if (pend >= 0 && (threadIdx.x & 63) == 0) __hip_atomic_fetch_add(cnt + 64 * pend, 1u, __ATOMIC_RELAXED, __HIP_MEMORY_SCOPE_AGENT);
        pend = u.pm;
    }
    __device__ __forceinline__ void flush() const {
        if (!publish) return;
        asm volatile("s_waitcnt vmcnt(0)" ::: "memory");
        if (pend >= 0 && (threadIdx.x & 63) == 0) __hip_atomic_fetch_add(cnt + 64 * pend, 1u, __ATOMIC_RELAXED, __HIP_MEMORY_SCOPE_AGENT);
        pend = -1;
    }
};
template <class Epi, class Sched, bool ALIGN_EPI = false, bool SP2 = false, bool GATHER = false>
__device__ __forceinline__ void gemm_phase(PG8_LAS unsigned char* lds, const Gemm g, const Sched& S, const Epi& E, const int* tok = nullptr) {
    static_assert(!GATHER || SP2, "GATHER is written for the SP2 loop only");
    const int tid = threadIdx.x, wid = __builtin_amdgcn_readfirstlane(tid >> 6), lane = tid & 63, wr = wid >> 2, wc = wid & 3, fr = lane & 15, fq = lane >> 4;
    const int K = g.K, nt = K / BK;
    unsigned voffA[2], voffB[2]; int gR[2], gC[2];
#pragma unroll
    for (int i = 0; i < 2; ++i) { int R, C; stage_rc(tid * 16 + i * 8192, R, C); const int Rb = Epi::PERM ? ((R & ~31) + perm32(R & 31)) : R; gR[i] = R; gC[i] = C;
        voffA[i] = (unsigned)(R * K + C) * 2u; voffB[i] = (unsigned)(Rb * K + C) * 2u; }
    unsigned vc0[2] = {0u, 0u}, vc1[2] = {0u, 0u}, vn0[2] = {0u, 0u}, vn1[2] = {0u, 0u};
#define PG8_GROWS(pm_, o0, o1) do { _Pragma("unroll") for (int _i = 0; _i < 2; ++_i) { o0[_i] = (unsigned)(tok[(pm_) * BM + gR[_i]] * K + gC[_i]) * 2u; o1[_i] = (unsigned)(tok[(pm_) * BM + HALF + gR[_i]] * K + gC[_i]) * 2u; } } while (0)
#define PG8_STAGE_A(bufoff, gbase, h, usenext) do { if constexpr (GATHER) { const unsigned _o0 = (usenext) ? ((h) ? vn1[0] : vn0[0]) : ((h) ? vc1[0] : vc0[0]), _o1 = (usenext) ? ((h) ? vn1[1] : vn0[1]) : ((h) ? vc1[1] : vc0[1]); \
        __builtin_amdgcn_global_load_lds((const unsigned*)((const char*)(gbase) + _o0), (PG8_LAS unsigned*)(lds + (bufoff) + ldsw), 16, 0, 0); \
        __builtin_amdgcn_global_load_lds((const unsigned*)((const char*)(gbase) + _o1), (PG8_LAS unsigned*)(lds + (bufoff) + ldsw + 8192), 16, 0, 0); } \
    else { PG8_STAGE(bufoff, (gbase) + (h) * hstep, voffA); } } while (0)
    const size_t kstep = (size_t)(BK * 2);
    const size_t hstep = (size_t)HALF * K * 2;
    const size_t tstep = 2 * hstep;
    const unsigned ldsw = (unsigned)wid * 1024u;
    const int aoff = lds_byte(wr * 64 + fr, fq * 8), boff = lds_byte(wc * 32 + fr, fq * 8);
#define PG8_SA(b, h) (((b) * 2 + (h)) * HTB)
#define PG8_SB(b, h) ((4 + (b) * 2 + (h)) * HTB)
#define PG8_STAGE(bufoff, gbase, voff) do { _Pragma("unroll") for (int _i = 0; _i < 2; ++_i) \
        __builtin_amdgcn_global_load_lds((const unsigned*)((const char*)(gbase) + (voff)[_i]), (PG8_LAS unsigned*)(lds + (bufoff) + ldsw + _i * 8192), 16, 0, 0); } while (0)
#define PG8_LDA(dst, b, h) do { _Pragma("unroll") for (int m = 0; m < 4; ++m) _Pragma("unroll") for (int k = 0; k < 2; ++k) dst[m][k] = *(const PG8_LAS bf16x8*)(lds + PG8_SA(b, h) + aoff + m * 2048 + k * 1024); } while (0)
#define PG8_LDB(dst, b, h) do { _Pragma("unroll") for (int n = 0; n < 2; ++n) _Pragma("unroll") for (int k = 0; k < 2; ++k) dst[n][k] = *(const PG8_LAS bf16x8*)(lds + PG8_SB(b, h) + boff + n * 2048 + k * 1024); } while (0)
#define PG8_MMA(ai, bj, At, Bt) do { __builtin_amdgcn_s_setprio(1); _Pragma("unroll") for (int m = 0; m < 4; ++m) _Pragma("unroll") for (int n = 0; n < 2; ++n) _Pragma("unroll") for (int k = 0; k < 2; ++k) \
        acc[ai][bj][m][n] = __builtin_amdgcn_mfma_f32_16x16x32_bf16(Bt[n][k], At[m][k], acc[ai][bj][m][n], 0, 0, 0); __builtin_amdgcn_s_setprio(0); } while (0)
#define PG8_WAIT_V(n) asm volatile("s_waitcnt vmcnt(" #n ")" ::: "memory")
#define PG8_WAIT_L(n) asm volatile("s_waitcnt lgkmcnt(" #n ")" ::: "memory")
#define PG8_BAR __builtin_amdgcn_s_barrier()
#define PG8_SCHED __builtin_amdgcn_sched_barrier(0)
    Unit cur, nxt; int ui = 0;
    if (!S.next(0, cur)) return;
    f32x4 acc[2][2][4][2];
#pragma unroll
    for (int a = 0; a < 2; ++a)
#pragma unroll
        for (int b = 0; b < 2; ++b)
#pragma unroll
            for (int m = 0; m < 4; ++m)
#pragma unroll
                for (int n = 0; n < 2; ++n) acc[a][b][m][n] = (f32x4){0.f, 0.f, 0.f, 0.f};
    bf16x8 At[4][2], B0[2][2], B1[2][2];
    const char* cA = GATHER ? (const char*)g.A : (const char*)g.A + (size_t)cur.pm * tstep; const char* cB = (const char*)g.Bt + (size_t)cur.pn * tstep;
    S.a_ready(cur);
    if constexpr (GATHER) PG8_GROWS(cur.pm, vc0, vc1);
    if constexpr (SP2) {
        PG8_STAGE(PG8_SB(0, 0), cB, voffB); PG8_STAGE(PG8_SB(0, 1), cB + hstep, voffB); PG8_STAGE_A(PG8_SA(0, 0), cA, 0, false); PG8_STAGE_A(PG8_SA(0, 1), cA, 1, false);
        if (wr == 1) PG8_BAR;
        PG8_WAIT_V(2); PG8_BAR;
        PG8_STAGE(PG8_SB(1, 0), cB + kstep, voffB); PG8_STAGE_A(PG8_SA(1, 0), cA + kstep, 0, false); PG8_STAGE(PG8_SB(1, 1), cB + hstep + kstep, voffB);
        PG8_WAIT_V(6); PG8_BAR;
    } else {
        PG8_STAGE(PG8_SB(0, 0), cB, voffB); PG8_STAGE(PG8_SA(0, 0), cA, voffA); PG8_STAGE(PG8_SB(0, 1), cB + hstep, voffB); PG8_STAGE(PG8_SA(0, 1), cA + hstep, voffA);
        if (wr == 1) PG8_BAR;
        PG8_WAIT_V(4); PG8_BAR;
        PG8_STAGE(PG8_SB(1, 0), cB + kstep, voffB); PG8_STAGE(PG8_SA(1, 0), cA + kstep, voffA); PG8_STAGE(PG8_SB(1, 1), cB + hstep + kstep, voffB);
        PG8_WAIT_V(6); PG8_BAR;
    }
    for (;;) {
        const bool has_next = S.next(ui + 1, nxt);
        const char* nA = GATHER ? (const char*)g.A : (has_next ? (const char*)g.A + (size_t)nxt.pm * tstep : cA); const char* nB = has_next ? (const char*)g.Bt + (size_t)nxt.pn * tstep : cB;
        if constexpr (GATHER) { if (has_next) PG8_GROWS(nxt.pm, vn0, vn1); else { vn0[0] = vc0[0]; vn0[1] = vc0[1]; vn1[0] = vc1[0]; vn1[1] = vc1[1]; } }
        for (int t = 0; t < nt; t += 2) {
            const bool last = (t == nt - 2);
            const char* a1 = cA + (size_t)(t + 1) * kstep;
            const char* a2 = last ? nA : cA + (size_t)(t + 2) * kstep; const char* b2 = last ? nB : cB + (size_t)(t + 2) * kstep;
            const char* a3 = a2 + kstep; const char* b3 = b2 + kstep;
            if (last && has_next) S.a_ready(nxt);
            if constexpr (SP2) {
            PG8_LDB(B0, 0, 0); PG8_LDB(B1, 0, 1); PG8_SCHED; PG8_LDA(At, 0, 0); PG8_STAGE_A(PG8_SA(1, 1), a1, 1, false);
            PG8_WAIT_V(8); PG8_WAIT_L(0); PG8_BAR; PG8_MMA(0, 0, At, B0); PG8_MMA(0, 1, At, B1); PG8_BAR; PG8_SCHED;
            PG8_LDA(At, 0, 1); PG8_STAGE(PG8_SB(0, 0), b2, voffB); PG8_STAGE(PG8_SB(0, 1), b2 + hstep, voffB); PG8_STAGE_A(PG8_SA(0, 0), a2, 0, last);
            PG8_WAIT_V(8); PG8_WAIT_L(0); PG8_BAR; PG8_MMA(1, 0, At, B0); PG8_MMA(1, 1, At, B1); PG8_BAR; PG8_SCHED;
            PG8_LDB(B0, 1, 0); PG8_LDB(B1, 1, 1); PG8_SCHED; PG8_LDA(At, 1, 0); PG8_STAGE_A(PG8_SA(0, 1), a2, 1, last);
            PG8_WAIT_V(8); PG8_WAIT_L(0); PG8_BAR; PG8_MMA(0, 0, At, B0); PG8_MMA(0, 1, At, B1); PG8_BAR; PG8_SCHED;
            PG8_LDA(At, 1, 1); PG8_STAGE(PG8_SB(1, 0), b3, voffB); PG8_STAGE(PG8_SB(1, 1), b3 + hstep, voffB); PG8_STAGE_A(PG8_SA(1, 0), a3, 0, last);
            PG8_WAIT_V(8); PG8_WAIT_L(0); PG8_BAR; PG8_MMA(1, 0, At, B0); PG8_MMA(1, 1, At, B1); PG8_BAR; PG8_SCHED;
            } else {
            PG8_LDB(B0, 0, 0); PG8_SCHED; PG8_LDA(At, 0, 0); PG8_STAGE(PG8_SA(1, 1), a1 + hstep, voffA);
            PG8_WAIT_L(8); PG8_BAR; PG8_WAIT_L(0); PG8_MMA(0, 0, At, B0); PG8_BAR; PG8_SCHED;
            PG8_LDB(B1, 0, 1); PG8_STAGE(PG8_SB(0, 0), b2, voffB);
            PG8_BAR; PG8_WAIT_L(0); PG8_MMA(0, 1, At, B1); PG8_BAR;
            PG8_LDA(At, 0, 1); PG8_STAGE(PG8_SA(0, 0), a2, voffA);
            PG8_BAR; PG8_WAIT_L(0); PG8_MMA(1, 0, At, B0); PG8_BAR; PG8_SCHED;
            PG8_STAGE(PG8_SB(0, 1), b2 + hstep, voffB);
            PG8_WAIT_V(6); PG8_BAR; PG8_MMA(1, 1, At, B1); PG8_BAR;
            PG8_LDB(B0, 1, 0); PG8_SCHED; PG8_LDA(At, 1, 0); PG8_STAGE(PG8_SA(0, 1), a2 + hstep, voffA);
            PG8_WAIT_L(8); PG8_BAR; PG8_WAIT_L(0); PG8_MMA(0, 0, At, B0); PG8_BAR; PG8_SCHED;
            PG8_LDB(B1, 1, 1); PG8_STAGE(PG8_SB(1, 0), b3, voffB);
            PG8_BAR; PG8_WAIT_L(0); PG8_MMA(0, 1, At, B1); PG8_BAR;
            PG8_LDA(At, 1, 1); PG8_STAGE(PG8_SA(1, 0), a3, voffA);
            PG8_BAR; PG8_WAIT_L(0); PG8_MMA(1, 0, At, B0); PG8_BAR; PG8_SCHED;
            PG8_STAGE(PG8_SB(1, 1), b3 + hstep, voffB);
            PG8_WAIT_V(6); PG8_BAR; PG8_MMA(1, 1, At, B1); PG8_BAR;
            }
        }
        if constexpr (ALIGN_EPI) { if (wr == 0) PG8_BAR; }
        if constexpr (!Epi::AFTER_DRAIN) { E(acc, cur, wr, wc, fr, fq); S.done(cur); }
        if (!has_next) break;
#pragma unroll
        for (int a = 0; a < 2; ++a)
#pragma unroll
            for (int b = 0; b < 2; ++b)
#pragma unroll
                for (int m = 0; m < 4; ++m)
#pragma unroll
                    for (int n = 0; n < 2; ++n) acc[a][b][m][n] = (f32x4){0.f, 0.f, 0.f, 0.f};
        cur = nxt; cA = nA; cB = nB; ++ui;
        if constexpr (GATHER) { vc0[0] = vn0[0]; vc0[1] = vn0[1]; vc1[0] = vn1[0]; vc1[1] = vn1[1]; }
        if constexpr (ALIGN_EPI) { if (wr == 1) PG8_BAR; }
    }
    PG8_WAIT_V(0);
    if constexpr (!ALIGN_EPI) { if (wr == 0) PG8_BAR; }
    PG8_BAR;
    if constexpr (Epi::AFTER_DRAIN) { E.fused(acc, cur, wr, wc, fr, fq, lds, wid, lane); S.done(cur); }
#undef PG8_SA
#undef PG8_SB
#undef PG8_STAGE
#undef PG8_STAGE_A
#undef PG8_GROWS
#undef PG8_LDA
#undef PG8_LDB
#undef PG8_MMA
#undef PG8_WAIT_V
#undef PG8_WAIT_L
#undef PG8_BAR
#undef PG8_SCHED
}
}

namespace attn {
typedef short bf16x8 __attribute__((ext_vector_type(8)));
typedef short s16x4 __attribute__((ext_vector_type(4)));
typedef float f32x16 __attribute__((ext_vector_type(16)));
typedef unsigned u32x4 __attribute__((ext_vector_type(4)));
typedef unsigned short bf16;
constexpr int D = 128, PITCH = 1024, SEQ = 2048;
constexpr float SCALE = 0.08838834764831845f, THR = 8.f;
constexpr int NW = 8, QBLK = 32, KVBLK = 64, QB = NW * QBLK;
constexpr int SHM_V = KVBLK * D * 2, SHM_K = KVBLK * D * 2;
constexpr int BIAS_OFF = 2 * SHM_V + 2 * SHM_K + NW * 64 * 4, NBIAS = 320;
constexpr int LDS_BYTES = BIAS_OFF + NBIAS * 4;
#define KSWZ(row, colB) ((row) * 256 + ((colB) ^ (((row) & 7) << 4)))
#define SBAR() __builtin_amdgcn_sched_barrier(0)
__device__ __forceinline__ int v_st(int k, int c) { const int kk = (k & ~0xC) | ((k & 4) << 1) | ((k & 8) >> 1); return ((kk >> 3) * 4 + (c >> 5)) * 512 + ((kk & 7) * 32 + (c & 31)) * 2; }
__device__ __forceinline__ int v_rd_base(int lane) { return ((lane & 3) << 3) | (((lane >> 2) & 3) << 6) | (((lane >> 4) & 1) << 5) | (((lane >> 5) & 1) << 8); }
constexpr int v_rd_off(int d0, int ks, int half) { return d0 * 512 + ks * 4096 + half * 2048; }
__device__ __forceinline__ int crow(int r, int hi) { return (r & 3) + 8 * (r >> 2) + 4 * hi; }
__device__ __forceinline__ unsigned cvtpk(float lo, float hi) { unsigned r; asm volatile("v_cvt_pk_bf16_f32 %0, %1, %2" : "=v"(r) : "v"(lo), "v"(hi)); return r; }
__device__ __forceinline__ bf16x8 load8(const bf16* p) { return *reinterpret_cast<const bf16x8*>(p); }
__device__ __forceinline__ int t5_bucket(int rel) {
    const int b = rel > 0 ? 16 : 0; const int n = rel < 0 ? -rel : rel; int v;
    if (n < 8) v = n; else if (n < 12) v = 8; else if (n < 16) v = 9; else if (n < 23) v = 10; else if (n < 32) v = 11; else if (n < 46) v = 12; else if (n < 65) v = 13; else if (n < 91) v = 14; else v = 15;
    return b + v;
}
__device__ __forceinline__ void bias_tile(f32x16& p0, f32x16& p1, const float* tabp) {
#pragma unroll
    for (int r = 0; r < 16; ++r) { const int c = (r & 3) + 8 * (r >> 2); p0[r] += tabp[59 - c]; p1[r] += tabp[59 - c - 32]; }
}
__device__ __forceinline__ void partialSM(f32x16& p0, f32x16& p1, float& m_reg, float& mn, float& alpha) {
    float pmax = p0[0]; for (int r = 1; r < 16; ++r) pmax = fmaxf(pmax, p0[r]); for (int r = 0; r < 16; ++r) pmax = fmaxf(pmax, p1[r]);
    { auto rr = __builtin_amdgcn_permlane32_swap(__float_as_uint(pmax), __float_as_uint(pmax), false, false);
      pmax = fmaxf(__uint_as_float(rr[0]), __uint_as_float(rr[1])); }
    constexpr float C2 = 1.4426950408889634f * SCALE;
    if (__builtin_expect(__all((pmax - m_reg) * SCALE <= THR), 1)) { mn = m_reg; alpha = 1.f; }
    else { mn = fmaxf(m_reg, pmax); alpha = __builtin_amdgcn_exp2f((m_reg - mn) * C2); m_reg = mn; }
    const float mnL = -mn * C2;
    for (int r = 0; r < 16; ++r) p0[r] = fmaf(p0[r], C2, mnL); for (int r = 0; r < 16; ++r) p1[r] = fmaf(p1[r], C2, mnL);
    for (int r = 0; r < 16; ++r) p0[r] = __builtin_amdgcn_exp2f(p0[r]);
}
__device__ __forceinline__ void finishSM(f32x16& p0, f32x16& p1, float alpha, float& l_reg, bf16x8& pa0, bf16x8& pa1, bf16x8& pa2, bf16x8& pa3) {
    for (int r = 0; r < 16; ++r) p1[r] = __builtin_amdgcn_exp2f(p1[r]);
    float ps = 0; for (int r = 0; r < 16; ++r) ps += p0[r]; for (int r = 0; r < 16; ++r) ps += p1[r];
    { auto rr = __builtin_amdgcn_permlane32_swap(__float_as_uint(ps), __float_as_uint(ps), false, false);
      ps = __uint_as_float(rr[0]) + __uint_as_float(rr[1]); }
    l_reg = l_reg * alpha + ps;
#define PK4(P, B_, OUT) do { unsigned a0 = cvtpk(P[B_+0], P[B_+1]), a1 = cvtpk(P[B_+2], P[B_+3]);                          \
        unsigned b0 = cvtpk(P[B_+4], P[B_+5]), b1 = cvtpk(P[B_+6], P[B_+7]);                                             \
        auto r0 = __builtin_amdgcn_permlane32_swap(a0, b0, false, false); auto r1 = __builtin_amdgcn_permlane32_swap(a1, b1, false, false); \
        u32x4 w = {r0[0], r1[0], r0[1], r1[1]}; OUT = *reinterpret_cast<bf16x8*>(&w); } while (0)
    PK4(p0, 0, pa0); PK4(p0, 8, pa1); PK4(p1, 0, pa2); PK4(p1, 8, pa3);
#undef PK4
}
template <int KB>
__device__ __forceinline__ void qkt(f32x16& p0, f32x16& p1, const char* K_lds, int r32, int hi, const bf16x8* qr, bool act) {
    if (!act) { const float NEG = -__builtin_inff();
#pragma unroll
        for (int r = 0; r < 16; ++r) { p0[r] = NEG; p1[r] = NEG; } return; }
    p0 = f32x16{}; p1 = f32x16{};
    const char* kb[4];
#pragma unroll
    for (int dd = 0; dd < 4; ++dd) kb[dd] = K_lds + KB * SHM_K + KSWZ(r32, (dd * 16 + hi * 8) * 2);
#pragma unroll
    for (int d0 = 0; d0 < 8; ++d0) { const char* a = kb[d0 & 3] + (d0 >> 2) * 128;
        bf16x8 b0 = *reinterpret_cast<const bf16x8*>(a);
        bf16x8 b1 = *reinterpret_cast<const bf16x8*>(a + 32 * 256);
        p0 = __builtin_amdgcn_mfma_f32_32x32x16_bf16(b0, qr[d0], p0, 0, 0, 0);
        p1 = __builtin_amdgcn_mfma_f32_32x32x16_bf16(b1, qr[d0], p1, 0, 0, 0); }
}
template <int VB>
__device__ __forceinline__ void pv_tile(f32x16* o, int vb0, bf16x8 pa0, bf16x8 pa1, bf16x8 pa2, bf16x8 pa3, bool act) {
    if (!act) return;
#define TRRD(dst, off) asm volatile("ds_read_b64_tr_b16 %0, %1 offset:%2" : "=&v"(dst) : "v"(vb0), "i"(off) : "memory")
#define PV_D0(d0) do { s16x4 l0, l1, l2, l3, h0, h1, h2, h3; constexpr int b_ = VB * SHM_V + v_rd_off(d0, 0, 0); \
        TRRD(l0, b_); TRRD(h0, b_ + 2048); TRRD(l1, b_ + 4096); TRRD(h1, b_ + 6144); TRRD(l2, b_ + 8192); TRRD(h2, b_ + 10240); TRRD(l3, b_ + 12288); TRRD(h3, b_ + 14336); \
        asm volatile("s_waitcnt lgkmcnt(0)" ::: "memory"); SBAR();   \
        o[d0] = __builtin_amdgcn_mfma_f32_32x32x16_bf16(pa0, (bf16x8){l0[0], l0[1], l0[2], l0[3], h0[0], h0[1], h0[2], h0[3]}, o[d0], 0, 0, 0);   \
        o[d0] = __builtin_amdgcn_mfma_f32_32x32x16_bf16(pa1, (bf16x8){l1[0], l1[1], l1[2], l1[3], h1[0], h1[1], h1[2], h1[3]}, o[d0], 0, 0, 0);   \
        o[d0] = __builtin_amdgcn_mfma_f32_32x32x16_bf16(pa2, (bf16x8){l2[0], l2[1], l2[2], l2[3], h2[0], h2[1], h2[2], h2[3]}, o[d0], 0, 0, 0);   \
        o[d0] = __builtin_amdgcn_mfma_f32_32x32x16_bf16(pa3, (bf16x8){l3[0], l3[1], l3[2], l3[3], h3[0], h3[1], h3[2], h3[3]}, o[d0], 0, 0, 0); } while (0)
    PV_D0(0); PV_D0(1); PV_D0(2); PV_D0(3);
#undef PV_D0
#undef TRRD
}
struct BlockRef { const bf16* Q; const bf16* K; const bf16* V; bf16* O; int P0; };
struct Seam { bf16x8 qr[8]; bf16x8 st_v0, st_v1, st_k0, st_k1; };
#define ROW(p, k0, rr) ((p) + (size_t)((k0) + (rr)) * PITCH + sc)
#define VMW() asm volatile("s_waitcnt vmcnt(0)" ::: "memory")
#define VMWN(n) asm volatile("s_waitcnt vmcnt(%0)" :: "i"(n) : "memory")
#define SLOAD_H(Kp, Vp, k0) do { S.st_v0 = load8(ROW(Vp, k0, sr)); S.st_v1 = load8(ROW(Vp, k0, 32 + sr)); S.st_k0 = load8(ROW(Kp, k0, sr)); S.st_k1 = load8(ROW(Kp, k0, 32 + sr)); } while (0)
#define SWRITE_HK(bf) do { *(bf16x8*)(K_lds + (bf) * SHM_K + kws) = S.st_k0; *(bf16x8*)(K_lds + (bf) * SHM_K + kws + 32 * 256) = S.st_k1; } while (0)
#define SWRITE_HV(bf) do { *(bf16x8*)(V_lds + (bf) * SHM_V + vst0) = S.st_v0; *(bf16x8*)(V_lds + (bf) * SHM_V + vst1) = S.st_v1; } while (0)
#define SWRITE_H(bf) do { SWRITE_HV(bf); SWRITE_HK(bf); } while (0)
__device__ __forceinline__ void attn_prime(const BlockRef& cur, char* lds, Seam& S) {
    const int tid = threadIdx.x, wid = __builtin_amdgcn_readfirstlane(tid >> 6), lane = tid & 63, r32 = lane & 31, hi = lane >> 5;
    const int sr = tid >> 4, sc = (tid & 15) * 8, kws = KSWZ(sr, sc * 2); char* K_lds = lds + 2 * SHM_V;
#pragma unroll
    for (int d0 = 0; d0 < 8; ++d0) S.qr[d0] = load8(cur.Q + (size_t)(wid * QBLK + r32) * PITCH + d0 * 16 + hi * 8);
    SLOAD_H(cur.K, cur.V, 0); VMW(); SWRITE_HK(0);
    __syncthreads();
}
__device__ __forceinline__ void attn_block(const BlockRef& cur, const BlockRef& nxt, char* lds, Seam& S) {
    const int tid = threadIdx.x, wid = __builtin_amdgcn_readfirstlane(tid >> 6), lane = tid & 63, r32 = lane & 31, hi = lane >> 5;
    const int NT = cur.P0 / KVBLK + QB / KVBLK;
    const int qlo = cur.P0 + wid * QBLK, cw = qlo >> 6;
    char* V_lds = lds; char* K_lds = lds + 2 * SHM_V;
    float* ws = (float*)(lds + 2 * SHM_V + 2 * SHM_K) + wid * 64; float* li_l = ws, * al_l = ws + 32;
    const float* btab = (const float*)(lds + BIAS_OFF);
    float m_reg = -1e30f, l_reg = 0; f32x16 o[4] = {};
    const int sr = tid >> 4, sc = (tid & 15) * 8, vst0 = v_st(sr, sc), vst1 = v_st(32 + sr, sc), kws = KSWZ(sr, sc * 2);
    const int vb0 = (int)(uintptr_t)V_lds + v_rd_base(lane);
    const bf16* Kh = cur.K; const bf16* Vh = cur.V;
    const int bb0 = qlo + r32 - 4 * hi + 4;
#define RESC(a) do { if (__any((a) < 1.f)) { if (hi == 0) al_l[r32] = (a); asm volatile("s_waitcnt lgkmcnt(0)" ::: "memory");              \
                     for (int d_ = 0; d_ < 4; ++d_) for (int r = 0; r < 16; ++r) o[d_][r] *= al_l[crow(r, hi)]; } } while (0)
#define KBASE(t) ((t) * KVBLK)
#define ACT(t) ((t) <= cw)
#define BIAST(P0_, P1_, t) do { if ((t) <= cw && (t) + 2 >= cw) bias_tile(P0_, P1_, btab + (bb0 - KBASE(t))); } while (0)
    constexpr int NQL = 8;
#define SEAM_K0() do { VMWN(NQL); SWRITE_HK(0); SBAR(); } while (0)
    f32x16 pA0, pA1, pB0, pB1; float mnA, mnB, alA, alB; bf16x8 pa0, pa1, pa2, pa3;
    SWRITE_HV(0); SBAR();
    SLOAD_H(Kh, Vh, KBASE(1));
    SBAR(); qkt<0>(pA0, pA1, K_lds, r32, hi, S.qr, ACT(0));
    BIAST(pA0, pA1, 0); partialSM(pA0, pA1, m_reg, mnA, alA);
    VMW(); SWRITE_H(1);
    __syncthreads();
#define HALF_STEP(PX0, PX1, mnX, alX, PY0, PY1, alY, t, KB, VB, SB) do {                                                      \
        SBAR(); qkt<KB>(PX0, PX1, K_lds, r32, hi, S.qr, ACT(t));                                                 \
        finishSM(PY0, PY1, alY, l_reg, pa0, pa1, pa2, pa3); SBAR();                                                           \
        if ((t) + 1 < NT) { SLOAD_H(Kh, Vh, KBASE((t) + 1)); SBAR(); }                                                         \
        pv_tile<VB>(o, vb0, pa0, pa1, pa2, pa3, ACT((t) - 1)); BIAST(PX0, PX1, (t)); partialSM(PX0, PX1, m_reg, mnX, alX);    \
        __syncthreads();                                                                                                      \
        if ((t) + 1 < NT) { VMW(); SWRITE_H(SB); }                                                                             \
        RESC(alX); __syncthreads(); } while (0)
    for (int t = 1; t + 1 < NT; t += 2) {
        HALF_STEP(pB0, pB1, mnB, alB, pA0, pA1, alA, t, 1, 0, 0);
        HALF_STEP(pA0, pA1, mnA, alA, pB0, pB1, alB, t + 1, 0, 1, 1);
    }
    { SBAR(); qkt<1>(pB0, pB1, K_lds, r32, hi, S.qr, ACT(NT - 1)); SBAR(); }
    SLOAD_H(nxt.K, nxt.V, 0); SBAR();
#pragma unroll
    for (int d0 = 0; d0 < 8; ++d0) S.qr[d0] = load8(nxt.Q + (size_t)(wid * QBLK + r32) * PITCH + d0 * 16 + hi * 8);
    SBAR();
    finishSM(pA0, pA1, alA, l_reg, pa0, pa1, pa2, pa3); SBAR();
    pv_tile<0>(o, vb0, pa0, pa1, pa2, pa3, ACT(NT - 2));
    { BIAST(pB0, pB1, NT - 1); partialSM(pB0, pB1, m_reg, mnB, alB); __syncthreads(); RESC(alB);
      finishSM(pB0, pB1, alB, l_reg, pa0, pa1, pa2, pa3); SBAR(); pv_tile<1>(o, vb0, pa0, pa1, pa2, pa3, ACT(NT - 1)); }
    SBAR(); SEAM_K0();
    if (hi == 0) li_l[r32] = l_reg; asm volatile("s_waitcnt lgkmcnt(0)" ::: "memory");
    float rli[16];
#pragma unroll
    for (int r = 0; r < 16; ++r) rli[r] = __builtin_amdgcn_rcpf(li_l[crow(r, hi)]);
    bf16* Ow = cur.O + (size_t)(wid * QBLK) * PITCH;
#pragma unroll
    for (int r = 0; r < 16; ++r) { const int orow = crow(r, hi);
#pragma unroll
        for (int d0 = 0; d0 < 4; ++d0) { const float v = o[d0][r] * rli[r];
            const float vn = __shfl_xor(v, 1);
            if ((r32 & 1) == 0) *(unsigned*)(Ow + (size_t)orow * PITCH + d0 * 32 + r32) = cvtpk(v, vn); } }
    __syncthreads();
#undef RESC
#undef KBASE
#undef ACT
#undef BIAST
#undef SEAM_K0
#undef HALF_STEP
}
#undef ROW
#undef VMW
#undef VMWN
#undef SLOAD_H
#undef SWRITE_HK
#undef SWRITE_HV
#undef SWRITE_H
#undef KSWZ
}

namespace attn2 {
using attn::bf16x8; using attn::s16x4; using attn::f32x16; using attn::u32x4; using attn::bf16;
using attn::v_st; using attn::v_rd_base; using attn::crow; using attn::cvtpk; using attn::load8; using attn::t5_bucket;
constexpr int D = 128, PITCH = 1024;
constexpr float SCALE = 0.08838834764831845f, THR = 8.f;
constexpr int NW = 8, QBLK = 32, KVBLK = 64, QB = 4 * QBLK;
constexpr int IMG = KVBLK * D * 2, SHM_V = 2 * IMG, SHM_K = KVBLK * D * 2;
constexpr int OFF_V = 0, OFF_K = 2 * SHM_V, OFF_PX = OFF_K + 2 * SHM_K, OFF_WS = OFF_PX + NW * 2048, OFF_MX = OFF_WS + NW * 64 * 4, BIAS_OFF = OFF_MX + NW * 32 * 4, NBIAS = 320;
constexpr int LDS_BYTES = BIAS_OFF + NBIAS * 4;
#define KSWZ(row, colB) ((row) * 256 + ((colB) ^ (((row) & 7) << 4)))
#define SBAR() __builtin_amdgcn_sched_barrier(0)
#ifndef ATTN_SGB
#define ATTN_SGB 1
#endif
#if ATTN_SGB
#define SGB_A() do { _Pragma("unroll") for (int g_ = 0; g_ < 8; ++g_) { __builtin_amdgcn_sched_group_barrier(0x008, 1, 0); __builtin_amdgcn_sched_group_barrier(0x402, 9, 0); } } while (0)
#else
#define SGB_A() do {} while (0)
#endif
#define L3 __attribute__((address_space(3)))
#define LP(T, byteoff) ((L3 T*)(uintptr_t)(unsigned)(byteoff))
__device__ __forceinline__ void bias_half(f32x16& p, const L3 float* tabp) {
#pragma unroll
    for (int r = 0; r < 16; ++r) { const int c = (r & 3) + 8 * (r >> 2); p[r] += tabp[59 - c]; }
}
__device__ __forceinline__ float rowmax_half(const f32x16& p) {
    float pmax = p[0];
#pragma unroll
    for (int r = 1; r < 16; ++r) pmax = fmaxf(pmax, p[r]);
    const auto rr = __builtin_amdgcn_permlane32_swap(__float_as_uint(pmax), __float_as_uint(pmax), false, false);
    return fmaxf(__uint_as_float(rr[0]), __uint_as_float(rr[1]));
}
__device__ __forceinline__ void partialSM(f32x16& p, float pmax, float& m_reg, float& alpha) {
    constexpr float C2 = 1.4426950408889634f * SCALE; float mn;
    if (__builtin_expect(__all((pmax - m_reg) * SCALE <= THR), 1)) { mn = m_reg; alpha = 1.f; }
    else { mn = fmaxf(m_reg, pmax); alpha = __builtin_amdgcn_exp2f((m_reg - mn) * C2); m_reg = mn; }
    const float mnL = -mn * C2;
#pragma unroll
    for (int r = 0; r < 16; ++r) p[r] = fmaf(p[r], C2, mnL);
#pragma unroll
    for (int r = 0; r < 8; ++r) p[r] = __builtin_amdgcn_exp2f(p[r]);
}
__device__ __forceinline__ void finishSM(f32x16& p, float alpha, float& l_reg, bf16x8& pa0, bf16x8& pa1) {
#pragma unroll
    for (int r = 8; r < 16; ++r) p[r] = __builtin_amdgcn_exp2f(p[r]);
    float ps = 0;
#pragma unroll
    for (int r = 0; r < 16; ++r) ps += p[r];
    { const auto rr = __builtin_amdgcn_permlane32_swap(__float_as_uint(ps), __float_as_uint(ps), false, false); ps = __uint_as_float(rr[0]) + __uint_as_float(rr[1]); }
    l_reg = l_reg * alpha + ps;
#define PK4(P, B_, OUT) do { unsigned a0 = cvtpk(P[B_+0], P[B_+1]), a1 = cvtpk(P[B_+2], P[B_+3]);                          \
        unsigned b0 = cvtpk(P[B_+4], P[B_+5]), b1 = cvtpk(P[B_+6], P[B_+7]);                                             \
        auto r0 = __builtin_amdgcn_permlane32_swap(a0, b0, false, false); auto r1 = __builtin_amdgcn_permlane32_swap(a1, b1, false, false); \
        u32x4 w = {r0[0], r1[0], r0[1], r1[1]}; OUT = *reinterpret_cast<bf16x8*>(&w); } while (0)
    PK4(p, 0, pa0); PK4(p, 8, pa1);
#undef PK4
}
template <int KB>
__device__ __forceinline__ void kload(bf16x8* kf, unsigned K_lds, int krow, int hi) {
    unsigned kb[4];
#pragma unroll
    for (int dd = 0; dd < 4; ++dd) kb[dd] = K_lds + KB * SHM_K + KSWZ(krow, (dd * 16 + hi * 8) * 2);
#pragma unroll
    for (int d0 = 0; d0 < 8; ++d0) kf[d0] = *LP(const bf16x8, kb[d0 & 3] + (d0 >> 2) * 128);
}
__device__ __forceinline__ void qmma(f32x16& p, const bf16x8* kf, const bf16x8* qr) {
    p = f32x16{};
#pragma unroll
    for (int d0 = 0; d0 < 8; ++d0) p = __builtin_amdgcn_mfma_f32_32x32x16_bf16(kf[d0], qr[d0], p, 0, 0, 0);
}
__device__ __forceinline__ void pneg(f32x16& p) { const float NEG = -__builtin_inff();
#pragma unroll
    for (int r = 0; r < 16; ++r) p[r] = NEG; }
template <int VB>
__device__ __forceinline__ void pv_tile(f32x16* o, int vbo, int vbp, bf16x8 po0, bf16x8 po1, bf16x8 pp0, bf16x8 pp1, bool act) {
    if (!act) return;
#define TRRD(dst, base, off) asm volatile("ds_read_b64_tr_b16 %0, %1 offset:%2" : "=&v"(dst) : "v"(base), "i"(off) : "memory")
#define PV_D0(d0) do { s16x4 l0, l1, l2, l3, h0, h1, h2, h3; constexpr int b_ = VB * SHM_V + (d0) * 512; \
        TRRD(l0, vbo, b_); TRRD(h0, vbo, b_ + 2048); TRRD(l1, vbo, b_ + 4096); TRRD(h1, vbo, b_ + 6144); TRRD(l2, vbp, b_); TRRD(h2, vbp, b_ + 2048); TRRD(l3, vbp, b_ + 4096); TRRD(h3, vbp, b_ + 6144); \
        asm volatile("s_waitcnt lgkmcnt(0)" ::: "memory"); SBAR();   \
        o[d0] = __builtin_amdgcn_mfma_f32_32x32x16_bf16(po0, (bf16x8){l0[0], l0[1], l0[2], l0[3], h0[0], h0[1], h0[2], h0[3]}, o[d0], 0, 0, 0);   \
        o[d0] = __builtin_amdgcn_mfma_f32_32x32x16_bf16(po1, (bf16x8){l1[0], l1[1], l1[2], l1[3], h1[0], h1[1], h1[2], h1[3]}, o[d0], 0, 0, 0);   \
        o[d0] = __builtin_amdgcn_mfma_f32_32x32x16_bf16(pp0, (bf16x8){l2[0], l2[1], l2[2], l2[3], h2[0], h2[1], h2[2], h2[3]}, o[d0], 0, 0, 0);   \
        o[d0] = __builtin_amdgcn_mfma_f32_32x32x16_bf16(pp1, (bf16x8){l3[0], l3[1], l3[2], l3[3], h3[0], h3[1], h3[2], h3[3]}, o[d0], 0, 0, 0); } while (0)
    PV_D0(0); PV_D0(1); PV_D0(2); PV_D0(3);
#undef PV_D0
#undef TRRD
}
struct BlockRef { const bf16* Q; const bf16* K; const bf16* V; bf16* O; int P0; };
struct Seam { bf16x8 qr[8]; bf16x8 k0[2], k1[2], v0[2], v1[2], v2[2], v3[2]; };
#define VMW() asm volatile("s_waitcnt vmcnt(0)" ::: "memory")
typedef __amdgpu_buffer_rsrc_t rsrc_t;
__device__ __forceinline__ rsrc_t mkrsrc(const bf16* p) { return __builtin_amdgcn_make_buffer_rsrc((void*)p, (short)0, 0x7fffffff, 0x00020000); }
__device__ __forceinline__ bf16x8 bld16(rsrc_t r, unsigned voff, unsigned soff) { return __builtin_bit_cast(bf16x8, __builtin_amdgcn_raw_buffer_load_b128(r, (int)voff, (int)soff, 0)); }
#define RB(kk_, radd) ((unsigned)(((kk_) + (radd)) * PITCH) * 2u)
#define SLOADK(set, rK_, kk_) do { S.k0[set] = bld16(rK_, lofs, RB(kk_, 0)); S.k1[set] = bld16(rK_, lofs, RB(kk_, 32)); } while (0)
#define SLOADV(set, rV_, kk_) do { S.v0[set] = bld16(rV_, lofs, RB(kk_, 0)); S.v1[set] = bld16(rV_, lofs, RB(kk_, 32)); S.v2[set] = bld16(rV_, lofs, RB(kk_, 0) + 256u); S.v3[set] = bld16(rV_, lofs, RB(kk_, 32) + 256u); } while (0)
#define SWRITE_K(bf, set) do { *LP(bf16x8, K_lds + (bf) * SHM_K + kws) = S.k0[set]; *LP(bf16x8, K_lds + (bf) * SHM_K + kws + 32 * 256) = S.k1[set]; } while (0)
#define SWRITE_V(bf, set) do { *LP(bf16x8, V_lds + (bf) * SHM_V + vst0) = S.v0[set]; *LP(bf16x8, V_lds + (bf) * SHM_V + vst0 + VST1) = S.v1[set]; *LP(bf16x8, V_lds + (bf) * SHM_V + IMG + vst0) = S.v2[set]; *LP(bf16x8, V_lds + (bf) * SHM_V + IMG + vst0 + VST1) = S.v3[set]; } while (0)
__device__ __forceinline__ void attn_prime(const BlockRef& cur, char* lds, Seam& S, int tid) {
    const int wid = __builtin_amdgcn_readfirstlane(tid >> 6), lane = tid & 63, r32 = lane & 31, hi = lane >> 5, pj = wid & 3;
    const int sr = tid >> 4, sc = (tid & 15) * 8, kws = KSWZ(sr, sc * 2); const unsigned K_lds = (unsigned)(uintptr_t)lds + OFF_K, lofs = (unsigned)(sr * PITCH + sc) * 2u, qofs = (unsigned)(r32 * PITCH + hi * 8) * 2u;
    const rsrc_t rQ = mkrsrc(cur.Q), rK = mkrsrc(cur.K), rV = mkrsrc(cur.V);
#pragma unroll
    for (int d0 = 0; d0 < 8; ++d0) S.qr[d0] = bld16(rQ, qofs, (unsigned)((pj * QBLK) * PITCH + d0 * 16) * 2u);
    SLOADK(0, rK, 0); VMW(); SWRITE_K(0, 0); SBAR();
    SLOADK(1, rK, KVBLK); SLOADV(0, rV, 0); SLOADK(0, rK, 2 * KVBLK); SLOADV(1, rV, KVBLK);
    __syncthreads();
}
__device__ __forceinline__ void attn_block(const BlockRef& cur, const BlockRef& nxt, char* lds, Seam& S, int tid) {
    const int wid = __builtin_amdgcn_readfirstlane(tid >> 6), lane = tid & 63, r32 = lane & 31, hi = lane >> 5, pj = wid & 3, kh = wid >> 2, pw = wid ^ 4;
    const int NT = cur.P0 / KVBLK + QB / KVBLK, NTn = nxt.P0 / KVBLK + QB / KVBLK;
    const int qlo = cur.P0 + pj * QBLK, cw = qlo >> 6;
    const unsigned L = (unsigned)(uintptr_t)lds, V_lds = L + OFF_V, K_lds = L + OFF_K;
    L3 float* li_l = LP(float, L + OFF_WS + wid * 256); L3 float* al_l = li_l + 32; const L3 float* li_p = LP(const float, L + OFF_WS + pw * 256);
    L3 float* mx_o = LP(float, L + OFF_MX + wid * 128); const L3 float* mx_p = LP(const float, L + OFF_MX + pw * 128);
    const unsigned px_o = L + OFF_PX + wid * 2048 + lane * 16, px_p = L + OFF_PX + pw * 2048 + lane * 16;
    const L3 float* btab = LP(const float, L + BIAS_OFF);
    float m_reg = -1e30f, l_reg = 0; f32x16 o[4] = {};
    const int sr = tid >> 4, sc = (tid & 15) * 8, vst0 = v_st(sr, sc), kws = KSWZ(sr, sc * 2); constexpr int VST1 = 8192;
    const unsigned lofs = (unsigned)(sr * PITCH + sc) * 2u, qofs = (unsigned)(r32 * PITCH + hi * 8) * 2u;
    const int vbase = (int)V_lds + v_rd_base(lane) + kh * IMG, vbo = vbase + kh * 8192, vbp = vbase + (1 - kh) * 8192;
    const int krow = kh * 32 + r32;
    const rsrc_t cK = mkrsrc(cur.K), cV = mkrsrc(cur.V), nK = mkrsrc(nxt.K), nV = mkrsrc(nxt.V);
    const int bb0 = qlo + r32 - 4 * hi + 4 - 32 * kh;
#define RESC(a) do { if (__any((a) < 1.f)) { if (hi == 0) al_l[r32] = (a); asm volatile("s_waitcnt lgkmcnt(0)" ::: "memory");              \
                     for (int d_ = 0; d_ < 4; ++d_) for (int r = 0; r < 16; ++r) o[d_][r] *= al_l[crow(r, hi)]; } } while (0)
#define KBASE(t) ((t) * KVBLK)
#define ACT(t) ((t) <= cw)
#define BIAST(P_, t) do { if ((t) <= cw && (t) + 2 >= cw) bias_half(P_, btab + (bb0 - KBASE(t))); } while (0)
#define PUTMAX(P_) do { const float pm_ = rowmax_half(P_); if (hi == 0) mx_o[r32] = pm_; pmx = pm_; } while (0)
#define GETMAX() fmaxf(pmx, mx_p[r32])
#define VLOADK(set, v) do { const int v_ = (v); if (v_ < NT) SLOADK(set, cK, KBASE(v_)); else SLOADK(set, nK, KBASE((v_ - NT) % NTn)); } while (0)
#define VLOADV(set, v) do { const int v_ = (v); if (v_ < NT) SLOADV(set, cV, KBASE(v_)); else SLOADV(set, nV, KBASE((v_ - NT) % NTn)); } while (0)
    f32x16 pA, pB; float alA, alB, pmx; bf16x8 po0, po1, pp0, pp1;
#define STEP(PX_, alX, PY_, alY, t, KB, HASPREV) do {                                                                               \
        SBAR(); SWRITE_V(KB, KB); SBAR(); VLOADV(KB, (t) + 2); SBAR();                                                               \
        if (ACT(t)) { bf16x8 kf_[8]; kload<KB>(kf_, K_lds, krow, hi); SBAR(); qmma(PX_, kf_, S.qr);                                  \
                      if (HASPREV) { finishSM(PY_, alY, l_reg, po0, po1); *LP(bf16x8, px_o) = po0; *LP(bf16x8, px_o + 1024) = po1; } SGB_A(); }   \
        else { pneg(PX_); if (HASPREV) { finishSM(PY_, alY, l_reg, po0, po1); *LP(bf16x8, px_o) = po0; *LP(bf16x8, px_o + 1024) = po1; } }        \
        SBAR(); BIAST(PX_, (t)); PUTMAX(PX_);                                                                                       \
        __syncthreads();                                                                                                           \
        if (HASPREV) { pp0 = *LP(const bf16x8, px_p); pp1 = *LP(const bf16x8, px_p + 1024); }                                        \
        partialSM(PX_, GETMAX(), m_reg, alX);                                                                                      \
        if (HASPREV) pv_tile<1 - KB>(o, vbo, vbp, po0, po1, pp0, pp1, ACT((t) - 1));                                                \
        SBAR(); SWRITE_K(1 - KB, 1 - KB); SBAR(); VLOADK(1 - KB, (t) + 3); SBAR();                                                   \
        RESC(alX); __syncthreads(); } while (0)
    for (int t = 0; t < NT; t += 2) {
        STEP(pA, alA, pB, alB, t, 0, t > 0);
        STEP(pB, alB, pA, alA, t + 1, 1, true);
    }
    { const rsrc_t nQ = mkrsrc(nxt.Q);
#pragma unroll
      for (int d0 = 0; d0 < 8; ++d0) S.qr[d0] = bld16(nQ, qofs, (unsigned)((pj * QBLK) * PITCH + d0 * 16) * 2u); }
    SBAR();
    finishSM(pB, alB, l_reg, po0, po1); *LP(bf16x8, px_o) = po0; *LP(bf16x8, px_o + 1024) = po1;
    if (hi == 0) li_l[r32] = l_reg;
    __syncthreads();
    pp0 = *LP(const bf16x8, px_p); pp1 = *LP(const bf16x8, px_p + 1024);
    pv_tile<1>(o, vbo, vbp, po0, po1, pp0, pp1, ACT(NT - 1));
    float rli[16];
#pragma unroll
    for (int r = 0; r < 16; ++r) rli[r] = __builtin_amdgcn_rcpf(li_l[crow(r, hi)] + li_p[crow(r, hi)]);
    int lane_off = hi * 4 * PITCH + r32; asm volatile("" : "+v"(lane_off));
    bf16* Ow = cur.O + ((pj * QBLK) * PITCH + kh * 128 + lane_off);
#pragma unroll
    for (int r = 0; r < 16; ++r) { const int orow = (r & 3) + 8 * (r >> 2);
#pragma unroll
        for (int d0 = 0; d0 < 4; ++d0) { const float v = o[d0][r] * rli[r];
            const float vn = __shfl_xor(v, 1);
            if ((r32 & 1) == 0) *(unsigned*)(Ow + (orow * PITCH + d0 * 32)) = cvtpk(v, vn); } }
    __syncthreads();
#undef RESC
#undef KBASE
#undef ACT
#undef BIAST
#undef PUTMAX
#undef GETMAX
#undef VLOADK
#undef VLOADV
#undef STEP
}
#undef SLOADK
#undef SLOADV
#undef SWRITE_K
#undef SWRITE_V
#undef VMW
#undef RB
#undef KSWZ
#undef L3
#undef LP
#undef SGB_A
}


constexpr int NWAVES = 8;
constexpr int BATCH = 16, SEQ = 2048, T = BATCH * SEQ, D = 1024, NIN = 8192, NE = 32, DE = 512;
constexpr int MAXT = 288, MAXS = MAXT * 256;
constexpr float LN_EPS = 1e-5f, RMS_EPS = 1e-6f, ALPHA = 1.189207115002721f, LAM_INIT = 0.2f;
constexpr size_t MiB = 1u << 20;
constexpr size_t WS_CTL = 0, CTL_ZERO_BYTES = 1 * MiB;
constexpr size_t WS_STATS = 1 * MiB, WS_EID = WS_STATS + 256 * 1024, WS_EW = WS_EID + 256 * 1024, WS_RANK = WS_EW + 256 * 1024, WS_SLOT = 2 * MiB, WS_CNTWG = WS_SLOT + 256 * 1024, WS_TOK = 3 * MiB;
constexpr size_t WS_WA = 4 * MiB, WS_WB = 6 * MiB, WS_WO = 8 * MiB, WS_WIN = 10 * MiB;
constexpr size_t WS_XN = 26 * MiB, WS_Q = 90 * MiB, WS_K = 154 * MiB, WS_V = 218 * MiB, WS_CB = 282 * MiB, WS_Z = 346 * MiB, WS_O1 = 410 * MiB;
constexpr size_t WS_WGU = 90 * MiB, WS_WD = 154 * MiB, WS_PRE = 186 * MiB, WS_XG = 314 * MiB, WS_END = 458 * MiB;
constexpr int CW_TMO = 0, CW_CODE = 1, CW_BAR = 4096, CW_MOE = 65536;
constexpr int RING_OFF = 0, RING_BYTES = 131072, RW_BYTES = 147456;
constexpr int LDSCTL_OFF = RW_BYTES, MISC_OFF = LDSCTL_OFF + 320, TAB_OFF = LDSCTL_OFF + 512, RSCR_OFF = LDSCTL_OFF + 1024;
constexpr int LDS_BYTES = 163840;
static_assert(RSCR_OFF + 8 * 128 * 4 + 1024 <= LDS_BYTES, "LDS map");

#define GAS __attribute__((address_space(1)))
#define LAS __attribute__((address_space(3)))
typedef unsigned short bf16;
#ifdef SWAP_CB_SGA
#define BUF_CB(P)  ((bf16*)(P).out)
#define BUF_SGA(P) ((bf16*)((P).ws + WS_CB))
#else
#define BUF_CB(P)  ((bf16*)((P).ws + WS_CB))
#define BUF_SGA(P) ((bf16*)(P).out)
#endif
#define BUF_SGB(P) ((bf16*)(P).out + (size_t)T * D)
typedef unsigned v4u __attribute__((ext_vector_type(4)));
typedef unsigned v2u __attribute__((ext_vector_type(2)));
typedef float f32x4 __attribute__((ext_vector_type(4)));
typedef GAS unsigned gu32;
#define RLX_AGENT __ATOMIC_RELAXED, __HIP_MEMORY_SCOPE_AGENT
#define LDS_WAIT() asm volatile("s_waitcnt lgkmcnt(0)" ::: "memory")
#define VM_WAIT() asm volatile("s_waitcnt vmcnt(0)" ::: "memory")
__device__ __forceinline__ unsigned f2bf(float f) { unsigned u = __builtin_bit_cast(unsigned, f); return (u + 0x7fffu + ((u >> 16) & 1u)) >> 16; }
__device__ __forceinline__ unsigned pk2(float lo, float hi) { return f2bf(lo) | (f2bf(hi) << 16); }
__device__ __forceinline__ float bflo(unsigned w) { return __uint_as_float(w << 16); }
__device__ __forceinline__ float bfhi(unsigned w) { return __uint_as_float(w & 0xffff0000u); }

#define XB_TMO      128
#define XB_XCNT(j)  (256  + 64 * (j))
#define XB_XSUB(j)  (1280 + 64 * (j))
#define XB_XGEN(j)  (2304 + 64 * (j))
#define XB_TOP      3328
#define XB_TOPGEN   3392
#define XCD_BAR_WORDS 3456
#define XB_SPIN_CAP (1u << 18)
__device__ __forceinline__ unsigned xb_ld(unsigned* p)              { return __hip_atomic_load(p, __ATOMIC_RELAXED, __HIP_MEMORY_SCOPE_AGENT); }
__device__ __forceinline__ unsigned xb_add(unsigned* p, unsigned v) { return __hip_atomic_fetch_add(p, v, __ATOMIC_RELAXED, __HIP_MEMORY_SCOPE_AGENT); }
__device__ __forceinline__ unsigned xb_xcc_id() { return (unsigned)__builtin_amdgcn_s_getreg((3 << 11) | 20) & 0xFu; }
#define XB_SPIN(cond, bar) do { unsigned _sp = 0; while (cond) { __builtin_amdgcn_s_sleep(1); \
    if ((++_sp & 255u) == 0u) { if (xb_ld(&(bar)[XB_TMO])) break; if (_sp > XB_SPIN_CAP) { atomicAdd(&(bar)[XB_TMO], 1u); break; } } } } while (0)
struct XcdBarrier { unsigned* bar; unsigned x; volatile LAS unsigned* st; };
__device__ __forceinline__ XcdBarrier xcd_barrier_post(unsigned* bar, volatile LAS unsigned* st) {
    XcdBarrier b; b.bar = bar; b.x = xb_xcc_id(); b.st = st;
    if (threadIdx.x == 0) (void)xb_add(&bar[XB_XCNT(b.x)], 1u);
    return b;
}
__device__ __forceinline__ void xcd_barrier_complete(unsigned* bar, unsigned x, unsigned& nloc, unsigned& nx) {
    const unsigned G = gridDim.x * gridDim.y * gridDim.z;
    unsigned sum, cnt, mine, sp = 0u;
    for (;;) {
        sum = 0u; cnt = 0u; mine = 0u;
#pragma unroll
        for (unsigned j = 0; j < 16; ++j) { const unsigned c = xb_ld(&bar[XB_XCNT(j)]); sum += c; cnt += (c > 0u) ? 1u : 0u; mine = (j == x) ? c : mine; }
        if (sum == G) break;
        __builtin_amdgcn_s_sleep(1);
        if ((++sp & 255u) == 0u) { if (xb_ld(&bar[XB_TMO])) break; if (sp > XB_SPIN_CAP) { atomicAdd(&bar[XB_TMO], 1u); break; } }
    }
    nloc = mine > 0u ? mine : 1u; nx = cnt > 0u ? cnt : 1u;
}
__device__ __forceinline__ void xcd_barrier(const XcdBarrier& b) {
    asm volatile("s_waitcnt vmcnt(0)" ::: "memory");
    __syncthreads();
    if (threadIdx.x == 0) {
        unsigned* bar = b.bar;
        __builtin_amdgcn_s_waitcnt(0);
        unsigned nloc = b.st[0], nx = b.st[1];
        if (nloc == 0u) { xcd_barrier_complete(bar, b.x, nloc, nx); b.st[0] = nloc; b.st[1] = nx; }
        const unsigned old = xb_add(&bar[XB_XSUB(b.x)], 1u);
        const unsigned gen = old / nloc;
        if (old + 1u == (gen + 1u) * nloc) {
            __builtin_amdgcn_fence(__ATOMIC_RELEASE, "agent");
            asm volatile("s_waitcnt vmcnt(0)" ::: "memory");
            const unsigned og = xb_add(&bar[XB_TOP], 1u);
            const unsigned tg = og / nx;
            if (og + 1u == (tg + 1u) * nx) xb_add(&bar[XB_TOPGEN], 1u);
            else XB_SPIN(xb_ld(&bar[XB_TOPGEN]) == tg, bar);
            __builtin_amdgcn_fence(__ATOMIC_ACQUIRE, "agent");
            xb_add(&bar[XB_XGEN(b.x)], 1u);
            asm volatile("s_waitcnt vmcnt(0)" ::: "memory");
        } else {
            XB_SPIN(xb_ld(&bar[XB_XGEN(b.x)]) == gen, bar);
            __builtin_amdgcn_fence(__ATOMIC_ACQUIRE, "agent");
            asm volatile("s_waitcnt vmcnt(0)" ::: "memory");
        }
    }
    __syncthreads();
}

struct Frame {
    LAS unsigned char* lds; volatile LAS unsigned* MISC; gu32* ctl;
    int tid, lane, wave, vcu, G;
};
__device__ __forceinline__ float wave_sum(float v) {
#pragma unroll
    for (int o = 1; o < 64; o <<= 1) v += __shfl_xor(v, o);
    return v;
}
__device__ __forceinline__ float wave_sum_fast(float v) {
    v += __int_as_float(__builtin_amdgcn_update_dpp(0, __float_as_int(v), 0x128, 0xf, 0xf, false));
    v += __int_as_float(__builtin_amdgcn_update_dpp(0, __float_as_int(v), 0x124, 0xf, 0xf, false));
    v += __int_as_float(__builtin_amdgcn_update_dpp(0, __float_as_int(v), 0x122, 0xf, 0xf, false));
    v += __int_as_float(__builtin_amdgcn_update_dpp(0, __float_as_int(v), 0x121, 0xf, 0xf, false));
    const int vi = __float_as_int(v);
    return (__int_as_float(__builtin_amdgcn_readlane(vi, 0)) + __int_as_float(__builtin_amdgcn_readlane(vi, 16))) + (__int_as_float(__builtin_amdgcn_readlane(vi, 32)) + __int_as_float(__builtin_amdgcn_readlane(vi, 48)));
}
__device__ __forceinline__ void transpose_item(const float* W, int K, int N, int k0, int n0, bf16* WT, int drow0, LAS float* scr, int lane) {
#pragma unroll 8
    for (int i = 0; i < 32; ++i) { const int kk = 2 * i + (lane >> 5); scr[kk * 33 + (lane & 31)] = W[(size_t)(k0 + kk) * N + n0 + (lane & 31)]; }
    LDS_WAIT(); asm volatile("" ::: "memory");
    const int c = lane & 7;
#pragma unroll
    for (int j = 0; j < 4; ++j) { const int n = (lane >> 3) + 8 * j; const LAS float* s = scr + (8 * c) * 33 + n;
        v4u o; o.x = pk2(s[0 * 33], s[1 * 33]); o.y = pk2(s[2 * 33], s[3 * 33]); o.z = pk2(s[4 * 33], s[5 * 33]); o.w = pk2(s[6 * 33], s[7 * 33]);
        *(GAS v4u*)(WT + (size_t)(drow0 + n) * K + k0 + 8 * c) = o; }
    LDS_WAIT(); asm volatile("" ::: "memory");
}
__device__ __forceinline__ int win_drow(int n0) {
    if (n0 < 4096 || n0 >= 6144) return n0;
    if (n0 < 5120) { const int r = n0 - 4096; return 4096 + 256 * (r >> 7) + (r & 127); }
    const int r = n0 - 5120; return 4096 + 256 * (r >> 7) + 128 + (r & 127);
}
struct Ptrs {
    const float *x, *ln_in_g, *ln_in_b, *w_in, *b_gate, *lq, *lk, *subln_g, *rel_bias, *conv_w, *w_a, *w_b, *w_o, *ln1_g, *ln1_b, *w_group, *b_group, *w_sub, *b_sub, *w_gate_e, *w_up_e, *w_down_e, *ln2_g, *ln2_b;
    float* out; unsigned char* ws;
};
__device__ __forceinline__ void p0_prologue(Frame& F, const Ptrs& P) {
    LAS float* scr = (LAS float*)(F.lds + RING_OFF + F.wave * 16384);
    const int gw = F.vcu * NWAVES + F.wave, NGW = F.G * NWAVES;
    constexpr int I_IN = (D / 64) * (NIN / 32), I_SQ = (D / 64) * (D / 32);
    bf16* Wt_in = (bf16*)(P.ws + WS_WIN); bf16* Wt_a = (bf16*)(P.ws + WS_WA); bf16* Wt_b = (bf16*)(P.ws + WS_WB); bf16* Wt_o = (bf16*)(P.ws + WS_WO);
    for (int it = gw; it < I_IN + 3 * I_SQ; it += NGW) {
        int r = it;
        if (r < I_IN) { const int kb = r / (NIN / 32), nb = r % (NIN / 32); transpose_item(P.w_in, D, NIN, 64 * kb, 32 * nb, Wt_in, win_drow(32 * nb), scr, F.lane); continue; } r -= I_IN;
        const int which = r / I_SQ; r -= which * I_SQ; const int kb = r / (D / 32), nb = r % (D / 32);
        const float* W = which == 0 ? P.w_a : (which == 1 ? P.w_b : P.w_o); bf16* WT = which == 0 ? Wt_a : (which == 1 ? Wt_b : Wt_o);
        transpose_item(W, D, D, 64 * kb, 32 * nb, WT, 32 * nb, scr, F.lane);
    }
    bf16* XN = (bf16*)(P.ws + WS_XN); float* stats = (float*)(P.ws + WS_STATS);
    for (int m = gw; m < T; m += NGW) {
        const GAS f32x4* xr = (const GAS f32x4*)(P.x + (size_t)m * D) + F.lane;
        f32x4 v[4]; float s = 0.f;
#pragma unroll
        for (int j = 0; j < 4; ++j) { v[j] = xr[64 * j]; s += (v[j].x + v[j].y) + (v[j].z + v[j].w); }
        const float mean = wave_sum(s) * (1.f / D); float s2 = 0.f;
#pragma unroll
        for (int j = 0; j < 4; ++j) { v[j] = v[j] - mean; s2 += (v[j].x * v[j].x + v[j].y * v[j].y) + (v[j].z * v[j].z + v[j].w * v[j].w); }
        const float rstd = 1.f / sqrtf(wave_sum(s2) * (1.f / D) + LN_EPS);
        GAS unsigned long long* o8 = (GAS unsigned long long*)(XN + (size_t)m * D) + F.lane;
#pragma unroll
        for (int j = 0; j < 4; ++j) { const f32x4 g = *((const GAS f32x4*)P.ln_in_g + F.lane + 64 * j), b = *((const GAS f32x4*)P.ln_in_b + F.lane + 64 * j); const f32x4 y = v[j] * rstd * g + b;
            o8[64 * j] = (unsigned long long)pk2(y.x, y.y) | ((unsigned long long)pk2(y.z, y.w) << 32); }
        if (F.lane == 0) { stats[2 * m] = mean; stats[2 * m + 1] = rstd; }
    }
}
__device__ __forceinline__ void p2_conv(Frame& F, const Ptrs& P) {
    bf16* CB = BUF_CB(P); const bf16* Z = (const bf16*)(P.ws + WS_Z);
    const int gw = F.vcu * NWAVES + F.wave, NGW = F.G * NWAVES, c0 = 16 * F.lane;
    float w0[16], w1[16], w2[16];
#pragma unroll
    for (int i = 0; i < 16; ++i) { w0[i] = P.conv_w[c0 + i]; w1[i] = P.conv_w[D + c0 + i]; w2[i] = P.conv_w[2 * D + c0 + i]; }
    for (int ch = gw; ch < T / 16; ch += NGW) {
        const int r0 = ch * 16; float z2[16], z1[16];
        if ((r0 & (SEQ - 1)) == 0) {
#pragma unroll
            for (int i = 0; i < 16; ++i) { z2[i] = 0.f; z1[i] = 0.f; }
        } else {
            const v4u a0 = *(const GAS v4u*)(Z + (size_t)(r0 - 2) * D + c0), a1 = *(const GAS v4u*)(Z + (size_t)(r0 - 2) * D + c0 + 8), b0 = *(const GAS v4u*)(Z + (size_t)(r0 - 1) * D + c0), b1 = *(const GAS v4u*)(Z + (size_t)(r0 - 1) * D + c0 + 8);
#pragma unroll
            for (int i = 0; i < 4; ++i) { z2[2 * i] = bflo(a0[i]); z2[2 * i + 1] = bfhi(a0[i]); z2[8 + 2 * i] = bflo(a1[i]); z2[8 + 2 * i + 1] = bfhi(a1[i]);
                                          z1[2 * i] = bflo(b0[i]); z1[2 * i + 1] = bfhi(b0[i]); z1[8 + 2 * i] = bflo(b1[i]); z1[8 + 2 * i + 1] = bfhi(b1[i]); }
        }
#pragma unroll 2
        for (int rr = 0; rr < 16; ++rr) { const size_t off = (size_t)(r0 + rr) * D + c0;
            const v4u za = *(const GAS v4u*)(Z + off), zb = *(const GAS v4u*)(Z + off + 8), ca = *(const GAS v4u*)(CB + off), cb = *(const GAS v4u*)(CB + off + 8);
            float zc[16], cv[16];
#pragma unroll
            for (int i = 0; i < 4; ++i) { zc[2 * i] = bflo(za[i]); zc[2 * i + 1] = bfhi(za[i]); zc[8 + 2 * i] = bflo(zb[i]); zc[8 + 2 * i + 1] = bfhi(zb[i]);
                                          cv[2 * i] = bflo(ca[i]); cv[2 * i + 1] = bfhi(ca[i]); cv[8 + 2 * i] = bflo(cb[i]); cv[8 + 2 * i + 1] = bfhi(cb[i]); }
            float u[16];
#pragma unroll
            for (int i = 0; i < 16; ++i) { u[i] = cv[i] * (z2[i] * w0[i] + z1[i] * w1[i] + zc[i] * w2[i]); z2[i] = z1[i]; z1[i] = zc[i]; }
            v4u oa, ob;
#pragma unroll
            for (int i = 0; i < 4; ++i) { oa[i] = pk2(u[2 * i], u[2 * i + 1]); ob[i] = pk2(u[8 + 2 * i], u[8 + 2 * i + 1]); }
            *(GAS v4u*)(CB + off) = oa; *(GAS v4u*)(CB + off + 8) = ob; }
    }
}
__device__ __forceinline__ attn::BlockRef attn_ref(const Ptrs& P, int s, int qb) {
    const int vh = s & 1, m = (s >> 1) & 1, h = (s >> 2) & 3, b = s >> 4;
    attn::BlockRef r; const size_t rowb = (size_t)b * SEQ * D;
    r.Q = (const bf16*)(P.ws + WS_Q) + rowb + (size_t)qb * 256 * D + h * 256 + m * 128;
    r.K = (const bf16*)(P.ws + WS_K) + rowb + h * 256 + m * 128;
    r.V = (const bf16*)(P.ws + WS_V) + rowb + h * 256 + vh * 128;
    r.O = (bf16*)(P.ws + (m ? WS_O1 : WS_XN)) + rowb + (size_t)qb * 256 * D + h * 256 + vh * 128;
    r.P0 = qb * 256; return r;
}
#ifndef P1_ALIGN
#define P1_ALIGN true
#endif
#ifndef P1_SP2
#define P1_SP2 true
#endif
#ifndef ATTN_PAIR
#define ATTN_PAIR 1
#endif
__device__ __forceinline__ attn2::BlockRef attn2_ref(const Ptrs& P, int st, int qb) {
    const int m = st & 1, h = (st >> 1) & 3, b = st >> 3;
    attn2::BlockRef r; const size_t rowb = (size_t)b * SEQ * D;
    r.Q = (const bf16*)(P.ws + WS_Q) + rowb + (size_t)qb * 128 * D + h * 256 + m * 128;
    r.K = (const bf16*)(P.ws + WS_K) + rowb + h * 256 + m * 128;
    r.V = (const bf16*)(P.ws + WS_V) + rowb + h * 256;
    r.O = (bf16*)(P.ws + (m ? WS_O1 : WS_XN)) + rowb + (size_t)qb * 128 * D + h * 256;
    r.P0 = qb * 128; return r;
}
__device__ __forceinline__ void p2_attention2(Frame& F, const Ptrs& P, char* lds) {
    float* btab = (float*)(lds + attn2::BIAS_OFF);
    for (int s2 = F.vcu; s2 < BATCH * 16; s2 += F.G) {
        const int st = s2 >> 1, half = s2 & 1, h = (st >> 1) & 3;
        __syncthreads();
        if (F.tid < attn2::NBIAS) { const int rel = 63 - F.tid; btab[F.tid] = (P.rel_bias[attn2::t5_bucket(rel) * 4 + h] - P.rel_bias[15 * 4 + h]) * (1.0f / attn2::SCALE); }
        __syncthreads();
#define QB_OF(i) (2 * (7 - (i)) + (((7 - (i)) & 1) ^ half))
        int tid_ = threadIdx.x; asm volatile("" : "+v"(tid_));
        attn2::Seam S; attn2::BlockRef cur = attn2_ref(P, st, QB_OF(0));
        attn2::attn_prime(cur, lds, S, tid_);
#pragma unroll 1
        for (int i = 0; i < 8; ++i) {
            const attn2::BlockRef nxt = (i < 7) ? attn2_ref(P, st, QB_OF(i + 1)) : cur;
            attn2::attn_block(cur, nxt, lds, S, tid_);
            cur = nxt;
        }
#undef QB_OF
    }
}
__device__ __forceinline__ void p2_attention(Frame& F, const Ptrs& P, char* lds) {
    float* btab = (float*)(lds + attn::BIAS_OFF);
    for (int s = F.vcu; s < BATCH * 16; s += F.G) {
        const int h = (s >> 2) & 3;
        __syncthreads();
        if (F.tid < attn::NBIAS) { const int rel = 63 - F.tid; btab[F.tid] = (P.rel_bias[attn::t5_bucket(rel) * 4 + h] - P.rel_bias[15 * 4 + h]) * (1.0f / attn::SCALE); }
        __syncthreads();
        attn::Seam S; attn::BlockRef cur = attn_ref(P, s, 0);
        attn::attn_prime(cur, lds, S);
#pragma unroll 1
        for (int qb = 0; qb < 8; ++qb) {
            const attn::BlockRef nxt = (qb < 7) ? attn_ref(P, s, qb + 1) : cur;
            attn::attn_block(cur, nxt, lds, S);
            cur = nxt;
        }
    }
}
__device__ __forceinline__ void p2b_combine(Frame& F, const Ptrs& P) {
    bf16* O0 = (bf16*)(P.ws + WS_XN); const bf16* O1 = (const bf16*)(P.ws + WS_O1);
    const int gw = F.vcu * NWAVES + F.wave, NGW = F.G * NWAVES, c0 = 16 * F.lane;
    const float l0 = wave_sum(P.lq[F.lane] * P.lk[F.lane] + P.lq[64 + F.lane] * P.lk[64 + F.lane]), l1 = wave_sum(P.lq[128 + F.lane] * P.lk[128 + F.lane] + P.lq[192 + F.lane] * P.lk[192 + F.lane]);
    const float lam = expf(l0) - expf(l1) + LAM_INIT;
    float g[16];
#pragma unroll
    for (int i = 0; i < 16; ++i) g[i] = P.subln_g[(c0 & 255) + i] * (1.f - LAM_INIT);
    for (int m = gw; m < T; m += NGW) { const size_t off = (size_t)m * D + c0;
        const v4u a0 = *(const GAS v4u*)(O0 + off), a1 = *(const GAS v4u*)(O0 + off + 8), b0 = *(const GAS v4u*)(O1 + off), b1 = *(const GAS v4u*)(O1 + off + 8);
        float d[16]; float ss = 0.f;
#pragma unroll
        for (int i = 0; i < 4; ++i) { d[2 * i] = bflo(a0[i]) - lam * bflo(b0[i]); d[2 * i + 1] = bfhi(a0[i]) - lam * bfhi(b0[i]); d[8 + 2 * i] = bflo(a1[i]) - lam * bflo(b1[i]); d[8 + 2 * i + 1] = bfhi(a1[i]) - lam * bfhi(b1[i]); }
#pragma unroll
        for (int i = 0; i < 16; ++i) ss += d[i] * d[i];
        ss += __shfl_xor(ss, 1); ss += __shfl_xor(ss, 2); ss += __shfl_xor(ss, 4); ss += __shfl_xor(ss, 8);
        const float rs = 1.f / sqrtf(ss * (1.f / 256.f) + RMS_EPS);
        v4u oa, ob;
#pragma unroll
        for (int i = 0; i < 4; ++i) { oa[i] = pk2(d[2 * i] * rs * g[2 * i], d[2 * i + 1] * rs * g[2 * i + 1]); ob[i] = pk2(d[8 + 2 * i] * rs * g[8 + 2 * i], d[8 + 2 * i + 1] * rs * g[8 + 2 * i + 1]); }
        *(GAS v4u*)(O0 + off) = oa; *(GAS v4u*)(O0 + off + 8) = ob; }
}
__device__ __forceinline__ void pe_experts(Frame& F, const Ptrs& P) {
    LAS float* scr = (LAS float*)(F.lds + RING_OFF + F.wave * 16384);
    const int gw = F.vcu * NWAVES + F.wave, NGW = F.G * NWAVES;
    bf16* Wgu = (bf16*)(P.ws + WS_WGU); bf16* Wd = (bf16*)(P.ws + WS_WD);
    constexpr int I_GU = (D / 64) * (DE / 32), I_DN = (DE / 64) * (D / 32);
    for (int it = gw; it < NE * (2 * I_GU + I_DN); it += NGW) {
        const int e = it / (2 * I_GU + I_DN); int r = it - e * (2 * I_GU + I_DN);
        if (r < 2 * I_GU) { const int up = r >= I_GU; r -= up * I_GU; const int kb = r / (DE / 32), nb = r % (DE / 32), n0 = 32 * nb;
            transpose_item((up ? P.w_up_e : P.w_gate_e) + (size_t)e * D * DE, D, DE, 64 * kb, n0, Wgu + (size_t)e * 1024 * D, 256 * (n0 >> 7) + 128 * up + (n0 & 127), scr, F.lane); }
        else { r -= 2 * I_GU; const int kb = r / (D / 32), nb = r % (D / 32);
            transpose_item(P.w_down_e + (size_t)e * DE * D, DE, D, 64 * kb, 32 * nb, Wd + (size_t)e * D * DE, 32 * nb, scr, F.lane); }
    }
}
__device__ __forceinline__ void p5_ln_route(Frame& F, const Ptrs& P) {
    LAS float* RW = (LAS float*)(F.lds + RING_OFF);
    LAS int* lcnt = (LAS int*)(F.lds + TAB_OFF);
    LAS float* rs = (LAS float*)(F.lds + RSCR_OFF) + F.wave * 128;
    for (int idx = F.tid; idx < D * 36; idx += NWAVES * 64) { const int d = idx / 36, o = idx - d * 36; float w;
        if (o < 4) w = P.w_group[d * 4 + o]; else { const int g = (o - 4) >> 3, e = (o - 4) & 7; w = P.w_sub[((size_t)g * D + d) * 8 + e]; }
        const int j = d >> 8, l = (d & 255) >> 2, i = d & 3, c = o >> 2, k = o & 3;
        RW[((((j * 4 + i) * 9 + c) * 64 + l) << 2) + k] = w; }
    if (F.tid < 32) lcnt[F.tid] = 0;
    __syncthreads();
    float* pre = (float*)(P.ws + WS_PRE); bf16* x1b = (bf16*)(P.ws + WS_XN);
    int* eid = (int*)(P.ws + WS_EID); float* ew = (float*)(P.ws + WS_EW); int* rank = (int*)(P.ws + WS_RANK);
    const int rows_per_wg = T / F.G, rbase = blockIdx.x * rows_per_wg;
    static_assert(pg8::PRE_BF16, "the pipelined LN1/routing loop reads bf16 pre");
    v2u raw[2][4];
#define P5_LOADPAIR(rp_) do { _Pragma("unroll") for (int r = 0; r < 2; ++r) { const GAS v2u* pr = (const GAS v2u*)((const bf16*)pre + (size_t)(rbase + (rp_) + r) * D) + F.lane; \
        _Pragma("unroll") for (int j = 0; j < 4; ++j) raw[r][j] = pr[64 * j]; } } while (0)
    if (F.wave * 2 < rows_per_wg) P5_LOADPAIR(F.wave * 2);
    for (int rp = F.wave * 2; rp < rows_per_wg; rp += NWAVES * 2) {
        f32x4 xv[2][4];
#pragma unroll
        for (int r = 0; r < 2; ++r) { const int row = rbase + rp + r;
            f32x4 v[4]; float s = 0.f;
#pragma unroll
            for (int j = 0; j < 4; ++j) { const v2u w = raw[r][j]; v[j] = (f32x4){bflo(w.x), bfhi(w.x), bflo(w.y), bfhi(w.y)}; s += (v[j].x + v[j].y) + (v[j].z + v[j].w); }
            const float mean = wave_sum_fast(s) * (1.f / D); float s2 = 0.f;
#pragma unroll
            for (int j = 0; j < 4; ++j) { v[j] = v[j] - mean; s2 += (v[j].x * v[j].x + v[j].y * v[j].y) + (v[j].z * v[j].z + v[j].w * v[j].w); }
            const float rstd = 1.f / sqrtf(wave_sum_fast(s2) * (1.f / D) + LN_EPS);
            GAS unsigned long long* o8 = (GAS unsigned long long*)(x1b + (size_t)row * D) + F.lane;
#pragma unroll
            for (int j = 0; j < 4; ++j) { const f32x4 g = *((const GAS f32x4*)P.ln1_g + F.lane + 64 * j), b = *((const GAS f32x4*)P.ln1_b + F.lane + 64 * j); const f32x4 y = v[j] * rstd * g + b;
                xv[r][j] = y; o8[64 * j] = (unsigned long long)pk2(y.x, y.y) | ((unsigned long long)pk2(y.z, y.w) << 32); } }
        if (rp + NWAVES * 2 < rows_per_wg) P5_LOADPAIR(rp + NWAVES * 2);
        f32x4 acc[2][9];
#pragma unroll
        for (int r = 0; r < 2; ++r)
#pragma unroll
            for (int c = 0; c < 9; ++c) acc[r][c] = (f32x4){0.f, 0.f, 0.f, 0.f};
        asm volatile("" ::: "memory"); __builtin_amdgcn_sched_barrier(0);
#pragma unroll
        for (int j = 0; j < 4; ++j)
#pragma unroll
            for (int i = 0; i < 4; ++i)
                { const LAS f32x4* wp = (const LAS f32x4*)(RW + (((j * 4 + i) * 9 * 64 + F.lane) << 2));
#pragma unroll
                  for (int c = 0; c < 9; ++c) { const f32x4 w = wp[c * 64]; acc[0][c] += w * xv[0][j][i]; acc[1][c] += w * xv[1][j][i]; }
                  asm volatile("" : "+v"(acc[0][0]), "+v"(acc[0][1]), "+v"(acc[0][2]), "+v"(acc[0][3]), "+v"(acc[0][4]), "+v"(acc[0][5]), "+v"(acc[0][6]), "+v"(acc[0][7]), "+v"(acc[0][8]) :: "memory");
                  asm volatile("" : "+v"(acc[1][0]), "+v"(acc[1][1]), "+v"(acc[1][2]), "+v"(acc[1][3]), "+v"(acc[1][4]), "+v"(acc[1][5]), "+v"(acc[1][6]), "+v"(acc[1][7]), "+v"(acc[1][8]) :: "memory");
                  __builtin_amdgcn_sched_barrier(0); }
        { float Y[36];
#pragma unroll
          for (int k = 0; k < 36; ++k) { const int i0 = 2 * k, i1 = 2 * k + 1;
              const auto rr = __builtin_amdgcn_permlane32_swap(__float_as_uint(acc[i0 / 36][(i0 % 36) >> 2][i0 & 3]), __float_as_uint(acc[i1 / 36][(i1 % 36) >> 2][i1 & 3]), false, false);
              Y[k] = __uint_as_float(rr[0]) + __uint_as_float(rr[1]); }
          float Z[18];
#pragma unroll
          for (int m = 0; m < 18; ++m) { const auto rr = __builtin_amdgcn_permlane16_swap(__float_as_uint(Y[2 * m]), __float_as_uint(Y[2 * m + 1]), false, false);
              Z[m] = __uint_as_float(rr[0]) + __uint_as_float(rr[1]); }
#pragma unroll
          for (int m = 0; m < 18; ++m) {
              Z[m] += __int_as_float(__builtin_amdgcn_update_dpp(0, __float_as_int(Z[m]), 0x128, 0xf, 0xf, false));
              Z[m] += __int_as_float(__builtin_amdgcn_update_dpp(0, __float_as_int(Z[m]), 0x124, 0xf, 0xf, false));
              Z[m] += __int_as_float(__builtin_amdgcn_update_dpp(0, __float_as_int(Z[m]), 0x122, 0xf, 0xf, false));
              Z[m] += __int_as_float(__builtin_amdgcn_update_dpp(0, __float_as_int(Z[m]), 0x121, 0xf, 0xf, false)); }
          const int rho = F.lane >> 4, pr = ((rho & 1) << 1) | (rho >> 1);
          if ((F.lane & 15) == 0) {
#pragma unroll
              for (int m = 0; m < 18; ++m) { const int idx = 4 * m + pr; rs[idx >= 36 ? idx + 28 : idx] = Z[m]; } } }
        LDS_WAIT(); asm volatile("" ::: "memory");
        if (F.lane < 2) { const int r = F.lane, row = rbase + rp + r; const LAS float* sa = rs + r * 64;
            float gmax = sa[0] + P.b_group[0]; int gi = 0;
            for (int g = 1; g < 4; ++g) { const float v = sa[g] + P.b_group[g]; if (v > gmax) { gmax = v; gi = g; } }
            float z = 0.f;
            for (int g = 0; g < 4; ++g) z += expf(sa[g] + P.b_group[g] - gmax);
            const float gp = 1.f / z;
            const LAS float* sl = sa + 4 + gi * 8; const float* bs = P.b_sub + gi * 8;
            float b0 = sl[0] + bs[0]; int i0 = 0;
            for (int e = 1; e < 8; ++e) { const float v = sl[e] + bs[e]; if (v > b0) { b0 = v; i0 = e; } }
            float b1 = -__builtin_inff(); int i1 = 0;
            for (int e = 0; e < 8; ++e) { const float v = sl[e] + bs[e]; if (e != i0 && v > b1) { b1 = v; i1 = e; } }
            const float e1 = expf(b1 - b0); const float w0 = gp / (1.f + e1), w1 = gp * e1 / (1.f + e1);
            const int ex0 = gi * 8 + i0, ex1 = gi * 8 + i1;
            eid[row * 2] = ex0; eid[row * 2 + 1] = ex1; ew[row * 2] = w0; ew[row * 2 + 1] = w1;
            rank[row * 2] = __hip_atomic_fetch_add(lcnt + ex0, 1, __ATOMIC_RELAXED, __HIP_MEMORY_SCOPE_WORKGROUP);
            rank[row * 2 + 1] = __hip_atomic_fetch_add(lcnt + ex1, 1, __ATOMIC_RELAXED, __HIP_MEMORY_SCOPE_WORKGROUP); }
        LDS_WAIT(); asm volatile("" ::: "memory");
    }
    __syncthreads();
    if (F.tid < 32) ((int*)(P.ws + WS_CNTWG))[blockIdx.x * 32 + F.tid] = lcnt[F.tid];
}
__device__ __forceinline__ void moe_tab(Frame& F, const Ptrs& P) {
    LAS int* tab = (LAS int*)(F.lds + TAB_OFF);
    const int* cntwg = (const int*)(P.ws + WS_CNTWG);
    __syncthreads();
    if (F.tid < 32) { int tot = 0, base = 0;
        for (int w = 0; w < F.G; ++w) { const int c = __hip_atomic_load(cntwg + w * 32 + F.tid, __ATOMIC_RELAXED, __HIP_MEMORY_SCOPE_AGENT); base += (w < (int)blockIdx.x) ? c : 0; tot += c; }
        tab[96 + F.tid] = tot; tab[64 + F.tid] = base; }
    __syncthreads();
    if (F.tid == 0) { int s = 0; for (int e = 0; e < 32; ++e) { tab[e] = s; s += (tab[96 + e] + 255) & ~255; } tab[32] = s; }
    __syncthreads();
}
__device__ __forceinline__ void p5b_place(Frame& F, const Ptrs& P) {
    LAS int* tab = (LAS int*)(F.lds + TAB_OFF);
    moe_tab(F, P);
    const int rows_per_wg = T / F.G, rbase = blockIdx.x * rows_per_wg;
    const int* eid = (const int*)(P.ws + WS_EID); const int* rank = (const int*)(P.ws + WS_RANK); int* slot = (int*)(P.ws + WS_SLOT);
    int* tokl = (int*)(P.ws + WS_TOK);
    for (int a = F.tid; a < rows_per_wg * 2; a += NWAVES * 64) { const int ga = rbase * 2 + a, e = eid[ga]; const int s = tab[e] + tab[64 + e] + rank[ga]; slot[ga] = s; tokl[s] = ga >> 1; }
    if (blockIdx.x < 32) { const int e = blockIdx.x; for (int s = tab[e] + tab[96 + e] + F.tid; s < tab[e + 1]; s += NWAVES * 64) tokl[s] = 0; }
}
struct P8Row { v4u x[2], y0[2], y1[2]; float w0, w1; };
__device__ __forceinline__ void p8_load(P8Row& R, const bf16* x1, const bf16* y, const int* slot, const float* ew, int row, int lane) {
    const int s0 = slot[row * 2], s1 = slot[row * 2 + 1]; R.w0 = ew[row * 2]; R.w1 = ew[row * 2 + 1];
    const GAS v4u* xr = (const GAS v4u*)(x1 + (size_t)row * D) + lane; const GAS v4u* a = (const GAS v4u*)(y + (size_t)s0 * D) + lane; const GAS v4u* b = (const GAS v4u*)(y + (size_t)s1 * D) + lane;
    R.x[0] = xr[0]; R.x[1] = xr[64]; R.y0[0] = a[0]; R.y0[1] = a[64]; R.y1[0] = b[0]; R.y1[1] = b[64];
}
__device__ __forceinline__ void p8_finish(const P8Row& R, const Ptrs& P, int row, int lane, bool poison) {
    float v[16]; float s = 0.f;
#pragma unroll
    for (int h = 0; h < 2; ++h)
#pragma unroll
        for (int i = 0; i < 4; ++i) { v[8 * h + 2 * i] = ALPHA * bflo(R.x[h][i]) + R.w0 * bflo(R.y0[h][i]) + R.w1 * bflo(R.y1[h][i]); v[8 * h + 2 * i + 1] = ALPHA * bfhi(R.x[h][i]) + R.w0 * bfhi(R.y0[h][i]) + R.w1 * bfhi(R.y1[h][i]); }
#pragma unroll
    for (int i = 0; i < 16; ++i) s += v[i];
    const float mean = wave_sum_fast(s) * (1.f / D); float s2 = 0.f;
#pragma unroll
    for (int i = 0; i < 16; ++i) { v[i] -= mean; s2 += v[i] * v[i]; }
    const float rstd = 1.f / sqrtf(wave_sum_fast(s2) * (1.f / D) + LN_EPS);
    const float qn = __builtin_nanf("");
#pragma unroll
    for (int h = 0; h < 2; ++h)
#pragma unroll
        for (int q = 0; q < 2; ++q) { const int c = 512 * h + 8 * lane + 4 * q; const f32x4 g = *(const GAS f32x4*)(P.ln2_g + c), b = *(const GAS f32x4*)(P.ln2_b + c);
            f32x4 o = {v[8 * h + 4 * q] * rstd * g.x + b.x, v[8 * h + 4 * q + 1] * rstd * g.y + b.y, v[8 * h + 4 * q + 2] * rstd * g.z + b.z, v[8 * h + 4 * q + 3] * rstd * g.w + b.w};
            if (poison) o = (f32x4){qn, qn, qn, qn};
            *(GAS f32x4*)(P.out + (size_t)row * D + c) = o; }
}
__device__ __forceinline__ void p8_final(Frame& F, const Ptrs& P, bool poison) {
    const bf16* x1 = (const bf16*)(P.ws + WS_XN); const bf16* y = (const bf16*)(P.ws + WS_XG);
    const int* slot = (const int*)(P.ws + WS_SLOT); const float* ew = (const float*)(P.ws + WS_EW);
    const int rows_per_wg = T / F.G, rbase = blockIdx.x * rows_per_wg;
    P8Row A, B;
    int rr = F.wave; if (rr < rows_per_wg) p8_load(A, x1, y, slot, ew, rbase + rr, F.lane);
    for (; rr < rows_per_wg; rr += 2 * NWAVES) {
        const bool hasB = rr + NWAVES < rows_per_wg; if (hasB) p8_load(B, x1, y, slot, ew, rbase + rr + NWAVES, F.lane);
        p8_finish(A, P, rbase + rr, F.lane, poison);
        if (hasB) { if (rr + 2 * NWAVES < rows_per_wg) p8_load(A, x1, y, slot, ew, rbase + rr + 2 * NWAVES, F.lane); p8_finish(B, P, rbase + rr + NWAVES, F.lane, poison); }
    }
}

constexpr int N_PHASES = 11;
struct Args { Ptrs p; int ph_lo, ph_hi, bar_region, flags; };
__global__ void __launch_bounds__(NWAVES * 64, 2) mega_fwd(Args args) {
    extern __shared__ __attribute__((aligned(16))) unsigned char lds[];
    Frame F; const Ptrs& P = args.p;
    F.lds = (LAS unsigned char*)lds; F.MISC = (volatile LAS unsigned*)(F.lds + MISC_OFF);
    F.tid = threadIdx.x; F.lane = F.tid & 63; F.wave = __builtin_amdgcn_readfirstlane(F.tid >> 6);
    F.G = gridDim.x; { const int bx = blockIdx.x; F.vcu = (F.G % 8 == 0) ? (bx % 8) * (F.G / 8) + bx / 8 : bx; }
    F.ctl = (gu32*)(P.ws + WS_CTL);
    for (int u = F.tid; u < (LDS_BYTES - LDSCTL_OFF) / 4; u += NWAVES * 64) ((LAS unsigned*)(F.lds + LDSCTL_OFF))[u] = 0u;
    __syncthreads();
    XcdBarrier bar = xcd_barrier_post((unsigned*)(F.ctl + CW_BAR) + args.bar_region * XCD_BAR_WORDS, F.MISC + 8);
    const int lo = args.ph_lo, hi = args.ph_hi;
#ifndef PH_MASK
#define PH_MASK 0x7ff
#endif
#define IN(k) (((PH_MASK >> (k)) & 1) && lo <= (k) && (k) < hi)
#define BOTH(k) (IN(k) && IN((k) + 1))
#define GRID_BAR() xcd_barrier(bar)
    const bool grid_ok = (F.G == 256);

    if (IN(0)) { p0_prologue(F, P); if (BOTH(0)) GRID_BAR(); }
    if (IN(1)) {
        pg8::Gemm g{(const pg8::bf16_t*)(P.ws + WS_XN), (const pg8::bf16_t*)(P.ws + WS_WIN), T, NIN, D}; pg8::StaticOrder S; S.init(T, NIN, F.G, (int)blockIdx.x);
        pg8::EpiInProj E{(pg8::bf16_t*)(P.ws + WS_Q), (size_t)(WS_K - WS_Q) / 2, BUF_CB(P), (pg8::bf16_t*)(P.ws + WS_Z), BUF_SGA(P), BUF_SGB(P)};
        pg8::gemm_phase<pg8::EpiInProj, pg8::StaticOrder, P1_ALIGN, P1_SP2>(F.lds + RING_OFF, g, S, E);
        if (BOTH(1)) GRID_BAR();
    }
    if (IN(2)) { if (!(args.flags & 2)) p2_conv(F, P); if (ATTN_PAIR) p2_attention2(F, P, (char*)lds + RING_OFF); else p2_attention(F, P, (char*)lds + RING_OFF); if (BOTH(2)) GRID_BAR(); }
    if (IN(3)) { if (!(args.flags & 1)) p2b_combine(F, P); pe_experts(F, P); if (BOTH(3)) GRID_BAR(); }
    if (IN(4)) {
        { pg8::Gemm g{(const pg8::bf16_t*)(P.ws + WS_XN), (const pg8::bf16_t*)(P.ws + WS_WA), T, D, D}; pg8::StaticOrder S; S.init(T, D, F.G, (int)blockIdx.x);
          pg8::EpiGate<false> E{BUF_SGA(P), nullptr, (pg8::bf16_t*)(P.ws + WS_O1), P.b_gate};
          pg8::gemm_phase<pg8::EpiGate<false>, pg8::StaticOrder, true, true>(F.lds + RING_OFF, g, S, E); }
        __syncthreads();
        { pg8::Gemm g{BUF_CB(P), (const pg8::bf16_t*)(P.ws + WS_WB), T, D, D}; pg8::StaticOrder S; S.init(T, D, F.G, (int)blockIdx.x);
          pg8::EpiGate<true> E{BUF_SGB(P), (const pg8::bf16_t*)(P.ws + WS_O1), (pg8::bf16_t*)(P.ws + WS_Z), P.b_gate + 1024};
          pg8::gemm_phase<pg8::EpiGate<true>, pg8::StaticOrder, true, true>(F.lds + RING_OFF, g, S, E); }
        if (BOTH(4)) GRID_BAR();
    }
    if (IN(5)) {
        pg8::Gemm g{(const pg8::bf16_t*)(P.ws + WS_Z), (const pg8::bf16_t*)(P.ws + WS_WO), T, D, D}; pg8::StaticOrder S; S.init(T, D, F.G, (int)blockIdx.x);
        pg8::EpiPre E{P.x, (const float*)(P.ws + WS_STATS), P.ln_in_g, P.ln_in_b, (float*)(P.ws + WS_PRE), ALPHA};
        pg8::gemm_phase<pg8::EpiPre, pg8::StaticOrder, true, true>(F.lds + RING_OFF, g, S, E);
        if (BOTH(5)) GRID_BAR();
    }
    if (IN(6)) { if (grid_ok) p5_ln_route(F, P); if (BOTH(6)) GRID_BAR(); }
    if (IN(7)) { if (grid_ok) p5b_place(F, P); if (BOTH(7)) GRID_BAR(); }
    if (IN(8)) {
        if (grid_ok) { if (lo == 8) moe_tab(F, P); pg8::Gemm g{(const pg8::bf16_t*)(P.ws + WS_XN), (const pg8::bf16_t*)(P.ws + WS_WGU), MAXS, NE * 1024, D};
          pg8::MoeOrder S{(const PG8_LAS int*)(F.lds + TAB_OFF), F.G, F.vcu, (unsigned*)(F.ctl + CW_MOE), 0u, MOE_HANDOFF != 0, (unsigned*)(F.ctl + CW_TMO), 0, -1}; pg8::EpiMoeUp E{(pg8::bf16_t*)P.out};
          pg8::gemm_phase<pg8::EpiMoeUp, pg8::MoeOrder, true, true, true>(F.lds + RING_OFF, g, S, E, (const int*)(P.ws + WS_TOK)); S.flush(); }
        if (BOTH(8)) { if (MOE_HANDOFF) __syncthreads(); else GRID_BAR(); }
    }
    if (IN(9)) {
        if (grid_ok) { if (lo == 9) moe_tab(F, P); pg8::Gemm g{(const pg8::bf16_t*)P.out, (const pg8::bf16_t*)(P.ws + WS_WD), MAXS, NE * 1024, DE};
          const bool ho = MOE_HANDOFF && lo <= 8;
          pg8::MoeOrder S{(const PG8_LAS int*)(F.lds + TAB_OFF), F.G, ho ? (F.vcu + F.G / 2) % F.G : F.vcu, (unsigned*)(F.ctl + CW_MOE), ho ? 32u : 0u, false, (unsigned*)(F.ctl + CW_TMO), 0, -1}; pg8::EpiMoeDown E{(pg8::bf16_t*)(P.ws + WS_XG)};
          pg8::gemm_phase<pg8::EpiMoeDown, pg8::MoeOrder, true, true>(F.lds + RING_OFF, g, S, E); }
        if (BOTH(9)) GRID_BAR();
    }
    if (IN(10)) {
        bool poison = !grid_ok || (__hip_atomic_load(F.ctl + CW_BAR + args.bar_region * XCD_BAR_WORDS + XB_TMO, RLX_AGENT) != 0u) || (__hip_atomic_load(F.ctl + CW_TMO, RLX_AGENT) != 0u);
        if (grid_ok) p8_final(F, P, poison);
        else { const float qn = __builtin_nanf(""); for (size_t i = (size_t)blockIdx.x * 512 + F.tid; i < (size_t)T * D; i += (size_t)F.G * 512) P.out[i] = qn; }
    }
#undef IN
#undef BOTH
#undef GRID_BAR
}

#if HYBRID
namespace nv {
constexpr int D = 1024, BATCH = 16, SEQ = 2048, T = BATCH * SEQ, NIN = 8192, NH = 4, HD = 128, NE = 32, DE = 512;
constexpr float LN_EPS = 1e-5f, RMS_EPS = 1e-6f;
constexpr float ALPHA = 1.189207115002721f;
constexpr float LAM_INIT = 0.2f;
constexpr int MOE_PAD = 64;
constexpr int MAX_SLOTS = 2 * T + NE * MOE_PAD;
constexpr int MAX_TILES = MAX_SLOTS / MOE_PAD;

__device__ __forceinline__ float wave_sum(float v) {
#pragma unroll
    for (int o = 1; o < 64; o <<= 1) v += __shfl_xor(v, o);
    return v;
}
__device__ __forceinline__ float wave_max(float v) {
#pragma unroll
    for (int o = 1; o < 64; o <<= 1) v = fmaxf(v, __shfl_xor(v, o));
    return v;
}
__device__ __forceinline__ float block_sum(float v, float* scr) {
    v = wave_sum(v); __syncthreads();
    if ((threadIdx.x & 63) == 0) scr[threadIdx.x >> 6] = v; __syncthreads();
    float r = 0.f; for (int i = 0; i < (int)(blockDim.x >> 6); ++i) r += scr[i]; __syncthreads(); return r;
}
__device__ __forceinline__ float block_max(float v, float* scr) {
    v = wave_max(v); __syncthreads();
    if ((threadIdx.x & 63) == 0) scr[threadIdx.x >> 6] = v; __syncthreads();
    float r = -INFINITY; for (int i = 0; i < (int)(blockDim.x >> 6); ++i) r = fmaxf(r, scr[i]); __syncthreads(); return r;
}

__global__ void k_ln_rows(const float* x, float a, const float* add, const float* g, const float* b, float* y) {
    __shared__ float scr[8];
    const size_t row = blockIdx.x; const float* xr = x + row * D; const float* ar = add ? add + row * D : nullptr;
    float v[4]; float s = 0.f;
    for (int j = 0; j < 4; ++j) { const int c = threadIdx.x + 256 * j; v[j] = a * xr[c] + (ar ? ar[c] : 0.f); s += v[j]; }
    const float mean = block_sum(s, scr) * (1.f / D); float q = 0.f;
    for (int j = 0; j < 4; ++j) { v[j] -= mean; q += v[j] * v[j]; }
    const float rstd = 1.f / sqrtf(block_sum(q, scr) * (1.f / D) + LN_EPS);
    for (int j = 0; j < 4; ++j) { const int c = threadIdx.x + 256 * j; y[row * D + c] = v[j] * rstd * g[c] + b[c]; }
}

struct TileAcc { float c[4][4]; };
__device__ __forceinline__ void gemm_tile(const float* __restrict__ A, int lda, const int* rowidx, int row0, const float* __restrict__ B, int ldb, int col0, int K, TileAcc& acc, float (*As)[65], float (*Bs)[65]) {
    const int tid = threadIdx.x, tx = tid & 15, ty = tid >> 4;
    for (int i = 0; i < 4; ++i) for (int j = 0; j < 4; ++j) acc.c[i][j] = 0.f;
    for (int k0 = 0; k0 < K; k0 += 16) {
        for (int e = tid; e < 64 * 16; e += 256) { const int r = e >> 4, k = e & 15; int gr = row0 + r; float v = 0.f;
            if (rowidx) { const int t = rowidx[gr]; if (t >= 0) v = A[(size_t)t * lda + k0 + k]; } else v = A[(size_t)gr * lda + k0 + k];
            As[k][r] = v; }
        for (int e = tid; e < 16 * 64; e += 256) { const int k = e >> 6, c = e & 63; Bs[k][c] = B[(size_t)(k0 + k) * ldb + col0 + c]; }
        __syncthreads();
#pragma unroll
        for (int k = 0; k < 16; ++k) { float a[4], b[4];
            for (int i = 0; i < 4; ++i) a[i] = As[k][ty * 4 + i];
            for (int j = 0; j < 4; ++j) b[j] = Bs[k][tx * 4 + j];
            for (int i = 0; i < 4; ++i) for (int j = 0; j < 4; ++j) acc.c[i][j] += a[i] * b[j]; }
        __syncthreads();
    }
}
__global__ void k_gemm(const float* A, int lda, const float* B, int ldb, float* C, int ldc, int K) {
    __shared__ float As[16][65], Bs[16][65];
    TileAcc acc; const int row0 = blockIdx.y * 64, col0 = blockIdx.x * 64;
    gemm_tile(A, lda, nullptr, row0, B, ldb, col0, K, acc, As, Bs);
    const int tx = threadIdx.x & 15, ty = threadIdx.x >> 4;
    for (int i = 0; i < 4; ++i) for (int j = 0; j < 4; ++j) C[(size_t)(row0 + ty * 4 + i) * ldc + col0 + tx * 4 + j] = acc.c[i][j];
}

__device__ __forceinline__ int t5_bucket(int rel) {
    int b = rel > 0 ? 16 : 0; const int n = rel < 0 ? -rel : rel; int v;
    if (n < 8) v = n; else if (n < 12) v = 8; else if (n < 16) v = 9; else if (n < 23) v = 10; else if (n < 32) v = 11; else if (n < 46) v = 12; else if (n < 65) v = 13; else if (n < 91) v = 14; else v = 15;
    return b + v;
}
__global__ void k_attn(const float* P, const float* rel_bias, const float* lq, const float* lk, const float* subln_g, float* ao) {
    __shared__ float q1[128], q2[128], lg[2][SEQ], scr[8];
    const int q = blockIdx.x, h = blockIdx.y, tid = threadIdx.x;
    float l0 = 0.f, l1 = 0.f; for (int i = 0; i < 128; ++i) { l0 += lq[i] * lk[i]; l1 += lq[128 + i] * lk[128 + i]; }
    const float lam = expf(l0) - expf(l1) + LAM_INIT;
    if (tid < 128) q1[tid] = P[(size_t)q * NIN + h * 256 + tid]; else q2[tid - 128] = P[(size_t)q * NIN + h * 256 + tid];
    __syncthreads();
    const int nk = (q / 64 + 1) * 64; const float scale = 0.08838834764831845f;
    float m1 = -INFINITY, m2 = -INFINITY;
    for (int k = tid; k < nk; k += 256) { const float* kr = P + (size_t)k * NIN + 1024 + h * 256; float s1 = 0.f, s2 = 0.f;
        for (int d = 0; d < 128; ++d) { s1 += q1[d] * kr[d]; s2 += q2[d] * kr[128 + d]; }
        const float bias = rel_bias[t5_bucket(k - q) * NH + h];
        s1 = s1 * scale + bias; s2 = s2 * scale + bias; lg[0][k] = s1; lg[1][k] = s2; m1 = fmaxf(m1, s1); m2 = fmaxf(m2, s2); }
    m1 = block_max(m1, scr); m2 = block_max(m2, scr);
    float z1 = 0.f, z2 = 0.f;
    for (int k = tid; k < nk; k += 256) { const float e1 = expf(lg[0][k] - m1), e2 = expf(lg[1][k] - m2); lg[0][k] = e1; lg[1][k] = e2; z1 += e1; z2 += e2; }
    z1 = block_sum(z1, scr); z2 = block_sum(z2, scr);
    for (int k = tid; k < nk; k += 256) lg[0][k] = lg[0][k] / z1 - lam * (lg[1][k] / z2);
    __syncthreads();
    float o = 0.f; const float* vb = P + 2048 + h * 256 + tid;
    for (int k = 0; k < nk; ++k) o += lg[0][k] * vb[(size_t)k * NIN];
    const float ms = block_sum(o * o, scr) * (1.f / 256.f);
    ao[(size_t)q * D + h * 256 + tid] = o * (1.f / sqrtf(ms + RMS_EPS)) * subln_g[tid] * (1.f - LAM_INIT);
}
__global__ void k_conv(const float* P, const float* cw, float* u) {
    const int t = blockIdx.x;
    for (int c = threadIdx.x; c < D; c += 256) { float z = 0.f;
        for (int w = 0; w < 3; ++w) { const int tt = t + w - 2; if (tt >= 0) z += P[(size_t)tt * NIN + 4096 + c] * P[(size_t)tt * NIN + 5120 + c] * cw[w * D + c]; }
        u[(size_t)t * D + c] = P[(size_t)t * NIN + 3072 + c] * z; }
}
__global__ void k_merge(const float* P, const float* bg, const float* yA, const float* yB, float* m) {
    const int t = blockIdx.x;
    for (int c = threadIdx.x; c < D; c += 256) { const float ga = 1.f / (1.f + expf(-(P[(size_t)t * NIN + 6144 + c] + bg[c]))), gb = 1.f / (1.f + expf(-(P[(size_t)t * NIN + 7168 + c] + bg[D + c])));
        m[(size_t)t * D + c] = ga * yA[(size_t)t * D + c] + gb * yB[(size_t)t * D + c]; }
}
__global__ void k_route(const float* x1, const float* wg, const float* bg, const float* wsub, const float* bsub, int* eid, float* ew, int* rank, int* cnt) {
    const int t = blockIdx.x * 4 + (threadIdx.x >> 6), lane = threadIdx.x & 63;
    float acc[36];
#pragma unroll
    for (int i = 0; i < 36; ++i) acc[i] = 0.f;
    for (int j = 0; j < 16; ++j) { const int d = lane + 64 * j; const float xv = x1[(size_t)t * D + d];
#pragma unroll
        for (int g = 0; g < 4; ++g) acc[g] += xv * wg[d * 4 + g];
#pragma unroll
        for (int g = 0; g < 4; ++g) {
#pragma unroll
            for (int e = 0; e < 8; ++e) acc[4 + g * 8 + e] += xv * wsub[((size_t)g * D + d) * 8 + e]; } }
#pragma unroll
    for (int i = 0; i < 36; ++i) acc[i] = wave_sum(acc[i]);
    __shared__ float sacc[4][36];
    const int wv = threadIdx.x >> 6;
#pragma unroll
    for (int i = 0; i < 36; ++i) if (lane == 0) sacc[wv][i] = acc[i];
    __syncthreads();
    if (lane == 0) {
        const float* sa = sacc[wv];
        float gmax = sa[0] + bg[0]; int gi = 0;
        for (int g = 1; g < 4; ++g) { const float v = sa[g] + bg[g]; if (v > gmax) { gmax = v; gi = g; } }
        float z = 0.f;
        for (int g = 0; g < 4; ++g) z += expf(sa[g] + bg[g] - gmax);
        const float gp = 1.f / z;
        const float* sl = sa + 4 + gi * 8; const float* bs = bsub + gi * 8;
        float b0 = sl[0] + bs[0]; int i0 = 0;
        for (int e = 1; e < 8; ++e) { const float v = sl[e] + bs[e]; if (v > b0) { b0 = v; i0 = e; } }
        float b1 = -INFINITY; int i1 = 0;
        for (int e = 0; e < 8; ++e) { const float v = sl[e] + bs[e]; if (e != i0 && v > b1) { b1 = v; i1 = e; } }
        const float e1 = expf(b1 - b0); const float w0 = gp / (1.f + e1), w1 = gp * e1 / (1.f + e1);
        const int ex0 = gi * 8 + i0, ex1 = gi * 8 + i1;
        eid[t * 2] = ex0; eid[t * 2 + 1] = ex1; ew[t * 2] = w0; ew[t * 2 + 1] = w1;
        rank[t * 2] = atomicAdd(&cnt[ex0], 1); rank[t * 2 + 1] = atomicAdd(&cnt[ex1], 1);
    }
}
__global__ void k_offsets(const int* cnt, int* pad_start, int* tile_expert) {
    if (threadIdx.x == 0) { int s = 0; for (int e = 0; e < NE; ++e) { pad_start[e] = s; const int p = (cnt[e] + MOE_PAD - 1) / MOE_PAD * MOE_PAD; for (int i = 0; i < p / MOE_PAD; ++i) tile_expert[s / MOE_PAD + i] = e; s += p; }
        pad_start[NE] = s; for (int i = s / MOE_PAD; i < MAX_TILES; ++i) tile_expert[i] = -1; }
}
__global__ void k_place(const int* eid, const float* ew, const int* rank, const int* pad_start, int* tok, float* wslot) {
    const int a = blockIdx.x * 256 + threadIdx.x; if (a >= 2 * T) return;
    const int s = pad_start[eid[a]] + rank[a]; tok[s] = a >> 1; wslot[s] = ew[a];
}
__global__ void k_moe_up(const float* x1, const int* tok, const int* tile_expert, const float* Wg, const float* Wu, float* h) {
    __shared__ float As[16][65], Bs[16][65];
    const int e = tile_expert[blockIdx.y]; if (e < 0) return;
    TileAcc g, u; const int row0 = blockIdx.y * 64, col0 = blockIdx.x * 64;
    gemm_tile(x1, D, tok, row0, Wg + (size_t)e * D * DE, DE, col0, D, g, As, Bs);
    gemm_tile(x1, D, tok, row0, Wu + (size_t)e * D * DE, DE, col0, D, u, As, Bs);
    const int tx = threadIdx.x & 15, ty = threadIdx.x >> 4;
    for (int i = 0; i < 4; ++i) for (int j = 0; j < 4; ++j) { const float gv = g.c[i][j]; h[(size_t)(row0 + ty * 4 + i) * DE + col0 + tx * 4 + j] = gv / (1.f + expf(-gv)) * u.c[i][j]; }
}
__global__ void k_moe_down(const float* h, const int* tok, const float* wslot, const int* tile_expert, const float* Wd, float* ffn) {
    __shared__ float As[16][65], Bs[16][65];
    const int e = tile_expert[blockIdx.y]; if (e < 0) return;
    TileAcc acc; const int row0 = blockIdx.y * 64, col0 = blockIdx.x * 64;
    gemm_tile(h, DE, nullptr, row0, Wd + (size_t)e * DE * D, D, col0, DE, acc, As, Bs);
    const int tx = threadIdx.x & 15, ty = threadIdx.x >> 4;
    for (int i = 0; i < 4; ++i) { const int r = row0 + ty * 4 + i; const int t = tok[r]; if (t < 0) continue; const float w = wslot[r];
        for (int j = 0; j < 4; ++j) atomicAdd(&ffn[(size_t)t * D + col0 + tx * 4 + j], w * acc.c[i][j]); }
}
}
#endif
#if HYBRID
__global__ void k_axpy(const float* xn, const float* mix, float* pre, float a, size_t n) { const size_t i = (size_t)blockIdx.x * 256 + threadIdx.x; if (i < n) pre[i] = a * xn[i] + mix[i]; }
__global__ void k_f2b(const float* src, int lds_, unsigned short* dst, int ldd, int cols, size_t rows) {
    const size_t i = (size_t)blockIdx.x * 256 + threadIdx.x; if (i >= rows * cols) return; const size_t r = i / cols; const int c = (int)(i % cols);
    dst[r * ldd + c] = (unsigned short)f2bf(src[r * lds_ + c]); }
__global__ void k_f2b_mul(const float* a, const float* b, int lds_, unsigned short* dst, int ldd, int cols, size_t rows) {
    const size_t i = (size_t)blockIdx.x * 256 + threadIdx.x; if (i >= rows * cols) return; const size_t r = i / cols; const int c = (int)(i % cols);
    dst[r * ldd + c] = (unsigned short)f2bf(a[r * lds_ + c] * b[r * lds_ + c]); }
__global__ void k_f2b_sig(const float* a, const float* bias, int lds_, unsigned short* dst, int ldd, int cols, size_t rows) {
    const size_t i = (size_t)blockIdx.x * 256 + threadIdx.x; if (i >= rows * cols) return; const size_t r = i / cols; const int c = (int)(i % cols);
    dst[r * ldd + c] = (unsigned short)f2bf(1.f / (1.f + expf(-(a[r * lds_ + c] + bias[c])))); }
#endif
static void launch_mega(const Ptrs& p, int lo, int hi, int region, int flags, hipStream_t stream) {
    Args a{}; a.p = p; a.ph_lo = lo; a.ph_hi = hi; a.bar_region = region; a.flags = flags;
    hipLaunchKernelGGL(mega_fwd, dim3(256), dim3(NWAVES * 64), LDS_BYTES, stream, a);
}
extern "C" void kernel_launch(void* const* d_in, const int* in_sizes, int n_in, void* d_out, int out_size, void* d_ws, size_t ws_size, hipStream_t stream) {
    static int ready = 0;
    if (ready == 0) {
        ready = 1;
        if (n_in != 24 || out_size != T * D || ws_size < WS_END) { fprintf(stderr, "kernel_launch: unexpected shapes (n_in %d out %d ws %zu)\n", n_in, out_size, ws_size); ready = -1; }
        else if (hipFuncSetAttribute((const void*)mega_fwd, hipFuncAttributeMaxDynamicSharedMemorySize, LDS_BYTES) != hipSuccess) { fprintf(stderr, "kernel_launch: hipFuncSetAttribute failed\n"); ready = -1; }
        (void)hipGetLastError();
    }
    if (ready < 0) return;
    Ptrs p{};
    const float** pp = (const float**)&p;
    for (int i = 0; i < 24; ++i) pp[i] = (const float*)d_in[i];
    p.out = (float*)d_out; p.ws = (unsigned char*)d_ws;
    (void)hipMemsetAsync((char*)d_ws + WS_CTL, 0, CTL_ZERO_BYTES, stream);
#if HYBRID == 0
#if defined(TIME_PHASE)
    launch_mega(p, 0, TIME_PHASE + 1, 0, 0, stream); launch_mega(p, TIME_PHASE, TIME_PHASE + 1, 1, 3, stream); if (TIME_PHASE + 1 < N_PHASES) launch_mega(p, TIME_PHASE + 1, N_PHASES, 2, 0, stream);
#elif defined(SPLIT_AT)
    launch_mega(p, 0, SPLIT_AT, 0, 0, stream); launch_mega(p, SPLIT_AT, N_PHASES, 1, 0, stream);
#else
    launch_mega(p, 0, N_PHASES, 0, 0, stream);
#endif
#else
    char* ws = (char*)d_ws; float* out = (float*)d_out;
    constexpr size_t NB = (HYBRID == 1 ? 330 : (HYBRID == 2 ? 90 : 410)) * MiB;
    float* Pb = (float*)(ws + NB); float* xnb = (float*)(ws + NB + 64 * MiB); float* ao = (float*)(ws + NB + 72 * MiB); float* ub = (float*)(ws + NB + 80 * MiB); float* yA = (float*)(ws + NB + 88 * MiB); float* yB = (float*)(ws + NB + 96 * MiB); float* mb = (float*)(ws + NB + 104 * MiB);
    float* pre = (float*)(ws + WS_PRE);
#ifndef TAKE_MASK
#define TAKE_MASK 0
#endif
#if HYBRID >= 2
    launch_mega(p, 0, TAKE_MASK ? 2 : 1, 0, 0, stream);
#endif
    for (int b = 0; b < BATCH; ++b) {
        const size_t r0 = (size_t)b * SEQ;
        nv::k_ln_rows<<<SEQ, 256, 0, stream>>>(p.x + r0 * D, 1.f, nullptr, p.ln_in_g, p.ln_in_b, xnb);
        nv::k_gemm<<<dim3(NIN / 64, SEQ / 64), 256, 0, stream>>>(xnb, D, p.w_in, NIN, Pb, NIN, D);
#if HYBRID == 3
        { const int nb = (int)(((size_t)SEQ * 1024 + 255) / 256);
          if (!(TAKE_MASK & 1)) k_f2b<<<nb, 256, 0, stream>>>(Pb, NIN, (unsigned short*)(ws + WS_Q) + r0 * D, D, 1024, SEQ);
          if (!(TAKE_MASK & 2)) k_f2b<<<nb, 256, 0, stream>>>(Pb + 1024, NIN, (unsigned short*)(ws + WS_K) + r0 * D, D, 1024, SEQ);
          if (!(TAKE_MASK & 4)) k_f2b<<<nb, 256, 0, stream>>>(Pb + 2048, NIN, (unsigned short*)(ws + WS_V) + r0 * D, D, 1024, SEQ);
          if (!(TAKE_MASK & 8)) k_f2b<<<nb, 256, 0, stream>>>(Pb + 3072, NIN, BUF_CB(p) + r0 * D, D, 1024, SEQ);
          if (!(TAKE_MASK & 16)) k_f2b_mul<<<nb, 256, 0, stream>>>(Pb + 4096, Pb + 5120, NIN, (unsigned short*)(ws + WS_Z) + r0 * D, D, 1024, SEQ);
          if (!(TAKE_MASK & 32)) k_f2b<<<nb, 256, 0, stream>>>(Pb + 6144, NIN, BUF_SGA(p) + r0 * D, D, 1024, SEQ);
          if (!(TAKE_MASK & 64)) k_f2b<<<nb, 256, 0, stream>>>(Pb + 7168, NIN, BUF_SGB(p) + r0 * D, D, 1024, SEQ); }
#else
        nv::k_attn<<<dim3(SEQ, nv::NH), 256, 0, stream>>>(Pb, p.rel_bias, p.lq, p.lk, p.subln_g, ao);
        nv::k_conv<<<SEQ, 256, 0, stream>>>(Pb, p.conv_w, ub);
#if HYBRID == 2
        { const int nb = (int)(((size_t)SEQ * 1024 + 255) / 256);
          k_f2b<<<nb, 256, 0, stream>>>(ao, D, (unsigned short*)(ws + WS_XN) + r0 * D, D, 1024, SEQ);
          k_f2b<<<nb, 256, 0, stream>>>(ub, D, BUF_CB(p) + r0 * D, D, 1024, SEQ);
          k_f2b<<<nb, 256, 0, stream>>>(Pb + 6144, NIN, BUF_SGA(p) + r0 * D, D, 1024, SEQ);
          k_f2b<<<nb, 256, 0, stream>>>(Pb + 7168, NIN, BUF_SGB(p) + r0 * D, D, 1024, SEQ); }
#else
        nv::k_gemm<<<dim3(D / 64, SEQ / 64), 256, 0, stream>>>(ao, D, p.w_a, D, yA, D, D);
        nv::k_gemm<<<dim3(D / 64, SEQ / 64), 256, 0, stream>>>(ub, D, p.w_b, D, yB, D, D);
        nv::k_merge<<<SEQ, 256, 0, stream>>>(Pb, p.b_gate, yA, yB, mb);
        nv::k_gemm<<<dim3(D / 64, SEQ / 64), 256, 0, stream>>>(mb, D, p.w_o, D, pre + r0 * D, D, D);
        k_axpy<<<(int)(((size_t)SEQ * D + 255) / 256), 256, 0, stream>>>(xnb, pre + r0 * D, pre + r0 * D, ALPHA, (size_t)SEQ * D);
#endif
#endif
    }
#if HYBRID == 1
    launch_mega(p, 3, 4, 1, 1, stream);
    launch_mega(p, 6, N_PHASES, 2, 0, stream);
#elif HYBRID == 2
    launch_mega(p, 3, 4, 1, 1, stream);
    launch_mega(p, 4, N_PHASES, 2, 0, stream);
#elif HYBRID == 3
    launch_mega(p, 2, N_PHASES, 1, 0, stream);
#endif
#endif
}
```

```cpp
#include <hip/hip_runtime.h>
#include <cstdio>
#include <cstdint>
#include <cmath>
namespace pg8 {
#define PG8_LAS __attribute__((address_space(3)))
typedef unsigned short bf16_t;
typedef short bf16x8 __attribute__((ext_vector_type(8)));
typedef float f32x4 __attribute__((ext_vector_type(4)));
typedef unsigned u32x4 __attribute__((ext_vector_type(4)));
constexpr int BM = 256, BK = 64, HALF = 128, HTB = HALF * BK * 2  , STAGE_BYTES = 8 * HTB, NXCD = 8, WGM = 8;

__host__ __device__ __forceinline__ int lds_byte(int r, int c) { const int st = (r >> 4) * 2 + (c >> 5), rr = r & 15, cc = c & 31, ob = rr * 64 + cc * 2; return st * 1024 + (ob ^ (((ob >> 9) & 1) << 5)); }
__host__ __device__ __forceinline__ void stage_rc(int b, int& R, int& C) { const int st = b / 1024, sb = b % 1024, swz = sb ^ (((sb >> 9) & 1) << 5); R = (st >> 1) * 16 + swz / 64; C = (st & 1) * 32 + (swz % 64) / 2; }
__host__ __device__ __forceinline__ int perm32(int rho) { const int n = rho >> 4, i = rho & 15; return 8 * (i >> 2) + 4 * n + (i & 3); }

struct Unit { int pm, pn; };
struct Gemm { const bf16_t* A; const bf16_t* Bt; int M, N, K; };

struct StaticOrder {
    int nM, nN, nwg, G, c;
    __host__ __device__ void init(int M, int N, int G_, int c_) { nM = M / BM; nN = N / BM; nwg = nM * nN; G = G_; c = c_; }
    __host__ __device__ bool next(int i, Unit& u) const {
        const long L = (long)i * G + c; if (L >= nwg) return false;
        int wgid = (int)L; { const int q = nwg / NXCD, r = nwg % NXCD, xcd = wgid % NXCD, off = wgid / NXCD; wgid = (xcd < r ? xcd * (q + 1) : r * (q + 1) + (xcd - r) * q) + off; }
        const int nig = WGM * nN, gid = wgid / nig, fm = gid * WGM, gsz = (nM - fm) < WGM ? (nM - fm) : WGM;
        u.pm = fm + ((wgid % nig) % gsz); u.pn = (wgid % nig) / gsz; return true;
    }
    __device__ __forceinline__ void a_ready(const Unit&) const {}
    __device__ __forceinline__ void done(const Unit&) const {}
};

__device__ __forceinline__ unsigned cvt_pk_bf16(float lo, float hi) { unsigned r; asm volatile("v_cvt_pk_bf16_f32 %0, %1, %2" : "=v"(r) : "v"(lo), "v"(hi)); return r; }
typedef float f32x2 __attribute__((ext_vector_type(2)));
__device__ __forceinline__ u32x4 pack8f(const f32x4 a, const f32x4 b) { u32x4 w; w.x = cvt_pk_bf16(a[0], a[1]); w.y = cvt_pk_bf16(a[2], a[3]); w.z = cvt_pk_bf16(b[0], b[1]); w.w = cvt_pk_bf16(b[2], b[3]); return w; }
__device__ __forceinline__ void unpack8f(const u32x4 w, f32x4& a, f32x4& b) {
    a[0] = __uint_as_float(w.x << 16); a[1] = __uint_as_float(w.x & 0xffff0000u); a[2] = __uint_as_float(w.y << 16); a[3] = __uint_as_float(w.y & 0xffff0000u);
    b[0] = __uint_as_float(w.z << 16); b[1] = __uint_as_float(w.z & 0xffff0000u); b[2] = __uint_as_float(w.w << 16); b[3] = __uint_as_float(w.w & 0xffff0000u); }
__device__ __forceinline__ float sigmoidf_fast(float x) { return __builtin_amdgcn_rcpf(1.0f + __expf(-x)); }

struct EpiInProj {
    static constexpr bool PERM = true, AFTER_DRAIN = false;
    bf16_t* qkv; size_t stride;
    bf16_t* cb;
    bf16_t* z;
    bf16_t* sga; bf16_t* sgb;
    __device__ __forceinline__ void operator()(const f32x4 (&acc)[2][2][4][2], const Unit& u, int wr, int wc, int fr, int fq) const {
        const int row0 = u.pm * BM + wr * 64 + fr; const int pn = u.pn;
        if (pn < 16 || pn >= 24) {
            bf16_t* base = (pn < 12) ? qkv + (size_t)(pn >> 2) * stride : (pn < 16 ? cb : (pn < 28 ? sga : sgb)); const int col0 = (pn & 3) * BM + wc * 32 + 8 * fq;
#pragma unroll
            for (int ai = 0; ai < 2; ++ai)
#pragma unroll
                for (int m = 0; m < 4; ++m) { bf16_t* rowp = base + (size_t)(row0 + ai * HALF + m * 16) * 1024 + col0;
#pragma unroll
                    for (int bj = 0; bj < 2; ++bj) *(u32x4*)(rowp + bj * HALF) = pack8f(acc[ai][bj][m][0], acc[ai][bj][m][1]); }
        } else {
            const int col0 = (pn - 16) * HALF + wc * 32 + 8 * fq;
#pragma unroll
            for (int ai = 0; ai < 2; ++ai)
#pragma unroll
                for (int m = 0; m < 4; ++m) { bf16_t* rowp = z + (size_t)(row0 + ai * HALF + m * 16) * 1024 + col0;
                    *(u32x4*)rowp = pack8f(acc[ai][0][m][0] * acc[ai][1][m][0], acc[ai][0][m][1] * acc[ai][1][m][1]); }
        }
    }
};
template <bool SECOND> struct EpiGate {
    static constexpr bool PERM = true, AFTER_DRAIN = false;
    const bf16_t* gate; const bf16_t* prev; bf16_t* out; const float* gbias;
    __device__ __forceinline__ void operator()(const f32x4 (&acc)[2][2][4][2], const Unit& u, int wr, int wc, int fr, int fq) const {
        const int row0 = u.pm * BM + wr * 64 + fr; const int col0 = u.pn * BM + wc * 32 + 8 * fq;
        f32x4 bv[2][2];
#pragma unroll
        for (int bj = 0; bj < 2; ++bj)
#pragma unroll
            for (int n = 0; n < 2; ++n) bv[bj][n] = *(const f32x4*)(gbias + col0 + bj * HALF + 4 * n);
#pragma unroll
        for (int ai = 0; ai < 2; ++ai)
#pragma unroll
            for (int m = 0; m < 4; ++m) { const size_t off = (size_t)(row0 + ai * HALF + m * 16) * 1024 + col0;
#pragma unroll
                for (int bj = 0; bj < 2; ++bj) { f32x4 g0, g1; unpack8f(*(const u32x4*)(gate + off + bj * HALF), g0, g1); g0 += bv[bj][0]; g1 += bv[bj][1];
#pragma unroll
                    for (int i = 0; i < 4; ++i) { g0[i] = sigmoidf_fast(g0[i]); g1[i] = sigmoidf_fast(g1[i]); }
                    f32x4 v0 = acc[ai][bj][m][0] * g0, v1 = acc[ai][bj][m][1] * g1;
                    if (SECOND) { f32x4 p0, p1; unpack8f(*(const u32x4*)(prev + off + bj * HALF), p0, p1); v0 += p0; v1 += p1; }
                    *(u32x4*)(out + off + bj * HALF) = pack8f(v0, v1); } }
    }
};
typedef unsigned u32x2 __attribute__((ext_vector_type(2)));
#ifndef PRE_BF16_KNOB
#define PRE_BF16_KNOB 1
#endif
constexpr bool PRE_BF16 = PRE_BF16_KNOB;
struct EpiPre {
    static constexpr bool PERM = false, AFTER_DRAIN = false;
    const float* x; const float* stats; const float* g; const float* b; float* pre; float alpha;
    __device__ __forceinline__ void operator()(const f32x4 (&acc)[2][2][4][2], const Unit& u, int wr, int wc, int fr, int fq) const {
        const int row0 = u.pm * BM + wr * 64 + fr; const int col0 = u.pn * BM + wc * 32 + 4 * fq;
#pragma unroll
        for (int ai = 0; ai < 2; ++ai)
#pragma unroll
            for (int m = 0; m < 4; ++m) { const int row = row0 + ai * HALF + m * 16; const size_t off = (size_t)row * 1024 + col0;
                const float mu = stats[2 * row], rs = stats[2 * row + 1];
#pragma unroll
                for (int bj = 0; bj < 2; ++bj)
#pragma unroll
                    for (int n = 0; n < 2; ++n) { const int c = bj * HALF + n * 16; const f32x4 xv = *(const f32x4*)(x + off + c), gv = *(const f32x4*)(g + col0 + c), bv = *(const f32x4*)(b + col0 + c);
                        const f32x4 o = ((xv - mu) * rs * gv + bv) * alpha + acc[ai][bj][m][n];
                        if constexpr (PRE_BF16) { u32x2 w; w.x = cvt_pk_bf16(o[0], o[1]); w.y = cvt_pk_bf16(o[2], o[3]); *(u32x2*)((bf16_t*)pre + off + c) = w; } else *(f32x4*)(pre + off + c) = o; } }
    }
};
#ifndef MOE_HANDOFF
#define MOE_HANDOFF 0
#endif
struct EpiMoeUp {
    static constexpr bool PERM = true, AFTER_DRAIN = false;
    bf16_t* h;
    __device__ __forceinline__ void operator()(const f32x4 (&acc)[2][2][4][2], const Unit& u, int wr, int wc, int fr, int fq) const {
        const int row0 = u.pm * BM + wr * 64 + fr; const int col0 = (u.pn & 3) * HALF + wc * 32 + 8 * fq;
#pragma unroll
        for (int ai = 0; ai < 2; ++ai)
#pragma unroll
            for (int m = 0; m < 4; ++m) { f32x4 v[2];
#pragma unroll
                for (int n = 0; n < 2; ++n)
#pragma unroll
                    for (int i = 0; i < 4; ++i) { const float gv = acc[ai][0][m][n][i]; v[n][i] = gv * sigmoidf_fast(gv) * acc[ai][1][m][n][i]; }
                bf16_t* dst = h + (size_t)(row0 + ai * HALF + m * 16) * 512 + col0; const u32x4 w = pack8f(v[0], v[1]);
                if (MOE_HANDOFF) asm volatile("global_store_dwordx4 %0, %1, off sc1\n\ts_nop 1" :: "v"(dst), "v"(w) : "memory"); else *(u32x4*)dst = w; }
    }
};
struct EpiMoeDown {
    static constexpr bool PERM = true, AFTER_DRAIN = false;
    bf16_t* y;
    __device__ __forceinline__ void operator()(const f32x4 (&acc)[2][2][4][2], const Unit& u, int wr, int wc, int fr, int fq) const {
        const int row0 = u.pm * BM + wr * 64 + fr; const int col0 = (u.pn & 3) * BM + wc * 32 + 8 * fq;
#pragma unroll
        for (int ai = 0; ai < 2; ++ai)
#pragma unroll
            for (int m = 0; m < 4; ++m) { bf16_t* rowp = y + (size_t)(row0 + ai * HALF + m * 16) * 1024 + col0;
#pragma unroll
                for (int bj = 0; bj < 2; ++bj) *(u32x4*)(rowp + bj * HALF) = pack8f(acc[ai][bj][m][0], acc[ai][bj][m][1]); }
    }
};
struct MoeOrder {
    const PG8_LAS int* tab; int G, c;
    unsigned* cnt;
    unsigned need;
    bool publish; unsigned* tmo;
    __device__ __forceinline__ bool next(int i, Unit& u) const {
        const int nunits = (tab[32] >> 8) * 4; const int L = i * G + c; if (L >= nunits) return false;
        const int tile = L >> 2, s = tile << 8; int e = 0;
#pragma unroll 1
        for (int k = 1; k < 32; ++k) e = (tab[k] <= s) ? k : e;
        u.pm = __builtin_amdgcn_readfirstlane(tile); u.pn = __builtin_amdgcn_readfirstlane(e * 4 + (L & 3)); return true;
    }
    mutable int calls;
    __device__ __forceinline__ void a_ready(const Unit& u) const {
        const int k = calls++;
        if (need == 0u || (k >= 1 && k < 4)) return;
        if (threadIdx.x < 64) {
            const int lane = threadIdx.x, nunits = (tab[32] >> 8) * 4;
            int tile = u.pm; bool mine = (lane == 0);
            if (k == 0) { const int L = lane * G + c; mine = (lane < 4) && (L < nunits); tile = mine ? (L >> 2) : u.pm; }
            const unsigned long long t0 = __builtin_amdgcn_s_memrealtime(); unsigned polls = 0;
            for (;;) {
                const bool ok = !mine || __hip_atomic_load(cnt + 64 * tile, __ATOMIC_RELAXED, __HIP_MEMORY_SCOPE_AGENT) >= need;
                if (__all(ok)) break;
                if ((++polls & 255u) == 0u && __builtin_amdgcn_readfirstlane(__hip_atomic_load(tmo, __ATOMIC_RELAXED, __HIP_MEMORY_SCOPE_AGENT)) != 0u) break;
                if (__builtin_amdgcn_s_memrealtime() - t0 > 2000000ull) { if (threadIdx.x == 0) __hip_atomic_store(tmo, 1u, __ATOMIC_RELAXED, __HIP_MEMORY_SCOPE_AGENT); break; }
                __builtin_amdgcn_s_sleep(2); }
            __builtin_amdgcn_fence(__ATOMIC_ACQUIRE, "agent");
            asm volatile("s_waitcnt vmcnt(0)" ::: "memory");
        }
        asm volatile("" ::: "memory"); __builtin_amdgcn_s_barrier(); asm volatile("" ::: "memory");
    }
    mutable int pend;
    __device__ __forceinline__ void done(const Unit& u) const {
        if (!publish) return;
        if (pend >= 0 && (threadIdx.x & 63) == 0) __hip_atomic_fetch_add(cnt + 64 * pend, 1u, __ATOMIC_RELAXED, __HIP_MEMORY_SCOPE_AGENT);
        pend = u.pm;
    }
    __device__ __forceinline__ void flush() const {
        if (!publish) return;
        asm volatile("s_waitcnt vmcnt(0)" ::: "memory");
        if (pend >= 0 && (threadIdx.x & 63) == 0) __hip_atomic_fetch_add(cnt + 64 * pend, 1u, __ATOMIC_RELAXED, __HIP_MEMORY_SCOPE_AGENT);
        pend = -1;
    }
};
template <class Epi, class Sched, bool ALIGN_EPI = false, bool SP2 = false, bool GATHER = false>
__device__ __forceinline__ void gemm_phase(PG8_LAS unsigned char* lds, const Gemm g, const Sched& S, const Epi& E, const int* tok = nullptr) {
    static_assert(!GATHER || SP2, "GATHER is written for the SP2 loop only");
    const int tid = threadIdx.x, wid = __builtin_amdgcn_readfirstlane(tid >> 6), lane = tid & 63, wr = wid >> 2, wc = wid & 3, fr = lane & 15, fq = lane >> 4;
    const int K = g.K, nt = K / BK;
    unsigned voffA[2], voffB[2]; int gR[2], gC[2];
#pragma unroll
    for (int i = 0; i < 2; ++i) { int R, C; stage_rc(tid * 16 + i * 8192, R, C); const int Rb = Epi::PERM ? ((R & ~31) + perm32(R & 31)) : R; gR[i] = R; gC[i] = C;
        voffA[i] = (unsigned)(R * K + C) * 2u; voffB[i] = (unsigned)(Rb * K + C) * 2u; }
    unsigned vc0[2] = {0u, 0u}, vc1[2] = {0u, 0u}, vn0[2] = {0u, 0u}, vn1[2] = {0u, 0u};
#define PG8_GROWS(pm_, o0, o1) do { _Pragma("unroll") for (int _i = 0; _i < 2; ++_i) { o0[_i] = (unsigned)(tok[(pm_) * BM + gR[_i]] * K + gC[_i]) * 2u; o1[_i] = (unsigned)(tok[(pm_) * BM + HALF + gR[_i]] * K + gC[_i]) * 2u; } } while (0)
#define PG8_STAGE_A(bufoff, gbase, h, usenext) do { if constexpr (GATHER) { const unsigned _o0 = (usenext) ? ((h) ? vn1[0] : vn0[0]) : ((h) ? vc1[0] : vc0[0]), _o1 = (usenext) ? ((h) ? vn1[1] : vn0[1]) : ((h) ? vc1[1] : vc0[1]); \
        __builtin_amdgcn_global_load_lds((const unsigned*)((const char*)(gbase) + _o0), (PG8_LAS unsigned*)(lds + (bufoff) + ldsw), 16, 0, 0); \
        __builtin_amdgcn_global_load_lds((const unsigned*)((const char*)(gbase) + _o1), (PG8_LAS unsigned*)(lds + (bufoff) + ldsw + 8192), 16, 0, 0); } \
    else { PG8_STAGE(bufoff, (gbase) + (h) * hstep, voffA); } } while (0)
    const size_t kstep = (size_t)(BK * 2);
    const size_t hstep = (size_t)HALF * K * 2;
    const size_t tstep = 2 * hstep;
    const unsigned ldsw = (unsigned)wid * 1024u;
    const int aoff = lds_byte(wr * 64 + fr, fq * 8), boff = lds_byte(wc * 32 + fr, fq * 8);
#define PG8_SA(b, h) (((b) * 2 + (h)) * HTB)
#define PG8_SB(b, h) ((4 + (b) * 2 + (h)) * HTB)
#define PG8_STAGE(bufoff, gbase, voff) do { _Pragma("unroll") for (int _i = 0; _i < 2; ++_i) \
        __builtin_amdgcn_global_load_lds((const unsigned*)((const char*)(gbase) + (voff)[_i]), (PG8_LAS unsigned*)(lds + (bufoff) + ldsw + _i * 8192), 16, 0, 0); } while (0)
#define PG8_LDA(dst, b, h) do { _Pragma("unroll") for (int m = 0; m < 4; ++m) _Pragma("unroll") for (int k = 0; k < 2; ++k) dst[m][k] = *(const PG8_LAS bf16x8*)(lds + PG8_SA(b, h) + aoff + m * 2048 + k * 1024); } while (0)
#define PG8_LDB(dst, b, h) do { _Pragma("unroll") for (int n = 0; n < 2; ++n) _Pragma("unroll") for (int k = 0; k < 2; ++k) dst[n][k] = *(const PG8_LAS bf16x8*)(lds + PG8_SB(b, h) + boff + n * 2048 + k * 1024); } while (0)
#define PG8_MMA(ai, bj, At, Bt) do { __builtin_amdgcn_s_setprio(1); _Pragma("unroll") for (int m = 0; m < 4; ++m) _Pragma("unroll") for (int n = 0; n < 2; ++n) _Pragma("unroll") for (int k = 0; k < 2; ++k) \
        acc[ai][bj][m][n] = __builtin_amdgcn_mfma_f32_16x16x32_bf16(Bt[n][k], At[m][k], acc[ai][bj][m][n], 0, 0, 0); __builtin_amdgcn_s_setprio(0); } while (0)
#define PG8_WAIT_V(n) asm volatile("s_waitcnt vmcnt(" #n ")" ::: "memory")
#define PG8_WAIT_L(n) asm volatile("s_waitcnt lgkmcnt(" #n ")" ::: "memory")
#define PG8_BAR __builtin_amdgcn_s_barrier()
#define PG8_SCHED __builtin_amdgcn_sched_barrier(0)
    Unit cur, nxt; int ui = 0;
    if (!S.next(0, cur)) return;
    f32x4 acc[2][2][4][2];
#pragma unroll
    for (int a = 0; a < 2; ++a)
#pragma unroll
        for (int b = 0; b < 2; ++b)
#pragma unroll
            for (int m = 0; m < 4; ++m)
#pragma unroll
                for (int n = 0; n < 2; ++n) acc[a][b][m][n] = (f32x4){0.f, 0.f, 0.f, 0.f};
    bf16x8 At[4][2], B0[2][2], B1[2][2];
    const char* cA = GATHER ? (const char*)g.A : (const char*)g.A + (size_t)cur.pm * tstep; const char* cB = (const char*)g.Bt + (size_t)cur.pn * tstep;
    S.a_ready(cur);
    if constexpr (GATHER) PG8_GROWS(cur.pm, vc0, vc1);
    if constexpr (SP2) {
        PG8_STAGE(PG8_SB(0, 0), cB, voffB); PG8_STAGE(PG8_SB(0, 1), cB + hstep, voffB); PG8_STAGE_A(PG8_SA(0, 0), cA, 0, false); PG8_STAGE_A(PG8_SA(0, 1), cA, 1, false);
        if (wr == 1) PG8_BAR;
        PG8_WAIT_V(2); PG8_BAR;
        PG8_STAGE(PG8_SB(1, 0), cB + kstep, voffB); PG8_STAGE_A(PG8_SA(1, 0), cA + kstep, 0, false); PG8_STAGE(PG8_SB(1, 1), cB + hstep + kstep, voffB);
        PG8_WAIT_V(6); PG8_BAR;
    } else {
        PG8_STAGE(PG8_SB(0, 0), cB, voffB); PG8_STAGE(PG8_SA(0, 0), cA, voffA); PG8_STAGE(PG8_SB(0, 1), cB + hstep, voffB); PG8_STAGE(PG8_SA(0, 1), cA + hstep, voffA);
        if (wr == 1) PG8_BAR;
        PG8_WAIT_V(4); PG8_BAR;
        PG8_STAGE(PG8_SB(1, 0), cB + kstep, voffB); PG8_STAGE(PG8_SA(1, 0), cA + kstep, voffA); PG8_STAGE(PG8_SB(1, 1), cB + hstep + kstep, voffB);
        PG8_WAIT_V(6); PG8_BAR;
    }
    for (;;) {
        const bool has_next = S.next(ui + 1, nxt);
        const char* nA = GATHER ? (const char*)g.A : (has_next ? (const char*)g.A + (size_t)nxt.pm * tstep : cA); const char* nB = has_next ? (const char*)g.Bt + (size_t)nxt.pn * tstep : cB;
        if constexpr (GATHER) { if (has_next) PG8_GROWS(nxt.pm, vn0, vn1); else { vn0[0] = vc0[0]; vn0[1] = vc0[1]; vn1[0] = vc1[0]; vn1[1] = vc1[1]; } }
        for (int t = 0; t < nt; t += 2) {
            const bool last = (t == nt - 2);
            const char* a1 = cA + (size_t)(t + 1) * kstep;
            const char* a2 = last ? nA : cA + (size_t)(t + 2) * kstep; const char* b2 = last ? nB : cB + (size_t)(t + 2) * kstep;
            const char* a3 = a2 + kstep; const char* b3 = b2 + kstep;
            if (last && has_next) S.a_ready(nxt);
            if constexpr (SP2) {
            PG8_LDB(B0, 0, 0); PG8_LDB(B1, 0, 1); PG8_SCHED; PG8_LDA(At, 0, 0); PG8_STAGE_A(PG8_SA(1, 1), a1, 1, false);
            PG8_WAIT_V(8); PG8_WAIT_L(0); PG8_BAR; PG8_MMA(0, 0, At, B0); PG8_MMA(0, 1, At, B1); PG8_BAR; PG8_SCHED;
            PG8_LDA(At, 0, 1); PG8_STAGE(PG8_SB(0, 0), b2, voffB); PG8_STAGE(PG8_SB(0, 1), b2 + hstep, voffB); PG8_STAGE_A(PG8_SA(0, 0), a2, 0, last);
            PG8_WAIT_V(8); PG8_WAIT_L(0); PG8_BAR; PG8_MMA(1, 0, At, B0); PG8_MMA(1, 1, At, B1); PG8_BAR; PG8_SCHED;
            PG8_LDB(B0, 1, 0); PG8_LDB(B1, 1, 1); PG8_SCHED; PG8_LDA(At, 1, 0); PG8_STAGE_A(PG8_SA(0, 1), a2, 1, last);
            PG8_WAIT_V(8); PG8_WAIT_L(0); PG8_BAR; PG8_MMA(0, 0, At, B0); PG8_MMA(0, 1, At, B1); PG8_BAR; PG8_SCHED;
            PG8_LDA(At, 1, 1); PG8_STAGE(PG8_SB(1, 0), b3, voffB); PG8_STAGE(PG8_SB(1, 1), b3 + hstep, voffB); PG8_STAGE_A(PG8_SA(1, 0), a3, 0, last);
            PG8_WAIT_V(8); PG8_WAIT_L(0); PG8_BAR; PG8_MMA(1, 0, At, B0); PG8_MMA(1, 1, At, B1); PG8_BAR; PG8_SCHED;
            } else {
            PG8_LDB(B0, 0, 0); PG8_SCHED; PG8_LDA(At, 0, 0); PG8_STAGE(PG8_SA(1, 1), a1 + hstep, voffA);
            PG8_WAIT_L(8); PG8_BAR; PG8_WAIT_L(0); PG8_MMA(0, 0, At, B0); PG8_BAR; PG8_SCHED;
            PG8_LDB(B1, 0, 1); PG8_STAGE(PG8_SB(0, 0), b2, voffB);
            PG8_BAR; PG8_WAIT_L(0); PG8_MMA(0, 1, At, B1); PG8_BAR;
            PG8_LDA(At, 0, 1); PG8_STAGE(PG8_SA(0, 0), a2, voffA);
            PG8_BAR; PG8_WAIT_L(0); PG8_MMA(1, 0, At, B0); PG8_BAR; PG8_SCHED;
            PG8_STAGE(PG8_SB(0, 1), b2 + hstep, voffB);
            PG8_WAIT_V(6); PG8_BAR; PG8_MMA(1, 1, At, B1); PG8_BAR;
            PG8_LDB(B0, 1, 0); PG8_SCHED; PG8_LDA(At, 1, 0); PG8_STAGE(PG8_SA(0, 1), a2 + hstep, voffA);
            PG8_WAIT_L(8); PG8_BAR; PG8_WAIT_L(0); PG8_MMA(0, 0, At, B0); PG8_BAR; PG8_SCHED;
            PG8_LDB(B1, 1, 1); PG8_STAGE(PG8_SB(1, 0), b3, voffB);
            PG8_BAR; PG8_WAIT_L(0); PG8_MMA(0, 1, At, B1); PG8_BAR;
            PG8_LDA(At, 1, 1); PG8_STAGE(PG8_SA(1, 0), a3, voffA);
            PG8_BAR; PG8_WAIT_L(0); PG8_MMA(1, 0, At, B0); PG8_BAR; PG8_SCHED;
            PG8_STAGE(PG8_SB(1, 1), b3 + hstep, voffB);
            PG8_WAIT_V(6); PG8_BAR; PG8_MMA(1, 1, At, B1); PG8_BAR;
            }
        }
        if constexpr (ALIGN_EPI) { if (wr == 0) PG8_BAR; }
        if constexpr (!Epi::AFTER_DRAIN) { E(acc, cur, wr, wc, fr, fq); S.done(cur); }
        if (!has_next) break;
#pragma unroll
        for (int a = 0; a < 2; ++a)
#pragma unroll
            for (int b = 0; b < 2; ++b)
#pragma unroll
                for (int m = 0; m < 4; ++m)
#pragma unroll
                    for (int n = 0; n < 2; ++n) acc[a][b][m][n] = (f32x4){0.f, 0.f, 0.f, 0.f};
        cur = nxt; cA = nA; cB = nB; ++ui;
        if constexpr (GATHER) { vc0[0] = vn0[0]; vc0[1] = vn0[1]; vc1[0] = vn1[0]; vc1[1] = vn1[1]; }
        if constexpr (ALIGN_EPI) { if (wr == 1) PG8_BAR; }
    }
    PG8_WAIT_V(0);
    if constexpr (!ALIGN_EPI) { if (wr == 0) PG8_BAR; }
    PG8_BAR;
    if constexpr (Epi::AFTER_DRAIN) { E.fused(acc, cur, wr, wc, fr, fq, lds, wid, lane); S.done(cur); }
#undef PG8_SA
#undef PG8_SB
#undef PG8_STAGE
#undef PG8_STAGE_A
#undef PG8_GROWS
#undef PG8_LDA
#undef PG8_LDB
#undef PG8_MMA
#undef PG8_WAIT_V
#undef PG8_WAIT_L
#undef PG8_BAR
#undef PG8_SCHED
}
}

namespace attn {
typedef short bf16x8 __attribute__((ext_vector_type(8)));
typedef short s16x4 __attribute__((ext_vector_type(4)));
typedef float f32x16 __attribute__((ext_vector_type(16)));
typedef unsigned u32x4 __attribute__((ext_vector_type(4)));
typedef unsigned short bf16;
constexpr int D = 128, PITCH = 1024, SEQ = 2048;
constexpr float SCALE = 0.08838834764831845f, THR = 8.f;
constexpr int NW = 8, QBLK = 32, KVBLK = 64, QB = NW * QBLK;
constexpr int SHM_V = KVBLK * D * 2, SHM_K = KVBLK * D * 2;
constexpr int BIAS_OFF = 2 * SHM_V + 2 * SHM_K + NW * 64 * 4, NBIAS = 320;
constexpr int LDS_BYTES = BIAS_OFF + NBIAS * 4;
#define KSWZ(row, colB) ((row) * 256 + ((colB) ^ (((row) & 7) << 4)))
#define SBAR() __builtin_amdgcn_sched_barrier(0)
__device__ __forceinline__ int v_st(int k, int c) { const int kk = (k & ~0xC) | ((k & 4) << 1) | ((k & 8) >> 1); return ((kk >> 3) * 4 + (c >> 5)) * 512 + ((kk & 7) * 32 + (c & 31)) * 2; }
__device__ __forceinline__ int v_rd_base(int lane) { return ((lane & 3) << 3) | (((lane >> 2) & 3) << 6) | (((lane >> 4) & 1) << 5) | (((lane >> 5) & 1) << 8); }
constexpr int v_rd_off(int d0, int ks, int half) { return d0 * 512 + ks * 4096 + half * 2048; }
__device__ __forceinline__ int crow(int r, int hi) { return (r & 3) + 8 * (r >> 2) + 4 * hi; }
__device__ __forceinline__ unsigned cvtpk(float lo, float hi) { unsigned r; asm volatile("v_cvt_pk_bf16_f32 %0, %1, %2" : "=v"(r) : "v"(lo), "v"(hi)); return r; }
__device__ __forceinline__ bf16x8 load8(const bf16* p) { return *reinterpret_cast<const bf16x8*>(p); }
__device__ __forceinline__ int t5_bucket(int rel) {
    const int b = rel > 0 ? 16 : 0; const int n = rel < 0 ? -rel : rel; int v;
    if (n < 8) v = n; else if (n < 12) v = 8; else if (n < 16) v = 9; else if (n < 23) v = 10; else if (n < 32) v = 11; else if (n < 46) v = 12; else if (n < 65) v = 13; else if (n < 91) v = 14; else v = 15;
    return b + v;
}
__device__ __forceinline__ void bias_tile(f32x16& p0, f32x16& p1, const float* tabp) {
#pragma unroll
    for (int r = 0; r < 16; ++r) { const int c = (r & 3) + 8 * (r >> 2); p0[r] += tabp[59 - c]; p1[r] += tabp[59 - c - 32]; }
}
__device__ __forceinline__ void partialSM(f32x16& p0, f32x16& p1, float& m_reg, float& mn, float& alpha) {
    float pmax = p0[0]; for (int r = 1; r < 16; ++r) pmax = fmaxf(pmax, p0[r]); for (int r = 0; r < 16; ++r) pmax = fmaxf(pmax, p1[r]);
    { auto rr = __builtin_amdgcn_permlane32_swap(__float_as_uint(pmax), __float_as_uint(pmax), false, false);
      pmax = fmaxf(__uint_as_float(rr[0]), __uint_as_float(rr[1])); }
    constexpr float C2 = 1.4426950408889634f * SCALE;
    if (__builtin_expect(__all((pmax - m_reg) * SCALE <= THR), 1)) { mn = m_reg; alpha = 1.f; }
    else { mn = fmaxf(m_reg, pmax); alpha = __builtin_amdgcn_exp2f((m_reg - mn) * C2); m_reg = mn; }
    const float mnL = -mn * C2;
    for (int r = 0; r < 16; ++r) p0[r] = fmaf(p0[r], C2, mnL); for (int r = 0; r < 16; ++r) p1[r] = fmaf(p1[r], C2, mnL);
    for (int r = 0; r < 16; ++r) p0[r] = __builtin_amdgcn_exp2f(p0[r]);
}
__device__ __forceinline__ void finishSM(f32x16& p0, f32x16& p1, float alpha, float& l_reg, bf16x8& pa0, bf16x8& pa1, bf16x8& pa2, bf16x8& pa3) {
    for (int r = 0; r < 16; ++r) p1[r] = __builtin_amdgcn_exp2f(p1[r]);
    float ps = 0; for (int r = 0; r < 16; ++r) ps += p0[r]; for (int r = 0; r < 16; ++r) ps += p1[r];
    { auto rr = __builtin_amdgcn_permlane32_swap(__float_as_uint(ps), __float_as_uint(ps), false, false);
      ps = __uint_as_float(rr[0]) + __uint_as_float(rr[1]); }
    l_reg = l_reg * alpha + ps;
#define PK4(P, B_, OUT) do { unsigned a0 = cvtpk(P[B_+0], P[B_+1]), a1 = cvtpk(P[B_+2], P[B_+3]);                          \
        unsigned b0 = cvtpk(P[B_+4], P[B_+5]), b1 = cvtpk(P[B_+6], P[B_+7]);                                             \
        auto r0 = __builtin_amdgcn_permlane32_swap(a0, b0, false, false); auto r1 = __builtin_amdgcn_permlane32_swap(a1, b1, false, false); \
        u32x4 w = {r0[0], r1[0], r0[1], r1[1]}; OUT = *reinterpret_cast<bf16x8*>(&w); } while (0)
    PK4(p0, 0, pa0); PK4(p0, 8, pa1); PK4(p1, 0, pa2); PK4(p1, 8, pa3);
#undef PK4
}
template <int KB>
__device__ __forceinline__ void qkt(f32x16& p0, f32x16& p1, const char* K_lds, int r32, int hi, const bf16x8* qr, bool act) {
    if (!act) { const float NEG = -__builtin_inff();
#pragma unroll
        for (int r = 0; r < 16; ++r) { p0[r] = NEG; p1[r] = NEG; } return; }
    p0 = f32x16{}; p1 = f32x16{};
    const char* kb[4];
#pragma unroll
    for (int dd = 0; dd < 4; ++dd) kb[dd] = K_lds + KB * SHM_K + KSWZ(r32, (dd * 16 + hi * 8) * 2);
#pragma unroll
    for (int d0 = 0; d0 < 8; ++d0) { const char* a = kb[d0 & 3] + (d0 >> 2) * 128;
        bf16x8 b0 = *reinterpret_cast<const bf16x8*>(a);
        bf16x8 b1 = *reinterpret_cast<const bf16x8*>(a + 32 * 256);
        p0 = __builtin_amdgcn_mfma_f32_32x32x16_bf16(b0, qr[d0], p0, 0, 0, 0);
        p1 = __builtin_amdgcn_mfma_f32_32x32x16_bf16(b1, qr[d0], p1, 0, 0, 0); }
}
template <int VB>
__device__ __forceinline__ void pv_tile(f32x16* o, int vb0, bf16x8 pa0, bf16x8 pa1, bf16x8 pa2, bf16x8 pa3, bool act) {
    if (!act) return;
#define TRRD(dst, off) asm volatile("ds_read_b64_tr_b16 %0, %1 offset:%2" : "=&v"(dst) : "v"(vb0), "i"(off) : "memory")
#define PV_D0(d0) do { s16x4 l0, l1, l2, l3, h0, h1, h2, h3; constexpr int b_ = VB * SHM_V + v_rd_off(d0, 0, 0); \
        TRRD(l0, b_); TRRD(h0, b_ + 2048); TRRD(l1, b_ + 4096); TRRD(h1, b_ + 6144); TRRD(l2, b_ + 8192); TRRD(h2, b_ + 10240); TRRD(l3, b_ + 12288); TRRD(h3, b_ + 14336); \
        asm volatile("s_waitcnt lgkmcnt(0)" ::: "memory"); SBAR();   \
        o[d0] = __builtin_amdgcn_mfma_f32_32x32x16_bf16(pa0, (bf16x8){l0[0], l0[1], l0[2], l0[3], h0[0], h0[1], h0[2], h0[3]}, o[d0], 0, 0, 0);   \
        o[d0] = __builtin_amdgcn_mfma_f32_32x32x16_bf16(pa1, (bf16x8){l1[0], l1[1], l1[2], l1[3], h1[0], h1[1], h1[2], h1[3]}, o[d0], 0, 0, 0);   \
        o[d0] = __builtin_amdgcn_mfma_f32_32x32x16_bf16(pa2, (bf16x8){l2[0], l2[1], l2[2], l2[3], h2[0], h2[1], h2[2], h2[3]}, o[d0], 0, 0, 0);   \
        o[d0] = __builtin_amdgcn_mfma_f32_32x32x16_bf16(pa3, (bf16x8){l3[0], l3[1], l3[2], l3[3], h3[0], h3[1], h3[2], h3[3]}, o[d0], 0, 0, 0); } while (0)
    PV_D0(0); PV_D0(1); PV_D0(2); PV_D0(3);
#undef PV_D0
#undef TRRD
}
struct BlockRef { const bf16* Q; const bf16* K; const bf16* V; bf16* O; int P0; };
struct Seam { bf16x8 qr[8]; bf16x8 st_v0, st_v1, st_k0, st_k1; };
#define ROW(p, k0, rr) ((p) + (size_t)((k0) + (rr)) * PITCH + sc)
#define VMW() asm volatile("s_waitcnt vmcnt(0)" ::: "memory")
#define VMWN(n) asm volatile("s_waitcnt vmcnt(%0)" :: "i"(n) : "memory")
#define SLOAD_H(Kp, Vp, k0) do { S.st_v0 = load8(ROW(Vp, k0, sr)); S.st_v1 = load8(ROW(Vp, k0, 32 + sr)); S.st_k0 = load8(ROW(Kp, k0, sr)); S.st_k1 = load8(ROW(Kp, k0, 32 + sr)); } while (0)
#define SWRITE_HK(bf) do { *(bf16x8*)(K_lds + (bf) * SHM_K + kws) = S.st_k0; *(bf16x8*)(K_lds + (bf) * SHM_K + kws + 32 * 256) = S.st_k1; } while (0)
#define SWRITE_HV(bf) do { *(bf16x8*)(V_lds + (bf) * SHM_V + vst0) = S.st_v0; *(bf16x8*)(V_lds + (bf) * SHM_V + vst1) = S.st_v1; } while (0)
#define SWRITE_H(bf) do { SWRITE_HV(bf); SWRITE_HK(bf); } while (0)
__device__ __forceinline__ void attn_prime(const BlockRef& cur, char* lds, Seam& S) {
    const int tid = threadIdx.x, wid = __builtin_amdgcn_readfirstlane(tid >> 6), lane = tid & 63, r32 = lane & 31, hi = lane >> 5;
    const int sr = tid >> 4, sc = (tid & 15) * 8, kws = KSWZ(sr, sc * 2); char* K_lds = lds + 2 * SHM_V;
#pragma unroll
    for (int d0 = 0; d0 < 8; ++d0) S.qr[d0] = load8(cur.Q + (size_t)(wid * QBLK + r32) * PITCH + d0 * 16 + hi * 8);
    SLOAD_H(cur.K, cur.V, 0); VMW(); SWRITE_HK(0);
    __syncthreads();
}
__device__ __forceinline__ void attn_block(const BlockRef& cur, const BlockRef& nxt, char* lds, Seam& S) {
    const int tid = threadIdx.x, wid = __builtin_amdgcn_readfirstlane(tid >> 6), lane = tid & 63, r32 = lane & 31, hi = lane >> 5;
    const int NT = cur.P0 / KVBLK + QB / KVBLK;
    const int qlo = cur.P0 + wid * QBLK, cw = qlo >> 6;
    char* V_lds = lds; char* K_lds = lds + 2 * SHM_V;
    float* ws = (float*)(lds + 2 * SHM_V + 2 * SHM_K) + wid * 64; float* li_l = ws, * al_l = ws + 32;
    const float* btab = (const float*)(lds + BIAS_OFF);
    float m_reg = -1e30f, l_reg = 0; f32x16 o[4] = {};
    const int sr = tid >> 4, sc = (tid & 15) * 8, vst0 = v_st(sr, sc), vst1 = v_st(32 + sr, sc), kws = KSWZ(sr, sc * 2);
    const int vb0 = (int)(uintptr_t)V_lds + v_rd_base(lane);
    const bf16* Kh = cur.K; const bf16* Vh = cur.V;
    const int bb0 = qlo + r32 - 4 * hi + 4;
#define RESC(a) do { if (__any((a) < 1.f)) { if (hi == 0) al_l[r32] = (a); asm volatile("s_waitcnt lgkmcnt(0)" ::: "memory");              \
                     for (int d_ = 0; d_ < 4; ++d_) for (int r = 0; r < 16; ++r) o[d_][r] *= al_l[crow(r, hi)]; } } while (0)
#define KBASE(t) ((t) * KVBLK)
#define ACT(t) ((t) <= cw)
#define BIAST(P0_, P1_, t) do { if ((t) <= cw && (t) + 2 >= cw) bias_tile(P0_, P1_, btab + (bb0 - KBASE(t))); } while (0)
    constexpr int NQL = 8;
#define SEAM_K0() do { VMWN(NQL); SWRITE_HK(0); SBAR(); } while (0)
    f32x16 pA0, pA1, pB0, pB1; float mnA, mnB, alA, alB; bf16x8 pa0, pa1, pa2, pa3;
    SWRITE_HV(0); SBAR();
    SLOAD_H(Kh, Vh, KBASE(1));
    SBAR(); qkt<0>(pA0, pA1, K_lds, r32, hi, S.qr, ACT(0));
    BIAST(pA0, pA1, 0); partialSM(pA0, pA1, m_reg, mnA, alA);
    VMW(); SWRITE_H(1);
    __syncthreads();
#define HALF_STEP(PX0, PX1, mnX, alX, PY0, PY1, alY, t, KB, VB, SB) do {                                                      \
        SBAR(); qkt<KB>(PX0, PX1, K_lds, r32, hi, S.qr, ACT(t));                                                 \
        finishSM(PY0, PY1, alY, l_reg, pa0, pa1, pa2, pa3); SBAR();                                                           \
        if ((t) + 1 < NT) { SLOAD_H(Kh, Vh, KBASE((t) + 1)); SBAR(); }                                                         \
        pv_tile<VB>(o, vb0, pa0, pa1, pa2, pa3, ACT((t) - 1)); BIAST(PX0, PX1, (t)); partialSM(PX0, PX1, m_reg, mnX, alX);    \
        __syncthreads();                                                                                                      \
        if ((t) + 1 < NT) { VMW(); SWRITE_H(SB); }                                                                             \
        RESC(alX); __syncthreads(); } while (0)
    for (int t = 1; t + 1 < NT; t += 2) {
        HALF_STEP(pB0, pB1, mnB, alB, pA0, pA1, alA, t, 1, 0, 0);
        HALF_STEP(pA0, pA1, mnA, alA, pB0, pB1, alB, t + 1, 0, 1, 1);
    }
    { SBAR(); qkt<1>(pB0, pB1, K_lds, r32, hi, S.qr, ACT(NT - 1)); SBAR(); }
    SLOAD_H(nxt.K, nxt.V, 0); SBAR();
#pragma unroll
    for (int d0 = 0; d0 < 8; ++d0) S.qr[d0] = load8(nxt.Q + (size_t)(wid * QBLK + r32) * PITCH + d0 * 16 + hi * 8);
    SBAR();
    finishSM(pA0, pA1, alA, l_reg, pa0, pa1, pa2, pa3); SBAR();
    pv_tile<0>(o, vb0, pa0, pa1, pa2, pa3, ACT(NT - 2));
    { BIAST(pB0, pB1, NT - 1); partialSM(pB0, pB1, m_reg, mnB, alB); __syncthreads(); RESC(alB);
      finishSM(pB0, pB1, alB, l_reg, pa0, pa1, pa2, pa3); SBAR(); pv_tile<1>(o, vb0, pa0, pa1, pa2, pa3, ACT(NT - 1)); }
    SBAR(); SEAM_K0();
    if (hi == 0) li_l[r32] = l_reg; asm volatile("s_waitcnt lgkmcnt(0)" ::: "memory");
    float rli[16];
#pragma unroll
    for (int r = 0; r < 16; ++r) rli[r] = __builtin_amdgcn_rcpf(li_l[crow(r, hi)]);
    bf16* Ow = cur.O + (size_t)(wid * QBLK) * PITCH;
#pragma unroll
    for (int r = 0; r < 16; ++r) { const int orow = crow(r, hi);
#pragma unroll
        for (int d0 = 0; d0 < 4; ++d0) { const float v = o[d0][r] * rli[r];
            const float vn = __shfl_xor(v, 1);
            if ((r32 & 1) == 0) *(unsigned*)(Ow + (size_t)orow * PITCH + d0 * 32 + r32) = cvtpk(v, vn); } }
    __syncthreads();
#undef RESC
#undef KBASE
#undef ACT
#undef BIAST
#undef SEAM_K0
#undef HALF_STEP
}
#undef ROW
#undef VMW
#undef VMWN
#undef SLOAD_H
#undef SWRITE_HK
#undef SWRITE_HV
#undef SWRITE_H
#undef KSWZ
}

namespace attn2 {
using attn::bf16x8; using attn::s16x4; using attn::f32x16; using attn::u32x4; using attn::bf16;
using attn::v_st; using attn::v_rd_base; using attn::crow; using attn::cvtpk; using attn::load8; using attn::t5_bucket;
constexpr int D = 128, PITCH = 1024;
constexpr float SCALE = 0.08838834764831845f, THR = 8.f;
constexpr int NW = 8, QBLK = 32, KVBLK = 64, QB = 4 * QBLK;
constexpr int IMG = KVBLK * D * 2, SHM_V = 2 * IMG, SHM_K = KVBLK * D * 2;
constexpr int OFF_V = 0, OFF_K = 2 * SHM_V, OFF_PX = OFF_K + 2 * SHM_K, OFF_WS = OFF_PX + NW * 2048, OFF_MX = OFF_WS + NW * 64 * 4, BIAS_OFF = OFF_MX + NW * 32 * 4, NBIAS = 320;
constexpr int LDS_BYTES = BIAS_OFF + NBIAS * 4;
#define KSWZ(row, colB) ((row) * 256 + ((colB) ^ (((row) & 7) << 4)))
#define SBAR() __builtin_amdgcn_sched_barrier(0)
#ifndef ATTN_SGB
#define ATTN_SGB 1
#endif
#if ATTN_SGB
#define SGB_A() do { _Pragma("unroll") for (int g_ = 0; g_ < 8; ++g_) { __builtin_amdgcn_sched_group_barrier(0x008, 1, 0); __builtin_amdgcn_sched_group_barrier(0x402, 9, 0); } } while (0)
#else
#define SGB_A() do {} while (0)
#endif
#define L3 __attribute__((address_space(3)))
#define LP(T, byteoff) ((L3 T*)(uintptr_t)(unsigned)(byteoff))
__device__ __forceinline__ void bias_half(f32x16& p, const L3 float* tabp) {
#pragma unroll
    for (int r = 0; r < 16; ++r) { const int c = (r & 3) + 8 * (r >> 2); p[r] += tabp[59 - c]; }
}
__device__ __forceinline__ float rowmax_half(const f32x16& p) {
    float pmax = p[0];
#pragma unroll
    for (int r = 1; r < 16; ++r) pmax = fmaxf(pmax, p[r]);
    const auto rr = __builtin_amdgcn_permlane32_swap(__float_as_uint(pmax), __float_as_uint(pmax), false, false);
    return fmaxf(__uint_as_float(rr[0]), __uint_as_float(rr[1]));
}
__device__ __forceinline__ void partialSM(f32x16& p, float pmax, float& m_reg, float& alpha) {
    constexpr float C2 = 1.4426950408889634f * SCALE; float mn;
    if (__builtin_expect(__all((pmax - m_reg) * SCALE <= THR), 1)) { mn = m_reg; alpha = 1.f; }
    else { mn = fmaxf(m_reg, pmax); alpha = __builtin_amdgcn_exp2f((m_reg - mn) * C2); m_reg = mn; }
    const float mnL = -mn * C2;
#pragma unroll
    for (int r = 0; r < 16; ++r) p[r] = fmaf(p[r], C2, mnL);
#pragma unroll
    for (int r = 0; r < 8; ++r) p[r] = __builtin_amdgcn_exp2f(p[r]);
}
__device__ __forceinline__ void finishSM(f32x16& p, float alpha, float& l_reg, bf16x8& pa0, bf16x8& pa1) {
#pragma unroll
    for (int r = 8; r < 16; ++r) p[r] = __builtin_amdgcn_exp2f(p[r]);
    float ps = 0;
#pragma unroll
    for (int r = 0; r < 16; ++r) ps += p[r];
    { const auto rr = __builtin_amdgcn_permlane32_swap(__float_as_uint(ps), __float_as_uint(ps), false, false); ps = __uint_as_float(rr[0]) + __uint_as_float(rr[1]); }
    l_reg = l_reg * alpha + ps;
#define PK4(P, B_, OUT) do { unsigned a0 = cvtpk(P[B_+0], P[B_+1]), a1 = cvtpk(P[B_+2], P[B_+3]);                          \
        unsigned b0 = cvtpk(P[B_+4], P[B_+5]), b1 = cvtpk(P[B_+6], P[B_+7]);                                             \
        auto r0 = __builtin_amdgcn_permlane32_swap(a0, b0, false, false); auto r1 = __builtin_amdgcn_permlane32_swap(a1, b1, false, false); \
        u32x4 w = {r0[0], r1[0], r0[1], r1[1]}; OUT = *reinterpret_cast<bf16x8*>(&w); } while (0)
    PK4(p, 0, pa0); PK4(p, 8, pa1);
#undef PK4
}
template <int KB>
__device__ __forceinline__ void kload(bf16x8* kf, unsigned K_lds, int krow, int hi) {
    unsigned kb[4];
#pragma unroll
    for (int dd = 0; dd < 4; ++dd) kb[dd] = K_lds + KB * SHM_K + KSWZ(krow, (dd * 16 + hi * 8) * 2);
#pragma unroll
    for (int d0 = 0; d0 < 8; ++d0) kf[d0] = *LP(const bf16x8, kb[d0 & 3] + (d0 >> 2) * 128);
}
__device__ __forceinline__ void qmma(f32x16& p, const bf16x8* kf, const bf16x8* qr) {
    p = f32x16{};
#pragma unroll
    for (int d0 = 0; d0 < 8; ++d0) p = __builtin_amdgcn_mfma_f32_32x32x16_bf16(kf[d0], qr[d0], p, 0, 0, 0);
}
__device__ __forceinline__ void pneg(f32x16& p) { const float NEG = -__builtin_inff();
#pragma unroll
    for (int r = 0; r < 16; ++r) p[r] = NEG; }
template <int VB>
__device__ __forceinline__ void pv_tile(f32x16* o, int vbo, int vbp, bf16x8 po0, bf16x8 po1, bf16x8 pp0, bf16x8 pp1, bool act) {
    if (!act) return;
#define TRRD(dst, base, off) asm volatile("ds_read_b64_tr_b16 %0, %1 offset:%2" : "=&v"(dst) : "v"(base), "i"(off) : "memory")
#define PV_D0(d0) do { s16x4 l0, l1, l2, l3, h0, h1, h2, h3; constexpr int b_ = VB * SHM_V + (d0) * 512; \
        TRRD(l0, vbo, b_); TRRD(h0, vbo, b_ + 2048); TRRD(l1, vbo, b_ + 4096); TRRD(h1, vbo, b_ + 6144); TRRD(l2, vbp, b_); TRRD(h2, vbp, b_ + 2048); TRRD(l3, vbp, b_ + 4096); TRRD(h3, vbp, b_ + 6144); \
        asm volatile("s_waitcnt lgkmcnt(0)" ::: "memory"); SBAR();   \
        o[d0] = __builtin_amdgcn_mfma_f32_32x32x16_bf16(po0, (bf16x8){l0[0], l0[1], l0[2], l0[3], h0[0], h0[1], h0[2], h0[3]}, o[d0], 0, 0, 0);   \
        o[d0] = __builtin_amdgcn_mfma_f32_32x32x16_bf16(po1, (bf16x8){l1[0], l1[1], l1[2], l1[3], h1[0], h1[1], h1[2], h1[3]}, o[d0], 0, 0, 0);   \
        o[d0] = __builtin_amdgcn_mfma_f32_32x32x16_bf16(pp0, (bf16x8){l2[0], l2[1], l2[2], l2[3], h2[0], h2[1], h2[2], h2[3]}, o[d0], 0, 0, 0);   \
        o[d0] = __builtin_amdgcn_mfma_f32_32x32x16_bf16(pp1, (bf16x8){l3[0], l3[1], l3[2], l3[3], h3[0], h3[1], h3[2], h3[3]}, o[d0], 0, 0, 0); } while (0)
    PV_D0(0); PV_D0(1); PV_D0(2); PV_D0(3);
#undef PV_D0
#undef TRRD
}
struct BlockRef { const bf16* Q; const bf16* K; const bf16* V; bf16* O; int P0; };
struct Seam { bf16x8 qr[8]; bf16x8 k0[2], k1[2], v0[2], v1[2], v2[2], v3[2]; };
#define VMW() asm volatile("s_waitcnt vmcnt(0)" ::: "memory")
typedef __amdgpu_buffer_rsrc_t rsrc_t;
__device__ __forceinline__ rsrc_t mkrsrc(const bf16* p) { return __builtin_amdgcn_make_buffer_rsrc((void*)p, (short)0, 0x7fffffff, 0x00020000); }
__device__ __forceinline__ bf16x8 bld16(rsrc_t r, unsigned voff, unsigned soff) { return __builtin_bit_cast(bf16x8, __builtin_amdgcn_raw_buffer_load_b128(r, (int)voff, (int)soff, 0)); }
#define RB(kk_, radd) ((unsigned)(((kk_) + (radd)) * PITCH) * 2u)
#define SLOADK(set, rK_, kk_) do { S.k0[set] = bld16(rK_, lofs, RB(kk_, 0)); S.k1[set] = bld16(rK_, lofs, RB(kk_, 32)); } while (0)
#define SLOADV(set, rV_, kk_) do { S.v0[set] = bld16(rV_, lofs, RB(kk_, 0)); S.v1[set] = bld16(rV_, lofs, RB(kk_, 32)); S.v2[set] = bld16(rV_, lofs, RB(kk_, 0) + 256u); S.v3[set] = bld16(rV_, lofs, RB(kk_, 32) + 256u); } while (0)
#define SWRITE_K(bf, set) do { *LP(bf16x8, K_lds + (bf) * SHM_K + kws) = S.k0[set]; *LP(bf16x8, K_lds + (bf) * SHM_K + kws + 32 * 256) = S.k1[set]; } while (0)
#define SWRITE_V(bf, set) do { *LP(bf16x8, V_lds + (bf) * SHM_V + vst0) = S.v0[set]; *LP(bf16x8, V_lds + (bf) * SHM_V + vst0 + VST1) = S.v1[set]; *LP(bf16x8, V_lds + (bf) * SHM_V + IMG + vst0) = S.v2[set]; *LP(bf16x8, V_lds + (bf) * SHM_V + IMG + vst0 + VST1) = S.v3[set]; } while (0)
__device__ __forceinline__ void attn_prime(const BlockRef& cur, char* lds, Seam& S, int tid) {
    const int wid = __builtin_amdgcn_readfirstlane(tid >> 6), lane = tid & 63, r32 = lane & 31, hi = lane >> 5, pj = wid & 3;
    const int sr = tid >> 4, sc = (tid & 15) * 8, kws = KSWZ(sr, sc * 2); const unsigned K_lds = (unsigned)(uintptr_t)lds + OFF_K, lofs = (unsigned)(sr * PITCH + sc) * 2u, qofs = (unsigned)(r32 * PITCH + hi * 8) * 2u;
    const rsrc_t rQ = mkrsrc(cur.Q), rK = mkrsrc(cur.K), rV = mkrsrc(cur.V);
#pragma unroll
    for (int d0 = 0; d0 < 8; ++d0) S.qr[d0] = bld16(rQ, qofs, (unsigned)((pj * QBLK) * PITCH + d0 * 16) * 2u);
    SLOADK(0, rK, 0); VMW(); SWRITE_K(0, 0); SBAR();
    SLOADK(1, rK, KVBLK); SLOADV(0, rV, 0); SLOADK(0, rK, 2 * KVBLK); SLOADV(1, rV, KVBLK);
    __syncthreads();
}
__device__ __forceinline__ void attn_block(const BlockRef& cur, const BlockRef& nxt, char* lds, Seam& S, int tid) {
    const int wid = __builtin_amdgcn_readfirstlane(tid >> 6), lane = tid & 63, r32 = lane & 31, hi = lane >> 5, pj = wid & 3, kh = wid >> 2, pw = wid ^ 4;
    const int NT = cur.P0 / KVBLK + QB / KVBLK, NTn = nxt.P0 / KVBLK + QB / KVBLK;
    const int qlo = cur.P0 + pj * QBLK, cw = qlo >> 6;
    const unsigned L = (unsigned)(uintptr_t)lds, V_lds = L + OFF_V, K_lds = L + OFF_K;
    L3 float* li_l = LP(float, L + OFF_WS + wid * 256); L3 float* al_l = li_l + 32; const L3 float* li_p = LP(const float, L + OFF_WS + pw * 256);
    L3 float* mx_o = LP(float, L + OFF_MX + wid * 128); const L3 float* mx_p = LP(const float, L + OFF_MX + pw * 128);
    const unsigned px_o = L + OFF_PX + wid * 2048 + lane * 16, px_p = L + OFF_PX + pw * 2048 + lane * 16;
    const L3 float* btab = LP(const float, L + BIAS_OFF);
    float m_reg = -1e30f, l_reg = 0; f32x16 o[4] = {};
    const int sr = tid >> 4, sc = (tid & 15) * 8, vst0 = v_st(sr, sc), kws = KSWZ(sr, sc * 2); constexpr int VST1 = 8192;
    const unsigned lofs = (unsigned)(sr * PITCH + sc) * 2u, qofs = (unsigned)(r32 * PITCH + hi * 8) * 2u;
    const int vbase = (int)V_lds + v_rd_base(lane) + kh * IMG, vbo = vbase + kh * 8192, vbp = vbase + (1 - kh) * 8192;
    const int krow = kh * 32 + r32;
    const rsrc_t cK = mkrsrc(cur.K), cV = mkrsrc(cur.V), nK = mkrsrc(nxt.K), nV = mkrsrc(nxt.V);
    const int bb0 = qlo + r32 - 4 * hi + 4 - 32 * kh;
#define RESC(a) do { if (__any((a) < 1.f)) { if (hi == 0) al_l[r32] = (a); asm volatile("s_waitcnt lgkmcnt(0)" ::: "memory");              \
                     for (int d_ = 0; d_ < 4; ++d_) for (int r = 0; r < 16; ++r) o[d_][r] *= al_l[crow(r, hi)]; } } while (0)
#define KBASE(t) ((t) * KVBLK)
#define ACT(t) ((t) <= cw)
#define BIAST(P_, t) do { if ((t) <= cw && (t) + 2 >= cw) bias_half(P_, btab + (bb0 - KBASE(t))); } while (0)
#define PUTMAX(P_) do { const float pm_ = rowmax_half(P_); if (hi == 0) mx_o[r32] = pm_; pmx = pm_; } while (0)
#define GETMAX() fmaxf(pmx, mx_p[r32])
#define VLOADK(set, v) do { const int v_ = (v); if (v_ < NT) SLOADK(set, cK, KBASE(v_)); else SLOADK(set, nK, KBASE((v_ - NT) % NTn)); } while (0)
#define VLOADV(set, v) do { const int v_ = (v); if (v_ < NT) SLOADV(set, cV, KBASE(v_)); else SLOADV(set, nV, KBASE((v_ - NT) % NTn)); } while (0)
    f32x16 pA, pB; float alA, alB, pmx; bf16x8 po0, po1, pp0, pp1;
#define STEP(PX_, alX, PY_, alY, t, KB, HASPREV) do {                                                                               \
        SBAR(); SWRITE_V(KB, KB); SBAR(); VLOADV(KB, (t) + 2); SBAR();                                                               \
        if (ACT(t)) { bf16x8 kf_[8]; kload<KB>(kf_, K_lds, krow, hi); SBAR(); qmma(PX_, kf_, S.qr);                                  \
                      if (HASPREV) { finishSM(PY_, alY, l_reg, po0, po1); *LP(bf16x8, px_o) = po0; *LP(bf16x8, px_o + 1024) = po1; } SGB_A(); }   \
        else { pneg(PX_); if (HASPREV) { finishSM(PY_, alY, l_reg, po0, po1); *LP(bf16x8, px_o) = po0; *LP(bf16x8, px_o + 1024) = po1; } }        \
        SBAR(); BIAST(PX_, (t)); PUTMAX(PX_);                                                                                       \
        __syncthreads();                                                                                                           \
        if (HASPREV) { pp0 = *LP(const bf16x8, px_p); pp1 = *LP(const bf16x8, px_p + 1024); }                                        \
        partialSM(PX_, GETMAX(), m_reg, alX);                                                                                      \
        if (HASPREV) pv_tile<1 - KB>(o, vbo, vbp, po0, po1, pp0, pp1, ACT((t) - 1));                                                \
        SBAR(); SWRITE_K(1 - KB, 1 - KB); SBAR(); VLOADK(1 - KB, (t) + 3); SBAR();                                                   \
        RESC(alX); __syncthreads(); } while (0)
    for (int t = 0; t < NT; t += 2) {
        STEP(pA, alA, pB, alB, t, 0, t > 0);
        STEP(pB, alB, pA, alA, t + 1, 1, true);
    }
    { const rsrc_t nQ = mkrsrc(nxt.Q);
#pragma unroll
      for (int d0 = 0; d0 < 8; ++d0) S.qr[d0] = bld16(nQ, qofs, (unsigned)((pj * QBLK) * PITCH + d0 * 16) * 2u); }
    SBAR();
    finishSM(pB, alB, l_reg, po0, po1); *LP(bf16x8, px_o) = po0; *LP(bf16x8, px_o + 1024) = po1;
    if (hi == 0) li_l[r32] = l_reg;
    __syncthreads();
    pp0 = *LP(const bf16x8, px_p); pp1 = *LP(const bf16x8, px_p + 1024);
    pv_tile<1>(o, vbo, vbp, po0, po1, pp0, pp1, ACT(NT - 1));
    float rli[16];
#pragma unroll
    for (int r = 0; r < 16; ++r) rli[r] = __builtin_amdgcn_rcpf(li_l[crow(r, hi)] + li_p[crow(r, hi)]);
    int lane_off = hi * 4 * PITCH + r32; asm volatile("" : "+v"(lane_off));
    bf16* Ow = cur.O + ((pj * QBLK) * PITCH + kh * 128 + lane_off);
#pragma unroll
    for (int r = 0; r < 16; ++r) { const int orow = (r & 3) + 8 * (r >> 2);
#pragma unroll
        for (int d0 = 0; d0 < 4; ++d0) { const float v = o[d0][r] * rli[r];
            const float vn = __shfl_xor(v, 1);
            if ((r32 & 1) == 0) *(unsigned*)(Ow + (orow * PITCH + d0 * 32)) = cvtpk(v, vn); } }
    __syncthreads();
#undef RESC
#undef KBASE
#undef ACT
#undef BIAST
#undef PUTMAX
#undef GETMAX
#undef VLOADK
#undef VLOADV
#undef STEP
}
#undef SLOADK
#undef SLOADV
#undef SWRITE_K
#undef SWRITE_V
#undef VMW
#undef RB
#undef KSWZ
#undef L3
#undef LP
#undef SGB_A
}


constexpr int NWAVES = 8;
constexpr int BATCH = 16, SEQ = 2048, T = BATCH * SEQ, D = 1024, NIN = 8192, NE = 32, DE = 512;
constexpr int MAXT = 288, MAXS = MAXT * 256;
constexpr float LN_EPS = 1e-5f, RMS_EPS = 1e-6f, ALPHA = 1.189207115002721f, LAM_INIT = 0.2f;
constexpr size_t MiB = 1u << 20;
constexpr size_t WS_CTL = 0, CTL_ZERO_BYTES = 1 * MiB;
constexpr size_t WS_STATS = 1 * MiB, WS_EID = WS_STATS + 256 * 1024, WS_EW = WS_EID + 256 * 1024, WS_RANK = WS_EW + 256 * 1024, WS_SLOT = 2 * MiB, WS_CNTWG = WS_SLOT + 256 * 1024, WS_TOK = 3 * MiB;
constexpr size_t WS_WA = 4 * MiB, WS_WB = 6 * MiB, WS_WO = 8 * MiB, WS_WIN = 10 * MiB;
constexpr size_t WS_XN = 26 * MiB, WS_Q = 90 * MiB, WS_K = 154 * MiB, WS_V = 218 * MiB, WS_CB = 282 * MiB, WS_Z = 346 * MiB, WS_O1 = 410 * MiB;
constexpr size_t WS_WGU = 90 * MiB, WS_WD = 154 * MiB, WS_PRE = 186 * MiB, WS_XG = 314 * MiB, WS_END = 458 * MiB;
constexpr int CW_TMO = 0, CW_CODE = 1, CW_BAR = 4096, CW_MOE = 65536;
constexpr int RING_OFF = 0, RING_BYTES = 131072, RW_BYTES = 147456;
constexpr int LDSCTL_OFF = RW_BYTES, MISC_OFF = LDSCTL_OFF + 320, TAB_OFF = LDSCTL_OFF + 512, RSCR_OFF = LDSCTL_OFF + 1024;
constexpr int LDS_BYTES = 163840;
static_assert(RSCR_OFF + 8 * 128 * 4 + 1024 <= LDS_BYTES, "LDS map");

#define GAS __attribute__((address_space(1)))
#define LAS __attribute__((address_space(3)))
typedef unsigned short bf16;
#ifdef SWAP_CB_SGA
#define BUF_CB(P)  ((bf16*)(P).out)
#define BUF_SGA(P) ((bf16*)((P).ws + WS_CB))
#else
#define BUF_CB(P)  ((bf16*)((P).ws + WS_CB))
#define BUF_SGA(P) ((bf16*)(P).out)
#endif
#define BUF_SGB(P) ((bf16*)(P).out + (size_t)T * D)
typedef unsigned v4u __attribute__((ext_vector_type(4)));
typedef unsigned v2u __attribute__((ext_vector_type(2)));
typedef float f32x4 __attribute__((ext_vector_type(4)));
typedef GAS unsigned gu32;
#define RLX_AGENT __ATOMIC_RELAXED, __HIP_MEMORY_SCOPE_AGENT
#define LDS_WAIT() asm volatile("s_waitcnt lgkmcnt(0)" ::: "memory")
#define VM_WAIT() asm volatile("s_waitcnt vmcnt(0)" ::: "memory")
__device__ __forceinline__ unsigned f2bf(float f) { unsigned u = __builtin_bit_cast(unsigned, f); return (u + 0x7fffu + ((u >> 16) & 1u)) >> 16; }
__device__ __forceinline__ unsigned pk2(float lo, float hi) { return f2bf(lo) | (f2bf(hi) << 16); }
__device__ __forceinline__ float bflo(unsigned w) { return __uint_as_float(w << 16); }
__device__ __forceinline__ float bfhi(unsigned w) { return __uint_as_float(w & 0xffff0000u); }

#define XB_TMO      128
#define XB_XCNT(j)  (256  + 64 * (j))
#define XB_XSUB(j)  (1280 + 64 * (j))
#define XB_XGEN(j)  (2304 + 64 * (j))
#define XB_TOP      3328
#define XB_TOPGEN   3392
#define XCD_BAR_WORDS 3456
#define XB_SPIN_CAP (1u << 18)
__device__ __forceinline__ unsigned xb_ld(unsigned* p)              { return __hip_atomic_load(p, __ATOMIC_RELAXED, __HIP_MEMORY_SCOPE_AGENT); }
__device__ __forceinline__ unsigned xb_add(unsigned* p, unsigned v) { return __hip_atomic_fetch_add(p, v, __ATOMIC_RELAXED, __HIP_MEMORY_SCOPE_AGENT); }
__device__ __forceinline__ unsigned xb_xcc_id() { return (unsigned)__builtin_amdgcn_s_getreg((3 << 11) | 20) & 0xFu; }
#define XB_SPIN(cond, bar) do { unsigned _sp = 0; while (cond) { __builtin_amdgcn_s_sleep(1); \
    if ((++_sp & 255u) == 0u) { if (xb_ld(&(bar)[XB_TMO])) break; if (_sp > XB_SPIN_CAP) { atomicAdd(&(bar)[XB_TMO], 1u); break; } } } } while (0)
struct XcdBarrier { unsigned* bar; unsigned x; volatile LAS unsigned* st; };
__device__ __forceinline__ XcdBarrier xcd_barrier_post(unsigned* bar, volatile LAS unsigned* st) {
    XcdBarrier b; b.bar = bar; b.x = xb_xcc_id(); b.st = st;
    if (threadIdx.x == 0) (void)xb_add(&bar[XB_XCNT(b.x)], 1u);
    return b;
}
__device__ __forceinline__ void xcd_barrier_complete(unsigned* bar, unsigned x, unsigned& nloc, unsigned& nx) {
    const unsigned G = gridDim.x * gridDim.y * gridDim.z;
    unsigned sum, cnt, mine, sp = 0u;
    for (;;) {
        sum = 0u; cnt = 0u; mine = 0u;
#pragma unroll
        for (unsigned j = 0; j < 16; ++j) { const unsigned c = xb_ld(&bar[XB_XCNT(j)]); sum += c; cnt += (c > 0u) ? 1u : 0u; mine = (j == x) ? c : mine; }
        if (sum == G) break;
        __builtin_amdgcn_s_sleep(1);
        if ((++sp & 255u) == 0u) { if (xb_ld(&bar[XB_TMO])) break; if (sp > XB_SPIN_CAP) { atomicAdd(&bar[XB_TMO], 1u); break; } }
    }
    nloc = mine > 0u ? mine : 1u; nx = cnt > 0u ? cnt : 1u;
}
__device__ __forceinline__ void xcd_barrier(const XcdBarrier& b) {
    asm volatile("s_waitcnt vmcnt(0)" ::: "memory");
    __syncthreads();
    if (threadIdx.x == 0) {
        unsigned* bar = b.bar;
        __builtin_amdgcn_s_waitcnt(0);
        unsigned nloc = b.st[0], nx = b.st[1];
        if (nloc == 0u) { xcd_barrier_complete(bar, b.x, nloc, nx); b.st[0] = nloc; b.st[1] = nx; }
        const unsigned old = xb_add(&bar[XB_XSUB(b.x)], 1u);
        const unsigned gen = old / nloc;
        if (old + 1u == (gen + 1u) * nloc) {
            __builtin_amdgcn_fence(__ATOMIC_RELEASE, "agent");
            asm volatile("s_waitcnt vmcnt(0)" ::: "memory");
            const unsigned og = xb_add(&bar[XB_TOP], 1u);
            const unsigned tg = og / nx;
            if (og + 1u == (tg + 1u) * nx) xb_add(&bar[XB_TOPGEN], 1u);
            else XB_SPIN(xb_ld(&bar[XB_TOPGEN]) == tg, bar);
            __builtin_amdgcn_fence(__ATOMIC_ACQUIRE, "agent");
            xb_add(&bar[XB_XGEN(b.x)], 1u);
            asm volatile("s_waitcnt vmcnt(0)" ::: "memory");
        } else {
            XB_SPIN(xb_ld(&bar[XB_XGEN(b.x)]) == gen, bar);
            __builtin_amdgcn_fence(__ATOMIC_ACQUIRE, "agent");
            asm volatile("s_waitcnt vmcnt(0)" ::: "memory");
        }
    }
    __syncthreads();
}

struct Frame {
    LAS unsigned char* lds; volatile LAS unsigned* MISC; gu32* ctl;
    int tid, lane, wave, vcu, G;
};
__device__ __forceinline__ float wave_sum(float v) {
#pragma unroll
    for (int o = 1; o < 64; o <<= 1) v += __shfl_xor(v, o);
    return v;
}
__device__ __forceinline__ float wave_sum_fast(float v) {
    v += __int_as_float(__builtin_amdgcn_update_dpp(0, __float_as_int(v), 0x128, 0xf, 0xf, false));
    v += __int_as_float(__builtin_amdgcn_update_dpp(0, __float_as_int(v), 0x124, 0xf, 0xf, false));
    v += __int_as_float(__builtin_amdgcn_update_dpp(0, __float_as_int(v), 0x122, 0xf, 0xf, false));
    v += __int_as_float(__builtin_amdgcn_update_dpp(0, __float_as_int(v), 0x121, 0xf, 0xf, false));
    const int vi = __float_as_int(v);
    return (__int_as_float(__builtin_amdgcn_readlane(vi, 0)) + __int_as_float(__builtin_amdgcn_readlane(vi, 16))) + (__int_as_float(__builtin_amdgcn_readlane(vi, 32)) + __int_as_float(__builtin_amdgcn_readlane(vi, 48)));
}
__device__ __forceinline__ void transpose_item(const float* W, int K, int N, int k0, int n0, bf16* WT, int drow0, LAS float* scr, int lane) {
#pragma unroll 8
    for (int i = 0; i < 32; ++i) { const int kk = 2 * i + (lane >> 5); scr[kk * 33 + (lane & 31)] = W[(size_t)(k0 + kk) * N + n0 + (lane & 31)]; }
    LDS_WAIT(); asm volatile("" ::: "memory");
    const int c = lane & 7;
#pragma unroll
    for (int j = 0; j < 4; ++j) { const int n = (lane >> 3) + 8 * j; const LAS float* s = scr + (8 * c) * 33 + n;
        v4u o; o.x = pk2(s[0 * 33], s[1 * 33]); o.y = pk2(s[2 * 33], s[3 * 33]); o.z = pk2(s[4 * 33], s[5 * 33]); o.w = pk2(s[6 * 33], s[7 * 33]);
        *(GAS v4u*)(WT + (size_t)(drow0 + n) * K + k0 + 8 * c) = o; }
    LDS_WAIT(); asm volatile("" ::: "memory");
}
__device__ __forceinline__ int win_drow(int n0) {
    if (n0 < 4096 || n0 >= 6144) return n0;
    if (n0 < 5120) { const int r = n0 - 4096; return 4096 + 256 * (r >> 7) + (r & 127); }
    const int r = n0 - 5120; return 4096 + 256 * (r >> 7) + 128 + (r & 127);
}
struct Ptrs {
    const float *x, *ln_in_g, *ln_in_b, *w_in, *b_gate, *lq, *lk, *subln_g, *rel_bias, *conv_w, *w_a, *w_b, *w_o, *ln1_g, *ln1_b, *w_group, *b_group, *w_sub, *b_sub, *w_gate_e, *w_up_e, *w_down_e, *ln2_g, *ln2_b;
    float* out; unsigned char* ws;
};
__device__ __forceinline__ void p0_prologue(Frame& F, const Ptrs& P) {
    LAS float* scr = (LAS float*)(F.lds + RING_OFF + F.wave * 16384);
    const int gw = F.vcu * NWAVES + F.wave, NGW = F.G * NWAVES;
    constexpr int I_IN = (D / 64) * (NIN / 32), I_SQ = (D / 64) * (D / 32);
    bf16* Wt_in = (bf16*)(P.ws + WS_WIN); bf16* Wt_a = (bf16*)(P.ws + WS_WA); bf16* Wt_b = (bf16*)(P.ws + WS_WB); bf16* Wt_o = (bf16*)(P.ws + WS_WO);
    for (int it = gw; it < I_IN + 3 * I_SQ; it += NGW) {
        int r = it;
        if (r < I_IN) { const int kb = r / (NIN / 32), nb = r % (NIN / 32); transpose_item(P.w_in, D, NIN, 64 * kb, 32 * nb, Wt_in, win_drow(32 * nb), scr, F.lane); continue; } r -= I_IN;
        const int which = r / I_SQ; r -= which * I_SQ; const int kb = r / (D / 32), nb = r % (D / 32);
        const float* W = which == 0 ? P.w_a : (which == 1 ? P.w_b : P.w_o); bf16* WT = which == 0 ? Wt_a : (which == 1 ? Wt_b : Wt_o);
        transpose_item(W, D, D, 64 * kb, 32 * nb, WT, 32 * nb, scr, F.lane);
    }
    bf16* XN = (bf16*)(P.ws + WS_XN); float* stats = (float*)(P.ws + WS_STATS);
    for (int m = gw; m < T; m += NGW) {
        const GAS f32x4* xr = (const GAS f32x4*)(P.x + (size_t)m * D) + F.lane;
        f32x4 v[4]; float s = 0.f;
#pragma unroll
        for (int j = 0; j < 4; ++j) { v[j] = xr[64 * j]; s += (v[j].x + v[j].y) + (v[j].z + v[j].w); }
        const float mean = wave_sum(s) * (1.f / D); float s2 = 0.f;
#pragma unroll
        for (int j = 0; j < 4; ++j) { v[j] = v[j] - mean; s2 += (v[j].x * v[j].x + v[j].y * v[j].y) + (v[j].z * v[j].z + v[j].w * v[j].w); }
        const float rstd = 1.f / sqrtf(wave_sum(s2) * (1.f / D) + LN_EPS);
        GAS unsigned long long* o8 = (GAS unsigned long long*)(XN + (size_t)m * D) + F.lane;
#pragma unroll
        for (int j = 0; j < 4; ++j) { const f32x4 g = *((const GAS f32x4*)P.ln_in_g + F.lane + 64 * j), b = *((const GAS f32x4*)P.ln_in_b + F.lane + 64 * j); const f32x4 y = v[j] * rstd * g + b;
            o8[64 * j] = (unsigned long long)pk2(y.x, y.y) | ((unsigned long long)pk2(y.z, y.w) << 32); }
        if (F.lane == 0) { stats[2 * m] = mean; stats[2 * m + 1] = rstd; }
    }
}
__device__ __forceinline__ void p2_conv(Frame& F, const Ptrs& P) {
    bf16* CB = BUF_CB(P); const bf16* Z = (const bf16*)(P.ws + WS_Z);
    const int gw = F.vcu * NWAVES + F.wave, NGW = F.G * NWAVES, c0 = 16 * F.lane;
    float w0[16], w1[16], w2[16];
#pragma unroll
    for (int i = 0; i < 16; ++i) { w0[i] = P.conv_w[c0 + i]; w1[i] = P.conv_w[D + c0 + i]; w2[i] = P.conv_w[2 * D + c0 + i]; }
    for (int ch = gw; ch < T / 16; ch += NGW) {
        const int r0 = ch * 16; float z2[16], z1[16];
        if ((r0 & (SEQ - 1)) == 0) {
#pragma unroll
            for (int i = 0; i < 16; ++i) { z2[i] = 0.f; z1[i] = 0.f; }
        } else {
            const v4u a0 = *(const GAS v4u*)(Z + (size_t)(r0 - 2) * D + c0), a1 = *(const GAS v4u*)(Z + (size_t)(r0 - 2) * D + c0 + 8), b0 = *(const GAS v4u*)(Z + (size_t)(r0 - 1) * D + c0), b1 = *(const GAS v4u*)(Z + (size_t)(r0 - 1) * D + c0 + 8);
#pragma unroll
            for (int i = 0; i < 4; ++i) { z2[2 * i] = bflo(a0[i]); z2[2 * i + 1] = bfhi(a0[i]); z2[8 + 2 * i] = bflo(a1[i]); z2[8 + 2 * i + 1] = bfhi(a1[i]);
                                          z1[2 * i] = bflo(b0[i]); z1[2 * i + 1] = bfhi(b0[i]); z1[8 + 2 * i] = bflo(b1[i]); z1[8 + 2 * i + 1] = bfhi(b1[i]); }
        }
#pragma unroll 2
        for (int rr = 0; rr < 16; ++rr) { const size_t off = (size_t)(r0 + rr) * D + c0;
            const v4u za = *(const GAS v4u*)(Z + off), zb = *(const GAS v4u*)(Z + off + 8), ca = *(const GAS v4u*)(CB + off), cb = *(const GAS v4u*)(CB + off + 8);
            float zc[16], cv[16];
#pragma unroll
            for (int i = 0; i < 4; ++i) { zc[2 * i] = bflo(za[i]); zc[2 * i + 1] = bfhi(za[i]); zc[8 + 2 * i] = bflo(zb[i]); zc[8 + 2 * i + 1] = bfhi(zb[i]);
                                          cv[2 * i] = bflo(ca[i]); cv[2 * i + 1] = bfhi(ca[i]); cv[8 + 2 * i] = bflo(cb[i]); cv[8 + 2 * i + 1] = bfhi(cb[i]); }
            float u[16];
#pragma unroll
            for (int i = 0; i < 16; ++i) { u[i] = cv[i] * (z2[i] * w0[i] + z1[i] * w1[i] + zc[i] * w2[i]); z2[i] = z1[i]; z1[i] = zc[i]; }
            v4u oa, ob;
#pragma unroll
            for (int i = 0; i < 4; ++i) { oa[i] = pk2(u[2 * i], u[2 * i + 1]); ob[i] = pk2(u[8 + 2 * i], u[8 + 2 * i + 1]); }
            *(GAS v4u*)(CB + off) = oa; *(GAS v4u*)(CB + off + 8) = ob; }
    }
}
__device__ __forceinline__ attn::BlockRef attn_ref(const Ptrs& P, int s, int qb) {
    const int vh = s & 1, m = (s >> 1) & 1, h = (s >> 2) & 3, b = s >> 4;
    attn::BlockRef r; const size_t rowb = (size_t)b * SEQ * D;
    r.Q = (const bf16*)(P.ws + WS_Q) + rowb + (size_t)qb * 256 * D + h * 256 + m * 128;
    r.K = (const bf16*)(P.ws + WS_K) + rowb + h * 256 + m * 128;
    r.V = (const bf16*)(P.ws + WS_V) + rowb + h * 256 + vh * 128;
    r.O = (bf16*)(P.ws + (m ? WS_O1 : WS_XN)) + rowb + (size_t)qb * 256 * D + h * 256 + vh * 128;
    r.P0 = qb * 256; return r;
}
#ifndef P1_ALIGN
#define P1_ALIGN true
#endif
#ifndef P1_SP2
#define P1_SP2 true
#endif
#ifndef ATTN_PAIR
#define ATTN_PAIR 1
#endif
__device__ __forceinline__ attn2::BlockRef attn2_ref(const Ptrs& P, int st, int qb) {
    const int m = st & 1, h = (st >> 1) & 3, b = st >> 3;
    attn2::BlockRef r; const size_t rowb = (size_t)b * SEQ * D;
    r.Q = (const bf16*)(P.ws + WS_Q) + rowb + (size_t)qb * 128 * D + h * 256 + m * 128;
    r.K = (const bf16*)(P.ws + WS_K) + rowb + h * 256 + m * 128;
    r.V = (const bf16*)(P.ws + WS_V) + rowb + h * 256;
    r.O = (bf16*)(P.ws + (m ? WS_O1 : WS_XN)) + rowb + (size_t)qb * 128 * D + h * 256;
    r.P0 = qb * 128; return r;
}
__device__ __forceinline__ void p2_attention2(Frame& F, const Ptrs& P, char* lds) {
    float* btab = (float*)(lds + attn2::BIAS_OFF);
    for (int s2 = F.vcu; s2 < BATCH * 16; s2 += F.G) {
        const int st = s2 >> 1, half = s2 & 1, h = (st >> 1) & 3;
        __syncthreads();
        if (F.tid < attn2::NBIAS) { const int rel = 63 - F.tid; btab[F.tid] = (P.rel_bias[attn2::t5_bucket(rel) * 4 + h] - P.rel_bias[15 * 4 + h]) * (1.0f / attn2::SCALE); }
        __syncthreads();
#define QB_OF(i) (2 * (7 - (i)) + (((7 - (i)) & 1) ^ half))
        int tid_ = threadIdx.x; asm volatile("" : "+v"(tid_));
        attn2::Seam S; attn2::BlockRef cur = attn2_ref(P, st, QB_OF(0));
        attn2::attn_prime(cur, lds, S, tid_);
#pragma unroll 1
        for (int i = 0; i < 8; ++i) {
            const attn2::BlockRef nxt = (i < 7) ? attn2_ref(P, st, QB_OF(i + 1)) : cur;
            attn2::attn_block(cur, nxt, lds, S, tid_);
            cur = nxt;
        }
#undef QB_OF
    }
}
__device__ __forceinline__ void p2_attention(Frame& F, const Ptrs& P, char* lds) {
    float* btab = (float*)(lds + attn::BIAS_OFF);
    for (int s = F.vcu; s < BATCH * 16; s += F.G) {
        const int h = (s >> 2) & 3;
        __syncthreads();
        if (F.tid < attn::NBIAS) { const int rel = 63 - F.tid; btab[F.tid] = (P.rel_bias[attn::t5_bucket(rel) * 4 + h] - P.rel_bias[15 * 4 + h]) * (1.0f / attn::SCALE); }
        __syncthreads();
        attn::Seam S; attn::BlockRef cur = attn_ref(P, s, 0);
        attn::attn_prime(cur, lds, S);
#pragma unroll 1
        for (int qb = 0; qb < 8; ++qb) {
            const attn::BlockRef nxt = (qb < 7) ? attn_ref(P, s, qb + 1) : cur;
            attn::attn_block(cur, nxt, lds, S);
            cur = nxt;
        }
    }
}
__device__ __forceinline__ void p2b_combine(Frame& F, const Ptrs& P) {
    bf16* O0 = (bf16*)(P.ws + WS_XN); const bf16* O1 = (const bf16*)(P.ws + WS_O1);
    const int gw = F.vcu * NWAVES + F.wave, NGW = F.G * NWAVES, c0 = 16 * F.lane;
    const float l0 = wave_sum(P.lq[F.lane] * P.lk[F.lane] + P.lq[64 + F.lane] * P.lk[64 + F.lane]), l1 = wave_sum(P.lq[128 + F.lane] * P.lk[128 + F.lane] + P.lq[192 + F.lane] * P.lk[192 + F.lane]);
    const float lam = expf(l0) - expf(l1) + LAM_INIT;
    float g[16];
#pragma unroll
    for (int i = 0; i < 16; ++i) g[i] = P.subln_g[(c0 & 255) + i] * (1.f - LAM_INIT);
    for (int m = gw; m < T; m += NGW) { const size_t off = (size_t)m * D + c0;
        const v4u a0 = *(const GAS v4u*)(O0 + off), a1 = *(const GAS v4u*)(O0 + off + 8), b0 = *(const GAS v4u*)(O1 + off), b1 = *(const GAS v4u*)(O1 + off + 8);
        float d[16]; float ss = 0.f;
#pragma unroll
        for (int i = 0; i < 4; ++i) { d[2 * i] = bflo(a0[i]) - lam * bflo(b0[i]); d[2 * i + 1] = bfhi(a0[i]) - lam * bfhi(b0[i]); d[8 + 2 * i] = bflo(a1[i]) - lam * bflo(b1[i]); d[8 + 2 * i + 1] = bfhi(a1[i]) - lam * bfhi(b1[i]); }
#pragma unroll
        for (int i = 0; i < 16; ++i) ss += d[i] * d[i];
        ss += __shfl_xor(ss, 1); ss += __shfl_xor(ss, 2); ss += __shfl_xor(ss, 4); ss += __shfl_xor(ss, 8);
        const float rs = 1.f / sqrtf(ss * (1.f / 256.f) + RMS_EPS);
        v4u oa, ob;
#pragma unroll
        for (int i = 0; i < 4; ++i) { oa[i] = pk2(d[2 * i] * rs * g[2 * i], d[2 * i + 1] * rs * g[2 * i + 1]); ob[i] = pk2(d[8 + 2 * i] * rs * g[8 + 2 * i], d[8 + 2 * i + 1] * rs * g[8 + 2 * i + 1]); }
        *(GAS v4u*)(O0 + off) = oa; *(GAS v4u*)(O0 + off + 8) = ob; }
}
__device__ __forceinline__ void pe_experts(Frame& F, const Ptrs& P) {
    LAS float* scr = (LAS float*)(F.lds + RING_OFF + F.wave * 16384);
    const int gw = F.vcu * NWAVES + F.wave, NGW = F.G * NWAVES;
    bf16* Wgu = (bf16*)(P.ws + WS_WGU); bf16* Wd = (bf16*)(P.ws + WS_WD);
    constexpr int I_GU = (D / 64) * (DE / 32), I_DN = (DE / 64) * (D / 32);
    for (int it = gw; it < NE * (2 * I_GU + I_DN); it += NGW) {
        const int e = it / (2 * I_GU + I_DN); int r = it - e * (2 * I_GU + I_DN);
        if (r < 2 * I_GU) { const int up = r >= I_GU; r -= up * I_GU; const int kb = r / (DE / 32), nb = r % (DE / 32), n0 = 32 * nb;
            transpose_item((up ? P.w_up_e : P.w_gate_e) + (size_t)e * D * DE, D, DE, 64 * kb, n0, Wgu + (size_t)e * 1024 * D, 256 * (n0 >> 7) + 128 * up + (n0 & 127), scr, F.lane); }
        else { r -= 2 * I_GU; const int kb = r / (D / 32), nb = r % (D / 32);
            transpose_item(P.w_down_e + (size_t)e * DE * D, DE, D, 64 * kb, 32 * nb, Wd + (size_t)e * D * DE, 32 * nb, scr, F.lane); }
    }
}
__device__ __forceinline__ void p5_ln_route(Frame& F, const Ptrs& P) {
    LAS float* RW = (LAS float*)(F.lds + RING_OFF);
    LAS int* lcnt = (LAS int*)(F.lds + TAB_OFF);
    LAS float* rs = (LAS float*)(F.lds + RSCR_OFF) + F.wave * 128;
    for (int idx = F.tid; idx < D * 36; idx += NWAVES * 64) { const int d = idx / 36, o = idx - d * 36; float w;
        if (o < 4) w = P.w_group[d * 4 + o]; else { const int g = (o - 4) >> 3, e = (o - 4) & 7; w = P.w_sub[((size_t)g * D + d) * 8 + e]; }
        const int j = d >> 8, l = (d & 255) >> 2, i = d & 3, c = o >> 2, k = o & 3;
        RW[((((j * 4 + i) * 9 + c) * 64 + l) << 2) + k] = w; }
    if (F.tid < 32) lcnt[F.tid] = 0;
    __syncthreads();
    float* pre = (float*)(P.ws + WS_PRE); bf16* x1b = (bf16*)(P.ws + WS_XN);
    int* eid = (int*)(P.ws + WS_EID); float* ew = (float*)(P.ws + WS_EW); int* rank = (int*)(P.ws + WS_RANK);
    const int rows_per_wg = T / F.G, rbase = blockIdx.x * rows_per_wg;
    static_assert(pg8::PRE_BF16, "the pipelined LN1/routing loop reads bf16 pre");
    v2u raw[2][4];
#define P5_LOADPAIR(rp_) do { _Pragma("unroll") for (int r = 0; r < 2; ++r) { const GAS v2u* pr = (const GAS v2u*)((const bf16*)pre + (size_t)(rbase + (rp_) + r) * D) + F.lane; \
        _Pragma("unroll") for (int j = 0; j < 4; ++j) raw[r][j] = pr[64 * j]; } } while (0)
    if (F.wave * 2 < rows_per_wg) P5_LOADPAIR(F.wave * 2);
    for (int rp = F.wave * 2; rp < rows_per_wg; rp += NWAVES * 2) {
        f32x4 xv[2][4];
#pragma unroll
        for (int r = 0; r < 2; ++r) { const int row = rbase + rp + r;
            f32x4 v[4]; float s = 0.f;
#pragma unroll
            for (int j = 0; j < 4; ++j) { const v2u w = raw[r][j]; v[j] = (f32x4){bflo(w.x), bfhi(w.x), bflo(w.y), bfhi(w.y)}; s += (v[j].x + v[j].y) + (v[j].z + v[j].w); }
            const float mean = wave_sum_fast(s) * (1.f / D); float s2 = 0.f;
#pragma unroll
            for (int j = 0; j < 4; ++j) { v[j] = v[j] - mean; s2 += (v[j].x * v[j].x + v[j].y * v[j].y) + (v[j].z * v[j].z + v[j].w * v[j].w); }
            const float rstd = 1.f / sqrtf(wave_sum_fast(s2) * (1.f / D) + LN_EPS);
            GAS unsigned long long* o8 = (GAS unsigned long long*)(x1b + (size_t)row * D) + F.lane;
#pragma unroll
            for (int j = 0; j < 4; ++j) { const f32x4 g = *((const GAS f32x4*)P.ln1_g + F.lane + 64 * j), b = *((const GAS f32x4*)P.ln1_b + F.lane + 64 * j); const f32x4 y = v[j] * rstd * g + b;
                xv[r][j] = y; o8[64 * j] = (unsigned long long)pk2(y.x, y.y) | ((unsigned long long)pk2(y.z, y.w) << 32); } }
        if (rp + NWAVES * 2 < rows_per_wg) P5_LOADPAIR(rp + NWAVES * 2);
        f32x4 acc[2][9];
#pragma unroll
        for (int r = 0; r < 2; ++r)
#pragma unroll
            for (int c = 0; c < 9; ++c) acc[r][c] = (f32x4){0.f, 0.f, 0.f, 0.f};
        asm volatile("" ::: "memory"); __builtin_amdgcn_sched_barrier(0);
#pragma unroll
        for (int j = 0; j < 4; ++j)
#pragma unroll
            for (int i = 0; i < 4; ++i)
                { const LAS f32x4* wp = (const LAS f32x4*)(RW + (((j * 4 + i) * 9 * 64 + F.lane) << 2));
#pragma unroll
                  for (int c = 0; c < 9; ++c) { const f32x4 w = wp[c * 64]; acc[0][c] += w * xv[0][j][i]; acc[1][c] += w * xv[1][j][i]; }
                  asm volatile("" : "+v"(acc[0][0]), "+v"(acc[0][1]), "+v"(acc[0][2]), "+v"(acc[0][3]), "+v"(acc[0][4]), "+v"(acc[0][5]), "+v"(acc[0][6]), "+v"(acc[0][7]), "+v"(acc[0][8]) :: "memory");
                  asm volatile("" : "+v"(acc[1][0]), "+v"(acc[1][1]), "+v"(acc[1][2]), "+v"(acc[1][3]), "+v"(acc[1][4]), "+v"(acc[1][5]), "+v"(acc[1][6]), "+v"(acc[1][7]), "+v"(acc[1][8]) :: "memory");
                  __builtin_amdgcn_sched_barrier(0); }
        { float Y[36];
#pragma unroll
          for (int k = 0; k < 36; ++k) { const int i0 = 2 * k, i1 = 2 * k + 1;
              const auto rr = __builtin_amdgcn_permlane32_swap(__float_as_uint(acc[i0 / 36][(i0 % 36) >> 2][i0 & 3]), __float_as_uint(acc[i1 / 36][(i1 % 36) >> 2][i1 & 3]), false, false);
              Y[k] = __uint_as_float(rr[0]) + __uint_as_float(rr[1]); }
          float Z[18];
#pragma unroll
          for (int m = 0; m < 18; ++m) { const auto rr = __builtin_amdgcn_permlane16_swap(__float_as_uint(Y[2 * m]), __float_as_uint(Y[2 * m + 1]), false, false);
              Z[m] = __uint_as_float(rr[0]) + __uint_as_float(rr[1]); }
#pragma unroll
          for (int m = 0; m < 18; ++m) {
              Z[m] += __int_as_float(__builtin_amdgcn_update_dpp(0, __float_as_int(Z[m]), 0x128, 0xf, 0xf, false));
              Z[m] += __int_as_float(__builtin_amdgcn_update_dpp(0, __float_as_int(Z[m]), 0x124, 0xf, 0xf, false));
              Z[m] += __int_as_float(__builtin_amdgcn_update_dpp(0, __float_as_int(Z[m]), 0x122, 0xf, 0xf, false));
              Z[m] += __int_as_float(__builtin_amdgcn_update_dpp(0, __float_as_int(Z[m]), 0x121, 0xf, 0xf, false)); }
          const int rho = F.lane >> 4, pr = ((rho & 1) << 1) | (rho >> 1);
          if ((F.lane & 15) == 0) {
#pragma unroll
              for (int m = 0; m < 18; ++m) { const int idx = 4 * m + pr; rs[idx >= 36 ? idx + 28 : idx] = Z[m]; } } }
        LDS_WAIT(); asm volatile("" ::: "memory");
        if (F.lane < 2) { const int r = F.lane, row = rbase + rp + r; const LAS float* sa = rs + r * 64;
            float gmax = sa[0] + P.b_group[0]; int gi = 0;
            for (int g = 1; g < 4; ++g) { const float v = sa[g] + P.b_group[g]; if (v > gmax) { gmax = v; gi = g; } }
            float z = 0.f;
            for (int g = 0; g < 4; ++g) z += expf(sa[g] + P.b_group[g] - gmax);
            const float gp = 1.f / z;
            const LAS float* sl = sa + 4 + gi * 8; const float* bs = P.b_sub + gi * 8;
            float b0 = sl[0] + bs[0]; int i0 = 0;
            for (int e = 1; e < 8; ++e) { const float v = sl[e] + bs[e]; if (v > b0) { b0 = v; i0 = e; } }
            float b1 = -__builtin_inff(); int i1 = 0;
            for (int e = 0; e < 8; ++e) { const float v = sl[e] + bs[e]; if (e != i0 && v > b1) { b1 = v; i1 = e; } }
            const float e1 = expf(b1 - b0); const float w0 = gp / (1.f + e1), w1 = gp * e1 / (1.f + e1);
            const int ex0 = gi * 8 + i0, ex1 = gi * 8 + i1;
            eid[row * 2] = ex0; eid[row * 2 + 1] = ex1; ew[row * 2] = w0; ew[row * 2 + 1] = w1;
            rank[row * 2] = __hip_atomic_fetch_add(lcnt + ex0, 1, __ATOMIC_RELAXED, __HIP_MEMORY_SCOPE_WORKGROUP);
            rank[row * 2 + 1] = __hip_atomic_fetch_add(lcnt + ex1, 1, __ATOMIC_RELAXED, __HIP_MEMORY_SCOPE_WORKGROUP); }
        LDS_WAIT(); asm volatile("" ::: "memory");
    }
    __syncthreads();
    if (F.tid < 32) ((int*)(P.ws + WS_CNTWG))[blockIdx.x * 32 + F.tid] = lcnt[F.tid];
}
__device__ __forceinline__ void moe_tab(Frame& F, const Ptrs& P) {
    LAS int* tab = (LAS int*)(F.lds + TAB_OFF);
    const int* cntwg = (const int*)(P.ws + WS_CNTWG);
    __syncthreads();
    if (F.tid < 32) { int tot = 0, base = 0;
        for (int w = 0; w < F.G; ++w) { const int c = __hip_atomic_load(cntwg + w * 32 + F.tid, __ATOMIC_RELAXED, __HIP_MEMORY_SCOPE_AGENT); base += (w < (int)blockIdx.x) ? c : 0; tot += c; }
        tab[96 + F.tid] = tot; tab[64 + F.tid] = base; }
    __syncthreads();
    if (F.tid == 0) { int s = 0; for (int e = 0; e < 32; ++e) { tab[e] = s; s += (tab[96 + e] + 255) & ~255; } tab[32] = s; }
    __syncthreads();
}
__device__ __forceinline__ void p5b_place(Frame& F, const Ptrs& P) {
    LAS int* tab = (LAS int*)(F.lds + TAB_OFF);
    moe_tab(F, P);
    const int rows_per_wg = T / F.G, rbase = blockIdx.x * rows_per_wg;
    const int* eid = (const int*)(P.ws + WS_EID); const int* rank = (const int*)(P.ws + WS_RANK); int* slot = (int*)(P.ws + WS_SLOT);
    int* tokl = (int*)(P.ws + WS_TOK);
    for (int a = F.tid; a < rows_per_wg * 2; a += NWAVES * 64) { const int ga = rbase * 2 + a, e = eid[ga]; const int s = tab[e] + tab[64 + e] + rank[ga]; slot[ga] = s; tokl[s] = ga >> 1; }
    if (blockIdx.x < 32) { const int e = blockIdx.x; for (int s = tab[e] + tab[96 + e] + F.tid; s < tab[e + 1]; s += NWAVES * 64) tokl[s] = 0; }
}
struct P8Row { v4u x[2], y0[2], y1[2]; float w0, w1; };
__device__ __forceinline__ void p8_load(P8Row& R, const bf16* x1, const bf16* y, const int* slot, const float* ew, int row, int lane) {
    const int s0 = slot[row * 2], s1 = slot[row * 2 + 1]; R.w0 = ew[row * 2]; R.w1 = ew[row * 2 + 1];
    const GAS v4u* xr = (const GAS v4u*)(x1 + (size_t)row * D) + lane; const GAS v4u* a = (const GAS v4u*)(y + (size_t)s0 * D) + lane; const GAS v4u* b = (const GAS v4u*)(y + (size_t)s1 * D) + lane;
    R.x[0] = xr[0]; R.x[1] = xr[64]; R.y0[0] = a[0]; R.y0[1] = a[64]; R.y1[0] = b[0]; R.y1[1] = b[64];
}
__device__ __forceinline__ void p8_finish(const P8Row& R, const Ptrs& P, int row, int lane, bool poison) {
    float v[16]; float s = 0.f;
#pragma unroll
    for (int h = 0; h < 2; ++h)
#pragma unroll
        for (int i = 0; i < 4; ++i) { v[8 * h + 2 * i] = ALPHA * bflo(R.x[h][i]) + R.w0 * bflo(R.y0[h][i]) + R.w1 * bflo(R.y1[h][i]); v[8 * h + 2 * i + 1] = ALPHA * bfhi(R.x[h][i]) + R.w0 * bfhi(R.y0[h][i]) + R.w1 * bfhi(R.y1[h][i]); }
#pragma unroll
    for (int i = 0; i < 16; ++i) s += v[i];
    const float mean = wave_sum_fast(s) * (1.f / D); float s2 = 0.f;
#pragma unroll
    for (int i = 0; i < 16; ++i) { v[i] -= mean; s2 += v[i] * v[i]; }
    const float rstd = 1.f / sqrtf(wave_sum_fast(s2) * (1.f / D) + LN_EPS);
    const float qn = __builtin_nanf("");
#pragma unroll
    for (int h = 0; h < 2; ++h)
#pragma unroll
        for (int q = 0; q < 2; ++q) { const int c = 512 * h + 8 * lane + 4 * q; const f32x4 g = *(const GAS f32x4*)(P.ln2_g + c), b = *(const GAS f32x4*)(P.ln2_b + c);
            f32x4 o = {v[8 * h + 4 * q] * rstd * g.x + b.x, v[8 * h + 4 * q + 1] * rstd * g.y + b.y, v[8 * h + 4 * q + 2] * rstd * g.z + b.z, v[8 * h + 4 * q + 3] * rstd * g.w + b.w};
            if (poison) o = (f32x4){qn, qn, qn, qn};
            *(GAS f32x4*)(P.out + (size_t)row * D + c) = o; }
}
__device__ __forceinline__ void p8_final(Frame& F, const Ptrs& P, bool poison) {
    const bf16* x1 = (const bf16*)(P.ws + WS_XN); const bf16* y = (const bf16*)(P.ws + WS_XG);
    const int* slot = (const int*)(P.ws + WS_SLOT); const float* ew = (const float*)(P.ws + WS_EW);
    const int rows_per_wg = T / F.G, rbase = blockIdx.x * rows_per_wg;
    P8Row A, B;
    int rr = F.wave; if (rr < rows_per_wg) p8_load(A, x1, y, slot, ew, rbase + rr, F.lane);
    for (; rr < rows_per_wg; rr += 2 * NWAVES) {
        const bool hasB = rr + NWAVES < rows_per_wg; if (hasB) p8_load(B, x1, y, slot, ew, rbase + rr + NWAVES, F.lane);
        p8_finish(A, P, rbase + rr, F.lane, poison);
        if (hasB) { if (rr + 2 * NWAVES < rows_per_wg) p8_load(A, x1, y, slot, ew, rbase + rr + 2 * NWAVES, F.lane); p8_finish(B, P, rbase + rr + NWAVES, F.lane, poison); }
    }
}

constexpr int N_PHASES = 11;
struct Args { Ptrs p; int ph_lo, ph_hi, bar_region, flags; };
__global__ void __launch_bounds__(NWAVES * 64, 2) mega_fwd(Args args) {
    extern __shared__ __attribute__((aligned(16))) unsigned char lds[];
    Frame F; const Ptrs& P = args.p;
    F.lds = (LAS unsigned char*)lds; F.MISC = (volatile LAS unsigned*)(F.lds + MISC_OFF);
    F.tid = threadIdx.x; F.lane = F.tid & 63; F.wave = __builtin_amdgcn_readfirstlane(F.tid >> 6);
    F.G = gridDim.x; { const int bx = blockIdx.x; F.vcu = (F.G % 8 == 0) ? (bx % 8) * (F.G / 8) + bx / 8 : bx; }
    F.ctl = (gu32*)(P.ws + WS_CTL);
    for (int u = F.tid; u < (LDS_BYTES - LDSCTL_OFF) / 4; u += NWAVES * 64) ((LAS unsigned*)(F.lds + LDSCTL_OFF))[u] = 0u;
    __syncthreads();
    XcdBarrier bar = xcd_barrier_post((unsigned*)(F.ctl + CW_BAR) + args.bar_region * XCD_BAR_WORDS, F.MISC + 8);
    const int lo = args.ph_lo, hi = args.ph_hi;
#ifndef PH_MASK
#define PH_MASK 0x7ff
#endif
#define IN(k) (((PH_MASK >> (k)) & 1) && lo <= (k) && (k) < hi)
#define BOTH(k) (IN(k) && IN((k) + 1))
#define GRID_BAR() xcd_barrier(bar)
    const bool grid_ok = (F.G == 256);

    if (IN(0)) { p0_prologue(F, P); if (BOTH(0)) GRID_BAR(); }
    if (IN(1)) {
        pg8::Gemm g{(const pg8::bf16_t*)(P.ws + WS_XN), (const pg8::bf16_t*)(P.ws + WS_WIN), T, NIN, D}; pg8::StaticOrder S; S.init(T, NIN, F.G, (int)blockIdx.x);
        pg8::EpiInProj E{(pg8::bf16_t*)(P.ws + WS_Q), (size_t)(WS_K - WS_Q) / 2, BUF_CB(P), (pg8::bf16_t*)(P.ws + WS_Z), BUF_SGA(P), BUF_SGB(P)};
        pg8::gemm_phase<pg8::EpiInProj, pg8::StaticOrder, P1_ALIGN, P1_SP2>(F.lds + RING_OFF, g, S, E);
        if (BOTH(1)) GRID_BAR();
    }
    if (IN(2)) { if (!(args.flags & 2)) p2_conv(F, P); if (ATTN_PAIR) p2_attention2(F, P, (char*)lds + RING_OFF); else p2_attention(F, P, (char*)lds + RING_OFF); if (BOTH(2)) GRID_BAR(); }
    if (IN(3)) { if (!(args.flags & 1)) p2b_combine(F, P); pe_experts(F, P); if (BOTH(3)) GRID_BAR(); }
    if (IN(4)) {
        { pg8::Gemm g{(const pg8::bf16_t*)(P.ws + WS_XN), (const pg8::bf16_t*)(P.ws + WS_WA), T, D, D}; pg8::StaticOrder S; S.init(T, D, F.G, (int)blockIdx.x);
          pg8::EpiGate<false> E{BUF_SGA(P), nullptr, (pg8::bf16_t*)(P.ws + WS_O1), P.b_gate};
          pg8::gemm_phase<pg8::EpiGate<false>, pg8::StaticOrder, true, true>(F.lds + RING_OFF, g, S, E); }
        __syncthreads();
        { pg8::Gemm g{BUF_CB(P), (const pg8::bf16_t*)(P.ws + WS_WB), T, D, D}; pg8::StaticOrder S; S.init(T, D, F.G, (int)blockIdx.x);
          pg8::EpiGate<true> E{BUF_SGB(P), (const pg8::bf16_t*)(P.ws + WS_O1), (pg8::bf16_t*)(P.ws + WS_Z), P.b_gate + 1024};
          pg8::gemm_phase<pg8::EpiGate<true>, pg8::StaticOrder, true, true>(F.lds + RING_OFF, g, S, E); }
        if (BOTH(4)) GRID_BAR();
    }
    if (IN(5)) {
        pg8::Gemm g{(const pg8::bf16_t*)(P.ws + WS_Z), (const pg8::bf16_t*)(P.ws + WS_WO), T, D, D}; pg8::StaticOrder S; S.init(T, D, F.G, (int)blockIdx.x);
        pg8::EpiPre E{P.x, (const float*)(P.ws + WS_STATS), P.ln_in_g, P.ln_in_b, (float*)(P.ws + WS_PRE), ALPHA};
        pg8::gemm_phase<pg8::EpiPre, pg8::StaticOrder, true, true>(F.lds + RING_OFF, g, S, E);
        if (BOTH(5)) GRID_BAR();
    }
    if (IN(6)) { if (grid_ok) p5_ln_route(F, P); if (BOTH(6)) GRID_BAR(); }
    if (IN(7)) { if (grid_ok) p5b_place(F, P); if (BOTH(7)) GRID_BAR(); }
    if (IN(8)) {
        if (grid_ok) { if (lo == 8) moe_tab(F, P); pg8::Gemm g{(const pg8::bf16_t*)(P.ws + WS_XN), (const pg8::bf16_t*)(P.ws + WS_WGU), MAXS, NE * 1024, D};
          pg8::MoeOrder S{(const PG8_LAS int*)(F.lds + TAB_OFF), F.G, F.vcu, (unsigned*)(F.ctl + CW_MOE), 0u, MOE_HANDOFF != 0, (unsigned*)(F.ctl + CW_TMO), 0, -1}; pg8::EpiMoeUp E{(pg8::bf16_t*)P.out};
          pg8::gemm_phase<pg8::EpiMoeUp, pg8::MoeOrder, true, true, true>(F.lds + RING_OFF, g, S, E, (const int*)(P.ws + WS_TOK)); S.flush(); }
        if (BOTH(8)) { if (MOE_HANDOFF) __syncthreads(); else GRID_BAR(); }
    }
    if (IN(9)) {
        if (grid_ok) { if (lo == 9) moe_tab(F, P); pg8::Gemm g{(const pg8::bf16_t*)P.out, (const pg8::bf16_t*)(P.ws + WS_WD), MAXS, NE * 1024, DE};
          const bool ho = MOE_HANDOFF && lo <= 8;
          pg8::MoeOrder S{(const PG8_LAS int*)(F.lds + TAB_OFF), F.G, ho ? (F.vcu + F.G / 2) % F.G : F.vcu, (unsigned*)(F.ctl + CW_MOE), ho ? 32u : 0u, false, (unsigned*)(F.ctl + CW_TMO), 0, -1}; pg8::EpiMoeDown E{(pg8::bf16_t*)(P.ws + WS_XG)};
          pg8::gemm_phase<pg8::EpiMoeDown, pg8::MoeOrder, true, true>(F.lds + RING_OFF, g, S, E); }
        if (BOTH(9)) GRID_BAR();
    }
    if (IN(10)) {
        bool poison = !grid_ok || (__hip_atomic_load(F.ctl + CW_BAR + args.bar_region * XCD_BAR_WORDS + XB_TMO, RLX_AGENT) != 0u) || (__hip_atomic_load(F.ctl + CW_TMO, RLX_AGENT) != 0u);
        if (grid_ok) p8_final(F, P, poison);
        else { const float qn = __builtin_nanf(""); for (size_t i = (size_t)blockIdx.x * 512 + F.tid; i < (size_t)T * D; i += (size_t)F.G * 512) P.out[i] = qn; }
    }
#undef IN
#undef BOTH
#undef GRID_BAR
}

static void launch_mega(const Ptrs& p, int lo, int hi, int region, int flags, hipStream_t stream) {
    Args a{}; a.p = p; a.ph_lo = lo; a.ph_hi = hi; a.bar_region = region; a.flags = flags;
    hipLaunchKernelGGL(mega_fwd, dim3(256), dim3(NWAVES * 64), LDS_BYTES, stream, a);
}
extern "C" void kernel_launch(void* const* d_in, const int* in_sizes, int n_in, void* d_out, int out_size, void* d_ws, size_t ws_size, hipStream_t stream) {
    static int ready = 0;
    if (ready == 0) {
        ready = 1;
        if (n_in != 24 || out_size != T * D || ws_size < WS_END) { fprintf(stderr, "kernel_launch: unexpected shapes (n_in %d out %d ws %zu)\n", n_in, out_size, ws_size); ready = -1; }
        else if (hipFuncSetAttribute((const void*)mega_fwd, hipFuncAttributeMaxDynamicSharedMemorySize, LDS_BYTES) != hipSuccess) { fprintf(stderr, "kernel_launch: hipFuncSetAttribute failed\n"); ready = -1; }
        (void)hipGetLastError();
    }
    if (ready < 0) return;
    Ptrs p{};
    const float** pp = (const float**)&p;
    for (int i = 0; i < 24; ++i) pp[i] = (const float*)d_in[i];
    p.out = (float*)d_out; p.ws = (unsigned char*)d_ws;
    (void)hipMemsetAsync((char*)d_ws + WS_CTL, 0, CTL_ZERO_BYTES, stream);
    launch_mega(p, 0, N_PHASES, 0, 0, stream);
}
```

```cpp
#include <hip/hip_runtime.h>
#include <cstdio>
#include <cstdint>
#include <cmath>
namespace pg8 {
#define PG8_LAS __attribute__((address_space(3)))
typedef unsigned short bf16_t;
typedef short bf16x8 __attribute__((ext_vector_type(8)));
typedef float f32x4 __attribute__((ext_vector_type(4)));
typedef unsigned u32x4 __attribute__((ext_vector_type(4)));
constexpr int BM = 256, BK = 64, HALF = 128, HTB = HALF * BK * 2  , STAGE_BYTES = 8 * HTB, NXCD = 8, WGM = 8;

__host__ __device__ __forceinline__ int lds_byte(int r, int c) { const int st = (r >> 4) * 2 + (c >> 5), rr = r & 15, cc = c & 31, ob = rr * 64 + cc * 2; return st * 1024 + (ob ^ (((ob >> 9) & 1) << 5)); }
__host__ __device__ __forceinline__ void stage_rc(int b, int& R, int& C) { const int st = b / 1024, sb = b % 1024, swz = sb ^ (((sb >> 9) & 1) << 5); R = (st >> 1) * 16 + swz / 64; C = (st & 1) * 32 + (swz % 64) / 2; }
__host__ __device__ __forceinline__ int perm32(int rho) { const int n = rho >> 4, i = rho & 15; return 8 * (i >> 2) + 4 * n + (i & 3); }

struct Unit { int pm, pn; };
struct Gemm { const bf16_t* A; const bf16_t* Bt; int M, N, K; };

struct StaticOrder {
    int nM, nN, nwg, G, c;
    __host__ __device__ void init(int M, int N, int G_, int c_) { nM = M / BM; nN = N / BM; nwg = nM * nN; G = G_; c = c_; }
    __host__ __device__ bool next(int i, Unit& u) const {
        const long L = (long)i * G + c; if (L >= nwg) return false;
        int wgid = (int)L; { const int q = nwg / NXCD, r = nwg % NXCD, xcd = wgid % NXCD, off = wgid / NXCD; wgid = (xcd < r ? xcd * (q + 1) : r * (q + 1) + (xcd - r) * q) + off; }
        const int nig = WGM * nN, gid = wgid / nig, fm = gid * WGM, gsz = (nM - fm) < WGM ? (nM - fm) : WGM;
        u.pm = fm + ((wgid % nig) % gsz); u.pn = (wgid % nig) / gsz; return true;
    }
    __device__ __forceinline__ void a_ready(const Unit&) const {}
    __device__ __forceinline__ void done(const Unit&) const {}
};

__device__ __forceinline__ unsigned cvt_pk_bf16(float lo, float hi) { unsigned r; asm volatile("v_cvt_pk_bf16_f32 %0, %1, %2" : "=v"(r) : "v"(lo), "v"(hi)); return r; }
typedef float f32x2 __attribute__((ext_vector_type(2)));
__device__ __forceinline__ u32x4 pack8f(const f32x4 a, const f32x4 b) { u32x4 w; w.x = cvt_pk_bf16(a[0], a[1]); w.y = cvt_pk_bf16(a[2], a[3]); w.z = cvt_pk_bf16(b[0], b[1]); w.w = cvt_pk_bf16(b[2], b[3]); return w; }
__device__ __forceinline__ void unpack8f(const u32x4 w, f32x4& a, f32x4& b) {
    a[0] = __uint_as_float(w.x << 16); a[1] = __uint_as_float(w.x & 0xffff0000u); a[2] = __uint_as_float(w.y << 16); a[3] = __uint_as_float(w.y & 0xffff0000u);
    b[0] = __uint_as_float(w.z << 16); b[1] = __uint_as_float(w.z & 0xffff0000u); b[2] = __uint_as_float(w.w << 16); b[3] = __uint_as_float(w.w & 0xffff0000u); }
__device__ __forceinline__ float sigmoidf_fast(float x) { return __builtin_amdgcn_rcpf(1.0f + __expf(-x)); }

struct EpiInProj {
    static constexpr bool PERM = true, AFTER_DRAIN = false;
    bf16_t* qkv; size_t stride;
    bf16_t* cb;
    bf16_t* z;
    bf16_t* sga; bf16_t* sgb;
    __device__ __forceinline__ void operator()(const f32x4 (&acc)[2][2][4][2], const Unit& u, int wr, int wc, int fr, int fq) const {
        const int row0 = u.pm * BM + wr * 64 + fr; const int pn = u.pn;
        if (pn < 16 || pn >= 24) {
            bf16_t* base = (pn < 12) ? qkv + (size_t)(pn >> 2) * stride : (pn < 16 ? cb : (pn < 28 ? sga : sgb)); const int col0 = (pn & 3) * BM + wc * 32 + 8 * fq;
#pragma unroll
            for (int ai = 0; ai < 2; ++ai)
#pragma unroll
                for (int m = 0; m < 4; ++m) { bf16_t* rowp = base + (size_t)(row0 + ai * HALF + m * 16) * 1024 + col0;
#pragma unroll
                    for (int bj = 0; bj < 2; ++bj) *(u32x4*)(rowp + bj * HALF) = pack8f(acc[ai][bj][m][0], acc[ai][bj][m][1]); }
        } else {
            const int col0 = (pn - 16) * HALF + wc * 32 + 8 * fq;
#pragma unroll
            for (int ai = 0; ai < 2; ++ai)
#pragma unroll
                for (int m = 0; m < 4; ++m) { bf16_t* rowp = z + (size_t)(row0 + ai * HALF + m * 16) * 1024 + col0;
                    *(u32x4*)rowp = pack8f(acc[ai][0][m][0] * acc[ai][1][m][0], acc[ai][0][m][1] * acc[ai][1][m][1]); }
        }
    }
};
template <bool SECOND> struct EpiGate {
    static constexpr bool PERM = true, AFTER_DRAIN = false;
    const bf16_t* gate; const bf16_t* prev; bf16_t* out; const float* gbias;
    __device__ __forceinline__ void operator()(const f32x4 (&acc)[2][2][4][2], const Unit& u, int wr, int wc, int fr, int fq) const {
        const int row0 = u.pm * BM + wr * 64 + fr; const int col0 = u.pn * BM + wc * 32 + 8 * fq;
        f32x4 bv[2][2];
#pragma unroll
        for (int bj = 0; bj < 2; ++bj)
#pragma unroll
            for (int n = 0; n < 2; ++n) bv[bj][n] = *(const f32x4*)(gbias + col0 + bj * HALF + 4 * n);
#pragma unroll
        for (int ai = 0; ai < 2; ++ai)
#pragma unroll
            for (int m = 0; m < 4; ++m) { const size_t off = (size_t)(row0 + ai * HALF + m * 16) * 1024 + col0;
#pragma unroll
                for (int bj = 0; bj < 2; ++bj) { f32x4 g0, g1; unpack8f(*(const u32x4*)(gate + off + bj * HALF), g0, g1); g0 += bv[bj][0]; g1 += bv[bj][1];
#pragma unroll
                    for (int i = 0; i < 4; ++i) { g0[i] = sigmoidf_fast(g0[i]); g1[i] = sigmoidf_fast(g1[i]); }
                    f32x4 v0 = acc[ai][bj][m][0] * g0, v1 = acc[ai][bj][m][1] * g1;
                    if (SECOND) { f32x4 p0, p1; unpack8f(*(const u32x4*)(prev + off + bj * HALF), p0, p1); v0 += p0; v1 += p1; }
                    *(u32x4*)(out + off + bj * HALF) = pack8f(v0, v1); } }
    }
};
typedef unsigned u32x2 __attribute__((ext_vector_type(2)));
#ifndef PRE_BF16_KNOB
#define PRE_BF16_KNOB 1
#endif
constexpr bool PRE_BF16 = PRE_BF16_KNOB;
struct EpiPre {
    static constexpr bool PERM = false, AFTER_DRAIN = false;
    const float* x; const float* stats; const float* g; const float* b; float* pre; float alpha;
    __device__ __forceinline__ void operator()(const f32x4 (&acc)[2][2][4][2], const Unit& u, int wr, int wc, int fr, int fq) const {
        const int row0 = u.pm * BM + wr * 64 + fr; const int col0 = u.pn * BM + wc * 32 + 4 * fq;
#pragma unroll
        for (int ai = 0; ai < 2; ++ai)
#pragma unroll
            for (int m = 0; m < 4; ++m) { const int row = row0 + ai * HALF + m * 16; const size_t off = (size_t)row * 1024 + col0;
                const float mu = stats[2 * row], rs = stats[2 * row + 1];
#pragma unroll
                for (int bj = 0; bj < 2; ++bj)
#pragma unroll
                    for (int n = 0; n < 2; ++n) { const int c = bj * HALF + n * 16; const f32x4 xv = *(const f32x4*)(x + off + c), gv = *(const f32x4*)(g + col0 + c), bv = *(const f32x4*)(b + col0 + c);
                        const f32x4 o = ((xv - mu) * rs * gv + bv) * alpha + acc[ai][bj][m][n];
                        if constexpr (PRE_BF16) { u32x2 w; w.x = cvt_pk_bf16(o[0], o[1]); w.y = cvt_pk_bf16(o[2], o[3]); *(u32x2*)((bf16_t*)pre + off + c) = w; } else *(f32x4*)(pre + off + c) = o; } }
    }
};
#ifndef MOE_HANDOFF
#define MOE_HANDOFF 0
#endif
struct EpiMoeUp {
    static constexpr bool PERM = true, AFTER_DRAIN = false;
    bf16_t* h; float sc;
    __device__ __forceinline__ void operator()(const f32x4 (&acc)[2][2][4][2], const Unit& u, int wr, int wc, int fr, int fq) const {
        const int row0 = u.pm * BM + wr * 64 + fr; const int col0 = (u.pn & 3) * HALF + wc * 32 + 8 * fq;
#pragma unroll
        for (int ai = 0; ai < 2; ++ai)
#pragma unroll
            for (int m = 0; m < 4; ++m) { f32x4 v[2];
#pragma unroll
                for (int n = 0; n < 2; ++n)
#pragma unroll
                    for (int i = 0; i < 4; ++i) { const float gv = acc[ai][0][m][n][i] * sc; v[n][i] = gv * sigmoidf_fast(gv) * (acc[ai][1][m][n][i] * sc); }
                bf16_t* dst = h + (size_t)(row0 + ai * HALF + m * 16) * 512 + col0; const u32x4 w = pack8f(v[0], v[1]);
                if (MOE_HANDOFF) asm volatile("global_store_dwordx4 %0, %1, off sc1\n\ts_nop 1" :: "v"(dst), "v"(w) : "memory"); else *(u32x4*)dst = w; }
    }
};
#ifndef MOE_FP8
#define MOE_FP8 1
#endif
#ifndef MOE_FP8_DOWN
#define MOE_FP8_DOWN 1
#endif
constexpr float F8_WS = 64.f, F8_HS = 8.f;
__device__ __forceinline__ unsigned pk4_fp8(float a, float b, float c, float d) { int w = __builtin_amdgcn_cvt_pk_fp8_f32(a, b, 0, false); w = __builtin_amdgcn_cvt_pk_fp8_f32(c, d, w, true); return (unsigned)w; }
struct EpiMoeUp8 {
    static constexpr bool PERM = true, AFTER_DRAIN = false;
    unsigned char* h;
    __device__ __forceinline__ void operator()(const f32x4 (&acc)[2][2][4][2], const Unit& u, int wr, int wc, int fr, int fq) const {
        const int row0 = u.pm * BM + wr * 64 + fr; const int col0 = (u.pn & 3) * HALF + wc * 32 + 8 * fq;
#pragma unroll
        for (int ai = 0; ai < 2; ++ai)
#pragma unroll
            for (int m = 0; m < 4; ++m) { f32x4 v[2];
#pragma unroll
                for (int n = 0; n < 2; ++n)
#pragma unroll
                    for (int i = 0; i < 4; ++i) { const float gv = acc[ai][0][m][n][i] * (1.f / F8_WS); v[n][i] = gv * sigmoidf_fast(gv) * acc[ai][1][m][n][i] * (F8_HS / F8_WS); }
                u32x2 w; w.x = pk4_fp8(v[0][0], v[0][1], v[0][2], v[0][3]); w.y = pk4_fp8(v[1][0], v[1][1], v[1][2], v[1][3]);
                *(u32x2*)(h + (size_t)(row0 + ai * HALF + m * 16) * 512 + col0) = w; }
    }
};
struct EpiMoeDown {
    static constexpr bool PERM = true, AFTER_DRAIN = false;
    bf16_t* y; float scale;
    __device__ __forceinline__ void operator()(const f32x4 (&acc)[2][2][4][2], const Unit& u, int wr, int wc, int fr, int fq) const {
        const int row0 = u.pm * BM + wr * 64 + fr; const int col0 = (u.pn & 3) * BM + wc * 32 + 8 * fq;
#pragma unroll
        for (int ai = 0; ai < 2; ++ai)
#pragma unroll
            for (int m = 0; m < 4; ++m) { bf16_t* rowp = y + (size_t)(row0 + ai * HALF + m * 16) * 1024 + col0;
#pragma unroll
                for (int bj = 0; bj < 2; ++bj) *(u32x4*)(rowp + bj * HALF) = pack8f(acc[ai][bj][m][0] * scale, acc[ai][bj][m][1] * scale); }
    }
};
struct MoeOrder {
    const PG8_LAS int* tab; int G, c;
    unsigned* cnt;
    unsigned need;
    bool publish; unsigned* tmo;
    __device__ __forceinline__ bool next(int i, Unit& u) const {
        const int nunits = (tab[32] >> 8) * 4; const int L = i * G + c; if (L >= nunits) return false;
        const int tile = L >> 2, s = tile << 8; int e = 0;
#pragma unroll 1
        for (int k = 1; k < 32; ++k) e = (tab[k] <= s) ? k : e;
        u.pm = __builtin_amdgcn_readfirstlane(tile); u.pn = __builtin_amdgcn_readfirstlane(e * 4 + (L & 3)); return true;
    }
    mutable int calls;
    __device__ __forceinline__ void a_ready(const Unit& u) const {
        const int k = calls++;
        if (need == 0u || (k >= 1 && k < 4)) return;
        if (threadIdx.x < 64) {
            const int lane = threadIdx.x, nunits = (tab[32] >> 8) * 4;
            int tile = u.pm; bool mine = (lane == 0);
            if (k == 0) { const int L = lane * G + c; mine = (lane < 4) && (L < nunits); tile = mine ? (L >> 2) : u.pm; }
            const unsigned long long t0 = __builtin_amdgcn_s_memrealtime(); unsigned polls = 0;
            for (;;) {
                const bool ok = !mine || __hip_atomic_load(cnt + 64 * tile, __ATOMIC_RELAXED, __HIP_MEMORY_SCOPE_AGENT) >= need;
                if (__all(ok)) break;
                if ((++polls & 255u) == 0u && __builtin_amdgcn_readfirstlane(__hip_atomic_load(tmo, __ATOMIC_RELAXED, __HIP_MEMORY_SCOPE_AGENT)) != 0u) break;
                if (__builtin_amdgcn_s_memrealtime() - t0 > 2000000ull) { if (threadIdx.x == 0) __hip_atomic_store(tmo, 1u, __ATOMIC_RELAXED, __HIP_MEMORY_SCOPE_AGENT); break; }
                __builtin_amdgcn_s_sleep(2); }
            __builtin_amdgcn_fence(__ATOMIC_ACQUIRE, "agent");
            asm volatile("s_waitcnt vmcnt(0)" ::: "memory");
        }
        asm volatile("" ::: "memory"); __builtin_amdgcn_s_barrier(); asm volatile("" ::: "memory");
    }
    mutable int pend;
    __device__ __forceinline__ void done(const Unit& u) const {
        if (!publish) return;
        if (pend >= 0 && (threadIdx.x & 63) == 0) __hip_atomic_fetch_add(cnt + 64 * pend, 1u, __ATOMIC_RELAXED, __HIP_MEMORY_SCOPE_AGENT);
        pend = u.pm;
    }
    __device__ __forceinline__ void flush() const {
        if (!publish) return;
        asm volatile("s_waitcnt vmcnt(0)" ::: "memory");
        if (pend >= 0 && (threadIdx.x & 63) == 0) __hip_atomic_fetch_add(cnt + 64 * pend, 1u, __ATOMIC_RELAXED, __HIP_MEMORY_SCOPE_AGENT);
        pend = -1;
    }
};
typedef int v8i __attribute__((ext_vector_type(8)));
typedef int v4i __attribute__((ext_vector_type(4)));
template <class Epi, class Sched, bool ALIGN_EPI = false, bool SP2 = false, bool GATHER = false, bool FP8 = false>
__device__ __forceinline__ void gemm_phase(PG8_LAS unsigned char* lds, const Gemm g, const Sched& S, const Epi& E, const int* tok = nullptr) {
    static_assert(!GATHER || SP2, "GATHER is written for the SP2 loop only"); static_assert(!FP8 || SP2, "FP8 is written for the SP2 loop only");
    const int tid = threadIdx.x, wid = __builtin_amdgcn_readfirstlane(tid >> 6), lane = tid & 63, wr = wid >> 2, wc = wid & 3, fr = lane & 15, fq = lane >> 4;
    const int K = g.K, nt = K / BK;
    unsigned voffA[2], voffB[2]; int gR[2], gC[2];
#pragma unroll
    for (int i = 0; i < 2; ++i) { int R, C; stage_rc(tid * 16 + i * 8192, R, C); const int Rb = Epi::PERM ? ((R & ~31) + perm32(R & 31)) : R; gR[i] = R; gC[i] = C;
        voffA[i] = (unsigned)(R * K + C) * 2u; voffB[i] = (unsigned)(Rb * K + C) * 2u; }
    unsigned vc0[2] = {0u, 0u}, vc1[2] = {0u, 0u}, vn0[2] = {0u, 0u}, vn1[2] = {0u, 0u};
#define PG8_GROWS(pm_, o0, o1) do { int t_ = tid; asm volatile("" : "+v"(t_));     \
        _Pragma("unroll") for (int _i = 0; _i < 2; ++_i) { int R_, C_; stage_rc(t_ * 16 + _i * 8192, R_, C_); o0[_i] = (unsigned)(tok[(pm_) * BM + R_] * K + C_) * 2u; o1[_i] = (unsigned)(tok[(pm_) * BM + HALF + R_] * K + C_) * 2u; } } while (0)
#define PG8_STAGE_A(bufoff, gbase, h, usenext) do { if constexpr (GATHER) { const unsigned _o0 = (usenext) ? ((h) ? vn1[0] : vn0[0]) : ((h) ? vc1[0] : vc0[0]), _o1 = (usenext) ? ((h) ? vn1[1] : vn0[1]) : ((h) ? vc1[1] : vc0[1]); \
        __builtin_amdgcn_raw_ptr_buffer_load_lds(rsA, (PG8_LAS unsigned*)(lds + (bufoff) + ldsw), 16, (int)_o0, (int)(gbase), 0, 0); \
        __builtin_amdgcn_raw_ptr_buffer_load_lds(rsA, (PG8_LAS unsigned*)(lds + (bufoff) + ldsw + 8192), 16, (int)_o1, (int)(gbase), 0, 0); } \
    else { PG8_STAGE(rsA, bufoff, (gbase) + (h) * hstep, voffA); } } while (0)
    const unsigned kstep = (unsigned)(BK * 2);
    const unsigned hstep = (unsigned)(HALF * K * 2);
    const unsigned tstep = 2 * hstep;
    const __amdgpu_buffer_rsrc_t rsA = __builtin_amdgcn_make_buffer_rsrc((void*)g.A, (short)0, 0x7fffffff, 0x00020000), rsB = __builtin_amdgcn_make_buffer_rsrc((void*)g.Bt, (short)0, 0x7fffffff, 0x00020000);
    const unsigned ldsw = (unsigned)wid * 1024u;
    const int aoff = lds_byte(wr * 64 + fr, fq * 8), boff = lds_byte(wc * 32 + fr, fq * 8);
    const int aoff0 = lds_byte(wr * 64 + fr, (2 * (fq & 1)) * 8) + (fq >> 1) * 1024, boff0 = lds_byte(wc * 32 + fr, (2 * (fq & 1)) * 8) + (fq >> 1) * 1024;
#define PG8_SA(b, h) (((b) * 2 + (h)) * HTB)
#define PG8_SB(b, h) ((4 + (b) * 2 + (h)) * HTB)
#define PG8_STAGE(rs, bufoff, soff, voff) do { _Pragma("unroll") for (int _i = 0; _i < 2; ++_i) \
        __builtin_amdgcn_raw_ptr_buffer_load_lds(rs, (PG8_LAS unsigned*)(lds + (bufoff) + ldsw + _i * 8192), 16, (int)(voff)[_i], (int)(soff), 0, 0); } while (0)
#define PG8_LD8(base_, o0_, o1_) __builtin_shufflevector(*(const PG8_LAS v4i*)(lds + (base_) + (o0_)), *(const PG8_LAS v4i*)(lds + (base_) + (o1_)), 0, 1, 2, 3, 4, 5, 6, 7)
#define PG8_LDA(dst, b, h) do { _Pragma("unroll") for (int m = 0; m < 4; ++m) { if constexpr (FP8) { dst##8[m] = PG8_LD8(PG8_SA(b, h) + m * 2048, aoff0, aoff0 + 16); } \
        else { _Pragma("unroll") for (int k = 0; k < 2; ++k) dst[m][k] = *(const PG8_LAS bf16x8*)(lds + PG8_SA(b, h) + aoff + m * 2048 + k * 1024); } } } while (0)
#define PG8_LDB(dst, b, h) do { _Pragma("unroll") for (int n = 0; n < 2; ++n) { if constexpr (FP8) { dst##8[n] = PG8_LD8(PG8_SB(b, h) + n * 2048, boff0, boff0 + 16); } \
        else { _Pragma("unroll") for (int k = 0; k < 2; ++k) dst[n][k] = *(const PG8_LAS bf16x8*)(lds + PG8_SB(b, h) + boff + n * 2048 + k * 1024); } } } while (0)
#define PG8_MMA(ai, bj, At, Bt) do { if constexpr (FP8) __builtin_amdgcn_sched_barrier(0); __builtin_amdgcn_s_setprio(1); _Pragma("unroll") for (int m = 0; m < 4; ++m) _Pragma("unroll") for (int n = 0; n < 2; ++n) { \
        if constexpr (FP8) acc[ai][bj][m][n] = __builtin_amdgcn_mfma_scale_f32_16x16x128_f8f6f4(Bt##8[n], At##8[m], acc[ai][bj][m][n], 0, 0, 0, 0x7f7f7f7f, 0, 0x7f7f7f7f); \
        else { _Pragma("unroll") for (int k = 0; k < 2; ++k) acc[ai][bj][m][n] = __builtin_amdgcn_mfma_f32_16x16x32_bf16(Bt[n][k], At[m][k], acc[ai][bj][m][n], 0, 0, 0); } } __builtin_amdgcn_s_setprio(0); \
        if constexpr (FP8) { asm volatile("" : "+v"(acc[ai][bj][0][0]), "+v"(acc[ai][bj][0][1]), "+v"(acc[ai][bj][1][0]), "+v"(acc[ai][bj][1][1]), "+v"(acc[ai][bj][2][0]), "+v"(acc[ai][bj][2][1]), "+v"(acc[ai][bj][3][0]), "+v"(acc[ai][bj][3][1])); \
                             __builtin_amdgcn_sched_barrier(0); } } while (0)
#define PG8_WAIT_V(n) asm volatile("s_waitcnt vmcnt(" #n ")" ::: "memory")
#define PG8_WAIT_L(n) asm volatile("s_waitcnt lgkmcnt(" #n ")" ::: "memory")
#define PG8_BAR __builtin_amdgcn_s_barrier()
#define PG8_SCHED __builtin_amdgcn_sched_barrier(0)
    Unit cur, nxt; int ui = 0;
    if (!S.next(0, cur)) return;
    f32x4 acc[2][2][4][2];
#pragma unroll
    for (int a = 0; a < 2; ++a)
#pragma unroll
        for (int b = 0; b < 2; ++b)
#pragma unroll
            for (int m = 0; m < 4; ++m)
#pragma unroll
                for (int n = 0; n < 2; ++n) acc[a][b][m][n] = (f32x4){0.f, 0.f, 0.f, 0.f};
    bf16x8 At[4][2], B0[2][2], B1[2][2]; v8i At8[4], B08[2], B18[2];
    unsigned cA = GATHER ? 0u : (unsigned)cur.pm * tstep, cB = (unsigned)cur.pn * tstep;
    S.a_ready(cur);
    if constexpr (GATHER) PG8_GROWS(cur.pm, vc0, vc1);
    if constexpr (SP2) {
        PG8_STAGE(rsB, PG8_SB(0, 0), cB, voffB); PG8_STAGE(rsB, PG8_SB(0, 1), cB + hstep, voffB); PG8_STAGE_A(PG8_SA(0, 0), cA, 0, false); PG8_STAGE_A(PG8_SA(0, 1), cA, 1, false);
        if (wr == 1) PG8_BAR;
        PG8_WAIT_V(2); PG8_BAR;
        PG8_STAGE(rsB, PG8_SB(1, 0), cB + kstep, voffB); PG8_STAGE_A(PG8_SA(1, 0), cA + kstep, 0, false); PG8_STAGE(rsB, PG8_SB(1, 1), cB + hstep + kstep, voffB);
        PG8_WAIT_V(6); PG8_BAR;
    } else {
        PG8_STAGE(rsB, PG8_SB(0, 0), cB, voffB); PG8_STAGE(rsA, PG8_SA(0, 0), cA, voffA); PG8_STAGE(rsB, PG8_SB(0, 1), cB + hstep, voffB); PG8_STAGE(rsA, PG8_SA(0, 1), cA + hstep, voffA);
        if (wr == 1) PG8_BAR;
        PG8_WAIT_V(4); PG8_BAR;
        PG8_STAGE(rsB, PG8_SB(1, 0), cB + kstep, voffB); PG8_STAGE(rsA, PG8_SA(1, 0), cA + kstep, voffA); PG8_STAGE(rsB, PG8_SB(1, 1), cB + hstep + kstep, voffB);
        PG8_WAIT_V(6); PG8_BAR;
    }
    for (;;) {
        const bool has_next = S.next(ui + 1, nxt);
        const unsigned nA = GATHER ? 0u : (has_next ? (unsigned)nxt.pm * tstep : cA), nB = has_next ? (unsigned)nxt.pn * tstep : cB;
        if constexpr (GATHER) { if (has_next) PG8_GROWS(nxt.pm, vn0, vn1); else { vn0[0] = vc0[0]; vn0[1] = vc0[1]; vn1[0] = vc1[0]; vn1[1] = vc1[1]; } }
#pragma unroll 1
        for (int t = 0; t < nt; t += 2) {
            const bool last = (t == nt - 2);
            const unsigned a1 = cA + (unsigned)(t + 1) * kstep;
            const unsigned a2 = last ? nA : cA + (unsigned)(t + 2) * kstep, b2 = last ? nB : cB + (unsigned)(t + 2) * kstep;
            const unsigned a3 = a2 + kstep, b3 = b2 + kstep;
            if (last && has_next) S.a_ready(nxt);
            if constexpr (SP2) {
            PG8_LDB(B0, 0, 0); PG8_LDB(B1, 0, 1); PG8_SCHED; PG8_LDA(At, 0, 0); PG8_STAGE_A(PG8_SA(1, 1), a1, 1, false);
            PG8_WAIT_V(8); PG8_WAIT_L(0); PG8_BAR; PG8_MMA(0, 0, At, B0); PG8_MMA(0, 1, At, B1); PG8_BAR; PG8_SCHED;
            PG8_LDA(At, 0, 1); PG8_STAGE(rsB, PG8_SB(0, 0), b2, voffB); PG8_STAGE(rsB, PG8_SB(0, 1), b2 + hstep, voffB); PG8_STAGE_A(PG8_SA(0, 0), a2, 0, last);
            PG8_WAIT_V(8); PG8_WAIT_L(0); PG8_BAR; PG8_MMA(1, 0, At, B0); PG8_MMA(1, 1, At, B1); PG8_BAR; PG8_SCHED;
            PG8_LDB(B0, 1, 0); PG8_LDB(B1, 1, 1); PG8_SCHED; PG8_LDA(At, 1, 0); PG8_STAGE_A(PG8_SA(0, 1), a2, 1, last);
            PG8_WAIT_V(8); PG8_WAIT_L(0); PG8_BAR; PG8_MMA(0, 0, At, B0); PG8_MMA(0, 1, At, B1); PG8_BAR; PG8_SCHED;
            PG8_LDA(At, 1, 1); PG8_STAGE(rsB, PG8_SB(1, 0), b3, voffB); PG8_STAGE(rsB, PG8_SB(1, 1), b3 + hstep, voffB); PG8_STAGE_A(PG8_SA(1, 0), a3, 0, last);
            PG8_WAIT_V(8); PG8_WAIT_L(0); PG8_BAR; PG8_MMA(1, 0, At, B0); PG8_MMA(1, 1, At, B1); PG8_BAR; PG8_SCHED;
            } else {
            PG8_LDB(B0, 0, 0); PG8_SCHED; PG8_LDA(At, 0, 0); PG8_STAGE(rsA, PG8_SA(1, 1), a1 + hstep, voffA);
            PG8_WAIT_L(8); PG8_BAR; PG8_WAIT_L(0); PG8_MMA(0, 0, At, B0); PG8_BAR; PG8_SCHED;
            PG8_LDB(B1, 0, 1); PG8_STAGE(rsB, PG8_SB(0, 0), b2, voffB);
            PG8_BAR; PG8_WAIT_L(0); PG8_MMA(0, 1, At, B1); PG8_BAR;
            PG8_LDA(At, 0, 1); PG8_STAGE(rsA, PG8_SA(0, 0), a2, voffA);
            PG8_BAR; PG8_WAIT_L(0); PG8_MMA(1, 0, At, B0); PG8_BAR; PG8_SCHED;
            PG8_STAGE(rsB, PG8_SB(0, 1), b2 + hstep, voffB);
            PG8_WAIT_V(6); PG8_BAR; PG8_MMA(1, 1, At, B1); PG8_BAR;
            PG8_LDB(B0, 1, 0); PG8_SCHED; PG8_LDA(At, 1, 0); PG8_STAGE(rsA, PG8_SA(0, 1), a2 + hstep, voffA);
            PG8_WAIT_L(8); PG8_BAR; PG8_WAIT_L(0); PG8_MMA(0, 0, At, B0); PG8_BAR; PG8_SCHED;
            PG8_LDB(B1, 1, 1); PG8_STAGE(rsB, PG8_SB(1, 0), b3, voffB);
            PG8_BAR; PG8_WAIT_L(0); PG8_MMA(0, 1, At, B1); PG8_BAR;
            PG8_LDA(At, 1, 1); PG8_STAGE(rsA, PG8_SA(1, 0), a3, voffA);
            PG8_BAR; PG8_WAIT_L(0); PG8_MMA(1, 0, At, B0); PG8_BAR; PG8_SCHED;
            PG8_STAGE(rsB, PG8_SB(1, 1), b3 + hstep, voffB);
            PG8_WAIT_V(6); PG8_BAR; PG8_MMA(1, 1, At, B1); PG8_BAR;
            }
        }
        if constexpr (ALIGN_EPI) { if (wr == 0) PG8_BAR; }
        if constexpr (!Epi::AFTER_DRAIN) { E(acc, cur, wr, wc, fr, fq); S.done(cur); }
        if (!has_next) break;
#pragma unroll
        for (int a = 0; a < 2; ++a)
#pragma unroll
            for (int b = 0; b < 2; ++b)
#pragma unroll
                for (int m = 0; m < 4; ++m)
#pragma unroll
                    for (int n = 0; n < 2; ++n) acc[a][b][m][n] = (f32x4){0.f, 0.f, 0.f, 0.f};
        cur = nxt; cA = nA; cB = nB; ++ui;
        if constexpr (GATHER) { vc0[0] = vn0[0]; vc0[1] = vn0[1]; vc1[0] = vn1[0]; vc1[1] = vn1[1]; }
        if constexpr (ALIGN_EPI) { if (wr == 1) PG8_BAR; }
    }
    PG8_WAIT_V(0);
    if constexpr (!ALIGN_EPI) { if (wr == 0) PG8_BAR; }
    PG8_BAR;
    if constexpr (Epi::AFTER_DRAIN) { E.fused(acc, cur, wr, wc, fr, fq, lds, wid, lane); S.done(cur); }
#undef PG8_SA
#undef PG8_SB
#undef PG8_STAGE
#undef PG8_STAGE_A
#undef PG8_GROWS
#undef PG8_LDA
#undef PG8_LDB
#undef PG8_MMA
#undef PG8_LD8
#undef PG8_WAIT_V
#undef PG8_WAIT_L
#undef PG8_BAR
#undef PG8_SCHED
}
}

namespace attn {
typedef short bf16x8 __attribute__((ext_vector_type(8)));
typedef short s16x4 __attribute__((ext_vector_type(4)));
typedef float f32x16 __attribute__((ext_vector_type(16)));
typedef unsigned u32x4 __attribute__((ext_vector_type(4)));
typedef unsigned short bf16;
constexpr int D = 128, PITCH = 1024, SEQ = 2048;
constexpr float SCALE = 0.08838834764831845f, THR = 8.f;
constexpr int NW = 8, QBLK = 32, KVBLK = 64, QB = NW * QBLK;
constexpr int SHM_V = KVBLK * D * 2, SHM_K = KVBLK * D * 2;
constexpr int BIAS_OFF = 2 * SHM_V + 2 * SHM_K + NW * 64 * 4, NBIAS = 320;
constexpr int LDS_BYTES = BIAS_OFF + NBIAS * 4;
#define KSWZ(row, colB) ((row) * 256 + ((colB) ^ (((row) & 7) << 4)))
#define SBAR() __builtin_amdgcn_sched_barrier(0)
__device__ __forceinline__ int v_st(int k, int c) { const int kk = (k & ~0xC) | ((k & 4) << 1) | ((k & 8) >> 1); return ((kk >> 3) * 4 + (c >> 5)) * 512 + ((kk & 7) * 32 + (c & 31)) * 2; }
__device__ __forceinline__ int v_rd_base(int lane) { return ((lane & 3) << 3) | (((lane >> 2) & 3) << 6) | (((lane >> 4) & 1) << 5) | (((lane >> 5) & 1) << 8); }
constexpr int v_rd_off(int d0, int ks, int half) { return d0 * 512 + ks * 4096 + half * 2048; }
__device__ __forceinline__ int crow(int r, int hi) { return (r & 3) + 8 * (r >> 2) + 4 * hi; }
__device__ __forceinline__ unsigned cvtpk(float lo, float hi) { unsigned r; asm volatile("v_cvt_pk_bf16_f32 %0, %1, %2" : "=v"(r) : "v"(lo), "v"(hi)); return r; }
__device__ __forceinline__ bf16x8 load8(const bf16* p) { return *reinterpret_cast<const bf16x8*>(p); }
__device__ __forceinline__ int t5_bucket(int rel) {
    const int b = rel > 0 ? 16 : 0; const int n = rel < 0 ? -rel : rel; int v;
    if (n < 8) v = n; else if (n < 12) v = 8; else if (n < 16) v = 9; else if (n < 23) v = 10; else if (n < 32) v = 11; else if (n < 46) v = 12; else if (n < 65) v = 13; else if (n < 91) v = 14; else v = 15;
    return b + v;
}
__device__ __forceinline__ void bias_tile(f32x16& p0, f32x16& p1, const float* tabp) {
#pragma unroll
    for (int r = 0; r < 16; ++r) { const int c = (r & 3) + 8 * (r >> 2); p0[r] += tabp[59 - c]; p1[r] += tabp[59 - c - 32]; }
}
__device__ __forceinline__ void partialSM(f32x16& p0, f32x16& p1, float& m_reg, float& mn, float& alpha) {
    float pmax = p0[0]; for (int r = 1; r < 16; ++r) pmax = fmaxf(pmax, p0[r]); for (int r = 0; r < 16; ++r) pmax = fmaxf(pmax, p1[r]);
    { auto rr = __builtin_amdgcn_permlane32_swap(__float_as_uint(pmax), __float_as_uint(pmax), false, false);
      pmax = fmaxf(__uint_as_float(rr[0]), __uint_as_float(rr[1])); }
    constexpr float C2 = 1.4426950408889634f * SCALE;
    if (__builtin_expect(__all((pmax - m_reg) * SCALE <= THR), 1)) { mn = m_reg; alpha = 1.f; }
    else { mn = fmaxf(m_reg, pmax); alpha = __builtin_amdgcn_exp2f((m_reg - mn) * C2); m_reg = mn; }
    const float mnL = -mn * C2;
    for (int r = 0; r < 16; ++r) p0[r] = fmaf(p0[r], C2, mnL); for (int r = 0; r < 16; ++r) p1[r] = fmaf(p1[r], C2, mnL);
    for (int r = 0; r < 16; ++r) p0[r] = __builtin_amdgcn_exp2f(p0[r]);
}
__device__ __forceinline__ void finishSM(f32x16& p0, f32x16& p1, float alpha, float& l_reg, bf16x8& pa0, bf16x8& pa1, bf16x8& pa2, bf16x8& pa3) {
    for (int r = 0; r < 16; ++r) p1[r] = __builtin_amdgcn_exp2f(p1[r]);
    float ps = 0; for (int r = 0; r < 16; ++r) ps += p0[r]; for (int r = 0; r < 16; ++r) ps += p1[r];
    { auto rr = __builtin_amdgcn_permlane32_swap(__float_as_uint(ps), __float_as_uint(ps), false, false);
      ps = __uint_as_float(rr[0]) + __uint_as_float(rr[1]); }
    l_reg = l_reg * alpha + ps;
#define PK4(P, B_, OUT) do { unsigned a0 = cvtpk(P[B_+0], P[B_+1]), a1 = cvtpk(P[B_+2], P[B_+3]);                          \
        unsigned b0 = cvtpk(P[B_+4], P[B_+5]), b1 = cvtpk(P[B_+6], P[B_+7]);                                             \
        auto r0 = __builtin_amdgcn_permlane32_swap(a0, b0, false, false); auto r1 = __builtin_amdgcn_permlane32_swap(a1, b1, false, false); \
        u32x4 w = {r0[0], r1[0], r0[1], r1[1]}; OUT = *reinterpret_cast<bf16x8*>(&w); } while (0)
    PK4(p0, 0, pa0); PK4(p0, 8, pa1); PK4(p1, 0, pa2); PK4(p1, 8, pa3);
#undef PK4
}
template <int KB>
__device__ __forceinline__ void qkt(f32x16& p0, f32x16& p1, const char* K_lds, int r32, int hi, const bf16x8* qr, bool act) {
    if (!act) { const float NEG = -__builtin_inff();
#pragma unroll
        for (int r = 0; r < 16; ++r) { p0[r] = NEG; p1[r] = NEG; } return; }
    p0 = f32x16{}; p1 = f32x16{};
    const char* kb[4];
#pragma unroll
    for (int dd = 0; dd < 4; ++dd) kb[dd] = K_lds + KB * SHM_K + KSWZ(r32, (dd * 16 + hi * 8) * 2);
#pragma unroll
    for (int d0 = 0; d0 < 8; ++d0) { const char* a = kb[d0 & 3] + (d0 >> 2) * 128;
        bf16x8 b0 = *reinterpret_cast<const bf16x8*>(a);
        bf16x8 b1 = *reinterpret_cast<const bf16x8*>(a + 32 * 256);
        p0 = __builtin_amdgcn_mfma_f32_32x32x16_bf16(b0, qr[d0], p0, 0, 0, 0);
        p1 = __builtin_amdgcn_mfma_f32_32x32x16_bf16(b1, qr[d0], p1, 0, 0, 0); }
}
template <int VB>
__device__ __forceinline__ void pv_tile(f32x16* o, int vb0, bf16x8 pa0, bf16x8 pa1, bf16x8 pa2, bf16x8 pa3, bool act) {
    if (!act) return;
#define TRRD(dst, off) asm volatile("ds_read_b64_tr_b16 %0, %1 offset:%2" : "=&v"(dst) : "v"(vb0), "i"(off) : "memory")
#define PV_D0(d0) do { s16x4 l0, l1, l2, l3, h0, h1, h2, h3; constexpr int b_ = VB * SHM_V + v_rd_off(d0, 0, 0); \
        TRRD(l0, b_); TRRD(h0, b_ + 2048); TRRD(l1, b_ + 4096); TRRD(h1, b_ + 6144); TRRD(l2, b_ + 8192); TRRD(h2, b_ + 10240); TRRD(l3, b_ + 12288); TRRD(h3, b_ + 14336); \
        asm volatile("s_waitcnt lgkmcnt(0)" ::: "memory"); SBAR();   \
        o[d0] = __builtin_amdgcn_mfma_f32_32x32x16_bf16(pa0, (bf16x8){l0[0], l0[1], l0[2], l0[3], h0[0], h0[1], h0[2], h0[3]}, o[d0], 0, 0, 0);   \
        o[d0] = __builtin_amdgcn_mfma_f32_32x32x16_bf16(pa1, (bf16x8){l1[0], l1[1], l1[2], l1[3], h1[0], h1[1], h1[2], h1[3]}, o[d0], 0, 0, 0);   \
        o[d0] = __builtin_amdgcn_mfma_f32_32x32x16_bf16(pa2, (bf16x8){l2[0], l2[1], l2[2], l2[3], h2[0], h2[1], h2[2], h2[3]}, o[d0], 0, 0, 0);   \
        o[d0] = __builtin_amdgcn_mfma_f32_32x32x16_bf16(pa3, (bf16x8){l3[0], l3[1], l3[2], l3[3], h3[0], h3[1], h3[2], h3[3]}, o[d0], 0, 0, 0); } while (0)
    PV_D0(0); PV_D0(1); PV_D0(2); PV_D0(3);
#undef PV_D0
#undef TRRD
}
struct BlockRef { const bf16* Q; const bf16* K; const bf16* V; bf16* O; int P0; };
struct Seam { bf16x8 qr[8]; bf16x8 st_v0, st_v1, st_k0, st_k1; };
#define ROW(p, k0, rr) ((p) + (size_t)((k0) + (rr)) * PITCH + sc)
#define VMW() asm volatile("s_waitcnt vmcnt(0)" ::: "memory")
#define VMWN(n) asm volatile("s_waitcnt vmcnt(%0)" :: "i"(n) : "memory")
#define SLOAD_H(Kp, Vp, k0) do { S.st_v0 = load8(ROW(Vp, k0, sr)); S.st_v1 = load8(ROW(Vp, k0, 32 + sr)); S.st_k0 = load8(ROW(Kp, k0, sr)); S.st_k1 = load8(ROW(Kp, k0, 32 + sr)); } while (0)
#define SWRITE_HK(bf) do { *(bf16x8*)(K_lds + (bf) * SHM_K + kws) = S.st_k0; *(bf16x8*)(K_lds + (bf) * SHM_K + kws + 32 * 256) = S.st_k1; } while (0)
#define SWRITE_HV(bf) do { *(bf16x8*)(V_lds + (bf) * SHM_V + vst0) = S.st_v0; *(bf16x8*)(V_lds + (bf) * SHM_V + vst1) = S.st_v1; } while (0)
#define SWRITE_H(bf) do { SWRITE_HV(bf); SWRITE_HK(bf); } while (0)
__device__ __forceinline__ void attn_prime(const BlockRef& cur, char* lds, Seam& S) {
    const int tid = threadIdx.x, wid = __builtin_amdgcn_readfirstlane(tid >> 6), lane = tid & 63, r32 = lane & 31, hi = lane >> 5;
    const int sr = tid >> 4, sc = (tid & 15) * 8, kws = KSWZ(sr, sc * 2); char* K_lds = lds + 2 * SHM_V;
#pragma unroll
    for (int d0 = 0; d0 < 8; ++d0) S.qr[d0] = load8(cur.Q + (size_t)(wid * QBLK + r32) * PITCH + d0 * 16 + hi * 8);
    SLOAD_H(cur.K, cur.V, 0); VMW(); SWRITE_HK(0);
    __syncthreads();
}
__device__ __forceinline__ void attn_block(const BlockRef& cur, const BlockRef& nxt, char* lds, Seam& S) {
    const int tid = threadIdx.x, wid = __builtin_amdgcn_readfirstlane(tid >> 6), lane = tid & 63, r32 = lane & 31, hi = lane >> 5;
    const int NT = cur.P0 / KVBLK + QB / KVBLK;
    const int qlo = cur.P0 + wid * QBLK, cw = qlo >> 6;
    char* V_lds = lds; char* K_lds = lds + 2 * SHM_V;
    float* ws = (float*)(lds + 2 * SHM_V + 2 * SHM_K) + wid * 64; float* li_l = ws, * al_l = ws + 32;
    const float* btab = (const float*)(lds + BIAS_OFF);
    float m_reg = -1e30f, l_reg = 0; f32x16 o[4] = {};
    const int sr = tid >> 4, sc = (tid & 15) * 8, vst0 = v_st(sr, sc), vst1 = v_st(32 + sr, sc), kws = KSWZ(sr, sc * 2);
    const int vb0 = (int)(uintptr_t)V_lds + v_rd_base(lane);
    const bf16* Kh = cur.K; const bf16* Vh = cur.V;
    const int bb0 = qlo + r32 - 4 * hi + 4;
#define RESC(a) do { if (__any((a) < 1.f)) { if (hi == 0) al_l[r32] = (a); asm volatile("s_waitcnt lgkmcnt(0)" ::: "memory");              \
                     for (int d_ = 0; d_ < 4; ++d_) for (int r = 0; r < 16; ++r) o[d_][r] *= al_l[crow(r, hi)]; } } while (0)
#define KBASE(t) ((t) * KVBLK)
#define ACT(t) ((t) <= cw)
#define BIAST(P0_, P1_, t) do { if ((t) <= cw && (t) + 2 >= cw) bias_tile(P0_, P1_, btab + (bb0 - KBASE(t))); } while (0)
    constexpr int NQL = 8;
#define SEAM_K0() do { VMWN(NQL); SWRITE_HK(0); SBAR(); } while (0)
    f32x16 pA0, pA1, pB0, pB1; float mnA, mnB, alA, alB; bf16x8 pa0, pa1, pa2, pa3;
    SWRITE_HV(0); SBAR();
    SLOAD_H(Kh, Vh, KBASE(1));
    SBAR(); qkt<0>(pA0, pA1, K_lds, r32, hi, S.qr, ACT(0));
    BIAST(pA0, pA1, 0); partialSM(pA0, pA1, m_reg, mnA, alA);
    VMW(); SWRITE_H(1);
    __syncthreads();
#define HALF_STEP(PX0, PX1, mnX, alX, PY0, PY1, alY, t, KB, VB, SB) do {                                                      \
        SBAR(); qkt<KB>(PX0, PX1, K_lds, r32, hi, S.qr, ACT(t));                                                 \
        finishSM(PY0, PY1, alY, l_reg, pa0, pa1, pa2, pa3); SBAR();                                                           \
        if ((t) + 1 < NT) { SLOAD_H(Kh, Vh, KBASE((t) + 1)); SBAR(); }                                                         \
        pv_tile<VB>(o, vb0, pa0, pa1, pa2, pa3, ACT((t) - 1)); BIAST(PX0, PX1, (t)); partialSM(PX0, PX1, m_reg, mnX, alX);    \
        __syncthreads();                                                                                                      \
        if ((t) + 1 < NT) { VMW(); SWRITE_H(SB); }                                                                             \
        RESC(alX); __syncthreads(); } while (0)
    for (int t = 1; t + 1 < NT; t += 2) {
        HALF_STEP(pB0, pB1, mnB, alB, pA0, pA1, alA, t, 1, 0, 0);
        HALF_STEP(pA0, pA1, mnA, alA, pB0, pB1, alB, t + 1, 0, 1, 1);
    }
    { SBAR(); qkt<1>(pB0, pB1, K_lds, r32, hi, S.qr, ACT(NT - 1)); SBAR(); }
    SLOAD_H(nxt.K, nxt.V, 0); SBAR();
#pragma unroll
    for (int d0 = 0; d0 < 8; ++d0) S.qr[d0] = load8(nxt.Q + (size_t)(wid * QBLK + r32) * PITCH + d0 * 16 + hi * 8);
    SBAR();
    finishSM(pA0, pA1, alA, l_reg, pa0, pa1, pa2, pa3); SBAR();
    pv_tile<0>(o, vb0, pa0, pa1, pa2, pa3, ACT(NT - 2));
    { BIAST(pB0, pB1, NT - 1); partialSM(pB0, pB1, m_reg, mnB, alB); __syncthreads(); RESC(alB);
      finishSM(pB0, pB1, alB, l_reg, pa0, pa1, pa2, pa3); SBAR(); pv_tile<1>(o, vb0, pa0, pa1, pa2, pa3, ACT(NT - 1)); }
    SBAR(); SEAM_K0();
    if (hi == 0) li_l[r32] = l_reg; asm volatile("s_waitcnt lgkmcnt(0)" ::: "memory");
    float rli[16];
#pragma unroll
    for (int r = 0; r < 16; ++r) rli[r] = __builtin_amdgcn_rcpf(li_l[crow(r, hi)]);
    bf16* Ow = cur.O + (size_t)(wid * QBLK) * PITCH;
#pragma unroll
    for (int r = 0; r < 16; ++r) { const int orow = crow(r, hi);
#pragma unroll
        for (int d0 = 0; d0 < 4; ++d0) { const float v = o[d0][r] * rli[r];
            const float vn = __shfl_xor(v, 1);
            if ((r32 & 1) == 0) *(unsigned*)(Ow + (size_t)orow * PITCH + d0 * 32 + r32) = cvtpk(v, vn); } }
    __syncthreads();
#undef RESC
#undef KBASE
#undef ACT
#undef BIAST
#undef SEAM_K0
#undef HALF_STEP
}
#undef ROW
#undef VMW
#undef VMWN
#undef SLOAD_H
#undef SWRITE_HK
#undef SWRITE_HV
#undef SWRITE_H
#undef KSWZ
}

namespace attn2 {
using attn::bf16x8; using attn::s16x4; using attn::f32x16; using attn::u32x4; using attn::bf16;
using attn::v_st; using attn::v_rd_base; using attn::crow; using attn::cvtpk; using attn::load8; using attn::t5_bucket;
constexpr int D = 128, PITCH = 1024;
constexpr float SCALE = 0.08838834764831845f, THR = 8.f;
constexpr int NW = 8, QBLK = 32, KVBLK = 64, QB = 4 * QBLK;
constexpr int IMG = KVBLK * D * 2, SHM_V = 2 * IMG, SHM_K = KVBLK * D * 2;
constexpr int OFF_V = 0, OFF_K = 2 * SHM_V, OFF_PX = OFF_K + 2 * SHM_K, OFF_WS = OFF_PX + NW * 2048, OFF_MX = OFF_WS + NW * 64 * 4, BIAS_OFF = OFF_MX + NW * 32 * 4, NBIAS = 320;
constexpr int LDS_BYTES = BIAS_OFF + NBIAS * 4;
#define KSWZ(row, colB) ((row) * 256 + ((colB) ^ (((row) & 7) << 4)))
#define SBAR() __builtin_amdgcn_sched_barrier(0)
#ifndef ATTN_SGB
#define ATTN_SGB 1
#endif
#if ATTN_SGB
#define SGB_A() do { _Pragma("unroll") for (int g_ = 0; g_ < 8; ++g_) { __builtin_amdgcn_sched_group_barrier(0x008, 1, 0); __builtin_amdgcn_sched_group_barrier(0x402, 9, 0); } } while (0)
#else
#define SGB_A() do {} while (0)
#endif
#define L3 __attribute__((address_space(3)))
#define LP(T, byteoff) ((L3 T*)(uintptr_t)(unsigned)(byteoff))
__device__ __forceinline__ void bias_half(f32x16& p, const L3 float* tabp) {
#pragma unroll
    for (int r = 0; r < 16; ++r) { const int c = (r & 3) + 8 * (r >> 2); p[r] += tabp[59 - c]; }
}
__device__ __forceinline__ float rowmax_half(const f32x16& p) {
    float pmax = p[0];
#pragma unroll
    for (int r = 1; r < 16; ++r) pmax = fmaxf(pmax, p[r]);
    const auto rr = __builtin_amdgcn_permlane32_swap(__float_as_uint(pmax), __float_as_uint(pmax), false, false);
    return fmaxf(__uint_as_float(rr[0]), __uint_as_float(rr[1]));
}
__device__ __forceinline__ void partialSM(f32x16& p, float pmax, float& m_reg, float& alpha) {
    constexpr float C2 = 1.4426950408889634f * SCALE; float mn;
    if (__builtin_expect(__all((pmax - m_reg) * SCALE <= THR), 1)) { mn = m_reg; alpha = 1.f; }
    else { mn = fmaxf(m_reg, pmax); alpha = __builtin_amdgcn_exp2f((m_reg - mn) * C2); m_reg = mn; }
    const float mnL = -mn * C2;
#pragma unroll
    for (int r = 0; r < 16; ++r) p[r] = fmaf(p[r], C2, mnL);
#pragma unroll
    for (int r = 0; r < 8; ++r) p[r] = __builtin_amdgcn_exp2f(p[r]);
}
__device__ __forceinline__ void finishSM(f32x16& p, float alpha, float& l_reg, bf16x8& pa0, bf16x8& pa1) {
#pragma unroll
    for (int r = 8; r < 16; ++r) p[r] = __builtin_amdgcn_exp2f(p[r]);
    float ps = 0;
#pragma unroll
    for (int r = 0; r < 16; ++r) ps += p[r];
    { const auto rr = __builtin_amdgcn_permlane32_swap(__float_as_uint(ps), __float_as_uint(ps), false, false); ps = __uint_as_float(rr[0]) + __uint_as_float(rr[1]); }
    l_reg = l_reg * alpha + ps;
#define PK4(P, B_, OUT) do { unsigned a0 = cvtpk(P[B_+0], P[B_+1]), a1 = cvtpk(P[B_+2], P[B_+3]);                          \
        unsigned b0 = cvtpk(P[B_+4], P[B_+5]), b1 = cvtpk(P[B_+6], P[B_+7]);                                             \
        auto r0 = __builtin_amdgcn_permlane32_swap(a0, b0, false, false); auto r1 = __builtin_amdgcn_permlane32_swap(a1, b1, false, false); \
        u32x4 w = {r0[0], r1[0], r0[1], r1[1]}; OUT = *reinterpret_cast<bf16x8*>(&w); } while (0)
    PK4(p, 0, pa0); PK4(p, 8, pa1);
#undef PK4
}
template <int KB>
__device__ __forceinline__ void kload(bf16x8* kf, unsigned K_lds, int krow, int hi) {
    unsigned kb[4];
#pragma unroll
    for (int dd = 0; dd < 4; ++dd) kb[dd] = K_lds + KB * SHM_K + KSWZ(krow, (dd * 16 + hi * 8) * 2);
#pragma unroll
    for (int d0 = 0; d0 < 8; ++d0) kf[d0] = *LP(const bf16x8, kb[d0 & 3] + (d0 >> 2) * 128);
}
__device__ __forceinline__ void qmma(f32x16& p, const bf16x8* kf, const bf16x8* qr) {
    p = f32x16{};
#pragma unroll
    for (int d0 = 0; d0 < 8; ++d0) p = __builtin_amdgcn_mfma_f32_32x32x16_bf16(kf[d0], qr[d0], p, 0, 0, 0);
}
__device__ __forceinline__ void pneg(f32x16& p) { const float NEG = -__builtin_inff();
#pragma unroll
    for (int r = 0; r < 16; ++r) p[r] = NEG; }
template <int VB>
__device__ __forceinline__ void pv_tile(f32x16* o, int vbo, int vbp, bf16x8 po0, bf16x8 po1, bf16x8 pp0, bf16x8 pp1, bool act) {
    if (!act) return;
#define TRRD(dst, base, off) asm volatile("ds_read_b64_tr_b16 %0, %1 offset:%2" : "=&v"(dst) : "v"(base), "i"(off) : "memory")
#define PV_D0(d0) do { s16x4 l0, l1, l2, l3, h0, h1, h2, h3; constexpr int b_ = VB * SHM_V + (d0) * 512; \
        TRRD(l0, vbo, b_); TRRD(h0, vbo, b_ + 2048); TRRD(l1, vbo, b_ + 4096); TRRD(h1, vbo, b_ + 6144); TRRD(l2, vbp, b_); TRRD(h2, vbp, b_ + 2048); TRRD(l3, vbp, b_ + 4096); TRRD(h3, vbp, b_ + 6144); \
        asm volatile("s_waitcnt lgkmcnt(0)" ::: "memory"); SBAR();   \
        o[d0] = __builtin_amdgcn_mfma_f32_32x32x16_bf16(po0, (bf16x8){l0[0], l0[1], l0[2], l0[3], h0[0], h0[1], h0[2], h0[3]}, o[d0], 0, 0, 0);   \
        o[d0] = __builtin_amdgcn_mfma_f32_32x32x16_bf16(po1, (bf16x8){l1[0], l1[1], l1[2], l1[3], h1[0], h1[1], h1[2], h1[3]}, o[d0], 0, 0, 0);   \
        o[d0] = __builtin_amdgcn_mfma_f32_32x32x16_bf16(pp0, (bf16x8){l2[0], l2[1], l2[2], l2[3], h2[0], h2[1], h2[2], h2[3]}, o[d0], 0, 0, 0);   \
        o[d0] = __builtin_amdgcn_mfma_f32_32x32x16_bf16(pp1, (bf16x8){l3[0], l3[1], l3[2], l3[3], h3[0], h3[1], h3[2], h3[3]}, o[d0], 0, 0, 0); } while (0)
    PV_D0(0); PV_D0(1); PV_D0(2); PV_D0(3);
#undef PV_D0
#undef TRRD
}
struct BlockRef { const bf16* Q; const bf16* K; const bf16* V; bf16* O; int P0; };
struct Seam { bf16x8 qr[8]; bf16x8 k0[2], k1[2], v0[2], v1[2], v2[2], v3[2]; };
#define VMW() asm volatile("s_waitcnt vmcnt(0)" ::: "memory")
typedef __amdgpu_buffer_rsrc_t rsrc_t;
__device__ __forceinline__ rsrc_t mkrsrc(const bf16* p) { return __builtin_amdgcn_make_buffer_rsrc((void*)p, (short)0, 0x7fffffff, 0x00020000); }
__device__ __forceinline__ bf16x8 bld16(rsrc_t r, unsigned voff, unsigned soff) { return __builtin_bit_cast(bf16x8, __builtin_amdgcn_raw_buffer_load_b128(r, (int)voff, (int)soff, 0)); }
#define RB(kk_, radd) ((unsigned)(((kk_) + (radd)) * PITCH) * 2u)
#define SLOADK(set, rK_, kk_) do { S.k0[set] = bld16(rK_, lofs, RB(kk_, 0)); S.k1[set] = bld16(rK_, lofs, RB(kk_, 32)); } while (0)
#define SLOADV(set, rV_, kk_) do { S.v0[set] = bld16(rV_, lofs, RB(kk_, 0)); S.v1[set] = bld16(rV_, lofs, RB(kk_, 32)); S.v2[set] = bld16(rV_, lofs, RB(kk_, 0) + 256u); S.v3[set] = bld16(rV_, lofs, RB(kk_, 32) + 256u); } while (0)
#define SWRITE_K(bf, set) do { *LP(bf16x8, K_lds + (bf) * SHM_K + kws) = S.k0[set]; *LP(bf16x8, K_lds + (bf) * SHM_K + kws + 32 * 256) = S.k1[set]; } while (0)
#define SWRITE_V(bf, set) do { *LP(bf16x8, V_lds + (bf) * SHM_V + vst0) = S.v0[set]; *LP(bf16x8, V_lds + (bf) * SHM_V + vst0 + VST1) = S.v1[set]; *LP(bf16x8, V_lds + (bf) * SHM_V + IMG + vst0) = S.v2[set]; *LP(bf16x8, V_lds + (bf) * SHM_V + IMG + vst0 + VST1) = S.v3[set]; } while (0)
__device__ __forceinline__ void attn_prime(const BlockRef& cur, char* lds, Seam& S, int tid) {
    const int wid = __builtin_amdgcn_readfirstlane(tid >> 6), lane = tid & 63, r32 = lane & 31, hi = lane >> 5, pj = wid & 3;
    const int sr = tid >> 4, sc = (tid & 15) * 8, kws = KSWZ(sr, sc * 2); const unsigned K_lds = (unsigned)(uintptr_t)lds + OFF_K, lofs = (unsigned)(sr * PITCH + sc) * 2u, qofs = (unsigned)(r32 * PITCH + hi * 8) * 2u;
    const rsrc_t rQ = mkrsrc(cur.Q), rK = mkrsrc(cur.K), rV = mkrsrc(cur.V);
#pragma unroll
    for (int d0 = 0; d0 < 8; ++d0) S.qr[d0] = bld16(rQ, qofs, (unsigned)((pj * QBLK) * PITCH + d0 * 16) * 2u);
    SLOADK(0, rK, 0); VMW(); SWRITE_K(0, 0); SBAR();
    SLOADK(1, rK, KVBLK); SLOADV(0, rV, 0); SLOADK(0, rK, 2 * KVBLK); SLOADV(1, rV, KVBLK);
    __syncthreads();
}
__device__ __forceinline__ void attn_block(const BlockRef& cur, const BlockRef& nxt, char* lds, Seam& S, int tid) {
    const int wid = __builtin_amdgcn_readfirstlane(tid >> 6), lane = tid & 63, r32 = lane & 31, hi = lane >> 5, pj = wid & 3, kh = wid >> 2, pw = wid ^ 4;
    const int NT = cur.P0 / KVBLK + QB / KVBLK, NTn = nxt.P0 / KVBLK + QB / KVBLK;
    const int qlo = cur.P0 + pj * QBLK, cw = qlo >> 6;
    const unsigned L = (unsigned)(uintptr_t)lds, V_lds = L + OFF_V, K_lds = L + OFF_K;
    L3 float* li_l = LP(float, L + OFF_WS + wid * 256); L3 float* al_l = li_l + 32; const L3 float* li_p = LP(const float, L + OFF_WS + pw * 256);
    L3 float* mx_o = LP(float, L + OFF_MX + wid * 128); const L3 float* mx_p = LP(const float, L + OFF_MX + pw * 128);
    const unsigned px_o = L + OFF_PX + wid * 2048 + lane * 16, px_p = L + OFF_PX + pw * 2048 + lane * 16;
    const L3 float* btab = LP(const float, L + BIAS_OFF);
    float m_reg = -1e30f, l_reg = 0; f32x16 o[4] = {};
    const int sr = tid >> 4, sc = (tid & 15) * 8, vst0 = v_st(sr, sc), kws = KSWZ(sr, sc * 2); constexpr int VST1 = 8192;
    const unsigned lofs = (unsigned)(sr * PITCH + sc) * 2u, qofs = (unsigned)(r32 * PITCH + hi * 8) * 2u;
    const int vbase = (int)V_lds + v_rd_base(lane) + kh * IMG, vbo = vbase + kh * 8192, vbp = vbase + (1 - kh) * 8192;
    const int krow = kh * 32 + r32;
    const rsrc_t cK = mkrsrc(cur.K), cV = mkrsrc(cur.V), nK = mkrsrc(nxt.K), nV = mkrsrc(nxt.V);
    const int bb0 = qlo + r32 - 4 * hi + 4 - 32 * kh;
#define RESC(a) do { if (__any((a) < 1.f)) { if (hi == 0) al_l[r32] = (a); asm volatile("s_waitcnt lgkmcnt(0)" ::: "memory");              \
                     for (int d_ = 0; d_ < 4; ++d_) for (int r = 0; r < 16; ++r) o[d_][r] *= al_l[crow(r, hi)]; } } while (0)
#define KBASE(t) ((t) * KVBLK)
#define ACT(t) ((t) <= cw)
#define BIAST(P_, t) do { if ((t) <= cw && (t) + 2 >= cw) bias_half(P_, btab + (bb0 - KBASE(t))); } while (0)
#define PUTMAX(P_) do { const float pm_ = rowmax_half(P_); if (hi == 0) mx_o[r32] = pm_; pmx = pm_; } while (0)
#define GETMAX() fmaxf(pmx, mx_p[r32])
#define VLOADK(set, v) do { const int v_ = (v); if (v_ < NT) SLOADK(set, cK, KBASE(v_)); else SLOADK(set, nK, KBASE((v_ - NT) % NTn)); } while (0)
#define VLOADV(set, v) do { const int v_ = (v); if (v_ < NT) SLOADV(set, cV, KBASE(v_)); else SLOADV(set, nV, KBASE((v_ - NT) % NTn)); } while (0)
    f32x16 pA, pB; float alA, alB, pmx; bf16x8 po0, po1, pp0, pp1;
#define STEP(PX_, alX, PY_, alY, t, KB, HASPREV) do {                                                                               \
        SBAR(); SWRITE_V(KB, KB); SBAR(); VLOADV(KB, (t) + 2); SBAR();                                                               \
        if (ACT(t)) { bf16x8 kf_[8]; kload<KB>(kf_, K_lds, krow, hi); SBAR(); qmma(PX_, kf_, S.qr);                                  \
                      if (HASPREV) { finishSM(PY_, alY, l_reg, po0, po1); *LP(bf16x8, px_o) = po0; *LP(bf16x8, px_o + 1024) = po1; } SGB_A(); }   \
        else { pneg(PX_); if (HASPREV) { finishSM(PY_, alY, l_reg, po0, po1); *LP(bf16x8, px_o) = po0; *LP(bf16x8, px_o + 1024) = po1; } }        \
        SBAR(); BIAST(PX_, (t)); PUTMAX(PX_);                                                                                       \
        __syncthreads();                                                                                                           \
        if (HASPREV) { pp0 = *LP(const bf16x8, px_p); pp1 = *LP(const bf16x8, px_p + 1024); }                                        \
        partialSM(PX_, GETMAX(), m_reg, alX);                                                                                      \
        if (HASPREV) pv_tile<1 - KB>(o, vbo, vbp, po0, po1, pp0, pp1, ACT((t) - 1));                                                \
        SBAR(); SWRITE_K(1 - KB, 1 - KB); SBAR(); VLOADK(1 - KB, (t) + 3); SBAR();                                                   \
        RESC(alX); __syncthreads(); } while (0)
    for (int t = 0; t < NT; t += 2) {
        STEP(pA, alA, pB, alB, t, 0, t > 0);
        STEP(pB, alB, pA, alA, t + 1, 1, true);
    }
    { const rsrc_t nQ = mkrsrc(nxt.Q);
#pragma unroll
      for (int d0 = 0; d0 < 8; ++d0) S.qr[d0] = bld16(nQ, qofs, (unsigned)((pj * QBLK) * PITCH + d0 * 16) * 2u); }
    SBAR();
    finishSM(pB, alB, l_reg, po0, po1); *LP(bf16x8, px_o) = po0; *LP(bf16x8, px_o + 1024) = po1;
    if (hi == 0) li_l[r32] = l_reg;
    __syncthreads();
    pp0 = *LP(const bf16x8, px_p); pp1 = *LP(const bf16x8, px_p + 1024);
    pv_tile<1>(o, vbo, vbp, po0, po1, pp0, pp1, ACT(NT - 1));
    float rli[16];
#pragma unroll
    for (int r = 0; r < 16; ++r) rli[r] = __builtin_amdgcn_rcpf(li_l[crow(r, hi)] + li_p[crow(r, hi)]);
    int lane_off = hi * 4 * PITCH + r32; asm volatile("" : "+v"(lane_off));
    bf16* Ow = cur.O + ((pj * QBLK) * PITCH + kh * 128 + lane_off);
#pragma unroll
    for (int r = 0; r < 16; ++r) { const int orow = (r & 3) + 8 * (r >> 2);
#pragma unroll
        for (int d0 = 0; d0 < 4; ++d0) { const float v = o[d0][r] * rli[r];
            const float vn = __shfl_xor(v, 1);
            if ((r32 & 1) == 0) *(unsigned*)(Ow + (orow * PITCH + d0 * 32)) = cvtpk(v, vn); } }
    __syncthreads();
#undef RESC
#undef KBASE
#undef ACT
#undef BIAST
#undef PUTMAX
#undef GETMAX
#undef VLOADK
#undef VLOADV
#undef STEP
}
#undef SLOADK
#undef SLOADV
#undef SWRITE_K
#undef SWRITE_V
#undef VMW
#undef RB
#undef KSWZ
#undef L3
#undef LP
#undef SGB_A
}


constexpr int NWAVES = 8;
constexpr int BATCH = 16, SEQ = 2048, T = BATCH * SEQ, D = 1024, NIN = 8192, NE = 32, DE = 512;
constexpr int MAXT = 288, MAXS = MAXT * 256;
constexpr float LN_EPS = 1e-5f, RMS_EPS = 1e-6f, ALPHA = 1.189207115002721f, LAM_INIT = 0.2f;
constexpr size_t MiB = 1u << 20;
constexpr size_t WS_CTL = 0, CTL_ZERO_BYTES = 1 * MiB;
constexpr size_t WS_STATS = 1 * MiB, WS_EID = WS_STATS + 256 * 1024, WS_EW = WS_EID + 256 * 1024, WS_RANK = WS_EW + 256 * 1024, WS_SLOT = 2 * MiB, WS_CNTWG = WS_SLOT + 256 * 1024, WS_TOK = 3 * MiB, WS_IDL = WS_TOK + 512 * 1024;
constexpr size_t WS_WA = 4 * MiB, WS_WB = 6 * MiB, WS_WO = 8 * MiB, WS_WIN = 10 * MiB;
constexpr size_t WS_XN = 26 * MiB, WS_Q = 90 * MiB, WS_K = 154 * MiB, WS_V = 218 * MiB, WS_CB = 282 * MiB, WS_Z = 346 * MiB, WS_O1 = 410 * MiB;
constexpr size_t WS_WGU = 90 * MiB, WS_WD = 154 * MiB, WS_PRE = 186 * MiB, WS_XG = 314 * MiB, WS_END = 458 * MiB;
constexpr size_t WS_WGU8 = 90 * MiB, WS_WD8 = 122 * MiB, WS_X18 = 250 * MiB;
constexpr int CW_TMO = 0, CW_CODE = 1, CW_BAR = 4096, CW_MOE = 65536;
constexpr int RING_OFF = 0, RING_BYTES = 131072, RW_BYTES = 147456;
constexpr int LDSCTL_OFF = RW_BYTES, MISC_OFF = LDSCTL_OFF + 320, TAB_OFF = LDSCTL_OFF + 512, RSCR_OFF = LDSCTL_OFF + 1024;
constexpr int LDS_BYTES = 163840;
static_assert(RSCR_OFF + 8 * 128 * 4 + 1024 <= LDS_BYTES, "LDS map");

#define GAS __attribute__((address_space(1)))
#define LAS __attribute__((address_space(3)))
typedef unsigned short bf16;
#ifdef SWAP_CB_SGA
#define BUF_CB(P)  ((bf16*)(P).out)
#define BUF_SGA(P) ((bf16*)((P).ws + WS_CB))
#else
#define BUF_CB(P)  ((bf16*)((P).ws + WS_CB))
#define BUF_SGA(P) ((bf16*)(P).out)
#endif
#define BUF_SGB(P) ((bf16*)(P).out + (size_t)T * D)
typedef unsigned v4u __attribute__((ext_vector_type(4)));
typedef unsigned v2u __attribute__((ext_vector_type(2)));
typedef float f32x4 __attribute__((ext_vector_type(4)));
typedef GAS unsigned gu32;
#define RLX_AGENT __ATOMIC_RELAXED, __HIP_MEMORY_SCOPE_AGENT
#define LDS_WAIT() asm volatile("s_waitcnt lgkmcnt(0)" ::: "memory")
#define VM_WAIT() asm volatile("s_waitcnt vmcnt(0)" ::: "memory")
__device__ __forceinline__ unsigned f2bf(float f) { unsigned u = __builtin_bit_cast(unsigned, f); return (u + 0x7fffu + ((u >> 16) & 1u)) >> 16; }
__device__ __forceinline__ unsigned pk2(float lo, float hi) { return f2bf(lo) | (f2bf(hi) << 16); }
__device__ __forceinline__ float bflo(unsigned w) { return __uint_as_float(w << 16); }
__device__ __forceinline__ float bfhi(unsigned w) { return __uint_as_float(w & 0xffff0000u); }

#define XB_TMO      128
#define XB_XCNT(j)  (256  + 64 * (j))
#define XB_XSUB(j)  (1280 + 64 * (j))
#define XB_XGEN(j)  (2304 + 64 * (j))
#define XB_TOP      3328
#define XB_TOPGEN   3392
#define XCD_BAR_WORDS 3456
#define XB_SPIN_CAP (1u << 18)
__device__ __forceinline__ unsigned xb_ld(unsigned* p)              { return __hip_atomic_load(p, __ATOMIC_RELAXED, __HIP_MEMORY_SCOPE_AGENT); }
__device__ __forceinline__ unsigned xb_add(unsigned* p, unsigned v) { return __hip_atomic_fetch_add(p, v, __ATOMIC_RELAXED, __HIP_MEMORY_SCOPE_AGENT); }
__device__ __forceinline__ unsigned xb_xcc_id() { return (unsigned)__builtin_amdgcn_s_getreg((3 << 11) | 20) & 0xFu; }
#define XB_SPIN(cond, bar) do { unsigned _sp = 0; while (cond) { __builtin_amdgcn_s_sleep(1); \
    if ((++_sp & 255u) == 0u) { if (xb_ld(&(bar)[XB_TMO])) break; if (_sp > XB_SPIN_CAP) { atomicAdd(&(bar)[XB_TMO], 1u); break; } } } } while (0)
struct XcdBarrier { unsigned* bar; unsigned x; volatile LAS unsigned* st; };
__device__ __forceinline__ XcdBarrier xcd_barrier_post(unsigned* bar, volatile LAS unsigned* st) {
    XcdBarrier b; b.bar = bar; b.x = xb_xcc_id(); b.st = st;
    if (threadIdx.x == 0) (void)xb_add(&bar[XB_XCNT(b.x)], 1u);
    return b;
}
__device__ __forceinline__ void xcd_barrier_complete(unsigned* bar, unsigned x, unsigned& nloc, unsigned& nx) {
    const unsigned G = gridDim.x * gridDim.y * gridDim.z;
    unsigned sum, cnt, mine, sp = 0u;
    for (;;) {
        sum = 0u; cnt = 0u; mine = 0u;
#pragma unroll
        for (unsigned j = 0; j < 16; ++j) { const unsigned c = xb_ld(&bar[XB_XCNT(j)]); sum += c; cnt += (c > 0u) ? 1u : 0u; mine = (j == x) ? c : mine; }
        if (sum == G) break;
        __builtin_amdgcn_s_sleep(1);
        if ((++sp & 255u) == 0u) { if (xb_ld(&bar[XB_TMO])) break; if (sp > XB_SPIN_CAP) { atomicAdd(&bar[XB_TMO], 1u); break; } }
    }
    nloc = mine > 0u ? mine : 1u; nx = cnt > 0u ? cnt : 1u;
}
__device__ __forceinline__ void xcd_barrier(const XcdBarrier& b) {
    asm volatile("s_waitcnt vmcnt(0)" ::: "memory");
    __syncthreads();
    if (threadIdx.x == 0) {
        unsigned* bar = b.bar;
        __builtin_amdgcn_s_waitcnt(0);
        unsigned nloc = b.st[0], nx = b.st[1];
        if (nloc == 0u) { xcd_barrier_complete(bar, b.x, nloc, nx); b.st[0] = nloc; b.st[1] = nx; }
        const unsigned old = xb_add(&bar[XB_XSUB(b.x)], 1u);
        const unsigned gen = old / nloc;
        if (old + 1u == (gen + 1u) * nloc) {
            __builtin_amdgcn_fence(__ATOMIC_RELEASE, "agent");
            asm volatile("s_waitcnt vmcnt(0)" ::: "memory");
            const unsigned og = xb_add(&bar[XB_TOP], 1u);
            const unsigned tg = og / nx;
            if (og + 1u == (tg + 1u) * nx) xb_add(&bar[XB_TOPGEN], 1u);
            else XB_SPIN(xb_ld(&bar[XB_TOPGEN]) == tg, bar);
            __builtin_amdgcn_fence(__ATOMIC_ACQUIRE, "agent");
            xb_add(&bar[XB_XGEN(b.x)], 1u);
            asm volatile("s_waitcnt vmcnt(0)" ::: "memory");
        } else {
            XB_SPIN(xb_ld(&bar[XB_XGEN(b.x)]) == gen, bar);
            __builtin_amdgcn_fence(__ATOMIC_ACQUIRE, "agent");
            asm volatile("s_waitcnt vmcnt(0)" ::: "memory");
        }
    }
    __syncthreads();
}

struct Frame {
    LAS unsigned char* lds; volatile LAS unsigned* MISC; gu32* ctl;
    int tid, lane, wave, vcu, G;
};
__device__ __forceinline__ float wave_sum(float v) {
#pragma unroll
    for (int o = 1; o < 64; o <<= 1) v += __shfl_xor(v, o);
    return v;
}
__device__ __forceinline__ float wave_sum_fast(float v) {
    v += __int_as_float(__builtin_amdgcn_update_dpp(0, __float_as_int(v), 0x128, 0xf, 0xf, false));
    v += __int_as_float(__builtin_amdgcn_update_dpp(0, __float_as_int(v), 0x124, 0xf, 0xf, false));
    v += __int_as_float(__builtin_amdgcn_update_dpp(0, __float_as_int(v), 0x122, 0xf, 0xf, false));
    v += __int_as_float(__builtin_amdgcn_update_dpp(0, __float_as_int(v), 0x121, 0xf, 0xf, false));
    const int vi = __float_as_int(v);
    return (__int_as_float(__builtin_amdgcn_readlane(vi, 0)) + __int_as_float(__builtin_amdgcn_readlane(vi, 16))) + (__int_as_float(__builtin_amdgcn_readlane(vi, 32)) + __int_as_float(__builtin_amdgcn_readlane(vi, 48)));
}
__device__ __forceinline__ void transpose_item(const float* W, int K, int N, int k0, int n0, bf16* WT, int drow0, LAS float* scr, int lane) {
#pragma unroll 8
    for (int i = 0; i < 32; ++i) { const int kk = 2 * i + (lane >> 5); scr[kk * 33 + (lane & 31)] = W[(size_t)(k0 + kk) * N + n0 + (lane & 31)]; }
    LDS_WAIT(); asm volatile("" ::: "memory");
    const int c = lane & 7;
#pragma unroll
    for (int j = 0; j < 4; ++j) { const int n = (lane >> 3) + 8 * j; const LAS float* s = scr + (8 * c) * 33 + n;
        v4u o; o.x = pk2(s[0 * 33], s[1 * 33]); o.y = pk2(s[2 * 33], s[3 * 33]); o.z = pk2(s[4 * 33], s[5 * 33]); o.w = pk2(s[6 * 33], s[7 * 33]);
        *(GAS v4u*)(WT + (size_t)(drow0 + n) * K + k0 + 8 * c) = o; }
    LDS_WAIT(); asm volatile("" ::: "memory");
}
__device__ __forceinline__ void transpose_item8(const float* W, int K, int N, int k0, int n0, unsigned char* WT, int drow0, LAS float* scr, int lane) {
#pragma unroll 8
    for (int i = 0; i < 32; ++i) { const int kk = 2 * i + (lane >> 5); scr[kk * 33 + (lane & 31)] = W[(size_t)(k0 + kk) * N + n0 + (lane & 31)]; }
    LDS_WAIT(); asm volatile("" ::: "memory");
    const int c = lane & 7; constexpr float sc = pg8::F8_WS;
#pragma unroll
    for (int j = 0; j < 4; ++j) { const int n = (lane >> 3) + 8 * j; const LAS float* s = scr + (8 * c) * 33 + n;
        v2u o; o.x = pg8::pk4_fp8(s[0 * 33] * sc, s[1 * 33] * sc, s[2 * 33] * sc, s[3 * 33] * sc); o.y = pg8::pk4_fp8(s[4 * 33] * sc, s[5 * 33] * sc, s[6 * 33] * sc, s[7 * 33] * sc);
        *(GAS v2u*)(WT + (size_t)(drow0 + n) * K + k0 + 8 * c) = o; }
    LDS_WAIT(); asm volatile("" ::: "memory");
}
__device__ __forceinline__ int win_drow(int n0) {
    if (n0 < 4096 || n0 >= 6144) return n0;
    if (n0 < 5120) { const int r = n0 - 4096; return 4096 + 256 * (r >> 7) + (r & 127); }
    const int r = n0 - 5120; return 4096 + 256 * (r >> 7) + 128 + (r & 127);
}
struct Ptrs {
    const float *x, *ln_in_g, *ln_in_b, *w_in, *b_gate, *lq, *lk, *subln_g, *rel_bias, *conv_w, *w_a, *w_b, *w_o, *ln1_g, *ln1_b, *w_group, *b_group, *w_sub, *b_sub, *w_gate_e, *w_up_e, *w_down_e, *ln2_g, *ln2_b;
    float* out; unsigned char* ws;
};
__device__ __forceinline__ void p0_prologue(Frame& F, const Ptrs& P) {
    LAS float* scr = (LAS float*)(F.lds + RING_OFF + F.wave * 16384);
    const int gw = F.vcu * NWAVES + F.wave, NGW = F.G * NWAVES;
    constexpr int I_IN = (D / 64) * (NIN / 32), I_SQ = (D / 64) * (D / 32);
    bf16* Wt_in = (bf16*)(P.ws + WS_WIN); bf16* Wt_a = (bf16*)(P.ws + WS_WA); bf16* Wt_b = (bf16*)(P.ws + WS_WB); bf16* Wt_o = (bf16*)(P.ws + WS_WO);
    for (int it = gw; it < I_IN + 3 * I_SQ; it += NGW) {
        int r = it;
        if (r < I_IN) { const int kb = r / (NIN / 32), nb = r % (NIN / 32); transpose_item(P.w_in, D, NIN, 64 * kb, 32 * nb, Wt_in, win_drow(32 * nb), scr, F.lane); continue; } r -= I_IN;
        const int which = r / I_SQ; r -= which * I_SQ; const int kb = r / (D / 32), nb = r % (D / 32);
        const float* W = which == 0 ? P.w_a : (which == 1 ? P.w_b : P.w_o); bf16* WT = which == 0 ? Wt_a : (which == 1 ? Wt_b : Wt_o);
        transpose_item(W, D, D, 64 * kb, 32 * nb, WT, 32 * nb, scr, F.lane);
    }
    bf16* XN = (bf16*)(P.ws + WS_XN); float* stats = (float*)(P.ws + WS_STATS);
    for (int m = gw; m < T; m += NGW) {
        const GAS f32x4* xr = (const GAS f32x4*)(P.x + (size_t)m * D) + F.lane;
        f32x4 v[4]; float s = 0.f;
#pragma unroll
        for (int j = 0; j < 4; ++j) { v[j] = xr[64 * j]; s += (v[j].x + v[j].y) + (v[j].z + v[j].w); }
        const float mean = wave_sum(s) * (1.f / D); float s2 = 0.f;
#pragma unroll
        for (int j = 0; j < 4; ++j) { v[j] = v[j] - mean; s2 += (v[j].x * v[j].x + v[j].y * v[j].y) + (v[j].z * v[j].z + v[j].w * v[j].w); }
        const float rstd = 1.f / sqrtf(wave_sum(s2) * (1.f / D) + LN_EPS);
        GAS unsigned long long* o8 = (GAS unsigned long long*)(XN + (size_t)m * D) + F.lane;
#pragma unroll
        for (int j = 0; j < 4; ++j) { const f32x4 g = *((const GAS f32x4*)P.ln_in_g + F.lane + 64 * j), b = *((const GAS f32x4*)P.ln_in_b + F.lane + 64 * j); const f32x4 y = v[j] * rstd * g + b;
            o8[64 * j] = (unsigned long long)pk2(y.x, y.y) | ((unsigned long long)pk2(y.z, y.w) << 32); }
        if (F.lane == 0) { stats[2 * m] = mean; stats[2 * m + 1] = rstd; }
    }
}
__device__ __forceinline__ void p2_conv(Frame& F, const Ptrs& P) {
    bf16* CB = BUF_CB(P); const bf16* Z = (const bf16*)(P.ws + WS_Z);
    const int gw = F.vcu * NWAVES + F.wave, NGW = F.G * NWAVES, c0 = 16 * F.lane;
    float w0[16], w1[16], w2[16];
#pragma unroll
    for (int i = 0; i < 16; ++i) { w0[i] = P.conv_w[c0 + i]; w1[i] = P.conv_w[D + c0 + i]; w2[i] = P.conv_w[2 * D + c0 + i]; }
    for (int ch = gw; ch < T / 16; ch += NGW) {
        const int r0 = ch * 16; float z2[16], z1[16];
        if ((r0 & (SEQ - 1)) == 0) {
#pragma unroll
            for (int i = 0; i < 16; ++i) { z2[i] = 0.f; z1[i] = 0.f; }
        } else {
            const v4u a0 = *(const GAS v4u*)(Z + (size_t)(r0 - 2) * D + c0), a1 = *(const GAS v4u*)(Z + (size_t)(r0 - 2) * D + c0 + 8), b0 = *(const GAS v4u*)(Z + (size_t)(r0 - 1) * D + c0), b1 = *(const GAS v4u*)(Z + (size_t)(r0 - 1) * D + c0 + 8);
#pragma unroll
            for (int i = 0; i < 4; ++i) { z2[2 * i] = bflo(a0[i]); z2[2 * i + 1] = bfhi(a0[i]); z2[8 + 2 * i] = bflo(a1[i]); z2[8 + 2 * i + 1] = bfhi(a1[i]);
                                          z1[2 * i] = bflo(b0[i]); z1[2 * i + 1] = bfhi(b0[i]); z1[8 + 2 * i] = bflo(b1[i]); z1[8 + 2 * i + 1] = bfhi(b1[i]); }
        }
#pragma unroll 2
        for (int rr = 0; rr < 16; ++rr) { const size_t off = (size_t)(r0 + rr) * D + c0;
            const v4u za = *(const GAS v4u*)(Z + off), zb = *(const GAS v4u*)(Z + off + 8), ca = *(const GAS v4u*)(CB + off), cb = *(const GAS v4u*)(CB + off + 8);
            float zc[16], cv[16];
#pragma unroll
            for (int i = 0; i < 4; ++i) { zc[2 * i] = bflo(za[i]); zc[2 * i + 1] = bfhi(za[i]); zc[8 + 2 * i] = bflo(zb[i]); zc[8 + 2 * i + 1] = bfhi(zb[i]);
                                          cv[2 * i] = bflo(ca[i]); cv[2 * i + 1] = bfhi(ca[i]); cv[8 + 2 * i] = bflo(cb[i]); cv[8 + 2 * i + 1] = bfhi(cb[i]); }
            float u[16];
#pragma unroll
            for (int i = 0; i < 16; ++i) { u[i] = cv[i] * (z2[i] * w0[i] + z1[i] * w1[i] + zc[i] * w2[i]); z2[i] = z1[i]; z1[i] = zc[i]; }
            v4u oa, ob;
#pragma unroll
            for (int i = 0; i < 4; ++i) { oa[i] = pk2(u[2 * i], u[2 * i + 1]); ob[i] = pk2(u[8 + 2 * i], u[8 + 2 * i + 1]); }
            *(GAS v4u*)(CB + off) = oa; *(GAS v4u*)(CB + off + 8) = ob; }
    }
}
__device__ __forceinline__ attn::BlockRef attn_ref(const Ptrs& P, int s, int qb) {
    const int vh = s & 1, m = (s >> 1) & 1, h = (s >> 2) & 3, b = s >> 4;
    attn::BlockRef r; const size_t rowb = (size_t)b * SEQ * D;
    r.Q = (const bf16*)(P.ws + WS_Q) + rowb + (size_t)qb * 256 * D + h * 256 + m * 128;
    r.K = (const bf16*)(P.ws + WS_K) + rowb + h * 256 + m * 128;
    r.V = (const bf16*)(P.ws + WS_V) + rowb + h * 256 + vh * 128;
    r.O = (bf16*)(P.ws + (m ? WS_O1 : WS_XN)) + rowb + (size_t)qb * 256 * D + h * 256 + vh * 128;
    r.P0 = qb * 256; return r;
}
#ifndef P1_ALIGN
#define P1_ALIGN true
#endif
#ifndef P1_SP2
#define P1_SP2 true
#endif
#ifndef ATTN_PAIR
#define ATTN_PAIR 1
#endif
__device__ __forceinline__ attn2::BlockRef attn2_ref(const Ptrs& P, int st, int qb) {
    const int m = st & 1, h = (st >> 1) & 3, b = st >> 3;
    attn2::BlockRef r; const size_t rowb = (size_t)b * SEQ * D;
    r.Q = (const bf16*)(P.ws + WS_Q) + rowb + (size_t)qb * 128 * D + h * 256 + m * 128;
    r.K = (const bf16*)(P.ws + WS_K) + rowb + h * 256 + m * 128;
    r.V = (const bf16*)(P.ws + WS_V) + rowb + h * 256;
    r.O = (bf16*)(P.ws + (m ? WS_O1 : WS_XN)) + rowb + (size_t)qb * 128 * D + h * 256;
    r.P0 = qb * 128; return r;
}
__device__ __forceinline__ void p2_attention2(Frame& F, const Ptrs& P, char* lds) {
    float* btab = (float*)(lds + attn2::BIAS_OFF);
    for (int s2 = F.vcu; s2 < BATCH * 16; s2 += F.G) {
        const int st = s2 >> 1, half = s2 & 1, h = (st >> 1) & 3;
        __syncthreads();
        if (F.tid < attn2::NBIAS) { const int rel = 63 - F.tid; btab[F.tid] = (P.rel_bias[attn2::t5_bucket(rel) * 4 + h] - P.rel_bias[15 * 4 + h]) * (1.0f / attn2::SCALE); }
        __syncthreads();
#define QB_OF(i) (2 * (7 - (i)) + (((7 - (i)) & 1) ^ half))
        int tid_ = threadIdx.x; asm volatile("" : "+v"(tid_));
        attn2::Seam S; attn2::BlockRef cur = attn2_ref(P, st, QB_OF(0));
        attn2::attn_prime(cur, lds, S, tid_);
#pragma unroll 1
        for (int i = 0; i < 8; ++i) {
            const attn2::BlockRef nxt = (i < 7) ? attn2_ref(P, st, QB_OF(i + 1)) : cur;
            attn2::attn_block(cur, nxt, lds, S, tid_);
            cur = nxt;
        }
#undef QB_OF
    }
}
__device__ __forceinline__ void p2_attention(Frame& F, const Ptrs& P, char* lds) {
    float* btab = (float*)(lds + attn::BIAS_OFF);
    for (int s = F.vcu; s < BATCH * 16; s += F.G) {
        const int h = (s >> 2) & 3;
        __syncthreads();
        if (F.tid < attn::NBIAS) { const int rel = 63 - F.tid; btab[F.tid] = (P.rel_bias[attn::t5_bucket(rel) * 4 + h] - P.rel_bias[15 * 4 + h]) * (1.0f / attn::SCALE); }
        __syncthreads();
        attn::Seam S; attn::BlockRef cur = attn_ref(P, s, 0);
        attn::attn_prime(cur, lds, S);
#pragma unroll 1
        for (int qb = 0; qb < 8; ++qb) {
            const attn::BlockRef nxt = (qb < 7) ? attn_ref(P, s, qb + 1) : cur;
            attn::attn_block(cur, nxt, lds, S);
            cur = nxt;
        }
    }
}
__device__ __forceinline__ void p2b_combine(Frame& F, const Ptrs& P) {
    bf16* O0 = (bf16*)(P.ws + WS_XN); const bf16* O1 = (const bf16*)(P.ws + WS_O1);
    const int gw = F.vcu * NWAVES + F.wave, NGW = F.G * NWAVES, c0 = 16 * F.lane;
    const float l0 = wave_sum(P.lq[F.lane] * P.lk[F.lane] + P.lq[64 + F.lane] * P.lk[64 + F.lane]), l1 = wave_sum(P.lq[128 + F.lane] * P.lk[128 + F.lane] + P.lq[192 + F.lane] * P.lk[192 + F.lane]);
    const float lam = expf(l0) - expf(l1) + LAM_INIT;
    float g[16];
#pragma unroll
    for (int i = 0; i < 16; ++i) g[i] = P.subln_g[(c0 & 255) + i] * (1.f - LAM_INIT);
    for (int m = gw; m < T; m += NGW) { const size_t off = (size_t)m * D + c0;
        const v4u a0 = *(const GAS v4u*)(O0 + off), a1 = *(const GAS v4u*)(O0 + off + 8), b0 = *(const GAS v4u*)(O1 + off), b1 = *(const GAS v4u*)(O1 + off + 8);
        float d[16]; float ss = 0.f;
#pragma unroll
        for (int i = 0; i < 4; ++i) { d[2 * i] = bflo(a0[i]) - lam * bflo(b0[i]); d[2 * i + 1] = bfhi(a0[i]) - lam * bfhi(b0[i]); d[8 + 2 * i] = bflo(a1[i]) - lam * bflo(b1[i]); d[8 + 2 * i + 1] = bfhi(a1[i]) - lam * bfhi(b1[i]); }
#pragma unroll
        for (int i = 0; i < 16; ++i) ss += d[i] * d[i];
        ss += __shfl_xor(ss, 1); ss += __shfl_xor(ss, 2); ss += __shfl_xor(ss, 4); ss += __shfl_xor(ss, 8);
        const float rs = 1.f / sqrtf(ss * (1.f / 256.f) + RMS_EPS);
        v4u oa, ob;
#pragma unroll
        for (int i = 0; i < 4; ++i) { oa[i] = pk2(d[2 * i] * rs * g[2 * i], d[2 * i + 1] * rs * g[2 * i + 1]); ob[i] = pk2(d[8 + 2 * i] * rs * g[8 + 2 * i], d[8 + 2 * i + 1] * rs * g[8 + 2 * i + 1]); }
        *(GAS v4u*)(O0 + off) = oa; *(GAS v4u*)(O0 + off + 8) = ob; }
}
__device__ __forceinline__ void pe_experts(Frame& F, const Ptrs& P) {
    LAS float* scr = (LAS float*)(F.lds + RING_OFF + F.wave * 16384);
    const int gw = F.vcu * NWAVES + F.wave, NGW = F.G * NWAVES;
    bf16* Wgu = (bf16*)(P.ws + WS_WGU); bf16* Wd = (bf16*)(P.ws + WS_WD);
    constexpr int I_GU = (D / 64) * (DE / 32), I_DN = (DE / 64) * (D / 32);
    for (int it = gw; it < NE * (2 * I_GU + I_DN); it += NGW) {
        const int e = it / (2 * I_GU + I_DN); int r = it - e * (2 * I_GU + I_DN);
        if (r < 2 * I_GU) { const int up = r >= I_GU; r -= up * I_GU; const int kb = r / (DE / 32), nb = r % (DE / 32), n0 = 32 * nb;
            if (MOE_FP8) transpose_item8((up ? P.w_up_e : P.w_gate_e) + (size_t)e * D * DE, D, DE, 64 * kb, n0, (unsigned char*)(P.ws + WS_WGU8) + (size_t)e * 1024 * D, 256 * (n0 >> 7) + 128 * up + (n0 & 127), scr, F.lane);
            else transpose_item((up ? P.w_up_e : P.w_gate_e) + (size_t)e * D * DE, D, DE, 64 * kb, n0, Wgu + (size_t)e * 1024 * D, 256 * (n0 >> 7) + 128 * up + (n0 & 127), scr, F.lane); }
        else { r -= 2 * I_GU; const int kb = r / (D / 32), nb = r % (D / 32);
            if (MOE_FP8 && MOE_FP8_DOWN) transpose_item8(P.w_down_e + (size_t)e * DE * D, DE, D, 64 * kb, 32 * nb, (unsigned char*)(P.ws + WS_WD8) + (size_t)e * D * DE, 32 * nb, scr, F.lane);
            else transpose_item(P.w_down_e + (size_t)e * DE * D, DE, D, 64 * kb, 32 * nb, Wd + (size_t)e * D * DE, 32 * nb, scr, F.lane); }
    }
}
__device__ __forceinline__ void p5_ln_route(Frame& F, const Ptrs& P) {
    LAS float* RW = (LAS float*)(F.lds + RING_OFF);
    LAS int* lcnt = (LAS int*)(F.lds + TAB_OFF);
    LAS float* rs = (LAS float*)(F.lds + RSCR_OFF) + F.wave * 128;
    for (int idx = F.tid; idx < D * 36; idx += NWAVES * 64) { const int d = idx / 36, o = idx - d * 36; float w;
        if (o < 4) w = P.w_group[d * 4 + o]; else { const int g = (o - 4) >> 3, e = (o - 4) & 7; w = P.w_sub[((size_t)g * D + d) * 8 + e]; }
        const int j = d >> 8, l = (d & 255) >> 2, i = d & 3, c = o >> 2, k = o & 3;
        RW[((((j * 4 + i) * 9 + c) * 64 + l) << 2) + k] = w; }
    if (F.tid < 32) lcnt[F.tid] = 0;
    __syncthreads();
    float* pre = (float*)(P.ws + WS_PRE); bf16* x1b = (bf16*)(P.ws + WS_XN);
    int* eid = (int*)(P.ws + WS_EID); float* ew = (float*)(P.ws + WS_EW); int* rank = (int*)(P.ws + WS_RANK);
    const int rows_per_wg = T / F.G, rbase = blockIdx.x * rows_per_wg;
    static_assert(pg8::PRE_BF16, "the pipelined LN1/routing loop reads bf16 pre");
    v2u raw[2][4];
#define P5_LOADPAIR(rp_) do { _Pragma("unroll") for (int r = 0; r < 2; ++r) { const GAS v2u* pr = (const GAS v2u*)((const bf16*)pre + (size_t)(rbase + (rp_) + r) * D) + F.lane; \
        _Pragma("unroll") for (int j = 0; j < 4; ++j) raw[r][j] = pr[64 * j]; } } while (0)
    if (F.wave * 2 < rows_per_wg) P5_LOADPAIR(F.wave * 2);
    for (int rp = F.wave * 2; rp < rows_per_wg; rp += NWAVES * 2) {
        f32x4 xv[2][4];
#pragma unroll
        for (int r = 0; r < 2; ++r) { const int row = rbase + rp + r;
            f32x4 v[4]; float s = 0.f;
#pragma unroll
            for (int j = 0; j < 4; ++j) { const v2u w = raw[r][j]; v[j] = (f32x4){bflo(w.x), bfhi(w.x), bflo(w.y), bfhi(w.y)}; s += (v[j].x + v[j].y) + (v[j].z + v[j].w); }
            const float mean = wave_sum_fast(s) * (1.f / D); float s2 = 0.f;
#pragma unroll
            for (int j = 0; j < 4; ++j) { v[j] = v[j] - mean; s2 += (v[j].x * v[j].x + v[j].y * v[j].y) + (v[j].z * v[j].z + v[j].w * v[j].w); }
            const float rstd = 1.f / sqrtf(wave_sum_fast(s2) * (1.f / D) + LN_EPS);
            GAS unsigned long long* o8 = (GAS unsigned long long*)(x1b + (size_t)row * D) + F.lane;
#pragma unroll
            for (int j = 0; j < 4; ++j) { const f32x4 g = *((const GAS f32x4*)P.ln1_g + F.lane + 64 * j), b = *((const GAS f32x4*)P.ln1_b + F.lane + 64 * j); const f32x4 y = v[j] * rstd * g + b;
                xv[r][j] = y; o8[64 * j] = (unsigned long long)pk2(y.x, y.y) | ((unsigned long long)pk2(y.z, y.w) << 32);
                if (MOE_FP8) *((GAS unsigned*)(P.ws + WS_X18 + (size_t)row * D) + F.lane + 64 * j) = pg8::pk4_fp8(y.x, y.y, y.z, y.w); } }
        if (rp + NWAVES * 2 < rows_per_wg) P5_LOADPAIR(rp + NWAVES * 2);
        f32x4 acc[2][9];
#pragma unroll
        for (int r = 0; r < 2; ++r)
#pragma unroll
            for (int c = 0; c < 9; ++c) acc[r][c] = (f32x4){0.f, 0.f, 0.f, 0.f};
        asm volatile("" ::: "memory"); __builtin_amdgcn_sched_barrier(0);
#pragma unroll
        for (int j = 0; j < 4; ++j)
#pragma unroll
            for (int i = 0; i < 4; ++i)
                { const LAS f32x4* wp = (const LAS f32x4*)(RW + (((j * 4 + i) * 9 * 64 + F.lane) << 2));
#pragma unroll
                  for (int c = 0; c < 9; ++c) { const f32x4 w = wp[c * 64]; acc[0][c] += w * xv[0][j][i]; acc[1][c] += w * xv[1][j][i]; }
                  asm volatile("" : "+v"(acc[0][0]), "+v"(acc[0][1]), "+v"(acc[0][2]), "+v"(acc[0][3]), "+v"(acc[0][4]), "+v"(acc[0][5]), "+v"(acc[0][6]), "+v"(acc[0][7]), "+v"(acc[0][8]) :: "memory");
                  asm volatile("" : "+v"(acc[1][0]), "+v"(acc[1][1]), "+v"(acc[1][2]), "+v"(acc[1][3]), "+v"(acc[1][4]), "+v"(acc[1][5]), "+v"(acc[1][6]), "+v"(acc[1][7]), "+v"(acc[1][8]) :: "memory");
                  __builtin_amdgcn_sched_barrier(0); }
        { float Y[36];
#pragma unroll
          for (int k = 0; k < 36; ++k) { const int i0 = 2 * k, i1 = 2 * k + 1;
              const auto rr = __builtin_amdgcn_permlane32_swap(__float_as_uint(acc[i0 / 36][(i0 % 36) >> 2][i0 & 3]), __float_as_uint(acc[i1 / 36][(i1 % 36) >> 2][i1 & 3]), false, false);
              Y[k] = __uint_as_float(rr[0]) + __uint_as_float(rr[1]); }
          float Z[18];
#pragma unroll
          for (int m = 0; m < 18; ++m) { const auto rr = __builtin_amdgcn_permlane16_swap(__float_as_uint(Y[2 * m]), __float_as_uint(Y[2 * m + 1]), false, false);
              Z[m] = __uint_as_float(rr[0]) + __uint_as_float(rr[1]); }
#pragma unroll
          for (int m = 0; m < 18; ++m) {
              Z[m] += __int_as_float(__builtin_amdgcn_update_dpp(0, __float_as_int(Z[m]), 0x128, 0xf, 0xf, false));
              Z[m] += __int_as_float(__builtin_amdgcn_update_dpp(0, __float_as_int(Z[m]), 0x124, 0xf, 0xf, false));
              Z[m] += __int_as_float(__builtin_amdgcn_update_dpp(0, __float_as_int(Z[m]), 0x122, 0xf, 0xf, false));
              Z[m] += __int_as_float(__builtin_amdgcn_update_dpp(0, __float_as_int(Z[m]), 0x121, 0xf, 0xf, false)); }
          const int rho = F.lane >> 4, pr = ((rho & 1) << 1) | (rho >> 1);
          if ((F.lane & 15) == 0) {
#pragma unroll
              for (int m = 0; m < 18; ++m) { const int idx = 4 * m + pr; rs[idx >= 36 ? idx + 28 : idx] = Z[m]; } } }
        LDS_WAIT(); asm volatile("" ::: "memory");
        if (F.lane < 2) { const int r = F.lane, row = rbase + rp + r; const LAS float* sa = rs + r * 64;
            float gmax = sa[0] + P.b_group[0]; int gi = 0;
            for (int g = 1; g < 4; ++g) { const float v = sa[g] + P.b_group[g]; if (v > gmax) { gmax = v; gi = g; } }
            float z = 0.f;
            for (int g = 0; g < 4; ++g) z += expf(sa[g] + P.b_group[g] - gmax);
            const float gp = 1.f / z;
            const LAS float* sl = sa + 4 + gi * 8; const float* bs = P.b_sub + gi * 8;
            float b0 = sl[0] + bs[0]; int i0 = 0;
            for (int e = 1; e < 8; ++e) { const float v = sl[e] + bs[e]; if (v > b0) { b0 = v; i0 = e; } }
            float b1 = -__builtin_inff(); int i1 = 0;
            for (int e = 0; e < 8; ++e) { const float v = sl[e] + bs[e]; if (e != i0 && v > b1) { b1 = v; i1 = e; } }
            const float e1 = expf(b1 - b0); const float w0 = gp / (1.f + e1), w1 = gp * e1 / (1.f + e1);
            const int ex0 = gi * 8 + i0, ex1 = gi * 8 + i1;
            eid[row * 2] = ex0; eid[row * 2 + 1] = ex1; ew[row * 2] = w0; ew[row * 2 + 1] = w1;
            rank[row * 2] = __hip_atomic_fetch_add(lcnt + ex0, 1, __ATOMIC_RELAXED, __HIP_MEMORY_SCOPE_WORKGROUP);
            rank[row * 2 + 1] = __hip_atomic_fetch_add(lcnt + ex1, 1, __ATOMIC_RELAXED, __HIP_MEMORY_SCOPE_WORKGROUP); }
        LDS_WAIT(); asm volatile("" ::: "memory");
    }
    __syncthreads();
    if (F.tid < 32) ((int*)(P.ws + WS_CNTWG))[blockIdx.x * 32 + F.tid] = lcnt[F.tid];
}
__device__ __forceinline__ void moe_tab(Frame& F, const Ptrs& P) {
    LAS int* tab = (LAS int*)(F.lds + TAB_OFF);
    const int* cntwg = (const int*)(P.ws + WS_CNTWG);
    __syncthreads();
    if (F.tid < 32) { int tot = 0, base = 0;
        for (int w = 0; w < F.G; ++w) { const int c = __hip_atomic_load(cntwg + w * 32 + F.tid, __ATOMIC_RELAXED, __HIP_MEMORY_SCOPE_AGENT); base += (w < (int)blockIdx.x) ? c : 0; tot += c; }
        tab[96 + F.tid] = tot; tab[64 + F.tid] = base; }
    __syncthreads();
    if (F.tid == 0) { int s = 0; for (int e = 0; e < 32; ++e) { tab[e] = s; s += (tab[96 + e] + 255) & ~255; } tab[32] = s; }
    __syncthreads();
}
__device__ __forceinline__ void p5b_place(Frame& F, const Ptrs& P) {
    LAS int* tab = (LAS int*)(F.lds + TAB_OFF);
    moe_tab(F, P);
    const int rows_per_wg = T / F.G, rbase = blockIdx.x * rows_per_wg;
    const int* eid = (const int*)(P.ws + WS_EID); const int* rank = (const int*)(P.ws + WS_RANK); int* slot = (int*)(P.ws + WS_SLOT);
    int* tokl = (int*)(P.ws + WS_TOK);
    for (int a = F.tid; a < rows_per_wg * 2; a += NWAVES * 64) { const int ga = rbase * 2 + a, e = eid[ga]; const int s = tab[e] + tab[64 + e] + rank[ga]; slot[ga] = s; tokl[s] = ga >> 1; }
    if (blockIdx.x < 32) { const int e = blockIdx.x; for (int s = tab[e] + tab[96 + e] + F.tid; s < tab[e + 1]; s += NWAVES * 64) tokl[s] = 0; }
    { int* idl = (int*)(P.ws + WS_IDL); for (int s = blockIdx.x * (NWAVES * 64) + F.tid; s < MAXS; s += F.G * NWAVES * 64) idl[s] = s; }
}
struct P8Row { v4u x[2], y0[2], y1[2]; float w0, w1; };
__device__ __forceinline__ void p8_load(P8Row& R, const bf16* x1, const bf16* y, const int* slot, const float* ew, int row, int lane) {
    const int s0 = slot[row * 2], s1 = slot[row * 2 + 1]; R.w0 = ew[row * 2]; R.w1 = ew[row * 2 + 1];
    const GAS v4u* xr = (const GAS v4u*)(x1 + (size_t)row * D) + lane; const GAS v4u* a = (const GAS v4u*)(y + (size_t)s0 * D) + lane; const GAS v4u* b = (const GAS v4u*)(y + (size_t)s1 * D) + lane;
    R.x[0] = xr[0]; R.x[1] = xr[64]; R.y0[0] = a[0]; R.y0[1] = a[64]; R.y1[0] = b[0]; R.y1[1] = b[64];
}
__device__ __forceinline__ void p8_finish(const P8Row& R, const Ptrs& P, int row, int lane, bool poison) {
    float v[16]; float s = 0.f;
#pragma unroll
    for (int h = 0; h < 2; ++h)
#pragma unroll
        for (int i = 0; i < 4; ++i) { v[8 * h + 2 * i] = ALPHA * bflo(R.x[h][i]) + R.w0 * bflo(R.y0[h][i]) + R.w1 * bflo(R.y1[h][i]); v[8 * h + 2 * i + 1] = ALPHA * bfhi(R.x[h][i]) + R.w0 * bfhi(R.y0[h][i]) + R.w1 * bfhi(R.y1[h][i]); }
#pragma unroll
    for (int i = 0; i < 16; ++i) s += v[i];
    const float mean = wave_sum_fast(s) * (1.f / D); float s2 = 0.f;
#pragma unroll
    for (int i = 0; i < 16; ++i) { v[i] -= mean; s2 += v[i] * v[i]; }
    const float rstd = 1.f / sqrtf(wave_sum_fast(s2) * (1.f / D) + LN_EPS);
    const float qn = __builtin_nanf("");
#pragma unroll
    for (int h = 0; h < 2; ++h)
#pragma unroll
        for (int q = 0; q < 2; ++q) { const int c = 512 * h + 8 * lane + 4 * q; const f32x4 g = *(const GAS f32x4*)(P.ln2_g + c), b = *(const GAS f32x4*)(P.ln2_b + c);
            f32x4 o = {v[8 * h + 4 * q] * rstd * g.x + b.x, v[8 * h + 4 * q + 1] * rstd * g.y + b.y, v[8 * h + 4 * q + 2] * rstd * g.z + b.z, v[8 * h + 4 * q + 3] * rstd * g.w + b.w};
            if (poison) o = (f32x4){qn, qn, qn, qn};
            *(GAS f32x4*)(P.out + (size_t)row * D + c) = o; }
}
__device__ __forceinline__ void p8_final(Frame& F, const Ptrs& P, bool poison) {
    const bf16* x1 = (const bf16*)(P.ws + WS_XN); const bf16* y = (const bf16*)(P.ws + WS_XG);
    const int* slot = (const int*)(P.ws + WS_SLOT); const float* ew = (const float*)(P.ws + WS_EW);
    const int rows_per_wg = T / F.G, rbase = blockIdx.x * rows_per_wg;
    P8Row A, B;
    int rr = F.wave; if (rr < rows_per_wg) p8_load(A, x1, y, slot, ew, rbase + rr, F.lane);
    for (; rr < rows_per_wg; rr += 2 * NWAVES) {
        const bool hasB = rr + NWAVES < rows_per_wg; if (hasB) p8_load(B, x1, y, slot, ew, rbase + rr + NWAVES, F.lane);
        p8_finish(A, P, rbase + rr, F.lane, poison);
        if (hasB) { if (rr + 2 * NWAVES < rows_per_wg) p8_load(A, x1, y, slot, ew, rbase + rr + 2 * NWAVES, F.lane); p8_finish(B, P, rbase + rr + NWAVES, F.lane, poison); }
    }
}

constexpr int N_PHASES = 11;
struct Args { Ptrs p; int ph_lo, ph_hi, bar_region, flags; };
__global__ void __launch_bounds__(NWAVES * 64, 2) mega_fwd(Args args) {
    extern __shared__ __attribute__((aligned(16))) unsigned char lds[];
    Frame F; const Ptrs& P = args.p;
    F.lds = (LAS unsigned char*)lds; F.MISC = (volatile LAS unsigned*)(F.lds + MISC_OFF);
    F.tid = threadIdx.x; F.lane = F.tid & 63; F.wave = __builtin_amdgcn_readfirstlane(F.tid >> 6);
    F.G = gridDim.x; { const int bx = blockIdx.x; F.vcu = (F.G % 8 == 0) ? (bx % 8) * (F.G / 8) + bx / 8 : bx; }
    F.ctl = (gu32*)(P.ws + WS_CTL);
    for (int u = F.tid; u < (LDS_BYTES - LDSCTL_OFF) / 4; u += NWAVES * 64) ((LAS unsigned*)(F.lds + LDSCTL_OFF))[u] = 0u;
    __syncthreads();
    XcdBarrier bar = xcd_barrier_post((unsigned*)(F.ctl + CW_BAR) + args.bar_region * XCD_BAR_WORDS, F.MISC + 8);
    const int lo = args.ph_lo, hi = args.ph_hi;
#ifndef PH_MASK
#define PH_MASK 0x7ff
#endif
#define IN(k) (((PH_MASK >> (k)) & 1) && lo <= (k) && (k) < hi)
#define BOTH(k) (IN(k) && IN((k) + 1))
#define GRID_BAR() xcd_barrier(bar)
    const bool grid_ok = (F.G == 256);

    if (IN(0)) { p0_prologue(F, P); if (BOTH(0)) GRID_BAR(); }
    if (IN(1)) {
        pg8::Gemm g{(const pg8::bf16_t*)(P.ws + WS_XN), (const pg8::bf16_t*)(P.ws + WS_WIN), T, NIN, D}; pg8::StaticOrder S; S.init(T, NIN, F.G, (int)blockIdx.x);
        pg8::EpiInProj E{(pg8::bf16_t*)(P.ws + WS_Q), (size_t)(WS_K - WS_Q) / 2, BUF_CB(P), (pg8::bf16_t*)(P.ws + WS_Z), BUF_SGA(P), BUF_SGB(P)};
        pg8::gemm_phase<pg8::EpiInProj, pg8::StaticOrder, P1_ALIGN, P1_SP2>(F.lds + RING_OFF, g, S, E);
        if (BOTH(1)) GRID_BAR();
    }
    if (IN(2)) { if (!(args.flags & 2)) p2_conv(F, P); if (ATTN_PAIR) p2_attention2(F, P, (char*)lds + RING_OFF); else p2_attention(F, P, (char*)lds + RING_OFF); if (BOTH(2)) GRID_BAR(); }
    if (IN(3)) { if (!(args.flags & 1)) p2b_combine(F, P); pe_experts(F, P); if (BOTH(3)) GRID_BAR(); }
    if (IN(4)) {
        { pg8::Gemm g{(const pg8::bf16_t*)(P.ws + WS_XN), (const pg8::bf16_t*)(P.ws + WS_WA), T, D, D}; pg8::StaticOrder S; S.init(T, D, F.G, (int)blockIdx.x);
          pg8::EpiGate<false> E{BUF_SGA(P), nullptr, (pg8::bf16_t*)(P.ws + WS_O1), P.b_gate};
          pg8::gemm_phase<pg8::EpiGate<false>, pg8::StaticOrder, true, true>(F.lds + RING_OFF, g, S, E); }
        __syncthreads();
        { pg8::Gemm g{BUF_CB(P), (const pg8::bf16_t*)(P.ws + WS_WB), T, D, D}; pg8::StaticOrder S; S.init(T, D, F.G, (int)blockIdx.x);
          pg8::EpiGate<true> E{BUF_SGB(P), (const pg8::bf16_t*)(P.ws + WS_O1), (pg8::bf16_t*)(P.ws + WS_Z), P.b_gate + 1024};
          pg8::gemm_phase<pg8::EpiGate<true>, pg8::StaticOrder, true, true>(F.lds + RING_OFF, g, S, E); }
        if (BOTH(4)) GRID_BAR();
    }
    if (IN(5)) {
        pg8::Gemm g{(const pg8::bf16_t*)(P.ws + WS_Z), (const pg8::bf16_t*)(P.ws + WS_WO), T, D, D}; pg8::StaticOrder S; S.init(T, D, F.G, (int)blockIdx.x);
        pg8::EpiPre E{P.x, (const float*)(P.ws + WS_STATS), P.ln_in_g, P.ln_in_b, (float*)(P.ws + WS_PRE), ALPHA};
        pg8::gemm_phase<pg8::EpiPre, pg8::StaticOrder, true, true>(F.lds + RING_OFF, g, S, E);
        if (BOTH(5)) GRID_BAR();
    }
    if (IN(6)) { if (grid_ok) p5_ln_route(F, P); if (BOTH(6)) GRID_BAR(); }
    if (IN(7)) { if (grid_ok) p5b_place(F, P); if (BOTH(7)) GRID_BAR(); }
    if (IN(8)) {
        if (grid_ok && MOE_FP8) { if (lo == 8) moe_tab(F, P); pg8::Gemm g{(const pg8::bf16_t*)(P.ws + WS_X18), (const pg8::bf16_t*)(P.ws + WS_WGU8), MAXS, NE * 1024, D / 2};
          pg8::MoeOrder S{(const PG8_LAS int*)(F.lds + TAB_OFF), F.G, F.vcu, (unsigned*)(F.ctl + CW_MOE), 0u, false, (unsigned*)(F.ctl + CW_TMO), 0, -1};
          if (MOE_FP8_DOWN) { pg8::EpiMoeUp8 E{(unsigned char*)P.out}; pg8::gemm_phase<pg8::EpiMoeUp8, pg8::MoeOrder, true, true, true, true>(F.lds + RING_OFF, g, S, E, (const int*)(P.ws + WS_TOK)); }
          else { pg8::EpiMoeUp E{(pg8::bf16_t*)P.out, 1.f / pg8::F8_WS}; pg8::gemm_phase<pg8::EpiMoeUp, pg8::MoeOrder, true, true, true, true>(F.lds + RING_OFF, g, S, E, (const int*)(P.ws + WS_TOK)); } }
        else if (grid_ok) { if (lo == 8) moe_tab(F, P); pg8::Gemm g{(const pg8::bf16_t*)(P.ws + WS_XN), (const pg8::bf16_t*)(P.ws + WS_WGU), MAXS, NE * 1024, D};
          pg8::MoeOrder S{(const PG8_LAS int*)(F.lds + TAB_OFF), F.G, F.vcu, (unsigned*)(F.ctl + CW_MOE), 0u, MOE_HANDOFF != 0, (unsigned*)(F.ctl + CW_TMO), 0, -1}; pg8::EpiMoeUp E{(pg8::bf16_t*)P.out, 1.f};
          pg8::gemm_phase<pg8::EpiMoeUp, pg8::MoeOrder, true, true, true>(F.lds + RING_OFF, g, S, E, (const int*)(P.ws + WS_TOK)); S.flush(); }
        if (BOTH(8)) { if (MOE_HANDOFF) __syncthreads(); else GRID_BAR(); }
    }
    if (IN(9)) {
        if (grid_ok && MOE_FP8 && MOE_FP8_DOWN) { if (lo == 9) moe_tab(F, P); pg8::Gemm g{(const pg8::bf16_t*)P.out, (const pg8::bf16_t*)(P.ws + WS_WD8), MAXS, NE * 1024, DE / 2};
          pg8::MoeOrder S{(const PG8_LAS int*)(F.lds + TAB_OFF), F.G, F.vcu, (unsigned*)(F.ctl + CW_MOE), 0u, false, (unsigned*)(F.ctl + CW_TMO), 0, -1}; pg8::EpiMoeDown E{(pg8::bf16_t*)(P.ws + WS_XG), 1.f / (pg8::F8_WS * pg8::F8_HS)};
          pg8::gemm_phase<pg8::EpiMoeDown, pg8::MoeOrder, true, true, true, true>(F.lds + RING_OFF, g, S, E, (const int*)(P.ws + WS_IDL)); }
        else if (grid_ok) { if (lo == 9) moe_tab(F, P); pg8::Gemm g{(const pg8::bf16_t*)P.out, (const pg8::bf16_t*)(P.ws + WS_WD), MAXS, NE * 1024, DE};
          const bool ho = MOE_HANDOFF && lo <= 8;
          pg8::MoeOrder S{(const PG8_LAS int*)(F.lds + TAB_OFF), F.G, ho ? (F.vcu + F.G / 2) % F.G : F.vcu, (unsigned*)(F.ctl + CW_MOE), ho ? 32u : 0u, false, (unsigned*)(F.ctl + CW_TMO), 0, -1}; pg8::EpiMoeDown E{(pg8::bf16_t*)(P.ws + WS_XG), 1.f};
          pg8::gemm_phase<pg8::EpiMoeDown, pg8::MoeOrder, true, true>(F.lds + RING_OFF, g, S, E); }
        if (BOTH(9)) GRID_BAR();
    }
    if (IN(10)) {
        bool poison = !grid_ok || (__hip_atomic_load(F.ctl + CW_BAR + args.bar_region * XCD_BAR_WORDS + XB_TMO, RLX_AGENT) != 0u) || (__hip_atomic_load(F.ctl + CW_TMO, RLX_AGENT) != 0u);
        if (grid_ok) p8_final(F, P, poison);
        else { const float qn = __builtin_nanf(""); for (size_t i = (size_t)blockIdx.x * 512 + F.tid; i < (size_t)T * D; i += (size_t)F.G * 512) P.out[i] = qn; }
    }
#undef IN
#undef BOTH
#undef GRID_BAR
}

static void launch_mega(const Ptrs& p, int lo, int hi, int region, int flags, hipStream_t stream) {
    Args a{}; a.p = p; a.ph_lo = lo; a.ph_hi = hi; a.bar_region = region; a.flags = flags;
    hipLaunchKernelGGL(mega_fwd, dim3(256), dim3(NWAVES * 64), LDS_BYTES, stream, a);
}
extern "C" void kernel_launch(void* const* d_in, const int* in_sizes, int n_in, void* d_out, int out_size, void* d_ws, size_t ws_size, hipStream_t stream) {
    static int ready = 0;
    if (ready == 0) {
        ready = 1;
        if (n_in != 24 || out_size != T * D || ws_size < WS_END) { fprintf(stderr, "kernel_launch: unexpected shapes (n_in %d out %d ws %zu)\n", n_in, out_size, ws_size); ready = -1; }
        else if (hipFuncSetAttribute((const void*)mega_fwd, hipFuncAttributeMaxDynamicSharedMemorySize, LDS_BYTES) != hipSuccess) { fprintf(stderr, "kernel_launch: hipFuncSetAttribute failed\n"); ready = -1; }
        (void)hipGetLastError();
    }
    if (ready < 0) return;
    Ptrs p{};
    const float** pp = (const float**)&p;
    for (int i = 0; i < 24; ++i) pp[i] = (const float*)d_in[i];
    p.out = (float*)d_out; p.ws = (unsigned char*)d_ws;
    (void)hipMemsetAsync((char*)d_ws + WS_CTL, 0, CTL_ZERO_BYTES, stream);
    launch_mega(p, 0, N_PHASES, 0, 0, stream);
}
```

```cpp
#include <hip/hip_runtime.h>
#include <cstdio>
#include <cstdint>
#include <cmath>
namespace pg8 {
#define PG8_LAS __attribute__((address_space(3)))
typedef unsigned short bf16_t;
typedef short bf16x8 __attribute__((ext_vector_type(8)));
typedef float f32x4 __attribute__((ext_vector_type(4)));
typedef unsigned u32x4 __attribute__((ext_vector_type(4)));
constexpr int BM = 256, BK = 64, HALF = 128, HTB = HALF * BK * 2  , STAGE_BYTES = 8 * HTB, NXCD = 8, WGM = 8;

__host__ __device__ __forceinline__ int lds_byte(int r, int c) { const int st = (r >> 4) * 2 + (c >> 5), rr = r & 15, cc = c & 31, ob = rr * 64 + cc * 2; return st * 1024 + (ob ^ (((ob >> 9) & 1) << 5)); }
__host__ __device__ __forceinline__ void stage_rc(int b, int& R, int& C) { const int st = b / 1024, sb = b % 1024, swz = sb ^ (((sb >> 9) & 1) << 5); R = (st >> 1) * 16 + swz / 64; C = (st & 1) * 32 + (swz % 64) / 2; }
__host__ __device__ __forceinline__ int perm32(int rho) { const int n = rho >> 4, i = rho & 15; return 8 * (i >> 2) + 4 * n + (i & 3); }

struct Unit { int pm, pn; };
struct Gemm { const bf16_t* A; const bf16_t* Bt; int M, N, K; };

struct StaticOrder {
    int nM, nN, nwg, G, c;
    __host__ __device__ void init(int M, int N, int G_, int c_) { nM = M / BM; nN = N / BM; nwg = nM * nN; G = G_; c = c_; }
    __host__ __device__ bool next(int i, Unit& u) const {
        const long L = (long)i * G + c; if (L >= nwg) return false;
        int wgid = (int)L; { const int q = nwg / NXCD, r = nwg % NXCD, xcd = wgid % NXCD, off = wgid / NXCD; wgid = (xcd < r ? xcd * (q + 1) : r * (q + 1) + (xcd - r) * q) + off; }
        const int nig = WGM * nN, gid = wgid / nig, fm = gid * WGM, gsz = (nM - fm) < WGM ? (nM - fm) : WGM;
        u.pm = fm + ((wgid % nig) % gsz); u.pn = (wgid % nig) / gsz; return true;
    }
    __device__ __forceinline__ void a_ready(const Unit&) const {}
    __device__ __forceinline__ void done(const Unit&) const {}
};

__device__ __forceinline__ unsigned cvt_pk_bf16(float lo, float hi) { unsigned r; asm volatile("v_cvt_pk_bf16_f32 %0, %1, %2" : "=v"(r) : "v"(lo), "v"(hi)); return r; }
typedef float f32x2 __attribute__((ext_vector_type(2)));
__device__ __forceinline__ u32x4 pack8f(const f32x4 a, const f32x4 b) { u32x4 w; w.x = cvt_pk_bf16(a[0], a[1]); w.y = cvt_pk_bf16(a[2], a[3]); w.z = cvt_pk_bf16(b[0], b[1]); w.w = cvt_pk_bf16(b[2], b[3]); return w; }
__device__ __forceinline__ void unpack8f(const u32x4 w, f32x4& a, f32x4& b) {
    a[0] = __uint_as_float(w.x << 16); a[1] = __uint_as_float(w.x & 0xffff0000u); a[2] = __uint_as_float(w.y << 16); a[3] = __uint_as_float(w.y & 0xffff0000u);
    b[0] = __uint_as_float(w.z << 16); b[1] = __uint_as_float(w.z & 0xffff0000u); b[2] = __uint_as_float(w.w << 16); b[3] = __uint_as_float(w.w & 0xffff0000u); }
__device__ __forceinline__ float sigmoidf_fast(float x) { return __builtin_amdgcn_rcpf(1.0f + __expf(-x)); }

struct EpiInProj {
    static constexpr bool PERM = true, AFTER_DRAIN = false;
    bf16_t* qkv; size_t stride;
    bf16_t* cb;
    bf16_t* z;
    bf16_t* sga; bf16_t* sgb;
    __device__ __forceinline__ void operator()(const f32x4 (&acc)[2][2][4][2], const Unit& u, int wr, int wc, int fr, int fq) const {
        const int row0 = u.pm * BM + wr * 64 + fr; const int pn = u.pn;
        if (pn < 16 || pn >= 24) {
            bf16_t* base = (pn < 12) ? qkv + (size_t)(pn >> 2) * stride : (pn < 16 ? cb : (pn < 28 ? sga : sgb)); const int col0 = (pn & 3) * BM + wc * 32 + 8 * fq;
#pragma unroll
            for (int ai = 0; ai < 2; ++ai)
#pragma unroll
                for (int m = 0; m < 4; ++m) { bf16_t* rowp = base + (size_t)(row0 + ai * HALF + m * 16) * 1024 + col0;
#pragma unroll
                    for (int bj = 0; bj < 2; ++bj) *(u32x4*)(rowp + bj * HALF) = pack8f(acc[ai][bj][m][0], acc[ai][bj][m][1]); }
        } else {
            const int col0 = (pn - 16) * HALF + wc * 32 + 8 * fq;
#pragma unroll
            for (int ai = 0; ai < 2; ++ai)
#pragma unroll
                for (int m = 0; m < 4; ++m) { bf16_t* rowp = z + (size_t)(row0 + ai * HALF + m * 16) * 1024 + col0;
                    *(u32x4*)rowp = pack8f(acc[ai][0][m][0] * acc[ai][1][m][0], acc[ai][0][m][1] * acc[ai][1][m][1]); }
        }
    }
};
template <bool SECOND> struct EpiGate {
    static constexpr bool PERM = true, AFTER_DRAIN = false;
    const bf16_t* gate; const bf16_t* prev; bf16_t* out; const float* gbias;
    __device__ __forceinline__ void operator()(const f32x4 (&acc)[2][2][4][2], const Unit& u, int wr, int wc, int fr, int fq) const {
        const int row0 = u.pm * BM + wr * 64 + fr; const int col0 = u.pn * BM + wc * 32 + 8 * fq;
        f32x4 bv[2][2];
#pragma unroll
        for (int bj = 0; bj < 2; ++bj)
#pragma unroll
            for (int n = 0; n < 2; ++n) bv[bj][n] = *(const f32x4*)(gbias + col0 + bj * HALF + 4 * n);
#pragma unroll
        for (int ai = 0; ai < 2; ++ai)
#pragma unroll
            for (int m = 0; m < 4; ++m) { const size_t off = (size_t)(row0 + ai * HALF + m * 16) * 1024 + col0;
#pragma unroll
                for (int bj = 0; bj < 2; ++bj) { f32x4 g0, g1; unpack8f(*(const u32x4*)(gate + off + bj * HALF), g0, g1); g0 += bv[bj][0]; g1 += bv[bj][1];
#pragma unroll
                    for (int i = 0; i < 4; ++i) { g0[i] = sigmoidf_fast(g0[i]); g1[i] = sigmoidf_fast(g1[i]); }
                    f32x4 v0 = acc[ai][bj][m][0] * g0, v1 = acc[ai][bj][m][1] * g1;
                    if (SECOND) { f32x4 p0, p1; unpack8f(*(const u32x4*)(prev + off + bj * HALF), p0, p1); v0 += p0; v1 += p1; }
                    *(u32x4*)(out + off + bj * HALF) = pack8f(v0, v1); } }
    }
};
typedef unsigned u32x2 __attribute__((ext_vector_type(2)));
#ifndef PRE_BF16_KNOB
#define PRE_BF16_KNOB 1
#endif
constexpr bool PRE_BF16 = PRE_BF16_KNOB;
struct EpiPre {
    static constexpr bool PERM = false, AFTER_DRAIN = false;
    const float* x; const float* stats; const float* g; const float* b; float* pre; float alpha;
    __device__ __forceinline__ void operator()(const f32x4 (&acc)[2][2][4][2], const Unit& u, int wr, int wc, int fr, int fq) const {
        const int row0 = u.pm * BM + wr * 64 + fr; const int col0 = u.pn * BM + wc * 32 + 4 * fq;
#pragma unroll
        for (int ai = 0; ai < 2; ++ai)
#pragma unroll
            for (int m = 0; m < 4; ++m) { const int row = row0 + ai * HALF + m * 16; const size_t off = (size_t)row * 1024 + col0;
                const float mu = stats[2 * row], rs = stats[2 * row + 1];
#pragma unroll
                for (int bj = 0; bj < 2; ++bj)
#pragma unroll
                    for (int n = 0; n < 2; ++n) { const int c = bj * HALF + n * 16; const f32x4 xv = *(const f32x4*)(x + off + c), gv = *(const f32x4*)(g + col0 + c), bv = *(const f32x4*)(b + col0 + c);
                        const f32x4 o = ((xv - mu) * rs * gv + bv) * alpha + acc[ai][bj][m][n];
                        if constexpr (PRE_BF16) { u32x2 w; w.x = cvt_pk_bf16(o[0], o[1]); w.y = cvt_pk_bf16(o[2], o[3]); *(u32x2*)((bf16_t*)pre + off + c) = w; } else *(f32x4*)(pre + off + c) = o; } }
    }
};
#ifndef MOE_HANDOFF
#define MOE_HANDOFF 0
#endif
struct EpiMoeUp {
    static constexpr bool PERM = true, AFTER_DRAIN = false;
    bf16_t* h; float sc;
    __device__ __forceinline__ void operator()(const f32x4 (&acc)[2][2][4][2], const Unit& u, int wr, int wc, int fr, int fq) const {
        const int row0 = u.pm * BM + wr * 64 + fr; const int col0 = (u.pn & 3) * HALF + wc * 32 + 8 * fq;
#pragma unroll
        for (int ai = 0; ai < 2; ++ai)
#pragma unroll
            for (int m = 0; m < 4; ++m) { f32x4 v[2];
#pragma unroll
                for (int n = 0; n < 2; ++n)
#pragma unroll
                    for (int i = 0; i < 4; ++i) { const float gv = acc[ai][0][m][n][i] * sc; v[n][i] = gv * sigmoidf_fast(gv) * (acc[ai][1][m][n][i] * sc); }
                bf16_t* dst = h + (size_t)(row0 + ai * HALF + m * 16) * 512 + col0; const u32x4 w = pack8f(v[0], v[1]);
                if (MOE_HANDOFF) asm volatile("global_store_dwordx4 %0, %1, off sc1\n\ts_nop 1" :: "v"(dst), "v"(w) : "memory"); else *(u32x4*)dst = w; }
    }
};
#ifndef MOE_FP8
#define MOE_FP8 1
#endif
#ifndef MOE_FP8_DOWN
#define MOE_FP8_DOWN 1
#endif
#ifndef MOE_DOWN_GATHER
#define MOE_DOWN_GATHER 0
#endif
constexpr float F8_WS = 64.f, F8_HS = 8.f;
__device__ __forceinline__ unsigned pk4_fp8(float a, float b, float c, float d) { int w = __builtin_amdgcn_cvt_pk_fp8_f32(a, b, 0, false); w = __builtin_amdgcn_cvt_pk_fp8_f32(c, d, w, true); return (unsigned)w; }
struct EpiMoeUp8 {
    static constexpr bool PERM = true, AFTER_DRAIN = false;
    unsigned char* h;
    __device__ __forceinline__ void operator()(const f32x4 (&acc)[2][2][4][2], const Unit& u, int wr, int wc, int fr, int fq) const {
        const int row0 = u.pm * BM + wr * 64 + fr; const int col0 = (u.pn & 3) * HALF + wc * 32 + 8 * fq;
#pragma unroll
        for (int ai = 0; ai < 2; ++ai)
#pragma unroll
            for (int m = 0; m < 4; ++m) { f32x4 v[2];
#pragma unroll
                for (int n = 0; n < 2; ++n)
#pragma unroll
                    for (int i = 0; i < 4; ++i) { const float gv = acc[ai][0][m][n][i] * (1.f / F8_WS); v[n][i] = gv * sigmoidf_fast(gv) * acc[ai][1][m][n][i] * (F8_HS / F8_WS); }
                u32x2 w; w.x = pk4_fp8(v[0][0], v[0][1], v[0][2], v[0][3]); w.y = pk4_fp8(v[1][0], v[1][1], v[1][2], v[1][3]);
                *(u32x2*)(h + (size_t)(row0 + ai * HALF + m * 16) * 512 + col0) = w; }
    }
};
struct EpiMoeDown {
    static constexpr bool PERM = true, AFTER_DRAIN = false;
    bf16_t* y; float scale;
    __device__ __forceinline__ void operator()(const f32x4 (&acc)[2][2][4][2], const Unit& u, int wr, int wc, int fr, int fq) const {
        const int row0 = u.pm * BM + wr * 64 + fr; const int col0 = (u.pn & 3) * BM + wc * 32 + 8 * fq;
#pragma unroll
        for (int ai = 0; ai < 2; ++ai)
#pragma unroll
            for (int m = 0; m < 4; ++m) { bf16_t* rowp = y + (size_t)(row0 + ai * HALF + m * 16) * 1024 + col0;
#pragma unroll
                for (int bj = 0; bj < 2; ++bj) *(u32x4*)(rowp + bj * HALF) = pack8f(acc[ai][bj][m][0] * scale, acc[ai][bj][m][1] * scale); }
    }
};
struct MoeOrder {
    const PG8_LAS int* tab; int G, c;
    unsigned* cnt;
    unsigned need;
    bool publish; unsigned* tmo;
    __device__ __forceinline__ bool next(int i, Unit& u) const {
        const int nunits = (tab[32] >> 8) * 4; const int L = i * G + c; if (L >= nunits) return false;
        const int tile = L >> 2, s = tile << 8; int e = 0;
#pragma unroll 1
        for (int k = 1; k < 32; ++k) e = (tab[k] <= s) ? k : e;
        u.pm = __builtin_amdgcn_readfirstlane(tile); u.pn = __builtin_amdgcn_readfirstlane(e * 4 + (L & 3)); return true;
    }
    mutable int calls;
    __device__ __forceinline__ void a_ready(const Unit& u) const {
        const int k = calls++;
        if (need == 0u || (k >= 1 && k < 4)) return;
        if (threadIdx.x < 64) {
            const int lane = threadIdx.x, nunits = (tab[32] >> 8) * 4;
            int tile = u.pm; bool mine = (lane == 0);
            if (k == 0) { const int L = lane * G + c; mine = (lane < 4) && (L < nunits); tile = mine ? (L >> 2) : u.pm; }
            const unsigned long long t0 = __builtin_amdgcn_s_memrealtime(); unsigned polls = 0;
            for (;;) {
                const bool ok = !mine || __hip_atomic_load(cnt + 64 * tile, __ATOMIC_RELAXED, __HIP_MEMORY_SCOPE_AGENT) >= need;
                if (__all(ok)) break;
                if ((++polls & 255u) == 0u && __builtin_amdgcn_readfirstlane(__hip_atomic_load(tmo, __ATOMIC_RELAXED, __HIP_MEMORY_SCOPE_AGENT)) != 0u) break;
                if (__builtin_amdgcn_s_memrealtime() - t0 > 2000000ull) { if (threadIdx.x == 0) __hip_atomic_store(tmo, 1u, __ATOMIC_RELAXED, __HIP_MEMORY_SCOPE_AGENT); break; }
                __builtin_amdgcn_s_sleep(2); }
            __builtin_amdgcn_fence(__ATOMIC_ACQUIRE, "agent");
            asm volatile("s_waitcnt vmcnt(0)" ::: "memory");
        }
        asm volatile("" ::: "memory"); __builtin_amdgcn_s_barrier(); asm volatile("" ::: "memory");
    }
    mutable int pend;
    __device__ __forceinline__ void done(const Unit& u) const {
        if (!publish) return;
        if (pend >= 0 && (threadIdx.x & 63) == 0) __hip_atomic_fetch_add(cnt + 64 * pend, 1u, __ATOMIC_RELAXED, __HIP_MEMORY_SCOPE_AGENT);
        pend = u.pm;
    }
    __device__ __forceinline__ void flush() const {
        if (!publish) return;
        asm volatile("s_waitcnt vmcnt(0)" ::: "memory");
        if (pend >= 0 && (threadIdx.x & 63) == 0) __hip_atomic_fetch_add(cnt + 64 * pend, 1u, __ATOMIC_RELAXED, __HIP_MEMORY_SCOPE_AGENT);
        pend = -1;
    }
};
#ifndef F8_PIN
#define F8_PIN 0
#endif
typedef int v8i __attribute__((ext_vector_type(8)));
typedef int v4i __attribute__((ext_vector_type(4)));
template <class Epi, class Sched, bool ALIGN_EPI = false, bool SP2 = false, bool GATHER = false, bool FP8 = false>
__device__ __forceinline__ void gemm_phase(PG8_LAS unsigned char* lds, const Gemm g, const Sched& S, const Epi& E, const int* tok = nullptr) {
    static_assert(!GATHER || SP2, "GATHER is written for the SP2 loop only"); static_assert(!FP8 || SP2, "FP8 is written for the SP2 loop only");
    const int tid = threadIdx.x, wid = __builtin_amdgcn_readfirstlane(tid >> 6), lane = tid & 63, wr = wid >> 2, wc = wid & 3, fr = lane & 15, fq = lane >> 4;
    const int K = g.K, nt = K / BK;
    unsigned voffA[2], voffB[2]; int gR[2], gC[2];
#pragma unroll
    for (int i = 0; i < 2; ++i) { int R, C; stage_rc(tid * 16 + i * 8192, R, C); const int Rb = Epi::PERM ? ((R & ~31) + perm32(R & 31)) : R; gR[i] = R; gC[i] = C;
        voffA[i] = (unsigned)(R * K + C) * 2u; voffB[i] = (unsigned)(Rb * K + C) * 2u; }
    unsigned vc0[2] = {0u, 0u}, vc1[2] = {0u, 0u}, vn0[2] = {0u, 0u}, vn1[2] = {0u, 0u};
#define PG8_GROWS(pm_, o0, o1) do { int t_ = tid; asm volatile("" : "+v"(t_));     \
        _Pragma("unroll") for (int _i = 0; _i < 2; ++_i) { int R_, C_; stage_rc(t_ * 16 + _i * 8192, R_, C_); o0[_i] = (unsigned)(tok[(pm_) * BM + R_] * K + C_) * 2u; o1[_i] = (unsigned)(tok[(pm_) * BM + HALF + R_] * K + C_) * 2u; } } while (0)
#define PG8_STAGE_A(bufoff, gbase, h, usenext) do { if constexpr (GATHER) { const unsigned _o0 = (usenext) ? ((h) ? vn1[0] : vn0[0]) : ((h) ? vc1[0] : vc0[0]), _o1 = (usenext) ? ((h) ? vn1[1] : vn0[1]) : ((h) ? vc1[1] : vc0[1]); \
        __builtin_amdgcn_raw_ptr_buffer_load_lds(rsA, (PG8_LAS unsigned*)(lds + (bufoff) + ldsw), 16, (int)_o0, (int)(gbase), 0, 0); \
        __builtin_amdgcn_raw_ptr_buffer_load_lds(rsA, (PG8_LAS unsigned*)(lds + (bufoff) + ldsw + 8192), 16, (int)_o1, (int)(gbase), 0, 0); } \
    else { PG8_STAGE(rsA, bufoff, (gbase) + (h) * hstep, voffA); } } while (0)
    const unsigned kstep = (unsigned)(BK * 2);
    const unsigned hstep = (unsigned)(HALF * K * 2);
    const unsigned tstep = 2 * hstep;
    const __amdgpu_buffer_rsrc_t rsA = __builtin_amdgcn_make_buffer_rsrc((void*)g.A, (short)0, 0x7fffffff, 0x00020000), rsB = __builtin_amdgcn_make_buffer_rsrc((void*)g.Bt, (short)0, 0x7fffffff, 0x00020000);
    const unsigned ldsw = (unsigned)wid * 1024u;
    const int aoff = lds_byte(wr * 64 + fr, fq * 8), boff = lds_byte(wc * 32 + fr, fq * 8);
    const int aoff0 = lds_byte(wr * 64 + fr, (2 * (fq & 1)) * 8) + (fq >> 1) * 1024, boff0 = lds_byte(wc * 32 + fr, (2 * (fq & 1)) * 8) + (fq >> 1) * 1024;
#define PG8_SA(b, h) (((b) * 2 + (h)) * HTB)
#define PG8_SB(b, h) ((4 + (b) * 2 + (h)) * HTB)
#define PG8_STAGE(rs, bufoff, soff, voff) do { _Pragma("unroll") for (int _i = 0; _i < 2; ++_i) \
        __builtin_amdgcn_raw_ptr_buffer_load_lds(rs, (PG8_LAS unsigned*)(lds + (bufoff) + ldsw + _i * 8192), 16, (int)(voff)[_i], (int)(soff), 0, 0); } while (0)
#define PG8_LD8(base_, o0_, o1_) __builtin_shufflevector(*(const PG8_LAS v4i*)(lds + (base_) + (o0_)), *(const PG8_LAS v4i*)(lds + (base_) + (o1_)), 0, 1, 2, 3, 4, 5, 6, 7)
#define PG8_LDA(dst, b, h) do { _Pragma("unroll") for (int m = 0; m < 4; ++m) { if constexpr (FP8) { dst##8[m] = PG8_LD8(PG8_SA(b, h) + m * 2048, aoff0, aoff0 + 16); } \
        else { _Pragma("unroll") for (int k = 0; k < 2; ++k) dst[m][k] = *(const PG8_LAS bf16x8*)(lds + PG8_SA(b, h) + aoff + m * 2048 + k * 1024); } } } while (0)
#define PG8_LDB(dst, b, h) do { _Pragma("unroll") for (int n = 0; n < 2; ++n) { if constexpr (FP8) { dst##8[n] = PG8_LD8(PG8_SB(b, h) + n * 2048, boff0, boff0 + 16); } \
        else { _Pragma("unroll") for (int k = 0; k < 2; ++k) dst[n][k] = *(const PG8_LAS bf16x8*)(lds + PG8_SB(b, h) + boff + n * 2048 + k * 1024); } } } while (0)
#define PG8_MMA(ai, bj, At, Bt) do { if constexpr (FP8) __builtin_amdgcn_sched_barrier(0); __builtin_amdgcn_s_setprio(1); _Pragma("unroll") for (int m = 0; m < 4; ++m) _Pragma("unroll") for (int n = 0; n < 2; ++n) { \
        if constexpr (FP8) acc[ai][bj][m][n] = __builtin_amdgcn_mfma_scale_f32_16x16x128_f8f6f4(Bt##8[n], At##8[m], acc[ai][bj][m][n], 0, 0, 0, 0x7f7f7f7f, 0, 0x7f7f7f7f); \
        else { _Pragma("unroll") for (int k = 0; k < 2; ++k) acc[ai][bj][m][n] = __builtin_amdgcn_mfma_f32_16x16x32_bf16(Bt[n][k], At[m][k], acc[ai][bj][m][n], 0, 0, 0); } } __builtin_amdgcn_s_setprio(0); \
        if constexpr (FP8) { if (F8_PIN) asm volatile("" : "+v"(acc[ai][bj][0][0]), "+v"(acc[ai][bj][0][1]), "+v"(acc[ai][bj][1][0]), "+v"(acc[ai][bj][1][1]), "+v"(acc[ai][bj][2][0]), "+v"(acc[ai][bj][2][1]), "+v"(acc[ai][bj][3][0]), "+v"(acc[ai][bj][3][1])); \
                             __builtin_amdgcn_sched_barrier(0); } } while (0)
#define PG8_WAIT_V(n) asm volatile("s_waitcnt vmcnt(" #n ")" ::: "memory")
#define PG8_WAIT_L(n) asm volatile("s_waitcnt lgkmcnt(" #n ")" ::: "memory")
#define PG8_BAR __builtin_amdgcn_s_barrier()
#define PG8_SCHED __builtin_amdgcn_sched_barrier(0)
    Unit cur, nxt; int ui = 0;
    if (!S.next(0, cur)) return;
    f32x4 acc[2][2][4][2];
#pragma unroll
    for (int a = 0; a < 2; ++a)
#pragma unroll
        for (int b = 0; b < 2; ++b)
#pragma unroll
            for (int m = 0; m < 4; ++m)
#pragma unroll
                for (int n = 0; n < 2; ++n) acc[a][b][m][n] = (f32x4){0.f, 0.f, 0.f, 0.f};
    bf16x8 At[4][2], B0[2][2], B1[2][2]; v8i At8[4], B08[2], B18[2];
    unsigned cA = GATHER ? 0u : (unsigned)cur.pm * tstep, cB = (unsigned)cur.pn * tstep;
    S.a_ready(cur);
    if constexpr (GATHER) PG8_GROWS(cur.pm, vc0, vc1);
    if constexpr (SP2) {
        PG8_STAGE(rsB, PG8_SB(0, 0), cB, voffB); PG8_STAGE(rsB, PG8_SB(0, 1), cB + hstep, voffB); PG8_STAGE_A(PG8_SA(0, 0), cA, 0, false); PG8_STAGE_A(PG8_SA(0, 1), cA, 1, false);
        if (wr == 1) PG8_BAR;
        PG8_WAIT_V(2); PG8_BAR;
        PG8_STAGE(rsB, PG8_SB(1, 0), cB + kstep, voffB); PG8_STAGE_A(PG8_SA(1, 0), cA + kstep, 0, false); PG8_STAGE(rsB, PG8_SB(1, 1), cB + hstep + kstep, voffB);
        PG8_WAIT_V(6); PG8_BAR;
    } else {
        PG8_STAGE(rsB, PG8_SB(0, 0), cB, voffB); PG8_STAGE(rsA, PG8_SA(0, 0), cA, voffA); PG8_STAGE(rsB, PG8_SB(0, 1), cB + hstep, voffB); PG8_STAGE(rsA, PG8_SA(0, 1), cA + hstep, voffA);
        if (wr == 1) PG8_BAR;
        PG8_WAIT_V(4); PG8_BAR;
        PG8_STAGE(rsB, PG8_SB(1, 0), cB + kstep, voffB); PG8_STAGE(rsA, PG8_SA(1, 0), cA + kstep, voffA); PG8_STAGE(rsB, PG8_SB(1, 1), cB + hstep + kstep, voffB);
        PG8_WAIT_V(6); PG8_BAR;
    }
    for (;;) {
        const bool has_next = S.next(ui + 1, nxt);
        const unsigned nA = GATHER ? 0u : (has_next ? (unsigned)nxt.pm * tstep : cA), nB = has_next ? (unsigned)nxt.pn * tstep : cB;
        if constexpr (GATHER) { if (has_next) PG8_GROWS(nxt.pm, vn0, vn1); else { vn0[0] = vc0[0]; vn0[1] = vc0[1]; vn1[0] = vc1[0]; vn1[1] = vc1[1]; } }
#pragma unroll 1
        for (int t = 0; t < nt; t += 2) {
            const bool last = (t == nt - 2);
            const unsigned a1 = cA + (unsigned)(t + 1) * kstep;
            const unsigned a2 = last ? nA : cA + (unsigned)(t + 2) * kstep, b2 = last ? nB : cB + (unsigned)(t + 2) * kstep;
            const unsigned a3 = a2 + kstep, b3 = b2 + kstep;
            if (last && has_next) S.a_ready(nxt);
            if constexpr (SP2) {
            PG8_LDB(B0, 0, 0); PG8_LDB(B1, 0, 1); PG8_SCHED; PG8_LDA(At, 0, 0); PG8_STAGE_A(PG8_SA(1, 1), a1, 1, false);
            PG8_WAIT_V(8); PG8_WAIT_L(0); PG8_BAR; PG8_MMA(0, 0, At, B0); PG8_MMA(0, 1, At, B1); PG8_BAR; PG8_SCHED;
            PG8_LDA(At, 0, 1); PG8_STAGE(rsB, PG8_SB(0, 0), b2, voffB); PG8_STAGE(rsB, PG8_SB(0, 1), b2 + hstep, voffB); PG8_STAGE_A(PG8_SA(0, 0), a2, 0, last);
            PG8_WAIT_V(8); PG8_WAIT_L(0); PG8_BAR; PG8_MMA(1, 0, At, B0); PG8_MMA(1, 1, At, B1); PG8_BAR; PG8_SCHED;
            PG8_LDB(B0, 1, 0); PG8_LDB(B1, 1, 1); PG8_SCHED; PG8_LDA(At, 1, 0); PG8_STAGE_A(PG8_SA(0, 1), a2, 1, last);
            PG8_WAIT_V(8); PG8_WAIT_L(0); PG8_BAR; PG8_MMA(0, 0, At, B0); PG8_MMA(0, 1, At, B1); PG8_BAR; PG8_SCHED;
            PG8_LDA(At, 1, 1); PG8_STAGE(rsB, PG8_SB(1, 0), b3, voffB); PG8_STAGE(rsB, PG8_SB(1, 1), b3 + hstep, voffB); PG8_STAGE_A(PG8_SA(1, 0), a3, 0, last);
            PG8_WAIT_V(8); PG8_WAIT_L(0); PG8_BAR; PG8_MMA(1, 0, At, B0); PG8_MMA(1, 1, At, B1); PG8_BAR; PG8_SCHED;
            } else {
            PG8_LDB(B0, 0, 0); PG8_SCHED; PG8_LDA(At, 0, 0); PG8_STAGE(rsA, PG8_SA(1, 1), a1 + hstep, voffA);
            PG8_WAIT_L(8); PG8_BAR; PG8_WAIT_L(0); PG8_MMA(0, 0, At, B0); PG8_BAR; PG8_SCHED;
            PG8_LDB(B1, 0, 1); PG8_STAGE(rsB, PG8_SB(0, 0), b2, voffB);
            PG8_BAR; PG8_WAIT_L(0); PG8_MMA(0, 1, At, B1); PG8_BAR;
            PG8_LDA(At, 0, 1); PG8_STAGE(rsA, PG8_SA(0, 0), a2, voffA);
            PG8_BAR; PG8_WAIT_L(0); PG8_MMA(1, 0, At, B0); PG8_BAR; PG8_SCHED;
            PG8_STAGE(rsB, PG8_SB(0, 1), b2 + hstep, voffB);
            PG8_WAIT_V(6); PG8_BAR; PG8_MMA(1, 1, At, B1); PG8_BAR;
            PG8_LDB(B0, 1, 0); PG8_SCHED; PG8_LDA(At, 1, 0); PG8_STAGE(rsA, PG8_SA(0, 1), a2 + hstep, voffA);
            PG8_WAIT_L(8); PG8_BAR; PG8_WAIT_L(0); PG8_MMA(0, 0, At, B0); PG8_BAR; PG8_SCHED;
            PG8_LDB(B1, 1, 1); PG8_STAGE(rsB, PG8_SB(1, 0), b3, voffB);
            PG8_BAR; PG8_WAIT_L(0); PG8_MMA(0, 1, At, B1); PG8_BAR;
            PG8_LDA(At, 1, 1); PG8_STAGE(rsA, PG8_SA(1, 0), a3, voffA);
            PG8_BAR; PG8_WAIT_L(0); PG8_MMA(1, 0, At, B0); PG8_BAR; PG8_SCHED;
            PG8_STAGE(rsB, PG8_SB(1, 1), b3 + hstep, voffB);
            PG8_WAIT_V(6); PG8_BAR; PG8_MMA(1, 1, At, B1); PG8_BAR;
            }
        }
        if constexpr (ALIGN_EPI) { if (wr == 0) PG8_BAR; }
        if constexpr (!Epi::AFTER_DRAIN) { E(acc, cur, wr, wc, fr, fq); S.done(cur); }
        if (!has_next) break;
#pragma unroll
        for (int a = 0; a < 2; ++a)
#pragma unroll
            for (int b = 0; b < 2; ++b)
#pragma unroll
                for (int m = 0; m < 4; ++m)
#pragma unroll
                    for (int n = 0; n < 2; ++n) acc[a][b][m][n] = (f32x4){0.f, 0.f, 0.f, 0.f};
        cur = nxt; cA = nA; cB = nB; ++ui;
        if constexpr (GATHER) { vc0[0] = vn0[0]; vc0[1] = vn0[1]; vc1[0] = vn1[0]; vc1[1] = vn1[1]; }
        if constexpr (ALIGN_EPI) { if (wr == 1) PG8_BAR; }
    }
    PG8_WAIT_V(0);
    if constexpr (!ALIGN_EPI) { if (wr == 0) PG8_BAR; }
    PG8_BAR;
    if constexpr (Epi::AFTER_DRAIN) { E.fused(acc, cur, wr, wc, fr, fq, lds, wid, lane); S.done(cur); }
#undef PG8_SA
#undef PG8_SB
#undef PG8_STAGE
#undef PG8_STAGE_A
#undef PG8_GROWS
#undef PG8_LDA
#undef PG8_LDB
#undef PG8_MMA
#undef PG8_LD8
#undef PG8_WAIT_V
#undef PG8_WAIT_L
#undef PG8_BAR
#undef PG8_SCHED
}
}

namespace attn {
typedef short bf16x8 __attribute__((ext_vector_type(8)));
typedef short s16x4 __attribute__((ext_vector_type(4)));
typedef float f32x16 __attribute__((ext_vector_type(16)));
typedef unsigned u32x4 __attribute__((ext_vector_type(4)));
typedef unsigned short bf16;
constexpr int D = 128, PITCH = 1024, SEQ = 2048;
constexpr float SCALE = 0.08838834764831845f, THR = 8.f;
constexpr int NW = 8, QBLK = 32, KVBLK = 64, QB = NW * QBLK;
constexpr int SHM_V = KVBLK * D * 2, SHM_K = KVBLK * D * 2;
constexpr int BIAS_OFF = 2 * SHM_V + 2 * SHM_K + NW * 64 * 4, NBIAS = 320;
constexpr int LDS_BYTES = BIAS_OFF + NBIAS * 4;
#define KSWZ(row, colB) ((row) * 256 + ((colB) ^ (((row) & 7) << 4)))
#define SBAR() __builtin_amdgcn_sched_barrier(0)
__device__ __forceinline__ int v_st(int k, int c) { const int kk = (k & ~0xC) | ((k & 4) << 1) | ((k & 8) >> 1); return ((kk >> 3) * 4 + (c >> 5)) * 512 + ((kk & 7) * 32 + (c & 31)) * 2; }
__device__ __forceinline__ int v_rd_base(int lane) { return ((lane & 3) << 3) | (((lane >> 2) & 3) << 6) | (((lane >> 4) & 1) << 5) | (((lane >> 5) & 1) << 8); }
constexpr int v_rd_off(int d0, int ks, int half) { return d0 * 512 + ks * 4096 + half * 2048; }
__device__ __forceinline__ int crow(int r, int hi) { return (r & 3) + 8 * (r >> 2) + 4 * hi; }
__device__ __forceinline__ unsigned cvtpk(float lo, float hi) { unsigned r; asm volatile("v_cvt_pk_bf16_f32 %0, %1, %2" : "=v"(r) : "v"(lo), "v"(hi)); return r; }
__device__ __forceinline__ bf16x8 load8(const bf16* p) { return *reinterpret_cast<const bf16x8*>(p); }
__device__ __forceinline__ int t5_bucket(int rel) {
    const int b = rel > 0 ? 16 : 0; const int n = rel < 0 ? -rel : rel; int v;
    if (n < 8) v = n; else if (n < 12) v = 8; else if (n < 16) v = 9; else if (n < 23) v = 10; else if (n < 32) v = 11; else if (n < 46) v = 12; else if (n < 65) v = 13; else if (n < 91) v = 14; else v = 15;
    return b + v;
}
__device__ __forceinline__ void bias_tile(f32x16& p0, f32x16& p1, const float* tabp) {
#pragma unroll
    for (int r = 0; r < 16; ++r) { const int c = (r & 3) + 8 * (r >> 2); p0[r] += tabp[59 - c]; p1[r] += tabp[59 - c - 32]; }
}
__device__ __forceinline__ void partialSM(f32x16& p0, f32x16& p1, float& m_reg, float& mn, float& alpha) {
    float pmax = p0[0]; for (int r = 1; r < 16; ++r) pmax = fmaxf(pmax, p0[r]); for (int r = 0; r < 16; ++r) pmax = fmaxf(pmax, p1[r]);
    { auto rr = __builtin_amdgcn_permlane32_swap(__float_as_uint(pmax), __float_as_uint(pmax), false, false);
      pmax = fmaxf(__uint_as_float(rr[0]), __uint_as_float(rr[1])); }
    constexpr float C2 = 1.4426950408889634f * SCALE;
    if (__builtin_expect(__all((pmax - m_reg) * SCALE <= THR), 1)) { mn = m_reg; alpha = 1.f; }
    else { mn = fmaxf(m_reg, pmax); alpha = __builtin_amdgcn_exp2f((m_reg - mn) * C2); m_reg = mn; }
    const float mnL = -mn * C2;
    for (int r = 0; r < 16; ++r) p0[r] = fmaf(p0[r], C2, mnL); for (int r = 0; r < 16; ++r) p1[r] = fmaf(p1[r], C2, mnL);
    for (int r = 0; r < 16; ++r) p0[r] = __builtin_amdgcn_exp2f(p0[r]);
}
__device__ __forceinline__ void finishSM(f32x16& p0, f32x16& p1, float alpha, float& l_reg, bf16x8& pa0, bf16x8& pa1, bf16x8& pa2, bf16x8& pa3) {
    for (int r = 0; r < 16; ++r) p1[r] = __builtin_amdgcn_exp2f(p1[r]);
    float ps = 0; for (int r = 0; r < 16; ++r) ps += p0[r]; for (int r = 0; r < 16; ++r) ps += p1[r];
    { auto rr = __builtin_amdgcn_permlane32_swap(__float_as_uint(ps), __float_as_uint(ps), false, false);
      ps = __uint_as_float(rr[0]) + __uint_as_float(rr[1]); }
    l_reg = l_reg * alpha + ps;
#define PK4(P, B_, OUT) do { unsigned a0 = cvtpk(P[B_+0], P[B_+1]), a1 = cvtpk(P[B_+2], P[B_+3]);                          \
        unsigned b0 = cvtpk(P[B_+4], P[B_+5]), b1 = cvtpk(P[B_+6], P[B_+7]);                                             \
        auto r0 = __builtin_amdgcn_permlane32_swap(a0, b0, false, false); auto r1 = __builtin_amdgcn_permlane32_swap(a1, b1, false, false); \
        u32x4 w = {r0[0], r1[0], r0[1], r1[1]}; OUT = *reinterpret_cast<bf16x8*>(&w); } while (0)
    PK4(p0, 0, pa0); PK4(p0, 8, pa1); PK4(p1, 0, pa2); PK4(p1, 8, pa3);
#undef PK4
}
template <int KB>
__device__ __forceinline__ void qkt(f32x16& p0, f32x16& p1, const char* K_lds, int r32, int hi, const bf16x8* qr, bool act) {
    if (!act) { const float NEG = -__builtin_inff();
#pragma unroll
        for (int r = 0; r < 16; ++r) { p0[r] = NEG; p1[r] = NEG; } return; }
    p0 = f32x16{}; p1 = f32x16{};
    const char* kb[4];
#pragma unroll
    for (int dd = 0; dd < 4; ++dd) kb[dd] = K_lds + KB * SHM_K + KSWZ(r32, (dd * 16 + hi * 8) * 2);
#pragma unroll
    for (int d0 = 0; d0 < 8; ++d0) { const char* a = kb[d0 & 3] + (d0 >> 2) * 128;
        bf16x8 b0 = *reinterpret_cast<const bf16x8*>(a);
        bf16x8 b1 = *reinterpret_cast<const bf16x8*>(a + 32 * 256);
        p0 = __builtin_amdgcn_mfma_f32_32x32x16_bf16(b0, qr[d0], p0, 0, 0, 0);
        p1 = __builtin_amdgcn_mfma_f32_32x32x16_bf16(b1, qr[d0], p1, 0, 0, 0); }
}
template <int VB>
__device__ __forceinline__ void pv_tile(f32x16* o, int vb0, bf16x8 pa0, bf16x8 pa1, bf16x8 pa2, bf16x8 pa3, bool act) {
    if (!act) return;
#define TRRD(dst, off) asm volatile("ds_read_b64_tr_b16 %0, %1 offset:%2" : "=&v"(dst) : "v"(vb0), "i"(off) : "memory")
#define PV_D0(d0) do { s16x4 l0, l1, l2, l3, h0, h1, h2, h3; constexpr int b_ = VB * SHM_V + v_rd_off(d0, 0, 0); \
        TRRD(l0, b_); TRRD(h0, b_ + 2048); TRRD(l1, b_ + 4096); TRRD(h1, b_ + 6144); TRRD(l2, b_ + 8192); TRRD(h2, b_ + 10240); TRRD(l3, b_ + 12288); TRRD(h3, b_ + 14336); \
        asm volatile("s_waitcnt lgkmcnt(0)" ::: "memory"); SBAR();   \
        o[d0] = __builtin_amdgcn_mfma_f32_32x32x16_bf16(pa0, (bf16x8){l0[0], l0[1], l0[2], l0[3], h0[0], h0[1], h0[2], h0[3]}, o[d0], 0, 0, 0);   \
        o[d0] = __builtin_amdgcn_mfma_f32_32x32x16_bf16(pa1, (bf16x8){l1[0], l1[1], l1[2], l1[3], h1[0], h1[1], h1[2], h1[3]}, o[d0], 0, 0, 0);   \
        o[d0] = __builtin_amdgcn_mfma_f32_32x32x16_bf16(pa2, (bf16x8){l2[0], l2[1], l2[2], l2[3], h2[0], h2[1], h2[2], h2[3]}, o[d0], 0, 0, 0);   \
        o[d0] = __builtin_amdgcn_mfma_f32_32x32x16_bf16(pa3, (bf16x8){l3[0], l3[1], l3[2], l3[3], h3[0], h3[1], h3[2], h3[3]}, o[d0], 0, 0, 0); } while (0)
    PV_D0(0); PV_D0(1); PV_D0(2); PV_D0(3);
#undef PV_D0
#undef TRRD
}
struct BlockRef { const bf16* Q; const bf16* K; const bf16* V; bf16* O; int P0; };
struct Seam { bf16x8 qr[8]; bf16x8 st_v0, st_v1, st_k0, st_k1; };
#define ROW(p, k0, rr) ((p) + (size_t)((k0) + (rr)) * PITCH + sc)
#define VMW() asm volatile("s_waitcnt vmcnt(0)" ::: "memory")
#define VMWN(n) asm volatile("s_waitcnt vmcnt(%0)" :: "i"(n) : "memory")
#define SLOAD_H(Kp, Vp, k0) do { S.st_v0 = load8(ROW(Vp, k0, sr)); S.st_v1 = load8(ROW(Vp, k0, 32 + sr)); S.st_k0 = load8(ROW(Kp, k0, sr)); S.st_k1 = load8(ROW(Kp, k0, 32 + sr)); } while (0)
#define SWRITE_HK(bf) do { *(bf16x8*)(K_lds + (bf) * SHM_K + kws) = S.st_k0; *(bf16x8*)(K_lds + (bf) * SHM_K + kws + 32 * 256) = S.st_k1; } while (0)
#define SWRITE_HV(bf) do { *(bf16x8*)(V_lds + (bf) * SHM_V + vst0) = S.st_v0; *(bf16x8*)(V_lds + (bf) * SHM_V + vst1) = S.st_v1; } while (0)
#define SWRITE_H(bf) do { SWRITE_HV(bf); SWRITE_HK(bf); } while (0)
__device__ __forceinline__ void attn_prime(const BlockRef& cur, char* lds, Seam& S) {
    const int tid = threadIdx.x, wid = __builtin_amdgcn_readfirstlane(tid >> 6), lane = tid & 63, r32 = lane & 31, hi = lane >> 5;
    const int sr = tid >> 4, sc = (tid & 15) * 8, kws = KSWZ(sr, sc * 2); char* K_lds = lds + 2 * SHM_V;
#pragma unroll
    for (int d0 = 0; d0 < 8; ++d0) S.qr[d0] = load8(cur.Q + (size_t)(wid * QBLK + r32) * PITCH + d0 * 16 + hi * 8);
    SLOAD_H(cur.K, cur.V, 0); VMW(); SWRITE_HK(0);
    __syncthreads();
}
__device__ __forceinline__ void attn_block(const BlockRef& cur, const BlockRef& nxt, char* lds, Seam& S) {
    const int tid = threadIdx.x, wid = __builtin_amdgcn_readfirstlane(tid >> 6), lane = tid & 63, r32 = lane & 31, hi = lane >> 5;
    const int NT = cur.P0 / KVBLK + QB / KVBLK;
    const int qlo = cur.P0 + wid * QBLK, cw = qlo >> 6;
    char* V_lds = lds; char* K_lds = lds + 2 * SHM_V;
    float* ws = (float*)(lds + 2 * SHM_V + 2 * SHM_K) + wid * 64; float* li_l = ws, * al_l = ws + 32;
    const float* btab = (const float*)(lds + BIAS_OFF);
    float m_reg = -1e30f, l_reg = 0; f32x16 o[4] = {};
    const int sr = tid >> 4, sc = (tid & 15) * 8, vst0 = v_st(sr, sc), vst1 = v_st(32 + sr, sc), kws = KSWZ(sr, sc * 2);
    const int vb0 = (int)(uintptr_t)V_lds + v_rd_base(lane);
    const bf16* Kh = cur.K; const bf16* Vh = cur.V;
    const int bb0 = qlo + r32 - 4 * hi + 4;
#define RESC(a) do { if (__any((a) < 1.f)) { if (hi == 0) al_l[r32] = (a); asm volatile("s_waitcnt lgkmcnt(0)" ::: "memory");              \
                     for (int d_ = 0; d_ < 4; ++d_) for (int r = 0; r < 16; ++r) o[d_][r] *= al_l[crow(r, hi)]; } } while (0)
#define KBASE(t) ((t) * KVBLK)
#define ACT(t) ((t) <= cw)
#define BIAST(P0_, P1_, t) do { if ((t) <= cw && (t) + 2 >= cw) bias_tile(P0_, P1_, btab + (bb0 - KBASE(t))); } while (0)
    constexpr int NQL = 8;
#define SEAM_K0() do { VMWN(NQL); SWRITE_HK(0); SBAR(); } while (0)
    f32x16 pA0, pA1, pB0, pB1; float mnA, mnB, alA, alB; bf16x8 pa0, pa1, pa2, pa3;
    SWRITE_HV(0); SBAR();
    SLOAD_H(Kh, Vh, KBASE(1));
    SBAR(); qkt<0>(pA0, pA1, K_lds, r32, hi, S.qr, ACT(0));
    BIAST(pA0, pA1, 0); partialSM(pA0, pA1, m_reg, mnA, alA);
    VMW(); SWRITE_H(1);
    __syncthreads();
#define HALF_STEP(PX0, PX1, mnX, alX, PY0, PY1, alY, t, KB, VB, SB) do {                                                      \
        SBAR(); qkt<KB>(PX0, PX1, K_lds, r32, hi, S.qr, ACT(t));                                                 \
        finishSM(PY0, PY1, alY, l_reg, pa0, pa1, pa2, pa3); SBAR();                                                           \
        if ((t) + 1 < NT) { SLOAD_H(Kh, Vh, KBASE((t) + 1)); SBAR(); }                                                         \
        pv_tile<VB>(o, vb0, pa0, pa1, pa2, pa3, ACT((t) - 1)); BIAST(PX0, PX1, (t)); partialSM(PX0, PX1, m_reg, mnX, alX);    \
        __syncthreads();                                                                                                      \
        if ((t) + 1 < NT) { VMW(); SWRITE_H(SB); }                                                                             \
        RESC(alX); __syncthreads(); } while (0)
    for (int t = 1; t + 1 < NT; t += 2) {
        HALF_STEP(pB0, pB1, mnB, alB, pA0, pA1, alA, t, 1, 0, 0);
        HALF_STEP(pA0, pA1, mnA, alA, pB0, pB1, alB, t + 1, 0, 1, 1);
    }
    { SBAR(); qkt<1>(pB0, pB1, K_lds, r32, hi, S.qr, ACT(NT - 1)); SBAR(); }
    SLOAD_H(nxt.K, nxt.V, 0); SBAR();
#pragma unroll
    for (int d0 = 0; d0 < 8; ++d0) S.qr[d0] = load8(nxt.Q + (size_t)(wid * QBLK + r32) * PITCH + d0 * 16 + hi * 8);
    SBAR();
    finishSM(pA0, pA1, alA, l_reg, pa0, pa1, pa2, pa3); SBAR();
    pv_tile<0>(o, vb0, pa0, pa1, pa2, pa3, ACT(NT - 2));
    { BIAST(pB0, pB1, NT - 1); partialSM(pB0, pB1, m_reg, mnB, alB); __syncthreads(); RESC(alB);
      finishSM(pB0, pB1, alB, l_reg, pa0, pa1, pa2, pa3); SBAR(); pv_tile<1>(o, vb0, pa0, pa1, pa2, pa3, ACT(NT - 1)); }
    SBAR(); SEAM_K0();
    if (hi == 0) li_l[r32] = l_reg; asm volatile("s_waitcnt lgkmcnt(0)" ::: "memory");
    float rli[16];
#pragma unroll
    for (int r = 0; r < 16; ++r) rli[r] = __builtin_amdgcn_rcpf(li_l[crow(r, hi)]);
    bf16* Ow = cur.O + (size_t)(wid * QBLK) * PITCH;
#pragma unroll
    for (int r = 0; r < 16; ++r) { const int orow = crow(r, hi);
#pragma unroll
        for (int d0 = 0; d0 < 4; ++d0) { const float v = o[d0][r] * rli[r];
            const float vn = __shfl_xor(v, 1);
            if ((r32 & 1) == 0) *(unsigned*)(Ow + (size_t)orow * PITCH + d0 * 32 + r32) = cvtpk(v, vn); } }
    __syncthreads();
#undef RESC
#undef KBASE
#undef ACT
#undef BIAST
#undef SEAM_K0
#undef HALF_STEP
}
#undef ROW
#undef VMW
#undef VMWN
#undef SLOAD_H
#undef SWRITE_HK
#undef SWRITE_HV
#undef SWRITE_H
#undef KSWZ
}

namespace attn2 {
using attn::bf16x8; using attn::s16x4; using attn::f32x16; using attn::u32x4; using attn::bf16;
using attn::v_st; using attn::v_rd_base; using attn::crow; using attn::cvtpk; using attn::load8; using attn::t5_bucket;
constexpr int D = 128, PITCH = 1024;
constexpr float SCALE = 0.08838834764831845f, THR = 8.f;
constexpr int NW = 8, QBLK = 32, KVBLK = 64, QB = 4 * QBLK;
constexpr int IMG = KVBLK * D * 2, SHM_V = 2 * IMG, SHM_K = KVBLK * D * 2;
constexpr int OFF_V = 0, OFF_K = 2 * SHM_V, OFF_PX = OFF_K + 2 * SHM_K, OFF_WS = OFF_PX + NW * 2048, OFF_MX = OFF_WS + NW * 64 * 4, BIAS_OFF = OFF_MX + NW * 32 * 4, NBIAS = 320;
constexpr int LDS_BYTES = BIAS_OFF + NBIAS * 4;
#define KSWZ(row, colB) ((row) * 256 + ((colB) ^ (((row) & 7) << 4)))
#define SBAR() __builtin_amdgcn_sched_barrier(0)
#ifndef ATTN_SGB
#define ATTN_SGB 1
#endif
#if ATTN_SGB
#define SGB_A() do { _Pragma("unroll") for (int g_ = 0; g_ < 8; ++g_) { __builtin_amdgcn_sched_group_barrier(0x008, 1, 0); __builtin_amdgcn_sched_group_barrier(0x402, 9, 0); } } while (0)
#else
#define SGB_A() do {} while (0)
#endif
#define L3 __attribute__((address_space(3)))
#define LP(T, byteoff) ((L3 T*)(uintptr_t)(unsigned)(byteoff))
__device__ __forceinline__ void bias_half(f32x16& p, const L3 float* tabp) {
#pragma unroll
    for (int r = 0; r < 16; ++r) { const int c = (r & 3) + 8 * (r >> 2); p[r] += tabp[59 - c]; }
}
__device__ __forceinline__ float rowmax_half(const f32x16& p) {
    float pmax = p[0];
#pragma unroll
    for (int r = 1; r < 16; ++r) pmax = fmaxf(pmax, p[r]);
    const auto rr = __builtin_amdgcn_permlane32_swap(__float_as_uint(pmax), __float_as_uint(pmax), false, false);
    return fmaxf(__uint_as_float(rr[0]), __uint_as_float(rr[1]));
}
__device__ __forceinline__ void partialSM(f32x16& p, float pmax, float& m_reg, float& alpha) {
    constexpr float C2 = 1.4426950408889634f * SCALE; float mn;
    if (__builtin_expect(__all((pmax - m_reg) * SCALE <= THR), 1)) { mn = m_reg; alpha = 1.f; }
    else { mn = fmaxf(m_reg, pmax); alpha = __builtin_amdgcn_exp2f((m_reg - mn) * C2); m_reg = mn; }
    const float mnL = -mn * C2;
#pragma unroll
    for (int r = 0; r < 16; ++r) p[r] = fmaf(p[r], C2, mnL);
#pragma unroll
    for (int r = 0; r < 8; ++r) p[r] = __builtin_amdgcn_exp2f(p[r]);
}
__device__ __forceinline__ void finishSM(f32x16& p, float alpha, float& l_reg, bf16x8& pa0, bf16x8& pa1) {
#pragma unroll
    for (int r = 8; r < 16; ++r) p[r] = __builtin_amdgcn_exp2f(p[r]);
    float ps = 0;
#pragma unroll
    for (int r = 0; r < 16; ++r) ps += p[r];
    { const auto rr = __builtin_amdgcn_permlane32_swap(__float_as_uint(ps), __float_as_uint(ps), false, false); ps = __uint_as_float(rr[0]) + __uint_as_float(rr[1]); }
    l_reg = l_reg * alpha + ps;
#define PK4(P, B_, OUT) do { unsigned a0 = cvtpk(P[B_+0], P[B_+1]), a1 = cvtpk(P[B_+2], P[B_+3]);                          \
        unsigned b0 = cvtpk(P[B_+4], P[B_+5]), b1 = cvtpk(P[B_+6], P[B_+7]);                                             \
        auto r0 = __builtin_amdgcn_permlane32_swap(a0, b0, false, false); auto r1 = __builtin_amdgcn_permlane32_swap(a1, b1, false, false); \
        u32x4 w = {r0[0], r1[0], r0[1], r1[1]}; OUT = *reinterpret_cast<bf16x8*>(&w); } while (0)
    PK4(p, 0, pa0); PK4(p, 8, pa1);
#undef PK4
}
template <int KB>
__device__ __forceinline__ void kload(bf16x8* kf, unsigned K_lds, int krow, int hi) {
    unsigned kb[4];
#pragma unroll
    for (int dd = 0; dd < 4; ++dd) kb[dd] = K_lds + KB * SHM_K + KSWZ(krow, (dd * 16 + hi * 8) * 2);
#pragma unroll
    for (int d0 = 0; d0 < 8; ++d0) kf[d0] = *LP(const bf16x8, kb[d0 & 3] + (d0 >> 2) * 128);
}
__device__ __forceinline__ void qmma(f32x16& p, const bf16x8* kf, const bf16x8* qr) {
    p = f32x16{};
#pragma unroll
    for (int d0 = 0; d0 < 8; ++d0) p = __builtin_amdgcn_mfma_f32_32x32x16_bf16(kf[d0], qr[d0], p, 0, 0, 0);
}
__device__ __forceinline__ void pneg(f32x16& p) { const float NEG = -__builtin_inff();
#pragma unroll
    for (int r = 0; r < 16; ++r) p[r] = NEG; }
template <int VB>
__device__ __forceinline__ void pv_tile(f32x16* o, int vbo, int vbp, bf16x8 po0, bf16x8 po1, bf16x8 pp0, bf16x8 pp1, bool act) {
    if (!act) return;
#define TRRD(dst, base, off) asm volatile("ds_read_b64_tr_b16 %0, %1 offset:%2" : "=&v"(dst) : "v"(base), "i"(off) : "memory")
#define PV_D0(d0) do { s16x4 l0, l1, l2, l3, h0, h1, h2, h3; constexpr int b_ = VB * SHM_V + (d0) * 512; \
        TRRD(l0, vbo, b_); TRRD(h0, vbo, b_ + 2048); TRRD(l1, vbo, b_ + 4096); TRRD(h1, vbo, b_ + 6144); TRRD(l2, vbp, b_); TRRD(h2, vbp, b_ + 2048); TRRD(l3, vbp, b_ + 4096); TRRD(h3, vbp, b_ + 6144); \
        asm volatile("s_waitcnt lgkmcnt(0)" ::: "memory"); SBAR();   \
        o[d0] = __builtin_amdgcn_mfma_f32_32x32x16_bf16(po0, (bf16x8){l0[0], l0[1], l0[2], l0[3], h0[0], h0[1], h0[2], h0[3]}, o[d0], 0, 0, 0);   \
        o[d0] = __builtin_amdgcn_mfma_f32_32x32x16_bf16(po1, (bf16x8){l1[0], l1[1], l1[2], l1[3], h1[0], h1[1], h1[2], h1[3]}, o[d0], 0, 0, 0);   \
        o[d0] = __builtin_amdgcn_mfma_f32_32x32x16_bf16(pp0, (bf16x8){l2[0], l2[1], l2[2], l2[3], h2[0], h2[1], h2[2], h2[3]}, o[d0], 0, 0, 0);   \
        o[d0] = __builtin_amdgcn_mfma_f32_32x32x16_bf16(pp1, (bf16x8){l3[0], l3[1], l3[2], l3[3], h3[0], h3[1], h3[2], h3[3]}, o[d0], 0, 0, 0); } while (0)
    PV_D0(0); PV_D0(1); PV_D0(2); PV_D0(3);
#undef PV_D0
#undef TRRD
}
struct BlockRef { const bf16* Q; const bf16* K; const bf16* V; bf16* O; int P0; };
struct Seam { bf16x8 qr[8]; bf16x8 k0[2], k1[2], v0[2], v1[2], v2[2], v3[2]; };
#define VMW() asm volatile("s_waitcnt vmcnt(0)" ::: "memory")
typedef __amdgpu_buffer_rsrc_t rsrc_t;
__device__ __forceinline__ rsrc_t mkrsrc(const bf16* p) { return __builtin_amdgcn_make_buffer_rsrc((void*)p, (short)0, 0x7fffffff, 0x00020000); }
__device__ __forceinline__ bf16x8 bld16(rsrc_t r, unsigned voff, unsigned soff) { return __builtin_bit_cast(bf16x8, __builtin_amdgcn_raw_buffer_load_b128(r, (int)voff, (int)soff, 0)); }
#define RB(kk_, radd) ((unsigned)(((kk_) + (radd)) * PITCH) * 2u)
#define SLOADK(set, rK_, kk_) do { S.k0[set] = bld16(rK_, lofs, RB(kk_, 0)); S.k1[set] = bld16(rK_, lofs, RB(kk_, 32)); } while (0)
#define SLOADV(set, rV_, kk_) do { S.v0[set] = bld16(rV_, lofs, RB(kk_, 0)); S.v1[set] = bld16(rV_, lofs, RB(kk_, 32)); S.v2[set] = bld16(rV_, lofs, RB(kk_, 0) + 256u); S.v3[set] = bld16(rV_, lofs, RB(kk_, 32) + 256u); } while (0)
#define SWRITE_K(bf, set) do { *LP(bf16x8, K_lds + (bf) * SHM_K + kws) = S.k0[set]; *LP(bf16x8, K_lds + (bf) * SHM_K + kws + 32 * 256) = S.k1[set]; } while (0)
#define SWRITE_V(bf, set) do { *LP(bf16x8, V_lds + (bf) * SHM_V + vst0) = S.v0[set]; *LP(bf16x8, V_lds + (bf) * SHM_V + vst0 + VST1) = S.v1[set]; *LP(bf16x8, V_lds + (bf) * SHM_V + IMG + vst0) = S.v2[set]; *LP(bf16x8, V_lds + (bf) * SHM_V + IMG + vst0 + VST1) = S.v3[set]; } while (0)
__device__ __forceinline__ void attn_prime(const BlockRef& cur, char* lds, Seam& S, int tid) {
    const int wid = __builtin_amdgcn_readfirstlane(tid >> 6), lane = tid & 63, r32 = lane & 31, hi = lane >> 5, pj = wid & 3;
    const int sr = tid >> 4, sc = (tid & 15) * 8, kws = KSWZ(sr, sc * 2); const unsigned K_lds = (unsigned)(uintptr_t)lds + OFF_K, lofs = (unsigned)(sr * PITCH + sc) * 2u, qofs = (unsigned)(r32 * PITCH + hi * 8) * 2u;
    const rsrc_t rQ = mkrsrc(cur.Q), rK = mkrsrc(cur.K), rV = mkrsrc(cur.V);
#pragma unroll
    for (int d0 = 0; d0 < 8; ++d0) S.qr[d0] = bld16(rQ, qofs, (unsigned)((pj * QBLK) * PITCH + d0 * 16) * 2u);
    SLOADK(0, rK, 0); VMW(); SWRITE_K(0, 0); SBAR();
    SLOADK(1, rK, KVBLK); SLOADV(0, rV, 0); SLOADK(0, rK, 2 * KVBLK); SLOADV(1, rV, KVBLK);
    __syncthreads();
}
__device__ __forceinline__ void attn_block(const BlockRef& cur, const BlockRef& nxt, char* lds, Seam& S, int tid) {
    const int wid = __builtin_amdgcn_readfirstlane(tid >> 6), lane = tid & 63, r32 = lane & 31, hi = lane >> 5, pj = wid & 3, kh = wid >> 2, pw = wid ^ 4;
    const int NT = cur.P0 / KVBLK + QB / KVBLK, NTn = nxt.P0 / KVBLK + QB / KVBLK;
    const int qlo = cur.P0 + pj * QBLK, cw = qlo >> 6;
    const unsigned L = (unsigned)(uintptr_t)lds, V_lds = L + OFF_V, K_lds = L + OFF_K;
    L3 float* li_l = LP(float, L + OFF_WS + wid * 256); L3 float* al_l = li_l + 32; const L3 float* li_p = LP(const float, L + OFF_WS + pw * 256);
    L3 float* mx_o = LP(float, L + OFF_MX + wid * 128); const L3 float* mx_p = LP(const float, L + OFF_MX + pw * 128);
    const unsigned px_o = L + OFF_PX + wid * 2048 + lane * 16, px_p = L + OFF_PX + pw * 2048 + lane * 16;
    const L3 float* btab = LP(const float, L + BIAS_OFF);
    float m_reg = -1e30f, l_reg = 0; f32x16 o[4] = {};
    const int sr = tid >> 4, sc = (tid & 15) * 8, vst0 = v_st(sr, sc), kws = KSWZ(sr, sc * 2); constexpr int VST1 = 8192;
    const unsigned lofs = (unsigned)(sr * PITCH + sc) * 2u, qofs = (unsigned)(r32 * PITCH + hi * 8) * 2u;
    const int vbase = (int)V_lds + v_rd_base(lane) + kh * IMG, vbo = vbase + kh * 8192, vbp = vbase + (1 - kh) * 8192;
    const int krow = kh * 32 + r32;
    const rsrc_t cK = mkrsrc(cur.K), cV = mkrsrc(cur.V), nK = mkrsrc(nxt.K), nV = mkrsrc(nxt.V);
    const int bb0 = qlo + r32 - 4 * hi + 4 - 32 * kh;
#define RESC(a) do { if (__any((a) < 1.f)) { if (hi == 0) al_l[r32] = (a); asm volatile("s_waitcnt lgkmcnt(0)" ::: "memory");              \
                     for (int d_ = 0; d_ < 4; ++d_) for (int r = 0; r < 16; ++r) o[d_][r] *= al_l[crow(r, hi)]; } } while (0)
#define KBASE(t) ((t) * KVBLK)
#define ACT(t) ((t) <= cw)
#define BIAST(P_, t) do { if ((t) <= cw && (t) + 2 >= cw) bias_half(P_, btab + (bb0 - KBASE(t))); } while (0)
#define PUTMAX(P_) do { const float pm_ = rowmax_half(P_); if (hi == 0) mx_o[r32] = pm_; pmx = pm_; } while (0)
#define GETMAX() fmaxf(pmx, mx_p[r32])
#define VLOADK(set, v) do { const int v_ = (v); if (v_ < NT) SLOADK(set, cK, KBASE(v_)); else SLOADK(set, nK, KBASE((v_ - NT) % NTn)); } while (0)
#define VLOADV(set, v) do { const int v_ = (v); if (v_ < NT) SLOADV(set, cV, KBASE(v_)); else SLOADV(set, nV, KBASE((v_ - NT) % NTn)); } while (0)
    f32x16 pA, pB; float alA, alB, pmx; bf16x8 po0, po1, pp0, pp1;
#define STEP(PX_, alX, PY_, alY, t, KB, HASPREV) do {                                                                               \
        SBAR(); SWRITE_V(KB, KB); SBAR(); VLOADV(KB, (t) + 2); SBAR();                                                               \
        if (ACT(t)) { bf16x8 kf_[8]; kload<KB>(kf_, K_lds, krow, hi); SBAR(); qmma(PX_, kf_, S.qr);                                  \
                      if (HASPREV) { finishSM(PY_, alY, l_reg, po0, po1); *LP(bf16x8, px_o) = po0; *LP(bf16x8, px_o + 1024) = po1; } SGB_A(); }   \
        else { pneg(PX_); if (HASPREV) { finishSM(PY_, alY, l_reg, po0, po1); *LP(bf16x8, px_o) = po0; *LP(bf16x8, px_o + 1024) = po1; } }        \
        SBAR(); BIAST(PX_, (t)); PUTMAX(PX_);                                                                                       \
        __syncthreads();                                                                                                           \
        if (HASPREV) { pp0 = *LP(const bf16x8, px_p); pp1 = *LP(const bf16x8, px_p + 1024); }                                        \
        partialSM(PX_, GETMAX(), m_reg, alX);                                                                                      \
        if (HASPREV) pv_tile<1 - KB>(o, vbo, vbp, po0, po1, pp0, pp1, ACT((t) - 1));                                                \
        SBAR(); SWRITE_K(1 - KB, 1 - KB); SBAR(); VLOADK(1 - KB, (t) + 3); SBAR();                                                   \
        RESC(alX); __syncthreads(); } while (0)
    for (int t = 0; t < NT; t += 2) {
        STEP(pA, alA, pB, alB, t, 0, t > 0);
        STEP(pB, alB, pA, alA, t + 1, 1, true);
    }
    { const rsrc_t nQ = mkrsrc(nxt.Q);
#pragma unroll
      for (int d0 = 0; d0 < 8; ++d0) S.qr[d0] = bld16(nQ, qofs, (unsigned)((pj * QBLK) * PITCH + d0 * 16) * 2u); }
    SBAR();
    finishSM(pB, alB, l_reg, po0, po1); *LP(bf16x8, px_o) = po0; *LP(bf16x8, px_o + 1024) = po1;
    if (hi == 0) li_l[r32] = l_reg;
    __syncthreads();
    pp0 = *LP(const bf16x8, px_p); pp1 = *LP(const bf16x8, px_p + 1024);
    pv_tile<1>(o, vbo, vbp, po0, po1, pp0, pp1, ACT(NT - 1));
    float rli[16];
#pragma unroll
    for (int r = 0; r < 16; ++r) rli[r] = __builtin_amdgcn_rcpf(li_l[crow(r, hi)] + li_p[crow(r, hi)]);
    int lane_off = hi * 4 * PITCH + r32; asm volatile("" : "+v"(lane_off));
    bf16* Ow = cur.O + ((pj * QBLK) * PITCH + kh * 128 + lane_off);
#pragma unroll
    for (int r = 0; r < 16; ++r) { const int orow = (r & 3) + 8 * (r >> 2);
#pragma unroll
        for (int d0 = 0; d0 < 4; ++d0) { const float v = o[d0][r] * rli[r];
            const float vn = __shfl_xor(v, 1);
            if ((r32 & 1) == 0) *(unsigned*)(Ow + (orow * PITCH + d0 * 32)) = cvtpk(v, vn); } }
    __syncthreads();
#undef RESC
#undef KBASE
#undef ACT
#undef BIAST
#undef PUTMAX
#undef GETMAX
#undef VLOADK
#undef VLOADV
#undef STEP
}
#undef SLOADK
#undef SLOADV
#undef SWRITE_K
#undef SWRITE_V
#undef VMW
#undef RB
#undef KSWZ
#undef L3
#undef LP
#undef SGB_A
}


constexpr int NWAVES = 8;
constexpr int BATCH = 16, SEQ = 2048, T = BATCH * SEQ, D = 1024, NIN = 8192, NE = 32, DE = 512;
constexpr int MAXT = 288, MAXS = MAXT * 256;
constexpr float LN_EPS = 1e-5f, RMS_EPS = 1e-6f, ALPHA = 1.189207115002721f, LAM_INIT = 0.2f;
constexpr size_t MiB = 1u << 20;
constexpr size_t WS_CTL = 0, CTL_ZERO_BYTES = 1 * MiB;
constexpr size_t WS_STATS = 1 * MiB, WS_EID = WS_STATS + 256 * 1024, WS_EW = WS_EID + 256 * 1024, WS_RANK = WS_EW + 256 * 1024, WS_SLOT = 2 * MiB, WS_CNTWG = WS_SLOT + 256 * 1024, WS_TOK = 3 * MiB, WS_IDL = WS_TOK + 512 * 1024;
constexpr size_t WS_WA = 4 * MiB, WS_WB = 6 * MiB, WS_WO = 8 * MiB, WS_WIN = 10 * MiB;
constexpr size_t WS_XN = 26 * MiB, WS_Q = 90 * MiB, WS_K = 154 * MiB, WS_V = 218 * MiB, WS_CB = 282 * MiB, WS_Z = 346 * MiB, WS_O1 = 410 * MiB;
constexpr size_t WS_WGU = 90 * MiB, WS_WD = 154 * MiB, WS_PRE = 186 * MiB, WS_XG = 314 * MiB, WS_END = 458 * MiB;
constexpr size_t WS_WGU8 = 90 * MiB, WS_WD8 = 122 * MiB, WS_X18 = 250 * MiB;
constexpr int CW_TMO = 0, CW_CODE = 1, CW_BAR = 4096, CW_MOE = 65536;
constexpr int RING_OFF = 0, RING_BYTES = 131072, RW_BYTES = 147456;
constexpr int LDSCTL_OFF = RW_BYTES, MISC_OFF = LDSCTL_OFF + 320, TAB_OFF = LDSCTL_OFF + 512, RSCR_OFF = LDSCTL_OFF + 1024;
constexpr int LDS_BYTES = 163840;
static_assert(RSCR_OFF + 8 * 128 * 4 + 1024 <= LDS_BYTES, "LDS map");

#define GAS __attribute__((address_space(1)))
#define LAS __attribute__((address_space(3)))
typedef unsigned short bf16;
#ifdef SWAP_CB_SGA
#define BUF_CB(P)  ((bf16*)(P).out)
#define BUF_SGA(P) ((bf16*)((P).ws + WS_CB))
#else
#define BUF_CB(P)  ((bf16*)((P).ws + WS_CB))
#define BUF_SGA(P) ((bf16*)(P).out)
#endif
#define BUF_SGB(P) ((bf16*)(P).out + (size_t)T * D)
typedef unsigned v4u __attribute__((ext_vector_type(4)));
typedef unsigned v2u __attribute__((ext_vector_type(2)));
typedef float f32x4 __attribute__((ext_vector_type(4)));
typedef GAS unsigned gu32;
#define RLX_AGENT __ATOMIC_RELAXED, __HIP_MEMORY_SCOPE_AGENT
#define LDS_WAIT() asm volatile("s_waitcnt lgkmcnt(0)" ::: "memory")
#define VM_WAIT() asm volatile("s_waitcnt vmcnt(0)" ::: "memory")
__device__ __forceinline__ unsigned f2bf(float f) { unsigned u = __builtin_bit_cast(unsigned, f); return (u + 0x7fffu + ((u >> 16) & 1u)) >> 16; }
__device__ __forceinline__ unsigned pk2(float lo, float hi) { return f2bf(lo) | (f2bf(hi) << 16); }
__device__ __forceinline__ float bflo(unsigned w) { return __uint_as_float(w << 16); }
__device__ __forceinline__ float bfhi(unsigned w) { return __uint_as_float(w & 0xffff0000u); }

#define XB_TMO      128
#define XB_XCNT(j)  (256  + 64 * (j))
#define XB_XSUB(j)  (1280 + 64 * (j))
#define XB_XGEN(j)  (2304 + 64 * (j))
#define XB_TOP      3328
#define XB_TOPGEN   3392
#define XCD_BAR_WORDS 3456
#define XB_SPIN_CAP (1u << 18)
__device__ __forceinline__ unsigned xb_ld(unsigned* p)              { return __hip_atomic_load(p, __ATOMIC_RELAXED, __HIP_MEMORY_SCOPE_AGENT); }
__device__ __forceinline__ unsigned xb_add(unsigned* p, unsigned v) { return __hip_atomic_fetch_add(p, v, __ATOMIC_RELAXED, __HIP_MEMORY_SCOPE_AGENT); }
__device__ __forceinline__ unsigned xb_xcc_id() { return (unsigned)__builtin_amdgcn_s_getreg((3 << 11) | 20) & 0xFu; }
#define XB_SPIN(cond, bar) do { unsigned _sp = 0; while (cond) { __builtin_amdgcn_s_sleep(1); \
    if ((++_sp & 255u) == 0u) { if (xb_ld(&(bar)[XB_TMO])) break; if (_sp > XB_SPIN_CAP) { atomicAdd(&(bar)[XB_TMO], 1u); break; } } } } while (0)
struct XcdBarrier { unsigned* bar; unsigned x; volatile LAS unsigned* st; };
__device__ __forceinline__ XcdBarrier xcd_barrier_post(unsigned* bar, volatile LAS unsigned* st) {
    XcdBarrier b; b.bar = bar; b.x = xb_xcc_id(); b.st = st;
    if (threadIdx.x == 0) (void)xb_add(&bar[XB_XCNT(b.x)], 1u);
    return b;
}
__device__ __forceinline__ void xcd_barrier_complete(unsigned* bar, unsigned x, unsigned& nloc, unsigned& nx) {
    const unsigned G = gridDim.x * gridDim.y * gridDim.z;
    unsigned sum, cnt, mine, sp = 0u;
    for (;;) {
        sum = 0u; cnt = 0u; mine = 0u;
#pragma unroll
        for (unsigned j = 0; j < 16; ++j) { const unsigned c = xb_ld(&bar[XB_XCNT(j)]); sum += c; cnt += (c > 0u) ? 1u : 0u; mine = (j == x) ? c : mine; }
        if (sum == G) break;
        __builtin_amdgcn_s_sleep(1);
        if ((++sp & 255u) == 0u) { if (xb_ld(&bar[XB_TMO])) break; if (sp > XB_SPIN_CAP) { atomicAdd(&bar[XB_TMO], 1u); break; } }
    }
    nloc = mine > 0u ? mine : 1u; nx = cnt > 0u ? cnt : 1u;
}
__device__ __forceinline__ void xcd_barrier(const XcdBarrier& b) {
    asm volatile("s_waitcnt vmcnt(0)" ::: "memory");
    __syncthreads();
    if (threadIdx.x == 0) {
        unsigned* bar = b.bar;
        __builtin_amdgcn_s_waitcnt(0);
        unsigned nloc = b.st[0], nx = b.st[1];
        if (nloc == 0u) { xcd_barrier_complete(bar, b.x, nloc, nx); b.st[0] = nloc; b.st[1] = nx; }
        const unsigned old = xb_add(&bar[XB_XSUB(b.x)], 1u);
        const unsigned gen = old / nloc;
        if (old + 1u == (gen + 1u) * nloc) {
            __builtin_amdgcn_fence(__ATOMIC_RELEASE, "agent");
            asm volatile("s_waitcnt vmcnt(0)" ::: "memory");
            const unsigned og = xb_add(&bar[XB_TOP], 1u);
            const unsigned tg = og / nx;
            if (og + 1u == (tg + 1u) * nx) xb_add(&bar[XB_TOPGEN], 1u);
            else XB_SPIN(xb_ld(&bar[XB_TOPGEN]) == tg, bar);
            __builtin_amdgcn_fence(__ATOMIC_ACQUIRE, "agent");
            xb_add(&bar[XB_XGEN(b.x)], 1u);
            asm volatile("s_waitcnt vmcnt(0)" ::: "memory");
        } else {
            XB_SPIN(xb_ld(&bar[XB_XGEN(b.x)]) == gen, bar);
            __builtin_amdgcn_fence(__ATOMIC_ACQUIRE, "agent");
            asm volatile("s_waitcnt vmcnt(0)" ::: "memory");
        }
    }
    __syncthreads();
}

struct Frame {
    LAS unsigned char* lds; volatile LAS unsigned* MISC; gu32* ctl;
    int tid, lane, wave, vcu, G;
};
__device__ __forceinline__ float wave_sum(float v) {
#pragma unroll
    for (int o = 1; o < 64; o <<= 1) v += __shfl_xor(v, o);
    return v;
}
__device__ __forceinline__ float wave_sum_fast(float v) {
    v += __int_as_float(__builtin_amdgcn_update_dpp(0, __float_as_int(v), 0x128, 0xf, 0xf, false));
    v += __int_as_float(__builtin_amdgcn_update_dpp(0, __float_as_int(v), 0x124, 0xf, 0xf, false));
    v += __int_as_float(__builtin_amdgcn_update_dpp(0, __float_as_int(v), 0x122, 0xf, 0xf, false));
    v += __int_as_float(__builtin_amdgcn_update_dpp(0, __float_as_int(v), 0x121, 0xf, 0xf, false));
    const int vi = __float_as_int(v);
    return (__int_as_float(__builtin_amdgcn_readlane(vi, 0)) + __int_as_float(__builtin_amdgcn_readlane(vi, 16))) + (__int_as_float(__builtin_amdgcn_readlane(vi, 32)) + __int_as_float(__builtin_amdgcn_readlane(vi, 48)));
}
__device__ __forceinline__ void transpose_item(const float* W, int K, int N, int k0, int n0, bf16* WT, int drow0, LAS float* scr, int lane) {
#pragma unroll 8
    for (int i = 0; i < 32; ++i) { const int kk = 2 * i + (lane >> 5); scr[kk * 33 + (lane & 31)] = W[(size_t)(k0 + kk) * N + n0 + (lane & 31)]; }
    LDS_WAIT(); asm volatile("" ::: "memory");
    const int c = lane & 7;
#pragma unroll
    for (int j = 0; j < 4; ++j) { const int n = (lane >> 3) + 8 * j; const LAS float* s = scr + (8 * c) * 33 + n;
        v4u o; o.x = pk2(s[0 * 33], s[1 * 33]); o.y = pk2(s[2 * 33], s[3 * 33]); o.z = pk2(s[4 * 33], s[5 * 33]); o.w = pk2(s[6 * 33], s[7 * 33]);
        *(GAS v4u*)(WT + (size_t)(drow0 + n) * K + k0 + 8 * c) = o; }
    LDS_WAIT(); asm volatile("" ::: "memory");
}
__device__ __forceinline__ void transpose_item8(const float* W, int K, int N, int k0, int n0, unsigned char* WT, int drow0, LAS float* scr, int lane) {
#pragma unroll 8
    for (int i = 0; i < 32; ++i) { const int kk = 2 * i + (lane >> 5); scr[kk * 33 + (lane & 31)] = W[(size_t)(k0 + kk) * N + n0 + (lane & 31)]; }
    LDS_WAIT(); asm volatile("" ::: "memory");
    const int c = lane & 7; constexpr float sc = pg8::F8_WS;
#pragma unroll
    for (int j = 0; j < 4; ++j) { const int n = (lane >> 3) + 8 * j; const LAS float* s = scr + (8 * c) * 33 + n;
        v2u o; o.x = pg8::pk4_fp8(s[0 * 33] * sc, s[1 * 33] * sc, s[2 * 33] * sc, s[3 * 33] * sc); o.y = pg8::pk4_fp8(s[4 * 33] * sc, s[5 * 33] * sc, s[6 * 33] * sc, s[7 * 33] * sc);
        *(GAS v2u*)(WT + (size_t)(drow0 + n) * K + k0 + 8 * c) = o; }
    LDS_WAIT(); asm volatile("" ::: "memory");
}
__device__ __forceinline__ int win_drow(int n0) {
    if (n0 < 4096 || n0 >= 6144) return n0;
    if (n0 < 5120) { const int r = n0 - 4096; return 4096 + 256 * (r >> 7) + (r & 127); }
    const int r = n0 - 5120; return 4096 + 256 * (r >> 7) + 128 + (r & 127);
}
struct Ptrs {
    const float *x, *ln_in_g, *ln_in_b, *w_in, *b_gate, *lq, *lk, *subln_g, *rel_bias, *conv_w, *w_a, *w_b, *w_o, *ln1_g, *ln1_b, *w_group, *b_group, *w_sub, *b_sub, *w_gate_e, *w_up_e, *w_down_e, *ln2_g, *ln2_b;
    float* out; unsigned char* ws;
};
__device__ __forceinline__ void p0_prologue(Frame& F, const Ptrs& P) {
    LAS float* scr = (LAS float*)(F.lds + RING_OFF + F.wave * 16384);
    const int gw = F.vcu * NWAVES + F.wave, NGW = F.G * NWAVES;
    constexpr int I_IN = (D / 64) * (NIN / 32), I_SQ = (D / 64) * (D / 32);
    bf16* Wt_in = (bf16*)(P.ws + WS_WIN); bf16* Wt_a = (bf16*)(P.ws + WS_WA); bf16* Wt_b = (bf16*)(P.ws + WS_WB); bf16* Wt_o = (bf16*)(P.ws + WS_WO);
    for (int it = gw; it < I_IN + 3 * I_SQ; it += NGW) {
        int r = it;
        if (r < I_IN) { const int kb = r / (NIN / 32), nb = r % (NIN / 32); transpose_item(P.w_in, D, NIN, 64 * kb, 32 * nb, Wt_in, win_drow(32 * nb), scr, F.lane); continue; } r -= I_IN;
        const int which = r / I_SQ; r -= which * I_SQ; const int kb = r / (D / 32), nb = r % (D / 32);
        const float* W = which == 0 ? P.w_a : (which == 1 ? P.w_b : P.w_o); bf16* WT = which == 0 ? Wt_a : (which == 1 ? Wt_b : Wt_o);
        transpose_item(W, D, D, 64 * kb, 32 * nb, WT, 32 * nb, scr, F.lane);
    }
    bf16* XN = (bf16*)(P.ws + WS_XN); float* stats = (float*)(P.ws + WS_STATS);
    for (int m = gw; m < T; m += NGW) {
        const GAS f32x4* xr = (const GAS f32x4*)(P.x + (size_t)m * D) + F.lane;
        f32x4 v[4]; float s = 0.f;
#pragma unroll
        for (int j = 0; j < 4; ++j) { v[j] = xr[64 * j]; s += (v[j].x + v[j].y) + (v[j].z + v[j].w); }
        const float mean = wave_sum(s) * (1.f / D); float s2 = 0.f;
#pragma unroll
        for (int j = 0; j < 4; ++j) { v[j] = v[j] - mean; s2 += (v[j].x * v[j].x + v[j].y * v[j].y) + (v[j].z * v[j].z + v[j].w * v[j].w); }
        const float rstd = 1.f / sqrtf(wave_sum(s2) * (1.f / D) + LN_EPS);
        GAS unsigned long long* o8 = (GAS unsigned long long*)(XN + (size_t)m * D) + F.lane;
#pragma unroll
        for (int j = 0; j < 4; ++j) { const f32x4 g = *((const GAS f32x4*)P.ln_in_g + F.lane + 64 * j), b = *((const GAS f32x4*)P.ln_in_b + F.lane + 64 * j); const f32x4 y = v[j] * rstd * g + b;
            o8[64 * j] = (unsigned long long)pk2(y.x, y.y) | ((unsigned long long)pk2(y.z, y.w) << 32); }
        if (F.lane == 0) { stats[2 * m] = mean; stats[2 * m + 1] = rstd; }
    }
}
__device__ __forceinline__ void p2_conv(Frame& F, const Ptrs& P) {
    bf16* CB = BUF_CB(P); const bf16* Z = (const bf16*)(P.ws + WS_Z);
    const int gw = F.vcu * NWAVES + F.wave, NGW = F.G * NWAVES, c0 = 16 * F.lane;
    float w0[16], w1[16], w2[16];
#pragma unroll
    for (int i = 0; i < 16; ++i) { w0[i] = P.conv_w[c0 + i]; w1[i] = P.conv_w[D + c0 + i]; w2[i] = P.conv_w[2 * D + c0 + i]; }
    for (int ch = gw; ch < T / 16; ch += NGW) {
        const int r0 = ch * 16; float z2[16], z1[16];
        if ((r0 & (SEQ - 1)) == 0) {
#pragma unroll
            for (int i = 0; i < 16; ++i) { z2[i] = 0.f; z1[i] = 0.f; }
        } else {
            const v4u a0 = *(const GAS v4u*)(Z + (size_t)(r0 - 2) * D + c0), a1 = *(const GAS v4u*)(Z + (size_t)(r0 - 2) * D + c0 + 8), b0 = *(const GAS v4u*)(Z + (size_t)(r0 - 1) * D + c0), b1 = *(const GAS v4u*)(Z + (size_t)(r0 - 1) * D + c0 + 8);
#pragma unroll
            for (int i = 0; i < 4; ++i) { z2[2 * i] = bflo(a0[i]); z2[2 * i + 1] = bfhi(a0[i]); z2[8 + 2 * i] = bflo(a1[i]); z2[8 + 2 * i + 1] = bfhi(a1[i]);
                                          z1[2 * i] = bflo(b0[i]); z1[2 * i + 1] = bfhi(b0[i]); z1[8 + 2 * i] = bflo(b1[i]); z1[8 + 2 * i + 1] = bfhi(b1[i]); }
        }
#pragma unroll 2
        for (int rr = 0; rr < 16; ++rr) { const size_t off = (size_t)(r0 + rr) * D + c0;
            const v4u za = *(const GAS v4u*)(Z + off), zb = *(const GAS v4u*)(Z + off + 8), ca = *(const GAS v4u*)(CB + off), cb = *(const GAS v4u*)(CB + off + 8);
            float zc[16], cv[16];
#pragma unroll
            for (int i = 0; i < 4; ++i) { zc[2 * i] = bflo(za[i]); zc[2 * i + 1] = bfhi(za[i]); zc[8 + 2 * i] = bflo(zb[i]); zc[8 + 2 * i + 1] = bfhi(zb[i]);
                                          cv[2 * i] = bflo(ca[i]); cv[2 * i + 1] = bfhi(ca[i]); cv[8 + 2 * i] = bflo(cb[i]); cv[8 + 2 * i + 1] = bfhi(cb[i]); }
            float u[16];
#pragma unroll
            for (int i = 0; i < 16; ++i) { u[i] = cv[i] * (z2[i] * w0[i] + z1[i] * w1[i] + zc[i] * w2[i]); z2[i] = z1[i]; z1[i] = zc[i]; }
            v4u oa, ob;
#pragma unroll
            for (int i = 0; i < 4; ++i) { oa[i] = pk2(u[2 * i], u[2 * i + 1]); ob[i] = pk2(u[8 + 2 * i], u[8 + 2 * i + 1]); }
            *(GAS v4u*)(CB + off) = oa; *(GAS v4u*)(CB + off + 8) = ob; }
    }
}
__device__ __forceinline__ attn::BlockRef attn_ref(const Ptrs& P, int s, int qb) {
    const int vh = s & 1, m = (s >> 1) & 1, h = (s >> 2) & 3, b = s >> 4;
    attn::BlockRef r; const size_t rowb = (size_t)b * SEQ * D;
    r.Q = (const bf16*)(P.ws + WS_Q) + rowb + (size_t)qb * 256 * D + h * 256 + m * 128;
    r.K = (const bf16*)(P.ws + WS_K) + rowb + h * 256 + m * 128;
    r.V = (const bf16*)(P.ws + WS_V) + rowb + h * 256 + vh * 128;
    r.O = (bf16*)(P.ws + (m ? WS_O1 : WS_XN)) + rowb + (size_t)qb * 256 * D + h * 256 + vh * 128;
    r.P0 = qb * 256; return r;
}
#ifndef P1_ALIGN
#define P1_ALIGN true
#endif
#ifndef P1_SP2
#define P1_SP2 true
#endif
#ifndef ATTN_PAIR
#define ATTN_PAIR 1
#endif
__device__ __forceinline__ attn2::BlockRef attn2_ref(const Ptrs& P, int st, int qb) {
    const int m = st & 1, h = (st >> 1) & 3, b = st >> 3;
    attn2::BlockRef r; const size_t rowb = (size_t)b * SEQ * D;
    r.Q = (const bf16*)(P.ws + WS_Q) + rowb + (size_t)qb * 128 * D + h * 256 + m * 128;
    r.K = (const bf16*)(P.ws + WS_K) + rowb + h * 256 + m * 128;
    r.V = (const bf16*)(P.ws + WS_V) + rowb + h * 256;
    r.O = (bf16*)(P.ws + (m ? WS_O1 : WS_XN)) + rowb + (size_t)qb * 128 * D + h * 256;
    r.P0 = qb * 128; return r;
}
__device__ __forceinline__ void p2_attention2(Frame& F, const Ptrs& P, char* lds) {
    float* btab = (float*)(lds + attn2::BIAS_OFF);
    for (int s2 = F.vcu; s2 < BATCH * 16; s2 += F.G) {
        const int st = s2 >> 1, half = s2 & 1, h = (st >> 1) & 3;
        __syncthreads();
        if (F.tid < attn2::NBIAS) { const int rel = 63 - F.tid; btab[F.tid] = (P.rel_bias[attn2::t5_bucket(rel) * 4 + h] - P.rel_bias[15 * 4 + h]) * (1.0f / attn2::SCALE); }
        __syncthreads();
#define QB_OF(i) (2 * (7 - (i)) + (((7 - (i)) & 1) ^ half))
        int tid_ = threadIdx.x; asm volatile("" : "+v"(tid_));
        attn2::Seam S; attn2::BlockRef cur = attn2_ref(P, st, QB_OF(0));
        attn2::attn_prime(cur, lds, S, tid_);
#pragma unroll 1
        for (int i = 0; i < 8; ++i) {
            const attn2::BlockRef nxt = (i < 7) ? attn2_ref(P, st, QB_OF(i + 1)) : cur;
            attn2::attn_block(cur, nxt, lds, S, tid_);
            cur = nxt;
        }
#undef QB_OF
    }
}
__device__ __forceinline__ void p2_attention(Frame& F, const Ptrs& P, char* lds) {
    float* btab = (float*)(lds + attn::BIAS_OFF);
    for (int s = F.vcu; s < BATCH * 16; s += F.G) {
        const int h = (s >> 2) & 3;
        __syncthreads();
        if (F.tid < attn::NBIAS) { const int rel = 63 - F.tid; btab[F.tid] = (P.rel_bias[attn::t5_bucket(rel) * 4 + h] - P.rel_bias[15 * 4 + h]) * (1.0f / attn::SCALE); }
        __syncthreads();
        attn::Seam S; attn::BlockRef cur = attn_ref(P, s, 0);
        attn::attn_prime(cur, lds, S);
#pragma unroll 1
        for (int qb = 0; qb < 8; ++qb) {
            const attn::BlockRef nxt = (qb < 7) ? attn_ref(P, s, qb + 1) : cur;
            attn::attn_block(cur, nxt, lds, S);
            cur = nxt;
        }
    }
}
__device__ __forceinline__ void p2b_combine(Frame& F, const Ptrs& P) {
    bf16* O0 = (bf16*)(P.ws + WS_XN); const bf16* O1 = (const bf16*)(P.ws + WS_O1);
    const int gw = F.vcu * NWAVES + F.wave, NGW = F.G * NWAVES, c0 = 16 * F.lane;
    const float l0 = wave_sum(P.lq[F.lane] * P.lk[F.lane] + P.lq[64 + F.lane] * P.lk[64 + F.lane]), l1 = wave_sum(P.lq[128 + F.lane] * P.lk[128 + F.lane] + P.lq[192 + F.lane] * P.lk[192 + F.lane]);
    const float lam = expf(l0) - expf(l1) + LAM_INIT;
    float g[16];
#pragma unroll
    for (int i = 0; i < 16; ++i) g[i] = P.subln_g[(c0 & 255) + i] * (1.f - LAM_INIT);
    for (int m = gw; m < T; m += NGW) { const size_t off = (size_t)m * D + c0;
        const v4u a0 = *(const GAS v4u*)(O0 + off), a1 = *(const GAS v4u*)(O0 + off + 8), b0 = *(const GAS v4u*)(O1 + off), b1 = *(const GAS v4u*)(O1 + off + 8);
        float d[16]; float ss = 0.f;
#pragma unroll
        for (int i = 0; i < 4; ++i) { d[2 * i] = bflo(a0[i]) - lam * bflo(b0[i]); d[2 * i + 1] = bfhi(a0[i]) - lam * bfhi(b0[i]); d[8 + 2 * i] = bflo(a1[i]) - lam * bflo(b1[i]); d[8 + 2 * i + 1] = bfhi(a1[i]) - lam * bfhi(b1[i]); }
#pragma unroll
        for (int i = 0; i < 16; ++i) ss += d[i] * d[i];
        ss += __shfl_xor(ss, 1); ss += __shfl_xor(ss, 2); ss += __shfl_xor(ss, 4); ss += __shfl_xor(ss, 8);
        const float rs = 1.f / sqrtf(ss * (1.f / 256.f) + RMS_EPS);
        v4u oa, ob;
#pragma unroll
        for (int i = 0; i < 4; ++i) { oa[i] = pk2(d[2 * i] * rs * g[2 * i], d[2 * i + 1] * rs * g[2 * i + 1]); ob[i] = pk2(d[8 + 2 * i] * rs * g[8 + 2 * i], d[8 + 2 * i + 1] * rs * g[8 + 2 * i + 1]); }
        *(GAS v4u*)(O0 + off) = oa; *(GAS v4u*)(O0 + off + 8) = ob; }
}
__device__ __forceinline__ void pe_experts(Frame& F, const Ptrs& P) {
    LAS float* scr = (LAS float*)(F.lds + RING_OFF + F.wave * 16384);
    const int gw = F.vcu * NWAVES + F.wave, NGW = F.G * NWAVES;
    bf16* Wgu = (bf16*)(P.ws + WS_WGU); bf16* Wd = (bf16*)(P.ws + WS_WD);
    constexpr int I_GU = (D / 64) * (DE / 32), I_DN = (DE / 64) * (D / 32);
    for (int it = gw; it < NE * (2 * I_GU + I_DN); it += NGW) {
        const int e = it / (2 * I_GU + I_DN); int r = it - e * (2 * I_GU + I_DN);
        if (r < 2 * I_GU) { const int up = r >= I_GU; r -= up * I_GU; const int kb = r / (DE / 32), nb = r % (DE / 32), n0 = 32 * nb;
            if (MOE_FP8) transpose_item8((up ? P.w_up_e : P.w_gate_e) + (size_t)e * D * DE, D, DE, 64 * kb, n0, (unsigned char*)(P.ws + WS_WGU8) + (size_t)e * 1024 * D, 256 * (n0 >> 7) + 128 * up + (n0 & 127), scr, F.lane);
            else transpose_item((up ? P.w_up_e : P.w_gate_e) + (size_t)e * D * DE, D, DE, 64 * kb, n0, Wgu + (size_t)e * 1024 * D, 256 * (n0 >> 7) + 128 * up + (n0 & 127), scr, F.lane); }
        else { r -= 2 * I_GU; const int kb = r / (D / 32), nb = r % (D / 32);
            if (MOE_FP8 && MOE_FP8_DOWN) transpose_item8(P.w_down_e + (size_t)e * DE * D, DE, D, 64 * kb, 32 * nb, (unsigned char*)(P.ws + WS_WD8) + (size_t)e * D * DE, 32 * nb, scr, F.lane);
            else transpose_item(P.w_down_e + (size_t)e * DE * D, DE, D, 64 * kb, 32 * nb, Wd + (size_t)e * D * DE, 32 * nb, scr, F.lane); }
    }
}
__device__ __forceinline__ void p5_ln_route(Frame& F, const Ptrs& P) {
    LAS float* RW = (LAS float*)(F.lds + RING_OFF);
    LAS int* lcnt = (LAS int*)(F.lds + TAB_OFF);
    LAS float* rs = (LAS float*)(F.lds + RSCR_OFF) + F.wave * 128;
    for (int idx = F.tid; idx < D * 36; idx += NWAVES * 64) { const int d = idx / 36, o = idx - d * 36; float w;
        if (o < 4) w = P.w_group[d * 4 + o]; else { const int g = (o - 4) >> 3, e = (o - 4) & 7; w = P.w_sub[((size_t)g * D + d) * 8 + e]; }
        const int j = d >> 8, l = (d & 255) >> 2, i = d & 3, c = o >> 2, k = o & 3;
        RW[((((j * 4 + i) * 9 + c) * 64 + l) << 2) + k] = w; }
    if (F.tid < 32) lcnt[F.tid] = 0;
    __syncthreads();
    float* pre = (float*)(P.ws + WS_PRE); bf16* x1b = (bf16*)(P.ws + WS_XN);
    int* eid = (int*)(P.ws + WS_EID); float* ew = (float*)(P.ws + WS_EW); int* rank = (int*)(P.ws + WS_RANK);
    const int rows_per_wg = T / F.G, rbase = blockIdx.x * rows_per_wg;
    static_assert(pg8::PRE_BF16, "the pipelined LN1/routing loop reads bf16 pre");
    v2u raw[2][4];
#define P5_LOADPAIR(rp_) do { _Pragma("unroll") for (int r = 0; r < 2; ++r) { const GAS v2u* pr = (const GAS v2u*)((const bf16*)pre + (size_t)(rbase + (rp_) + r) * D) + F.lane; \
        _Pragma("unroll") for (int j = 0; j < 4; ++j) raw[r][j] = pr[64 * j]; } } while (0)
    if (F.wave * 2 < rows_per_wg) P5_LOADPAIR(F.wave * 2);
    for (int rp = F.wave * 2; rp < rows_per_wg; rp += NWAVES * 2) {
        f32x4 xv[2][4];
#pragma unroll
        for (int r = 0; r < 2; ++r) { const int row = rbase + rp + r;
            f32x4 v[4]; float s = 0.f;
#pragma unroll
            for (int j = 0; j < 4; ++j) { const v2u w = raw[r][j]; v[j] = (f32x4){bflo(w.x), bfhi(w.x), bflo(w.y), bfhi(w.y)}; s += (v[j].x + v[j].y) + (v[j].z + v[j].w); }
            const float mean = wave_sum_fast(s) * (1.f / D); float s2 = 0.f;
#pragma unroll
            for (int j = 0; j < 4; ++j) { v[j] = v[j] - mean; s2 += (v[j].x * v[j].x + v[j].y * v[j].y) + (v[j].z * v[j].z + v[j].w * v[j].w); }
            const float rstd = 1.f / sqrtf(wave_sum_fast(s2) * (1.f / D) + LN_EPS);
            GAS unsigned long long* o8 = (GAS unsigned long long*)(x1b + (size_t)row * D) + F.lane;
#pragma unroll
            for (int j = 0; j < 4; ++j) { const f32x4 g = *((const GAS f32x4*)P.ln1_g + F.lane + 64 * j), b = *((const GAS f32x4*)P.ln1_b + F.lane + 64 * j); const f32x4 y = v[j] * rstd * g + b;
                xv[r][j] = y; o8[64 * j] = (unsigned long long)pk2(y.x, y.y) | ((unsigned long long)pk2(y.z, y.w) << 32);
                if (MOE_FP8) *((GAS unsigned*)(P.ws + WS_X18 + (size_t)row * D) + F.lane + 64 * j) = pg8::pk4_fp8(y.x, y.y, y.z, y.w); } }
        if (rp + NWAVES * 2 < rows_per_wg) P5_LOADPAIR(rp + NWAVES * 2);
        f32x4 acc[2][9];
#pragma unroll
        for (int r = 0; r < 2; ++r)
#pragma unroll
            for (int c = 0; c < 9; ++c) acc[r][c] = (f32x4){0.f, 0.f, 0.f, 0.f};
        asm volatile("" ::: "memory"); __builtin_amdgcn_sched_barrier(0);
#pragma unroll
        for (int j = 0; j < 4; ++j)
#pragma unroll
            for (int i = 0; i < 4; ++i)
                { const LAS f32x4* wp = (const LAS f32x4*)(RW + (((j * 4 + i) * 9 * 64 + F.lane) << 2));
#pragma unroll
                  for (int c = 0; c < 9; ++c) { const f32x4 w = wp[c * 64]; acc[0][c] += w * xv[0][j][i]; acc[1][c] += w * xv[1][j][i]; }
                  asm volatile("" : "+v"(acc[0][0]), "+v"(acc[0][1]), "+v"(acc[0][2]), "+v"(acc[0][3]), "+v"(acc[0][4]), "+v"(acc[0][5]), "+v"(acc[0][6]), "+v"(acc[0][7]), "+v"(acc[0][8]) :: "memory");
                  asm volatile("" : "+v"(acc[1][0]), "+v"(acc[1][1]), "+v"(acc[1][2]), "+v"(acc[1][3]), "+v"(acc[1][4]), "+v"(acc[1][5]), "+v"(acc[1][6]), "+v"(acc[1][7]), "+v"(acc[1][8]) :: "memory");
                  __builtin_amdgcn_sched_barrier(0); }
        { float Y[36];
#pragma unroll
          for (int k = 0; k < 36; ++k) { const int i0 = 2 * k, i1 = 2 * k + 1;
              const auto rr = __builtin_amdgcn_permlane32_swap(__float_as_uint(acc[i0 / 36][(i0 % 36) >> 2][i0 & 3]), __float_as_uint(acc[i1 / 36][(i1 % 36) >> 2][i1 & 3]), false, false);
              Y[k] = __uint_as_float(rr[0]) + __uint_as_float(rr[1]); }
          float Z[18];
#pragma unroll
          for (int m = 0; m < 18; ++m) { const auto rr = __builtin_amdgcn_permlane16_swap(__float_as_uint(Y[2 * m]), __float_as_uint(Y[2 * m + 1]), false, false);
              Z[m] = __uint_as_float(rr[0]) + __uint_as_float(rr[1]); }
#pragma unroll
          for (int m = 0; m < 18; ++m) {
              Z[m] += __int_as_float(__builtin_amdgcn_update_dpp(0, __float_as_int(Z[m]), 0x128, 0xf, 0xf, false));
              Z[m] += __int_as_float(__builtin_amdgcn_update_dpp(0, __float_as_int(Z[m]), 0x124, 0xf, 0xf, false));
              Z[m] += __int_as_float(__builtin_amdgcn_update_dpp(0, __float_as_int(Z[m]), 0x122, 0xf, 0xf, false));
              Z[m] += __int_as_float(__builtin_amdgcn_update_dpp(0, __float_as_int(Z[m]), 0x121, 0xf, 0xf, false)); }
          const int rho = F.lane >> 4, pr = ((rho & 1) << 1) | (rho >> 1);
          if ((F.lane & 15) == 0) {
#pragma unroll
              for (int m = 0; m < 18; ++m) { const int idx = 4 * m + pr; rs[idx >= 36 ? idx + 28 : idx] = Z[m]; } } }
        LDS_WAIT(); asm volatile("" ::: "memory");
        if (F.lane < 2) { const int r = F.lane, row = rbase + rp + r; const LAS float* sa = rs + r * 64;
            float gmax = sa[0] + P.b_group[0]; int gi = 0;
            for (int g = 1; g < 4; ++g) { const float v = sa[g] + P.b_group[g]; if (v > gmax) { gmax = v; gi = g; } }
            float z = 0.f;
            for (int g = 0; g < 4; ++g) z += expf(sa[g] + P.b_group[g] - gmax);
            const float gp = 1.f / z;
            const LAS float* sl = sa + 4 + gi * 8; const float* bs = P.b_sub + gi * 8;
            float b0 = sl[0] + bs[0]; int i0 = 0;
            for (int e = 1; e < 8; ++e) { const float v = sl[e] + bs[e]; if (v > b0) { b0 = v; i0 = e; } }
            float b1 = -__builtin_inff(); int i1 = 0;
            for (int e = 0; e < 8; ++e) { const float v = sl[e] + bs[e]; if (e != i0 && v > b1) { b1 = v; i1 = e; } }
            const float e1 = expf(b1 - b0); const float w0 = gp / (1.f + e1), w1 = gp * e1 / (1.f + e1);
            const int ex0 = gi * 8 + i0, ex1 = gi * 8 + i1;
            eid[row * 2] = ex0; eid[row * 2 + 1] = ex1; ew[row * 2] = w0; ew[row * 2 + 1] = w1;
            rank[row * 2] = __hip_atomic_fetch_add(lcnt + ex0, 1, __ATOMIC_RELAXED, __HIP_MEMORY_SCOPE_WORKGROUP);
            rank[row * 2 + 1] = __hip_atomic_fetch_add(lcnt + ex1, 1, __ATOMIC_RELAXED, __HIP_MEMORY_SCOPE_WORKGROUP); }
        LDS_WAIT(); asm volatile("" ::: "memory");
    }
    __syncthreads();
    if (F.tid < 32) ((int*)(P.ws + WS_CNTWG))[blockIdx.x * 32 + F.tid] = lcnt[F.tid];
}
__device__ __forceinline__ void moe_tab(Frame& F, const Ptrs& P) {
    LAS int* tab = (LAS int*)(F.lds + TAB_OFF);
    const int* cntwg = (const int*)(P.ws + WS_CNTWG);
    __syncthreads();
    if (F.tid < 32) { int tot = 0, base = 0;
        for (int w = 0; w < F.G; ++w) { const int c = __hip_atomic_load(cntwg + w * 32 + F.tid, __ATOMIC_RELAXED, __HIP_MEMORY_SCOPE_AGENT); base += (w < (int)blockIdx.x) ? c : 0; tot += c; }
        tab[96 + F.tid] = tot; tab[64 + F.tid] = base; }
    __syncthreads();
    if (F.tid == 0) { int s = 0; for (int e = 0; e < 32; ++e) { tab[e] = s; s += (tab[96 + e] + 255) & ~255; } tab[32] = s; }
    __syncthreads();
}
__device__ __forceinline__ void p5b_place(Frame& F, const Ptrs& P) {
    LAS int* tab = (LAS int*)(F.lds + TAB_OFF);
    moe_tab(F, P);
    const int rows_per_wg = T / F.G, rbase = blockIdx.x * rows_per_wg;
    const int* eid = (const int*)(P.ws + WS_EID); const int* rank = (const int*)(P.ws + WS_RANK); int* slot = (int*)(P.ws + WS_SLOT);
    int* tokl = (int*)(P.ws + WS_TOK);
    for (int a = F.tid; a < rows_per_wg * 2; a += NWAVES * 64) { const int ga = rbase * 2 + a, e = eid[ga]; const int s = tab[e] + tab[64 + e] + rank[ga]; slot[ga] = s; tokl[s] = ga >> 1; }
    if (blockIdx.x < 32) { const int e = blockIdx.x; for (int s = tab[e] + tab[96 + e] + F.tid; s < tab[e + 1]; s += NWAVES * 64) tokl[s] = 0; }
    { int* idl = (int*)(P.ws + WS_IDL); for (int s = blockIdx.x * (NWAVES * 64) + F.tid; s < MAXS; s += F.G * NWAVES * 64) idl[s] = s; }
}
struct P8Row { v4u x[2], y0[2], y1[2]; float w0, w1; };
__device__ __forceinline__ void p8_load(P8Row& R, const bf16* x1, const bf16* y, const int* slot, const float* ew, int row, int lane) {
    const int s0 = slot[row * 2], s1 = slot[row * 2 + 1]; R.w0 = ew[row * 2]; R.w1 = ew[row * 2 + 1];
    const GAS v4u* xr = (const GAS v4u*)(x1 + (size_t)row * D) + lane; const GAS v4u* a = (const GAS v4u*)(y + (size_t)s0 * D) + lane; const GAS v4u* b = (const GAS v4u*)(y + (size_t)s1 * D) + lane;
    R.x[0] = xr[0]; R.x[1] = xr[64]; R.y0[0] = a[0]; R.y0[1] = a[64]; R.y1[0] = b[0]; R.y1[1] = b[64];
}
__device__ __forceinline__ void p8_finish(const P8Row& R, const Ptrs& P, int row, int lane, bool poison) {
    float v[16]; float s = 0.f;
#pragma unroll
    for (int h = 0; h < 2; ++h)
#pragma unroll
        for (int i = 0; i < 4; ++i) { v[8 * h + 2 * i] = ALPHA * bflo(R.x[h][i]) + R.w0 * bflo(R.y0[h][i]) + R.w1 * bflo(R.y1[h][i]); v[8 * h + 2 * i + 1] = ALPHA * bfhi(R.x[h][i]) + R.w0 * bfhi(R.y0[h][i]) + R.w1 * bfhi(R.y1[h][i]); }
#pragma unroll
    for (int i = 0; i < 16; ++i) s += v[i];
    const float mean = wave_sum_fast(s) * (1.f / D); float s2 = 0.f;
#pragma unroll
    for (int i = 0; i < 16; ++i) { v[i] -= mean; s2 += v[i] * v[i]; }
    const float rstd = 1.f / sqrtf(wave_sum_fast(s2) * (1.f / D) + LN_EPS);
    const float qn = __builtin_nanf("");
#pragma unroll
    for (int h = 0; h < 2; ++h)
#pragma unroll
        for (int q = 0; q < 2; ++q) { const int c = 512 * h + 8 * lane + 4 * q; const f32x4 g = *(const GAS f32x4*)(P.ln2_g + c), b = *(const GAS f32x4*)(P.ln2_b + c);
            f32x4 o = {v[8 * h + 4 * q] * rstd * g.x + b.x, v[8 * h + 4 * q + 1] * rstd * g.y + b.y, v[8 * h + 4 * q + 2] * rstd * g.z + b.z, v[8 * h + 4 * q + 3] * rstd * g.w + b.w};
            if (poison) o = (f32x4){qn, qn, qn, qn};
            *(GAS f32x4*)(P.out + (size_t)row * D + c) = o; }
}
__device__ __forceinline__ void p8_final(Frame& F, const Ptrs& P, bool poison) {
    const bf16* x1 = (const bf16*)(P.ws + WS_XN); const bf16* y = (const bf16*)(P.ws + WS_XG);
    const int* slot = (const int*)(P.ws + WS_SLOT); const float* ew = (const float*)(P.ws + WS_EW);
    const int rows_per_wg = T / F.G, rbase = blockIdx.x * rows_per_wg;
    P8Row A, B;
    int rr = F.wave; if (rr < rows_per_wg) p8_load(A, x1, y, slot, ew, rbase + rr, F.lane);
    for (; rr < rows_per_wg; rr += 2 * NWAVES) {
        const bool hasB = rr + NWAVES < rows_per_wg; if (hasB) p8_load(B, x1, y, slot, ew, rbase + rr + NWAVES, F.lane);
        p8_finish(A, P, rbase + rr, F.lane, poison);
        if (hasB) { if (rr + 2 * NWAVES < rows_per_wg) p8_load(A, x1, y, slot, ew, rbase + rr + 2 * NWAVES, F.lane); p8_finish(B, P, rbase + rr + NWAVES, F.lane, poison); }
    }
}

constexpr int N_PHASES = 11;
struct Args { Ptrs p; int ph_lo, ph_hi, bar_region, flags; };
__global__ void __launch_bounds__(NWAVES * 64, 2) mega_fwd(Args args) {
    extern __shared__ __attribute__((aligned(16))) unsigned char lds[];
    Frame F; const Ptrs& P = args.p;
    F.lds = (LAS unsigned char*)lds; F.MISC = (volatile LAS unsigned*)(F.lds + MISC_OFF);
    F.tid = threadIdx.x; F.lane = F.tid & 63; F.wave = __builtin_amdgcn_readfirstlane(F.tid >> 6);
    F.G = gridDim.x; { const int bx = blockIdx.x; F.vcu = (F.G % 8 == 0) ? (bx % 8) * (F.G / 8) + bx / 8 : bx; }
    F.ctl = (gu32*)(P.ws + WS_CTL);
    for (int u = F.tid; u < (LDS_BYTES - LDSCTL_OFF) / 4; u += NWAVES * 64) ((LAS unsigned*)(F.lds + LDSCTL_OFF))[u] = 0u;
    __syncthreads();
    XcdBarrier bar = xcd_barrier_post((unsigned*)(F.ctl + CW_BAR) + args.bar_region * XCD_BAR_WORDS, F.MISC + 8);
    const int lo = args.ph_lo, hi = args.ph_hi;
#ifndef PH_MASK
#define PH_MASK 0x7ff
#endif
#define IN(k) (((PH_MASK >> (k)) & 1) && lo <= (k) && (k) < hi)
#define BOTH(k) (IN(k) && IN((k) + 1))
#define GRID_BAR() xcd_barrier(bar)
    const bool grid_ok = (F.G == 256);

    if (IN(0)) { p0_prologue(F, P); if (BOTH(0)) GRID_BAR(); }
    if (IN(1)) {
        pg8::Gemm g{(const pg8::bf16_t*)(P.ws + WS_XN), (const pg8::bf16_t*)(P.ws + WS_WIN), T, NIN, D}; pg8::StaticOrder S; S.init(T, NIN, F.G, (int)blockIdx.x);
        pg8::EpiInProj E{(pg8::bf16_t*)(P.ws + WS_Q), (size_t)(WS_K - WS_Q) / 2, BUF_CB(P), (pg8::bf16_t*)(P.ws + WS_Z), BUF_SGA(P), BUF_SGB(P)};
        pg8::gemm_phase<pg8::EpiInProj, pg8::StaticOrder, P1_ALIGN, P1_SP2>(F.lds + RING_OFF, g, S, E);
        if (BOTH(1)) GRID_BAR();
    }
    if (IN(2)) { if (!(args.flags & 2)) p2_conv(F, P); if (ATTN_PAIR) p2_attention2(F, P, (char*)lds + RING_OFF); else p2_attention(F, P, (char*)lds + RING_OFF); if (BOTH(2)) GRID_BAR(); }
    if (IN(3)) { if (!(args.flags & 1)) p2b_combine(F, P); pe_experts(F, P); if (BOTH(3)) GRID_BAR(); }
    if (IN(4)) {
        { pg8::Gemm g{(const pg8::bf16_t*)(P.ws + WS_XN), (const pg8::bf16_t*)(P.ws + WS_WA), T, D, D}; pg8::StaticOrder S; S.init(T, D, F.G, (int)blockIdx.x);
          pg8::EpiGate<false> E{BUF_SGA(P), nullptr, (pg8::bf16_t*)(P.ws + WS_O1), P.b_gate};
          pg8::gemm_phase<pg8::EpiGate<false>, pg8::StaticOrder, true, true>(F.lds + RING_OFF, g, S, E); }
        __syncthreads();
        { pg8::Gemm g{BUF_CB(P), (const pg8::bf16_t*)(P.ws + WS_WB), T, D, D}; pg8::StaticOrder S; S.init(T, D, F.G, (int)blockIdx.x);
          pg8::EpiGate<true> E{BUF_SGB(P), (const pg8::bf16_t*)(P.ws + WS_O1), (pg8::bf16_t*)(P.ws + WS_Z), P.b_gate + 1024};
          pg8::gemm_phase<pg8::EpiGate<true>, pg8::StaticOrder, true, true>(F.lds + RING_OFF, g, S, E); }
        if (BOTH(4)) GRID_BAR();
    }
    if (IN(5)) {
        pg8::Gemm g{(const pg8::bf16_t*)(P.ws + WS_Z), (const pg8::bf16_t*)(P.ws + WS_WO), T, D, D}; pg8::StaticOrder S; S.init(T, D, F.G, (int)blockIdx.x);
        pg8::EpiPre E{P.x, (const float*)(P.ws + WS_STATS), P.ln_in_g, P.ln_in_b, (float*)(P.ws + WS_PRE), ALPHA};
        pg8::gemm_phase<pg8::EpiPre, pg8::StaticOrder, true, true>(F.lds + RING_OFF, g, S, E);
        if (BOTH(5)) GRID_BAR();
    }
    if (IN(6)) { if (grid_ok) p5_ln_route(F, P); if (BOTH(6)) GRID_BAR(); }
    if (IN(7)) { if (grid_ok) p5b_place(F, P); if (BOTH(7)) GRID_BAR(); }
    if (IN(8)) {
        if (grid_ok && MOE_FP8) { if (lo == 8) moe_tab(F, P); pg8::Gemm g{(const pg8::bf16_t*)(P.ws + WS_X18), (const pg8::bf16_t*)(P.ws + WS_WGU8), MAXS, NE * 1024, D / 2};
          pg8::MoeOrder S{(const PG8_LAS int*)(F.lds + TAB_OFF), F.G, F.vcu, (unsigned*)(F.ctl + CW_MOE), 0u, false, (unsigned*)(F.ctl + CW_TMO), 0, -1};
          if (MOE_FP8_DOWN) { pg8::EpiMoeUp8 E{(unsigned char*)P.out}; pg8::gemm_phase<pg8::EpiMoeUp8, pg8::MoeOrder, true, true, true, true>(F.lds + RING_OFF, g, S, E, (const int*)(P.ws + WS_TOK)); }
          else { pg8::EpiMoeUp E{(pg8::bf16_t*)P.out, 1.f / pg8::F8_WS}; pg8::gemm_phase<pg8::EpiMoeUp, pg8::MoeOrder, true, true, true, true>(F.lds + RING_OFF, g, S, E, (const int*)(P.ws + WS_TOK)); } }
        else if (grid_ok) { if (lo == 8) moe_tab(F, P); pg8::Gemm g{(const pg8::bf16_t*)(P.ws + WS_XN), (const pg8::bf16_t*)(P.ws + WS_WGU), MAXS, NE * 1024, D};
          pg8::MoeOrder S{(const PG8_LAS int*)(F.lds + TAB_OFF), F.G, F.vcu, (unsigned*)(F.ctl + CW_MOE), 0u, MOE_HANDOFF != 0, (unsigned*)(F.ctl + CW_TMO), 0, -1}; pg8::EpiMoeUp E{(pg8::bf16_t*)P.out, 1.f};
          pg8::gemm_phase<pg8::EpiMoeUp, pg8::MoeOrder, true, true, true>(F.lds + RING_OFF, g, S, E, (const int*)(P.ws + WS_TOK)); S.flush(); }
        if (BOTH(8)) { if (MOE_HANDOFF) __syncthreads(); else GRID_BAR(); }
    }
    if (IN(9)) {
        if (grid_ok && MOE_FP8 && MOE_FP8_DOWN) { if (lo == 9) moe_tab(F, P); pg8::Gemm g{(const pg8::bf16_t*)P.out, (const pg8::bf16_t*)(P.ws + WS_WD8), MAXS, NE * 1024, DE / 2};
          pg8::MoeOrder S{(const PG8_LAS int*)(F.lds + TAB_OFF), F.G, F.vcu, (unsigned*)(F.ctl + CW_MOE), 0u, false, (unsigned*)(F.ctl + CW_TMO), 0, -1}; pg8::EpiMoeDown E{(pg8::bf16_t*)(P.ws + WS_XG), 1.f / (pg8::F8_WS * pg8::F8_HS)};
          if (MOE_DOWN_GATHER) pg8::gemm_phase<pg8::EpiMoeDown, pg8::MoeOrder, true, true, true, true>(F.lds + RING_OFF, g, S, E, (const int*)(P.ws + WS_IDL)); else pg8::gemm_phase<pg8::EpiMoeDown, pg8::MoeOrder, true, true, false, true>(F.lds + RING_OFF, g, S, E); }
        else if (grid_ok) { if (lo == 9) moe_tab(F, P); pg8::Gemm g{(const pg8::bf16_t*)P.out, (const pg8::bf16_t*)(P.ws + WS_WD), MAXS, NE * 1024, DE};
          const bool ho = MOE_HANDOFF && lo <= 8;
          pg8::MoeOrder S{(const PG8_LAS int*)(F.lds + TAB_OFF), F.G, ho ? (F.vcu + F.G / 2) % F.G : F.vcu, (unsigned*)(F.ctl + CW_MOE), ho ? 32u : 0u, false, (unsigned*)(F.ctl + CW_TMO), 0, -1}; pg8::EpiMoeDown E{(pg8::bf16_t*)(P.ws + WS_XG), 1.f};
          pg8::gemm_phase<pg8::EpiMoeDown, pg8::MoeOrder, true, true>(F.lds + RING_OFF, g, S, E); }
        if (BOTH(9)) GRID_BAR();
    }
    if (IN(10)) {
        bool poison = !grid_ok || (__hip_atomic_load(F.ctl + CW_BAR + args.bar_region * XCD_BAR_WORDS + XB_TMO, RLX_AGENT) != 0u) || (__hip_atomic_load(F.ctl + CW_TMO, RLX_AGENT) != 0u);
        if (grid_ok) p8_final(F, P, poison);
        else { const float qn = __builtin_nanf(""); for (size_t i = (size_t)blockIdx.x * 512 + F.tid; i < (size_t)T * D; i += (size_t)F.G * 512) P.out[i] = qn; }
    }
#undef IN
#undef BOTH
#undef GRID_BAR
}

static void launch_mega(const Ptrs& p, int lo, int hi, int region, int flags, hipStream_t stream) {
    Args a{}; a.p = p; a.ph_lo = lo; a.ph_hi = hi; a.bar_region = region; a.flags = flags;
    hipLaunchKernelGGL(mega_fwd, dim3(256), dim3(NWAVES * 64), LDS_BYTES, stream, a);
}
extern "C" void kernel_launch(void* const* d_in, const int* in_sizes, int n_in, void* d_out, int out_size, void* d_ws, size_t ws_size, hipStream_t stream) {
    static int ready = 0;
    if (ready == 0) {
        ready = 1;
        if (n_in != 24 || out_size != T * D || ws_size < WS_END) { fprintf(stderr, "kernel_launch: unexpected shapes (n_in %d out %d ws %zu)\n", n_in, out_size, ws_size); ready = -1; }
        else if (hipFuncSetAttribute((const void*)mega_fwd, hipFuncAttributeMaxDynamicSharedMemorySize, LDS_BYTES) != hipSuccess) { fprintf(stderr, "kernel_launch: hipFuncSetAttribute failed\n"); ready = -1; }
        (void)hipGetLastError();
    }
    if (ready < 0) return;
    Ptrs p{};
    const float** pp = (const float**)&p;
    for (int i = 0; i < 24; ++i) pp[i] = (const float*)d_in[i];
    p.out = (float*)d_out; p.ws = (unsigned char*)d_ws;
    (void)hipMemsetAsync((char*)d_ws + WS_CTL, 0, CTL_ZERO_BYTES, stream);
    launch_mega(p, 0, N_PHASES, 0, 0, stream);
}
```

```cpp
#ifndef INPROJ_F8_LO
#define INPROJ_F8_LO 24
#endif
#ifndef INPROJ_F8_HI
#define INPROJ_F8_HI 40
#endif
#include <hip/hip_runtime.h>
#include <cstdio>
#include <cstdint>
#include <cmath>
#ifndef MOE_HANDOFF
#define MOE_HANDOFF 0
#endif
#ifndef RW_PREFILL
#define RW_PREFILL 1
#endif
#ifndef HO_PLAINSTORE
#define HO_PLAINSTORE 0
#endif
#ifndef X1_RECOMPUTE
#define X1_RECOMPUTE 1
#endif
#ifndef ATTN_SMLATE
#define ATTN_SMLATE 0
#endif
#ifndef ATTN_DMA
#define ATTN_DMA 0
#endif
#ifndef ATTN_PVSM
#define ATTN_PVSM 0
#endif
#ifndef PLACE_ATOMIC
#define PLACE_ATOMIC 1
#endif
#ifndef STAGGER_TICKS
#define STAGGER_TICKS 0
#endif
#ifndef MOE_Y8
#define MOE_Y8 1
#endif
#ifndef F8_SCALE
#define F8_SCALE 0
#endif
#ifndef F8_CHUNK_SPLIT
#define F8_CHUNK_SPLIT 1
#endif
#ifndef INPROJ_BUFST
#define INPROJ_BUFST 1
#endif
#ifndef LANE_ASM
#define LANE_ASM 1
#endif
#if LANE_ASM
__device__ __forceinline__ int lane_fresh() { int l; asm volatile("v_mbcnt_lo_u32_b32 %0, -1, 0\n\tv_mbcnt_hi_u32_b32 %0, -1, %0" : "=v"(l)); return l; }
#else
__device__ __forceinline__ int lane_fresh() { return (int)threadIdx.x & 63; }
#endif
namespace pg8 {
#define PG8_LAS __attribute__((address_space(3)))
typedef unsigned short bf16_t;
typedef short bf16x8 __attribute__((ext_vector_type(8)));
typedef float f32x4 __attribute__((ext_vector_type(4)));
typedef unsigned u32x4 __attribute__((ext_vector_type(4)));
constexpr int BM = 256, BK = 64, HALF = 128, HTB = HALF * BK * 2  , STAGE_BYTES = 8 * HTB, NXCD = 8, WGM = 8;

__host__ __device__ __forceinline__ int lds_byte(int r, int c) { const int st = (r >> 4) * 2 + (c >> 5), rr = r & 15, cc = c & 31, ob = rr * 64 + cc * 2; return st * 1024 + (ob ^ (((ob >> 9) & 1) << 5)); }
__host__ __device__ __forceinline__ void stage_rc(int b, int& R, int& C) { const int st = b / 1024, sb = b % 1024, swz = sb ^ (((sb >> 9) & 1) << 5); R = (st >> 1) * 16 + swz / 64; C = (st & 1) * 32 + (swz % 64) / 2; }
__host__ __device__ __forceinline__ int perm32(int rho) { const int n = rho >> 4, i = rho & 15; return 8 * (i >> 2) + 4 * n + (i & 3); }

struct Unit { int pm, pn; };
struct Gemm { const bf16_t* A; const bf16_t* Bt; int M, N, K; };

struct StaticOrder {
    int nM, nN, nwg, G, c;
    __host__ __device__ void init(int M, int N, int G_, int c_) { nM = M / BM; nN = N / BM; nwg = nM * nN; G = G_; c = c_; }
    __host__ __device__ bool next(int i, Unit& u) const {
        const long L = (long)i * G + c; if (L >= nwg) return false;
        int wgid = (int)L; { const int q = nwg / NXCD, r = nwg % NXCD, xcd = wgid % NXCD, off = wgid / NXCD; wgid = (xcd < r ? xcd * (q + 1) : r * (q + 1) + (xcd - r) * q) + off; }
        const int nig = WGM * nN, gid = wgid / nig, fm = gid * WGM, gsz = (nM - fm) < WGM ? (nM - fm) : WGM;
        u.pm = fm + ((wgid % nig) % gsz); u.pn = (wgid % nig) / gsz; return true;
    }
    __device__ __forceinline__ void a_ready(const Unit&) const {}
    __device__ __forceinline__ void done(const Unit&) const {}
};
struct RangeOrder {
    StaticOrder S; int pn0;
    __device__ __forceinline__ bool next(int i, Unit& u) const { if (!S.next(i, u)) return false; u.pn = (u.pn + pn0) & 31; return true; }
    __device__ __forceinline__ void a_ready(const Unit&) const {}
    __device__ __forceinline__ void done(const Unit&) const {}
};

__device__ __forceinline__ unsigned cvt_pk_bf16(float lo, float hi) { unsigned r; asm volatile("v_cvt_pk_bf16_f32 %0, %1, %2" : "=v"(r) : "v"(lo), "v"(hi)); return r; }
typedef float f32x2 __attribute__((ext_vector_type(2)));
__device__ __forceinline__ u32x4 pack8f(const f32x4 a, const f32x4 b) { u32x4 w; w.x = cvt_pk_bf16(a[0], a[1]); w.y = cvt_pk_bf16(a[2], a[3]); w.z = cvt_pk_bf16(b[0], b[1]); w.w = cvt_pk_bf16(b[2], b[3]); return w; }
__device__ __forceinline__ void unpack8f(const u32x4 w, f32x4& a, f32x4& b) {
    a[0] = __uint_as_float(w.x << 16); a[1] = __uint_as_float(w.x & 0xffff0000u); a[2] = __uint_as_float(w.y << 16); a[3] = __uint_as_float(w.y & 0xffff0000u);
    b[0] = __uint_as_float(w.z << 16); b[1] = __uint_as_float(w.z & 0xffff0000u); b[2] = __uint_as_float(w.w << 16); b[3] = __uint_as_float(w.w & 0xffff0000u); }
__device__ __forceinline__ float sigmoidf_fast(float x) { return __builtin_amdgcn_rcpf(1.0f + __expf(-x)); }

struct EpiInProj {
    static constexpr bool PERM = true, AFTER_DRAIN = false;
    bf16_t* qkv; size_t stride;
    bf16_t* cb;
    bf16_t* z;
    bf16_t* sga; bf16_t* sgb;
    float sc;
#if INPROJ_BUFST
    __device__ __forceinline__ void operator()(const f32x4 (&acc)[2][2][4][2], const Unit& u, int wr, int wc, int, int) const {
        const int pn = u.pn, l = lane_fresh(); const unsigned voff = (unsigned)((wr * 64 + (l & 15)) * 1024 + wc * 32 + 8 * (l >> 4)) * 2u;
        if (pn < 16 || pn >= 24) {
            char* bp = (char*)((pn < 12) ? qkv + (size_t)(pn >> 2) * stride : (pn < 16 ? cb : (pn < 28 ? sga : sgb))) + ((size_t)u.pm * BM * 1024 + (size_t)(pn & 3) * BM) * 2;
#pragma unroll
            for (int ai = 0; ai < 2; ++ai)
#pragma unroll
                for (int m = 0; m < 4; ++m)
#pragma unroll
                    for (int bj = 0; bj < 2; ++bj) *(u32x4*)(bp + (voff + (unsigned)((ai * HALF + m * 16) * 1024 + bj * HALF) * 2u)) = pack8f(acc[ai][bj][m][0] * sc, acc[ai][bj][m][1] * sc);
        } else {
            char* bp = (char*)z + ((size_t)u.pm * BM * 1024 + (size_t)(pn - 16) * HALF) * 2; const float s2 = sc * sc;
#pragma unroll
            for (int ai = 0; ai < 2; ++ai)
#pragma unroll
                for (int m = 0; m < 4; ++m)
                    *(u32x4*)(bp + (voff + (unsigned)((ai * HALF + m * 16) * 1024) * 2u)) = pack8f(acc[ai][0][m][0] * acc[ai][1][m][0] * s2, acc[ai][0][m][1] * acc[ai][1][m][1] * s2);
        }
    }
#else
    __device__ __forceinline__ void operator()(const f32x4 (&acc)[2][2][4][2], const Unit& u, int wr, int wc, int fr, int fq) const {
        const int row0 = u.pm * BM + wr * 64 + fr; const int pn = u.pn;
        if (pn < 16 || pn >= 24) {
            bf16_t* base = (pn < 12) ? qkv + (size_t)(pn >> 2) * stride : (pn < 16 ? cb : (pn < 28 ? sga : sgb)); const int col0 = (pn & 3) * BM + wc * 32 + 8 * fq;
#pragma unroll
            for (int ai = 0; ai < 2; ++ai)
#pragma unroll
                for (int m = 0; m < 4; ++m) { bf16_t* rowp = base + (size_t)(row0 + ai * HALF + m * 16) * 1024 + col0;
#pragma unroll
                    for (int bj = 0; bj < 2; ++bj) *(u32x4*)(rowp + bj * HALF) = pack8f(acc[ai][bj][m][0] * sc, acc[ai][bj][m][1] * sc); }
        } else {
            const int col0 = (pn - 16) * HALF + wc * 32 + 8 * fq; const float s2 = sc * sc;
#pragma unroll
            for (int ai = 0; ai < 2; ++ai)
#pragma unroll
                for (int m = 0; m < 4; ++m) { bf16_t* rowp = z + (size_t)(row0 + ai * HALF + m * 16) * 1024 + col0;
                    *(u32x4*)rowp = pack8f(acc[ai][0][m][0] * acc[ai][1][m][0] * s2, acc[ai][0][m][1] * acc[ai][1][m][1] * s2); }
        }
    }
#endif
};
template <bool SECOND> struct EpiGate {
    static constexpr bool PERM = true, AFTER_DRAIN = false;
    const bf16_t* gate; const bf16_t* prev; bf16_t* out; const float* gbias;
    __device__ __forceinline__ void operator()(const f32x4 (&acc)[2][2][4][2], const Unit& u, int wr, int wc, int fr, int fq) const {
        const int row0 = u.pm * BM + wr * 64 + fr; const int col0 = u.pn * BM + wc * 32 + 8 * fq;
        f32x4 bv[2][2];
#pragma unroll
        for (int bj = 0; bj < 2; ++bj)
#pragma unroll
            for (int n = 0; n < 2; ++n) bv[bj][n] = *(const f32x4*)(gbias + col0 + bj * HALF + 4 * n);
#pragma unroll
        for (int ai = 0; ai < 2; ++ai)
#pragma unroll
            for (int m = 0; m < 4; ++m) { const size_t off = (size_t)(row0 + ai * HALF + m * 16) * 1024 + col0;
#pragma unroll
                for (int bj = 0; bj < 2; ++bj) { f32x4 g0, g1; unpack8f(*(const u32x4*)(gate + off + bj * HALF), g0, g1); g0 += bv[bj][0]; g1 += bv[bj][1];
#pragma unroll
                    for (int i = 0; i < 4; ++i) { g0[i] = sigmoidf_fast(g0[i]); g1[i] = sigmoidf_fast(g1[i]); }
                    f32x4 v0 = acc[ai][bj][m][0] * g0, v1 = acc[ai][bj][m][1] * g1;
                    if (SECOND) { f32x4 p0, p1; unpack8f(*(const u32x4*)(prev + off + bj * HALF), p0, p1); v0 += p0; v1 += p1; }
                    *(u32x4*)(out + off + bj * HALF) = pack8f(v0, v1); } }
    }
};
typedef unsigned u32x2 __attribute__((ext_vector_type(2)));
#ifndef PRE_BF16_KNOB
#define PRE_BF16_KNOB 1
#endif
constexpr bool PRE_BF16 = PRE_BF16_KNOB;
struct EpiPre {
    static constexpr bool PERM = false, AFTER_DRAIN = false;
    const float* x; const float* stats; const float* g; const float* b; float* pre; float alpha;
    __device__ __forceinline__ void operator()(const f32x4 (&acc)[2][2][4][2], const Unit& u, int wr, int wc, int fr, int fq) const {
        const int row0 = u.pm * BM + wr * 64 + fr; const int col0 = u.pn * BM + wc * 32 + 4 * fq;
#pragma unroll
        for (int ai = 0; ai < 2; ++ai)
#pragma unroll
            for (int m = 0; m < 4; ++m) { const int row = row0 + ai * HALF + m * 16; const size_t off = (size_t)row * 1024 + col0;
                const float mu = stats[2 * row], rs = stats[2 * row + 1];
#pragma unroll
                for (int bj = 0; bj < 2; ++bj)
#pragma unroll
                    for (int n = 0; n < 2; ++n) { const int c = bj * HALF + n * 16; const f32x4 xv = *(const f32x4*)(x + off + c), gv = *(const f32x4*)(g + col0 + c), bv = *(const f32x4*)(b + col0 + c);
                        const f32x4 o = ((xv - mu) * rs * gv + bv) * alpha + acc[ai][bj][m][n];
                        if constexpr (PRE_BF16) { u32x2 w; w.x = cvt_pk_bf16(o[0], o[1]); w.y = cvt_pk_bf16(o[2], o[3]); *(u32x2*)((bf16_t*)pre + off + c) = w; } else *(f32x4*)(pre + off + c) = o; } }
    }
};
struct EpiMoeUp {
    static constexpr bool PERM = true, AFTER_DRAIN = false;
    bf16_t* h; float sc;
    __device__ __forceinline__ void operator()(const f32x4 (&acc)[2][2][4][2], const Unit& u, int wr, int wc, int fr, int fq) const {
        const int row0 = u.pm * BM + wr * 64 + fr; const int col0 = (u.pn & 3) * HALF + wc * 32 + 8 * fq;
#pragma unroll
        for (int ai = 0; ai < 2; ++ai)
#pragma unroll
            for (int m = 0; m < 4; ++m) { f32x4 v[2];
#pragma unroll
                for (int n = 0; n < 2; ++n)
#pragma unroll
                    for (int i = 0; i < 4; ++i) { const float gv = acc[ai][0][m][n][i] * sc; v[n][i] = gv * sigmoidf_fast(gv) * (acc[ai][1][m][n][i] * sc); }
                bf16_t* dst = h + (size_t)(row0 + ai * HALF + m * 16) * 512 + col0; const u32x4 w = pack8f(v[0], v[1]);
                if (MOE_HANDOFF) asm volatile("global_store_dwordx4 %0, %1, off sc1\n\ts_nop 1" :: "v"(dst), "v"(w) : "memory"); else *(u32x4*)dst = w; }
    }
};
#ifndef MOE_FP8
#define MOE_FP8 1
#endif
#ifndef MOE_FP8_DOWN
#define MOE_FP8_DOWN 1
#endif
#ifndef MOE_DOWN_GATHER
#define MOE_DOWN_GATHER 0
#endif
constexpr float F8_WS = 64.f, F8_HS = 8.f;
__device__ __forceinline__ unsigned pk4_fp8(float a, float b, float c, float d) { int w = __builtin_amdgcn_cvt_pk_fp8_f32(a, b, 0, false); w = __builtin_amdgcn_cvt_pk_fp8_f32(c, d, w, true); return (unsigned)w; }
struct EpiMoeUp8 {
    static constexpr bool PERM = true, AFTER_DRAIN = false;
    unsigned char* h;
    __device__ __forceinline__ void operator()(const f32x4 (&acc)[2][2][4][2], const Unit& u, int wr, int wc, int, int) const {
        const int l = lane_fresh(), fr = l & 15, fq = l >> 4;
        const int row0 = u.pm * BM + wr * 64 + fr; const int col0 = (u.pn & 3) * HALF + wc * 32 + 8 * fq;
#pragma unroll
        for (int ai = 0; ai < 2; ++ai)
#pragma unroll
            for (int m = 0; m < 4; ++m) { f32x4 v[2];
#pragma unroll
                for (int n = 0; n < 2; ++n)
#pragma unroll
                    for (int i = 0; i < 4; ++i) { const float gv = acc[ai][0][m][n][i] * (1.f / F8_WS); v[n][i] = fminf(fmaxf(gv * sigmoidf_fast(gv) * acc[ai][1][m][n][i] * (F8_HS / F8_WS), -440.f), 440.f); }
                u32x2 w; w.x = pk4_fp8(v[0][0], v[0][1], v[0][2], v[0][3]); w.y = pk4_fp8(v[1][0], v[1][1], v[1][2], v[1][3]);
                if (MOE_HANDOFF && !HO_PLAINSTORE) { const unsigned long long ubv = (unsigned long long)(uintptr_t)(h + (size_t)u.pm * BM * 512 + (u.pn & 3) * HALF);
                    const unsigned long long ub = ((unsigned long long)(unsigned)__builtin_amdgcn_readfirstlane((int)(ubv >> 32)) << 32) | (unsigned)__builtin_amdgcn_readfirstlane((int)ubv); const unsigned vo = (unsigned)((wr * 64 + fr + ai * HALF + m * 16) * 512 + wc * 32 + 8 * fq);
                    asm volatile("global_store_dwordx2 %0, %1, %2 sc1\n\ts_nop 1" :: "v"(vo), "v"(w), "s"(ub) : "memory"); }
                else *(u32x2*)(h + (size_t)(row0 + ai * HALF + m * 16) * 512 + col0) = w; }
    }
};
struct EpiMoeDown {
    static constexpr bool PERM = true, AFTER_DRAIN = false;
    bf16_t* y; float scale;
    __device__ __forceinline__ void operator()(const f32x4 (&acc)[2][2][4][2], const Unit& u, int wr, int wc, int fr, int fq) const {
        const int row0 = u.pm * BM + wr * 64 + fr; const int col0 = (u.pn & 3) * BM + wc * 32 + 8 * fq;
#pragma unroll
        for (int ai = 0; ai < 2; ++ai)
#pragma unroll
            for (int m = 0; m < 4; ++m) { bf16_t* rowp = y + (size_t)(row0 + ai * HALF + m * 16) * 1024 + col0;
#pragma unroll
                for (int bj = 0; bj < 2; ++bj) *(u32x4*)(rowp + bj * HALF) = pack8f(acc[ai][bj][m][0] * scale, acc[ai][bj][m][1] * scale); }
    }
};
constexpr float Y8_S = 64.f;
struct EpiMoeDown8 {
    static constexpr bool PERM = true, AFTER_DRAIN = false;
    unsigned char* y; float scale;
    __device__ __forceinline__ void operator()(const f32x4 (&acc)[2][2][4][2], const Unit& u, int wr, int wc, int fr, int fq) const {
        const int row0 = u.pm * BM + wr * 64 + fr; const int col0 = (u.pn & 3) * BM + wc * 32 + 8 * fq;
#pragma unroll
        for (int ai = 0; ai < 2; ++ai)
#pragma unroll
            for (int m = 0; m < 4; ++m) { unsigned char* rowp = y + (size_t)(row0 + ai * HALF + m * 16) * 1024 + col0;
#pragma unroll
                for (int bj = 0; bj < 2; ++bj) { f32x4 a = acc[ai][bj][m][0] * scale, b = acc[ai][bj][m][1] * scale;
#pragma unroll
                    for (int i = 0; i < 4; ++i) { a[i] = fminf(fmaxf(a[i], -440.f), 440.f); b[i] = fminf(fmaxf(b[i], -440.f), 440.f); }
                    u32x2 w; w.x = pk4_fp8(a[0], a[1], a[2], a[3]); w.y = pk4_fp8(b[0], b[1], b[2], b[3]);
                    *(u32x2*)(rowp + bj * HALF) = w; } }
    }
};
struct MoeOrder {
    const PG8_LAS int* tab; int G, c;
    unsigned* cnt;
    unsigned need;
    bool publish; unsigned* tmo;
    __device__ __forceinline__ bool next(int i, Unit& u) const {
        const PG8_LAS int* tb = tab; asm volatile("" : "+v"(tb));
        const int nunits = (tb[32] >> 8) * 4; const int L = i * G + c; if (L >= nunits) return false;
        const int tile = L >> 2, s = tile << 8; int e = 0;
#pragma unroll 1
        for (int k = 1; k < 32; ++k) e = (tb[k] <= s) ? k : e;
        u.pm = __builtin_amdgcn_readfirstlane(tile); u.pn = __builtin_amdgcn_readfirstlane(e * 4 + (L & 3)); return true;
    }
    __device__ __forceinline__ int row_off(const Unit& u) const { if (PLACE_ATOMIC) { const int e = u.pn >> 2; return e * 65536 + (u.pm << 8) - tab[e]; } return u.pm * BM; }
    __device__ __forceinline__ int row_mask() const { return PLACE_ATOMIC ? 32767 : -1; }
    mutable int calls;
    __device__ __forceinline__ void a_ready(const Unit& u) const {
        const int k = calls++;
        if (need == 0u || (k >= 1 && k < 4)) return;
        if (wave == 0) {
            const int lane = lane_fresh(), nunits = (tab[32] >> 8) * 4;
            int tile = u.pm; bool mine = (lane == 0);
            if (k == 0) { const int L = lane * G + c; mine = (lane < 4) && (L < nunits); tile = mine ? (L >> 2) : u.pm; }
            const unsigned long long t0 = __builtin_amdgcn_s_memrealtime(); unsigned polls = 0;
            for (;;) {
                const bool ok = !mine || __hip_atomic_load(cnt + 64 * tile, __ATOMIC_RELAXED, __HIP_MEMORY_SCOPE_AGENT) >= need;
                if (__all(ok)) break;
                if ((++polls & 255u) == 0u && __builtin_amdgcn_readfirstlane(__hip_atomic_load(tmo, __ATOMIC_RELAXED, __HIP_MEMORY_SCOPE_AGENT)) != 0u) break;
                if (__builtin_amdgcn_s_memrealtime() - t0 > 2000000ull) { if (lane == 0) __hip_atomic_store(tmo, 1u, __ATOMIC_RELAXED, __HIP_MEMORY_SCOPE_AGENT); break; }
                __builtin_amdgcn_s_sleep(2); }
            __builtin_amdgcn_fence(__ATOMIC_ACQUIRE, "agent");
            asm volatile("s_waitcnt vmcnt(0)" ::: "memory");
        }
        asm volatile("" ::: "memory"); __builtin_amdgcn_s_barrier(); asm volatile("" ::: "memory");
    }
    mutable int pend;
    int wave = 0;
    __device__ __forceinline__ void done(const Unit& u) const {
        if (!publish) return;
        if (pend >= 0 && lane_fresh() == 0) __hip_atomic_fetch_add(cnt + 64 * pend, 1u, __ATOMIC_RELAXED, __HIP_MEMORY_SCOPE_AGENT);
        pend = u.pm;
    }
    __device__ __forceinline__ void flush() const {
        if (!publish) return;
        asm volatile("s_waitcnt vmcnt(0)" ::: "memory");
        if (pend >= 0 && lane_fresh() == 0) __hip_atomic_fetch_add(cnt + 64 * pend, 1u, __ATOMIC_RELAXED, __HIP_MEMORY_SCOPE_AGENT);
        pend = -1;
    }
};
#ifndef F8_PIN
#define F8_PIN 0
#endif
typedef int v8i __attribute__((ext_vector_type(8)));
typedef int v4i __attribute__((ext_vector_type(4)));
template <class Epi, class Sched, bool ALIGN_EPI = false, bool SP2 = false, bool GATHER = false, bool FP8 = false>
__device__ __forceinline__ void gemm_phase(PG8_LAS unsigned char* lds, const int wid, const Gemm g, const Sched& S, const Epi& E, const int* tok = nullptr) {
    static_assert(!GATHER || SP2, "GATHER is written for the SP2 loop only"); static_assert(!FP8 || SP2, "FP8 is written for the SP2 loop only");
    const int lane = lane_fresh(), tid = wid * 64 + lane, wr = wid >> 2, wc = wid & 3, fr = lane & 15, fq = lane >> 4;
    const int K = g.K, nt = K / BK;
    unsigned voffA[2], voffB[2]; int gR[2], gC[2];
#pragma unroll
    for (int i = 0; i < 2; ++i) { int R, C; stage_rc(tid * 16 + i * 8192, R, C); const int Rb = Epi::PERM ? ((R & ~31) + perm32(R & 31)) : R; gR[i] = R; gC[i] = C;
        voffA[i] = (unsigned)(R * K + C) * 2u; voffB[i] = (unsigned)(Rb * K + C) * 2u; }
    unsigned vc0[2] = {0u, 0u}, vc1[2] = {0u, 0u}, vn0[2] = {0u, 0u}, vn1[2] = {0u, 0u};
#define PG8_GROWS(u_, o0, o1) do { const int t_ = wid * 64 + lane_fresh(); const int ro_ = S.row_off(u_), rm_ = S.row_mask();     \
        _Pragma("unroll") for (int _i = 0; _i < 2; ++_i) { int R_, C_; stage_rc(t_ * 16 + _i * 8192, R_, C_); o0[_i] = (unsigned)((tok[ro_ + R_] & rm_) * K + C_) * 2u; o1[_i] = (unsigned)((tok[ro_ + HALF + R_] & rm_) * K + C_) * 2u; } } while (0)
#define PG8_STAGE_A(bufoff, gbase, h, usenext) do { if constexpr (GATHER) { const unsigned _o0 = (usenext) ? ((h) ? vn1[0] : vn0[0]) : ((h) ? vc1[0] : vc0[0]), _o1 = (usenext) ? ((h) ? vn1[1] : vn0[1]) : ((h) ? vc1[1] : vc0[1]); \
        __builtin_amdgcn_raw_ptr_buffer_load_lds(rsA, (PG8_LAS unsigned*)(lds + (bufoff) + ldsw), 16, (int)_o0, (int)(gbase), 0, 0); \
        __builtin_amdgcn_raw_ptr_buffer_load_lds(rsA, (PG8_LAS unsigned*)(lds + (bufoff) + ldsw + 8192), 16, (int)_o1, (int)(gbase), 0, 0); } \
    else { PG8_STAGE(rsA, bufoff, (gbase) + (h) * hstep, voffA); } } while (0)
    const unsigned kstep = (unsigned)(BK * 2);
    const unsigned hstep = (unsigned)(HALF * K * 2);
    const unsigned tstep = 2 * hstep;
    const __amdgpu_buffer_rsrc_t rsA = __builtin_amdgcn_make_buffer_rsrc((void*)g.A, (short)0, 0x7fffffff, 0x00020000), rsB = __builtin_amdgcn_make_buffer_rsrc((void*)g.Bt, (short)0, 0x7fffffff, 0x00020000);
    const unsigned ldsw = (unsigned)wid * 1024u;
    const int aoff = lds_byte(wr * 64 + fr, fq * 8), boff = lds_byte(wc * 32 + fr, fq * 8);
#if F8_CHUNK_SPLIT
    const int aoff0 = aoff, boff0 = boff; constexpr int F8_O1 = 1024;
#else
    const int aoff0 = lds_byte(wr * 64 + fr, (2 * (fq & 1)) * 8) + (fq >> 1) * 1024, boff0 = lds_byte(wc * 32 + fr, (2 * (fq & 1)) * 8) + (fq >> 1) * 1024; constexpr int F8_O1 = 16;
#endif
#define PG8_SA(b, h) (((b) * 2 + (h)) * HTB)
#define PG8_SB(b, h) ((4 + (b) * 2 + (h)) * HTB)
#define PG8_STAGE(rs, bufoff, soff, voff) do { _Pragma("unroll") for (int _i = 0; _i < 2; ++_i) \
        __builtin_amdgcn_raw_ptr_buffer_load_lds(rs, (PG8_LAS unsigned*)(lds + (bufoff) + ldsw + _i * 8192), 16, (int)(voff)[_i], (int)(soff), 0, 0); } while (0)
#define PG8_LD8(base_, o0_, o1_) __builtin_shufflevector(*(const PG8_LAS v4i*)(lds + (base_) + (o0_)), *(const PG8_LAS v4i*)(lds + (base_) + (o1_)), 0, 1, 2, 3, 4, 5, 6, 7)
#define PG8_LDA(dst, b, h) do { _Pragma("unroll") for (int m = 0; m < 4; ++m) { if constexpr (FP8) { dst##8[m] = PG8_LD8(PG8_SA(b, h) + m * 2048, aoff0, aoff0 + F8_O1); } \
        else { _Pragma("unroll") for (int k = 0; k < 2; ++k) dst[m][k] = *(const PG8_LAS bf16x8*)(lds + PG8_SA(b, h) + aoff + m * 2048 + k * 1024); } } } while (0)
#define PG8_LDB(dst, b, h) do { _Pragma("unroll") for (int n = 0; n < 2; ++n) { if constexpr (FP8) { dst##8[n] = PG8_LD8(PG8_SB(b, h) + n * 2048, boff0, boff0 + F8_O1); } \
        else { _Pragma("unroll") for (int k = 0; k < 2; ++k) dst[n][k] = *(const PG8_LAS bf16x8*)(lds + PG8_SB(b, h) + boff + n * 2048 + k * 1024); } } } while (0)
#define PG8_MMA(ai, bj, At, Bt) do { if constexpr (FP8) __builtin_amdgcn_sched_barrier(0); __builtin_amdgcn_s_setprio(1); _Pragma("unroll") for (int m = 0; m < 4; ++m) _Pragma("unroll") for (int n = 0; n < 2; ++n) { \
        if constexpr (FP8) acc[ai][bj][m][n] = __builtin_amdgcn_mfma_scale_f32_16x16x128_f8f6f4(Bt##8[n], At##8[m], acc[ai][bj][m][n], 0, 0, 0, F8_SCALE, 0, F8_SCALE); \
        else { _Pragma("unroll") for (int k = 0; k < 2; ++k) acc[ai][bj][m][n] = __builtin_amdgcn_mfma_f32_16x16x32_bf16(Bt[n][k], At[m][k], acc[ai][bj][m][n], 0, 0, 0); } } __builtin_amdgcn_s_setprio(0); \
        if constexpr (FP8) { if (F8_PIN) asm volatile("" : "+v"(acc[ai][bj][0][0]), "+v"(acc[ai][bj][0][1]), "+v"(acc[ai][bj][1][0]), "+v"(acc[ai][bj][1][1]), "+v"(acc[ai][bj][2][0]), "+v"(acc[ai][bj][2][1]), "+v"(acc[ai][bj][3][0]), "+v"(acc[ai][bj][3][1])); \
                             __builtin_amdgcn_sched_barrier(0); } } while (0)
#define PG8_WAIT_V(n) asm volatile("s_waitcnt vmcnt(" #n ")" ::: "memory")
#define PG8_WAIT_L(n) asm volatile("s_waitcnt lgkmcnt(" #n ")" ::: "memory")
#define PG8_BAR __builtin_amdgcn_s_barrier()
#define PG8_SCHED __builtin_amdgcn_sched_barrier(0)
    Unit cur, nxt; int ui = 0;
    if (!S.next(0, cur)) return;
    f32x4 acc[2][2][4][2];
#pragma unroll
    for (int a = 0; a < 2; ++a)
#pragma unroll
        for (int b = 0; b < 2; ++b)
#pragma unroll
            for (int m = 0; m < 4; ++m)
#pragma unroll
                for (int n = 0; n < 2; ++n) acc[a][b][m][n] = (f32x4){0.f, 0.f, 0.f, 0.f};
    bf16x8 At[4][2], B0[2][2], B1[2][2]; v8i At8[4], B08[2], B18[2];
    unsigned cA = GATHER ? 0u : (unsigned)cur.pm * tstep, cB = (unsigned)cur.pn * tstep;
    S.a_ready(cur);
    if constexpr (GATHER) PG8_GROWS(cur, vc0, vc1);
    if constexpr (SP2) {
        PG8_STAGE(rsB, PG8_SB(0, 0), cB, voffB); PG8_STAGE(rsB, PG8_SB(0, 1), cB + hstep, voffB); PG8_STAGE_A(PG8_SA(0, 0), cA, 0, false); PG8_STAGE_A(PG8_SA(0, 1), cA, 1, false);
        if (wr == 1) PG8_BAR;
        PG8_WAIT_V(2); PG8_BAR;
        PG8_STAGE(rsB, PG8_SB(1, 0), cB + kstep, voffB); PG8_STAGE_A(PG8_SA(1, 0), cA + kstep, 0, false); PG8_STAGE(rsB, PG8_SB(1, 1), cB + hstep + kstep, voffB);
        PG8_WAIT_V(6); PG8_BAR;
    } else {
        PG8_STAGE(rsB, PG8_SB(0, 0), cB, voffB); PG8_STAGE(rsA, PG8_SA(0, 0), cA, voffA); PG8_STAGE(rsB, PG8_SB(0, 1), cB + hstep, voffB); PG8_STAGE(rsA, PG8_SA(0, 1), cA + hstep, voffA);
        if (wr == 1) PG8_BAR;
        PG8_WAIT_V(4); PG8_BAR;
        PG8_STAGE(rsB, PG8_SB(1, 0), cB + kstep, voffB); PG8_STAGE(rsA, PG8_SA(1, 0), cA + kstep, voffA); PG8_STAGE(rsB, PG8_SB(1, 1), cB + hstep + kstep, voffB);
        PG8_WAIT_V(6); PG8_BAR;
    }
    for (;;) {
        const bool has_next = S.next(ui + 1, nxt);
        const unsigned nA = GATHER ? 0u : (has_next ? (unsigned)nxt.pm * tstep : cA), nB = has_next ? (unsigned)nxt.pn * tstep : cB;
        if constexpr (GATHER) { if (has_next) PG8_GROWS(nxt, vn0, vn1); else { vn0[0] = vc0[0]; vn0[1] = vc0[1]; vn1[0] = vc1[0]; vn1[1] = vc1[1]; } }
#pragma unroll 1
        for (int t = 0; t < nt; t += 2) {
            const bool last = (t == nt - 2);
            const unsigned a1 = cA + (unsigned)(t + 1) * kstep;
            const unsigned a2 = last ? nA : cA + (unsigned)(t + 2) * kstep, b2 = last ? nB : cB + (unsigned)(t + 2) * kstep;
            const unsigned a3 = a2 + kstep, b3 = b2 + kstep;
            if (last && has_next) S.a_ready(nxt);
            if constexpr (SP2) {
            PG8_LDB(B0, 0, 0); PG8_LDB(B1, 0, 1); PG8_SCHED; PG8_LDA(At, 0, 0); PG8_STAGE_A(PG8_SA(1, 1), a1, 1, false);
            PG8_WAIT_V(8); PG8_WAIT_L(0); PG8_BAR; PG8_MMA(0, 0, At, B0); PG8_MMA(0, 1, At, B1); PG8_BAR; PG8_SCHED;
            PG8_LDA(At, 0, 1); PG8_STAGE(rsB, PG8_SB(0, 0), b2, voffB); PG8_STAGE(rsB, PG8_SB(0, 1), b2 + hstep, voffB); PG8_STAGE_A(PG8_SA(0, 0), a2, 0, last);
            PG8_WAIT_V(8); PG8_WAIT_L(0); PG8_BAR; PG8_MMA(1, 0, At, B0); PG8_MMA(1, 1, At, B1); PG8_BAR; PG8_SCHED;
            PG8_LDB(B0, 1, 0); PG8_LDB(B1, 1, 1); PG8_SCHED; PG8_LDA(At, 1, 0); PG8_STAGE_A(PG8_SA(0, 1), a2, 1, last);
            PG8_WAIT_V(8); PG8_WAIT_L(0); PG8_BAR; PG8_MMA(0, 0, At, B0); PG8_MMA(0, 1, At, B1); PG8_BAR; PG8_SCHED;
            PG8_LDA(At, 1, 1); PG8_STAGE(rsB, PG8_SB(1, 0), b3, voffB); PG8_STAGE(rsB, PG8_SB(1, 1), b3 + hstep, voffB); PG8_STAGE_A(PG8_SA(1, 0), a3, 0, last);
            PG8_WAIT_V(8); PG8_WAIT_L(0); PG8_BAR; PG8_MMA(1, 0, At, B0); PG8_MMA(1, 1, At, B1); PG8_BAR; PG8_SCHED;
            } else {
            PG8_LDB(B0, 0, 0); PG8_SCHED; PG8_LDA(At, 0, 0); PG8_STAGE(rsA, PG8_SA(1, 1), a1 + hstep, voffA);
            PG8_WAIT_L(8); PG8_BAR; PG8_WAIT_L(0); PG8_MMA(0, 0, At, B0); PG8_BAR; PG8_SCHED;
            PG8_LDB(B1, 0, 1); PG8_STAGE(rsB, PG8_SB(0, 0), b2, voffB);
            PG8_BAR; PG8_WAIT_L(0); PG8_MMA(0, 1, At, B1); PG8_BAR;
            PG8_LDA(At, 0, 1); PG8_STAGE(rsA, PG8_SA(0, 0), a2, voffA);
            PG8_BAR; PG8_WAIT_L(0); PG8_MMA(1, 0, At, B0); PG8_BAR; PG8_SCHED;
            PG8_STAGE(rsB, PG8_SB(0, 1), b2 + hstep, voffB);
            PG8_WAIT_V(6); PG8_BAR; PG8_MMA(1, 1, At, B1); PG8_BAR;
            PG8_LDB(B0, 1, 0); PG8_SCHED; PG8_LDA(At, 1, 0); PG8_STAGE(rsA, PG8_SA(0, 1), a2 + hstep, voffA);
            PG8_WAIT_L(8); PG8_BAR; PG8_WAIT_L(0); PG8_MMA(0, 0, At, B0); PG8_BAR; PG8_SCHED;
            PG8_LDB(B1, 1, 1); PG8_STAGE(rsB, PG8_SB(1, 0), b3, voffB);
            PG8_BAR; PG8_WAIT_L(0); PG8_MMA(0, 1, At, B1); PG8_BAR;
            PG8_LDA(At, 1, 1); PG8_STAGE(rsA, PG8_SA(1, 0), a3, voffA);
            PG8_BAR; PG8_WAIT_L(0); PG8_MMA(1, 0, At, B0); PG8_BAR; PG8_SCHED;
            PG8_STAGE(rsB, PG8_SB(1, 1), b3 + hstep, voffB);
            PG8_WAIT_V(6); PG8_BAR; PG8_MMA(1, 1, At, B1); PG8_BAR;
            }
        }
        if constexpr (ALIGN_EPI) { if (wr == 0) PG8_BAR; }
        if constexpr (!Epi::AFTER_DRAIN) { E(acc, cur, wr, wc, fr, fq); S.done(cur); }
        if (!has_next) break;
#pragma unroll
        for (int a = 0; a < 2; ++a)
#pragma unroll
            for (int b = 0; b < 2; ++b)
#pragma unroll
                for (int m = 0; m < 4; ++m)
#pragma unroll
                    for (int n = 0; n < 2; ++n) acc[a][b][m][n] = (f32x4){0.f, 0.f, 0.f, 0.f};
        cur = nxt; cA = nA; cB = nB; ++ui;
        if constexpr (GATHER) { vc0[0] = vn0[0]; vc0[1] = vn0[1]; vc1[0] = vn1[0]; vc1[1] = vn1[1]; }
        if constexpr (ALIGN_EPI) { if (wr == 1) PG8_BAR; }
    }
    PG8_WAIT_V(0);
    if constexpr (!ALIGN_EPI) { if (wr == 0) PG8_BAR; }
    PG8_BAR;
    if constexpr (Epi::AFTER_DRAIN) { E.fused(acc, cur, wr, wc, fr, fq, lds, wid, lane); S.done(cur); }
#undef PG8_SA
#undef PG8_SB
#undef PG8_STAGE
#undef PG8_STAGE_A
#undef PG8_GROWS
#undef PG8_LDA
#undef PG8_LDB
#undef PG8_MMA
#undef PG8_LD8
#undef PG8_WAIT_V
#undef PG8_WAIT_L
#undef PG8_BAR
#undef PG8_SCHED
}
}

namespace attn {
typedef short bf16x8 __attribute__((ext_vector_type(8)));
typedef short s16x4 __attribute__((ext_vector_type(4)));
typedef float f32x16 __attribute__((ext_vector_type(16)));
typedef unsigned u32x4 __attribute__((ext_vector_type(4)));
typedef unsigned short bf16;
constexpr int D = 128, PITCH = 1024, SEQ = 2048;
constexpr float SCALE = 0.08838834764831845f, THR = 8.f;
constexpr int NW = 8, QBLK = 32, KVBLK = 64, QB = NW * QBLK;
constexpr int SHM_V = KVBLK * D * 2, SHM_K = KVBLK * D * 2;
constexpr int BIAS_OFF = 2 * SHM_V + 2 * SHM_K + NW * 64 * 4, NBIAS = 320;
constexpr int LDS_BYTES = BIAS_OFF + NBIAS * 4;
#define KSWZ(row, colB) ((row) * 256 + ((colB) ^ (((row) & 7) << 4)))
#define SBAR() __builtin_amdgcn_sched_barrier(0)
__device__ __forceinline__ int v_st(int k, int c) { const int kk = (k & ~0xC) | ((k & 4) << 1) | ((k & 8) >> 1); return ((kk >> 3) * 4 + (c >> 5)) * 512 + ((kk & 7) * 32 + (c & 31)) * 2; }
__device__ __forceinline__ int v_rd_base(int lane) { return ((lane & 3) << 3) | (((lane >> 2) & 3) << 6) | (((lane >> 4) & 1) << 5) | (((lane >> 5) & 1) << 8); }
constexpr int v_rd_off(int d0, int ks, int half) { return d0 * 512 + ks * 4096 + half * 2048; }
__device__ __forceinline__ int crow(int r, int hi) { return (r & 3) + 8 * (r >> 2) + 4 * hi; }
__device__ __forceinline__ unsigned cvtpk(float lo, float hi) { unsigned r; asm volatile("v_cvt_pk_bf16_f32 %0, %1, %2" : "=v"(r) : "v"(lo), "v"(hi)); return r; }
__device__ __forceinline__ bf16x8 load8(const bf16* p) { return *reinterpret_cast<const bf16x8*>(p); }
__device__ __forceinline__ int t5_bucket(int rel) {
    const int b = rel > 0 ? 16 : 0; const int n = rel < 0 ? -rel : rel; int v;
    if (n < 8) v = n; else if (n < 12) v = 8; else if (n < 16) v = 9; else if (n < 23) v = 10; else if (n < 32) v = 11; else if (n < 46) v = 12; else if (n < 65) v = 13; else if (n < 91) v = 14; else v = 15;
    return b + v;
}
__device__ __forceinline__ void bias_tile(f32x16& p0, f32x16& p1, const float* tabp) {
#pragma unroll
    for (int r = 0; r < 16; ++r) { const int c = (r & 3) + 8 * (r >> 2); p0[r] += tabp[59 - c]; p1[r] += tabp[59 - c - 32]; }
}
__device__ __forceinline__ void partialSM(f32x16& p0, f32x16& p1, float& m_reg, float& mn, float& alpha) {
    float pmax = p0[0]; for (int r = 1; r < 16; ++r) pmax = fmaxf(pmax, p0[r]); for (int r = 0; r < 16; ++r) pmax = fmaxf(pmax, p1[r]);
    { auto rr = __builtin_amdgcn_permlane32_swap(__float_as_uint(pmax), __float_as_uint(pmax), false, false);
      pmax = fmaxf(__uint_as_float(rr[0]), __uint_as_float(rr[1])); }
    constexpr float C2 = 1.4426950408889634f * SCALE;
    if (__builtin_expect(__all((pmax - m_reg) * SCALE <= THR), 1)) { mn = m_reg; alpha = 1.f; }
    else { mn = fmaxf(m_reg, pmax); alpha = __builtin_amdgcn_exp2f((m_reg - mn) * C2); m_reg = mn; }
    const float mnL = -mn * C2;
    for (int r = 0; r < 16; ++r) p0[r] = fmaf(p0[r], C2, mnL); for (int r = 0; r < 16; ++r) p1[r] = fmaf(p1[r], C2, mnL);
    for (int r = 0; r < 16; ++r) p0[r] = __builtin_amdgcn_exp2f(p0[r]);
}
__device__ __forceinline__ void finishSM(f32x16& p0, f32x16& p1, float alpha, float& l_reg, bf16x8& pa0, bf16x8& pa1, bf16x8& pa2, bf16x8& pa3) {
    for (int r = 0; r < 16; ++r) p1[r] = __builtin_amdgcn_exp2f(p1[r]);
    float ps = 0; for (int r = 0; r < 16; ++r) ps += p0[r]; for (int r = 0; r < 16; ++r) ps += p1[r];
    { auto rr = __builtin_amdgcn_permlane32_swap(__float_as_uint(ps), __float_as_uint(ps), false, false);
      ps = __uint_as_float(rr[0]) + __uint_as_float(rr[1]); }
    l_reg = l_reg * alpha + ps;
#define PK4(P, B_, OUT) do { unsigned a0 = cvtpk(P[B_+0], P[B_+1]), a1 = cvtpk(P[B_+2], P[B_+3]);                          \
        unsigned b0 = cvtpk(P[B_+4], P[B_+5]), b1 = cvtpk(P[B_+6], P[B_+7]);                                             \
        auto r0 = __builtin_amdgcn_permlane32_swap(a0, b0, false, false); auto r1 = __builtin_amdgcn_permlane32_swap(a1, b1, false, false); \
        u32x4 w = {r0[0], r1[0], r0[1], r1[1]}; OUT = *reinterpret_cast<bf16x8*>(&w); } while (0)
    PK4(p0, 0, pa0); PK4(p0, 8, pa1); PK4(p1, 0, pa2); PK4(p1, 8, pa3);
#undef PK4
}
template <int KB>
__device__ __forceinline__ void qkt(f32x16& p0, f32x16& p1, const char* K_lds, int r32, int hi, const bf16x8* qr, bool act) {
    if (!act) { const float NEG = -__builtin_inff();
#pragma unroll
        for (int r = 0; r < 16; ++r) { p0[r] = NEG; p1[r] = NEG; } return; }
    p0 = f32x16{}; p1 = f32x16{};
    const char* kb[4];
#pragma unroll
    for (int dd = 0; dd < 4; ++dd) kb[dd] = K_lds + KB * SHM_K + KSWZ(r32, (dd * 16 + hi * 8) * 2);
#pragma unroll
    for (int d0 = 0; d0 < 8; ++d0) { const char* a = kb[d0 & 3] + (d0 >> 2) * 128;
        bf16x8 b0 = *reinterpret_cast<const bf16x8*>(a);
        bf16x8 b1 = *reinterpret_cast<const bf16x8*>(a + 32 * 256);
        p0 = __builtin_amdgcn_mfma_f32_32x32x16_bf16(b0, qr[d0], p0, 0, 0, 0);
        p1 = __builtin_amdgcn_mfma_f32_32x32x16_bf16(b1, qr[d0], p1, 0, 0, 0); }
}
template <int VB>
__device__ __forceinline__ void pv_tile(f32x16* o, int vb0, bf16x8 pa0, bf16x8 pa1, bf16x8 pa2, bf16x8 pa3, bool act) {
    if (!act) return;
#define TRRD(dst, off) asm volatile("ds_read_b64_tr_b16 %0, %1 offset:%2" : "=&v"(dst) : "v"(vb0), "i"(off) : "memory")
#define PV_D0(d0) do { s16x4 l0, l1, l2, l3, h0, h1, h2, h3; constexpr int b_ = VB * SHM_V + v_rd_off(d0, 0, 0); \
        TRRD(l0, b_); TRRD(h0, b_ + 2048); TRRD(l1, b_ + 4096); TRRD(h1, b_ + 6144); TRRD(l2, b_ + 8192); TRRD(h2, b_ + 10240); TRRD(l3, b_ + 12288); TRRD(h3, b_ + 14336); \
        asm volatile("s_waitcnt lgkmcnt(0)" ::: "memory"); SBAR();   \
        o[d0] = __builtin_amdgcn_mfma_f32_32x32x16_bf16(pa0, (bf16x8){l0[0], l0[1], l0[2], l0[3], h0[0], h0[1], h0[2], h0[3]}, o[d0], 0, 0, 0);   \
        o[d0] = __builtin_amdgcn_mfma_f32_32x32x16_bf16(pa1, (bf16x8){l1[0], l1[1], l1[2], l1[3], h1[0], h1[1], h1[2], h1[3]}, o[d0], 0, 0, 0);   \
        o[d0] = __builtin_amdgcn_mfma_f32_32x32x16_bf16(pa2, (bf16x8){l2[0], l2[1], l2[2], l2[3], h2[0], h2[1], h2[2], h2[3]}, o[d0], 0, 0, 0);   \
        o[d0] = __builtin_amdgcn_mfma_f32_32x32x16_bf16(pa3, (bf16x8){l3[0], l3[1], l3[2], l3[3], h3[0], h3[1], h3[2], h3[3]}, o[d0], 0, 0, 0); } while (0)
    PV_D0(0); PV_D0(1); PV_D0(2); PV_D0(3);
#undef PV_D0
#undef TRRD
}
struct BlockRef { const bf16* Q; const bf16* K; const bf16* V; bf16* O; int P0; };
struct Seam { bf16x8 qr[8]; bf16x8 st_v0, st_v1, st_k0, st_k1; };
#define ROW(p, k0, rr) ((p) + (size_t)((k0) + (rr)) * PITCH + sc)
#define VMW() asm volatile("s_waitcnt vmcnt(0)" ::: "memory")
#define VMWN(n) asm volatile("s_waitcnt vmcnt(%0)" :: "i"(n) : "memory")
#define SLOAD_H(Kp, Vp, k0) do { S.st_v0 = load8(ROW(Vp, k0, sr)); S.st_v1 = load8(ROW(Vp, k0, 32 + sr)); S.st_k0 = load8(ROW(Kp, k0, sr)); S.st_k1 = load8(ROW(Kp, k0, 32 + sr)); } while (0)
#define SWRITE_HK(bf) do { *(bf16x8*)(K_lds + (bf) * SHM_K + kws) = S.st_k0; *(bf16x8*)(K_lds + (bf) * SHM_K + kws + 32 * 256) = S.st_k1; } while (0)
#define SWRITE_HV(bf) do { *(bf16x8*)(V_lds + (bf) * SHM_V + vst0) = S.st_v0; *(bf16x8*)(V_lds + (bf) * SHM_V + vst1) = S.st_v1; } while (0)
#define SWRITE_H(bf) do { SWRITE_HV(bf); SWRITE_HK(bf); } while (0)
__device__ __forceinline__ void attn_prime(const BlockRef& cur, char* lds, Seam& S) {
    const int tid = threadIdx.x, wid = __builtin_amdgcn_readfirstlane(tid >> 6), lane = tid & 63, r32 = lane & 31, hi = lane >> 5;
    const int sr = tid >> 4, sc = (tid & 15) * 8, kws = KSWZ(sr, sc * 2); char* K_lds = lds + 2 * SHM_V;
#pragma unroll
    for (int d0 = 0; d0 < 8; ++d0) S.qr[d0] = load8(cur.Q + (size_t)(wid * QBLK + r32) * PITCH + d0 * 16 + hi * 8);
    SLOAD_H(cur.K, cur.V, 0); VMW(); SWRITE_HK(0);
    __syncthreads();
}
__device__ __forceinline__ void attn_block(const BlockRef& cur, const BlockRef& nxt, char* lds, Seam& S) {
    const int tid = threadIdx.x, wid = __builtin_amdgcn_readfirstlane(tid >> 6), lane = tid & 63, r32 = lane & 31, hi = lane >> 5;
    const int NT = cur.P0 / KVBLK + QB / KVBLK;
    const int qlo = cur.P0 + wid * QBLK, cw = qlo >> 6;
    char* V_lds = lds; char* K_lds = lds + 2 * SHM_V;
    float* ws = (float*)(lds + 2 * SHM_V + 2 * SHM_K) + wid * 64; float* li_l = ws, * al_l = ws + 32;
    const float* btab = (const float*)(lds + BIAS_OFF);
    float m_reg = -1e30f, l_reg = 0; f32x16 o[4] = {};
    const int sr = tid >> 4, sc = (tid & 15) * 8, vst0 = v_st(sr, sc), vst1 = v_st(32 + sr, sc), kws = KSWZ(sr, sc * 2);
    const int vb0 = (int)(uintptr_t)V_lds + v_rd_base(lane);
    const bf16* Kh = cur.K; const bf16* Vh = cur.V;
    const int bb0 = qlo + r32 - 4 * hi + 4;
#define RESC(a) do { if (__any((a) < 1.f)) { if (hi == 0) al_l[r32] = (a); asm volatile("s_waitcnt lgkmcnt(0)" ::: "memory");              \
                     for (int d_ = 0; d_ < 4; ++d_) for (int r = 0; r < 16; ++r) o[d_][r] *= al_l[crow(r, hi)]; } } while (0)
#define KBASE(t) ((t) * KVBLK)
#define ACT(t) ((t) <= cw)
#define BIAST(P0_, P1_, t) do { if ((t) <= cw && (t) + 2 >= cw) bias_tile(P0_, P1_, btab + (bb0 - KBASE(t))); } while (0)
    constexpr int NQL = 8;
#define SEAM_K0() do { VMWN(NQL); SWRITE_HK(0); SBAR(); } while (0)
    f32x16 pA0, pA1, pB0, pB1; float mnA, mnB, alA, alB; bf16x8 pa0, pa1, pa2, pa3;
    SWRITE_HV(0); SBAR();
    SLOAD_H(Kh, Vh, KBASE(1));
    SBAR(); qkt<0>(pA0, pA1, K_lds, r32, hi, S.qr, ACT(0));
    BIAST(pA0, pA1, 0); partialSM(pA0, pA1, m_reg, mnA, alA);
    VMW(); SWRITE_H(1);
    __syncthreads();
#define HALF_STEP(PX0, PX1, mnX, alX, PY0, PY1, alY, t, KB, VB, SB) do {                                                      \
        SBAR(); qkt<KB>(PX0, PX1, K_lds, r32, hi, S.qr, ACT(t));                                                 \
        finishSM(PY0, PY1, alY, l_reg, pa0, pa1, pa2, pa3); SBAR();                                                           \
        if ((t) + 1 < NT) { SLOAD_H(Kh, Vh, KBASE((t) + 1)); SBAR(); }                                                         \
        pv_tile<VB>(o, vb0, pa0, pa1, pa2, pa3, ACT((t) - 1)); BIAST(PX0, PX1, (t)); partialSM(PX0, PX1, m_reg, mnX, alX);    \
        __syncthreads();                                                                                                      \
        if ((t) + 1 < NT) { VMW(); SWRITE_H(SB); }                                                                             \
        RESC(alX); __syncthreads(); } while (0)
    for (int t = 1; t + 1 < NT; t += 2) {
        HALF_STEP(pB0, pB1, mnB, alB, pA0, pA1, alA, t, 1, 0, 0);
        HALF_STEP(pA0, pA1, mnA, alA, pB0, pB1, alB, t + 1, 0, 1, 1);
    }
    { SBAR(); qkt<1>(pB0, pB1, K_lds, r32, hi, S.qr, ACT(NT - 1)); SBAR(); }
    SLOAD_H(nxt.K, nxt.V, 0); SBAR();
#pragma unroll
    for (int d0 = 0; d0 < 8; ++d0) S.qr[d0] = load8(nxt.Q + (size_t)(wid * QBLK + r32) * PITCH + d0 * 16 + hi * 8);
    SBAR();
    finishSM(pA0, pA1, alA, l_reg, pa0, pa1, pa2, pa3); SBAR();
    pv_tile<0>(o, vb0, pa0, pa1, pa2, pa3, ACT(NT - 2));
    { BIAST(pB0, pB1, NT - 1); partialSM(pB0, pB1, m_reg, mnB, alB); __syncthreads(); RESC(alB);
      finishSM(pB0, pB1, alB, l_reg, pa0, pa1, pa2, pa3); SBAR(); pv_tile<1>(o, vb0, pa0, pa1, pa2, pa3, ACT(NT - 1)); }
    SBAR(); SEAM_K0();
    if (hi == 0) li_l[r32] = l_reg; asm volatile("s_waitcnt lgkmcnt(0)" ::: "memory");
    float rli[16];
#pragma unroll
    for (int r = 0; r < 16; ++r) rli[r] = __builtin_amdgcn_rcpf(li_l[crow(r, hi)]);
    bf16* Ow = cur.O + (size_t)(wid * QBLK) * PITCH;
#pragma unroll
    for (int r = 0; r < 16; ++r) { const int orow = crow(r, hi);
#pragma unroll
        for (int d0 = 0; d0 < 4; ++d0) { const float v = o[d0][r] * rli[r];
            const float vn = __shfl_xor(v, 1);
            if ((r32 & 1) == 0) *(unsigned*)(Ow + (size_t)orow * PITCH + d0 * 32 + r32) = cvtpk(v, vn); } }
    __syncthreads();
#undef RESC
#undef KBASE
#undef ACT
#undef BIAST
#undef SEAM_K0
#undef HALF_STEP
}
#undef ROW
#undef VMW
#undef VMWN
#undef SLOAD_H
#undef SWRITE_HK
#undef SWRITE_HV
#undef SWRITE_H
#undef KSWZ
}

namespace attn2 {
using attn::bf16x8; using attn::s16x4; using attn::f32x16; using attn::u32x4; using attn::bf16;
using attn::v_st; using attn::v_rd_base; using attn::crow; using attn::cvtpk; using attn::load8; using attn::t5_bucket;
constexpr int D = 128, PITCH = 1024;
constexpr float SCALE = 0.08838834764831845f, THR = 8.f;
constexpr int NW = 8, QBLK = 32, KVBLK = 64, QB = 4 * QBLK;
constexpr int IMG = KVBLK * D * 2, SHM_V = 2 * IMG, SHM_K = KVBLK * D * 2;
constexpr int OFF_V = 0, OFF_K = 2 * SHM_V, OFF_PX = OFF_K + 2 * SHM_K, OFF_WS = OFF_PX + NW * 2048, OFF_MX = OFF_WS + NW * 64 * 4, BIAS_OFF = OFF_MX + NW * 32 * 4, NBIAS = 320;
constexpr int LDS_BYTES = BIAS_OFF + NBIAS * 4;
#define KSWZ(row, colB) ((row) * 256 + ((colB) ^ (((row) & 7) << 4)))
#define SBAR() __builtin_amdgcn_sched_barrier(0)
#ifndef ATTN_SGB
#define ATTN_SGB 1
#endif
#if ATTN_SGB
#define SGB_A() do { _Pragma("unroll") for (int g_ = 0; g_ < 8; ++g_) { __builtin_amdgcn_sched_group_barrier(0x008, 1, 0); __builtin_amdgcn_sched_group_barrier(0x402, 9, 0); } } while (0)
#else
#define SGB_A() do {} while (0)
#endif
#define L3 __attribute__((address_space(3)))
#define LP(T, byteoff) ((L3 T*)(uintptr_t)(unsigned)(byteoff))
__device__ __forceinline__ void bias_half(f32x16& p, const L3 float* tabp) {
#pragma unroll
    for (int r = 0; r < 16; ++r) { const int c = (r & 3) + 8 * (r >> 2); p[r] += tabp[59 - c]; }
}
__device__ __forceinline__ float rowmax_half(const f32x16& p) {
    float pmax = p[0];
#pragma unroll
    for (int r = 1; r < 16; ++r) pmax = fmaxf(pmax, p[r]);
    const auto rr = __builtin_amdgcn_permlane32_swap(__float_as_uint(pmax), __float_as_uint(pmax), false, false);
    return fmaxf(__uint_as_float(rr[0]), __uint_as_float(rr[1]));
}
__device__ __forceinline__ void partialSM(f32x16& p, float pmax, float& m_reg, float& alpha) {
    constexpr float C2 = 1.4426950408889634f * SCALE; float mn;
    if (__builtin_expect(__all((pmax - m_reg) * SCALE <= THR), 1)) { mn = m_reg; alpha = 1.f; }
    else { mn = fmaxf(m_reg, pmax); alpha = __builtin_amdgcn_exp2f((m_reg - mn) * C2); m_reg = mn; }
    const float mnL = -mn * C2;
#pragma unroll
    for (int r = 0; r < 16; ++r) p[r] = fmaf(p[r], C2, mnL);
#pragma unroll
    for (int r = 0; r < 8; ++r) p[r] = __builtin_amdgcn_exp2f(p[r]);
}
__device__ __forceinline__ void finishSM(f32x16& p, float alpha, float& l_reg, bf16x8& pa0, bf16x8& pa1, float mnL = 0.f) {
    if (ATTN_SMLATE) { constexpr float C2 = 1.4426950408889634f * SCALE;
#pragma unroll
        for (int r = 0; r < 16; ++r) p[r] = __builtin_amdgcn_exp2f(fmaf(p[r], C2, mnL)); }
    else {
#pragma unroll
    for (int r = 8; r < 16; ++r) p[r] = __builtin_amdgcn_exp2f(p[r]); }
    float ps = 0;
#pragma unroll
    for (int r = 0; r < 16; ++r) ps += p[r];
    { const auto rr = __builtin_amdgcn_permlane32_swap(__float_as_uint(ps), __float_as_uint(ps), false, false); ps = __uint_as_float(rr[0]) + __uint_as_float(rr[1]); }
    l_reg = l_reg * alpha + ps;
#define PK4(P, B_, OUT) do { unsigned a0 = cvtpk(P[B_+0], P[B_+1]), a1 = cvtpk(P[B_+2], P[B_+3]);                          \
        unsigned b0 = cvtpk(P[B_+4], P[B_+5]), b1 = cvtpk(P[B_+6], P[B_+7]);                                             \
        auto r0 = __builtin_amdgcn_permlane32_swap(a0, b0, false, false); auto r1 = __builtin_amdgcn_permlane32_swap(a1, b1, false, false); \
        u32x4 w = {r0[0], r1[0], r0[1], r1[1]}; OUT = *reinterpret_cast<bf16x8*>(&w); } while (0)
    PK4(p, 0, pa0); PK4(p, 8, pa1);
#undef PK4
}
template <int KB>
__device__ __forceinline__ void kload(bf16x8* kf, unsigned K_lds, int krow, int hi) {
    unsigned kb[4];
#pragma unroll
    for (int dd = 0; dd < 4; ++dd) kb[dd] = K_lds + KB * SHM_K + KSWZ(krow, (dd * 16 + hi * 8) * 2);
#pragma unroll
    for (int d0 = 0; d0 < 8; ++d0) kf[d0] = *LP(const bf16x8, kb[d0 & 3] + (d0 >> 2) * 128);
}
__device__ __forceinline__ void qmma(f32x16& p, const bf16x8* kf, const bf16x8* qr) {
    p = f32x16{};
#pragma unroll
    for (int d0 = 0; d0 < 8; ++d0) p = __builtin_amdgcn_mfma_f32_32x32x16_bf16(kf[d0], qr[d0], p, 0, 0, 0);
}
__device__ __forceinline__ void pneg(f32x16& p) { const float NEG = -__builtin_inff();
#pragma unroll
    for (int r = 0; r < 16; ++r) p[r] = NEG; }
#if ATTN_PVSM == 2
#define PVB() __builtin_amdgcn_sched_barrier(0x406)
#else
#define PVB() SBAR()
#endif
template <int VB>
__device__ __forceinline__ void pv_tile(f32x16* o, int vbo, int vbp, bf16x8 po0, bf16x8 po1, bf16x8 pp0, bf16x8 pp1, bool act) {
    if (!act) return;
#define TRRD(dst, base, off) asm volatile("ds_read_b64_tr_b16 %0, %1 offset:%2" : "=&v"(dst) : "v"(base), "i"(off) : "memory")
#define PV_D0(d0) do { s16x4 l0, l1, l2, l3, h0, h1, h2, h3; constexpr int b_ = VB * SHM_V + (d0) * 512; \
        TRRD(l0, vbo, b_); TRRD(h0, vbo, b_ + 2048); TRRD(l1, vbo, b_ + 4096); TRRD(h1, vbo, b_ + 6144); TRRD(l2, vbp, b_); TRRD(h2, vbp, b_ + 2048); TRRD(l3, vbp, b_ + 4096); TRRD(h3, vbp, b_ + 6144); \
        asm volatile("s_waitcnt lgkmcnt(0)" ::: "memory"); PVB();   \
        o[d0] = __builtin_amdgcn_mfma_f32_32x32x16_bf16(po0, (bf16x8){l0[0], l0[1], l0[2], l0[3], h0[0], h0[1], h0[2], h0[3]}, o[d0], 0, 0, 0);   \
        o[d0] = __builtin_amdgcn_mfma_f32_32x32x16_bf16(po1, (bf16x8){l1[0], l1[1], l1[2], l1[3], h1[0], h1[1], h1[2], h1[3]}, o[d0], 0, 0, 0);   \
        o[d0] = __builtin_amdgcn_mfma_f32_32x32x16_bf16(pp0, (bf16x8){l2[0], l2[1], l2[2], l2[3], h2[0], h2[1], h2[2], h2[3]}, o[d0], 0, 0, 0);   \
        o[d0] = __builtin_amdgcn_mfma_f32_32x32x16_bf16(pp1, (bf16x8){l3[0], l3[1], l3[2], l3[3], h3[0], h3[1], h3[2], h3[3]}, o[d0], 0, 0, 0); } while (0)
    PV_D0(0); PV_D0(1); PV_D0(2); PV_D0(3);
#undef PV_D0
#undef TRRD
}
__device__ __forceinline__ float partialSM_head(float pmax, float& m_reg, float& alpha) {
    constexpr float C2 = 1.4426950408889634f * SCALE; float mn;
    if (__builtin_expect(__all((pmax - m_reg) * SCALE <= THR), 1)) { mn = m_reg; alpha = 1.f; }
    else { mn = fmaxf(m_reg, pmax); alpha = __builtin_amdgcn_exp2f((m_reg - mn) * C2); m_reg = mn; }
    return -mn * C2;
}
#define PSM_SLICE(P_, i, mnL_) do { constexpr float C2_ = 1.4426950408889634f * SCALE; P_[i] = fmaf(P_[i], C2_, mnL_); if ((i) >= 8) P_[(i) - 8] = __builtin_amdgcn_exp2f(P_[(i) - 8]); } while (0)
#ifndef PVSM_TEST
#define PVSM_TEST 0
#endif
#ifndef PVSM_SBAR
#define PVSM_SBAR 1
#endif
#if PVSM_SBAR
#define PSB() SBAR()
#else
#define PSB() do {} while (0)
#endif
template <int VB>
__device__ __forceinline__ void pv_tile_sm(f32x16* o, int vbo, int vbp, bf16x8 po0, bf16x8 po1, bf16x8 pp0, bf16x8 pp1, bool act, f32x16& p, float mnL) {
    if (!act || PVSM_TEST) {
#pragma unroll
        for (int i = 0; i < 16; ++i) PSM_SLICE(p, i, mnL);
        if (PVSM_TEST) pv_tile<VB>(o, vbo, vbp, po0, po1, pp0, pp1, act);
        return; }
#define TRRD(dst, base, off) asm volatile("ds_read_b64_tr_b16 %0, %1 offset:%2" : "=&v"(dst) : "v"(base), "i"(off) : "memory")
#define PV_D0(d0) do { s16x4 l0, l1, l2, l3, h0, h1, h2, h3; constexpr int b_ = VB * SHM_V + (d0) * 512; \
        TRRD(l0, vbo, b_); TRRD(h0, vbo, b_ + 2048); TRRD(l1, vbo, b_ + 4096); TRRD(h1, vbo, b_ + 6144); TRRD(l2, vbp, b_); TRRD(h2, vbp, b_ + 2048); TRRD(l3, vbp, b_ + 4096); TRRD(h3, vbp, b_ + 6144); \
        asm volatile("s_waitcnt lgkmcnt(0)" ::: "memory"); SBAR();   \
        o[d0] = __builtin_amdgcn_mfma_f32_32x32x16_bf16(po0, (bf16x8){l0[0], l0[1], l0[2], l0[3], h0[0], h0[1], h0[2], h0[3]}, o[d0], 0, 0, 0); PSB(); PSM_SLICE(p, 4 * (d0) + 0, mnL); PSB();  \
        o[d0] = __builtin_amdgcn_mfma_f32_32x32x16_bf16(po1, (bf16x8){l1[0], l1[1], l1[2], l1[3], h1[0], h1[1], h1[2], h1[3]}, o[d0], 0, 0, 0); PSB(); PSM_SLICE(p, 4 * (d0) + 1, mnL); PSB();  \
        o[d0] = __builtin_amdgcn_mfma_f32_32x32x16_bf16(pp0, (bf16x8){l2[0], l2[1], l2[2], l2[3], h2[0], h2[1], h2[2], h2[3]}, o[d0], 0, 0, 0); PSB(); PSM_SLICE(p, 4 * (d0) + 2, mnL); PSB();  \
        o[d0] = __builtin_amdgcn_mfma_f32_32x32x16_bf16(pp1, (bf16x8){l3[0], l3[1], l3[2], l3[3], h3[0], h3[1], h3[2], h3[3]}, o[d0], 0, 0, 0); PSB(); PSM_SLICE(p, 4 * (d0) + 3, mnL); PSB(); } while (0)
    PV_D0(0); PV_D0(1); PV_D0(2); PV_D0(3);
#undef PV_D0
#undef TRRD
}
struct BlockRef { const bf16* Q; const bf16* K; const bf16* V; bf16* O; int P0; };
struct Seam { bf16x8 qr[8]; bf16x8 k0[2], k1[2], v0[2], v1[2], v2[2], v3[2]; };
#define VMW() asm volatile("s_waitcnt vmcnt(0)" ::: "memory")
typedef __amdgpu_buffer_rsrc_t rsrc_t;
__device__ __forceinline__ rsrc_t mkrsrc(const bf16* p) { return __builtin_amdgcn_make_buffer_rsrc((void*)p, (short)0, 0x7fffffff, 0x00020000); }
__device__ __forceinline__ bf16x8 bld16(rsrc_t r, unsigned voff, unsigned soff) { return __builtin_bit_cast(bf16x8, __builtin_amdgcn_raw_buffer_load_b128(r, (int)voff, (int)soff, 0)); }
#define RB(kk_, radd) ((unsigned)(((kk_) + (radd)) * PITCH) * 2u)
#define SLOADK(set, rK_, kk_) do { S.k0[set] = bld16(rK_, lofs, RB(kk_, 0)); S.k1[set] = bld16(rK_, lofs, RB(kk_, 32)); } while (0)
#define SLOADV(set, rV_, kk_) do { S.v0[set] = bld16(rV_, lofs, RB(kk_, 0)); S.v1[set] = bld16(rV_, lofs, RB(kk_, 32)); S.v2[set] = bld16(rV_, lofs, RB(kk_, 0) + 256u); S.v3[set] = bld16(rV_, lofs, RB(kk_, 32) + 256u); } while (0)
#define SWRITE_K(bf, set) do { *LP(bf16x8, K_lds + (bf) * SHM_K + kws) = S.k0[set]; *LP(bf16x8, K_lds + (bf) * SHM_K + kws + 32 * 256) = S.k1[set]; } while (0)
#define SWRITE_V(bf, set) do { *LP(bf16x8, V_lds + (bf) * SHM_V + vst0) = S.v0[set]; *LP(bf16x8, V_lds + (bf) * SHM_V + vst0 + VST1) = S.v1[set]; *LP(bf16x8, V_lds + (bf) * SHM_V + IMG + vst0) = S.v2[set]; *LP(bf16x8, V_lds + (bf) * SHM_V + IMG + vst0 + VST1) = S.v3[set]; } while (0)
#define DMA16(rs_, ldsaddr_, voff_, soff_) __builtin_amdgcn_raw_ptr_buffer_load_lds(rs_, (L3 unsigned*)(uintptr_t)(unsigned)(ldsaddr_), 16, (int)(voff_), (int)(soff_), 0, 0)
#define DMAK(bf, rK_, kk_) do { DMA16(rK_, K_lds + (bf) * SHM_K + (2 * wid) * 1024, kofs0, RB((kk_) + 8 * wid, 0)); DMA16(rK_, K_lds + (bf) * SHM_K + (2 * wid + 1) * 1024, kofs1, RB((kk_) + 8 * wid, 4)); } while (0)
#define DMAV(bf, rV_, kk_) do { DMA16(rV_, V_lds + (bf) * SHM_V + (2 * wid) * 1024, vofs, RB(kk_, 0)); DMA16(rV_, V_lds + (bf) * SHM_V + (2 * wid + 1) * 1024, vofs, RB(kk_, 0) + 128u); \
                                DMA16(rV_, V_lds + (bf) * SHM_V + IMG + (2 * wid) * 1024, vofs, RB(kk_, 0) + 256u); DMA16(rV_, V_lds + (bf) * SHM_V + IMG + (2 * wid + 1) * 1024, vofs, RB(kk_, 0) + 384u); } while (0)
#define DMA_LANE_OFFS() const unsigned kofs0 = (unsigned)((lane >> 4) * PITCH) * 2u + (unsigned)((16 * (lane & 15)) ^ ((lane >> 4) << 4)), kofs1 = (unsigned)((lane >> 4) * PITCH) * 2u + (unsigned)((16 * (lane & 15)) ^ ((4 + (lane >> 4)) << 4)); \
    const int vkk_ = 8 * wid + ((lane & 31) >> 2), vk_ = (vkk_ & ~0xC) | ((vkk_ & 4) << 1) | ((vkk_ & 8) >> 1); const unsigned vofs = (unsigned)(vk_ * PITCH + (lane >> 5) * 32 + (lane & 3) * 8) * 2u
__device__ __forceinline__ void attn_prime(const BlockRef& cur, char* lds, Seam& S, int tid) {
    const int wid = __builtin_amdgcn_readfirstlane(tid >> 6), lane = tid & 63, r32 = lane & 31, hi = lane >> 5, pj = wid & 3;
    const int sr = tid >> 4, sc = (tid & 15) * 8, kws = KSWZ(sr, sc * 2); const unsigned K_lds = (unsigned)(uintptr_t)lds + OFF_K, lofs = (unsigned)(sr * PITCH + sc) * 2u, qofs = (unsigned)(r32 * PITCH + hi * 8) * 2u;
    const rsrc_t rQ = mkrsrc(cur.Q), rK = mkrsrc(cur.K), rV = mkrsrc(cur.V);
#pragma unroll
    for (int d0 = 0; d0 < 8; ++d0) S.qr[d0] = bld16(rQ, qofs, (unsigned)((pj * QBLK) * PITCH + d0 * 16) * 2u);
#if ATTN_DMA
    { const unsigned V_lds = (unsigned)(uintptr_t)lds + OFF_V; (void)V_lds; (void)rV; (void)kws; (void)lofs; DMA_LANE_OFFS(); (void)vofs;
      DMAK(0, rK, 0); DMAK(1, rK, KVBLK); VMW(); }
#else
    SLOADK(0, rK, 0); VMW(); SWRITE_K(0, 0); SBAR();
    SLOADK(1, rK, KVBLK); SLOADV(0, rV, 0); SLOADK(0, rK, 2 * KVBLK); SLOADV(1, rV, KVBLK);
#endif
    __syncthreads();
}
__device__ __forceinline__ void attn_block(const BlockRef& cur, const BlockRef& nxt, char* lds, Seam& S, int tid) {
    const int wid = __builtin_amdgcn_readfirstlane(tid >> 6), lane = tid & 63, r32 = lane & 31, hi = lane >> 5, pj = wid & 3, kh = wid >> 2, pw = wid ^ 4;
    const int NT = cur.P0 / KVBLK + QB / KVBLK, NTn = nxt.P0 / KVBLK + QB / KVBLK;
    const int qlo = cur.P0 + pj * QBLK, cw = qlo >> 6;
    const unsigned L = (unsigned)(uintptr_t)lds, V_lds = L + OFF_V, K_lds = L + OFF_K;
    L3 float* li_l = LP(float, L + OFF_WS + wid * 256); L3 float* al_l = li_l + 32; const L3 float* li_p = LP(const float, L + OFF_WS + pw * 256);
    L3 float* mx_o = LP(float, L + OFF_MX + wid * 128); const L3 float* mx_p = LP(const float, L + OFF_MX + pw * 128);
    const unsigned px_o = L + OFF_PX + wid * 2048 + lane * 16, px_p = L + OFF_PX + pw * 2048 + lane * 16;
    const L3 float* btab = LP(const float, L + BIAS_OFF);
    float m_reg = -1e30f, l_reg = 0; f32x16 o[4] = {};
    const int sr = tid >> 4, sc = (tid & 15) * 8, vst0 = v_st(sr, sc), kws = KSWZ(sr, sc * 2); constexpr int VST1 = 8192;
    const unsigned lofs = (unsigned)(sr * PITCH + sc) * 2u, qofs = (unsigned)(r32 * PITCH + hi * 8) * 2u;
    const int vbase = (int)V_lds + v_rd_base(lane) + kh * IMG, vbo = vbase + kh * 8192, vbp = vbase + (1 - kh) * 8192;
    const int krow = kh * 32 + r32;
    const rsrc_t cK = mkrsrc(cur.K), cV = mkrsrc(cur.V), nK = mkrsrc(nxt.K), nV = mkrsrc(nxt.V);
    const int bb0 = qlo + r32 - 4 * hi + 4 - 32 * kh;
#define RESC(a) do { if (__any((a) < 1.f)) { if (hi == 0) al_l[r32] = (a); asm volatile("s_waitcnt lgkmcnt(0)" ::: "memory");              \
                     for (int d_ = 0; d_ < 4; ++d_) for (int r = 0; r < 16; ++r) o[d_][r] *= al_l[crow(r, hi)]; } } while (0)
#define KBASE(t) ((t) * KVBLK)
#define ACT(t) ((t) <= cw)
#define BIAST(P_, t) do { if ((t) <= cw && (t) + 2 >= cw) bias_half(P_, btab + (bb0 - KBASE(t))); } while (0)
#define PUTMAX(P_) do { const float pm_ = rowmax_half(P_); if (hi == 0) mx_o[r32] = pm_; pmx = pm_; } while (0)
#define GETMAX() fmaxf(pmx, mx_p[r32])
#define VLOADK(set, v) do { const int v_ = (v); if (v_ < NT) SLOADK(set, cK, KBASE(v_)); else SLOADK(set, nK, KBASE((v_ - NT) % NTn)); } while (0)
#define VLOADV(set, v) do { const int v_ = (v); if (v_ < NT) SLOADV(set, cV, KBASE(v_)); else SLOADV(set, nV, KBASE((v_ - NT) % NTn)); } while (0)
#if ATTN_DMA
#define KDMA_V(bf, v) do { const int v_ = (v); if (v_ < NT) DMAK(bf, cK, KBASE(v_)); else DMAK(bf, nK, KBASE((v_ - NT) % NTn)); } while (0)
#define STAGE_A(KB, t) do { SBAR(); DMAV(KB, cV, KBASE(t)); SBAR(); } while (0)
#define STAGE_B(KB, t) do { SBAR(); KDMA_V(KB, (t) + 2); SBAR(); } while (0)
#define DMA_WAIT() asm volatile("s_waitcnt vmcnt(6)" ::: "memory")
    DMA_LANE_OFFS();
#else
#define STAGE_A(KB, t) do { SBAR(); SWRITE_V(KB, KB); SBAR(); VLOADV(KB, (t) + 2); SBAR(); } while (0)
#define STAGE_B(KB, t) do { SBAR(); SWRITE_K(1 - KB, 1 - KB); SBAR(); VLOADK(1 - KB, (t) + 3); SBAR(); } while (0)
#define DMA_WAIT() do {} while (0)
#endif
    f32x16 pA, pB; float alA, alB, pmx, mnpA = 0.f, mnpB = 0.f; bf16x8 po0, po1, pp0, pp1;
#define STEP(PX_, alX, PY_, alY, t, KB, HASPREV) do {                                                                               \
        STAGE_A(KB, t);                                                                                                            \
        if (ACT(t)) { bf16x8 kf_[8]; kload<KB>(kf_, K_lds, krow, hi); SBAR(); qmma(PX_, kf_, S.qr);                                  \
                      if (HASPREV) { finishSM(PY_, alY, l_reg, po0, po1, mn##PY_); *LP(bf16x8, px_o) = po0; *LP(bf16x8, px_o + 1024) = po1; } SGB_A(); }   \
        else { pneg(PX_); if (HASPREV) { finishSM(PY_, alY, l_reg, po0, po1, mn##PY_); *LP(bf16x8, px_o) = po0; *LP(bf16x8, px_o + 1024) = po1; } }        \
        SBAR(); BIAST(PX_, (t)); PUTMAX(PX_);                                                                                       \
        DMA_WAIT(); __syncthreads();                                                                                               \
        if (HASPREV) { pp0 = *LP(const bf16x8, px_p); pp1 = *LP(const bf16x8, px_p + 1024); }                                        \
        if (ATTN_PVSM == 1 && (HASPREV)) { const float mnL_ = partialSM_head(GETMAX(), m_reg, alX); pv_tile_sm<1 - KB>(o, vbo, vbp, po0, po1, pp0, pp1, ACT((t) - 1), PX_, mnL_); }   \
        else { if (ATTN_SMLATE) mn##PX_ = partialSM_head(GETMAX(), m_reg, alX); else partialSM(PX_, GETMAX(), m_reg, alX); if (HASPREV) pv_tile<1 - KB>(o, vbo, vbp, po0, po1, pp0, pp1, ACT((t) - 1)); }  \
        STAGE_B(KB, t);                                                                                                            \
        RESC(alX); DMA_WAIT(); __syncthreads(); } while (0)
    for (int t = 0; t < NT; t += 2) {
        STEP(pA, alA, pB, alB, t, 0, t > 0);
        STEP(pB, alB, pA, alA, t + 1, 1, true);
    }
    { const rsrc_t nQ = mkrsrc(nxt.Q);
#pragma unroll
      for (int d0 = 0; d0 < 8; ++d0) S.qr[d0] = bld16(nQ, qofs, (unsigned)((pj * QBLK) * PITCH + d0 * 16) * 2u); }
    SBAR();
    finishSM(pB, alB, l_reg, po0, po1, mnpB); *LP(bf16x8, px_o) = po0; *LP(bf16x8, px_o + 1024) = po1;
    if (hi == 0) li_l[r32] = l_reg;
#if ATTN_DMA
    asm volatile("s_waitcnt vmcnt(10)" ::: "memory");
#endif
    __syncthreads();
    pp0 = *LP(const bf16x8, px_p); pp1 = *LP(const bf16x8, px_p + 1024);
    pv_tile<1>(o, vbo, vbp, po0, po1, pp0, pp1, ACT(NT - 1));
    float rli[16];
#pragma unroll
    for (int r = 0; r < 16; ++r) rli[r] = __builtin_amdgcn_rcpf(li_l[crow(r, hi)] + li_p[crow(r, hi)]);
    int lane_off = hi * 4 * PITCH + r32; asm volatile("" : "+v"(lane_off));
    bf16* Ow = cur.O + ((pj * QBLK) * PITCH + kh * 128 + lane_off);
#pragma unroll
    for (int r = 0; r < 16; ++r) { const int orow = (r & 3) + 8 * (r >> 2);
#pragma unroll
        for (int d0 = 0; d0 < 4; ++d0) { const float v = o[d0][r] * rli[r];
            const float vn = __shfl_xor(v, 1);
            if ((r32 & 1) == 0) *(unsigned*)(Ow + (orow * PITCH + d0 * 32)) = cvtpk(v, vn); } }
    __syncthreads();
#undef RESC
#undef KBASE
#undef ACT
#undef BIAST
#undef PUTMAX
#undef GETMAX
#undef VLOADK
#undef VLOADV
#undef STAGE_A
#undef STAGE_B
#undef DMA_WAIT
#undef STEP
}
#undef SLOADK
#undef SLOADV
#undef SWRITE_K
#undef SWRITE_V
#undef VMW
#undef RB
#undef KSWZ
#undef L3
#undef LP
#undef SGB_A
}


constexpr int NWAVES = 8;
constexpr int BATCH = 16, SEQ = 2048, T = BATCH * SEQ, D = 1024, NIN = 8192, NE = 32, DE = 512;
constexpr int MAXT = 288, MAXS = MAXT * 256;
constexpr float LN_EPS = 1e-5f, RMS_EPS = 1e-6f, ALPHA = 1.189207115002721f, LAM_INIT = 0.2f;
constexpr size_t MiB = 1u << 20;
constexpr size_t WS_CTL = 0, CTL_ZERO_BYTES = 1 * MiB;
constexpr size_t WS_STATS = 1 * MiB, WS_EID = WS_STATS + 256 * 1024, WS_EW = WS_EID + 256 * 1024, WS_RANK = WS_EW + 256 * 1024, WS_SLOT = 2 * MiB, WS_CNTWG = WS_SLOT + 256 * 1024, WS_TOK = 3 * MiB, WS_IDL = WS_TOK + 512 * 1024;
constexpr size_t WS_WA = 4 * MiB, WS_WB = 6 * MiB, WS_WO = 8 * MiB, WS_WIN = 10 * MiB;
constexpr size_t WS_XN = 26 * MiB, WS_Q = 90 * MiB, WS_K = 154 * MiB, WS_V = 218 * MiB, WS_CB = 282 * MiB, WS_Z = 346 * MiB, WS_O1 = 410 * MiB;
constexpr size_t WS_WGU = 90 * MiB, WS_WD = 154 * MiB, WS_PRE = 186 * MiB, WS_XG = 314 * MiB, WS_END = 483 * MiB;
constexpr size_t WS_WIN8 = 410 * MiB, WS_XN8 = 426 * MiB;
constexpr float XN8_S = 16.f;
constexpr size_t WS_WGU8 = 90 * MiB, WS_WD8 = 122 * MiB, WS_X18 = 250 * MiB;
constexpr int CW_TMO = 0, CW_CODE = 1, CW_BAR = 4096, CW_MOE = 65536, CW_GCNT = 200000;
constexpr size_t WS_RWIMG = 482 * MiB;
constexpr size_t WS_TOKE = 474 * MiB; constexpr int TOKE_CAP = 65536;
constexpr int RING_OFF = 0, RING_BYTES = 131072, RW_BYTES = 147456;
constexpr int LDSCTL_OFF = RW_BYTES, MISC_OFF = LDSCTL_OFF + 320, TAB_OFF = LDSCTL_OFF + 512, RSCR_OFF = LDSCTL_OFF + 1024;
constexpr int LDS_BYTES = 163840;
constexpr int LEID_OFF = LDSCTL_OFF + 6144, LRANK_OFF = LDSCTL_OFF + 7168;
static_assert(RSCR_OFF + 8 * 128 * 4 + 1024 <= LEID_OFF && LRANK_OFF + 1024 <= LDS_BYTES, "LDS map");

#define GAS __attribute__((address_space(1)))
#define LAS __attribute__((address_space(3)))
typedef unsigned short bf16;
#ifdef SWAP_CB_SGA
#define BUF_CB(P)  ((bf16*)(P).out)
#define BUF_SGA(P) ((bf16*)((P).ws + WS_CB))
#else
#define BUF_CB(P)  ((bf16*)((P).ws + WS_CB))
#define BUF_SGA(P) ((bf16*)(P).out)
#endif
#define BUF_SGB(P) ((bf16*)(P).out + (size_t)T * D)
typedef unsigned v4u __attribute__((ext_vector_type(4)));
typedef unsigned v2u __attribute__((ext_vector_type(2)));
typedef float f32x4 __attribute__((ext_vector_type(4)));
typedef GAS unsigned gu32;
#define RLX_AGENT __ATOMIC_RELAXED, __HIP_MEMORY_SCOPE_AGENT
#define LDS_WAIT() asm volatile("s_waitcnt lgkmcnt(0)" ::: "memory")
#define VM_WAIT() asm volatile("s_waitcnt vmcnt(0)" ::: "memory")
__device__ __forceinline__ unsigned f2bf(float f) { unsigned u = __builtin_bit_cast(unsigned, f); return (u + 0x7fffu + ((u >> 16) & 1u)) >> 16; }
__device__ __forceinline__ unsigned pk2(float lo, float hi) { return f2bf(lo) | (f2bf(hi) << 16); }
__device__ __forceinline__ float bflo(unsigned w) { return __uint_as_float(w << 16); }
__device__ __forceinline__ float bfhi(unsigned w) { return __uint_as_float(w & 0xffff0000u); }

#define XB_TMO      128
#define XB_XCNT(j)  (256  + 64 * (j))
#define XB_XSUB(j)  (1280 + 64 * (j))
#define XB_XGEN(j)  (2304 + 64 * (j))
#define XB_TOP      3328
#define XB_TOPGEN   3392
#define XCD_BAR_WORDS 3456
#define XB_SPIN_CAP (1u << 18)
__device__ __forceinline__ unsigned xb_ld(unsigned* p)              { return __hip_atomic_load(p, __ATOMIC_RELAXED, __HIP_MEMORY_SCOPE_AGENT); }
__device__ __forceinline__ unsigned xb_add(unsigned* p, unsigned v) { return __hip_atomic_fetch_add(p, v, __ATOMIC_RELAXED, __HIP_MEMORY_SCOPE_AGENT); }
__device__ __forceinline__ unsigned xb_xcc_id() { return (unsigned)__builtin_amdgcn_s_getreg((3 << 11) | 20) & 0xFu; }
#define XB_SPIN(cond, bar) do { unsigned _sp = 0; while (cond) { __builtin_amdgcn_s_sleep(1); \
    if ((++_sp & 255u) == 0u) { if (xb_ld(&(bar)[XB_TMO])) break; if (_sp > XB_SPIN_CAP) { atomicAdd(&(bar)[XB_TMO], 1u); break; } } } } while (0)
struct XcdBarrier { unsigned* bar; unsigned x; volatile LAS unsigned* st; int wave; };
__device__ __forceinline__ XcdBarrier xcd_barrier_post(unsigned* bar, volatile LAS unsigned* st, int wave) {
    XcdBarrier b; b.bar = bar; b.x = xb_xcc_id(); b.st = st; b.wave = wave;
    if (wave == 0 && lane_fresh() == 0) (void)xb_add(&bar[XB_XCNT(b.x)], 1u);
    return b;
}
__device__ __forceinline__ void xcd_barrier_complete(unsigned* bar, unsigned x, unsigned& nloc, unsigned& nx) {
    const unsigned G = gridDim.x * gridDim.y * gridDim.z;
    unsigned sum, cnt, mine, sp = 0u;
    for (;;) {
        sum = 0u; cnt = 0u; mine = 0u;
#pragma unroll
        for (unsigned j = 0; j < 16; ++j) { const unsigned c = xb_ld(&bar[XB_XCNT(j)]); sum += c; cnt += (c > 0u) ? 1u : 0u; mine = (j == x) ? c : mine; }
        if (sum == G) break;
        __builtin_amdgcn_s_sleep(1);
        if ((++sp & 255u) == 0u) { if (xb_ld(&bar[XB_TMO])) break; if (sp > XB_SPIN_CAP) { atomicAdd(&bar[XB_TMO], 1u); break; } }
    }
    nloc = mine > 0u ? mine : 1u; nx = cnt > 0u ? cnt : 1u;
}
__device__ __forceinline__ void xcd_barrier(const XcdBarrier& b) {
    asm volatile("s_waitcnt vmcnt(0)" ::: "memory");
    __syncthreads();
    if (b.wave == 0 && lane_fresh() == 0) {
        unsigned* bar = b.bar;
        __builtin_amdgcn_s_waitcnt(0);
        unsigned nloc = b.st[0], nx = b.st[1];
        if (nloc == 0u) { xcd_barrier_complete(bar, b.x, nloc, nx); b.st[0] = nloc; b.st[1] = nx; }
        const unsigned old = xb_add(&bar[XB_XSUB(b.x)], 1u);
        const unsigned gen = old / nloc;
        if (old + 1u == (gen + 1u) * nloc) {
            __builtin_amdgcn_fence(__ATOMIC_RELEASE, "agent");
            asm volatile("s_waitcnt vmcnt(0)" ::: "memory");
            const unsigned og = xb_add(&bar[XB_TOP], 1u);
            const unsigned tg = og / nx;
            if (og + 1u == (tg + 1u) * nx) xb_add(&bar[XB_TOPGEN], 1u);
            else XB_SPIN(xb_ld(&bar[XB_TOPGEN]) == tg, bar);
            __builtin_amdgcn_fence(__ATOMIC_ACQUIRE, "agent");
            xb_add(&bar[XB_XGEN(b.x)], 1u);
            asm volatile("s_waitcnt vmcnt(0)" ::: "memory");
        } else {
            XB_SPIN(xb_ld(&bar[XB_XGEN(b.x)]) == gen, bar);
            __builtin_amdgcn_fence(__ATOMIC_ACQUIRE, "agent");
            asm volatile("s_waitcnt vmcnt(0)" ::: "memory");
        }
    }
    __syncthreads();
}

struct Frame {
    LAS unsigned char* lds; volatile LAS unsigned* MISC; gu32* ctl;
    int tid, lane, wave, vcu, G;
};
__device__ __forceinline__ float wave_sum(float v) {
#pragma unroll
    for (int o = 1; o < 64; o <<= 1) v += __shfl_xor(v, o);
    return v;
}
__device__ __forceinline__ float wave_sum_fast(float v) {
    v += __int_as_float(__builtin_amdgcn_update_dpp(0, __float_as_int(v), 0x128, 0xf, 0xf, false));
    v += __int_as_float(__builtin_amdgcn_update_dpp(0, __float_as_int(v), 0x124, 0xf, 0xf, false));
    v += __int_as_float(__builtin_amdgcn_update_dpp(0, __float_as_int(v), 0x122, 0xf, 0xf, false));
    v += __int_as_float(__builtin_amdgcn_update_dpp(0, __float_as_int(v), 0x121, 0xf, 0xf, false));
    const int vi = __float_as_int(v);
    return (__int_as_float(__builtin_amdgcn_readlane(vi, 0)) + __int_as_float(__builtin_amdgcn_readlane(vi, 16))) + (__int_as_float(__builtin_amdgcn_readlane(vi, 32)) + __int_as_float(__builtin_amdgcn_readlane(vi, 48)));
}
__device__ __forceinline__ void transpose_item(const float* W, int K, int N, int k0, int n0, bf16* WT, int drow0, LAS float* scr, int lane) {
#pragma unroll 8
    for (int i = 0; i < 32; ++i) { const int kk = 2 * i + (lane >> 5); scr[kk * 33 + (lane & 31)] = W[(size_t)(k0 + kk) * N + n0 + (lane & 31)]; }
    LDS_WAIT(); asm volatile("" ::: "memory");
    const int c = lane & 7;
#pragma unroll
    for (int j = 0; j < 4; ++j) { const int n = (lane >> 3) + 8 * j; const LAS float* s = scr + (8 * c) * 33 + n;
        v4u o; o.x = pk2(s[0 * 33], s[1 * 33]); o.y = pk2(s[2 * 33], s[3 * 33]); o.z = pk2(s[4 * 33], s[5 * 33]); o.w = pk2(s[6 * 33], s[7 * 33]);
        *(GAS v4u*)(WT + (size_t)(drow0 + n) * K + k0 + 8 * c) = o; }
    LDS_WAIT(); asm volatile("" ::: "memory");
}
__device__ __forceinline__ void transpose_item8(const float* W, int K, int N, int k0, int n0, unsigned char* WT, int drow0, LAS float* scr, int lane) {
#pragma unroll 8
    for (int i = 0; i < 32; ++i) { const int kk = 2 * i + (lane >> 5); scr[kk * 33 + (lane & 31)] = W[(size_t)(k0 + kk) * N + n0 + (lane & 31)]; }
    LDS_WAIT(); asm volatile("" ::: "memory");
    const int c = lane & 7; constexpr float sc = pg8::F8_WS;
#pragma unroll
    for (int j = 0; j < 4; ++j) { const int n = (lane >> 3) + 8 * j; const LAS float* s = scr + (8 * c) * 33 + n;
        v2u o; o.x = pg8::pk4_fp8(s[0 * 33] * sc, s[1 * 33] * sc, s[2 * 33] * sc, s[3 * 33] * sc); o.y = pg8::pk4_fp8(s[4 * 33] * sc, s[5 * 33] * sc, s[6 * 33] * sc, s[7 * 33] * sc);
        *(GAS v2u*)(WT + (size_t)(drow0 + n) * K + k0 + 8 * c) = o; }
    LDS_WAIT(); asm volatile("" ::: "memory");
}
__device__ __forceinline__ int win_drow(int n0) {
    if (n0 < 4096 || n0 >= 6144) return n0;
    if (n0 < 5120) { const int r = n0 - 4096; return 4096 + 256 * (r >> 7) + (r & 127); }
    const int r = n0 - 5120; return 4096 + 256 * (r >> 7) + 128 + (r & 127);
}
struct Ptrs {
    const float *x, *ln_in_g, *ln_in_b, *w_in, *b_gate, *lq, *lk, *subln_g, *rel_bias, *conv_w, *w_a, *w_b, *w_o, *ln1_g, *ln1_b, *w_group, *b_group, *w_sub, *b_sub, *w_gate_e, *w_up_e, *w_down_e, *ln2_g, *ln2_b;
    float* out; unsigned char* ws;
};
__device__ __forceinline__ void p0_prologue(Frame& F, const Ptrs& P) {
    LAS float* scr = (LAS float*)(F.lds + RING_OFF + F.wave * 16384);
    const int gw = F.vcu * NWAVES + F.wave, NGW = F.G * NWAVES;
    constexpr int I_IN = (D / 64) * (NIN / 32), I_SQ = (D / 64) * (D / 32);
    bf16* Wt_in = (bf16*)(P.ws + WS_WIN); bf16* Wt_a = (bf16*)(P.ws + WS_WA); bf16* Wt_b = (bf16*)(P.ws + WS_WB); bf16* Wt_o = (bf16*)(P.ws + WS_WO);
    for (int it = gw; it < I_IN + 3 * I_SQ; it += NGW) {
        int r = it;
        if (r < I_IN) { const int kb = r / (NIN / 32), nb = r % (NIN / 32); const int dr = win_drow(32 * nb), tile = dr >> 8;
            if (((tile - INPROJ_F8_LO) & 31) < INPROJ_F8_HI - INPROJ_F8_LO) transpose_item8(P.w_in, D, NIN, 64 * kb, 32 * nb, (unsigned char*)(P.ws + WS_WIN8), dr, scr, F.lane);
            else transpose_item(P.w_in, D, NIN, 64 * kb, 32 * nb, Wt_in, dr, scr, F.lane);
            continue; } r -= I_IN;
        const int which = r / I_SQ; r -= which * I_SQ; const int kb = r / (D / 32), nb = r % (D / 32);
        const float* W = which == 0 ? P.w_a : (which == 1 ? P.w_b : P.w_o); bf16* WT = which == 0 ? Wt_a : (which == 1 ? Wt_b : Wt_o);
        transpose_item(W, D, D, 64 * kb, 32 * nb, WT, 32 * nb, scr, F.lane);
    }
    bf16* XN = (bf16*)(P.ws + WS_XN); float* stats = (float*)(P.ws + WS_STATS);
    for (int m = gw; m < T; m += NGW) {
        const GAS f32x4* xr = (const GAS f32x4*)(P.x + (size_t)m * D) + F.lane;
        f32x4 v[4]; float s = 0.f;
#pragma unroll
        for (int j = 0; j < 4; ++j) { v[j] = xr[64 * j]; s += (v[j].x + v[j].y) + (v[j].z + v[j].w); }
        const float mean = wave_sum(s) * (1.f / D); float s2 = 0.f;
#pragma unroll
        for (int j = 0; j < 4; ++j) { v[j] = v[j] - mean; s2 += (v[j].x * v[j].x + v[j].y * v[j].y) + (v[j].z * v[j].z + v[j].w * v[j].w); }
        const float rstd = 1.f / sqrtf(wave_sum(s2) * (1.f / D) + LN_EPS);
        GAS unsigned long long* o8 = (GAS unsigned long long*)(XN + (size_t)m * D) + F.lane;
#pragma unroll
        for (int j = 0; j < 4; ++j) { const f32x4 g = *((const GAS f32x4*)P.ln_in_g + F.lane + 64 * j), b = *((const GAS f32x4*)P.ln_in_b + F.lane + 64 * j); const f32x4 y = v[j] * rstd * g + b;
            if (INPROJ_F8_HI - INPROJ_F8_LO < 32) o8[64 * j] = (unsigned long long)pk2(y.x, y.y) | ((unsigned long long)pk2(y.z, y.w) << 32);
            if (INPROJ_F8_HI > INPROJ_F8_LO) *((GAS unsigned*)(P.ws + WS_XN8 + (size_t)m * D) + F.lane + 64 * j) = pg8::pk4_fp8(fminf(fmaxf(y.x * XN8_S, -440.f), 440.f), fminf(fmaxf(y.y * XN8_S, -440.f), 440.f), fminf(fmaxf(y.z * XN8_S, -440.f), 440.f), fminf(fmaxf(y.w * XN8_S, -440.f), 440.f)); }
        if (F.lane == 0) { stats[2 * m] = mean; stats[2 * m + 1] = rstd; }
    }
}
__device__ __forceinline__ void p2_conv(Frame& F, const Ptrs& P) {
    bf16* CB = BUF_CB(P); const bf16* Z = (const bf16*)(P.ws + WS_Z);
    const int gw = F.vcu * NWAVES + F.wave, NGW = F.G * NWAVES, c0 = 16 * F.lane;
    float w0[16], w1[16], w2[16];
#pragma unroll
    for (int i = 0; i < 16; ++i) { w0[i] = P.conv_w[c0 + i]; w1[i] = P.conv_w[D + c0 + i]; w2[i] = P.conv_w[2 * D + c0 + i]; }
    for (int ch = gw; ch < T / 16; ch += NGW) {
        const int r0 = ch * 16; float z2[16], z1[16];
        if ((r0 & (SEQ - 1)) == 0) {
#pragma unroll
            for (int i = 0; i < 16; ++i) { z2[i] = 0.f; z1[i] = 0.f; }
        } else {
            const v4u a0 = *(const GAS v4u*)(Z + (size_t)(r0 - 2) * D + c0), a1 = *(const GAS v4u*)(Z + (size_t)(r0 - 2) * D + c0 + 8), b0 = *(const GAS v4u*)(Z + (size_t)(r0 - 1) * D + c0), b1 = *(const GAS v4u*)(Z + (size_t)(r0 - 1) * D + c0 + 8);
#pragma unroll
            for (int i = 0; i < 4; ++i) { z2[2 * i] = bflo(a0[i]); z2[2 * i + 1] = bfhi(a0[i]); z2[8 + 2 * i] = bflo(a1[i]); z2[8 + 2 * i + 1] = bfhi(a1[i]);
                                          z1[2 * i] = bflo(b0[i]); z1[2 * i + 1] = bfhi(b0[i]); z1[8 + 2 * i] = bflo(b1[i]); z1[8 + 2 * i + 1] = bfhi(b1[i]); }
        }
#pragma unroll 2
        for (int rr = 0; rr < 16; ++rr) { const size_t off = (size_t)(r0 + rr) * D + c0;
            const v4u za = *(const GAS v4u*)(Z + off), zb = *(const GAS v4u*)(Z + off + 8), ca = *(const GAS v4u*)(CB + off), cb = *(const GAS v4u*)(CB + off + 8);
            float zc[16], cv[16];
#pragma unroll
            for (int i = 0; i < 4; ++i) { zc[2 * i] = bflo(za[i]); zc[2 * i + 1] = bfhi(za[i]); zc[8 + 2 * i] = bflo(zb[i]); zc[8 + 2 * i + 1] = bfhi(zb[i]);
                                          cv[2 * i] = bflo(ca[i]); cv[2 * i + 1] = bfhi(ca[i]); cv[8 + 2 * i] = bflo(cb[i]); cv[8 + 2 * i + 1] = bfhi(cb[i]); }
            float u[16];
#pragma unroll
            for (int i = 0; i < 16; ++i) { u[i] = cv[i] * (z2[i] * w0[i] + z1[i] * w1[i] + zc[i] * w2[i]); z2[i] = z1[i]; z1[i] = zc[i]; }
            v4u oa, ob;
#pragma unroll
            for (int i = 0; i < 4; ++i) { oa[i] = pk2(u[2 * i], u[2 * i + 1]); ob[i] = pk2(u[8 + 2 * i], u[8 + 2 * i + 1]); }
            *(GAS v4u*)(CB + off) = oa; *(GAS v4u*)(CB + off + 8) = ob; }
    }
}
__device__ __forceinline__ attn::BlockRef attn_ref(const Ptrs& P, int s, int qb) {
    const int vh = s & 1, m = (s >> 1) & 1, h = (s >> 2) & 3, b = s >> 4;
    attn::BlockRef r; const size_t rowb = (size_t)b * SEQ * D;
    r.Q = (const bf16*)(P.ws + WS_Q) + rowb + (size_t)qb * 256 * D + h * 256 + m * 128;
    r.K = (const bf16*)(P.ws + WS_K) + rowb + h * 256 + m * 128;
    r.V = (const bf16*)(P.ws + WS_V) + rowb + h * 256 + vh * 128;
    r.O = (bf16*)(P.ws + (m ? WS_O1 : WS_XN)) + rowb + (size_t)qb * 256 * D + h * 256 + vh * 128;
    r.P0 = qb * 256; return r;
}
#ifndef P1_ALIGN
#define P1_ALIGN true
#endif
#ifndef P1_SP2
#define P1_SP2 true
#endif
#ifndef ATTN_PAIR
#define ATTN_PAIR 1
#endif
__device__ __forceinline__ attn2::BlockRef attn2_ref(const Ptrs& P, int st, int qb) {
    const int m = st & 1, h = (st >> 1) & 3, b = st >> 3;
    attn2::BlockRef r; const size_t rowb = (size_t)b * SEQ * D;
    r.Q = (const bf16*)(P.ws + WS_Q) + rowb + (size_t)qb * 128 * D + h * 256 + m * 128;
    r.K = (const bf16*)(P.ws + WS_K) + rowb + h * 256 + m * 128;
    r.V = (const bf16*)(P.ws + WS_V) + rowb + h * 256;
    r.O = (bf16*)(P.ws + (m ? WS_O1 : WS_XN)) + rowb + (size_t)qb * 128 * D + h * 256;
    r.P0 = qb * 128; return r;
}
__device__ __forceinline__ void p2_attention2(Frame& F, const Ptrs& P, char* lds) {
    float* btab = (float*)(lds + attn2::BIAS_OFF);
    for (int s2 = F.vcu; s2 < BATCH * 16; s2 += F.G) {
        const int st = s2 >> 1, half = s2 & 1, h = (st >> 1) & 3;
        __syncthreads();
        if (F.tid < attn2::NBIAS) { const int rel = 63 - F.tid; btab[F.tid] = (P.rel_bias[attn2::t5_bucket(rel) * 4 + h] - P.rel_bias[15 * 4 + h]) * (1.0f / attn2::SCALE); }
        __syncthreads();
#define QB_OF(i) (2 * (7 - (i)) + (((7 - (i)) & 1) ^ half))
        const int tid_ = F.wave * 64 + lane_fresh();
        attn2::Seam S; attn2::BlockRef cur = attn2_ref(P, st, QB_OF(0));
        attn2::attn_prime(cur, lds, S, tid_);
#pragma unroll 1
        for (int i = 0; i < 8; ++i) {
            const attn2::BlockRef nxt = (i < 7) ? attn2_ref(P, st, QB_OF(i + 1)) : cur;
            attn2::attn_block(cur, nxt, lds, S, tid_);
            cur = nxt;
        }
#undef QB_OF
    }
}
__device__ __forceinline__ void p2_attention(Frame& F, const Ptrs& P, char* lds) {
    float* btab = (float*)(lds + attn::BIAS_OFF);
    for (int s = F.vcu; s < BATCH * 16; s += F.G) {
        const int h = (s >> 2) & 3;
        __syncthreads();
        if (F.tid < attn::NBIAS) { const int rel = 63 - F.tid; btab[F.tid] = (P.rel_bias[attn::t5_bucket(rel) * 4 + h] - P.rel_bias[15 * 4 + h]) * (1.0f / attn::SCALE); }
        __syncthreads();
        attn::Seam S; attn::BlockRef cur = attn_ref(P, s, 0);
        attn::attn_prime(cur, lds, S);
#pragma unroll 1
        for (int qb = 0; qb < 8; ++qb) {
            const attn::BlockRef nxt = (qb < 7) ? attn_ref(P, s, qb + 1) : cur;
            attn::attn_block(cur, nxt, lds, S);
            cur = nxt;
        }
    }
}
__device__ __forceinline__ void p2b_combine(Frame& F, const Ptrs& P) {
    bf16* O0 = (bf16*)(P.ws + WS_XN); const bf16* O1 = (const bf16*)(P.ws + WS_O1);
    const int gw = F.vcu * NWAVES + F.wave, NGW = F.G * NWAVES, c0 = 16 * F.lane;
    const float l0 = wave_sum(P.lq[F.lane] * P.lk[F.lane] + P.lq[64 + F.lane] * P.lk[64 + F.lane]), l1 = wave_sum(P.lq[128 + F.lane] * P.lk[128 + F.lane] + P.lq[192 + F.lane] * P.lk[192 + F.lane]);
    const float lam = expf(l0) - expf(l1) + LAM_INIT;
    float g[16];
#pragma unroll
    for (int i = 0; i < 16; ++i) g[i] = P.subln_g[(c0 & 255) + i] * (1.f - LAM_INIT);
    for (int m = gw; m < T; m += NGW) { const size_t off = (size_t)m * D + c0;
        const v4u a0 = *(const GAS v4u*)(O0 + off), a1 = *(const GAS v4u*)(O0 + off + 8), b0 = *(const GAS v4u*)(O1 + off), b1 = *(const GAS v4u*)(O1 + off + 8);
        float d[16]; float ss = 0.f;
#pragma unroll
        for (int i = 0; i < 4; ++i) { d[2 * i] = bflo(a0[i]) - lam * bflo(b0[i]); d[2 * i + 1] = bfhi(a0[i]) - lam * bfhi(b0[i]); d[8 + 2 * i] = bflo(a1[i]) - lam * bflo(b1[i]); d[8 + 2 * i + 1] = bfhi(a1[i]) - lam * bfhi(b1[i]); }
#pragma unroll
        for (int i = 0; i < 16; ++i) ss += d[i] * d[i];
        ss += __shfl_xor(ss, 1); ss += __shfl_xor(ss, 2); ss += __shfl_xor(ss, 4); ss += __shfl_xor(ss, 8);
        const float rs = 1.f / sqrtf(ss * (1.f / 256.f) + RMS_EPS);
        v4u oa, ob;
#pragma unroll
        for (int i = 0; i < 4; ++i) { oa[i] = pk2(d[2 * i] * rs * g[2 * i], d[2 * i + 1] * rs * g[2 * i + 1]); ob[i] = pk2(d[8 + 2 * i] * rs * g[8 + 2 * i], d[8 + 2 * i + 1] * rs * g[8 + 2 * i + 1]); }
        *(GAS v4u*)(O0 + off) = oa; *(GAS v4u*)(O0 + off + 8) = ob; }
}
__device__ __forceinline__ void pe_experts(Frame& F, const Ptrs& P) {
    LAS float* scr = (LAS float*)(F.lds + RING_OFF + F.wave * 16384);
    const int gw = F.vcu * NWAVES + F.wave, NGW = F.G * NWAVES;
    bf16* Wgu = (bf16*)(P.ws + WS_WGU); bf16* Wd = (bf16*)(P.ws + WS_WD);
    constexpr int I_GU = (D / 64) * (DE / 32), I_DN = (DE / 64) * (D / 32);
    for (int it = gw; it < NE * (2 * I_GU + I_DN); it += NGW) {
        const int e = it / (2 * I_GU + I_DN); int r = it - e * (2 * I_GU + I_DN);
        if (r < 2 * I_GU) { const int up = r >= I_GU; r -= up * I_GU; const int kb = r / (DE / 32), nb = r % (DE / 32), n0 = 32 * nb;
            if (MOE_FP8) transpose_item8((up ? P.w_up_e : P.w_gate_e) + (size_t)e * D * DE, D, DE, 64 * kb, n0, (unsigned char*)(P.ws + WS_WGU8) + (size_t)e * 1024 * D, 256 * (n0 >> 7) + 128 * up + (n0 & 127), scr, F.lane);
            else transpose_item((up ? P.w_up_e : P.w_gate_e) + (size_t)e * D * DE, D, DE, 64 * kb, n0, Wgu + (size_t)e * 1024 * D, 256 * (n0 >> 7) + 128 * up + (n0 & 127), scr, F.lane); }
        else { r -= 2 * I_GU; const int kb = r / (D / 32), nb = r % (D / 32);
            if (MOE_FP8 && MOE_FP8_DOWN) transpose_item8(P.w_down_e + (size_t)e * DE * D, DE, D, 64 * kb, 32 * nb, (unsigned char*)(P.ws + WS_WD8) + (size_t)e * D * DE, 32 * nb, scr, F.lane);
            else transpose_item(P.w_down_e + (size_t)e * DE * D, DE, D, 64 * kb, 32 * nb, Wd + (size_t)e * D * DE, 32 * nb, scr, F.lane); }
    }
}
__device__ __forceinline__ int rw_index(int idx, int& d, int& o) { d = idx / 36; o = idx - d * 36; const int j = d >> 8, l = (d & 255) >> 2, i = d & 3, c = o >> 2, k = o & 3; return ((((j * 4 + i) * 9 + c) * 64 + l) << 2) + k; }
__device__ __forceinline__ float rw_value(const Ptrs& P, int d, int o) { if (o < 4) return P.w_group[d * 4 + o]; const int g = (o - 4) >> 3, e = (o - 4) & 7; return P.w_sub[((size_t)g * D + d) * 8 + e]; }
__device__ __forceinline__ void rw_build_global(Frame& F, const Ptrs& P) {
    float* img = (float*)(P.ws + WS_RWIMG);
    for (int idx = F.vcu * (NWAVES * 64) + F.tid; idx < D * 36; idx += F.G * NWAVES * 64) { int d, o; const int at = rw_index(idx, d, o); img[at] = rw_value(P, d, o); }
}
__device__ __forceinline__ void rw_fill_lds(Frame& F, const Ptrs& P) {
    const GAS v4u* src = (const GAS v4u*)(P.ws + WS_RWIMG); LAS v4u* dst = (LAS v4u*)(F.lds + RING_OFF);
#pragma unroll 6
    for (int q = F.tid; q < RW_BYTES / 16; q += NWAVES * 64) dst[q] = src[q];
}
__device__ __forceinline__ void p5_ln_route(Frame& F, const Ptrs& P, bool prefilled) {
    LAS float* RW = (LAS float*)(F.lds + RING_OFF);
    LAS int* lcnt = (LAS int*)(F.lds + TAB_OFF);
    LAS float* rs = (LAS float*)(F.lds + RSCR_OFF) + F.wave * 128;
    if (!prefilled) for (int idx = F.tid; idx < D * 36; idx += NWAVES * 64) { const int d = idx / 36, o = idx - d * 36; float w;
        if (o < 4) w = P.w_group[d * 4 + o]; else { const int g = (o - 4) >> 3, e = (o - 4) & 7; w = P.w_sub[((size_t)g * D + d) * 8 + e]; }
        const int j = d >> 8, l = (d & 255) >> 2, i = d & 3, c = o >> 2, k = o & 3;
        RW[((((j * 4 + i) * 9 + c) * 64 + l) << 2) + k] = w; }
    if (F.tid < 32) lcnt[F.tid] = 0;
    __syncthreads();
    float* pre = (float*)(P.ws + WS_PRE); bf16* x1b = (bf16*)(P.ws + WS_XN);
    int* eid = (int*)(P.ws + WS_EID); float* ew = (float*)(P.ws + WS_EW); int* rank = (int*)(P.ws + WS_RANK);
    const int rows_per_wg = T / F.G, rbase = blockIdx.x * rows_per_wg;
    static_assert(pg8::PRE_BF16, "the pipelined LN1/routing loop reads bf16 pre");
    v2u raw[2][4];
#define P5_LOADPAIR(rp_) do { _Pragma("unroll") for (int r = 0; r < 2; ++r) { const GAS v2u* pr = (const GAS v2u*)((const bf16*)pre + (size_t)(rbase + (rp_) + r) * D) + F.lane; \
        _Pragma("unroll") for (int j = 0; j < 4; ++j) raw[r][j] = pr[64 * j]; } } while (0)
    if (F.wave * 2 < rows_per_wg) P5_LOADPAIR(F.wave * 2);
    for (int rp = F.wave * 2; rp < rows_per_wg; rp += NWAVES * 2) {
        f32x4 xv[2][4];
#pragma unroll
        for (int r = 0; r < 2; ++r) { const int row = rbase + rp + r;
            f32x4 v[4]; float s = 0.f;
#pragma unroll
            for (int j = 0; j < 4; ++j) { const v2u w = raw[r][j]; v[j] = (f32x4){bflo(w.x), bfhi(w.x), bflo(w.y), bfhi(w.y)}; s += (v[j].x + v[j].y) + (v[j].z + v[j].w); }
            const float mean = wave_sum_fast(s) * (1.f / D); float s2 = 0.f;
#pragma unroll
            for (int j = 0; j < 4; ++j) { v[j] = v[j] - mean; s2 += (v[j].x * v[j].x + v[j].y * v[j].y) + (v[j].z * v[j].z + v[j].w * v[j].w); }
            const float rstd = 1.f / sqrtf(wave_sum_fast(s2) * (1.f / D) + LN_EPS);
            GAS unsigned long long* o8 = (GAS unsigned long long*)(x1b + (size_t)row * D) + F.lane;
#pragma unroll
            for (int j = 0; j < 4; ++j) { const f32x4 g = *((const GAS f32x4*)P.ln1_g + F.lane + 64 * j), b = *((const GAS f32x4*)P.ln1_b + F.lane + 64 * j); const f32x4 y = v[j] * rstd * g + b;
                xv[r][j] = y; if (!(X1_RECOMPUTE && MOE_FP8)) o8[64 * j] = (unsigned long long)pk2(y.x, y.y) | ((unsigned long long)pk2(y.z, y.w) << 32);
                if (MOE_FP8) *((GAS unsigned*)(P.ws + WS_X18 + (size_t)row * D) + F.lane + 64 * j) = pg8::pk4_fp8(y.x, y.y, y.z, y.w); } }
        if (rp + NWAVES * 2 < rows_per_wg) P5_LOADPAIR(rp + NWAVES * 2);
        f32x4 acc[2][9];
#pragma unroll
        for (int r = 0; r < 2; ++r)
#pragma unroll
            for (int c = 0; c < 9; ++c) acc[r][c] = (f32x4){0.f, 0.f, 0.f, 0.f};
        asm volatile("" ::: "memory"); __builtin_amdgcn_sched_barrier(0);
#pragma unroll
        for (int j = 0; j < 4; ++j)
#pragma unroll
            for (int i = 0; i < 4; ++i)
                { const LAS f32x4* wp = (const LAS f32x4*)(RW + (((j * 4 + i) * 9 * 64 + F.lane) << 2));
#pragma unroll
                  for (int c = 0; c < 9; ++c) { const f32x4 w = wp[c * 64]; acc[0][c] += w * xv[0][j][i]; acc[1][c] += w * xv[1][j][i]; }
                  asm volatile("" : "+v"(acc[0][0]), "+v"(acc[0][1]), "+v"(acc[0][2]), "+v"(acc[0][3]), "+v"(acc[0][4]), "+v"(acc[0][5]), "+v"(acc[0][6]), "+v"(acc[0][7]), "+v"(acc[0][8]) :: "memory");
                  asm volatile("" : "+v"(acc[1][0]), "+v"(acc[1][1]), "+v"(acc[1][2]), "+v"(acc[1][3]), "+v"(acc[1][4]), "+v"(acc[1][5]), "+v"(acc[1][6]), "+v"(acc[1][7]), "+v"(acc[1][8]) :: "memory");
                  __builtin_amdgcn_sched_barrier(0); }
        { float Y[36];
#pragma unroll
          for (int k = 0; k < 36; ++k) { const int i0 = 2 * k, i1 = 2 * k + 1;
              const auto rr = __builtin_amdgcn_permlane32_swap(__float_as_uint(acc[i0 / 36][(i0 % 36) >> 2][i0 & 3]), __float_as_uint(acc[i1 / 36][(i1 % 36) >> 2][i1 & 3]), false, false);
              Y[k] = __uint_as_float(rr[0]) + __uint_as_float(rr[1]); }
          float Z[18];
#pragma unroll
          for (int m = 0; m < 18; ++m) { const auto rr = __builtin_amdgcn_permlane16_swap(__float_as_uint(Y[2 * m]), __float_as_uint(Y[2 * m + 1]), false, false);
              Z[m] = __uint_as_float(rr[0]) + __uint_as_float(rr[1]); }
#pragma unroll
          for (int m = 0; m < 18; ++m) {
              Z[m] += __int_as_float(__builtin_amdgcn_update_dpp(0, __float_as_int(Z[m]), 0x128, 0xf, 0xf, false));
              Z[m] += __int_as_float(__builtin_amdgcn_update_dpp(0, __float_as_int(Z[m]), 0x124, 0xf, 0xf, false));
              Z[m] += __int_as_float(__builtin_amdgcn_update_dpp(0, __float_as_int(Z[m]), 0x122, 0xf, 0xf, false));
              Z[m] += __int_as_float(__builtin_amdgcn_update_dpp(0, __float_as_int(Z[m]), 0x121, 0xf, 0xf, false)); }
          const int rho = F.lane >> 4, pr = ((rho & 1) << 1) | (rho >> 1);
          if ((F.lane & 15) == 0) {
#pragma unroll
              for (int m = 0; m < 18; ++m) { const int idx = 4 * m + pr; rs[idx >= 36 ? idx + 28 : idx] = Z[m]; } } }
        LDS_WAIT(); asm volatile("" ::: "memory");
        if (F.lane < 2) { const int r = F.lane, row = rbase + rp + r; const LAS float* sa = rs + r * 64;
            float gmax = sa[0] + P.b_group[0]; int gi = 0;
            for (int g = 1; g < 4; ++g) { const float v = sa[g] + P.b_group[g]; if (v > gmax) { gmax = v; gi = g; } }
            float z = 0.f;
            for (int g = 0; g < 4; ++g) z += expf(sa[g] + P.b_group[g] - gmax);
            const float gp = 1.f / z;
            const LAS float* sl = sa + 4 + gi * 8; const float* bs = P.b_sub + gi * 8;
            float b0 = sl[0] + bs[0]; int i0 = 0;
            for (int e = 1; e < 8; ++e) { const float v = sl[e] + bs[e]; if (v > b0) { b0 = v; i0 = e; } }
            float b1 = -__builtin_inff(); int i1 = 0;
            for (int e = 0; e < 8; ++e) { const float v = sl[e] + bs[e]; if (e != i0 && v > b1) { b1 = v; i1 = e; } }
            const float e1 = expf(b1 - b0); const float w0 = gp / (1.f + e1), w1 = gp * e1 / (1.f + e1);
            const int ex0 = gi * 8 + i0, ex1 = gi * 8 + i1;
            eid[row * 2] = ex0; eid[row * 2 + 1] = ex1; ew[row * 2] = w0; ew[row * 2 + 1] = w1;
            const int r0 = __hip_atomic_fetch_add(lcnt + ex0, 1, __ATOMIC_RELAXED, __HIP_MEMORY_SCOPE_WORKGROUP), r1 = __hip_atomic_fetch_add(lcnt + ex1, 1, __ATOMIC_RELAXED, __HIP_MEMORY_SCOPE_WORKGROUP);
            if (PLACE_ATOMIC) { LAS int* le = (LAS int*)(F.lds + LEID_OFF) + (rp + r) * 2; LAS int* lr = (LAS int*)(F.lds + LRANK_OFF) + (rp + r) * 2; le[0] = ex0; le[1] = ex1; lr[0] = r0; lr[1] = r1; }
            else { rank[row * 2] = r0; rank[row * 2 + 1] = r1; } }
        LDS_WAIT(); asm volatile("" ::: "memory");
    }
    __syncthreads();
    if (PLACE_ATOMIC) {
        LAS int* wgb = lcnt + 64;
        if (F.tid < 32) wgb[F.tid] = (int)__hip_atomic_fetch_add((unsigned*)F.ctl + CW_GCNT + 64 * F.tid, (unsigned)lcnt[F.tid], __ATOMIC_RELAXED, __HIP_MEMORY_SCOPE_AGENT);
        __syncthreads();
        int* toke = (int*)(P.ws + WS_TOKE);
        for (int a = F.tid; a < rows_per_wg * 2; a += NWAVES * 64) { const int e = ((LAS int*)(F.lds + LEID_OFF))[a], p = wgb[e] + ((LAS int*)(F.lds + LRANK_OFF))[a]; rank[rbase * 2 + a] = p; toke[e * TOKE_CAP + p] = rbase + (a >> 1); }
    } else if (F.tid < 32) ((int*)(P.ws + WS_CNTWG))[blockIdx.x * 32 + F.tid] = lcnt[F.tid];
}
__device__ __forceinline__ void moe_tab(Frame& F, const Ptrs& P) {
    LAS int* tab = (LAS int*)(F.lds + TAB_OFF);
    const int* cntwg = (const int*)(P.ws + WS_CNTWG);
    __syncthreads();
    if (PLACE_ATOMIC) { if (F.tid < 32) tab[96 + F.tid] = (int)__hip_atomic_load((unsigned*)F.ctl + CW_GCNT + 64 * F.tid, __ATOMIC_RELAXED, __HIP_MEMORY_SCOPE_AGENT); }
    else if (F.tid < 32) { int tot = 0, base = 0;
        for (int w = 0; w < F.G; ++w) { const int c = __hip_atomic_load(cntwg + w * 32 + F.tid, __ATOMIC_RELAXED, __HIP_MEMORY_SCOPE_AGENT); base += (w < (int)blockIdx.x) ? c : 0; tot += c; }
        tab[96 + F.tid] = tot; tab[64 + F.tid] = base; }
    __syncthreads();
    if (F.tid == 0) { int s = 0; for (int e = 0; e < 32; ++e) { tab[e] = s; s += (tab[96 + e] + 255) & ~255; } tab[32] = s; }
    __syncthreads();
}
__device__ __forceinline__ void p5b_place(Frame& F, const Ptrs& P) {
    LAS int* tab = (LAS int*)(F.lds + TAB_OFF);
    moe_tab(F, P);
    const int rows_per_wg = T / F.G, rbase = blockIdx.x * rows_per_wg;
    const int* eid = (const int*)(P.ws + WS_EID); const int* rank = (const int*)(P.ws + WS_RANK); int* slot = (int*)(P.ws + WS_SLOT);
    int* tokl = (int*)(P.ws + WS_TOK);
    for (int a = F.tid; a < rows_per_wg * 2; a += NWAVES * 64) { const int ga = rbase * 2 + a, e = eid[ga]; const int s = tab[e] + tab[64 + e] + rank[ga]; slot[ga] = s; tokl[s] = ga >> 1; }
    if (blockIdx.x < 32) { const int e = blockIdx.x; for (int s = tab[e] + tab[96 + e] + F.tid; s < tab[e + 1]; s += NWAVES * 64) tokl[s] = 0; }
    { int* idl = (int*)(P.ws + WS_IDL); for (int s = blockIdx.x * (NWAVES * 64) + F.tid; s < MAXS; s += F.G * NWAVES * 64) idl[s] = s; }
}
#if MOE_Y8
struct P8Row { v4u x[2]; v2u y0[2], y1[2]; float w0, w1; };
__device__ __forceinline__ void p8_load(P8Row& R, const bf16* x1, const bf16* y, const int* slot, const float* ew, int row, int lane, const int* eid, const LAS int* tab) {
    int s0 = slot[row * 2], s1 = slot[row * 2 + 1]; R.w0 = ew[row * 2] * (1.f / pg8::Y8_S); R.w1 = ew[row * 2 + 1] * (1.f / pg8::Y8_S);
    if (PLACE_ATOMIC) { s0 += tab[eid[row * 2]]; s1 += tab[eid[row * 2 + 1]]; }
    const GAS v4u* xr = (const GAS v4u*)(x1 + (size_t)row * D) + lane; const GAS v2u* a = (const GAS v2u*)((const unsigned char*)y + (size_t)s0 * D) + lane; const GAS v2u* b = (const GAS v2u*)((const unsigned char*)y + (size_t)s1 * D) + lane;
    R.x[0] = xr[0]; R.x[1] = xr[64]; R.y0[0] = a[0]; R.y0[1] = a[64]; R.y1[0] = b[0]; R.y1[1] = b[64];
}
__device__ __forceinline__ void y8_unpack(const v2u w, float (&o)[8]) {
    const auto a = __builtin_amdgcn_cvt_pk_f32_fp8((int)w.x, false), b = __builtin_amdgcn_cvt_pk_f32_fp8((int)w.x, true), c = __builtin_amdgcn_cvt_pk_f32_fp8((int)w.y, false), d = __builtin_amdgcn_cvt_pk_f32_fp8((int)w.y, true);
    o[0] = a[0]; o[1] = a[1]; o[2] = b[0]; o[3] = b[1]; o[4] = c[0]; o[5] = c[1]; o[6] = d[0]; o[7] = d[1];
}
#else
struct P8Row { v4u x[2], y0[2], y1[2]; float w0, w1; };
__device__ __forceinline__ void y8_unpack(const v4u w, float (&o)[8]) {
#pragma unroll
    for (int i = 0; i < 4; ++i) { o[2 * i] = bflo(w[i]); o[2 * i + 1] = bfhi(w[i]); }
}
__device__ __forceinline__ void p8_load(P8Row& R, const bf16* x1, const bf16* y, const int* slot, const float* ew, int row, int lane, const int* eid, const LAS int* tab) {
    int s0 = slot[row * 2], s1 = slot[row * 2 + 1]; R.w0 = ew[row * 2]; R.w1 = ew[row * 2 + 1];
    if (PLACE_ATOMIC) { s0 += tab[eid[row * 2]]; s1 += tab[eid[row * 2 + 1]]; }
    const GAS v4u* xr = (const GAS v4u*)(x1 + (size_t)row * D) + lane; const GAS v4u* a = (const GAS v4u*)(y + (size_t)s0 * D) + lane; const GAS v4u* b = (const GAS v4u*)(y + (size_t)s1 * D) + lane;
    R.x[0] = xr[0]; R.x[1] = xr[64]; R.y0[0] = a[0]; R.y0[1] = a[64]; R.y1[0] = b[0]; R.y1[1] = b[64];
}
#endif
__device__ __forceinline__ void p8_finish(const P8Row& R, const Ptrs& P, int row, int lane, bool poison) {
    float v[16]; float s = 0.f; float ya[2][8], yb[2][8]; y8_unpack(R.y0[0], ya[0]); y8_unpack(R.y0[1], ya[1]); y8_unpack(R.y1[0], yb[0]); y8_unpack(R.y1[1], yb[1]);
    float xq[16];
#pragma unroll
    for (int h = 0; h < 2; ++h)
#pragma unroll
        for (int i = 0; i < 4; ++i) { xq[8 * h + 2 * i] = bflo(R.x[h][i]); xq[8 * h + 2 * i + 1] = bfhi(R.x[h][i]); }
    if (X1_RECOMPUTE && MOE_FP8) {
        float t = 0.f;
#pragma unroll
        for (int i = 0; i < 16; ++i) t += xq[i];
        const float mu = wave_sum_fast(t) * (1.f / D); float t2 = 0.f;
#pragma unroll
        for (int i = 0; i < 16; ++i) { xq[i] -= mu; t2 += xq[i] * xq[i]; }
        const float rs = 1.f / sqrtf(wave_sum_fast(t2) * (1.f / D) + LN_EPS);
#pragma unroll
        for (int h = 0; h < 2; ++h)
#pragma unroll
            for (int q = 0; q < 2; ++q) { const int c = 512 * h + 8 * lane + 4 * q; const f32x4 g = *(const GAS f32x4*)(P.ln1_g + c), b = *(const GAS f32x4*)(P.ln1_b + c);
#pragma unroll
                for (int k = 0; k < 4; ++k) xq[8 * h + 4 * q + k] = xq[8 * h + 4 * q + k] * rs * g[k] + b[k]; }
    }
#pragma unroll
    for (int i = 0; i < 16; ++i) v[i] = ALPHA * xq[i] + R.w0 * ya[i >> 3][i & 7] + R.w1 * yb[i >> 3][i & 7];
#pragma unroll
    for (int i = 0; i < 16; ++i) s += v[i];
    const float mean = wave_sum_fast(s) * (1.f / D); float s2 = 0.f;
#pragma unroll
    for (int i = 0; i < 16; ++i) { v[i] -= mean; s2 += v[i] * v[i]; }
    const float rstd = 1.f / sqrtf(wave_sum_fast(s2) * (1.f / D) + LN_EPS);
    const float qn = __builtin_nanf("");
#pragma unroll
    for (int h = 0; h < 2; ++h)
#pragma unroll
        for (int q = 0; q < 2; ++q) { const int c = 512 * h + 8 * lane + 4 * q; const f32x4 g = *(const GAS f32x4*)(P.ln2_g + c), b = *(const GAS f32x4*)(P.ln2_b + c);
            f32x4 o = {v[8 * h + 4 * q] * rstd * g.x + b.x, v[8 * h + 4 * q + 1] * rstd * g.y + b.y, v[8 * h + 4 * q + 2] * rstd * g.z + b.z, v[8 * h + 4 * q + 3] * rstd * g.w + b.w};
            if (poison) o = (f32x4){qn, qn, qn, qn};
            *(GAS f32x4*)(P.out + (size_t)row * D + c) = o; }
}
__device__ __forceinline__ void p8_final(Frame& F, const Ptrs& P, bool poison) {
    const bf16* x1 = (const bf16*)(P.ws + ((X1_RECOMPUTE && MOE_FP8) ? WS_PRE : WS_XN)); const bf16* y = (const bf16*)(P.ws + WS_XG);
    const int* slot = (const int*)(P.ws + (PLACE_ATOMIC ? WS_RANK : WS_SLOT)); const int* eid = (const int*)(P.ws + WS_EID); const LAS int* tab = (const LAS int*)(F.lds + TAB_OFF); const float* ew = (const float*)(P.ws + WS_EW);
    const int rows_per_wg = T / F.G, rbase = blockIdx.x * rows_per_wg;
    P8Row A, B;
    int rr = F.wave; if (rr < rows_per_wg) p8_load(A, x1, y, slot, ew, rbase + rr, F.lane, eid, tab);
    for (; rr < rows_per_wg; rr += 2 * NWAVES) {
        const bool hasB = rr + NWAVES < rows_per_wg; if (hasB) p8_load(B, x1, y, slot, ew, rbase + rr + NWAVES, F.lane, eid, tab);
        p8_finish(A, P, rbase + rr, F.lane, poison);
        if (hasB) { if (rr + 2 * NWAVES < rows_per_wg) p8_load(A, x1, y, slot, ew, rbase + rr + 2 * NWAVES, F.lane, eid, tab); p8_finish(B, P, rbase + rr + NWAVES, F.lane, poison); }
    }
}

constexpr int N_PHASES = 11;
struct Args { Ptrs p; int ph_lo, ph_hi, bar_region, flags; };
__global__ void __launch_bounds__(NWAVES * 64, 2) mega_fwd(Args args) {
    extern __shared__ __attribute__((aligned(16))) unsigned char lds[];
    Frame F; const Ptrs& P = args.p;
    F.lds = (LAS unsigned char*)lds; F.MISC = (volatile LAS unsigned*)(F.lds + MISC_OFF);
    F.wave = __builtin_amdgcn_readfirstlane((int)threadIdx.x >> 6);
#define REFRESH() do { F.lane = lane_fresh(); F.tid = F.wave * 64 + F.lane; } while (0)
    REFRESH();
    F.G = gridDim.x; { const int bx = blockIdx.x; F.vcu = (F.G % 8 == 0) ? (bx % 8) * (F.G / 8) + bx / 8 : bx; }
    F.ctl = (gu32*)(P.ws + WS_CTL);
    for (int u = F.tid; u < (LDS_BYTES - LDSCTL_OFF) / 4; u += NWAVES * 64) ((LAS unsigned*)(F.lds + LDSCTL_OFF))[u] = 0u;
    __syncthreads();
    XcdBarrier bar = xcd_barrier_post((unsigned*)(F.ctl + CW_BAR) + args.bar_region * XCD_BAR_WORDS, F.MISC + 8, F.wave);
    const int lo = args.ph_lo, hi = args.ph_hi;
#ifndef PH_MASK
#define PH_MASK 0x7ff
#endif
#define IN(k) (((PH_MASK >> (k)) & 1) && lo <= (k) && (k) < hi)
#define BOTH(k) (IN(k) && IN((k) + 1))
#define GRID_BAR() xcd_barrier(bar)
    const bool grid_ok = (F.G == 256);

    if (IN(0)) { REFRESH(); p0_prologue(F, P); if (RW_PREFILL) rw_build_global(F, P); if (BOTH(0)) GRID_BAR(); }
    if (IN(1)) { REFRESH();
        constexpr int F8N = INPROJ_F8_HI - INPROJ_F8_LO;
        if (F8N > 0) { pg8::Gemm g{(const pg8::bf16_t*)(P.ws + WS_XN8), (const pg8::bf16_t*)(P.ws + WS_WIN8), T, F8N * 256, D / 2}; pg8::RangeOrder S; S.S.init(T, F8N * 256, F.G, (int)blockIdx.x); S.pn0 = INPROJ_F8_LO;
            pg8::EpiInProj E{(pg8::bf16_t*)(P.ws + WS_Q), (size_t)(WS_K - WS_Q) / 2, BUF_CB(P), (pg8::bf16_t*)(P.ws + WS_Z), BUF_SGA(P), BUF_SGB(P), 1.f / (pg8::F8_WS * XN8_S)};
            pg8::gemm_phase<pg8::EpiInProj, pg8::RangeOrder, true, true, false, true>(F.lds + RING_OFF, F.wave, g, S, E); }
        if (F8N > 0 && F8N < 32) __syncthreads();
        if (F8N < 32) { pg8::Gemm g{(const pg8::bf16_t*)(P.ws + WS_XN), (const pg8::bf16_t*)(P.ws + WS_WIN), T, (32 - F8N) * 256, D}; pg8::RangeOrder S; S.S.init(T, (32 - F8N) * 256, F.G, (int)blockIdx.x); S.pn0 = INPROJ_F8_HI & 31;
            pg8::EpiInProj E{(pg8::bf16_t*)(P.ws + WS_Q), (size_t)(WS_K - WS_Q) / 2, BUF_CB(P), (pg8::bf16_t*)(P.ws + WS_Z), BUF_SGA(P), BUF_SGB(P), 1.f};
            pg8::gemm_phase<pg8::EpiInProj, pg8::RangeOrder, P1_ALIGN, P1_SP2>(F.lds + RING_OFF, F.wave, g, S, E); }
        if (BOTH(1)) GRID_BAR();
    }
    if (IN(2)) { REFRESH(); if (!(args.flags & 2)) p2_conv(F, P); if (ATTN_PAIR) p2_attention2(F, P, (char*)lds + RING_OFF); else p2_attention(F, P, (char*)lds + RING_OFF); if (BOTH(2)) GRID_BAR(); }
    if (IN(3)) { REFRESH(); if (!(args.flags & 1)) p2b_combine(F, P); pe_experts(F, P); if (BOTH(3)) GRID_BAR(); }
    if (IN(4)) { REFRESH();
#if STAGGER_TICKS
        { const unsigned long long t0 = __builtin_amdgcn_s_memrealtime(); const unsigned long long w = (unsigned long long)(blockIdx.x & 3) * STAGGER_TICKS;
          while (__builtin_amdgcn_s_memrealtime() - t0 < w) __builtin_amdgcn_s_sleep(8); }
#endif
        { pg8::Gemm g{(const pg8::bf16_t*)(P.ws + WS_XN), (const pg8::bf16_t*)(P.ws + WS_WA), T, D, D}; pg8::StaticOrder S; S.init(T, D, F.G, (int)blockIdx.x);
          pg8::EpiGate<false> E{BUF_SGA(P), nullptr, (pg8::bf16_t*)(P.ws + WS_O1), P.b_gate};
          pg8::gemm_phase<pg8::EpiGate<false>, pg8::StaticOrder, true, true>(F.lds + RING_OFF, F.wave, g, S, E); }
        __syncthreads();
        { pg8::Gemm g{BUF_CB(P), (const pg8::bf16_t*)(P.ws + WS_WB), T, D, D}; pg8::StaticOrder S; S.init(T, D, F.G, (int)blockIdx.x);
          pg8::EpiGate<true> E{BUF_SGB(P), (const pg8::bf16_t*)(P.ws + WS_O1), (pg8::bf16_t*)(P.ws + WS_Z), P.b_gate + 1024};
          pg8::gemm_phase<pg8::EpiGate<true>, pg8::StaticOrder, true, true>(F.lds + RING_OFF, F.wave, g, S, E); }
        if (BOTH(4)) GRID_BAR();
    }
    if (IN(5)) { REFRESH();
        pg8::Gemm g{(const pg8::bf16_t*)(P.ws + WS_Z), (const pg8::bf16_t*)(P.ws + WS_WO), T, D, D}; pg8::StaticOrder S; S.init(T, D, F.G, (int)blockIdx.x);
        pg8::EpiPre E{P.x, (const float*)(P.ws + WS_STATS), P.ln_in_g, P.ln_in_b, (float*)(P.ws + WS_PRE), ALPHA};
        pg8::gemm_phase<pg8::EpiPre, pg8::StaticOrder, true, true>(F.lds + RING_OFF, F.wave, g, S, E);
        if (RW_PREFILL && BOTH(5) && lo == 0) rw_fill_lds(F, P);
        if (BOTH(5)) GRID_BAR();
    }
    if (IN(6)) { REFRESH(); if (grid_ok) p5_ln_route(F, P, RW_PREFILL && BOTH(5) && lo == 0); if (BOTH(6)) GRID_BAR(); }
    if (IN(7) && !PLACE_ATOMIC) { REFRESH(); if (grid_ok) p5b_place(F, P); if (BOTH(7)) GRID_BAR(); }
    if (IN(8)) { REFRESH();
        if (grid_ok && MOE_FP8) { if (lo == 8 || PLACE_ATOMIC) moe_tab(F, P); pg8::Gemm g{(const pg8::bf16_t*)(P.ws + WS_X18), (const pg8::bf16_t*)(P.ws + WS_WGU8), MAXS, NE * 1024, D / 2};
          pg8::MoeOrder S{(const PG8_LAS int*)(F.lds + TAB_OFF), F.G, F.vcu, (unsigned*)(F.ctl + CW_MOE), 0u, MOE_HANDOFF != 0, (unsigned*)(F.ctl + CW_TMO), 0, -1, F.wave};
          if (MOE_FP8_DOWN) { pg8::EpiMoeUp8 E{(unsigned char*)P.out}; pg8::gemm_phase<pg8::EpiMoeUp8, pg8::MoeOrder, true, true, true, true>(F.lds + RING_OFF, F.wave, g, S, E, (const int*)(P.ws + (PLACE_ATOMIC ? WS_TOKE : WS_TOK))); S.flush(); }
          else { pg8::EpiMoeUp E{(pg8::bf16_t*)P.out, 1.f / pg8::F8_WS}; pg8::gemm_phase<pg8::EpiMoeUp, pg8::MoeOrder, true, true, true, true>(F.lds + RING_OFF, F.wave, g, S, E, (const int*)(P.ws + WS_TOK)); } }
        else if (grid_ok) { if (lo == 8) moe_tab(F, P); pg8::Gemm g{(const pg8::bf16_t*)(P.ws + WS_XN), (const pg8::bf16_t*)(P.ws + WS_WGU), MAXS, NE * 1024, D};
          pg8::MoeOrder S{(const PG8_LAS int*)(F.lds + TAB_OFF), F.G, F.vcu, (unsigned*)(F.ctl + CW_MOE), 0u, MOE_HANDOFF != 0, (unsigned*)(F.ctl + CW_TMO), 0, -1}; pg8::EpiMoeUp E{(pg8::bf16_t*)P.out, 1.f};
          pg8::gemm_phase<pg8::EpiMoeUp, pg8::MoeOrder, true, true, true>(F.lds + RING_OFF, F.wave, g, S, E, (const int*)(P.ws + WS_TOK)); S.flush(); }
        if (BOTH(8)) { if (MOE_HANDOFF) __syncthreads(); else GRID_BAR(); }
    }
    if (IN(9)) { REFRESH();
        if (grid_ok && MOE_FP8 && MOE_FP8_DOWN) { if (lo == 9) moe_tab(F, P); pg8::Gemm g{(const pg8::bf16_t*)P.out, (const pg8::bf16_t*)(P.ws + WS_WD8), MAXS, NE * 1024, DE / 2};
          const bool ho8 = MOE_HANDOFF && lo <= 8;
          pg8::MoeOrder S{(const PG8_LAS int*)(F.lds + TAB_OFF), F.G, ho8 ? (F.vcu + F.G / 2) % F.G : F.vcu, (unsigned*)(F.ctl + CW_MOE), ho8 ? 32u : 0u, false, (unsigned*)(F.ctl + CW_TMO), 0, -1, F.wave};
#if MOE_Y8
          pg8::EpiMoeDown8 E{(unsigned char*)(P.ws + WS_XG), pg8::Y8_S / (pg8::F8_WS * pg8::F8_HS)}; pg8::gemm_phase<pg8::EpiMoeDown8, pg8::MoeOrder, true, true, false, true>(F.lds + RING_OFF, F.wave, g, S, E); }
#else
          pg8::EpiMoeDown E{(pg8::bf16_t*)(P.ws + WS_XG), 1.f / (pg8::F8_WS * pg8::F8_HS)};
          if (MOE_DOWN_GATHER) pg8::gemm_phase<pg8::EpiMoeDown, pg8::MoeOrder, true, true, true, true>(F.lds + RING_OFF, F.wave, g, S, E, (const int*)(P.ws + WS_IDL)); else pg8::gemm_phase<pg8::EpiMoeDown, pg8::MoeOrder, true, true, false, true>(F.lds + RING_OFF, F.wave, g, S, E); }
#endif
        else if (grid_ok) { if (lo == 9) moe_tab(F, P); pg8::Gemm g{(const pg8::bf16_t*)P.out, (const pg8::bf16_t*)(P.ws + WS_WD), MAXS, NE * 1024, DE};
          const bool ho = MOE_HANDOFF && lo <= 8;
          pg8::MoeOrder S{(const PG8_LAS int*)(F.lds + TAB_OFF), F.G, ho ? (F.vcu + F.G / 2) % F.G : F.vcu, (unsigned*)(F.ctl + CW_MOE), ho ? 32u : 0u, false, (unsigned*)(F.ctl + CW_TMO), 0, -1}; pg8::EpiMoeDown E{(pg8::bf16_t*)(P.ws + WS_XG), 1.f};
          pg8::gemm_phase<pg8::EpiMoeDown, pg8::MoeOrder, true, true>(F.lds + RING_OFF, F.wave, g, S, E); }
        if (BOTH(9)) GRID_BAR();
    }
    if (IN(10)) { REFRESH();
        bool poison = !grid_ok || (__hip_atomic_load(F.ctl + CW_BAR + args.bar_region * XCD_BAR_WORDS + XB_TMO, RLX_AGENT) != 0u) || (__hip_atomic_load(F.ctl + CW_TMO, RLX_AGENT) != 0u);
        if (grid_ok) { if (PLACE_ATOMIC && lo == 10) moe_tab(F, P); p8_final(F, P, poison); }
        else { const float qn = __builtin_nanf(""); for (size_t i = (size_t)blockIdx.x * 512 + F.tid; i < (size_t)T * D; i += (size_t)F.G * 512) P.out[i] = qn; }
    }
#undef IN
#undef BOTH
#undef GRID_BAR
}

static void launch_mega(const Ptrs& p, int lo, int hi, int region, int flags, hipStream_t stream) {
    Args a{}; a.p = p; a.ph_lo = lo; a.ph_hi = hi; a.bar_region = region; a.flags = flags;
    hipLaunchKernelGGL(mega_fwd, dim3(256), dim3(NWAVES * 64), LDS_BYTES, stream, a);
}
extern "C" void kernel_launch(void* const* d_in, const int* in_sizes, int n_in, void* d_out, int out_size, void* d_ws, size_t ws_size, hipStream_t stream) {
    static int ready = 0;
    if (ready == 0) {
        ready = 1;
        if (n_in != 24 || out_size != T * D || ws_size < WS_END) { fprintf(stderr, "kernel_launch: unexpected shapes (n_in %d out %d ws %zu)\n", n_in, out_size, ws_size); ready = -1; }
        else if (hipFuncSetAttribute((const void*)mega_fwd, hipFuncAttributeMaxDynamicSharedMemorySize, LDS_BYTES) != hipSuccess) { fprintf(stderr, "kernel_launch: hipFuncSetAttribute failed\n"); ready = -1; }
        (void)hipGetLastError();
    }
    if (ready < 0) return;
    Ptrs p{};
    const float** pp = (const float**)&p;
    for (int i = 0; i < 24; ++i) pp[i] = (const float*)d_in[i];
    p.out = (float*)d_out; p.ws = (unsigned char*)d_ws;
    (void)hipMemsetAsync((char*)d_ws + WS_CTL, 0, CTL_ZERO_BYTES, stream);
    launch_mega(p, 0, N_PHASES, 0, 0, stream);
}
```

```cpp
#ifndef INPROJ_F8_LO
#define INPROJ_F8_LO 24
#endif
#ifndef INPROJ_F8_HI
#define INPROJ_F8_HI 40
#endif
#include <hip/hip_runtime.h>
#include <cstdio>
#include <cstdint>
#include <cmath>
#ifndef MOE_HANDOFF
#define MOE_HANDOFF 0
#endif
#ifndef F8_WGM
#define F8_WGM 8
#endif
#ifndef EPI_PACK
#define EPI_PACK 0
#endif
#ifndef ATTN_PRIO_WIDE
#define ATTN_PRIO_WIDE 1
#endif
#ifndef ATTN_PRIO
#define ATTN_PRIO 1
#endif
#ifndef GB_KEEP
#define GB_KEEP 1
#endif
#ifndef RES_STREAM
#define RES_STREAM 1
#endif
#ifndef G8XN
#define G8XN 1
#endif
#ifndef G8_INV
#define G8_INV 32
#endif
#ifndef GATE_MERGED
#define GATE_MERGED 1
#endif
#ifndef EPI_PIPE
#define EPI_PIPE 1
#endif
#ifndef P10_DEPTH3
#define P10_DEPTH3 1
#endif
#ifndef RW_PREFILL
#define RW_PREFILL 1
#endif
#ifndef HO_PLAINSTORE
#define HO_PLAINSTORE 0
#endif
#ifndef X1_RECOMPUTE
#define X1_RECOMPUTE 1
#endif
#ifndef ATTN_SMLATE
#define ATTN_SMLATE 0
#endif
#ifndef ATTN_DMA
#define ATTN_DMA 0
#endif
#ifndef ATTN_PVSM
#define ATTN_PVSM 0
#endif
#ifndef PLACE_ATOMIC
#define PLACE_ATOMIC 1
#endif
#ifndef STAGGER_TICKS
#define STAGGER_TICKS 0
#endif
#ifndef MOE_Y8
#define MOE_Y8 1
#endif
#ifndef F8_SCALE
#define F8_SCALE 0
#endif
#ifndef F8_CHUNK_SPLIT
#define F8_CHUNK_SPLIT 1
#endif
#ifndef INPROJ_BUFST
#define INPROJ_BUFST 1
#endif
#ifndef LANE_ASM
#define LANE_ASM 1
#endif
#if LANE_ASM
__device__ __forceinline__ int lane_fresh() { int l; asm volatile("v_mbcnt_lo_u32_b32 %0, -1, 0\n\tv_mbcnt_hi_u32_b32 %0, -1, %0" : "=v"(l)); return l; }
#else
__device__ __forceinline__ int lane_fresh() { return (int)threadIdx.x & 63; }
#endif
namespace pg8 {
#define PG8_LAS __attribute__((address_space(3)))
typedef unsigned short bf16_t;
typedef short bf16x8 __attribute__((ext_vector_type(8)));
typedef float f32x4 __attribute__((ext_vector_type(4)));
typedef unsigned u32x4 __attribute__((ext_vector_type(4)));
typedef unsigned u32x2 __attribute__((ext_vector_type(2)));
constexpr int BM = 256, BK = 64, HALF = 128, HTB = HALF * BK * 2  , STAGE_BYTES = 8 * HTB, NXCD = 8, WGM = 8;

__host__ __device__ __forceinline__ int lds_byte(int r, int c) { const int st = (r >> 4) * 2 + (c >> 5), rr = r & 15, cc = c & 31, ob = rr * 64 + cc * 2; return st * 1024 + (ob ^ (((ob >> 9) & 1) << 5)); }
__host__ __device__ __forceinline__ void stage_rc(int b, int& R, int& C) { const int st = b / 1024, sb = b % 1024, swz = sb ^ (((sb >> 9) & 1) << 5); R = (st >> 1) * 16 + swz / 64; C = (st & 1) * 32 + (swz % 64) / 2; }
__host__ __device__ __forceinline__ int perm32(int rho) { const int n = rho >> 4, i = rho & 15; return 8 * (i >> 2) + 4 * n + (i & 3); }

struct Unit { int pm, pn; };
struct Gemm { const bf16_t* A; const bf16_t* Bt; int M, N, K; int lda = 0; int ksplit = 1 << 30; unsigned ajump = 0; const bf16_t* R = nullptr; float ralpha = 0.f; };

struct StaticOrder {
    int nM, nN, nwg, G, c; int wgm = WGM;
    __host__ __device__ void init(int M, int N, int G_, int c_) { nM = M / BM; nN = N / BM; nwg = nM * nN; G = G_; c = c_; }
    __host__ __device__ bool next(int i, Unit& u) const {
        const long L = (long)i * G + c; if (L >= nwg) return false;
        int wgid = (int)L; { const int q = nwg / NXCD, r = nwg % NXCD, xcd = wgid % NXCD, off = wgid / NXCD; wgid = (xcd < r ? xcd * (q + 1) : r * (q + 1) + (xcd - r) * q) + off; }
        const int nig = wgm * nN, gid = wgid / nig, fm = gid * wgm, gsz = (nM - fm) < wgm ? (nM - fm) : wgm;
        u.pm = fm + ((wgid % nig) % gsz); u.pn = (wgid % nig) / gsz; return true;
    }
    __device__ __forceinline__ void a_ready(const Unit&) const {}
    __device__ __forceinline__ void done(const Unit&) const {}
};
struct RangeOrder {
    StaticOrder S; int pn0;
    __device__ __forceinline__ bool next(int i, Unit& u) const { if (!S.next(i, u)) return false; u.pn = (u.pn + pn0) & 31; return true; }
    __device__ __forceinline__ void a_ready(const Unit&) const {}
    __device__ __forceinline__ void done(const Unit&) const {}
};

__device__ __forceinline__ unsigned cvt_pk_bf16(float lo, float hi) { unsigned r; asm volatile("v_cvt_pk_bf16_f32 %0, %1, %2" : "=v"(r) : "v"(lo), "v"(hi)); return r; }
typedef float f32x2 __attribute__((ext_vector_type(2)));
__device__ __forceinline__ u32x4 pack8f(const f32x4 a, const f32x4 b) { u32x4 w; w.x = cvt_pk_bf16(a[0], a[1]); w.y = cvt_pk_bf16(a[2], a[3]); w.z = cvt_pk_bf16(b[0], b[1]); w.w = cvt_pk_bf16(b[2], b[3]); return w; }
__device__ __forceinline__ void unpack8f(const u32x4 w, f32x4& a, f32x4& b) {
    a[0] = __uint_as_float(w.x << 16); a[1] = __uint_as_float(w.x & 0xffff0000u); a[2] = __uint_as_float(w.y << 16); a[3] = __uint_as_float(w.y & 0xffff0000u);
    b[0] = __uint_as_float(w.z << 16); b[1] = __uint_as_float(w.z & 0xffff0000u); b[2] = __uint_as_float(w.w << 16); b[3] = __uint_as_float(w.w & 0xffff0000u); }
__device__ __forceinline__ float sigmoidf_fast(float x) { return __builtin_amdgcn_rcpf(1.0f + __expf(-x)); }

struct EpiInProj {
    static constexpr bool PERM = true, AFTER_DRAIN = false;
    bf16_t* qkv; size_t stride;
    bf16_t* cb;
    bf16_t* z;
    bf16_t* sga; bf16_t* sgb;
    float sc;
#if INPROJ_BUFST
    __device__ __forceinline__ void operator()(const f32x4 (&acc)[2][2][4][2], const Unit& u, int wr, int wc, int, int) const {
        const int pn = u.pn, l = lane_fresh(); const unsigned voff = (unsigned)((wr * 64 + (l & 15)) * 1024 + wc * 32 + 8 * (l >> 4)) * 2u;
        if (G8XN && pn >= 24) {
            unsigned char* bp = (unsigned char*)(pn < 28 ? sga : sgb) + ((size_t)u.pm * BM * 1024 + (size_t)(pn & 3) * BM); const unsigned vo8 = voff >> 1; const float s16 = sc * (float)G8_INV;
#pragma unroll
            for (int ai = 0; ai < 2; ++ai)
#pragma unroll
                for (int m = 0; m < 4; ++m)
#pragma unroll
                    for (int bj = 0; bj < 2; ++bj) { u32x2 w = {0u, 0u};
#pragma unroll
                        for (int i = 0; i < 4; ++i) { w.x = __builtin_amdgcn_cvt_pk_u8_f32(fminf(fmaxf(fmaf(acc[ai][bj][m][0][i], s16, 128.5f), 0.f), 255.f), i, w.x); w.y = __builtin_amdgcn_cvt_pk_u8_f32(fminf(fmaxf(fmaf(acc[ai][bj][m][1][i], s16, 128.5f), 0.f), 255.f), i, w.y); }
                        *(u32x2*)(bp + (vo8 + (unsigned)((ai * HALF + m * 16) * 1024 + bj * HALF))) = w; }
        } else if (pn < 16 || pn >= 24) {
            char* bp = (char*)((pn < 12) ? qkv + (size_t)(pn >> 2) * stride : (pn < 16 ? cb : (pn < 28 ? sga : sgb))) + ((size_t)u.pm * BM * 1024 + (size_t)(pn & 3) * BM) * 2;
#pragma unroll
            for (int ai = 0; ai < 2; ++ai)
#pragma unroll
                for (int m = 0; m < 4; ++m)
#pragma unroll
                    for (int bj = 0; bj < 2; ++bj) *(u32x4*)(bp + (voff + (unsigned)((ai * HALF + m * 16) * 1024 + bj * HALF) * 2u)) = pack8f(acc[ai][bj][m][0] * sc, acc[ai][bj][m][1] * sc);
        } else {
            char* bp = (char*)z + ((size_t)u.pm * BM * 1024 + (size_t)(pn - 16) * HALF) * 2; const float s2 = sc * sc;
#pragma unroll
            for (int ai = 0; ai < 2; ++ai)
#pragma unroll
                for (int m = 0; m < 4; ++m)
                    *(u32x4*)(bp + (voff + (unsigned)((ai * HALF + m * 16) * 1024) * 2u)) = pack8f(acc[ai][0][m][0] * acc[ai][1][m][0] * s2, acc[ai][0][m][1] * acc[ai][1][m][1] * s2);
        }
    }
#else
    __device__ __forceinline__ void operator()(const f32x4 (&acc)[2][2][4][2], const Unit& u, int wr, int wc, int fr, int fq) const {
        const int row0 = u.pm * BM + wr * 64 + fr; const int pn = u.pn;
        if (pn < 16 || pn >= 24) {
            bf16_t* base = (pn < 12) ? qkv + (size_t)(pn >> 2) * stride : (pn < 16 ? cb : (pn < 28 ? sga : sgb)); const int col0 = (pn & 3) * BM + wc * 32 + 8 * fq;
#pragma unroll
            for (int ai = 0; ai < 2; ++ai)
#pragma unroll
                for (int m = 0; m < 4; ++m) { bf16_t* rowp = base + (size_t)(row0 + ai * HALF + m * 16) * 1024 + col0;
#pragma unroll
                    for (int bj = 0; bj < 2; ++bj) *(u32x4*)(rowp + bj * HALF) = pack8f(acc[ai][bj][m][0] * sc, acc[ai][bj][m][1] * sc); }
        } else {
            const int col0 = (pn - 16) * HALF + wc * 32 + 8 * fq; const float s2 = sc * sc;
#pragma unroll
            for (int ai = 0; ai < 2; ++ai)
#pragma unroll
                for (int m = 0; m < 4; ++m) { bf16_t* rowp = z + (size_t)(row0 + ai * HALF + m * 16) * 1024 + col0;
                    *(u32x4*)rowp = pack8f(acc[ai][0][m][0] * acc[ai][1][m][0] * s2, acc[ai][0][m][1] * acc[ai][1][m][1] * s2); }
        }
    }
#endif
};
template <bool SECOND> struct EpiGate {
    static constexpr bool PERM = true, AFTER_DRAIN = false;
    const bf16_t* gate; const bf16_t* prev; bf16_t* out; const float* gbias;
    __device__ __forceinline__ void operator()(const f32x4 (&acc)[2][2][4][2], const Unit& u, int wr, int wc, int fr, int fq) const {
        const int row0 = u.pm * BM + wr * 64 + fr; const int col0 = u.pn * BM + wc * 32 + 8 * fq;
        f32x4 bv[2][2];
#pragma unroll
        for (int bj = 0; bj < 2; ++bj)
#pragma unroll
            for (int n = 0; n < 2; ++n) bv[bj][n] = *(const f32x4*)(gbias + col0 + bj * HALF + 4 * n);
#if EPI_PIPE
        u32x4 gq[2][2][2], pq[2][2][2];
#define EG_LOAD(b_, k_) do { _Pragma("unroll") for (int mm = 0; mm < 2; ++mm) { const size_t o_ = (size_t)(row0 + ((k_) >> 1) * HALF + (2 * ((k_) & 1) + mm) * 16) * 1024 + col0; \
            _Pragma("unroll") for (int bj = 0; bj < 2; ++bj) { gq[b_][mm][bj] = *(const u32x4*)(gate + o_ + bj * HALF); if (SECOND) pq[b_][mm][bj] = *(const u32x4*)(prev + o_ + bj * HALF); } } } while (0)
#define EG_DO(b_, k_) do { _Pragma("unroll") for (int mm = 0; mm < 2; ++mm) { const int ai = (k_) >> 1, m = 2 * ((k_) & 1) + mm; const size_t off = (size_t)(row0 + ai * HALF + m * 16) * 1024 + col0; \
            _Pragma("unroll") for (int bj = 0; bj < 2; ++bj) { f32x4 g0, g1; unpack8f(gq[b_][mm][bj], g0, g1); g0 += bv[bj][0]; g1 += bv[bj][1]; \
                _Pragma("unroll") for (int i = 0; i < 4; ++i) { g0[i] = sigmoidf_fast(g0[i]); g1[i] = sigmoidf_fast(g1[i]); } \
                f32x4 v0 = acc[ai][bj][m][0] * g0, v1 = acc[ai][bj][m][1] * g1; \
                if (SECOND) { f32x4 p0, p1; unpack8f(pq[b_][mm][bj], p0, p1); v0 += p0; v1 += p1; } \
                *(u32x4*)(out + off + bj * HALF) = pack8f(v0, v1); } } } while (0)
        EG_LOAD(0, 0); EG_LOAD(1, 1);
        EG_DO(0, 0); EG_LOAD(0, 2);
        EG_DO(1, 1); EG_LOAD(1, 3);
        EG_DO(0, 2);
        EG_DO(1, 3);
#undef EG_LOAD
#undef EG_DO
#else
#pragma unroll
        for (int ai = 0; ai < 2; ++ai)
#pragma unroll
            for (int m = 0; m < 4; ++m) { const size_t off = (size_t)(row0 + ai * HALF + m * 16) * 1024 + col0;
#pragma unroll
                for (int bj = 0; bj < 2; ++bj) { f32x4 g0, g1; unpack8f(*(const u32x4*)(gate + off + bj * HALF), g0, g1); g0 += bv[bj][0]; g1 += bv[bj][1];
#pragma unroll
                    for (int i = 0; i < 4; ++i) { g0[i] = sigmoidf_fast(g0[i]); g1[i] = sigmoidf_fast(g1[i]); }
                    f32x4 v0 = acc[ai][bj][m][0] * g0, v1 = acc[ai][bj][m][1] * g1;
                    if (SECOND) { f32x4 p0, p1; unpack8f(*(const u32x4*)(prev + off + bj * HALF), p0, p1); v0 += p0; v1 += p1; }
                    *(u32x4*)(out + off + bj * HALF) = pack8f(v0, v1); } }
#endif
    }
};
struct EpiGateM {
    static constexpr bool PERM = true, AFTER_DRAIN = false;
    const bf16_t* ga; const bf16_t* gb; bf16_t* out; const float* bias;
    static __device__ __forceinline__ void dec8(const u32x2 w, const f32x4 b0, const f32x4 b1, f32x4& o0, f32x4& o1) {
#pragma unroll
        for (int i = 0; i < 4; ++i) { o0[i] = fmaf((float)((w.x >> (8 * i)) & 0xffu), 1.f / G8_INV, b0[i] - 128.f / G8_INV); o1[i] = fmaf((float)((w.y >> (8 * i)) & 0xffu), 1.f / G8_INV, b1[i] - 128.f / G8_INV); }
    }
    __device__ __forceinline__ void mid(f32x4 (&acc)[2][2][4][2], const Unit& u, int wr, int wc, u32x2 (&keep)[8][2]) const {
        const int l = lane_fresh(), fr = l & 15, fq = l >> 4; const unsigned voff = (unsigned)((wr * 64 + fr) * 1024 + wc * 32 + 8 * fq) * 2u; const int col0 = u.pn * BM + wc * 32 + 8 * fq;
        constexpr int ES = G8XN ? 1 : 2;
        const char* pa = (const char*)ga + ((size_t)u.pm * BM * 1024 + (size_t)u.pn * BM) * ES; const char* pb = (const char*)gb + ((size_t)u.pm * BM * 1024 + (size_t)u.pn * BM) * ES; const unsigned vo = G8XN ? voff >> 1 : voff;
        f32x4 ba[2][2], bb[2][2];
#pragma unroll
        for (int bj = 0; bj < 2; ++bj)
#pragma unroll
            for (int n = 0; n < 2; ++n) { ba[bj][n] = *(const f32x4*)(bias + col0 + bj * HALF + 4 * n); bb[bj][n] = *(const f32x4*)(bias + 1024 + col0 + bj * HALF + 4 * n); }
#if G8XN
        u32x2 qa[3][2];
#define GM_LOAD(b_, k_) do { const unsigned o_ = vo + (unsigned)((((k_) >> 2) * HALF + ((k_) & 3) * 16) * 1024); _Pragma("unroll") for (int bj = 0; bj < 2; ++bj) { qa[b_][bj] = *(const u32x2*)(pa + (o_ + bj * HALF)); keep[k_][bj] = *(const u32x2*)(pb + (o_ + bj * HALF)); } } while (0)
#define GM_UNPACK(b_, bj) dec8(qa[b_][bj], ba[bj][0], ba[bj][1], a0, a1); dec8(keep[kk_][bj], bb[bj][0], bb[bj][1], b0, b1)
#else
        u32x4 qa[3][2], qb[3][2];
#define GM_LOAD(b_, k_) do { const unsigned o_ = voff + (unsigned)((((k_) >> 2) * HALF + ((k_) & 3) * 16) * 1024) * 2u; _Pragma("unroll") for (int bj = 0; bj < 2; ++bj) { qa[b_][bj] = *(const u32x4*)(pa + (o_ + bj * HALF * 2)); qb[b_][bj] = *(const u32x4*)(pb + (o_ + bj * HALF * 2)); } } while (0)
#define GM_UNPACK(b_, bj) unpack8f(qa[b_][bj], a0, a1); unpack8f(qb[b_][bj], b0, b1); a0 += ba[bj][0]; a1 += ba[bj][1]; b0 += bb[bj][0]; b1 += bb[bj][1]
#endif
#define GM_DO(b_, k_) do { constexpr int ai = (k_) >> 2, m = (k_) & 3, kk_ = (k_); _Pragma("unroll") for (int bj = 0; bj < 2; ++bj) { f32x4 a0, a1, b0, b1; GM_UNPACK(b_, bj); \
            _Pragma("unroll") for (int i = 0; i < 4; ++i) { a0[i] = sigmoidf_fast(a0[i]) * (1.0f + __expf(-fmaxf(b0[i], -30.f))); a1[i] = sigmoidf_fast(a1[i]) * (1.0f + __expf(-fmaxf(b1[i], -30.f))); } \
            acc[ai][bj][m][0] *= a0; acc[ai][bj][m][1] *= a1; } asm volatile("" ::: "memory"); } while (0)
        GM_LOAD(0, 0); GM_LOAD(1, 1); GM_LOAD(2, 2); asm volatile("" ::: "memory");
        GM_DO(0, 0); GM_LOAD(0, 3); GM_DO(1, 1); GM_LOAD(1, 4); GM_DO(2, 2); GM_LOAD(2, 5);
        GM_DO(0, 3); GM_LOAD(0, 6); GM_DO(1, 4); GM_LOAD(1, 7); GM_DO(2, 5); GM_DO(0, 6); GM_DO(1, 7);
#undef GM_LOAD
#undef GM_DO
#undef GM_UNPACK
    }
    __device__ __forceinline__ void fin(const f32x4 (&acc)[2][2][4][2], const Unit& u, int wr, int wc, const u32x2 (&keep)[8][2]) const {
        const int l = lane_fresh(), fr = l & 15, fq = l >> 4; const unsigned voff = (unsigned)((wr * 64 + fr) * 1024 + wc * 32 + 8 * fq) * 2u; const int col0 = u.pn * BM + wc * 32 + 8 * fq;
        char* po = (char*)out + ((size_t)u.pm * BM * 1024 + (size_t)u.pn * BM) * 2;
        f32x4 bb[2][2];
#pragma unroll
        for (int bj = 0; bj < 2; ++bj)
#pragma unroll
            for (int n = 0; n < 2; ++n) bb[bj][n] = *(const f32x4*)(bias + 1024 + col0 + bj * HALF + 4 * n);
#pragma unroll
        for (int k = 0; k < 8; ++k) { const int ai = k >> 2, m = k & 3; const unsigned o_ = voff + (unsigned)((ai * HALF + m * 16) * 1024) * 2u;
#pragma unroll
            for (int bj = 0; bj < 2; ++bj) { f32x4 b0, b1; dec8(keep[k][bj], bb[bj][0], bb[bj][1], b0, b1);
#pragma unroll
                for (int i = 0; i < 4; ++i) { b0[i] = sigmoidf_fast(fmaxf(b0[i], -30.f)); b1[i] = sigmoidf_fast(fmaxf(b1[i], -30.f)); }
                *(u32x4*)(po + (o_ + bj * HALF * 2)) = pack8f(acc[ai][bj][m][0] * b0, acc[ai][bj][m][1] * b1); } }
    }
    __device__ __forceinline__ void operator()(const f32x4 (&acc)[2][2][4][2], const Unit& u, int wr, int wc, int, int) const {
        const int l = lane_fresh(), fr = l & 15, fq = l >> 4; const unsigned voff = (unsigned)((wr * 64 + fr) * 1024 + wc * 32 + 8 * fq) * 2u; const int col0 = u.pn * BM + wc * 32 + 8 * fq;
        constexpr int ES = G8XN ? 1 : 2; const unsigned vo = G8XN ? voff >> 1 : voff;
        const char* pb = (const char*)gb + ((size_t)u.pm * BM * 1024 + (size_t)u.pn * BM) * ES; char* po = (char*)out + ((size_t)u.pm * BM * 1024 + (size_t)u.pn * BM) * 2;
        f32x4 bb[2][2];
#pragma unroll
        for (int bj = 0; bj < 2; ++bj)
#pragma unroll
            for (int n = 0; n < 2; ++n) bb[bj][n] = *(const f32x4*)(bias + 1024 + col0 + bj * HALF + 4 * n);
#if G8XN
        u32x2 qb[4][2];
#define GE_LOAD(b_, k_) do { const unsigned o_ = vo + (unsigned)((((k_) >> 2) * HALF + ((k_) & 3) * 16) * 1024); _Pragma("unroll") for (int bj = 0; bj < 2; ++bj) qb[b_][bj] = *(const u32x2*)(pb + (o_ + bj * HALF)); } while (0)
#define GE_UNPACK(b_, bj) dec8(qb[b_][bj], bb[bj][0], bb[bj][1], b0, b1)
#else
        u32x4 qb[4][2];
#define GE_LOAD(b_, k_) do { const unsigned o_ = voff + (unsigned)((((k_) >> 2) * HALF + ((k_) & 3) * 16) * 1024) * 2u; _Pragma("unroll") for (int bj = 0; bj < 2; ++bj) qb[b_][bj] = *(const u32x4*)(pb + (o_ + bj * HALF * 2)); } while (0)
#define GE_UNPACK(b_, bj) unpack8f(qb[b_][bj], b0, b1); b0 += bb[bj][0]; b1 += bb[bj][1]
#endif
#define GE_DO(b_, k_) do { constexpr int ai = (k_) >> 2, m = (k_) & 3; const unsigned o_ = voff + (unsigned)((ai * HALF + m * 16) * 1024) * 2u; _Pragma("unroll") for (int bj = 0; bj < 2; ++bj) { f32x4 b0, b1; GE_UNPACK(b_, bj); \
            _Pragma("unroll") for (int i = 0; i < 4; ++i) { b0[i] = sigmoidf_fast(fmaxf(b0[i], -30.f)); b1[i] = sigmoidf_fast(fmaxf(b1[i], -30.f)); } \
            *(u32x4*)(po + (o_ + bj * HALF * 2)) = pack8f(acc[ai][bj][m][0] * b0, acc[ai][bj][m][1] * b1); } } while (0)
        GE_LOAD(0, 0); GE_LOAD(1, 1); GE_LOAD(2, 2); GE_LOAD(3, 3);
        GE_DO(0, 0); GE_LOAD(0, 4); GE_DO(1, 1); GE_LOAD(1, 5); GE_DO(2, 2); GE_LOAD(2, 6); GE_DO(3, 3); GE_LOAD(3, 7);
        GE_DO(0, 4); GE_DO(1, 5); GE_DO(2, 6); GE_DO(3, 7);
#undef GE_LOAD
#undef GE_DO
#undef GE_UNPACK
    }
};
typedef unsigned u32x2 __attribute__((ext_vector_type(2)));
#ifndef PRE_BF16_KNOB
#define PRE_BF16_KNOB 1
#endif
constexpr bool PRE_BF16 = PRE_BF16_KNOB;
struct EpiPre {
    static constexpr bool PERM = false, AFTER_DRAIN = false;
    const float* x; const float* stats; const float* g; const float* b; float* pre; float alpha;
    __device__ __forceinline__ void operator()(const f32x4 (&acc)[2][2][4][2], const Unit& u, int wr, int wc, int fr, int fq) const {
        const int row0 = u.pm * BM + wr * 64 + fr; const int col0 = u.pn * BM + wc * 32 + 4 * fq;
#if EPI_PIPE
#if EPI_PACK
        u32x2 pk[2][2][4][2];
#pragma unroll
        for (int ai = 0; ai < 2; ++ai)
#pragma unroll
            for (int bj = 0; bj < 2; ++bj)
#pragma unroll
                for (int m = 0; m < 4; ++m)
#pragma unroll
                    for (int n = 0; n < 2; ++n) { pk[ai][bj][m][n].x = cvt_pk_bf16(acc[ai][bj][m][n][0], acc[ai][bj][m][n][1]); pk[ai][bj][m][n].y = cvt_pk_bf16(acc[ai][bj][m][n][2], acc[ai][bj][m][n][3]); }
#define EP_ACC(ai_, bj_, m_, n_) ((f32x4){__uint_as_float(pk[ai_][bj_][m_][n_].x << 16), __uint_as_float(pk[ai_][bj_][m_][n_].x & 0xffff0000u), __uint_as_float(pk[ai_][bj_][m_][n_].y << 16), __uint_as_float(pk[ai_][bj_][m_][n_].y & 0xffff0000u)})
        constexpr int NB = 6;
#else
#define EP_ACC(ai_, bj_, m_, n_) acc[ai_][bj_][m_][n_]
        constexpr int NB = 3;
#endif
        float mus[NB], rss[NB];
        f32x4 gq[2][2], bq[2][2];
#pragma unroll
        for (int bj = 0; bj < 2; ++bj)
#pragma unroll
            for (int n = 0; n < 2; ++n) { const int c = bj * HALF + n * 16; gq[bj][n] = *(const f32x4*)(g + col0 + c) * alpha; bq[bj][n] = *(const f32x4*)(b + col0 + c) * alpha; }
        f32x4 xq[NB][2][2];
#define EP_LOAD(b_, k_) do { const int r_ = row0 + ((k_) >> 2) * HALF + ((k_) & 3) * 16; mus[b_] = stats[2 * r_]; rss[b_] = stats[2 * r_ + 1]; const size_t o_ = (size_t)r_ * 1024 + col0; _Pragma("unroll") for (int bj = 0; bj < 2; ++bj) _Pragma("unroll") for (int n = 0; n < 2; ++n) xq[b_][bj][n] = *(const f32x4*)(x + o_ + bj * HALF + n * 16); } while (0)
#define EP_DO(b_, k_) do { constexpr int ai = (k_) >> 2, m = (k_) & 3; const size_t off = (size_t)(row0 + ai * HALF + m * 16) * 1024 + col0; \
            _Pragma("unroll") for (int bj = 0; bj < 2; ++bj) _Pragma("unroll") for (int n = 0; n < 2; ++n) { const int c = bj * HALF + n * 16; \
                const f32x4 o = ((xq[b_][bj][n] - mus[b_]) * rss[b_]) * gq[bj][n] + bq[bj][n] + EP_ACC(ai, bj, m, n); \
                if constexpr (PRE_BF16) { u32x2 w; w.x = cvt_pk_bf16(o[0], o[1]); w.y = cvt_pk_bf16(o[2], o[3]); *(u32x2*)((bf16_t*)pre + off + c) = w; } else *(f32x4*)(pre + off + c) = o; } } while (0)
#if EPI_PACK
        EP_LOAD(0, 0); EP_LOAD(1, 1); EP_LOAD(2, 2); EP_LOAD(3, 3); EP_LOAD(4, 4); EP_LOAD(5, 5);
        EP_DO(0, 0); EP_LOAD(0, 6); EP_DO(1, 1); EP_LOAD(1, 7); EP_DO(2, 2); EP_DO(3, 3); EP_DO(4, 4); EP_DO(5, 5); EP_DO(0, 6); EP_DO(1, 7);
#else
        EP_LOAD(0, 0); EP_LOAD(1, 1); EP_LOAD(2, 2);
        EP_DO(0, 0); EP_LOAD(0, 3); EP_DO(1, 1); EP_LOAD(1, 4); EP_DO(2, 2); EP_LOAD(2, 5);
        EP_DO(0, 3); EP_LOAD(0, 6); EP_DO(1, 4); EP_LOAD(1, 7); EP_DO(2, 5); EP_DO(0, 6); EP_DO(1, 7);
#endif
#undef EP_LOAD
#undef EP_DO
#undef EP_ACC
#else
#pragma unroll
        for (int ai = 0; ai < 2; ++ai)
#pragma unroll
            for (int m = 0; m < 4; ++m) { const int row = row0 + ai * HALF + m * 16; const size_t off = (size_t)row * 1024 + col0;
                const float mu = stats[2 * row], rs = stats[2 * row + 1];
#pragma unroll
                for (int bj = 0; bj < 2; ++bj)
#pragma unroll
                    for (int n = 0; n < 2; ++n) { const int c = bj * HALF + n * 16; const f32x4 xv = *(const f32x4*)(x + off + c), gv = *(const f32x4*)(g + col0 + c), bv = *(const f32x4*)(b + col0 + c);
                        const f32x4 o = ((xv - mu) * rs * gv + bv) * alpha + acc[ai][bj][m][n];
                        if constexpr (PRE_BF16) { u32x2 w; w.x = cvt_pk_bf16(o[0], o[1]); w.y = cvt_pk_bf16(o[2], o[3]); *(u32x2*)((bf16_t*)pre + off + c) = w; } else *(f32x4*)(pre + off + c) = o; } }
#endif
    }
};
struct EpiStoreBf16 {
    static constexpr bool PERM = true, AFTER_DRAIN = false;
    bf16_t* out;
    __device__ __forceinline__ void operator()(const f32x4 (&acc)[2][2][4][2], const Unit& u, int wr, int wc, int, int) const {
        const int l = lane_fresh(), fr = l & 15, fq = l >> 4; const unsigned voff = (unsigned)((wr * 64 + fr) * 1024 + wc * 32 + 8 * fq) * 2u;
        char* po = (char*)out + ((size_t)u.pm * BM * 1024 + (size_t)u.pn * BM) * 2;
#pragma unroll
        for (int ai = 0; ai < 2; ++ai)
#pragma unroll
            for (int m = 0; m < 4; ++m)
#pragma unroll
                for (int bj = 0; bj < 2; ++bj) *(u32x4*)(po + (voff + (unsigned)((ai * HALF + m * 16) * 1024 + bj * HALF) * 2u)) = pack8f(acc[ai][bj][m][0], acc[ai][bj][m][1]);
    }
};
struct EpiPre2 {
    static constexpr bool PERM = true, AFTER_DRAIN = false;
    const bf16_t* xn; bf16_t* pre; float alpha;
    __device__ __forceinline__ void operator()(const f32x4 (&acc)[2][2][4][2], const Unit& u, int wr, int wc, int, int) const {
        const int l = lane_fresh(), fr = l & 15, fq = l >> 4; const unsigned voff = (unsigned)((wr * 64 + fr) * 1024 + wc * 32 + 8 * fq) * 2u;
        const char* px = (const char*)xn + ((size_t)u.pm * BM * 1024 + (size_t)u.pn * BM) * 2; char* po = (char*)pre + ((size_t)u.pm * BM * 1024 + (size_t)u.pn * BM) * 2;
        u32x4 q[4][2];
#define E2_LOAD(b_, k_) do { const unsigned o_ = voff + (unsigned)((((k_) >> 2) * HALF + ((k_) & 3) * 16) * 1024) * 2u; _Pragma("unroll") for (int bj = 0; bj < 2; ++bj) q[b_][bj] = *(const u32x4*)(px + (o_ + bj * HALF * 2)); } while (0)
#define E2_DO(b_, k_) do { constexpr int ai = (k_) >> 2, m = (k_) & 3; const unsigned o_ = voff + (unsigned)((ai * HALF + m * 16) * 1024) * 2u; _Pragma("unroll") for (int bj = 0; bj < 2; ++bj) { f32x4 x0, x1; unpack8f(q[b_][bj], x0, x1); \
            *(u32x4*)(po + (o_ + bj * HALF * 2)) = pack8f(x0 * alpha + acc[ai][bj][m][0], x1 * alpha + acc[ai][bj][m][1]); } } while (0)
        E2_LOAD(0, 0); E2_LOAD(1, 1); E2_LOAD(2, 2); E2_LOAD(3, 3);
        E2_DO(0, 0); E2_LOAD(0, 4); E2_DO(1, 1); E2_LOAD(1, 5); E2_DO(2, 2); E2_LOAD(2, 6); E2_DO(3, 3); E2_LOAD(3, 7);
        E2_DO(0, 4); E2_DO(1, 5); E2_DO(2, 6); E2_DO(3, 7);
#undef E2_LOAD
#undef E2_DO
    }
};
struct EpiMoeUp {
    static constexpr bool PERM = true, AFTER_DRAIN = false;
    bf16_t* h; float sc;
    __device__ __forceinline__ void operator()(const f32x4 (&acc)[2][2][4][2], const Unit& u, int wr, int wc, int fr, int fq) const {
        const int row0 = u.pm * BM + wr * 64 + fr; const int col0 = (u.pn & 3) * HALF + wc * 32 + 8 * fq;
#pragma unroll
        for (int ai = 0; ai < 2; ++ai)
#pragma unroll
            for (int m = 0; m < 4; ++m) { f32x4 v[2];
#pragma unroll
                for (int n = 0; n < 2; ++n)
#pragma unroll
                    for (int i = 0; i < 4; ++i) { const float gv = acc[ai][0][m][n][i] * sc; v[n][i] = gv * sigmoidf_fast(gv) * (acc[ai][1][m][n][i] * sc); }
                bf16_t* dst = h + (size_t)(row0 + ai * HALF + m * 16) * 512 + col0; const u32x4 w = pack8f(v[0], v[1]);
                if (MOE_HANDOFF) asm volatile("global_store_dwordx4 %0, %1, off sc1\n\ts_nop 1" :: "v"(dst), "v"(w) : "memory"); else *(u32x4*)dst = w; }
    }
};
#ifndef MOE_FP8
#define MOE_FP8 1
#endif
#ifndef MOE_FP8_DOWN
#define MOE_FP8_DOWN 1
#endif
#ifndef MOE_DOWN_GATHER
#define MOE_DOWN_GATHER 0
#endif
constexpr float F8_WS = 64.f, F8_HS = 8.f;
__device__ __forceinline__ unsigned pk4_fp8(float a, float b, float c, float d) { int w = __builtin_amdgcn_cvt_pk_fp8_f32(a, b, 0, false); w = __builtin_amdgcn_cvt_pk_fp8_f32(c, d, w, true); return (unsigned)w; }
struct EpiMoeUp8 {
    static constexpr bool PERM = true, AFTER_DRAIN = false;
    unsigned char* h;
    __device__ __forceinline__ void operator()(const f32x4 (&acc)[2][2][4][2], const Unit& u, int wr, int wc, int, int) const {
        const int l = lane_fresh(), fr = l & 15, fq = l >> 4;
        const int row0 = u.pm * BM + wr * 64 + fr; const int col0 = (u.pn & 3) * HALF + wc * 32 + 8 * fq;
#pragma unroll
        for (int ai = 0; ai < 2; ++ai)
#pragma unroll
            for (int m = 0; m < 4; ++m) { f32x4 v[2];
#pragma unroll
                for (int n = 0; n < 2; ++n)
#pragma unroll
                    for (int i = 0; i < 4; ++i) { const float gv = acc[ai][0][m][n][i] * (1.f / F8_WS); v[n][i] = fminf(fmaxf(gv * sigmoidf_fast(gv) * acc[ai][1][m][n][i] * (F8_HS / F8_WS), -440.f), 440.f); }
                u32x2 w; w.x = pk4_fp8(v[0][0], v[0][1], v[0][2], v[0][3]); w.y = pk4_fp8(v[1][0], v[1][1], v[1][2], v[1][3]);
                if (MOE_HANDOFF && !HO_PLAINSTORE) { const unsigned long long ubv = (unsigned long long)(uintptr_t)(h + (size_t)u.pm * BM * 512 + (u.pn & 3) * HALF);
                    const unsigned long long ub = ((unsigned long long)(unsigned)__builtin_amdgcn_readfirstlane((int)(ubv >> 32)) << 32) | (unsigned)__builtin_amdgcn_readfirstlane((int)ubv); const unsigned vo = (unsigned)((wr * 64 + fr + ai * HALF + m * 16) * 512 + wc * 32 + 8 * fq);
                    asm volatile("global_store_dwordx2 %0, %1, %2 sc1\n\ts_nop 1" :: "v"(vo), "v"(w), "s"(ub) : "memory"); }
                else *(u32x2*)(h + (size_t)(row0 + ai * HALF + m * 16) * 512 + col0) = w; }
    }
};
struct EpiMoeDown {
    static constexpr bool PERM = true, AFTER_DRAIN = false;
    bf16_t* y; float scale;
    __device__ __forceinline__ void operator()(const f32x4 (&acc)[2][2][4][2], const Unit& u, int wr, int wc, int fr, int fq) const {
        const int row0 = u.pm * BM + wr * 64 + fr; const int col0 = (u.pn & 3) * BM + wc * 32 + 8 * fq;
#pragma unroll
        for (int ai = 0; ai < 2; ++ai)
#pragma unroll
            for (int m = 0; m < 4; ++m) { bf16_t* rowp = y + (size_t)(row0 + ai * HALF + m * 16) * 1024 + col0;
#pragma unroll
                for (int bj = 0; bj < 2; ++bj) *(u32x4*)(rowp + bj * HALF) = pack8f(acc[ai][bj][m][0] * scale, acc[ai][bj][m][1] * scale); }
    }
};
constexpr float Y8_S = 64.f;
struct EpiMoeDown8 {
    static constexpr bool PERM = true, AFTER_DRAIN = false;
    unsigned char* y; float scale;
    __device__ __forceinline__ void operator()(const f32x4 (&acc)[2][2][4][2], const Unit& u, int wr, int wc, int fr, int fq) const {
        const int row0 = u.pm * BM + wr * 64 + fr; const int col0 = (u.pn & 3) * BM + wc * 32 + 8 * fq;
#pragma unroll
        for (int ai = 0; ai < 2; ++ai)
#pragma unroll
            for (int m = 0; m < 4; ++m) { unsigned char* rowp = y + (size_t)(row0 + ai * HALF + m * 16) * 1024 + col0;
#pragma unroll
                for (int bj = 0; bj < 2; ++bj) { f32x4 a = acc[ai][bj][m][0] * scale, b = acc[ai][bj][m][1] * scale;
#pragma unroll
                    for (int i = 0; i < 4; ++i) { a[i] = fminf(fmaxf(a[i], -440.f), 440.f); b[i] = fminf(fmaxf(b[i], -440.f), 440.f); }
                    u32x2 w; w.x = pk4_fp8(a[0], a[1], a[2], a[3]); w.y = pk4_fp8(b[0], b[1], b[2], b[3]);
                    *(u32x2*)(rowp + bj * HALF) = w; } }
    }
};
struct MoeOrder {
    const PG8_LAS int* tab; int G, c;
    unsigned* cnt;
    unsigned need;
    bool publish; unsigned* tmo;
    __device__ __forceinline__ bool next(int i, Unit& u) const {
        const PG8_LAS int* tb = tab; asm volatile("" : "+v"(tb));
        const int nunits = (tb[32] >> 8) * 4; const int L = i * G + c; if (L >= nunits) return false;
        const int tile = L >> 2, s = tile << 8; int e = 0;
#pragma unroll 1
        for (int k = 1; k < 32; ++k) e = (tb[k] <= s) ? k : e;
        u.pm = __builtin_amdgcn_readfirstlane(tile); u.pn = __builtin_amdgcn_readfirstlane(e * 4 + (L & 3)); return true;
    }
    __device__ __forceinline__ int row_off(const Unit& u) const { if (PLACE_ATOMIC) { const int e = u.pn >> 2; return e * 65536 + (u.pm << 8) - tab[e]; } return u.pm * BM; }
    __device__ __forceinline__ int row_mask() const { return PLACE_ATOMIC ? 32767 : -1; }
    mutable int calls;
    __device__ __forceinline__ void a_ready(const Unit& u) const {
        const int k = calls++;
        if (need == 0u || (k >= 1 && k < 4)) return;
        if (wave == 0) {
            const int lane = lane_fresh(), nunits = (tab[32] >> 8) * 4;
            int tile = u.pm; bool mine = (lane == 0);
            if (k == 0) { const int L = lane * G + c; mine = (lane < 4) && (L < nunits); tile = mine ? (L >> 2) : u.pm; }
            const unsigned long long t0 = __builtin_amdgcn_s_memrealtime(); unsigned polls = 0;
            for (;;) {
                const bool ok = !mine || __hip_atomic_load(cnt + 64 * tile, __ATOMIC_RELAXED, __HIP_MEMORY_SCOPE_AGENT) >= need;
                if (__all(ok)) break;
                if ((++polls & 255u) == 0u && __builtin_amdgcn_readfirstlane(__hip_atomic_load(tmo, __ATOMIC_RELAXED, __HIP_MEMORY_SCOPE_AGENT)) != 0u) break;
                if (__builtin_amdgcn_s_memrealtime() - t0 > 2000000ull) { if (lane == 0) __hip_atomic_store(tmo, 1u, __ATOMIC_RELAXED, __HIP_MEMORY_SCOPE_AGENT); break; }
                __builtin_amdgcn_s_sleep(2); }
            __builtin_amdgcn_fence(__ATOMIC_ACQUIRE, "agent");
            asm volatile("s_waitcnt vmcnt(0)" ::: "memory");
        }
        asm volatile("" ::: "memory"); __builtin_amdgcn_s_barrier(); asm volatile("" ::: "memory");
    }
    mutable int pend;
    int wave = 0;
    __device__ __forceinline__ void done(const Unit& u) const {
        if (!publish) return;
        if (pend >= 0 && lane_fresh() == 0) __hip_atomic_fetch_add(cnt + 64 * pend, 1u, __ATOMIC_RELAXED, __HIP_MEMORY_SCOPE_AGENT);
        pend = u.pm;
    }
    __device__ __forceinline__ void flush() const {
        if (!publish) return;
        asm volatile("s_waitcnt vmcnt(0)" ::: "memory");
        if (pend >= 0 && lane_fresh() == 0) __hip_atomic_fetch_add(cnt + 64 * pend, 1u, __ATOMIC_RELAXED, __HIP_MEMORY_SCOPE_AGENT);
        pend = -1;
    }
};
#ifndef F8_PIN
#define F8_PIN 0
#endif
typedef int v8i __attribute__((ext_vector_type(8)));
typedef int v4i __attribute__((ext_vector_type(4)));
template <class Epi, class Sched, bool ALIGN_EPI = false, bool SP2 = false, bool GATHER = false, bool FP8 = false, bool MID = false, bool RES = false>
__device__ __forceinline__ void gemm_phase(PG8_LAS unsigned char* lds, const int wid, const Gemm g, const Sched& S, const Epi& E, const int* tok = nullptr) {
    static_assert(!GATHER || SP2, "GATHER is written for the SP2 loop only"); static_assert(!FP8 || SP2, "FP8 is written for the SP2 loop only"); static_assert(!MID || (SP2 && !GATHER), "MID is written for the SP2 loop, no gather"); static_assert(!RES || (SP2 && ALIGN_EPI && !GATHER && !FP8 && !MID), "RES: bf16 SP2 loop with aligned epilogues only");
    const int lane = lane_fresh(), tid = wid * 64 + lane, wr = wid >> 2, wc = wid & 3, fr = lane & 15, fq = lane >> 4;
    const int K = g.K, nt = K / BK, KA = g.lda ? g.lda : g.K;
    unsigned voffA[2], voffB[2]; int gR[2], gC[2];
#pragma unroll
    for (int i = 0; i < 2; ++i) { int R, C; stage_rc(tid * 16 + i * 8192, R, C); const int Rb = Epi::PERM ? ((R & ~31) + perm32(R & 31)) : R; gR[i] = R; gC[i] = C;
        voffA[i] = (unsigned)(R * KA + C) * 2u; voffB[i] = (unsigned)(Rb * K + C) * 2u; }
    unsigned vc0[2] = {0u, 0u}, vc1[2] = {0u, 0u}, vn0[2] = {0u, 0u}, vn1[2] = {0u, 0u};
#define PG8_GROWS(u_, o0, o1) do { const int t_ = wid * 64 + lane_fresh(); const int ro_ = S.row_off(u_), rm_ = S.row_mask();     \
        _Pragma("unroll") for (int _i = 0; _i < 2; ++_i) { int R_, C_; stage_rc(t_ * 16 + _i * 8192, R_, C_); o0[_i] = (unsigned)((tok[ro_ + R_] & rm_) * K + C_) * 2u; o1[_i] = (unsigned)((tok[ro_ + HALF + R_] & rm_) * K + C_) * 2u; } } while (0)
#define PG8_STAGE_A(bufoff, gbase, h, usenext) do { if constexpr (GATHER) { const unsigned _o0 = (usenext) ? ((h) ? vn1[0] : vn0[0]) : ((h) ? vc1[0] : vc0[0]), _o1 = (usenext) ? ((h) ? vn1[1] : vn0[1]) : ((h) ? vc1[1] : vc0[1]); \
        __builtin_amdgcn_raw_ptr_buffer_load_lds(rsA, (PG8_LAS unsigned*)(lds + (bufoff) + ldsw), 16, (int)_o0, (int)(gbase), 0, 0); \
        __builtin_amdgcn_raw_ptr_buffer_load_lds(rsA, (PG8_LAS unsigned*)(lds + (bufoff) + ldsw + 8192), 16, (int)_o1, (int)(gbase), 0, 0); } \
    else { PG8_STAGE(rsA, bufoff, (gbase) + (h) * hstepA, voffA); } } while (0)
    const unsigned kstep = (unsigned)(BK * 2);
    const unsigned hstep = (unsigned)(HALF * K * 2);
    const unsigned tstep = 2 * hstep;
    const unsigned hstepA = (unsigned)(HALF * KA * 2), tstepA = 2 * hstepA;
    const unsigned ajmp = g.ajump - (unsigned)g.ksplit * kstep;
    const __amdgpu_buffer_rsrc_t rsR = __builtin_amdgcn_make_buffer_rsrc((void*)(RES ? g.R : g.A), (short)0, 0x7fffffff, 0x00020000);
    const unsigned voffR = (unsigned)((wr * 64 + fr) * g.N + wc * 32 + 8 * fq) * 2u, ldsR = (unsigned)STAGE_BYTES + (unsigned)wid * 1024u;
#define PG8_STAGE_R(t_) do { if constexpr (RES) { const unsigned so_ = (unsigned)((cur.pm * BM + ((t_) >> 3) * HALF + (((t_) >> 1) & 3) * 16) * g.N + cur.pn * BM + ((t_) & 1) * HALF) * 2u; \
        __builtin_amdgcn_raw_ptr_buffer_load_lds(rsR, (PG8_LAS unsigned*)(lds + ldsR + ((t_) & 1) * 8192), 16, (int)voffR, (int)so_, 0, 0); } } while (0)
#define PG8_RADD(AI_, M_, BJ_) { acc[AI_][BJ_][M_][0] += rx0_ * g.ralpha; acc[AI_][BJ_][M_][1] += rx1_ * g.ralpha; }
#define PG8_CONSUME_R(slot_, step_, BJ_) do { if constexpr (RES) { const u32x4 rw_ = *(const PG8_LAS u32x4*)(lds + ldsR + (slot_) * 8192 + lane * 16); f32x4 rx0_, rx1_; unpack8f(rw_, rx0_, rx1_); \
        switch (step_) { case 0: PG8_RADD(0, 0, BJ_) break; case 1: PG8_RADD(0, 1, BJ_) break; case 2: PG8_RADD(0, 2, BJ_) break; case 3: PG8_RADD(0, 3, BJ_) break; \
                         case 4: PG8_RADD(1, 0, BJ_) break; case 5: PG8_RADD(1, 1, BJ_) break; case 6: PG8_RADD(1, 2, BJ_) break; default: PG8_RADD(1, 3, BJ_) break; } } } while (0)
#define PG8_WAIT_VK() do { if constexpr (RES) PG8_WAIT_V(9); else PG8_WAIT_V(8); } while (0)
    const __amdgpu_buffer_rsrc_t rsA = __builtin_amdgcn_make_buffer_rsrc((void*)g.A, (short)0, 0x7fffffff, 0x00020000), rsB = __builtin_amdgcn_make_buffer_rsrc((void*)g.Bt, (short)0, 0x7fffffff, 0x00020000);
    const unsigned ldsw = (unsigned)wid * 1024u;
    const int aoff = lds_byte(wr * 64 + fr, fq * 8), boff = lds_byte(wc * 32 + fr, fq * 8);
#if F8_CHUNK_SPLIT
    const int aoff0 = aoff, boff0 = boff; constexpr int F8_O1 = 1024;
#else
    const int aoff0 = lds_byte(wr * 64 + fr, (2 * (fq & 1)) * 8) + (fq >> 1) * 1024, boff0 = lds_byte(wc * 32 + fr, (2 * (fq & 1)) * 8) + (fq >> 1) * 1024; constexpr int F8_O1 = 16;
#endif
#define PG8_SA(b, h) (((b) * 2 + (h)) * HTB)
#define PG8_SB(b, h) ((4 + (b) * 2 + (h)) * HTB)
#define PG8_STAGE(rs, bufoff, soff, voff) do { _Pragma("unroll") for (int _i = 0; _i < 2; ++_i) \
        __builtin_amdgcn_raw_ptr_buffer_load_lds(rs, (PG8_LAS unsigned*)(lds + (bufoff) + ldsw + _i * 8192), 16, (int)(voff)[_i], (int)(soff), 0, 0); } while (0)
#define PG8_LD8(base_, o0_, o1_) __builtin_shufflevector(*(const PG8_LAS v4i*)(lds + (base_) + (o0_)), *(const PG8_LAS v4i*)(lds + (base_) + (o1_)), 0, 1, 2, 3, 4, 5, 6, 7)
#define PG8_LDA(dst, b, h) do { _Pragma("unroll") for (int m = 0; m < 4; ++m) { if constexpr (FP8) { dst##8[m] = PG8_LD8(PG8_SA(b, h) + m * 2048, aoff0, aoff0 + F8_O1); } \
        else { _Pragma("unroll") for (int k = 0; k < 2; ++k) dst[m][k] = *(const PG8_LAS bf16x8*)(lds + PG8_SA(b, h) + aoff + m * 2048 + k * 1024); } } } while (0)
#define PG8_LDB(dst, b, h) do { _Pragma("unroll") for (int n = 0; n < 2; ++n) { if constexpr (FP8) { dst##8[n] = PG8_LD8(PG8_SB(b, h) + n * 2048, boff0, boff0 + F8_O1); } \
        else { _Pragma("unroll") for (int k = 0; k < 2; ++k) dst[n][k] = *(const PG8_LAS bf16x8*)(lds + PG8_SB(b, h) + boff + n * 2048 + k * 1024); } } } while (0)
#define PG8_MMA(ai, bj, At, Bt) do { if constexpr (FP8) __builtin_amdgcn_sched_barrier(0); __builtin_amdgcn_s_setprio(1); _Pragma("unroll") for (int m = 0; m < 4; ++m) _Pragma("unroll") for (int n = 0; n < 2; ++n) { \
        if constexpr (FP8) acc[ai][bj][m][n] = __builtin_amdgcn_mfma_scale_f32_16x16x128_f8f6f4(Bt##8[n], At##8[m], acc[ai][bj][m][n], 0, 0, 0, F8_SCALE, 0, F8_SCALE); \
        else { _Pragma("unroll") for (int k = 0; k < 2; ++k) acc[ai][bj][m][n] = __builtin_amdgcn_mfma_f32_16x16x32_bf16(Bt[n][k], At[m][k], acc[ai][bj][m][n], 0, 0, 0); } } __builtin_amdgcn_s_setprio(0); \
        if constexpr (FP8) { if (F8_PIN) asm volatile("" : "+v"(acc[ai][bj][0][0]), "+v"(acc[ai][bj][0][1]), "+v"(acc[ai][bj][1][0]), "+v"(acc[ai][bj][1][1]), "+v"(acc[ai][bj][2][0]), "+v"(acc[ai][bj][2][1]), "+v"(acc[ai][bj][3][0]), "+v"(acc[ai][bj][3][1])); \
                             __builtin_amdgcn_sched_barrier(0); } } while (0)
#define PG8_WAIT_V(n) asm volatile("s_waitcnt vmcnt(" #n ")" ::: "memory")
#define PG8_WAIT_L(n) asm volatile("s_waitcnt lgkmcnt(" #n ")" ::: "memory")
#define PG8_BAR __builtin_amdgcn_s_barrier()
#define PG8_SCHED __builtin_amdgcn_sched_barrier(0)
    Unit cur, nxt; int ui = 0;
    if (!S.next(0, cur)) return;
    f32x4 acc[2][2][4][2];
#pragma unroll
    for (int a = 0; a < 2; ++a)
#pragma unroll
        for (int b = 0; b < 2; ++b)
#pragma unroll
            for (int m = 0; m < 4; ++m)
#pragma unroll
                for (int n = 0; n < 2; ++n) acc[a][b][m][n] = (f32x4){0.f, 0.f, 0.f, 0.f};
    bf16x8 At[4][2], B0[2][2], B1[2][2]; v8i At8[4], B08[2], B18[2];
    u32x2 midkeep[8][2];
    unsigned cA = GATHER ? 0u : (unsigned)cur.pm * tstepA, cB = (unsigned)cur.pn * tstep;
    S.a_ready(cur);
    if constexpr (GATHER) PG8_GROWS(cur, vc0, vc1);
    if constexpr (SP2) {
        PG8_STAGE(rsB, PG8_SB(0, 0), cB, voffB); PG8_STAGE(rsB, PG8_SB(0, 1), cB + hstep, voffB); PG8_STAGE_A(PG8_SA(0, 0), cA, 0, false); PG8_STAGE_A(PG8_SA(0, 1), cA, 1, false);
        if (wr == 1) PG8_BAR;
        PG8_WAIT_V(2); PG8_BAR;
        PG8_STAGE(rsB, PG8_SB(1, 0), cB + kstep, voffB); PG8_STAGE_A(PG8_SA(1, 0), cA + kstep, 0, false); PG8_STAGE(rsB, PG8_SB(1, 1), cB + hstep + kstep, voffB);
        PG8_WAIT_V(6); PG8_BAR;
    } else {
        PG8_STAGE(rsB, PG8_SB(0, 0), cB, voffB); PG8_STAGE(rsA, PG8_SA(0, 0), cA, voffA); PG8_STAGE(rsB, PG8_SB(0, 1), cB + hstep, voffB); PG8_STAGE(rsA, PG8_SA(0, 1), cA + hstep, voffA);
        if (wr == 1) PG8_BAR;
        PG8_WAIT_V(4); PG8_BAR;
        PG8_STAGE(rsB, PG8_SB(1, 0), cB + kstep, voffB); PG8_STAGE(rsA, PG8_SA(1, 0), cA + kstep, voffA); PG8_STAGE(rsB, PG8_SB(1, 1), cB + hstep + kstep, voffB);
        PG8_WAIT_V(6); PG8_BAR;
    }
    for (;;) {
        const bool has_next = S.next(ui + 1, nxt);
        const unsigned nA = GATHER ? 0u : (has_next ? (unsigned)nxt.pm * tstepA : cA), nB = has_next ? (unsigned)nxt.pn * tstep : cB;
        if constexpr (GATHER) { if (has_next) PG8_GROWS(nxt, vn0, vn1); else { vn0[0] = vc0[0]; vn0[1] = vc0[1]; vn1[0] = vc1[0]; vn1[1] = vc1[1]; } }
        auto kbody = [&](const int t) __attribute__((always_inline)) {
            const bool last = (t == nt - 2);
            const unsigned a1 = cA + (unsigned)(t + 1) * kstep + ((t + 1 >= g.ksplit) ? ajmp : 0u);
            const unsigned a2 = last ? nA : cA + (unsigned)(t + 2) * kstep + ((t + 2 >= g.ksplit) ? ajmp : 0u), b2 = last ? nB : cB + (unsigned)(t + 2) * kstep;
            if constexpr (MID) { if (t == g.ksplit) E.mid(acc, cur, wr, wc, midkeep); }
            const unsigned a3 = a2 + kstep, b3 = b2 + kstep;
            if (last && has_next) S.a_ready(nxt);
            if constexpr (SP2) {
            PG8_LDB(B0, 0, 0); PG8_LDB(B1, 0, 1); PG8_SCHED; PG8_LDA(At, 0, 0); PG8_STAGE_A(PG8_SA(1, 1), a1, 1, false); PG8_STAGE_R(t);
            PG8_WAIT_VK(); if (t > 0) PG8_CONSUME_R(1, (t >> 1) - 1, 1); PG8_WAIT_L(0); PG8_BAR; PG8_MMA(0, 0, At, B0); PG8_MMA(0, 1, At, B1); PG8_BAR; PG8_SCHED;
            PG8_LDA(At, 0, 1); PG8_STAGE(rsB, PG8_SB(0, 0), b2, voffB); PG8_STAGE(rsB, PG8_SB(0, 1), b2 + hstep, voffB); PG8_STAGE_A(PG8_SA(0, 0), a2, 0, last);
            PG8_WAIT_VK(); PG8_WAIT_L(0); PG8_BAR; PG8_MMA(1, 0, At, B0); PG8_MMA(1, 1, At, B1); PG8_BAR; PG8_SCHED;
            PG8_LDB(B0, 1, 0); PG8_LDB(B1, 1, 1); PG8_SCHED; PG8_LDA(At, 1, 0); PG8_STAGE_A(PG8_SA(0, 1), a2, 1, last); PG8_STAGE_R(t + 1);
            PG8_WAIT_VK(); PG8_CONSUME_R(0, t >> 1, 0); PG8_WAIT_L(0); PG8_BAR; PG8_MMA(0, 0, At, B0); PG8_MMA(0, 1, At, B1); PG8_BAR; PG8_SCHED;
            PG8_LDA(At, 1, 1); PG8_STAGE(rsB, PG8_SB(1, 0), b3, voffB); PG8_STAGE(rsB, PG8_SB(1, 1), b3 + hstep, voffB); PG8_STAGE_A(PG8_SA(1, 0), a3, 0, last);
            PG8_WAIT_VK(); PG8_WAIT_L(0); PG8_BAR; PG8_MMA(1, 0, At, B0); PG8_MMA(1, 1, At, B1); PG8_BAR; PG8_SCHED;
            } else {
            PG8_LDB(B0, 0, 0); PG8_SCHED; PG8_LDA(At, 0, 0); PG8_STAGE(rsA, PG8_SA(1, 1), a1 + hstep, voffA);
            PG8_WAIT_L(8); PG8_BAR; PG8_WAIT_L(0); PG8_MMA(0, 0, At, B0); PG8_BAR; PG8_SCHED;
            PG8_LDB(B1, 0, 1); PG8_STAGE(rsB, PG8_SB(0, 0), b2, voffB);
            PG8_BAR; PG8_WAIT_L(0); PG8_MMA(0, 1, At, B1); PG8_BAR;
            PG8_LDA(At, 0, 1); PG8_STAGE(rsA, PG8_SA(0, 0), a2, voffA);
            PG8_BAR; PG8_WAIT_L(0); PG8_MMA(1, 0, At, B0); PG8_BAR; PG8_SCHED;
            PG8_STAGE(rsB, PG8_SB(0, 1), b2 + hstep, voffB);
            PG8_WAIT_V(6); PG8_BAR; PG8_MMA(1, 1, At, B1); PG8_BAR;
            PG8_LDB(B0, 1, 0); PG8_SCHED; PG8_LDA(At, 1, 0); PG8_STAGE(rsA, PG8_SA(0, 1), a2 + hstep, voffA);
            PG8_WAIT_L(8); PG8_BAR; PG8_WAIT_L(0); PG8_MMA(0, 0, At, B0); PG8_BAR; PG8_SCHED;
            PG8_LDB(B1, 1, 1); PG8_STAGE(rsB, PG8_SB(1, 0), b3, voffB);
            PG8_BAR; PG8_WAIT_L(0); PG8_MMA(0, 1, At, B1); PG8_BAR;
            PG8_LDA(At, 1, 1); PG8_STAGE(rsA, PG8_SA(1, 0), a3, voffA);
            PG8_BAR; PG8_WAIT_L(0); PG8_MMA(1, 0, At, B0); PG8_BAR; PG8_SCHED;
            PG8_STAGE(rsB, PG8_SB(1, 1), b3 + hstep, voffB);
            PG8_WAIT_V(6); PG8_BAR; PG8_MMA(1, 1, At, B1); PG8_BAR;
            }
        };
        if constexpr (RES) {
#pragma unroll
            for (int t = 0; t < 16; t += 2) kbody(t);
        } else {
#pragma unroll 1
            for (int t = 0; t < nt; t += 2) kbody(t);
        }
        if constexpr (ALIGN_EPI) { if (wr == 0) PG8_BAR; }
        if constexpr (RES) { PG8_WAIT_V(6); PG8_CONSUME_R(1, 7, 1); }
        if constexpr (MID && GB_KEEP) { E.fin(acc, cur, wr, wc, midkeep); S.done(cur); }
        else if constexpr (!Epi::AFTER_DRAIN) { E(acc, cur, wr, wc, fr, fq); S.done(cur); }
        if (!has_next) break;
#pragma unroll
        for (int a = 0; a < 2; ++a)
#pragma unroll
            for (int b = 0; b < 2; ++b)
#pragma unroll
                for (int m = 0; m < 4; ++m)
#pragma unroll
                    for (int n = 0; n < 2; ++n) acc[a][b][m][n] = (f32x4){0.f, 0.f, 0.f, 0.f};
        cur = nxt; cA = nA; cB = nB; ++ui;
        if constexpr (GATHER) { vc0[0] = vn0[0]; vc0[1] = vn0[1]; vc1[0] = vn1[0]; vc1[1] = vn1[1]; }
        if constexpr (ALIGN_EPI) { if (wr == 1) PG8_BAR; }
    }
    PG8_WAIT_V(0);
    if constexpr (!ALIGN_EPI) { if (wr == 0) PG8_BAR; }
    PG8_BAR;
    if constexpr (Epi::AFTER_DRAIN) { E.fused(acc, cur, wr, wc, fr, fq, lds, wid, lane); S.done(cur); }
#undef PG8_STAGE_R
#undef PG8_RADD
#undef PG8_CONSUME_R
#undef PG8_WAIT_VK
#undef PG8_SA
#undef PG8_SB
#undef PG8_STAGE
#undef PG8_STAGE_A
#undef PG8_GROWS
#undef PG8_LDA
#undef PG8_LDB
#undef PG8_MMA
#undef PG8_LD8
#undef PG8_WAIT_V
#undef PG8_WAIT_L
#undef PG8_BAR
#undef PG8_SCHED
}
}

namespace attn {
typedef short bf16x8 __attribute__((ext_vector_type(8)));
typedef short s16x4 __attribute__((ext_vector_type(4)));
typedef float f32x16 __attribute__((ext_vector_type(16)));
typedef unsigned u32x4 __attribute__((ext_vector_type(4)));
typedef unsigned short bf16;
constexpr int D = 128, PITCH = 1024, SEQ = 2048;
constexpr float SCALE = 0.08838834764831845f, THR = 8.f;
constexpr int NW = 8, QBLK = 32, KVBLK = 64, QB = NW * QBLK;
constexpr int SHM_V = KVBLK * D * 2, SHM_K = KVBLK * D * 2;
constexpr int BIAS_OFF = 2 * SHM_V + 2 * SHM_K + NW * 64 * 4, NBIAS = 320;
constexpr int LDS_BYTES = BIAS_OFF + NBIAS * 4;
#define KSWZ(row, colB) ((row) * 256 + ((colB) ^ (((row) & 7) << 4)))
#define SBAR() __builtin_amdgcn_sched_barrier(0)
__device__ __forceinline__ int v_st(int k, int c) { const int kk = (k & ~0xC) | ((k & 4) << 1) | ((k & 8) >> 1); return ((kk >> 3) * 4 + (c >> 5)) * 512 + ((kk & 7) * 32 + (c & 31)) * 2; }
__device__ __forceinline__ int v_rd_base(int lane) { return ((lane & 3) << 3) | (((lane >> 2) & 3) << 6) | (((lane >> 4) & 1) << 5) | (((lane >> 5) & 1) << 8); }
constexpr int v_rd_off(int d0, int ks, int half) { return d0 * 512 + ks * 4096 + half * 2048; }
__device__ __forceinline__ int crow(int r, int hi) { return (r & 3) + 8 * (r >> 2) + 4 * hi; }
__device__ __forceinline__ unsigned cvtpk(float lo, float hi) { unsigned r; asm volatile("v_cvt_pk_bf16_f32 %0, %1, %2" : "=v"(r) : "v"(lo), "v"(hi)); return r; }
__device__ __forceinline__ bf16x8 load8(const bf16* p) { return *reinterpret_cast<const bf16x8*>(p); }
__device__ __forceinline__ int t5_bucket(int rel) {
    const int b = rel > 0 ? 16 : 0; const int n = rel < 0 ? -rel : rel; int v;
    if (n < 8) v = n; else if (n < 12) v = 8; else if (n < 16) v = 9; else if (n < 23) v = 10; else if (n < 32) v = 11; else if (n < 46) v = 12; else if (n < 65) v = 13; else if (n < 91) v = 14; else v = 15;
    return b + v;
}
__device__ __forceinline__ void bias_tile(f32x16& p0, f32x16& p1, const float* tabp) {
#pragma unroll
    for (int r = 0; r < 16; ++r) { const int c = (r & 3) + 8 * (r >> 2); p0[r] += tabp[59 - c]; p1[r] += tabp[59 - c - 32]; }
}
__device__ __forceinline__ void partialSM(f32x16& p0, f32x16& p1, float& m_reg, float& mn, float& alpha) {
    float pmax = p0[0]; for (int r = 1; r < 16; ++r) pmax = fmaxf(pmax, p0[r]); for (int r = 0; r < 16; ++r) pmax = fmaxf(pmax, p1[r]);
    { auto rr = __builtin_amdgcn_permlane32_swap(__float_as_uint(pmax), __float_as_uint(pmax), false, false);
      pmax = fmaxf(__uint_as_float(rr[0]), __uint_as_float(rr[1])); }
    constexpr float C2 = 1.4426950408889634f * SCALE;
    if (__builtin_expect(__all((pmax - m_reg) * SCALE <= THR), 1)) { mn = m_reg; alpha = 1.f; }
    else { mn = fmaxf(m_reg, pmax); alpha = __builtin_amdgcn_exp2f((m_reg - mn) * C2); m_reg = mn; }
    const float mnL = -mn * C2;
    for (int r = 0; r < 16; ++r) p0[r] = fmaf(p0[r], C2, mnL); for (int r = 0; r < 16; ++r) p1[r] = fmaf(p1[r], C2, mnL);
    for (int r = 0; r < 16; ++r) p0[r] = __builtin_amdgcn_exp2f(p0[r]);
}
__device__ __forceinline__ void finishSM(f32x16& p0, f32x16& p1, float alpha, float& l_reg, bf16x8& pa0, bf16x8& pa1, bf16x8& pa2, bf16x8& pa3) {
    for (int r = 0; r < 16; ++r) p1[r] = __builtin_amdgcn_exp2f(p1[r]);
    float ps = 0; for (int r = 0; r < 16; ++r) ps += p0[r]; for (int r = 0; r < 16; ++r) ps += p1[r];
    { auto rr = __builtin_amdgcn_permlane32_swap(__float_as_uint(ps), __float_as_uint(ps), false, false);
      ps = __uint_as_float(rr[0]) + __uint_as_float(rr[1]); }
    l_reg = l_reg * alpha + ps;
#define PK4(P, B_, OUT) do { unsigned a0 = cvtpk(P[B_+0], P[B_+1]), a1 = cvtpk(P[B_+2], P[B_+3]);                          \
        unsigned b0 = cvtpk(P[B_+4], P[B_+5]), b1 = cvtpk(P[B_+6], P[B_+7]);                                             \
        auto r0 = __builtin_amdgcn_permlane32_swap(a0, b0, false, false); auto r1 = __builtin_amdgcn_permlane32_swap(a1, b1, false, false); \
        u32x4 w = {r0[0], r1[0], r0[1], r1[1]}; OUT = *reinterpret_cast<bf16x8*>(&w); } while (0)
    PK4(p0, 0, pa0); PK4(p0, 8, pa1); PK4(p1, 0, pa2); PK4(p1, 8, pa3);
#undef PK4
}
template <int KB>
__device__ __forceinline__ void qkt(f32x16& p0, f32x16& p1, const char* K_lds, int r32, int hi, const bf16x8* qr, bool act) {
    if (!act) { const float NEG = -__builtin_inff();
#pragma unroll
        for (int r = 0; r < 16; ++r) { p0[r] = NEG; p1[r] = NEG; } return; }
    p0 = f32x16{}; p1 = f32x16{};
    const char* kb[4];
#pragma unroll
    for (int dd = 0; dd < 4; ++dd) kb[dd] = K_lds + KB * SHM_K + KSWZ(r32, (dd * 16 + hi * 8) * 2);
#pragma unroll
    for (int d0 = 0; d0 < 8; ++d0) { const char* a = kb[d0 & 3] + (d0 >> 2) * 128;
        bf16x8 b0 = *reinterpret_cast<const bf16x8*>(a);
        bf16x8 b1 = *reinterpret_cast<const bf16x8*>(a + 32 * 256);
        p0 = __builtin_amdgcn_mfma_f32_32x32x16_bf16(b0, qr[d0], p0, 0, 0, 0);
        p1 = __builtin_amdgcn_mfma_f32_32x32x16_bf16(b1, qr[d0], p1, 0, 0, 0); }
}
template <int VB>
__device__ __forceinline__ void pv_tile(f32x16* o, int vb0, bf16x8 pa0, bf16x8 pa1, bf16x8 pa2, bf16x8 pa3, bool act) {
    if (!act) return;
#define TRRD(dst, off) asm volatile("ds_read_b64_tr_b16 %0, %1 offset:%2" : "=&v"(dst) : "v"(vb0), "i"(off) : "memory")
#define PV_D0(d0) do { s16x4 l0, l1, l2, l3, h0, h1, h2, h3; constexpr int b_ = VB * SHM_V + v_rd_off(d0, 0, 0); \
        TRRD(l0, b_); TRRD(h0, b_ + 2048); TRRD(l1, b_ + 4096); TRRD(h1, b_ + 6144); TRRD(l2, b_ + 8192); TRRD(h2, b_ + 10240); TRRD(l3, b_ + 12288); TRRD(h3, b_ + 14336); \
        asm volatile("s_waitcnt lgkmcnt(0)" ::: "memory"); SBAR();   \
        o[d0] = __builtin_amdgcn_mfma_f32_32x32x16_bf16(pa0, (bf16x8){l0[0], l0[1], l0[2], l0[3], h0[0], h0[1], h0[2], h0[3]}, o[d0], 0, 0, 0);   \
        o[d0] = __builtin_amdgcn_mfma_f32_32x32x16_bf16(pa1, (bf16x8){l1[0], l1[1], l1[2], l1[3], h1[0], h1[1], h1[2], h1[3]}, o[d0], 0, 0, 0);   \
        o[d0] = __builtin_amdgcn_mfma_f32_32x32x16_bf16(pa2, (bf16x8){l2[0], l2[1], l2[2], l2[3], h2[0], h2[1], h2[2], h2[3]}, o[d0], 0, 0, 0);   \
        o[d0] = __builtin_amdgcn_mfma_f32_32x32x16_bf16(pa3, (bf16x8){l3[0], l3[1], l3[2], l3[3], h3[0], h3[1], h3[2], h3[3]}, o[d0], 0, 0, 0); } while (0)
    PV_D0(0); PV_D0(1); PV_D0(2); PV_D0(3);
#undef PV_D0
#undef TRRD
}
struct BlockRef { const bf16* Q; const bf16* K; const bf16* V; bf16* O; int P0; };
struct Seam { bf16x8 qr[8]; bf16x8 st_v0, st_v1, st_k0, st_k1; };
#define ROW(p, k0, rr) ((p) + (size_t)((k0) + (rr)) * PITCH + sc)
#define VMW() asm volatile("s_waitcnt vmcnt(0)" ::: "memory")
#define VMWN(n) asm volatile("s_waitcnt vmcnt(%0)" :: "i"(n) : "memory")
#define SLOAD_H(Kp, Vp, k0) do { S.st_v0 = load8(ROW(Vp, k0, sr)); S.st_v1 = load8(ROW(Vp, k0, 32 + sr)); S.st_k0 = load8(ROW(Kp, k0, sr)); S.st_k1 = load8(ROW(Kp, k0, 32 + sr)); } while (0)
#define SWRITE_HK(bf) do { *(bf16x8*)(K_lds + (bf) * SHM_K + kws) = S.st_k0; *(bf16x8*)(K_lds + (bf) * SHM_K + kws + 32 * 256) = S.st_k1; } while (0)
#define SWRITE_HV(bf) do { *(bf16x8*)(V_lds + (bf) * SHM_V + vst0) = S.st_v0; *(bf16x8*)(V_lds + (bf) * SHM_V + vst1) = S.st_v1; } while (0)
#define SWRITE_H(bf) do { SWRITE_HV(bf); SWRITE_HK(bf); } while (0)
__device__ __forceinline__ void attn_prime(const BlockRef& cur, char* lds, Seam& S) {
    const int tid = threadIdx.x, wid = __builtin_amdgcn_readfirstlane(tid >> 6), lane = tid & 63, r32 = lane & 31, hi = lane >> 5;
    const int sr = tid >> 4, sc = (tid & 15) * 8, kws = KSWZ(sr, sc * 2); char* K_lds = lds + 2 * SHM_V;
#pragma unroll
    for (int d0 = 0; d0 < 8; ++d0) S.qr[d0] = load8(cur.Q + (size_t)(wid * QBLK + r32) * PITCH + d0 * 16 + hi * 8);
    SLOAD_H(cur.K, cur.V, 0); VMW(); SWRITE_HK(0);
    __syncthreads();
}
__device__ __forceinline__ void attn_block(const BlockRef& cur, const BlockRef& nxt, char* lds, Seam& S) {
    const int tid = threadIdx.x, wid = __builtin_amdgcn_readfirstlane(tid >> 6), lane = tid & 63, r32 = lane & 31, hi = lane >> 5;
    const int NT = cur.P0 / KVBLK + QB / KVBLK;
    const int qlo = cur.P0 + wid * QBLK, cw = qlo >> 6;
    char* V_lds = lds; char* K_lds = lds + 2 * SHM_V;
    float* ws = (float*)(lds + 2 * SHM_V + 2 * SHM_K) + wid * 64; float* li_l = ws, * al_l = ws + 32;
    const float* btab = (const float*)(lds + BIAS_OFF);
    float m_reg = -1e30f, l_reg = 0; f32x16 o[4] = {};
    const int sr = tid >> 4, sc = (tid & 15) * 8, vst0 = v_st(sr, sc), vst1 = v_st(32 + sr, sc), kws = KSWZ(sr, sc * 2);
    const int vb0 = (int)(uintptr_t)V_lds + v_rd_base(lane);
    const bf16* Kh = cur.K; const bf16* Vh = cur.V;
    const int bb0 = qlo + r32 - 4 * hi + 4;
#define RESC(a) do { if (__any((a) < 1.f)) { if (hi == 0) al_l[r32] = (a); asm volatile("s_waitcnt lgkmcnt(0)" ::: "memory");              \
                     for (int d_ = 0; d_ < 4; ++d_) for (int r = 0; r < 16; ++r) o[d_][r] *= al_l[crow(r, hi)]; } } while (0)
#define KBASE(t) ((t) * KVBLK)
#define ACT(t) ((t) <= cw)
#define BIAST(P0_, P1_, t) do { if ((t) <= cw && (t) + 2 >= cw) bias_tile(P0_, P1_, btab + (bb0 - KBASE(t))); } while (0)
    constexpr int NQL = 8;
#define SEAM_K0() do { VMWN(NQL); SWRITE_HK(0); SBAR(); } while (0)
    f32x16 pA0, pA1, pB0, pB1; float mnA, mnB, alA, alB; bf16x8 pa0, pa1, pa2, pa3;
    SWRITE_HV(0); SBAR();
    SLOAD_H(Kh, Vh, KBASE(1));
    SBAR(); qkt<0>(pA0, pA1, K_lds, r32, hi, S.qr, ACT(0));
    BIAST(pA0, pA1, 0); partialSM(pA0, pA1, m_reg, mnA, alA);
    VMW(); SWRITE_H(1);
    __syncthreads();
#define HALF_STEP(PX0, PX1, mnX, alX, PY0, PY1, alY, t, KB, VB, SB) do {                                                      \
        SBAR(); qkt<KB>(PX0, PX1, K_lds, r32, hi, S.qr, ACT(t));                                                 \
        finishSM(PY0, PY1, alY, l_reg, pa0, pa1, pa2, pa3); SBAR();                                                           \
        if ((t) + 1 < NT) { SLOAD_H(Kh, Vh, KBASE((t) + 1)); SBAR(); }                                                         \
        pv_tile<VB>(o, vb0, pa0, pa1, pa2, pa3, ACT((t) - 1)); BIAST(PX0, PX1, (t)); partialSM(PX0, PX1, m_reg, mnX, alX);    \
        __syncthreads();                                                                                                      \
        if ((t) + 1 < NT) { VMW(); SWRITE_H(SB); }                                                                             \
        RESC(alX); __syncthreads(); } while (0)
    for (int t = 1; t + 1 < NT; t += 2) {
        HALF_STEP(pB0, pB1, mnB, alB, pA0, pA1, alA, t, 1, 0, 0);
        HALF_STEP(pA0, pA1, mnA, alA, pB0, pB1, alB, t + 1, 0, 1, 1);
    }
    { SBAR(); qkt<1>(pB0, pB1, K_lds, r32, hi, S.qr, ACT(NT - 1)); SBAR(); }
    SLOAD_H(nxt.K, nxt.V, 0); SBAR();
#pragma unroll
    for (int d0 = 0; d0 < 8; ++d0) S.qr[d0] = load8(nxt.Q + (size_t)(wid * QBLK + r32) * PITCH + d0 * 16 + hi * 8);
    SBAR();
    finishSM(pA0, pA1, alA, l_reg, pa0, pa1, pa2, pa3); SBAR();
    pv_tile<0>(o, vb0, pa0, pa1, pa2, pa3, ACT(NT - 2));
    { BIAST(pB0, pB1, NT - 1); partialSM(pB0, pB1, m_reg, mnB, alB); __syncthreads(); RESC(alB);
      finishSM(pB0, pB1, alB, l_reg, pa0, pa1, pa2, pa3); SBAR(); pv_tile<1>(o, vb0, pa0, pa1, pa2, pa3, ACT(NT - 1)); }
    SBAR(); SEAM_K0();
    if (hi == 0) li_l[r32] = l_reg; asm volatile("s_waitcnt lgkmcnt(0)" ::: "memory");
    float rli[16];
#pragma unroll
    for (int r = 0; r < 16; ++r) rli[r] = __builtin_amdgcn_rcpf(li_l[crow(r, hi)]);
    bf16* Ow = cur.O + (size_t)(wid * QBLK) * PITCH;
#pragma unroll
    for (int r = 0; r < 16; ++r) { const int orow = crow(r, hi);
#pragma unroll
        for (int d0 = 0; d0 < 4; ++d0) { const float v = o[d0][r] * rli[r];
            const float vn = __shfl_xor(v, 1);
            if ((r32 & 1) == 0) *(unsigned*)(Ow + (size_t)orow * PITCH + d0 * 32 + r32) = cvtpk(v, vn); } }
    __syncthreads();
#undef RESC
#undef KBASE
#undef ACT
#undef BIAST
#undef SEAM_K0
#undef HALF_STEP
}
#undef ROW
#undef VMW
#undef VMWN
#undef SLOAD_H
#undef SWRITE_HK
#undef SWRITE_HV
#undef SWRITE_H
#undef KSWZ
}

namespace attn2 {
using attn::bf16x8; using attn::s16x4; using attn::f32x16; using attn::u32x4; using attn::bf16;
using attn::v_st; using attn::v_rd_base; using attn::crow; using attn::cvtpk; using attn::load8; using attn::t5_bucket;
constexpr int D = 128, PITCH = 1024;
constexpr float SCALE = 0.08838834764831845f, THR = 8.f;
constexpr int NW = 8, QBLK = 32, KVBLK = 64, QB = 4 * QBLK;
constexpr int IMG = KVBLK * D * 2, SHM_V = 2 * IMG, SHM_K = KVBLK * D * 2;
constexpr int OFF_V = 0, OFF_K = 2 * SHM_V, OFF_PX = OFF_K + 2 * SHM_K, OFF_WS = OFF_PX + NW * 2048, OFF_MX = OFF_WS + NW * 64 * 4, BIAS_OFF = OFF_MX + NW * 32 * 4, NBIAS = 320;
constexpr int LDS_BYTES = BIAS_OFF + NBIAS * 4;
#define KSWZ(row, colB) ((row) * 256 + ((colB) ^ (((row) & 7) << 4)))
#define SBAR() __builtin_amdgcn_sched_barrier(0)
#ifndef ATTN_SGB
#define ATTN_SGB 1
#endif
#if ATTN_SGB
#define SGB_A() do { _Pragma("unroll") for (int g_ = 0; g_ < 8; ++g_) { __builtin_amdgcn_sched_group_barrier(0x008, 1, 0); __builtin_amdgcn_sched_group_barrier(0x402, 9, 0); } } while (0)
#else
#define SGB_A() do {} while (0)
#endif
#define L3 __attribute__((address_space(3)))
#define LP(T, byteoff) ((L3 T*)(uintptr_t)(unsigned)(byteoff))
__device__ __forceinline__ void bias_half(f32x16& p, const L3 float* tabp) {
#pragma unroll
    for (int r = 0; r < 16; ++r) { const int c = (r & 3) + 8 * (r >> 2); p[r] += tabp[59 - c]; }
}
__device__ __forceinline__ float rowmax_half(const f32x16& p) {
    float pmax = p[0];
#pragma unroll
    for (int r = 1; r < 16; ++r) pmax = fmaxf(pmax, p[r]);
    const auto rr = __builtin_amdgcn_permlane32_swap(__float_as_uint(pmax), __float_as_uint(pmax), false, false);
    return fmaxf(__uint_as_float(rr[0]), __uint_as_float(rr[1]));
}
__device__ __forceinline__ void partialSM(f32x16& p, float pmax, float& m_reg, float& alpha) {
    constexpr float C2 = 1.4426950408889634f * SCALE; float mn;
    if (__builtin_expect(__all((pmax - m_reg) * SCALE <= THR), 1)) { mn = m_reg; alpha = 1.f; }
    else { mn = fmaxf(m_reg, pmax); alpha = __builtin_amdgcn_exp2f((m_reg - mn) * C2); m_reg = mn; }
    const float mnL = -mn * C2;
#pragma unroll
    for (int r = 0; r < 16; ++r) p[r] = fmaf(p[r], C2, mnL);
#pragma unroll
    for (int r = 0; r < 8; ++r) p[r] = __builtin_amdgcn_exp2f(p[r]);
}
__device__ __forceinline__ void finishSM(f32x16& p, float alpha, float& l_reg, bf16x8& pa0, bf16x8& pa1, float mnL = 0.f) {
    if (ATTN_SMLATE) { constexpr float C2 = 1.4426950408889634f * SCALE;
#pragma unroll
        for (int r = 0; r < 16; ++r) p[r] = __builtin_amdgcn_exp2f(fmaf(p[r], C2, mnL)); }
    else {
#pragma unroll
    for (int r = 8; r < 16; ++r) p[r] = __builtin_amdgcn_exp2f(p[r]); }
    float ps = 0;
#pragma unroll
    for (int r = 0; r < 16; ++r) ps += p[r];
    { const auto rr = __builtin_amdgcn_permlane32_swap(__float_as_uint(ps), __float_as_uint(ps), false, false); ps = __uint_as_float(rr[0]) + __uint_as_float(rr[1]); }
    l_reg = l_reg * alpha + ps;
#define PK4(P, B_, OUT) do { unsigned a0 = cvtpk(P[B_+0], P[B_+1]), a1 = cvtpk(P[B_+2], P[B_+3]);                          \
        unsigned b0 = cvtpk(P[B_+4], P[B_+5]), b1 = cvtpk(P[B_+6], P[B_+7]);                                             \
        auto r0 = __builtin_amdgcn_permlane32_swap(a0, b0, false, false); auto r1 = __builtin_amdgcn_permlane32_swap(a1, b1, false, false); \
        u32x4 w = {r0[0], r1[0], r0[1], r1[1]}; OUT = *reinterpret_cast<bf16x8*>(&w); } while (0)
    PK4(p, 0, pa0); PK4(p, 8, pa1);
#undef PK4
}
template <int KB>
__device__ __forceinline__ void kload(bf16x8* kf, unsigned K_lds, int krow, int hi) {
    unsigned kb[4];
#pragma unroll
    for (int dd = 0; dd < 4; ++dd) kb[dd] = K_lds + KB * SHM_K + KSWZ(krow, (dd * 16 + hi * 8) * 2);
#pragma unroll
    for (int d0 = 0; d0 < 8; ++d0) kf[d0] = *LP(const bf16x8, kb[d0 & 3] + (d0 >> 2) * 128);
}
__device__ __forceinline__ void qmma(f32x16& p, const bf16x8* kf, const bf16x8* qr) {
    p = f32x16{};
    if (ATTN_PRIO) __builtin_amdgcn_s_setprio(1);
#pragma unroll
    for (int d0 = 0; d0 < 8; ++d0) p = __builtin_amdgcn_mfma_f32_32x32x16_bf16(kf[d0], qr[d0], p, 0, 0, 0);
    if (ATTN_PRIO) __builtin_amdgcn_s_setprio(0);
}
__device__ __forceinline__ void pneg(f32x16& p) { const float NEG = -__builtin_inff();
#pragma unroll
    for (int r = 0; r < 16; ++r) p[r] = NEG; }
#if ATTN_PVSM == 2
#define PVB() __builtin_amdgcn_sched_barrier(0x406)
#else
#define PVB() SBAR()
#endif
template <int VB>
__device__ __forceinline__ void pv_tile(f32x16* o, int vbo, int vbp, bf16x8 po0, bf16x8 po1, bf16x8 pp0, bf16x8 pp1, bool act) {
    if (!act) return;
#define TRRD(dst, base, off) asm volatile("ds_read_b64_tr_b16 %0, %1 offset:%2" : "=&v"(dst) : "v"(base), "i"(off) : "memory")
#define PV_D0(d0) do { s16x4 l0, l1, l2, l3, h0, h1, h2, h3; constexpr int b_ = VB * SHM_V + (d0) * 512; if (ATTN_PRIO_WIDE) __builtin_amdgcn_s_setprio(1); \
        TRRD(l0, vbo, b_); TRRD(h0, vbo, b_ + 2048); TRRD(l1, vbo, b_ + 4096); TRRD(h1, vbo, b_ + 6144); TRRD(l2, vbp, b_); TRRD(h2, vbp, b_ + 2048); TRRD(l3, vbp, b_ + 4096); TRRD(h3, vbp, b_ + 6144); \
        asm volatile("s_waitcnt lgkmcnt(0)" ::: "memory"); PVB(); if (ATTN_PRIO) __builtin_amdgcn_s_setprio(1);  \
        o[d0] = __builtin_amdgcn_mfma_f32_32x32x16_bf16(po0, (bf16x8){l0[0], l0[1], l0[2], l0[3], h0[0], h0[1], h0[2], h0[3]}, o[d0], 0, 0, 0);   \
        o[d0] = __builtin_amdgcn_mfma_f32_32x32x16_bf16(po1, (bf16x8){l1[0], l1[1], l1[2], l1[3], h1[0], h1[1], h1[2], h1[3]}, o[d0], 0, 0, 0);   \
        o[d0] = __builtin_amdgcn_mfma_f32_32x32x16_bf16(pp0, (bf16x8){l2[0], l2[1], l2[2], l2[3], h2[0], h2[1], h2[2], h2[3]}, o[d0], 0, 0, 0);   \
        o[d0] = __builtin_amdgcn_mfma_f32_32x32x16_bf16(pp1, (bf16x8){l3[0], l3[1], l3[2], l3[3], h3[0], h3[1], h3[2], h3[3]}, o[d0], 0, 0, 0); if (ATTN_PRIO) __builtin_amdgcn_s_setprio(0); } while (0)
    PV_D0(0); PV_D0(1); PV_D0(2); PV_D0(3);
#undef PV_D0
#undef TRRD
}
__device__ __forceinline__ float partialSM_head(float pmax, float& m_reg, float& alpha) {
    constexpr float C2 = 1.4426950408889634f * SCALE; float mn;
    if (__builtin_expect(__all((pmax - m_reg) * SCALE <= THR), 1)) { mn = m_reg; alpha = 1.f; }
    else { mn = fmaxf(m_reg, pmax); alpha = __builtin_amdgcn_exp2f((m_reg - mn) * C2); m_reg = mn; }
    return -mn * C2;
}
#define PSM_SLICE(P_, i, mnL_) do { constexpr float C2_ = 1.4426950408889634f * SCALE; P_[i] = fmaf(P_[i], C2_, mnL_); if ((i) >= 8) P_[(i) - 8] = __builtin_amdgcn_exp2f(P_[(i) - 8]); } while (0)
#ifndef PVSM_TEST
#define PVSM_TEST 0
#endif
#ifndef PVSM_SBAR
#define PVSM_SBAR 1
#endif
#if PVSM_SBAR
#define PSB() SBAR()
#else
#define PSB() do {} while (0)
#endif
template <int VB>
__device__ __forceinline__ void pv_tile_sm(f32x16* o, int vbo, int vbp, bf16x8 po0, bf16x8 po1, bf16x8 pp0, bf16x8 pp1, bool act, f32x16& p, float mnL) {
    if (!act || PVSM_TEST) {
#pragma unroll
        for (int i = 0; i < 16; ++i) PSM_SLICE(p, i, mnL);
        if (PVSM_TEST) pv_tile<VB>(o, vbo, vbp, po0, po1, pp0, pp1, act);
        return; }
#define TRRD(dst, base, off) asm volatile("ds_read_b64_tr_b16 %0, %1 offset:%2" : "=&v"(dst) : "v"(base), "i"(off) : "memory")
#define PV_D0(d0) do { s16x4 l0, l1, l2, l3, h0, h1, h2, h3; constexpr int b_ = VB * SHM_V + (d0) * 512; \
        TRRD(l0, vbo, b_); TRRD(h0, vbo, b_ + 2048); TRRD(l1, vbo, b_ + 4096); TRRD(h1, vbo, b_ + 6144); TRRD(l2, vbp, b_); TRRD(h2, vbp, b_ + 2048); TRRD(l3, vbp, b_ + 4096); TRRD(h3, vbp, b_ + 6144); \
        asm volatile("s_waitcnt lgkmcnt(0)" ::: "memory"); SBAR();   \
        o[d0] = __builtin_amdgcn_mfma_f32_32x32x16_bf16(po0, (bf16x8){l0[0], l0[1], l0[2], l0[3], h0[0], h0[1], h0[2], h0[3]}, o[d0], 0, 0, 0); PSB(); PSM_SLICE(p, 4 * (d0) + 0, mnL); PSB();  \
        o[d0] = __builtin_amdgcn_mfma_f32_32x32x16_bf16(po1, (bf16x8){l1[0], l1[1], l1[2], l1[3], h1[0], h1[1], h1[2], h1[3]}, o[d0], 0, 0, 0); PSB(); PSM_SLICE(p, 4 * (d0) + 1, mnL); PSB();  \
        o[d0] = __builtin_amdgcn_mfma_f32_32x32x16_bf16(pp0, (bf16x8){l2[0], l2[1], l2[2], l2[3], h2[0], h2[1], h2[2], h2[3]}, o[d0], 0, 0, 0); PSB(); PSM_SLICE(p, 4 * (d0) + 2, mnL); PSB();  \
        o[d0] = __builtin_amdgcn_mfma_f32_32x32x16_bf16(pp1, (bf16x8){l3[0], l3[1], l3[2], l3[3], h3[0], h3[1], h3[2], h3[3]}, o[d0], 0, 0, 0); PSB(); PSM_SLICE(p, 4 * (d0) + 3, mnL); PSB(); } while (0)
    PV_D0(0); PV_D0(1); PV_D0(2); PV_D0(3);
#undef PV_D0
#undef TRRD
}
struct BlockRef { const bf16* Q; const bf16* K; const bf16* V; bf16* O; int P0; };
struct Seam { bf16x8 qr[8]; bf16x8 k0[2], k1[2], v0[2], v1[2], v2[2], v3[2]; };
#define VMW() asm volatile("s_waitcnt vmcnt(0)" ::: "memory")
typedef __amdgpu_buffer_rsrc_t rsrc_t;
__device__ __forceinline__ rsrc_t mkrsrc(const bf16* p) { return __builtin_amdgcn_make_buffer_rsrc((void*)p, (short)0, 0x7fffffff, 0x00020000); }
__device__ __forceinline__ bf16x8 bld16(rsrc_t r, unsigned voff, unsigned soff) { return __builtin_bit_cast(bf16x8, __builtin_amdgcn_raw_buffer_load_b128(r, (int)voff, (int)soff, 0)); }
#define RB(kk_, radd) ((unsigned)(((kk_) + (radd)) * PITCH) * 2u)
#define SLOADK(set, rK_, kk_) do { S.k0[set] = bld16(rK_, lofs, RB(kk_, 0)); S.k1[set] = bld16(rK_, lofs, RB(kk_, 32)); } while (0)
#define SLOADV(set, rV_, kk_) do { S.v0[set] = bld16(rV_, lofs, RB(kk_, 0)); S.v1[set] = bld16(rV_, lofs, RB(kk_, 32)); S.v2[set] = bld16(rV_, lofs, RB(kk_, 0) + 256u); S.v3[set] = bld16(rV_, lofs, RB(kk_, 32) + 256u); } while (0)
#define SWRITE_K(bf, set) do { *LP(bf16x8, K_lds + (bf) * SHM_K + kws) = S.k0[set]; *LP(bf16x8, K_lds + (bf) * SHM_K + kws + 32 * 256) = S.k1[set]; } while (0)
#define SWRITE_V(bf, set) do { *LP(bf16x8, V_lds + (bf) * SHM_V + vst0) = S.v0[set]; *LP(bf16x8, V_lds + (bf) * SHM_V + vst0 + VST1) = S.v1[set]; *LP(bf16x8, V_lds + (bf) * SHM_V + IMG + vst0) = S.v2[set]; *LP(bf16x8, V_lds + (bf) * SHM_V + IMG + vst0 + VST1) = S.v3[set]; } while (0)
#define DMA16(rs_, ldsaddr_, voff_, soff_) __builtin_amdgcn_raw_ptr_buffer_load_lds(rs_, (L3 unsigned*)(uintptr_t)(unsigned)(ldsaddr_), 16, (int)(voff_), (int)(soff_), 0, 0)
#define DMAK(bf, rK_, kk_) do { DMA16(rK_, K_lds + (bf) * SHM_K + (2 * wid) * 1024, kofs0, RB((kk_) + 8 * wid, 0)); DMA16(rK_, K_lds + (bf) * SHM_K + (2 * wid + 1) * 1024, kofs1, RB((kk_) + 8 * wid, 4)); } while (0)
#define DMAV(bf, rV_, kk_) do { DMA16(rV_, V_lds + (bf) * SHM_V + (2 * wid) * 1024, vofs, RB(kk_, 0)); DMA16(rV_, V_lds + (bf) * SHM_V + (2 * wid + 1) * 1024, vofs, RB(kk_, 0) + 128u); \
                                DMA16(rV_, V_lds + (bf) * SHM_V + IMG + (2 * wid) * 1024, vofs, RB(kk_, 0) + 256u); DMA16(rV_, V_lds + (bf) * SHM_V + IMG + (2 * wid + 1) * 1024, vofs, RB(kk_, 0) + 384u); } while (0)
#define DMA_LANE_OFFS() const unsigned kofs0 = (unsigned)((lane >> 4) * PITCH) * 2u + (unsigned)((16 * (lane & 15)) ^ ((lane >> 4) << 4)), kofs1 = (unsigned)((lane >> 4) * PITCH) * 2u + (unsigned)((16 * (lane & 15)) ^ ((4 + (lane >> 4)) << 4)); \
    const int vkk_ = 8 * wid + ((lane & 31) >> 2), vk_ = (vkk_ & ~0xC) | ((vkk_ & 4) << 1) | ((vkk_ & 8) >> 1); const unsigned vofs = (unsigned)(vk_ * PITCH + (lane >> 5) * 32 + (lane & 3) * 8) * 2u
__device__ __forceinline__ void attn_prime(const BlockRef& cur, char* lds, Seam& S, int tid) {
    const int wid = __builtin_amdgcn_readfirstlane(tid >> 6), lane = tid & 63, r32 = lane & 31, hi = lane >> 5, pj = wid & 3;
    const int sr = tid >> 4, sc = (tid & 15) * 8, kws = KSWZ(sr, sc * 2); const unsigned K_lds = (unsigned)(uintptr_t)lds + OFF_K, lofs = (unsigned)(sr * PITCH + sc) * 2u, qofs = (unsigned)(r32 * PITCH + hi * 8) * 2u;
    const rsrc_t rQ = mkrsrc(cur.Q), rK = mkrsrc(cur.K), rV = mkrsrc(cur.V);
#pragma unroll
    for (int d0 = 0; d0 < 8; ++d0) S.qr[d0] = bld16(rQ, qofs, (unsigned)((pj * QBLK) * PITCH + d0 * 16) * 2u);
#if ATTN_DMA
    { const unsigned V_lds = (unsigned)(uintptr_t)lds + OFF_V; (void)V_lds; (void)rV; (void)kws; (void)lofs; DMA_LANE_OFFS(); (void)vofs;
      DMAK(0, rK, 0); DMAK(1, rK, KVBLK); VMW(); }
#else
    SLOADK(0, rK, 0); VMW(); SWRITE_K(0, 0); SBAR();
    SLOADK(1, rK, KVBLK); SLOADV(0, rV, 0); SLOADK(0, rK, 2 * KVBLK); SLOADV(1, rV, KVBLK);
#endif
    __syncthreads();
}
__device__ __forceinline__ void attn_block(const BlockRef& cur, const BlockRef& nxt, char* lds, Seam& S, int tid) {
    const int wid = __builtin_amdgcn_readfirstlane(tid >> 6), lane = tid & 63, r32 = lane & 31, hi = lane >> 5, pj = wid & 3, kh = wid >> 2, pw = wid ^ 4;
    const int NT = cur.P0 / KVBLK + QB / KVBLK, NTn = nxt.P0 / KVBLK + QB / KVBLK;
    const int qlo = cur.P0 + pj * QBLK, cw = qlo >> 6;
    const unsigned L = (unsigned)(uintptr_t)lds, V_lds = L + OFF_V, K_lds = L + OFF_K;
    L3 float* li_l = LP(float, L + OFF_WS + wid * 256); L3 float* al_l = li_l + 32; const L3 float* li_p = LP(const float, L + OFF_WS + pw * 256);
    L3 float* mx_o = LP(float, L + OFF_MX + wid * 128); const L3 float* mx_p = LP(const float, L + OFF_MX + pw * 128);
    const unsigned px_o = L + OFF_PX + wid * 2048 + lane * 16, px_p = L + OFF_PX + pw * 2048 + lane * 16;
    const L3 float* btab = LP(const float, L + BIAS_OFF);
    float m_reg = -1e30f, l_reg = 0; f32x16 o[4] = {};
    const int sr = tid >> 4, sc = (tid & 15) * 8, vst0 = v_st(sr, sc), kws = KSWZ(sr, sc * 2); constexpr int VST1 = 8192;
    const unsigned lofs = (unsigned)(sr * PITCH + sc) * 2u, qofs = (unsigned)(r32 * PITCH + hi * 8) * 2u;
    const int vbase = (int)V_lds + v_rd_base(lane) + kh * IMG, vbo = vbase + kh * 8192, vbp = vbase + (1 - kh) * 8192;
    const int krow = kh * 32 + r32;
    const rsrc_t cK = mkrsrc(cur.K), cV = mkrsrc(cur.V), nK = mkrsrc(nxt.K), nV = mkrsrc(nxt.V);
    const int bb0 = qlo + r32 - 4 * hi + 4 - 32 * kh;
#define RESC(a) do { if (__any((a) < 1.f)) { if (hi == 0) al_l[r32] = (a); asm volatile("s_waitcnt lgkmcnt(0)" ::: "memory");              \
                     for (int d_ = 0; d_ < 4; ++d_) for (int r = 0; r < 16; ++r) o[d_][r] *= al_l[crow(r, hi)]; } } while (0)
#define KBASE(t) ((t) * KVBLK)
#define ACT(t) ((t) <= cw)
#define BIAST(P_, t) do { if ((t) <= cw && (t) + 2 >= cw) bias_half(P_, btab + (bb0 - KBASE(t))); } while (0)
#define PUTMAX(P_) do { const float pm_ = rowmax_half(P_); if (hi == 0) mx_o[r32] = pm_; pmx = pm_; } while (0)
#define GETMAX() fmaxf(pmx, mx_p[r32])
#define VLOADK(set, v) do { const int v_ = (v); if (v_ < NT) SLOADK(set, cK, KBASE(v_)); else SLOADK(set, nK, KBASE((v_ - NT) % NTn)); } while (0)
#define VLOADV(set, v) do { const int v_ = (v); if (v_ < NT) SLOADV(set, cV, KBASE(v_)); else SLOADV(set, nV, KBASE((v_ - NT) % NTn)); } while (0)
#if ATTN_DMA
#define KDMA_V(bf, v) do { const int v_ = (v); if (v_ < NT) DMAK(bf, cK, KBASE(v_)); else DMAK(bf, nK, KBASE((v_ - NT) % NTn)); } while (0)
#define STAGE_A(KB, t) do { SBAR(); DMAV(KB, cV, KBASE(t)); SBAR(); } while (0)
#define STAGE_B(KB, t) do { SBAR(); KDMA_V(KB, (t) + 2); SBAR(); } while (0)
#define DMA_WAIT() asm volatile("s_waitcnt vmcnt(6)" ::: "memory")
    DMA_LANE_OFFS();
#else
#define STAGE_A(KB, t) do { SBAR(); SWRITE_V(KB, KB); SBAR(); VLOADV(KB, (t) + 2); SBAR(); } while (0)
#define STAGE_B(KB, t) do { SBAR(); SWRITE_K(1 - KB, 1 - KB); SBAR(); VLOADK(1 - KB, (t) + 3); SBAR(); } while (0)
#define DMA_WAIT() do {} while (0)
#endif
    f32x16 pA, pB; float alA, alB, pmx, mnpA = 0.f, mnpB = 0.f; bf16x8 po0, po1, pp0, pp1;
#define STEP(PX_, alX, PY_, alY, t, KB, HASPREV) do {                                                                               \
        STAGE_A(KB, t);                                                                                                            \
        if (ACT(t)) { bf16x8 kf_[8]; if (ATTN_PRIO_WIDE) __builtin_amdgcn_s_setprio(1); kload<KB>(kf_, K_lds, krow, hi); SBAR(); qmma(PX_, kf_, S.qr);                                  \
                      if (HASPREV) { finishSM(PY_, alY, l_reg, po0, po1, mn##PY_); *LP(bf16x8, px_o) = po0; *LP(bf16x8, px_o + 1024) = po1; } SGB_A(); }   \
        else { pneg(PX_); if (HASPREV) { finishSM(PY_, alY, l_reg, po0, po1, mn##PY_); *LP(bf16x8, px_o) = po0; *LP(bf16x8, px_o + 1024) = po1; } }        \
        SBAR(); BIAST(PX_, (t)); PUTMAX(PX_);                                                                                       \
        DMA_WAIT(); __syncthreads();                                                                                               \
        if (HASPREV) { pp0 = *LP(const bf16x8, px_p); pp1 = *LP(const bf16x8, px_p + 1024); }                                        \
        if (ATTN_PVSM == 1 && (HASPREV)) { const float mnL_ = partialSM_head(GETMAX(), m_reg, alX); pv_tile_sm<1 - KB>(o, vbo, vbp, po0, po1, pp0, pp1, ACT((t) - 1), PX_, mnL_); }   \
        else { if (ATTN_SMLATE) mn##PX_ = partialSM_head(GETMAX(), m_reg, alX); else partialSM(PX_, GETMAX(), m_reg, alX); if (HASPREV) pv_tile<1 - KB>(o, vbo, vbp, po0, po1, pp0, pp1, ACT((t) - 1)); }  \
        STAGE_B(KB, t);                                                                                                            \
        RESC(alX); DMA_WAIT(); __syncthreads(); } while (0)
    for (int t = 0; t < NT; t += 2) {
        STEP(pA, alA, pB, alB, t, 0, t > 0);
        STEP(pB, alB, pA, alA, t + 1, 1, true);
    }
    { const rsrc_t nQ = mkrsrc(nxt.Q);
#pragma unroll
      for (int d0 = 0; d0 < 8; ++d0) S.qr[d0] = bld16(nQ, qofs, (unsigned)((pj * QBLK) * PITCH + d0 * 16) * 2u); }
    SBAR();
    finishSM(pB, alB, l_reg, po0, po1, mnpB); *LP(bf16x8, px_o) = po0; *LP(bf16x8, px_o + 1024) = po1;
    if (hi == 0) li_l[r32] = l_reg;
#if ATTN_DMA
    asm volatile("s_waitcnt vmcnt(10)" ::: "memory");
#endif
    __syncthreads();
    pp0 = *LP(const bf16x8, px_p); pp1 = *LP(const bf16x8, px_p + 1024);
    pv_tile<1>(o, vbo, vbp, po0, po1, pp0, pp1, ACT(NT - 1));
    float rli[16];
#pragma unroll
    for (int r = 0; r < 16; ++r) rli[r] = __builtin_amdgcn_rcpf(li_l[crow(r, hi)] + li_p[crow(r, hi)]);
    int lane_off = hi * 4 * PITCH + r32; asm volatile("" : "+v"(lane_off));
    bf16* Ow = cur.O + ((pj * QBLK) * PITCH + kh * 128 + lane_off);
#pragma unroll
    for (int r = 0; r < 16; ++r) { const int orow = (r & 3) + 8 * (r >> 2);
#pragma unroll
        for (int d0 = 0; d0 < 4; ++d0) { const float v = o[d0][r] * rli[r];
            const float vn = __shfl_xor(v, 1);
            if ((r32 & 1) == 0) *(unsigned*)(Ow + (orow * PITCH + d0 * 32)) = cvtpk(v, vn); } }
    __syncthreads();
#undef RESC
#undef KBASE
#undef ACT
#undef BIAST
#undef PUTMAX
#undef GETMAX
#undef VLOADK
#undef VLOADV
#undef STAGE_A
#undef STAGE_B
#undef DMA_WAIT
#undef STEP
}
#undef SLOADK
#undef SLOADV
#undef SWRITE_K
#undef SWRITE_V
#undef VMW
#undef RB
#undef KSWZ
#undef L3
#undef LP
#undef SGB_A
}


constexpr int NWAVES = 8;
constexpr int BATCH = 16, SEQ = 2048, T = BATCH * SEQ, D = 1024, NIN = 8192, NE = 32, DE = 512;
constexpr int MAXT = 288, MAXS = MAXT * 256;
constexpr float LN_EPS = 1e-5f, RMS_EPS = 1e-6f, ALPHA = 1.189207115002721f, LAM_INIT = 0.2f;
constexpr size_t MiB = 1u << 20;
constexpr size_t WS_CTL = 0, CTL_ZERO_BYTES = 1 * MiB;
constexpr size_t WS_STATS = 1 * MiB, WS_EID = WS_STATS + 256 * 1024, WS_EW = WS_EID + 256 * 1024, WS_RANK = WS_EW + 256 * 1024, WS_SLOT = 2 * MiB, WS_CNTWG = WS_SLOT + 256 * 1024, WS_TOK = 3 * MiB, WS_IDL = WS_TOK + 512 * 1024;
constexpr size_t WS_WA = 4 * MiB, WS_WB = 6 * MiB, WS_WO = 8 * MiB, WS_WIN = 10 * MiB;
constexpr size_t WS_XN = 26 * MiB, WS_Q = 90 * MiB, WS_K = 154 * MiB, WS_V = 218 * MiB, WS_CB = 282 * MiB, WS_Z = 346 * MiB, WS_O1 = 410 * MiB;
constexpr size_t WS_WGU = 90 * MiB, WS_WD = 154 * MiB, WS_PRE = 186 * MiB, WS_XG = 314 * MiB, WS_END = 483 * MiB;
constexpr size_t WS_WIN8 = 410 * MiB, WS_XN8 = 426 * MiB;
constexpr float XN8_S = 16.f;
constexpr size_t WS_WGU8 = 90 * MiB, WS_WD8 = 122 * MiB, WS_X18 = 250 * MiB;
constexpr int CW_TMO = 0, CW_CODE = 1, CW_BAR = 4096, CW_MOE = 65536, CW_GCNT = 200000;
constexpr size_t WS_RWIMG = 482 * MiB;
constexpr size_t WS_TOKE = 474 * MiB; constexpr int TOKE_CAP = 65536;
constexpr int RING_OFF = 0, RING_BYTES = 131072, RW_BYTES = 147456;
constexpr int LDSCTL_OFF = RW_BYTES, MISC_OFF = LDSCTL_OFF + 320, TAB_OFF = LDSCTL_OFF + 512, RSCR_OFF = LDSCTL_OFF + 1024;
constexpr int LDS_BYTES = 163840;
constexpr int LEID_OFF = LDSCTL_OFF + 6144, LRANK_OFF = LDSCTL_OFF + 7168;
static_assert(RSCR_OFF + 8 * 128 * 4 + 1024 <= LEID_OFF && LRANK_OFF + 1024 <= LDS_BYTES, "LDS map");

#define GAS __attribute__((address_space(1)))
#define LAS __attribute__((address_space(3)))
typedef unsigned short bf16;
#ifdef SWAP_CB_SGA
#define BUF_CB(P)  ((bf16*)(P).out)
#define BUF_SGA(P) ((bf16*)((P).ws + WS_CB))
#else
#define BUF_CB(P)  ((bf16*)((P).ws + WS_CB))
#define BUF_SGA(P) ((bf16*)(P).out)
#endif
#if G8XN
#undef BUF_SGA
#define BUF_SGA(P) ((bf16*)(P).out)
#define BUF_SGB(P) ((bf16*)((unsigned char*)(P).out + (size_t)T * D))
#define BUF_XN(P)  ((bf16*)(P).out + (size_t)T * D)
#else
#define BUF_SGB(P) ((bf16*)(P).out + (size_t)T * D)
#define BUF_XN(P)  ((bf16*)((P).ws + WS_XN))
#endif
typedef unsigned v4u __attribute__((ext_vector_type(4)));
typedef unsigned v2u __attribute__((ext_vector_type(2)));
typedef float f32x4 __attribute__((ext_vector_type(4)));
typedef GAS unsigned gu32;
#define RLX_AGENT __ATOMIC_RELAXED, __HIP_MEMORY_SCOPE_AGENT
#define LDS_WAIT() asm volatile("s_waitcnt lgkmcnt(0)" ::: "memory")
#define VM_WAIT() asm volatile("s_waitcnt vmcnt(0)" ::: "memory")
__device__ __forceinline__ unsigned f2bf(float f) { unsigned u = __builtin_bit_cast(unsigned, f); return (u + 0x7fffu + ((u >> 16) & 1u)) >> 16; }
__device__ __forceinline__ unsigned pk2(float lo, float hi) { return f2bf(lo) | (f2bf(hi) << 16); }
__device__ __forceinline__ float bflo(unsigned w) { return __uint_as_float(w << 16); }
__device__ __forceinline__ float bfhi(unsigned w) { return __uint_as_float(w & 0xffff0000u); }

#define XB_TMO      128
#define XB_XCNT(j)  (256  + 64 * (j))
#define XB_XSUB(j)  (1280 + 64 * (j))
#define XB_XGEN(j)  (2304 + 64 * (j))
#define XB_TOP      3328
#define XB_TOPGEN   3392
#define XCD_BAR_WORDS 3456
#define XB_SPIN_CAP (1u << 18)
__device__ __forceinline__ unsigned xb_ld(unsigned* p)              { return __hip_atomic_load(p, __ATOMIC_RELAXED, __HIP_MEMORY_SCOPE_AGENT); }
__device__ __forceinline__ unsigned xb_add(unsigned* p, unsigned v) { return __hip_atomic_fetch_add(p, v, __ATOMIC_RELAXED, __HIP_MEMORY_SCOPE_AGENT); }
__device__ __forceinline__ unsigned xb_xcc_id() { return (unsigned)__builtin_amdgcn_s_getreg((3 << 11) | 20) & 0xFu; }
#define XB_SPIN(cond, bar) do { unsigned _sp = 0; while (cond) { __builtin_amdgcn_s_sleep(1); \
    if ((++_sp & 255u) == 0u) { if (xb_ld(&(bar)[XB_TMO])) break; if (_sp > XB_SPIN_CAP) { atomicAdd(&(bar)[XB_TMO], 1u); break; } } } } while (0)
struct XcdBarrier { unsigned* bar; unsigned x; volatile LAS unsigned* st; int wave; };
__device__ __forceinline__ XcdBarrier xcd_barrier_post(unsigned* bar, volatile LAS unsigned* st, int wave) {
    XcdBarrier b; b.bar = bar; b.x = xb_xcc_id(); b.st = st; b.wave = wave;
    if (wave == 0 && lane_fresh() == 0) (void)xb_add(&bar[XB_XCNT(b.x)], 1u);
    return b;
}
__device__ __forceinline__ void xcd_barrier_complete(unsigned* bar, unsigned x, unsigned& nloc, unsigned& nx) {
    const unsigned G = gridDim.x * gridDim.y * gridDim.z;
    unsigned sum, cnt, mine, sp = 0u;
    for (;;) {
        sum = 0u; cnt = 0u; mine = 0u;
#pragma unroll
        for (unsigned j = 0; j < 16; ++j) { const unsigned c = xb_ld(&bar[XB_XCNT(j)]); sum += c; cnt += (c > 0u) ? 1u : 0u; mine = (j == x) ? c : mine; }
        if (sum == G) break;
        __builtin_amdgcn_s_sleep(1);
        if ((++sp & 255u) == 0u) { if (xb_ld(&bar[XB_TMO])) break; if (sp > XB_SPIN_CAP) { atomicAdd(&bar[XB_TMO], 1u); break; } }
    }
    nloc = mine > 0u ? mine : 1u; nx = cnt > 0u ? cnt : 1u;
}
__device__ __forceinline__ void xcd_barrier(const XcdBarrier& b) {
    asm volatile("s_waitcnt vmcnt(0)" ::: "memory");
    __syncthreads();
    if (b.wave == 0 && lane_fresh() == 0) {
        unsigned* bar = b.bar;
        __builtin_amdgcn_s_waitcnt(0);
        unsigned nloc = b.st[0], nx = b.st[1];
        if (nloc == 0u) { xcd_barrier_complete(bar, b.x, nloc, nx); b.st[0] = nloc; b.st[1] = nx; }
        const unsigned old = xb_add(&bar[XB_XSUB(b.x)], 1u);
        const unsigned gen = old / nloc;
        if (old + 1u == (gen + 1u) * nloc) {
            __builtin_amdgcn_fence(__ATOMIC_RELEASE, "agent");
            asm volatile("s_waitcnt vmcnt(0)" ::: "memory");
            const unsigned og = xb_add(&bar[XB_TOP], 1u);
            const unsigned tg = og / nx;
            if (og + 1u == (tg + 1u) * nx) xb_add(&bar[XB_TOPGEN], 1u);
            else XB_SPIN(xb_ld(&bar[XB_TOPGEN]) == tg, bar);
            __builtin_amdgcn_fence(__ATOMIC_ACQUIRE, "agent");
            xb_add(&bar[XB_XGEN(b.x)], 1u);
            asm volatile("s_waitcnt vmcnt(0)" ::: "memory");
        } else {
            XB_SPIN(xb_ld(&bar[XB_XGEN(b.x)]) == gen, bar);
            __builtin_amdgcn_fence(__ATOMIC_ACQUIRE, "agent");
            asm volatile("s_waitcnt vmcnt(0)" ::: "memory");
        }
    }
    __syncthreads();
}

struct Frame {
    LAS unsigned char* lds; volatile LAS unsigned* MISC; gu32* ctl;
    int tid, lane, wave, vcu, G;
};
__device__ __forceinline__ float wave_sum(float v) {
#pragma unroll
    for (int o = 1; o < 64; o <<= 1) v += __shfl_xor(v, o);
    return v;
}
__device__ __forceinline__ float wave_sum_fast(float v) {
    v += __int_as_float(__builtin_amdgcn_update_dpp(0, __float_as_int(v), 0x128, 0xf, 0xf, false));
    v += __int_as_float(__builtin_amdgcn_update_dpp(0, __float_as_int(v), 0x124, 0xf, 0xf, false));
    v += __int_as_float(__builtin_amdgcn_update_dpp(0, __float_as_int(v), 0x122, 0xf, 0xf, false));
    v += __int_as_float(__builtin_amdgcn_update_dpp(0, __float_as_int(v), 0x121, 0xf, 0xf, false));
    const int vi = __float_as_int(v);
    return (__int_as_float(__builtin_amdgcn_readlane(vi, 0)) + __int_as_float(__builtin_amdgcn_readlane(vi, 16))) + (__int_as_float(__builtin_amdgcn_readlane(vi, 32)) + __int_as_float(__builtin_amdgcn_readlane(vi, 48)));
}
__device__ __forceinline__ void transpose_item(const float* W, int K, int N, int k0, int n0, bf16* WT, int drow0, LAS float* scr, int lane) {
#pragma unroll 8
    for (int i = 0; i < 32; ++i) { const int kk = 2 * i + (lane >> 5); scr[kk * 33 + (lane & 31)] = W[(size_t)(k0 + kk) * N + n0 + (lane & 31)]; }
    LDS_WAIT(); asm volatile("" ::: "memory");
    const int c = lane & 7;
#pragma unroll
    for (int j = 0; j < 4; ++j) { const int n = (lane >> 3) + 8 * j; const LAS float* s = scr + (8 * c) * 33 + n;
        v4u o; o.x = pk2(s[0 * 33], s[1 * 33]); o.y = pk2(s[2 * 33], s[3 * 33]); o.z = pk2(s[4 * 33], s[5 * 33]); o.w = pk2(s[6 * 33], s[7 * 33]);
        *(GAS v4u*)(WT + (size_t)(drow0 + n) * K + k0 + 8 * c) = o; }
    LDS_WAIT(); asm volatile("" ::: "memory");
}
__device__ __forceinline__ void transpose_item_p(const float* W, int N, int k0, int n0, bf16* WT, int dpitch, int dcol0, int drow0, LAS float* scr, int lane) {
#pragma unroll 8
    for (int i = 0; i < 32; ++i) { const int kk = 2 * i + (lane >> 5); scr[kk * 33 + (lane & 31)] = W[(size_t)(k0 + kk) * N + n0 + (lane & 31)]; }
    LDS_WAIT(); asm volatile("" ::: "memory");
    const int c = lane & 7;
#pragma unroll
    for (int j = 0; j < 4; ++j) { const int n = (lane >> 3) + 8 * j; const LAS float* s = scr + (8 * c) * 33 + n;
        v4u o; o.x = pk2(s[0 * 33], s[1 * 33]); o.y = pk2(s[2 * 33], s[3 * 33]); o.z = pk2(s[4 * 33], s[5 * 33]); o.w = pk2(s[6 * 33], s[7 * 33]);
        *(GAS v4u*)(WT + (size_t)(drow0 + n) * dpitch + dcol0 + 8 * c) = o; }
    LDS_WAIT(); asm volatile("" ::: "memory");
}
__device__ __forceinline__ void transpose_item8(const float* W, int K, int N, int k0, int n0, unsigned char* WT, int drow0, LAS float* scr, int lane) {
#pragma unroll 8
    for (int i = 0; i < 32; ++i) { const int kk = 2 * i + (lane >> 5); scr[kk * 33 + (lane & 31)] = W[(size_t)(k0 + kk) * N + n0 + (lane & 31)]; }
    LDS_WAIT(); asm volatile("" ::: "memory");
    const int c = lane & 7; constexpr float sc = pg8::F8_WS;
#pragma unroll
    for (int j = 0; j < 4; ++j) { const int n = (lane >> 3) + 8 * j; const LAS float* s = scr + (8 * c) * 33 + n;
        v2u o; o.x = pg8::pk4_fp8(s[0 * 33] * sc, s[1 * 33] * sc, s[2 * 33] * sc, s[3 * 33] * sc); o.y = pg8::pk4_fp8(s[4 * 33] * sc, s[5 * 33] * sc, s[6 * 33] * sc, s[7 * 33] * sc);
        *(GAS v2u*)(WT + (size_t)(drow0 + n) * K + k0 + 8 * c) = o; }
    LDS_WAIT(); asm volatile("" ::: "memory");
}
__device__ __forceinline__ int win_drow(int n0) {
    if (n0 < 4096 || n0 >= 6144) return n0;
    if (n0 < 5120) { const int r = n0 - 4096; return 4096 + 256 * (r >> 7) + (r & 127); }
    const int r = n0 - 5120; return 4096 + 256 * (r >> 7) + 128 + (r & 127);
}
struct Ptrs {
    const float *x, *ln_in_g, *ln_in_b, *w_in, *b_gate, *lq, *lk, *subln_g, *rel_bias, *conv_w, *w_a, *w_b, *w_o, *ln1_g, *ln1_b, *w_group, *b_group, *w_sub, *b_sub, *w_gate_e, *w_up_e, *w_down_e, *ln2_g, *ln2_b;
    float* out; unsigned char* ws;
};
__device__ __forceinline__ void p0_prologue(Frame& F, const Ptrs& P) {
    LAS float* scr = (LAS float*)(F.lds + RING_OFF + F.wave * 16384);
    const int gw = F.vcu * NWAVES + F.wave, NGW = F.G * NWAVES;
    constexpr int I_IN = (D / 64) * (NIN / 32), I_SQ = (D / 64) * (D / 32);
    bf16* Wt_in = (bf16*)(P.ws + WS_WIN); bf16* Wt_a = (bf16*)(P.ws + WS_WA); bf16* Wt_b = (bf16*)(P.ws + WS_WB); bf16* Wt_o = (bf16*)(P.ws + WS_WO);
    for (int it = gw; it < I_IN + 3 * I_SQ; it += NGW) {
        int r = it;
        if (r < I_IN) { const int kb = r / (NIN / 32), nb = r % (NIN / 32); const int dr = win_drow(32 * nb), tile = dr >> 8;
            if (((tile - INPROJ_F8_LO) & 31) < INPROJ_F8_HI - INPROJ_F8_LO) transpose_item8(P.w_in, D, NIN, 64 * kb, 32 * nb, (unsigned char*)(P.ws + WS_WIN8), dr, scr, F.lane);
            else transpose_item(P.w_in, D, NIN, 64 * kb, 32 * nb, Wt_in, dr, scr, F.lane);
            continue; } r -= I_IN;
        const int which = r / I_SQ; r -= which * I_SQ; const int kb = r / (D / 32), nb = r % (D / 32);
        const float* W = which == 0 ? P.w_a : (which == 1 ? P.w_b : P.w_o);
        if (GATE_MERGED && which < 2) transpose_item_p(W, D, 64 * kb, 32 * nb, Wt_a, 2 * D, 64 * kb + which * D, 32 * nb, scr, F.lane);
        else { bf16* WT = which == 0 ? Wt_a : (which == 1 ? Wt_b : Wt_o); transpose_item(W, D, D, 64 * kb, 32 * nb, WT, 32 * nb, scr, F.lane); }
    }
    bf16* XN = BUF_XN(P); float* stats = (float*)(P.ws + WS_STATS);
    for (int m = gw; m < T; m += NGW) {
        f32x4 v[4]; float s = 0.f;
        const GAS f32x4* xr = (const GAS f32x4*)(P.x + (size_t)m * D) + F.lane;
#pragma unroll
        for (int j = 0; j < 4; ++j) { v[j] = xr[64 * j]; s += (v[j].x + v[j].y) + (v[j].z + v[j].w); }
        const float mean = wave_sum(s) * (1.f / D); float s2 = 0.f;
#pragma unroll
        for (int j = 0; j < 4; ++j) { v[j] = v[j] - mean; s2 += (v[j].x * v[j].x + v[j].y * v[j].y) + (v[j].z * v[j].z + v[j].w * v[j].w); }
        const float rstd = 1.f / sqrtf(wave_sum(s2) * (1.f / D) + LN_EPS);
        GAS unsigned long long* o8 = (GAS unsigned long long*)(XN + (size_t)m * D) + F.lane;
#pragma unroll
        for (int j = 0; j < 4; ++j) { const f32x4 g = *((const GAS f32x4*)P.ln_in_g + F.lane + 64 * j), b = *((const GAS f32x4*)P.ln_in_b + F.lane + 64 * j); const f32x4 y = v[j] * rstd * g + b;
            if (INPROJ_F8_HI - INPROJ_F8_LO < 32) o8[64 * j] = (unsigned long long)pk2(y.x, y.y) | ((unsigned long long)pk2(y.z, y.w) << 32);
            if (INPROJ_F8_HI > INPROJ_F8_LO) *((GAS unsigned*)(P.ws + WS_XN8 + (size_t)m * D) + F.lane + 64 * j) = pg8::pk4_fp8(fminf(fmaxf(y.x * XN8_S, -440.f), 440.f), fminf(fmaxf(y.y * XN8_S, -440.f), 440.f), fminf(fmaxf(y.z * XN8_S, -440.f), 440.f), fminf(fmaxf(y.w * XN8_S, -440.f), 440.f)); }
        if (F.lane == 0) { stats[2 * m] = mean; stats[2 * m + 1] = rstd; }
    }
}
__device__ __forceinline__ void p2_conv(Frame& F, const Ptrs& P) {
    bf16* CB = BUF_CB(P); const bf16* Z = (const bf16*)(P.ws + WS_Z);
    const int gw = F.vcu * NWAVES + F.wave, NGW = F.G * NWAVES, c0 = 16 * F.lane;
    float w0[16], w1[16], w2[16];
#pragma unroll
    for (int i = 0; i < 16; ++i) { w0[i] = P.conv_w[c0 + i]; w1[i] = P.conv_w[D + c0 + i]; w2[i] = P.conv_w[2 * D + c0 + i]; }
    for (int ch = gw; ch < T / 16; ch += NGW) {
        const int r0 = ch * 16; float z2[16], z1[16];
        if ((r0 & (SEQ - 1)) == 0) {
#pragma unroll
            for (int i = 0; i < 16; ++i) { z2[i] = 0.f; z1[i] = 0.f; }
        } else {
            const v4u a0 = *(const GAS v4u*)(Z + (size_t)(r0 - 2) * D + c0), a1 = *(const GAS v4u*)(Z + (size_t)(r0 - 2) * D + c0 + 8), b0 = *(const GAS v4u*)(Z + (size_t)(r0 - 1) * D + c0), b1 = *(const GAS v4u*)(Z + (size_t)(r0 - 1) * D + c0 + 8);
#pragma unroll
            for (int i = 0; i < 4; ++i) { z2[2 * i] = bflo(a0[i]); z2[2 * i + 1] = bfhi(a0[i]); z2[8 + 2 * i] = bflo(a1[i]); z2[8 + 2 * i + 1] = bfhi(a1[i]);
                                          z1[2 * i] = bflo(b0[i]); z1[2 * i + 1] = bfhi(b0[i]); z1[8 + 2 * i] = bflo(b1[i]); z1[8 + 2 * i + 1] = bfhi(b1[i]); }
        }
#pragma unroll 2
        for (int rr = 0; rr < 16; ++rr) { const size_t off = (size_t)(r0 + rr) * D + c0;
            const v4u za = *(const GAS v4u*)(Z + off), zb = *(const GAS v4u*)(Z + off + 8), ca = *(const GAS v4u*)(CB + off), cb = *(const GAS v4u*)(CB + off + 8);
            float zc[16], cv[16];
#pragma unroll
            for (int i = 0; i < 4; ++i) { zc[2 * i] = bflo(za[i]); zc[2 * i + 1] = bfhi(za[i]); zc[8 + 2 * i] = bflo(zb[i]); zc[8 + 2 * i + 1] = bfhi(zb[i]);
                                          cv[2 * i] = bflo(ca[i]); cv[2 * i + 1] = bfhi(ca[i]); cv[8 + 2 * i] = bflo(cb[i]); cv[8 + 2 * i + 1] = bfhi(cb[i]); }
            float u[16];
#pragma unroll
            for (int i = 0; i < 16; ++i) { u[i] = cv[i] * (z2[i] * w0[i] + z1[i] * w1[i] + zc[i] * w2[i]); z2[i] = z1[i]; z1[i] = zc[i]; }
            v4u oa, ob;
#pragma unroll
            for (int i = 0; i < 4; ++i) { oa[i] = pk2(u[2 * i], u[2 * i + 1]); ob[i] = pk2(u[8 + 2 * i], u[8 + 2 * i + 1]); }
            *(GAS v4u*)(CB + off) = oa; *(GAS v4u*)(CB + off + 8) = ob; }
    }
}
__device__ __forceinline__ attn::BlockRef attn_ref(const Ptrs& P, int s, int qb) {
    const int vh = s & 1, m = (s >> 1) & 1, h = (s >> 2) & 3, b = s >> 4;
    attn::BlockRef r; const size_t rowb = (size_t)b * SEQ * D;
    r.Q = (const bf16*)(P.ws + WS_Q) + rowb + (size_t)qb * 256 * D + h * 256 + m * 128;
    r.K = (const bf16*)(P.ws + WS_K) + rowb + h * 256 + m * 128;
    r.V = (const bf16*)(P.ws + WS_V) + rowb + h * 256 + vh * 128;
    r.O = (bf16*)(P.ws + (m ? WS_O1 : WS_XN)) + rowb + (size_t)qb * 256 * D + h * 256 + vh * 128;
    r.P0 = qb * 256; return r;
}
#ifndef P1_ALIGN
#define P1_ALIGN true
#endif
#ifndef P1_SP2
#define P1_SP2 true
#endif
#ifndef ATTN_PAIR
#define ATTN_PAIR 1
#endif
__device__ __forceinline__ attn2::BlockRef attn2_ref(const Ptrs& P, int st, int qb) {
    const int m = st & 1, h = (st >> 1) & 3, b = st >> 3;
    attn2::BlockRef r; const size_t rowb = (size_t)b * SEQ * D;
    r.Q = (const bf16*)(P.ws + WS_Q) + rowb + (size_t)qb * 128 * D + h * 256 + m * 128;
    r.K = (const bf16*)(P.ws + WS_K) + rowb + h * 256 + m * 128;
    r.V = (const bf16*)(P.ws + WS_V) + rowb + h * 256;
    r.O = (bf16*)(P.ws + (m ? WS_O1 : WS_XN)) + rowb + (size_t)qb * 128 * D + h * 256;
    r.P0 = qb * 128; return r;
}
__device__ __forceinline__ void p2_attention2(Frame& F, const Ptrs& P, char* lds) {
    float* btab = (float*)(lds + attn2::BIAS_OFF);
    for (int s2 = F.vcu; s2 < BATCH * 16; s2 += F.G) {
        const int st = s2 >> 1, half = s2 & 1, h = (st >> 1) & 3;
        __syncthreads();
        if (F.tid < attn2::NBIAS) { const int rel = 63 - F.tid; btab[F.tid] = (P.rel_bias[attn2::t5_bucket(rel) * 4 + h] - P.rel_bias[15 * 4 + h]) * (1.0f / attn2::SCALE); }
        __syncthreads();
#define QB_OF(i) (2 * (7 - (i)) + (((7 - (i)) & 1) ^ half))
        const int tid_ = F.wave * 64 + lane_fresh();
        attn2::Seam S; attn2::BlockRef cur = attn2_ref(P, st, QB_OF(0));
        attn2::attn_prime(cur, lds, S, tid_);
#pragma unroll 1
        for (int i = 0; i < 8; ++i) {
            const attn2::BlockRef nxt = (i < 7) ? attn2_ref(P, st, QB_OF(i + 1)) : cur;
            attn2::attn_block(cur, nxt, lds, S, tid_);
            cur = nxt;
        }
#undef QB_OF
    }
}
__device__ __forceinline__ void p2_attention(Frame& F, const Ptrs& P, char* lds) {
    float* btab = (float*)(lds + attn::BIAS_OFF);
    for (int s = F.vcu; s < BATCH * 16; s += F.G) {
        const int h = (s >> 2) & 3;
        __syncthreads();
        if (F.tid < attn::NBIAS) { const int rel = 63 - F.tid; btab[F.tid] = (P.rel_bias[attn::t5_bucket(rel) * 4 + h] - P.rel_bias[15 * 4 + h]) * (1.0f / attn::SCALE); }
        __syncthreads();
        attn::Seam S; attn::BlockRef cur = attn_ref(P, s, 0);
        attn::attn_prime(cur, lds, S);
#pragma unroll 1
        for (int qb = 0; qb < 8; ++qb) {
            const attn::BlockRef nxt = (qb < 7) ? attn_ref(P, s, qb + 1) : cur;
            attn::attn_block(cur, nxt, lds, S);
            cur = nxt;
        }
    }
}
__device__ __forceinline__ void p2b_combine(Frame& F, const Ptrs& P) {
    bf16* O0 = (bf16*)(P.ws + WS_XN); const bf16* O1 = (const bf16*)(P.ws + WS_O1);
    const int gw = F.vcu * NWAVES + F.wave, NGW = F.G * NWAVES, c0 = 16 * F.lane;
    const float l0 = wave_sum(P.lq[F.lane] * P.lk[F.lane] + P.lq[64 + F.lane] * P.lk[64 + F.lane]), l1 = wave_sum(P.lq[128 + F.lane] * P.lk[128 + F.lane] + P.lq[192 + F.lane] * P.lk[192 + F.lane]);
    const float lam = expf(l0) - expf(l1) + LAM_INIT;
    float g[16];
#pragma unroll
    for (int i = 0; i < 16; ++i) g[i] = P.subln_g[(c0 & 255) + i] * (1.f - LAM_INIT);
    for (int m = gw; m < T; m += NGW) { const size_t off = (size_t)m * D + c0;
        const v4u a0 = *(const GAS v4u*)(O0 + off), a1 = *(const GAS v4u*)(O0 + off + 8), b0 = *(const GAS v4u*)(O1 + off), b1 = *(const GAS v4u*)(O1 + off + 8);
        float d[16]; float ss = 0.f;
#pragma unroll
        for (int i = 0; i < 4; ++i) { d[2 * i] = bflo(a0[i]) - lam * bflo(b0[i]); d[2 * i + 1] = bfhi(a0[i]) - lam * bfhi(b0[i]); d[8 + 2 * i] = bflo(a1[i]) - lam * bflo(b1[i]); d[8 + 2 * i + 1] = bfhi(a1[i]) - lam * bfhi(b1[i]); }
#pragma unroll
        for (int i = 0; i < 16; ++i) ss += d[i] * d[i];
        ss += __shfl_xor(ss, 1); ss += __shfl_xor(ss, 2); ss += __shfl_xor(ss, 4); ss += __shfl_xor(ss, 8);
        const float rs = 1.f / sqrtf(ss * (1.f / 256.f) + RMS_EPS);
        v4u oa, ob;
#pragma unroll
        for (int i = 0; i < 4; ++i) { oa[i] = pk2(d[2 * i] * rs * g[2 * i], d[2 * i + 1] * rs * g[2 * i + 1]); ob[i] = pk2(d[8 + 2 * i] * rs * g[8 + 2 * i], d[8 + 2 * i + 1] * rs * g[8 + 2 * i + 1]); }
        *(GAS v4u*)(O0 + off) = oa; *(GAS v4u*)(O0 + off + 8) = ob; }
}
__device__ __forceinline__ void pe_experts(Frame& F, const Ptrs& P) {
    LAS float* scr = (LAS float*)(F.lds + RING_OFF + F.wave * 16384);
    const int gw = F.vcu * NWAVES + F.wave, NGW = F.G * NWAVES;
    bf16* Wgu = (bf16*)(P.ws + WS_WGU); bf16* Wd = (bf16*)(P.ws + WS_WD);
    constexpr int I_GU = (D / 64) * (DE / 32), I_DN = (DE / 64) * (D / 32);
    for (int it = gw; it < NE * (2 * I_GU + I_DN); it += NGW) {
        const int e = it / (2 * I_GU + I_DN); int r = it - e * (2 * I_GU + I_DN);
        if (r < 2 * I_GU) { const int up = r >= I_GU; r -= up * I_GU; const int kb = r / (DE / 32), nb = r % (DE / 32), n0 = 32 * nb;
            if (MOE_FP8) transpose_item8((up ? P.w_up_e : P.w_gate_e) + (size_t)e * D * DE, D, DE, 64 * kb, n0, (unsigned char*)(P.ws + WS_WGU8) + (size_t)e * 1024 * D, 256 * (n0 >> 7) + 128 * up + (n0 & 127), scr, F.lane);
            else transpose_item((up ? P.w_up_e : P.w_gate_e) + (size_t)e * D * DE, D, DE, 64 * kb, n0, Wgu + (size_t)e * 1024 * D, 256 * (n0 >> 7) + 128 * up + (n0 & 127), scr, F.lane); }
        else { r -= 2 * I_GU; const int kb = r / (D / 32), nb = r % (D / 32);
            if (MOE_FP8 && MOE_FP8_DOWN) transpose_item8(P.w_down_e + (size_t)e * DE * D, DE, D, 64 * kb, 32 * nb, (unsigned char*)(P.ws + WS_WD8) + (size_t)e * D * DE, 32 * nb, scr, F.lane);
            else transpose_item(P.w_down_e + (size_t)e * DE * D, DE, D, 64 * kb, 32 * nb, Wd + (size_t)e * D * DE, 32 * nb, scr, F.lane); }
    }
}
__device__ __forceinline__ int rw_index(int idx, int& d, int& o) { d = idx / 36; o = idx - d * 36; const int j = d >> 8, l = (d & 255) >> 2, i = d & 3, c = o >> 2, k = o & 3; return ((((j * 4 + i) * 9 + c) * 64 + l) << 2) + k; }
__device__ __forceinline__ float rw_value(const Ptrs& P, int d, int o) { if (o < 4) return P.w_group[d * 4 + o]; const int g = (o - 4) >> 3, e = (o - 4) & 7; return P.w_sub[((size_t)g * D + d) * 8 + e]; }
__device__ __forceinline__ void rw_build_global(Frame& F, const Ptrs& P) {
    float* img = (float*)(P.ws + WS_RWIMG);
    for (int idx = F.vcu * (NWAVES * 64) + F.tid; idx < D * 36; idx += F.G * NWAVES * 64) { int d, o; const int at = rw_index(idx, d, o); img[at] = rw_value(P, d, o); }
}
__device__ __forceinline__ void rw_fill_lds(Frame& F, const Ptrs& P) {
    const GAS v4u* src = (const GAS v4u*)(P.ws + WS_RWIMG); LAS v4u* dst = (LAS v4u*)(F.lds + RING_OFF);
#pragma unroll 6
    for (int q = F.tid; q < RW_BYTES / 16; q += NWAVES * 64) dst[q] = src[q];
}
__device__ __forceinline__ void p5_ln_route(Frame& F, const Ptrs& P, bool prefilled) {
    LAS float* RW = (LAS float*)(F.lds + RING_OFF);
    LAS int* lcnt = (LAS int*)(F.lds + TAB_OFF);
    LAS float* rs = (LAS float*)(F.lds + RSCR_OFF) + F.wave * 128;
    if (!prefilled) for (int idx = F.tid; idx < D * 36; idx += NWAVES * 64) { const int d = idx / 36, o = idx - d * 36; float w;
        if (o < 4) w = P.w_group[d * 4 + o]; else { const int g = (o - 4) >> 3, e = (o - 4) & 7; w = P.w_sub[((size_t)g * D + d) * 8 + e]; }
        const int j = d >> 8, l = (d & 255) >> 2, i = d & 3, c = o >> 2, k = o & 3;
        RW[((((j * 4 + i) * 9 + c) * 64 + l) << 2) + k] = w; }
    if (F.tid < 32) lcnt[F.tid] = 0;
    __syncthreads();
    float* pre = (float*)(P.ws + WS_PRE); bf16* x1b = (bf16*)(P.ws + WS_XN);
    int* eid = (int*)(P.ws + WS_EID); float* ew = (float*)(P.ws + WS_EW); int* rank = (int*)(P.ws + WS_RANK);
    const int rows_per_wg = T / F.G, rbase = blockIdx.x * rows_per_wg;
    static_assert(pg8::PRE_BF16, "the pipelined LN1/routing loop reads bf16 pre");
    v2u raw[2][4];
#define P5_LOADPAIR(rp_) do { _Pragma("unroll") for (int r = 0; r < 2; ++r) { const GAS v2u* pr = (const GAS v2u*)((const bf16*)pre + (size_t)(rbase + (rp_) + r) * D) + F.lane; \
        _Pragma("unroll") for (int j = 0; j < 4; ++j) raw[r][j] = pr[64 * j]; } } while (0)
    if (F.wave * 2 < rows_per_wg) P5_LOADPAIR(F.wave * 2);
    for (int rp = F.wave * 2; rp < rows_per_wg; rp += NWAVES * 2) {
        f32x4 xv[2][4];
#pragma unroll
        for (int r = 0; r < 2; ++r) { const int row = rbase + rp + r;
            f32x4 v[4]; float s = 0.f;
#pragma unroll
            for (int j = 0; j < 4; ++j) { const v2u w = raw[r][j]; v[j] = (f32x4){bflo(w.x), bfhi(w.x), bflo(w.y), bfhi(w.y)}; s += (v[j].x + v[j].y) + (v[j].z + v[j].w); }
            const float mean = wave_sum_fast(s) * (1.f / D); float s2 = 0.f;
#pragma unroll
            for (int j = 0; j < 4; ++j) { v[j] = v[j] - mean; s2 += (v[j].x * v[j].x + v[j].y * v[j].y) + (v[j].z * v[j].z + v[j].w * v[j].w); }
            const float rstd = 1.f / sqrtf(wave_sum_fast(s2) * (1.f / D) + LN_EPS);
            GAS unsigned long long* o8 = (GAS unsigned long long*)(x1b + (size_t)row * D) + F.lane;
#pragma unroll
            for (int j = 0; j < 4; ++j) { const f32x4 g = *((const GAS f32x4*)P.ln1_g + F.lane + 64 * j), b = *((const GAS f32x4*)P.ln1_b + F.lane + 64 * j); const f32x4 y = v[j] * rstd * g + b;
                xv[r][j] = y; if (!(X1_RECOMPUTE && MOE_FP8)) o8[64 * j] = (unsigned long long)pk2(y.x, y.y) | ((unsigned long long)pk2(y.z, y.w) << 32);
                if (MOE_FP8) *((GAS unsigned*)(P.ws + WS_X18 + (size_t)row * D) + F.lane + 64 * j) = pg8::pk4_fp8(y.x, y.y, y.z, y.w); } }
        if (rp + NWAVES * 2 < rows_per_wg) P5_LOADPAIR(rp + NWAVES * 2);
        f32x4 acc[2][9];
#pragma unroll
        for (int r = 0; r < 2; ++r)
#pragma unroll
            for (int c = 0; c < 9; ++c) acc[r][c] = (f32x4){0.f, 0.f, 0.f, 0.f};
        asm volatile("" ::: "memory"); __builtin_amdgcn_sched_barrier(0);
#pragma unroll
        for (int j = 0; j < 4; ++j)
#pragma unroll
            for (int i = 0; i < 4; ++i)
                { const LAS f32x4* wp = (const LAS f32x4*)(RW + (((j * 4 + i) * 9 * 64 + F.lane) << 2));
#pragma unroll
                  for (int c = 0; c < 9; ++c) { const f32x4 w = wp[c * 64]; acc[0][c] += w * xv[0][j][i]; acc[1][c] += w * xv[1][j][i]; }
                  asm volatile("" : "+v"(acc[0][0]), "+v"(acc[0][1]), "+v"(acc[0][2]), "+v"(acc[0][3]), "+v"(acc[0][4]), "+v"(acc[0][5]), "+v"(acc[0][6]), "+v"(acc[0][7]), "+v"(acc[0][8]) :: "memory");
                  asm volatile("" : "+v"(acc[1][0]), "+v"(acc[1][1]), "+v"(acc[1][2]), "+v"(acc[1][3]), "+v"(acc[1][4]), "+v"(acc[1][5]), "+v"(acc[1][6]), "+v"(acc[1][7]), "+v"(acc[1][8]) :: "memory");
                  __builtin_amdgcn_sched_barrier(0); }
        { float Y[36];
#pragma unroll
          for (int k = 0; k < 36; ++k) { const int i0 = 2 * k, i1 = 2 * k + 1;
              const auto rr = __builtin_amdgcn_permlane32_swap(__float_as_uint(acc[i0 / 36][(i0 % 36) >> 2][i0 & 3]), __float_as_uint(acc[i1 / 36][(i1 % 36) >> 2][i1 & 3]), false, false);
              Y[k] = __uint_as_float(rr[0]) + __uint_as_float(rr[1]); }
          float Z[18];
#pragma unroll
          for (int m = 0; m < 18; ++m) { const auto rr = __builtin_amdgcn_permlane16_swap(__float_as_uint(Y[2 * m]), __float_as_uint(Y[2 * m + 1]), false, false);
              Z[m] = __uint_as_float(rr[0]) + __uint_as_float(rr[1]); }
#pragma unroll
          for (int m = 0; m < 18; ++m) {
              Z[m] += __int_as_float(__builtin_amdgcn_update_dpp(0, __float_as_int(Z[m]), 0x128, 0xf, 0xf, false));
              Z[m] += __int_as_float(__builtin_amdgcn_update_dpp(0, __float_as_int(Z[m]), 0x124, 0xf, 0xf, false));
              Z[m] += __int_as_float(__builtin_amdgcn_update_dpp(0, __float_as_int(Z[m]), 0x122, 0xf, 0xf, false));
              Z[m] += __int_as_float(__builtin_amdgcn_update_dpp(0, __float_as_int(Z[m]), 0x121, 0xf, 0xf, false)); }
          const int rho = F.lane >> 4, pr = ((rho & 1) << 1) | (rho >> 1);
          if ((F.lane & 15) == 0) {
#pragma unroll
              for (int m = 0; m < 18; ++m) { const int idx = 4 * m + pr; rs[idx >= 36 ? idx + 28 : idx] = Z[m]; } } }
        LDS_WAIT(); asm volatile("" ::: "memory");
        if (F.lane < 2) { const int r = F.lane, row = rbase + rp + r; const LAS float* sa = rs + r * 64;
            float gmax = sa[0] + P.b_group[0]; int gi = 0;
            for (int g = 1; g < 4; ++g) { const float v = sa[g] + P.b_group[g]; if (v > gmax) { gmax = v; gi = g; } }
            float z = 0.f;
            for (int g = 0; g < 4; ++g) z += expf(sa[g] + P.b_group[g] - gmax);
            const float gp = 1.f / z;
            const LAS float* sl = sa + 4 + gi * 8; const float* bs = P.b_sub + gi * 8;
            float b0 = sl[0] + bs[0]; int i0 = 0;
            for (int e = 1; e < 8; ++e) { const float v = sl[e] + bs[e]; if (v > b0) { b0 = v; i0 = e; } }
            float b1 = -__builtin_inff(); int i1 = 0;
            for (int e = 0; e < 8; ++e) { const float v = sl[e] + bs[e]; if (e != i0 && v > b1) { b1 = v; i1 = e; } }
            const float e1 = expf(b1 - b0); const float w0 = gp / (1.f + e1), w1 = gp * e1 / (1.f + e1);
            const int ex0 = gi * 8 + i0, ex1 = gi * 8 + i1;
            eid[row * 2] = ex0; eid[row * 2 + 1] = ex1; ew[row * 2] = w0; ew[row * 2 + 1] = w1;
            const int r0 = __hip_atomic_fetch_add(lcnt + ex0, 1, __ATOMIC_RELAXED, __HIP_MEMORY_SCOPE_WORKGROUP), r1 = __hip_atomic_fetch_add(lcnt + ex1, 1, __ATOMIC_RELAXED, __HIP_MEMORY_SCOPE_WORKGROUP);
            if (PLACE_ATOMIC) { LAS int* le = (LAS int*)(F.lds + LEID_OFF) + (rp + r) * 2; LAS int* lr = (LAS int*)(F.lds + LRANK_OFF) + (rp + r) * 2; le[0] = ex0; le[1] = ex1; lr[0] = r0; lr[1] = r1; }
            else { rank[row * 2] = r0; rank[row * 2 + 1] = r1; } }
        LDS_WAIT(); asm volatile("" ::: "memory");
    }
    __syncthreads();
    if (PLACE_ATOMIC) {
        LAS int* wgb = lcnt + 64;
        if (F.tid < 32) wgb[F.tid] = (int)__hip_atomic_fetch_add((unsigned*)F.ctl + CW_GCNT + 64 * F.tid, (unsigned)lcnt[F.tid], __ATOMIC_RELAXED, __HIP_MEMORY_SCOPE_AGENT);
        __syncthreads();
        int* toke = (int*)(P.ws + WS_TOKE);
        for (int a = F.tid; a < rows_per_wg * 2; a += NWAVES * 64) { const int e = ((LAS int*)(F.lds + LEID_OFF))[a], p = wgb[e] + ((LAS int*)(F.lds + LRANK_OFF))[a]; rank[rbase * 2 + a] = p; toke[e * TOKE_CAP + p] = rbase + (a >> 1); }
    } else if (F.tid < 32) ((int*)(P.ws + WS_CNTWG))[blockIdx.x * 32 + F.tid] = lcnt[F.tid];
}
__device__ __forceinline__ void moe_tab(Frame& F, const Ptrs& P) {
    LAS int* tab = (LAS int*)(F.lds + TAB_OFF);
    const int* cntwg = (const int*)(P.ws + WS_CNTWG);
    __syncthreads();
    if (PLACE_ATOMIC) { if (F.tid < 32) tab[96 + F.tid] = (int)__hip_atomic_load((unsigned*)F.ctl + CW_GCNT + 64 * F.tid, __ATOMIC_RELAXED, __HIP_MEMORY_SCOPE_AGENT); }
    else if (F.tid < 32) { int tot = 0, base = 0;
        for (int w = 0; w < F.G; ++w) { const int c = __hip_atomic_load(cntwg + w * 32 + F.tid, __ATOMIC_RELAXED, __HIP_MEMORY_SCOPE_AGENT); base += (w < (int)blockIdx.x) ? c : 0; tot += c; }
        tab[96 + F.tid] = tot; tab[64 + F.tid] = base; }
    __syncthreads();
    if (F.tid == 0) { int s = 0; for (int e = 0; e < 32; ++e) { tab[e] = s; s += (tab[96 + e] + 255) & ~255; } tab[32] = s; }
    __syncthreads();
}
__device__ __forceinline__ void p5b_place(Frame& F, const Ptrs& P) {
    LAS int* tab = (LAS int*)(F.lds + TAB_OFF);
    moe_tab(F, P);
    const int rows_per_wg = T / F.G, rbase = blockIdx.x * rows_per_wg;
    const int* eid = (const int*)(P.ws + WS_EID); const int* rank = (const int*)(P.ws + WS_RANK); int* slot = (int*)(P.ws + WS_SLOT);
    int* tokl = (int*)(P.ws + WS_TOK);
    for (int a = F.tid; a < rows_per_wg * 2; a += NWAVES * 64) { const int ga = rbase * 2 + a, e = eid[ga]; const int s = tab[e] + tab[64 + e] + rank[ga]; slot[ga] = s; tokl[s] = ga >> 1; }
    if (blockIdx.x < 32) { const int e = blockIdx.x; for (int s = tab[e] + tab[96 + e] + F.tid; s < tab[e + 1]; s += NWAVES * 64) tokl[s] = 0; }
    { int* idl = (int*)(P.ws + WS_IDL); for (int s = blockIdx.x * (NWAVES * 64) + F.tid; s < MAXS; s += F.G * NWAVES * 64) idl[s] = s; }
}
#if MOE_Y8
struct P8Row { v4u x[2]; v2u y0[2], y1[2]; float w0, w1; };
__device__ __forceinline__ void p8_load(P8Row& R, const bf16* x1, const bf16* y, const int* slot, const float* ew, int row, int lane, const int* eid, const LAS int* tab) {
    int s0 = slot[row * 2], s1 = slot[row * 2 + 1]; R.w0 = ew[row * 2] * (1.f / pg8::Y8_S); R.w1 = ew[row * 2 + 1] * (1.f / pg8::Y8_S);
    if (PLACE_ATOMIC) { s0 += tab[eid[row * 2]]; s1 += tab[eid[row * 2 + 1]]; }
    const GAS v4u* xr = (const GAS v4u*)(x1 + (size_t)row * D) + lane; const GAS v2u* a = (const GAS v2u*)((const unsigned char*)y + (size_t)s0 * D) + lane; const GAS v2u* b = (const GAS v2u*)((const unsigned char*)y + (size_t)s1 * D) + lane;
    R.x[0] = xr[0]; R.x[1] = xr[64]; R.y0[0] = a[0]; R.y0[1] = a[64]; R.y1[0] = b[0]; R.y1[1] = b[64];
}
__device__ __forceinline__ void y8_unpack(const v2u w, float (&o)[8]) {
    const auto a = __builtin_amdgcn_cvt_pk_f32_fp8((int)w.x, false), b = __builtin_amdgcn_cvt_pk_f32_fp8((int)w.x, true), c = __builtin_amdgcn_cvt_pk_f32_fp8((int)w.y, false), d = __builtin_amdgcn_cvt_pk_f32_fp8((int)w.y, true);
    o[0] = a[0]; o[1] = a[1]; o[2] = b[0]; o[3] = b[1]; o[4] = c[0]; o[5] = c[1]; o[6] = d[0]; o[7] = d[1];
}
#else
struct P8Row { v4u x[2], y0[2], y1[2]; float w0, w1; };
__device__ __forceinline__ void y8_unpack(const v4u w, float (&o)[8]) {
#pragma unroll
    for (int i = 0; i < 4; ++i) { o[2 * i] = bflo(w[i]); o[2 * i + 1] = bfhi(w[i]); }
}
__device__ __forceinline__ void p8_load(P8Row& R, const bf16* x1, const bf16* y, const int* slot, const float* ew, int row, int lane, const int* eid, const LAS int* tab) {
    int s0 = slot[row * 2], s1 = slot[row * 2 + 1]; R.w0 = ew[row * 2]; R.w1 = ew[row * 2 + 1];
    if (PLACE_ATOMIC) { s0 += tab[eid[row * 2]]; s1 += tab[eid[row * 2 + 1]]; }
    const GAS v4u* xr = (const GAS v4u*)(x1 + (size_t)row * D) + lane; const GAS v4u* a = (const GAS v4u*)(y + (size_t)s0 * D) + lane; const GAS v4u* b = (const GAS v4u*)(y + (size_t)s1 * D) + lane;
    R.x[0] = xr[0]; R.x[1] = xr[64]; R.y0[0] = a[0]; R.y0[1] = a[64]; R.y1[0] = b[0]; R.y1[1] = b[64];
}
#endif
__device__ __forceinline__ void p8_finish(const P8Row& R, const Ptrs& P, int row, int lane, bool poison) {
    float v[16]; float s = 0.f; float ya[2][8], yb[2][8]; y8_unpack(R.y0[0], ya[0]); y8_unpack(R.y0[1], ya[1]); y8_unpack(R.y1[0], yb[0]); y8_unpack(R.y1[1], yb[1]);
    float xq[16];
#pragma unroll
    for (int h = 0; h < 2; ++h)
#pragma unroll
        for (int i = 0; i < 4; ++i) { xq[8 * h + 2 * i] = bflo(R.x[h][i]); xq[8 * h + 2 * i + 1] = bfhi(R.x[h][i]); }
    if (X1_RECOMPUTE && MOE_FP8) {
        float t = 0.f;
#pragma unroll
        for (int i = 0; i < 16; ++i) t += xq[i];
        const float mu = wave_sum_fast(t) * (1.f / D); float t2 = 0.f;
#pragma unroll
        for (int i = 0; i < 16; ++i) { xq[i] -= mu; t2 += xq[i] * xq[i]; }
        const float rs = 1.f / sqrtf(wave_sum_fast(t2) * (1.f / D) + LN_EPS);
#pragma unroll
        for (int h = 0; h < 2; ++h)
#pragma unroll
            for (int q = 0; q < 2; ++q) { const int c = 512 * h + 8 * lane + 4 * q; const f32x4 g = *(const GAS f32x4*)(P.ln1_g + c), b = *(const GAS f32x4*)(P.ln1_b + c);
#pragma unroll
                for (int k = 0; k < 4; ++k) xq[8 * h + 4 * q + k] = xq[8 * h + 4 * q + k] * rs * g[k] + b[k]; }
    }
#pragma unroll
    for (int i = 0; i < 16; ++i) v[i] = ALPHA * xq[i] + R.w0 * ya[i >> 3][i & 7] + R.w1 * yb[i >> 3][i & 7];
#pragma unroll
    for (int i = 0; i < 16; ++i) s += v[i];
    const float mean = wave_sum_fast(s) * (1.f / D); float s2 = 0.f;
#pragma unroll
    for (int i = 0; i < 16; ++i) { v[i] -= mean; s2 += v[i] * v[i]; }
    const float rstd = 1.f / sqrtf(wave_sum_fast(s2) * (1.f / D) + LN_EPS);
    const float qn = __builtin_nanf("");
#pragma unroll
    for (int h = 0; h < 2; ++h)
#pragma unroll
        for (int q = 0; q < 2; ++q) { const int c = 512 * h + 8 * lane + 4 * q; const f32x4 g = *(const GAS f32x4*)(P.ln2_g + c), b = *(const GAS f32x4*)(P.ln2_b + c);
            f32x4 o = {v[8 * h + 4 * q] * rstd * g.x + b.x, v[8 * h + 4 * q + 1] * rstd * g.y + b.y, v[8 * h + 4 * q + 2] * rstd * g.z + b.z, v[8 * h + 4 * q + 3] * rstd * g.w + b.w};
            if (poison) o = (f32x4){qn, qn, qn, qn};
            *(GAS f32x4*)(P.out + (size_t)row * D + c) = o; }
}
__device__ __forceinline__ void p8_final(Frame& F, const Ptrs& P, bool poison) {
    const bf16* x1 = (const bf16*)(P.ws + ((X1_RECOMPUTE && MOE_FP8) ? WS_PRE : WS_XN)); const bf16* y = (const bf16*)(P.ws + WS_XG);
    const int* slot = (const int*)(P.ws + (PLACE_ATOMIC ? WS_RANK : WS_SLOT)); const int* eid = (const int*)(P.ws + WS_EID); const LAS int* tab = (const LAS int*)(F.lds + TAB_OFF); const float* ew = (const float*)(P.ws + WS_EW);
    const int rows_per_wg = T / F.G, rbase = blockIdx.x * rows_per_wg;
#if P10_DEPTH3
    P8Row R0, R1, R2; const int nr = (rows_per_wg - F.wave + NWAVES - 1) / NWAVES;
#define P8_ROW(i_) (rbase + F.wave + NWAVES * (i_))
    if (0 < nr) p8_load(R0, x1, y, slot, ew, P8_ROW(0), F.lane, eid, tab);
    if (1 < nr) p8_load(R1, x1, y, slot, ew, P8_ROW(1), F.lane, eid, tab);
    for (int i = 0; i < nr; i += 3) {
        if (i + 2 < nr) p8_load(R2, x1, y, slot, ew, P8_ROW(i + 2), F.lane, eid, tab);
        p8_finish(R0, P, P8_ROW(i), F.lane, poison);
        if (i + 1 < nr) { if (i + 3 < nr) p8_load(R0, x1, y, slot, ew, P8_ROW(i + 3), F.lane, eid, tab); p8_finish(R1, P, P8_ROW(i + 1), F.lane, poison); }
        if (i + 2 < nr) { if (i + 4 < nr) p8_load(R1, x1, y, slot, ew, P8_ROW(i + 4), F.lane, eid, tab); p8_finish(R2, P, P8_ROW(i + 2), F.lane, poison); }
    }
#undef P8_ROW
#else
    P8Row A, B;
    int rr = F.wave; if (rr < rows_per_wg) p8_load(A, x1, y, slot, ew, rbase + rr, F.lane, eid, tab);
    for (; rr < rows_per_wg; rr += 2 * NWAVES) {
        const bool hasB = rr + NWAVES < rows_per_wg; if (hasB) p8_load(B, x1, y, slot, ew, rbase + rr + NWAVES, F.lane, eid, tab);
        p8_finish(A, P, rbase + rr, F.lane, poison);
        if (hasB) { if (rr + 2 * NWAVES < rows_per_wg) p8_load(A, x1, y, slot, ew, rbase + rr + 2 * NWAVES, F.lane, eid, tab); p8_finish(B, P, rbase + rr + NWAVES, F.lane, poison); }
    }
#endif
}

constexpr int N_PHASES = 11;
struct Args { Ptrs p; int ph_lo, ph_hi, bar_region, flags; };
__global__ void __launch_bounds__(NWAVES * 64, 2) mega_fwd(Args args) {
    extern __shared__ __attribute__((aligned(16))) unsigned char lds[];
    Frame F; const Ptrs& P = args.p;
    F.lds = (LAS unsigned char*)lds; F.MISC = (volatile LAS unsigned*)(F.lds + MISC_OFF);
    F.wave = __builtin_amdgcn_readfirstlane((int)threadIdx.x >> 6);
#define REFRESH() do { F.lane = lane_fresh(); F.tid = F.wave * 64 + F.lane; } while (0)
    REFRESH();
    F.G = gridDim.x; { const int bx = blockIdx.x; F.vcu = (F.G % 8 == 0) ? (bx % 8) * (F.G / 8) + bx / 8 : bx; }
    F.ctl = (gu32*)(P.ws + WS_CTL);
    for (int u = F.tid; u < (LDS_BYTES - LDSCTL_OFF) / 4; u += NWAVES * 64) ((LAS unsigned*)(F.lds + LDSCTL_OFF))[u] = 0u;
    __syncthreads();
    XcdBarrier bar = xcd_barrier_post((unsigned*)(F.ctl + CW_BAR) + args.bar_region * XCD_BAR_WORDS, F.MISC + 8, F.wave);
    const int lo = args.ph_lo, hi = args.ph_hi;
#ifndef PH_MASK
#define PH_MASK 0x7ff
#endif
#define IN(k) (((PH_MASK >> (k)) & 1) && lo <= (k) && (k) < hi)
#define BOTH(k) (IN(k) && IN((k) + 1))
#define GRID_BAR() xcd_barrier(bar)
    const bool grid_ok = (F.G == 256);

    if (IN(0)) { REFRESH(); p0_prologue(F, P); if (RW_PREFILL) rw_build_global(F, P); if (BOTH(0)) GRID_BAR(); }
    if (IN(1)) { REFRESH();
        constexpr int F8N = INPROJ_F8_HI - INPROJ_F8_LO;
        if (F8N > 0) { pg8::Gemm g{(const pg8::bf16_t*)(P.ws + WS_XN8), (const pg8::bf16_t*)(P.ws + WS_WIN8), T, F8N * 256, D / 2}; pg8::RangeOrder S; S.S.init(T, F8N * 256, F.G, (int)blockIdx.x); S.S.wgm = F8_WGM; S.pn0 = INPROJ_F8_LO;
            pg8::EpiInProj E{(pg8::bf16_t*)(P.ws + WS_Q), (size_t)(WS_K - WS_Q) / 2, BUF_CB(P), (pg8::bf16_t*)(P.ws + WS_Z), BUF_SGA(P), BUF_SGB(P), 1.f / (pg8::F8_WS * XN8_S)};
            pg8::gemm_phase<pg8::EpiInProj, pg8::RangeOrder, true, true, false, true>(F.lds + RING_OFF, F.wave, g, S, E); }
        if (F8N > 0 && F8N < 32) __syncthreads();
        if (F8N < 32) { pg8::Gemm g{(const pg8::bf16_t*)BUF_XN(P), (const pg8::bf16_t*)(P.ws + WS_WIN), T, (32 - F8N) * 256, D}; pg8::RangeOrder S; S.S.init(T, (32 - F8N) * 256, F.G, (int)blockIdx.x); S.pn0 = INPROJ_F8_HI & 31;
            pg8::EpiInProj E{(pg8::bf16_t*)(P.ws + WS_Q), (size_t)(WS_K - WS_Q) / 2, BUF_CB(P), (pg8::bf16_t*)(P.ws + WS_Z), BUF_SGA(P), BUF_SGB(P), 1.f};
            pg8::gemm_phase<pg8::EpiInProj, pg8::RangeOrder, P1_ALIGN, P1_SP2>(F.lds + RING_OFF, F.wave, g, S, E); }
        if (BOTH(1)) GRID_BAR();
    }
    if (IN(2)) { REFRESH(); if (!(args.flags & 2)) p2_conv(F, P); if (ATTN_PAIR) p2_attention2(F, P, (char*)lds + RING_OFF); else p2_attention(F, P, (char*)lds + RING_OFF); if (BOTH(2)) GRID_BAR(); }
    if (IN(3)) { REFRESH(); if (!(args.flags & 1)) p2b_combine(F, P); pe_experts(F, P); if (BOTH(3)) GRID_BAR(); }
    static_assert(GATE_MERGED || !G8XN, "the 8-bit gate codes are read by the merged gate GEMM only");
    if (IN(4) && GATE_MERGED) { REFRESH();
        static_assert(WS_WB == WS_WA + 2 * MiB && WS_CB > WS_XN, "merged gate GEMM: the W_A | W_B copy spans both slots; u lies behind ao");
        pg8::Gemm g{(const pg8::bf16_t*)(P.ws + WS_XN), (const pg8::bf16_t*)(P.ws + WS_WA), T, D, 2 * D, D, D / pg8::BK, (unsigned)(WS_CB - WS_XN)}; pg8::StaticOrder S; S.init(T, D, F.G, (int)blockIdx.x);
        pg8::EpiGateM E{BUF_SGA(P), BUF_SGB(P), (pg8::bf16_t*)(P.ws + WS_Z), P.b_gate};
        pg8::gemm_phase<pg8::EpiGateM, pg8::StaticOrder, true, true, false, false, true>(F.lds + RING_OFF, F.wave, g, S, E);
        if (BOTH(4)) GRID_BAR();
    } else if (IN(4)) { REFRESH();
#if STAGGER_TICKS
        { const unsigned long long t0 = __builtin_amdgcn_s_memrealtime(); const unsigned long long w = (unsigned long long)(blockIdx.x & 3) * STAGGER_TICKS;
          while (__builtin_amdgcn_s_memrealtime() - t0 < w) __builtin_amdgcn_s_sleep(8); }
#endif
        { pg8::Gemm g{(const pg8::bf16_t*)(P.ws + WS_XN), (const pg8::bf16_t*)(P.ws + WS_WA), T, D, D}; pg8::StaticOrder S; S.init(T, D, F.G, (int)blockIdx.x);
          pg8::EpiGate<false> E{BUF_SGA(P), nullptr, (pg8::bf16_t*)(P.ws + WS_O1), P.b_gate};
          pg8::gemm_phase<pg8::EpiGate<false>, pg8::StaticOrder, true, true>(F.lds + RING_OFF, F.wave, g, S, E); }
        __syncthreads();
        { pg8::Gemm g{BUF_CB(P), (const pg8::bf16_t*)(P.ws + WS_WB), T, D, D}; pg8::StaticOrder S; S.init(T, D, F.G, (int)blockIdx.x);
          pg8::EpiGate<true> E{BUF_SGB(P), (const pg8::bf16_t*)(P.ws + WS_O1), (pg8::bf16_t*)(P.ws + WS_Z), P.b_gate + 1024};
          pg8::gemm_phase<pg8::EpiGate<true>, pg8::StaticOrder, true, true>(F.lds + RING_OFF, F.wave, g, S, E); }
        if (BOTH(4)) GRID_BAR();
    }
    if (IN(5)) { REFRESH();
        pg8::Gemm g{(const pg8::bf16_t*)(P.ws + WS_Z), (const pg8::bf16_t*)(P.ws + WS_WO), T, D, D}; pg8::StaticOrder S; S.init(T, D, F.G, (int)blockIdx.x);
#if G8XN && RES_STREAM
        g.R = (const pg8::bf16_t*)BUF_XN(P); g.ralpha = ALPHA; pg8::EpiStoreBf16 E{(pg8::bf16_t*)(P.ws + WS_PRE)};
        pg8::gemm_phase<pg8::EpiStoreBf16, pg8::StaticOrder, true, true, false, false, false, true>(F.lds + RING_OFF, F.wave, g, S, E);
#elif G8XN
        pg8::EpiPre2 E{(const pg8::bf16_t*)BUF_XN(P), (pg8::bf16_t*)(P.ws + WS_PRE), ALPHA};
        pg8::gemm_phase<pg8::EpiPre2, pg8::StaticOrder, true, true>(F.lds + RING_OFF, F.wave, g, S, E);
#else
        pg8::EpiPre E{P.x, (const float*)(P.ws + WS_STATS), P.ln_in_g, P.ln_in_b, (float*)(P.ws + WS_PRE), ALPHA};
        pg8::gemm_phase<pg8::EpiPre, pg8::StaticOrder, true, true>(F.lds + RING_OFF, F.wave, g, S, E);
#endif
        if (RW_PREFILL && BOTH(5) && lo == 0) { REFRESH(); rw_fill_lds(F, P); }
        if (BOTH(5)) GRID_BAR();
    }
    if (IN(6)) { REFRESH(); if (grid_ok) p5_ln_route(F, P, RW_PREFILL && BOTH(5) && lo == 0); if (BOTH(6)) GRID_BAR(); }
    if (IN(7) && !PLACE_ATOMIC) { REFRESH(); if (grid_ok) p5b_place(F, P); if (BOTH(7)) GRID_BAR(); }
    if (IN(8)) { REFRESH();
        if (grid_ok && MOE_FP8) { if (lo == 8 || PLACE_ATOMIC) moe_tab(F, P); pg8::Gemm g{(const pg8::bf16_t*)(P.ws + WS_X18), (const pg8::bf16_t*)(P.ws + WS_WGU8), MAXS, NE * 1024, D / 2};
          pg8::MoeOrder S{(const PG8_LAS int*)(F.lds + TAB_OFF), F.G, F.vcu, (unsigned*)(F.ctl + CW_MOE), 0u, MOE_HANDOFF != 0, (unsigned*)(F.ctl + CW_TMO), 0, -1, F.wave};
          if (MOE_FP8_DOWN) { pg8::EpiMoeUp8 E{(unsigned char*)P.out}; pg8::gemm_phase<pg8::EpiMoeUp8, pg8::MoeOrder, true, true, true, true>(F.lds + RING_OFF, F.wave, g, S, E, (const int*)(P.ws + (PLACE_ATOMIC ? WS_TOKE : WS_TOK))); S.flush(); }
          else { pg8::EpiMoeUp E{(pg8::bf16_t*)P.out, 1.f / pg8::F8_WS}; pg8::gemm_phase<pg8::EpiMoeUp, pg8::MoeOrder, true, true, true, true>(F.lds + RING_OFF, F.wave, g, S, E, (const int*)(P.ws + WS_TOK)); } }
        else if (grid_ok) { if (lo == 8) moe_tab(F, P); pg8::Gemm g{(const pg8::bf16_t*)(P.ws + WS_XN), (const pg8::bf16_t*)(P.ws + WS_WGU), MAXS, NE * 1024, D};
          pg8::MoeOrder S{(const PG8_LAS int*)(F.lds + TAB_OFF), F.G, F.vcu, (unsigned*)(F.ctl + CW_MOE), 0u, MOE_HANDOFF != 0, (unsigned*)(F.ctl + CW_TMO), 0, -1}; pg8::EpiMoeUp E{(pg8::bf16_t*)P.out, 1.f};
          pg8::gemm_phase<pg8::EpiMoeUp, pg8::MoeOrder, true, true, true>(F.lds + RING_OFF, F.wave, g, S, E, (const int*)(P.ws + WS_TOK)); S.flush(); }
        if (BOTH(8)) { if (MOE_HANDOFF) __syncthreads(); else GRID_BAR(); }
    }
    if (IN(9)) { REFRESH();
        if (grid_ok && MOE_FP8 && MOE_FP8_DOWN) { if (lo == 9) moe_tab(F, P); pg8::Gemm g{(const pg8::bf16_t*)P.out, (const pg8::bf16_t*)(P.ws + WS_WD8), MAXS, NE * 1024, DE / 2};
          const bool ho8 = MOE_HANDOFF && lo <= 8;
          pg8::MoeOrder S{(const PG8_LAS int*)(F.lds + TAB_OFF), F.G, ho8 ? (F.vcu + F.G / 2) % F.G : F.vcu, (unsigned*)(F.ctl + CW_MOE), ho8 ? 32u : 0u, false, (unsigned*)(F.ctl + CW_TMO), 0, -1, F.wave};
#if MOE_Y8
          pg8::EpiMoeDown8 E{(unsigned char*)(P.ws + WS_XG), pg8::Y8_S / (pg8::F8_WS * pg8::F8_HS)}; pg8::gemm_phase<pg8::EpiMoeDown8, pg8::MoeOrder, true, true, false, true>(F.lds + RING_OFF, F.wave, g, S, E); }
#else
          pg8::EpiMoeDown E{(pg8::bf16_t*)(P.ws + WS_XG), 1.f / (pg8::F8_WS * pg8::F8_HS)};
          if (MOE_DOWN_GATHER) pg8::gemm_phase<pg8::EpiMoeDown, pg8::MoeOrder, true, true, true, true>(F.lds + RING_OFF, F.wave, g, S, E, (const int*)(P.ws + WS_IDL)); else pg8::gemm_phase<pg8::EpiMoeDown, pg8::MoeOrder, true, true, false, true>(F.lds + RING_OFF, F.wave, g, S, E); }
#endif
        else if (grid_ok) { if (lo == 9) moe_tab(F, P); pg8::Gemm g{(const pg8::bf16_t*)P.out, (const pg8::bf16_t*)(P.ws + WS_WD), MAXS, NE * 1024, DE};
          const bool ho = MOE_HANDOFF && lo <= 8;
          pg8::MoeOrder S{(const PG8_LAS int*)(F.lds + TAB_OFF), F.G, ho ? (F.vcu + F.G / 2) % F.G : F.vcu, (unsigned*)(F.ctl + CW_MOE), ho ? 32u : 0u, false, (unsigned*)(F.ctl + CW_TMO), 0, -1}; pg8::EpiMoeDown E{(pg8::bf16_t*)(P.ws + WS_XG), 1.f};
          pg8::gemm_phase<pg8::EpiMoeDown, pg8::MoeOrder, true, true>(F.lds + RING_OFF, F.wave, g, S, E); }
        if (BOTH(9)) GRID_BAR();
    }
    if (IN(10)) { REFRESH();
        bool poison = !grid_ok || (__hip_atomic_load(F.ctl + CW_BAR + args.bar_region * XCD_BAR_WORDS + XB_TMO, RLX_AGENT) != 0u) || (__hip_atomic_load(F.ctl + CW_TMO, RLX_AGENT) != 0u);
        if (grid_ok) { if (PLACE_ATOMIC && lo == 10) moe_tab(F, P); p8_final(F, P, poison); }
        else { const float qn = __builtin_nanf(""); for (size_t i = (size_t)blockIdx.x * 512 + F.tid; i < (size_t)T * D; i += (size_t)F.G * 512) P.out[i] = qn; }
    }
#undef IN
#undef BOTH
#undef GRID_BAR
}

static void launch_mega(const Ptrs& p, int lo, int hi, int region, int flags, hipStream_t stream) {
    Args a{}; a.p = p; a.ph_lo = lo; a.ph_hi = hi; a.bar_region = region; a.flags = flags;
    hipLaunchKernelGGL(mega_fwd, dim3(256), dim3(NWAVES * 64), LDS_BYTES, stream, a);
}
extern "C" void kernel_launch(void* const* d_in, const int* in_sizes, int n_in, void* d_out, int out_size, void* d_ws, size_t ws_size, hipStream_t stream) {
    static int ready = 0;
    if (ready == 0) {
        ready = 1;
        if (n_in != 24 || out_size != T * D || ws_size < WS_END) { fprintf(stderr, "kernel_launch: unexpected shapes (n_in %d out %d ws %zu)\n", n_in, out_size, ws_size); ready = -1; }
        else if (hipFuncSetAttribute((const void*)mega_fwd, hipFuncAttributeMaxDynamicSharedMemorySize, LDS_BYTES) != hipSuccess) { fprintf(stderr, "kernel_launch: hipFuncSetAttribute failed\n"); ready = -1; }
        (void)hipGetLastError();
    }
    if (ready < 0) return;
    Ptrs p{};
    const float** pp = (const float**)&p;
    for (int i = 0; i < 24; ++i) pp[i] = (const float*)d_in[i];
    p.out = (float*)d_out; p.ws = (unsigned char*)d_ws;
    (void)hipMemsetAsync((char*)d_ws + WS_CTL, 0, CTL_ZERO_BYTES, stream);
    launch_mega(p, 0, N_PHASES, 0, 0, stream);
}
```
